# Optimizing an MI355X kernel written in HIP

```python
import jax
import jax.numpy as jnp
from jax import lax
import numpy as np

D_MODEL = 1024
BATCH = 32
SEQ = 2048
DEPTH = 2

HEAD_DIM = 64
NORM_EPS = 1e-6
A_HEADS = 8
A_WIDTH = A_HEADS * HEAD_DIM
A_PATTERNS = ((128, 1), (512, 4), (2048, 16))
A_ROT_DIMS = HEAD_DIM // 4
A_ROPE_THETA = 500000.0
B_Q_HEADS = 8
B_KV_HEADS = 2
B_Q_WIDTH = B_Q_HEADS * HEAD_DIM
B_KV_WIDTH = B_KV_HEADS * HEAD_DIM
B_ROPE_THETA = 10000.0
GRID_W = 64
Q_BLOCK = 128
IN_SPLITS = (A_WIDTH, A_WIDTH, A_WIDTH, B_Q_WIDTH, B_KV_WIDTH, B_KV_WIDTH, D_MODEL, D_MODEL)
IN_COLS = sum(IN_SPLITS)
IN_OFFSETS = tuple(int(v) for v in np.cumsum(IN_SPLITS)[:-1])
N_EXPERTS = 32
N_GROUPS = 4
EXPERTS_PER_GROUP = N_EXPERTS // N_GROUPS
TOP_K = 2
D_FF_EXPERT = D_MODEL // 2
MOE_BLOCK = 256

kernel_name = "hybrid_dilated_gqa_grouped_moe_block"


def rms_norm(x, g):
    xf = x.astype(jnp.float32)
    y = xf * lax.rsqrt(jnp.mean(xf * xf, axis=-1, keepdims=True) + NORM_EPS)
    return (y * g.astype(jnp.float32)).astype(x.dtype)


def modulate(h, shift, scale):
    return h * (1 + scale) + shift


def rope(x, pos, theta):
    half = x.shape[-1] // 2
    freqs = theta ** (-jnp.arange(half, dtype=jnp.float32) / half)
    ang = pos.astype(jnp.float32)[:, None] * freqs
    cos = jnp.cos(ang)[:, None, :]
    sin = jnp.sin(ang)[:, None, :]
    xf = x.astype(jnp.float32)
    x1, x2 = xf[..., :half], xf[..., half:]
    return jnp.concatenate([x1 * cos - x2 * sin, x2 * cos + x1 * sin], axis=-1).astype(x.dtype)


def partial_rope(x, pos):
    return jnp.concatenate([rope(x[..., :A_ROT_DIMS], pos, A_ROPE_THETA), x[..., A_ROT_DIMS:]], axis=-1)


def axial_rope(x, row, col):
    half = x.shape[-1] // 2
    return jnp.concatenate([rope(x[..., :half], row, B_ROPE_THETA), rope(x[..., half:], col, B_ROPE_THETA)], axis=-1)


def dilated_window_attention(q, k, v, dilation, radius):
    B, S, H, E = q.shape
    L = S // dilation
    nb = -(-L // radius)
    Lp = nb * radius

    def strided(a, lo, hi):
        a = a.reshape(B, L, dilation, H, E).transpose(0, 2, 1, 3, 4)
        return jnp.pad(a, ((0, 0), (0, 0), (lo, hi), (0, 0), (0, 0)))

    qs = strided(q, 0, Lp - L).reshape(B, dilation, nb, radius, H, E)

    def band(a):
        a = strided(a, radius, Lp - L + radius).reshape(B, dilation, nb + 2, radius, H, E)
        return jnp.concatenate([a[:, :, :-2], a[:, :, 1:-1], a[:, :, 2:]], axis=3)

    kw, vw = band(k), band(v)
    s = jnp.einsum('bdnqhe,bdnkhe->bdnhqk', qs, kw).astype(jnp.float32) * (E ** -0.5)
    n_idx = jnp.arange(nb)[:, None, None]
    qi = jnp.arange(radius)[None, :, None]
    ki = jnp.arange(3 * radius)[None, None, :]
    kpos = n_idx * radius - radius + ki
    valid = (jnp.abs(ki - radius - qi) <= radius) & (kpos >= 0) & (kpos < L)
    s = jnp.where(valid[:, None], s, -jnp.inf)
    lse = jax.nn.logsumexp(s, axis=-1, keepdims=True)
    p = jnp.exp(s - lse).astype(v.dtype)
    o = jnp.einsum('bdnhqk,bdnkhe->bdnqhe', p, vw).reshape(B, dilation, Lp, H, E)[:, :, :L]
    o = o.transpose(0, 2, 1, 3, 4).reshape(B, S, H, E)
    lse = lse[..., 0].transpose(0, 1, 2, 4, 3).reshape(B, dilation, Lp, H)[:, :, :L]
    lse = lse.transpose(0, 2, 1, 3).reshape(B, S, H)
    return o, lse


def gqa_attention(q, k, v):
    B, S, HQ, E = q.shape
    G = HQ // B_KV_HEADS
    nq = S // Q_BLOCK
    qb = q.reshape(B, nq, Q_BLOCK, B_KV_HEADS, G, E).transpose(1, 0, 2, 3, 4, 5)

    def block(qblk):
        s = jnp.einsum('bqkge,bske->bkgqs', qblk, k).astype(jnp.float32) * (E ** -0.5)
        p = jax.nn.softmax(s, axis=-1).astype(v.dtype)
        return jnp.einsum('bkgqs,bske->bqkge', p, v)

    o = lax.map(block, qb)
    return o.transpose(1, 0, 2, 3, 4, 5).reshape(B, S, HQ * E)


def hybrid_mixer(h, w_in, qn_a, kn_a, qn_b, kn_b, w_pa, w_pb, w_out, pos, row, col):
    B, S, _ = h.shape
    z = h @ w_in
    qa, ka, va, qb, kb, vb, ga, gb = jnp.split(z, IN_OFFSETS, axis=-1)

    def heads(a):
        return a.reshape(B, S, -1, HEAD_DIM)

    qa = partial_rope(rms_norm(heads(qa), qn_a), pos)
    ka = partial_rope(rms_norm(heads(ka), kn_a), pos)
    va = heads(va)
    outs, lses = [], []
    for window, dil in A_PATTERNS:
        o, lse = dilated_window_attention(qa, ka, va, dil, window // (2 * dil))
        outs.append(o)
        lses.append(lse)
    alpha = jax.nn.softmax(jnp.stack(lses), axis=0)
    ya = jnp.einsum('pbsh,pbshe->bshe', alpha, jnp.stack(outs).astype(jnp.float32))
    ya = ya.astype(h.dtype).reshape(B, S, A_WIDTH)

    qb = axial_rope(rms_norm(heads(qb), qn_b), row, col)
    kb = axial_rope(rms_norm(heads(kb), kn_b), row, col)
    yb = gqa_attention(qb, kb, heads(vb))

    merged = jax.nn.sigmoid(ga) * (ya @ w_pa) + jax.nn.sigmoid(gb) * (yb @ w_pb)
    return merged @ w_out


def grouped_moe(h, w_router, w_gate, w_up, w_down):
    B, S, D = h.shape
    T = B * S
    hf = h.reshape(T, D)
    probs = jax.nn.softmax((hf @ w_router).astype(jnp.float32), axis=-1)
    pg = probs.reshape(T, N_GROUPS, EXPERTS_PER_GROUP)
    group_score = lax.top_k(pg, TOP_K)[0].sum(-1)
    g_sel = jnp.argmax(group_score, axis=-1).astype(jnp.int32)
    in_group = pg[jnp.arange(T), g_sel]
    top_w, top_j = lax.top_k(in_group, TOP_K)
    top_e = g_sel[:, None] * EXPERTS_PER_GROUP + top_j.astype(jnp.int32)
    top_w = top_w / jnp.sum(top_w, axis=-1, keepdims=True)

    A = T * TOP_K
    e_flat = top_e.reshape(A)
    tok = jnp.repeat(jnp.arange(T, dtype=jnp.int32), TOP_K)
    wt = top_w.reshape(A)
    order = jnp.argsort(e_flat)
    e_sorted = e_flat[order]
    counts = jnp.zeros((N_EXPERTS,), jnp.int32).at[e_flat].add(1)
    padded = (counts + MOE_BLOCK - 1) // MOE_BLOCK * MOE_BLOCK
    pad_end = jnp.cumsum(padded)
    pad_start = pad_end - padded
    start = jnp.cumsum(counts) - counts
    dest = pad_start[e_sorted] + jnp.arange(A, dtype=jnp.int32) - start[e_sorted]
    n_pad = -(-(A + N_EXPERTS * MOE_BLOCK) // MOE_BLOCK) * MOE_BLOCK
    n_blocks = n_pad // MOE_BLOCK
    buf_tok = jnp.full((n_pad,), T, jnp.int32).at[dest].set(tok[order])
    buf_w = jnp.zeros((n_pad,), jnp.float32).at[dest].set(wt[order])
    blk_e = jnp.minimum(jnp.searchsorted(pad_end, jnp.arange(n_blocks) * MOE_BLOCK, side='right'),
                        N_EXPERTS - 1)
    xb = jnp.concatenate([hf, jnp.zeros((1, D), hf.dtype)], axis=0)[buf_tok]
    xb = xb.reshape(n_blocks, MOE_BLOCK, D)

    def expert_block(args):
        xblk, e = args
        return (jax.nn.silu(xblk @ w_gate[e]) * (xblk @ w_up[e])) @ w_down[e]

    yb = lax.map(expert_block, (xb, blk_e)).reshape(n_pad, D)
    out = jnp.zeros((T + 1, D), h.dtype).at[buf_tok].add(yb * buf_w[:, None].astype(h.dtype))
    return out[:T].reshape(B, S, D)


def setup_inputs(seed: int = 0) -> dict:
    key = jax.random.key(seed)
    ks = jax.random.split(key, 18)

    def nrm(k, shape, scale):
        return jax.random.normal(k, shape, jnp.float32) * scale

    return {
        "x": nrm(ks[0], (BATCH, SEQ, D_MODEL), 1.0),
        "c": nrm(ks[1], (BATCH, D_MODEL), 1.0),
        "w_ada": nrm(ks[2], (DEPTH, D_MODEL, 6 * D_MODEL), 0.5 * D_MODEL ** -0.5),
        "b_ada": nrm(ks[3], (DEPTH, 6 * D_MODEL), 0.02),
        "g_mix": 1.0 + nrm(ks[4], (DEPTH, D_MODEL), 0.02),
        "w_in": nrm(ks[5], (DEPTH, D_MODEL, IN_COLS), D_MODEL ** -0.5),
        "qn_a": 1.0 + nrm(ks[6], (DEPTH, HEAD_DIM), 0.02),
        "kn_a": 1.0 + nrm(ks[7], (DEPTH, HEAD_DIM), 0.02),
        "qn_b": 1.0 + nrm(ks[8], (DEPTH, HEAD_DIM), 0.02),
        "kn_b": 1.0 + nrm(ks[9], (DEPTH, HEAD_DIM), 0.02),
        "w_pa": nrm(ks[10], (DEPTH, A_WIDTH, D_MODEL), A_WIDTH ** -0.5),
        "w_pb": nrm(ks[11], (DEPTH, B_Q_WIDTH, D_MODEL), B_Q_WIDTH ** -0.5),
        "w_out": nrm(ks[12], (DEPTH, D_MODEL, D_MODEL), D_MODEL ** -0.5),
        "g_ffn": 1.0 + nrm(ks[13], (DEPTH, D_MODEL), 0.02),
        "w_router": nrm(ks[14], (D_MODEL, N_EXPERTS), D_MODEL ** -0.5),
        "w_gate": nrm(ks[15], (DEPTH, N_EXPERTS, D_MODEL, D_FF_EXPERT), D_MODEL ** -0.5),
        "w_up": nrm(ks[16], (DEPTH, N_EXPERTS, D_MODEL, D_FF_EXPERT), D_MODEL ** -0.5),
        "w_down": nrm(ks[17], (DEPTH, N_EXPERTS, D_FF_EXPERT, D_MODEL), D_FF_EXPERT ** -0.5),
    }


def reference(x, c, w_ada, b_ada, g_mix, w_in, qn_a, kn_a, qn_b, kn_b, w_pa, w_pb, w_out,
              g_ffn, w_router, w_gate, w_up, w_down):
    B, S, D = x.shape
    pos = jnp.arange(S, dtype=jnp.int32)
    rows = S // GRID_W
    row = jnp.repeat(jnp.arange(rows, dtype=jnp.int32), GRID_W)
    col = jnp.tile(jnp.arange(GRID_W, dtype=jnp.int32), rows)
    cond = jax.nn.silu(c)
    for l in range(DEPTH):
        mod = (cond @ w_ada[l] + b_ada[l])[:, None, :]
        sh1, sc1, gt1, sh2, sc2, gt2 = jnp.split(mod, 6, axis=-1)
        h = modulate(rms_norm(x, g_mix[l]), sh1, sc1)
        x = x + gt1 * hybrid_mixer(h, w_in[l], qn_a[l], kn_a[l], qn_b[l], kn_b[l],
                                   w_pa[l], w_pb[l], w_out[l], pos, row, col)
        h = modulate(rms_norm(x, g_ffn[l]), sh2, sc2)
        x = x + gt2 * grouped_moe(h, w_router, w_gate[l], w_up[l], w_down[l])
    return x
```

```cpp
#include <hip/hip_runtime.h>
#include <cstdio>
#include <cstdint>

#ifndef INPROJ_WGM
#define INPROJ_WGM 4
#endif
#ifndef GEMM_ALIGN
#define GEMM_ALIGN 1
#endif
#ifndef ROWB
#define ROWB 4
#endif
#ifndef N1K_WGM
#define N1K_WGM 8
#endif
#ifndef OUT_ROWMAJOR
#define OUT_ROWMAJOR 0
#endif
#ifndef REP_PRO
#define REP_PRO 1
#endif
#ifndef REP_ATTB
#define REP_ATTB 1
#endif
#ifndef REP_ATTA
#define REP_ATTA 1
#endif
#ifndef REP_INPROJ
#define REP_INPROJ 1
#endif
#ifndef REP_NORM1
#define REP_NORM1 1
#endif
#ifndef REP_GU
#define REP_GU 1
#endif
#ifndef REP_PAB
#define REP_PAB 1
#endif
#ifndef REP_OUT
#define REP_OUT 1
#endif
#ifndef REP_DOWN
#define REP_DOWN 1
#endif
#ifndef REP_NORM2
#define REP_NORM2 1
#endif
#ifndef MK_ONE_LAUNCH
#define MK_ONE_LAUNCH 1
#endif

#define LAS __attribute__((address_space(3)))
#define GAS __attribute__((address_space(1)))
typedef unsigned short bf16_t;
typedef short bf16x8 __attribute__((ext_vector_type(8)));
typedef short s16x4 __attribute__((ext_vector_type(4)));
typedef float f32x4 __attribute__((ext_vector_type(4)));
typedef float f32x16 __attribute__((ext_vector_type(16)));
typedef unsigned u32x4 __attribute__((ext_vector_type(4)));
typedef unsigned u32x2 __attribute__((ext_vector_type(2)));

constexpr int NB = 32, SEQ = 2048, DM = 1024, TT = NB * SEQ;
constexpr int NC = 4352;
constexpr int NEXP = 32, DFF = 512, NPAD = 139264, NBLK = 544;
constexpr int MODW = 6 * DM;
constexpr float QSCALE = 0.125f * 1.4426950408889634f;

constexpr size_t MiB = 1u << 20;
constexpr size_t WS_CTL = 0, CTL_ZERO_BYTES = 64 * 1024;
constexpr size_t WS_MOD = 1 * MiB;
constexpr size_t WS_TE = 2 * MiB + 512 * 1024, WS_TRK = 3 * MiB, WS_TW = 3 * MiB + 512 * 1024, WS_POS = 4 * MiB;
constexpr size_t WS_CNT = 4 * MiB + 512 * 1024;
constexpr size_t WS_BLKE = WS_CNT + 64 * 1024;
constexpr size_t WS_BTOK = WS_CNT + 128 * 1024;
constexpr size_t WS_WR = 5 * MiB + 256 * 1024;
constexpr size_t WS_WIN = 6 * MiB;
constexpr size_t WIN_BYTES = (size_t)NC * DM * 2;
constexpr size_t WS_WPA = 23 * MiB, WS_WPB = 25 * MiB, WS_WOUT = 27 * MiB;
constexpr size_t WS_WGU = 31 * MiB;
constexpr size_t WS_WDN = 159 * MiB;
constexpr size_t WS_H = 223 * MiB;
constexpr size_t WS_QKV = 351 * MiB;
constexpr size_t WS_GATE = 639 * MiB;
constexpr size_t WS_XB = 896 * MiB;
constexpr size_t WS_END = 1024 * MiB;
constexpr int CW_BAR = 4096;

constexpr int RING_BYTES = 133120;
constexpr int MISC_OFF = RING_BYTES;
constexpr int LDS_BYTES = 147456;

#define RLX_AGENT __ATOMIC_RELAXED, __HIP_MEMORY_SCOPE_AGENT
typedef float f32x2_t __attribute__((ext_vector_type(2))); typedef __bf16 bf16x2_t __attribute__((ext_vector_type(2)));
__device__ __forceinline__ unsigned cvt_pk_bf16(float lo, float hi) { const f32x2_t v = {lo, hi}; const bf16x2_t b = __builtin_convertvector(v, bf16x2_t); return __builtin_bit_cast(unsigned, b); }
__device__ __forceinline__ float bf_lo(unsigned w) { return __uint_as_float(w << 16); }
__device__ __forceinline__ float bf_hi(unsigned w) { return __uint_as_float(w & 0xffff0000u); }
__device__ __forceinline__ float shx(float v, int mask, int lane) { return __int_as_float(__builtin_amdgcn_ds_bpermute((lane ^ mask) << 2, __float_as_int(v))); }
__device__ __forceinline__ float wave_sum(float v, int lane) {
#pragma unroll
    for (int o = 1; o < 64; o <<= 1) v += shx(v, o, lane);
    return v;
}
__device__ __forceinline__ float wave_max(float v, int lane) {
#pragma unroll
    for (int o = 1; o < 64; o <<= 1) v = fmaxf(v, shx(v, o, lane));
    return v;
}
__device__ __forceinline__ float sigmoid_f(float x) { return __builtin_amdgcn_rcpf(1.0f + __builtin_amdgcn_exp2f(-1.4426950408889634f * x)); }

#define XB_TMO      128
#define XB_XCNT(j)  (256  + 64 * (j))
#define XB_XSUB(j)  (1280 + 64 * (j))
#define XB_XGEN(j)  (2304 + 64 * (j))
#define XB_TOP      3328
#define XB_TOPGEN   3392
#define XCD_BAR_WORDS 3456
#define XB_SPIN_CAP (1u << 18)

__device__ __forceinline__ unsigned xb_ld(unsigned* p)              { return __hip_atomic_load(p, __ATOMIC_RELAXED, __HIP_MEMORY_SCOPE_AGENT); }
__device__ __forceinline__ unsigned xb_add(unsigned* p, unsigned v) { return __hip_atomic_fetch_add(p, v, __ATOMIC_RELAXED, __HIP_MEMORY_SCOPE_AGENT); }
__device__ __forceinline__ unsigned xb_xcc_id() { return (unsigned)__builtin_amdgcn_s_getreg((3 << 11) | 20) & 0xFu; }
#define XB_SPIN(cond, bar) do { unsigned _sp = 0; while (cond) { __builtin_amdgcn_s_sleep(1); \
    if ((++_sp & 255u) == 0u) { if (xb_ld(&(bar)[XB_TMO])) break; if (_sp > XB_SPIN_CAP) { atomicAdd(&(bar)[XB_TMO], 1u); break; } } } } while (0)

struct XcdBarrier { unsigned* bar; unsigned x; volatile LAS unsigned* st; };

__device__ __forceinline__ XcdBarrier xcd_barrier_post(unsigned* bar, volatile LAS unsigned* st) {
    XcdBarrier b; b.bar = bar; b.x = xb_xcc_id(); b.st = st;
    if (threadIdx.x == 0) (void)xb_add(&bar[XB_XCNT(b.x)], 1u);
    return b;
}
__device__ __forceinline__ void xcd_barrier_complete(unsigned* bar, unsigned x, unsigned& nloc, unsigned& nx) {
    const unsigned G = gridDim.x * gridDim.y * gridDim.z;
    unsigned sum, cnt, mine, sp = 0u;
    for (;;) {
        sum = 0u; cnt = 0u; mine = 0u;
#pragma unroll
        for (unsigned j = 0; j < 16; ++j) { const unsigned c = xb_ld(&bar[XB_XCNT(j)]); sum += c; cnt += (c > 0u) ? 1u : 0u; mine = (j == x) ? c : mine; }
        if (sum == G) break;
        __builtin_amdgcn_s_sleep(1);
        if ((++sp & 255u) == 0u) { if (xb_ld(&bar[XB_TMO])) break; if (sp > XB_SPIN_CAP) { atomicAdd(&bar[XB_TMO], 1u); break; } }
    }
    nloc = mine > 0u ? mine : 1u; nx = cnt > 0u ? cnt : 1u;
}
__device__ __forceinline__ void xcd_barrier(const XcdBarrier& b, const bool is_t0  ) {
    asm volatile("s_waitcnt vmcnt(0)" ::: "memory");
    __syncthreads();
    if (is_t0) {
        unsigned* bar = b.bar; unsigned bx_ = b.x;
        asm volatile("" : "+s"(bar), "+s"(bx_));
        __builtin_amdgcn_s_waitcnt(0);
        unsigned nloc = b.st[0], nx = b.st[1];
        if (nloc == 0u) { xcd_barrier_complete(bar, bx_, nloc, nx); b.st[0] = nloc; b.st[1] = nx; }
        const unsigned old = xb_add(&bar[XB_XSUB(bx_)], 1u);
        const unsigned gen = old / nloc;
        if (old + 1u == (gen + 1u) * nloc) {
            __builtin_amdgcn_fence(__ATOMIC_RELEASE, "agent");
            asm volatile("s_waitcnt vmcnt(0)" ::: "memory");
            const unsigned og = xb_add(&bar[XB_TOP], 1u);
            const unsigned tg = og / nx;
            if (og + 1u == (tg + 1u) * nx) xb_add(&bar[XB_TOPGEN], 1u);
            else XB_SPIN(xb_ld(&bar[XB_TOPGEN]) == tg, bar);
            __builtin_amdgcn_fence(__ATOMIC_ACQUIRE, "agent");
            xb_add(&bar[XB_XGEN(bx_)], 1u);
            asm volatile("s_waitcnt vmcnt(0)" ::: "memory");
        } else {
            XB_SPIN(xb_ld(&bar[XB_XGEN(bx_)]) == gen, bar);
            __builtin_amdgcn_fence(__ATOMIC_ACQUIRE, "agent");
            asm volatile("s_waitcnt vmcnt(0)" ::: "memory");
        }
    }
    __syncthreads();
}

namespace pg8 {
constexpr int BM = 256, BK = 64, HALF = 128, HTB = HALF * BK * 2, STAGE_BYTES = 8 * HTB, NXCD = 8, WGM = 8;
__host__ __device__ __forceinline__ int lds_byte(int r, int c) { const int st = (r >> 4) * 2 + (c >> 5), rr = r & 15, cc = c & 31, ob = rr * 64 + cc * 2; return st * 1024 + (ob ^ (((ob >> 9) & 1) << 5)); }
__host__ __device__ __forceinline__ void stage_rc(int b, int& R, int& C) { const int st = b / 1024, sb = b % 1024, swz = sb ^ (((sb >> 9) & 1) << 5); R = (st >> 1) * 16 + swz / 64; C = (st & 1) * 32 + (swz % 64) / 2; }
__host__ __device__ __forceinline__ int perm32(int rho) { const int n = rho >> 4, i = rho & 15; return 8 * (i >> 2) + 4 * n + (i & 3); }

struct Unit { int pm, pn; };
struct Gemm { const bf16_t* A; const bf16_t* Bt; int K; };

struct StaticOrder {
    static constexpr bool GATHER = false;
    int nM, nN, nwg, G, c, wgm = WGM;
    __device__ void init(int M, int N, int G_, int c_) { asm volatile("" : "+s"(c_));     nM = M / BM; nN = N / BM; nwg = nM * nN; G = G_; c = c_; }
    int rowmajor = 0;
    __device__ __forceinline__ bool next(int i, Unit& u) const {
        if (rowmajor) { const int upw = (nwg + G - 1) / G, k = c * upw + i; if (i >= upw || k >= nwg) return false; u.pm = k / nN; u.pn = k % nN; return true; }
        const long L = (long)i * G + c; if (L >= nwg) return false;
        int wgid = (int)L; { const int q = nwg / NXCD, r = nwg % NXCD, xcd = wgid % NXCD, off = wgid / NXCD; wgid = (xcd < r ? xcd * (q + 1) : r * (q + 1) + (xcd - r) * q) + off; }
        const int nig = wgm * nN, gid = wgid / nig, fm = gid * wgm, gsz = (nM - fm) < wgm ? (nM - fm) : wgm;
        u.pm = fm + ((wgid % nig) % gsz); u.pn = (wgid % nig) / gsz; return true;
    }
    __device__ __forceinline__ void aoff(const Unit&, const int (&)[2], const unsigned (&)[2], int, unsigned (&)[2][2]) const {}
};
struct MoeOrder {
    static constexpr bool GATHER = true;
    const int* blk_e; const int* rowidx; int nunits, G, c;
    __device__ __forceinline__ bool next(int i, Unit& u) const {
        const int L = i * G + c; if (L >= nunits) return false;
        const int blk = L >> 2; const int e = blk_e[blk]; u.pm = blk; u.pn = 4 * e + (L & 3); return true;
    }
    __device__ __forceinline__ void aoff(const Unit& u, const int (&RA)[2], const unsigned (&CA2)[2], int K, unsigned (&o)[2][2]) const {
#pragma unroll
        for (int h = 0; h < 2; ++h)
#pragma unroll
            for (int i = 0; i < 2; ++i) { const int r = u.pm * BM + h * HALF + RA[i]; const int src = rowidx ? rowidx[r] : r; o[h][i] = (unsigned)src * (unsigned)(K * 2) + CA2[i]; }
    }
};

template <class Epi, class Sched>
__device__ __forceinline__ void gemm_phase(LAS unsigned char* lds, const Gemm g, const Sched& S, const Epi& E, const int wid) {
    int lane_; asm volatile("v_mbcnt_lo_u32_b32 %0, -1, 0\n\tv_mbcnt_hi_u32_b32 %0, -1, %0" : "=v"(lane_));
    const int lane = lane_, tid = wid * 64 + lane, wr = wid >> 2, wc = wid & 3, fr = lane & 15, fq = lane >> 4;
    const int K = g.K, nt = K / BK;
    unsigned voffA[2], voffB[2], CA2[2]; int RA[2];
#pragma unroll
    for (int i = 0; i < 2; ++i) { int R, C; stage_rc(tid * 16 + i * 8192, R, C); const int Rb = Epi::PERM ? ((R & ~31) + perm32(R & 31)) : R;
        RA[i] = R; CA2[i] = (unsigned)C * 2u; voffA[i] = (unsigned)(R * K + C) * 2u; voffB[i] = (unsigned)(Rb * K + C) * 2u; }
    const size_t kstep = (size_t)(BK * 2);
    const size_t hstep = (size_t)HALF * K * 2;
    const size_t tstep = 2 * hstep;
    const unsigned ldsw = (unsigned)wid * 1024u;
    const int aoff = lds_byte(wr * 64 + fr, fq * 8), boff = lds_byte(wc * 32 + fr, fq * 8);
    const char* Ab = (const char*)g.A;
#define PG8_SA(b, h) (((b) * 2 + (h)) * HTB)
#define PG8_SB(b, h) ((4 + (b) * 2 + (h)) * HTB)
#define PG8_STAGEB(bufoff, gbase, voff) do { _Pragma("unroll") for (int _i = 0; _i < 2; ++_i) \
        __builtin_amdgcn_global_load_lds((const unsigned*)((const char*)(gbase) + (voff)[_i]), (LAS unsigned*)(lds + (bufoff) + ldsw + _i * 8192), 16, 0, 0); } while (0)
#define PG8_STAGEA(bufoff, H_, kb, NEXT) do { if constexpr (Sched::GATHER) { _Pragma("unroll") for (int _i = 0; _i < 2; ++_i) { const unsigned _o = (NEXT) ? na[H_][_i] : ca[H_][_i]; \
            __builtin_amdgcn_global_load_lds((const unsigned*)(Ab + (size_t)_o + (size_t)(kb)), (LAS unsigned*)(lds + (bufoff) + ldsw + _i * 8192), 16, 0, 0); } } \
        else { const char* _b = Ab + ((NEXT) ? nU : cU) + (size_t)(H_) * hstep + (size_t)(kb); _Pragma("unroll") for (int _i = 0; _i < 2; ++_i) \
            __builtin_amdgcn_global_load_lds((const unsigned*)(_b + voffA[_i]), (LAS unsigned*)(lds + (bufoff) + ldsw + _i * 8192), 16, 0, 0); } } while (0)
#define PG8_LDA(dst, b, h) do { _Pragma("unroll") for (int m = 0; m < 4; ++m) _Pragma("unroll") for (int k = 0; k < 2; ++k) dst[m][k] = *(const LAS bf16x8*)(lds + PG8_SA(b, h) + aoff + m * 2048 + k * 1024); } while (0)
#define PG8_LDB(dst, b, h) do { _Pragma("unroll") for (int n = 0; n < 2; ++n) _Pragma("unroll") for (int k = 0; k < 2; ++k) dst[n][k] = *(const LAS bf16x8*)(lds + PG8_SB(b, h) + boff + n * 2048 + k * 1024); } while (0)
#define PG8_MMA(ai, bj, At, Bt) do { __builtin_amdgcn_s_setprio(1); _Pragma("unroll") for (int m = 0; m < 4; ++m) _Pragma("unroll") for (int n = 0; n < 2; ++n) _Pragma("unroll") for (int k = 0; k < 2; ++k) \
        acc[ai][bj][m][n] = __builtin_amdgcn_mfma_f32_16x16x32_bf16(Bt[n][k], At[m][k], acc[ai][bj][m][n], 0, 0, 0); __builtin_amdgcn_s_setprio(0); } while (0)
#define PG8_WAIT_V(n) asm volatile("s_waitcnt vmcnt(" #n ")" ::: "memory")
#define PG8_WAIT_L(n) asm volatile("s_waitcnt lgkmcnt(" #n ")" ::: "memory")
#define PG8_BAR __builtin_amdgcn_s_barrier()
#define PG8_SCHED __builtin_amdgcn_sched_barrier(0)
    Unit cur, nxt; int ui = 0;
    if (!S.next(0, cur)) return;
    f32x4 acc[2][2][4][2];
#pragma unroll
    for (int a = 0; a < 2; ++a)
#pragma unroll
        for (int b = 0; b < 2; ++b)
#pragma unroll
            for (int m = 0; m < 4; ++m)
#pragma unroll
                for (int n = 0; n < 2; ++n) acc[a][b][m][n] = (f32x4){0.f, 0.f, 0.f, 0.f};
    bf16x8 At[4][2], B0[2][2], B1[2][2];
    unsigned ca[2][2], na[2][2];
    size_t cU = 0, nU = 0;
    if constexpr (Sched::GATHER) S.aoff(cur, RA, CA2, K, ca); else cU = (size_t)cur.pm * tstep;
    const char* cB = (const char*)g.Bt + (size_t)cur.pn * tstep;
    PG8_STAGEB(PG8_SB(0, 0), cB, voffB); PG8_STAGEB(PG8_SB(0, 1), cB + hstep, voffB); PG8_STAGEA(PG8_SA(0, 0), 0, 0, false); PG8_STAGEA(PG8_SA(0, 1), 1, 0, false);
    if (wr == 1) PG8_BAR;
    PG8_WAIT_V(2); PG8_BAR;
    PG8_STAGEB(PG8_SB(1, 0), cB + kstep, voffB); PG8_STAGEA(PG8_SA(1, 0), 0, kstep, false); PG8_STAGEB(PG8_SB(1, 1), cB + hstep + kstep, voffB);
    PG8_WAIT_V(6); PG8_BAR;
    for (;;) {
        const bool has_next = S.next(ui + 1, nxt);
        if constexpr (Sched::GATHER) {
            if (has_next) S.aoff(nxt, RA, CA2, K, na);
            else {
#pragma unroll
                for (int h = 0; h < 2; ++h)
#pragma unroll
                    for (int i = 0; i < 2; ++i) na[h][i] = ca[h][i];
            }
        } else nU = has_next ? (size_t)nxt.pm * tstep : cU;
        const char* nB = has_next ? (const char*)g.Bt + (size_t)nxt.pn * tstep : cB;
        for (int t = 0; t < nt; t += 2) {
            const bool last = (t == nt - 2);
            const size_t kb1 = (size_t)(t + 1) * kstep;
            const size_t kb2 = last ? 0 : (size_t)(t + 2) * kstep, kb3 = kb2 + kstep;
            const char* b2 = last ? nB : cB + (size_t)(t + 2) * kstep; const char* b3 = b2 + kstep;
            PG8_LDB(B0, 0, 0); PG8_LDB(B1, 0, 1); PG8_SCHED; PG8_LDA(At, 0, 0); PG8_STAGEA(PG8_SA(1, 1), 1, kb1, false);
            PG8_WAIT_V(8); PG8_WAIT_L(0); PG8_BAR; PG8_MMA(0, 0, At, B0); PG8_MMA(0, 1, At, B1); PG8_BAR; PG8_SCHED;
            PG8_LDA(At, 0, 1); PG8_STAGEB(PG8_SB(0, 0), b2, voffB); PG8_STAGEB(PG8_SB(0, 1), b2 + hstep, voffB); PG8_STAGEA(PG8_SA(0, 0), 0, kb2, last);
            PG8_WAIT_V(8); PG8_WAIT_L(0); PG8_BAR; PG8_MMA(1, 0, At, B0); PG8_MMA(1, 1, At, B1); PG8_BAR; PG8_SCHED;
            PG8_LDB(B0, 1, 0); PG8_LDB(B1, 1, 1); PG8_SCHED; PG8_LDA(At, 1, 0); PG8_STAGEA(PG8_SA(0, 1), 1, kb2, last);
            PG8_WAIT_V(8); PG8_WAIT_L(0); PG8_BAR; PG8_MMA(0, 0, At, B0); PG8_MMA(0, 1, At, B1); PG8_BAR; PG8_SCHED;
            PG8_LDA(At, 1, 1); PG8_STAGEB(PG8_SB(1, 0), b3, voffB); PG8_STAGEB(PG8_SB(1, 1), b3 + hstep, voffB); PG8_STAGEA(PG8_SA(1, 0), 0, kb3, last);
            PG8_WAIT_V(8); PG8_WAIT_L(0); PG8_BAR; PG8_MMA(1, 0, At, B0); PG8_MMA(1, 1, At, B1); PG8_BAR; PG8_SCHED;
            if constexpr (Epi::MIDK) { if (t + 2 == nt / 2) E.mid(acc, cur, wr, wc, fr, fq); }
        }
#if GEMM_ALIGN
        if (wr == 0) PG8_BAR;
#endif
        E(acc, cur, wr, wc, fr, fq);
        if (!has_next) break;
#pragma unroll
        for (int a = 0; a < 2; ++a)
#pragma unroll
            for (int b = 0; b < 2; ++b)
#pragma unroll
                for (int m = 0; m < 4; ++m)
#pragma unroll
                    for (int n = 0; n < 2; ++n) acc[a][b][m][n] = (f32x4){0.f, 0.f, 0.f, 0.f};
        cur = nxt; cB = nB; cU = nU; ++ui;
        if constexpr (Sched::GATHER) {
#pragma unroll
            for (int h = 0; h < 2; ++h)
#pragma unroll
                for (int i = 0; i < 2; ++i) ca[h][i] = na[h][i];
        }
#if GEMM_ALIGN
        if (wr == 1) PG8_BAR;
#endif
    }
    PG8_WAIT_V(0);
#if !GEMM_ALIGN
    if (wr == 0) PG8_BAR;
#endif
    PG8_BAR;
#undef PG8_SA
#undef PG8_SB
#undef PG8_STAGEA
#undef PG8_STAGEB
#undef PG8_LDA
#undef PG8_LDB
#undef PG8_MMA
#undef PG8_WAIT_V
#undef PG8_WAIT_L
#undef PG8_BAR
#undef PG8_SCHED
}

typedef const f32x4 (&AccRef)[2][2][4][2];

__device__ __forceinline__ u32x4 pack8(const f32x4& a, const f32x4& b) { u32x4 w; w.x = cvt_pk_bf16(a[0], a[1]); w.y = cvt_pk_bf16(a[2], a[3]); w.z = cvt_pk_bf16(b[0], b[1]); w.w = cvt_pk_bf16(b[2], b[3]); return w; }

struct EpiInProj {
    static constexpr bool PERM = true, MIDK = false;
    bf16_t *QA, *KA, *VA, *QB, *KB, *VB, *SA, *SB;
    const LAS float* normw;
    template <int ROPE>
    __device__ __forceinline__ void head_tile(AccRef acc, bf16_t* dst, int ld, int hcol, int gsel, float scale, int row0, int fr, int fq) const {
        int d0[2];
#pragma unroll
        for (int bj = 0; bj < 2; ++bj) d0[bj] = (ROPE == 1) ? (fq == 0 ? 8 * bj : 8 + 8 * fq + 24 * bj) : (fq < 2 ? 8 * fq + 16 * bj : 16 + 8 * fq + 16 * bj);
        f32x4 g[2][2];
#pragma unroll
        for (int bj = 0; bj < 2; ++bj)
#pragma unroll
            for (int n = 0; n < 2; ++n) g[bj][n] = *(const LAS f32x4*)(normw + gsel * 64 + d0[bj] + 4 * n);
        constexpr float FA[8] = {1.591549431e-01f, 3.086376340e-02f, 5.985185713e-03f, 1.160663641e-03f, 2.250790790e-04f, 4.364795279e-05f, 8.464330808e-06f, 1.641426263e-06f};
        constexpr float FB[16] = {1.591549431e-01f, 8.949940161e-02f, 5.032921210e-02f, 2.830219583e-02f, 1.591549431e-02f, 8.949940161e-03f, 5.032921210e-03f, 2.830219583e-03f,
                                  1.591549431e-03f, 8.949940161e-04f, 5.032921210e-04f, 2.830219583e-04f, 1.591549431e-04f, 8.949940161e-05f, 5.032921210e-05f, 2.830219583e-05f};
        float fq8[8];
#pragma unroll
        for (int k = 0; k < 8; ++k) fq8[k] = (ROPE == 1) ? FA[k] : ((fq & 1) ? FB[8 + k] : FB[k]);
        const bool rot = (ROPE == 2) || (fq == 0);
#pragma unroll
        for (int ai = 0; ai < 2; ++ai)
#pragma unroll
            for (int m = 0; m < 4; ++m) {
                const int row = row0 + ai * HALF + m * 16; const int s = row & (SEQ - 1);
                f32x4 y[2][2]; float ss = 0.f;
#pragma unroll
                for (int bj = 0; bj < 2; ++bj)
#pragma unroll
                    for (int n = 0; n < 2; ++n) { y[bj][n] = acc[ai][bj][m][n]; const f32x4 q = y[bj][n] * y[bj][n]; ss += (q[0] + q[1]) + (q[2] + q[3]); }
                ss += shx(ss, 16, fr + 16 * fq); ss += shx(ss, 32, fr + 16 * fq);
                const float rinv = __builtin_amdgcn_rsqf(ss * (1.0f / 64.0f) + 1e-6f);
#pragma unroll
                for (int bj = 0; bj < 2; ++bj)
#pragma unroll
                    for (int n = 0; n < 2; ++n) y[bj][n] = y[bj][n] * rinv * g[bj][n];
                if (ROPE != 0) {
                    const float pos = (float)((ROPE == 1) ? s : (fq < 2 ? (s >> 6) : (s & 63)));
#pragma unroll
                    for (int n = 0; n < 2; ++n)
#pragma unroll
                        for (int j = 0; j < 4; ++j) {
                            const float xr = __builtin_amdgcn_fractf(pos * fq8[4 * n + j]);
                            const float c = rot ? __builtin_amdgcn_cosf(xr) : 1.0f, s_ = rot ? __builtin_amdgcn_sinf(xr) : 0.0f;
                            const float x1 = y[0][n][j], x2 = y[1][n][j];
                            y[0][n][j] = x1 * c - x2 * s_; y[1][n][j] = x2 * c + x1 * s_;
                        }
                }
                bf16_t* rowp = dst + (size_t)row * ld + hcol + 8 * fq;
#pragma unroll
                for (int bj = 0; bj < 2; ++bj) *(u32x4*)(rowp + 32 * bj) = pack8(y[bj][0] * scale, y[bj][1] * scale);
            }
    }
    __device__ __forceinline__ void operator()(AccRef acc, const Unit& u, int wr, int wc, int fr_, int fq_) const {
        int fr = fr_, fq = fq_; asm volatile("" : "+v"(fr), "+v"(fq));
        const int pn = u.pn; const int row0 = u.pm * BM + wr * 64 + fr;
        if (pn >= 9) {
            bf16_t* base = (pn < 13) ? SA : SB; const int colt = ((pn - 9) & 3) * 256 + wc * 32 + 8 * fq;
#pragma unroll
            for (int ai = 0; ai < 2; ++ai)
#pragma unroll
                for (int m = 0; m < 4; ++m) { bf16_t* rowp = base + (size_t)(row0 + ai * HALF + m * 16) * DM + colt;
#pragma unroll
                    for (int bj = 0; bj < 2; ++bj) { f32x4 v0 = acc[ai][bj][m][0], v1 = acc[ai][bj][m][1];
#pragma unroll
                        for (int j = 0; j < 4; ++j) { v0[j] = sigmoid_f(v0[j]); v1[j] = sigmoid_f(v1[j]); }
                        *(u32x4*)(rowp + bj * HALF) = pack8(v0, v1); } }
        } else if (pn == 4 || pn == 5) {
            const int colt = (pn - 4) * 256 + wc * 32 + 8 * fq;
#pragma unroll
            for (int ai = 0; ai < 2; ++ai)
#pragma unroll
                for (int m = 0; m < 4; ++m) { bf16_t* rowp = VA + (size_t)(row0 + ai * HALF + m * 16) * 512 + colt;
#pragma unroll
                    for (int bj = 0; bj < 2; ++bj) *(u32x4*)(rowp + bj * HALF) = pack8(acc[ai][bj][m][0], acc[ai][bj][m][1]); }
        } else if (pn < 2)  head_tile<1>(acc, QA, 512, 64 * (4 * pn + wc), 0, QSCALE, row0, fr, fq);
        else if (pn < 4)    head_tile<1>(acc, KA, 512, 64 * (4 * (pn - 2) + wc), 1, 1.0f, row0, fr, fq);
        else if (pn < 8)    head_tile<2>(acc, QB, 512, 64 * (4 * (pn - 6) + wc), 2, QSCALE, row0, fr, fq);
        else if (wc < 2)    head_tile<2>(acc, KB, 128, 64 * wc, 3, 1.0f, row0, fr, fq);
        else {
#pragma unroll
            for (int ai = 0; ai < 2; ++ai)
#pragma unroll
                for (int m = 0; m < 4; ++m) { bf16_t* rowp = VB + (size_t)(row0 + ai * HALF + m * 16) * 128 + 64 * (wc - 2) + 8 * fq;
#pragma unroll
                    for (int bj = 0; bj < 2; ++bj) *(u32x4*)(rowp + 32 * bj) = pack8(acc[ai][bj][m][0], acc[ai][bj][m][1]); }
        }
    }
};

struct EpiMergeFused {
    static constexpr bool PERM = true, MIDK = true;
    bf16_t* MG; const bf16_t* GA; const bf16_t* GB;
    __device__ __forceinline__ void mid(f32x4 (&acc)[2][2][4][2], const Unit& u, int wr, int wc, int fr_, int fq_) const {
        int fr = fr_, fq = fq_; asm volatile("" : "+v"(fr), "+v"(fq));
        const int row0 = u.pm * BM + wr * 64 + fr, col0 = u.pn * BM + wc * 32 + 8 * fq;
#pragma unroll
        for (int ai = 0; ai < 2; ++ai)
#pragma unroll
            for (int m = 0; m < 4; ++m) { const size_t ro = (size_t)(row0 + ai * HALF + m * 16) * DM + col0;
#pragma unroll
                for (int bj = 0; bj < 2; ++bj) {
                    const u32x4 a = *(const u32x4*)(GA + ro + bj * HALF), b = *(const u32x4*)(GB + ro + bj * HALF);
                    const float sa[8] = {bf_lo(a.x), bf_hi(a.x), bf_lo(a.y), bf_hi(a.y), bf_lo(a.z), bf_hi(a.z), bf_lo(a.w), bf_hi(a.w)};
                    const float sb[8] = {bf_lo(b.x), bf_hi(b.x), bf_lo(b.y), bf_hi(b.y), bf_lo(b.z), bf_hi(b.z), bf_lo(b.w), bf_hi(b.w)};
#pragma unroll
                    for (int n = 0; n < 2; ++n)
#pragma unroll
                        for (int j = 0; j < 4; ++j) acc[ai][bj][m][n][j] *= sa[4 * n + j] * __builtin_amdgcn_rcpf(fmaxf(sb[4 * n + j], 1e-12f));
                } }
    }
    __device__ __forceinline__ void operator()(AccRef acc, const Unit& u, int wr, int wc, int fr_, int fq_) const {
        int fr = fr_, fq = fq_; asm volatile("" : "+v"(fr), "+v"(fq));
        const int row0 = u.pm * BM + wr * 64 + fr, col0 = u.pn * BM + wc * 32 + 8 * fq;
#pragma unroll
        for (int ai = 0; ai < 2; ++ai)
#pragma unroll
            for (int m = 0; m < 4; ++m) { const size_t ro = (size_t)(row0 + ai * HALF + m * 16) * DM + col0;
#pragma unroll
                for (int bj = 0; bj < 2; ++bj) {
                    const u32x4 b = *(const u32x4*)(GB + ro + bj * HALF);
                    const float sb[8] = {bf_lo(b.x), bf_hi(b.x), bf_lo(b.y), bf_hi(b.y), bf_lo(b.z), bf_hi(b.z), bf_lo(b.w), bf_hi(b.w)};
                    f32x4 v0 = acc[ai][bj][m][0], v1 = acc[ai][bj][m][1];
#pragma unroll
                    for (int j = 0; j < 4; ++j) { v0[j] *= fmaxf(sb[j], 1e-12f); v1[j] *= fmaxf(sb[4 + j], 1e-12f); }
                    *(u32x4*)(MG + ro + bj * HALF) = pack8(v0, v1); } }
    }
};

struct EpiResidB {
    static constexpr bool PERM = true, MIDK = false;
    const float* Xf; const bf16_t* Xb; bf16_t* O; const float* gate;
    __device__ __forceinline__ void operator()(AccRef acc, const Unit& u, int wr, int wc, int fr_, int fq_) const {
        int fr = fr_, fq = fq_; asm volatile("" : "+v"(fr), "+v"(fq));
        const int row0 = u.pm * BM + wr * 64 + fr, col0 = u.pn * BM + wc * 32 + 8 * fq; const int b = (u.pm * BM) >> 11;
        f32x4 gt[2][2];
#pragma unroll
        for (int bj = 0; bj < 2; ++bj)
#pragma unroll
            for (int n = 0; n < 2; ++n) gt[bj][n] = *(const f32x4*)(gate + (size_t)b * MODW + col0 + bj * HALF + 4 * n);
#pragma unroll
        for (int ai = 0; ai < 2; ++ai)
#pragma unroll
            for (int m = 0; m < 4; ++m) { const size_t ro = (size_t)(row0 + ai * HALF + m * 16) * DM + col0;
#pragma unroll
                for (int bj = 0; bj < 2; ++bj) {
                    f32x4 x0, x1;
                    if (Xf) { x0 = *(const f32x4*)(Xf + ro + bj * HALF); x1 = *(const f32x4*)(Xf + ro + bj * HALF + 4); }
                    else { const u32x4 w = *(const u32x4*)(Xb + ro + bj * HALF); x0 = (f32x4){bf_lo(w.x), bf_hi(w.x), bf_lo(w.y), bf_hi(w.y)}; x1 = (f32x4){bf_lo(w.z), bf_hi(w.z), bf_lo(w.w), bf_hi(w.w)}; }
                    *(u32x4*)(O + ro + bj * HALF) = pack8(x0 + gt[bj][0] * acc[ai][bj][m][0], x1 + gt[bj][1] * acc[ai][bj][m][1]); } }
    }
};
struct EpiSwiGLU {
    static constexpr bool PERM = true, MIDK = false;
    bf16_t* ACT;
    __device__ __forceinline__ void operator()(AccRef acc, const Unit& u, int wr, int wc, int fr_, int fq_) const {
        int fr = fr_, fq = fq_; asm volatile("" : "+v"(fr), "+v"(fq));
        const int row0 = u.pm * BM + wr * 64 + fr, col0 = (u.pn & 3) * HALF + wc * 32 + 8 * fq;
#pragma unroll
        for (int ai = 0; ai < 2; ++ai)
#pragma unroll
            for (int m = 0; m < 4; ++m) { f32x4 r[2];
#pragma unroll
                for (int n = 0; n < 2; ++n)
#pragma unroll
                    for (int j = 0; j < 4; ++j) { const float gg = acc[ai][0][m][n][j], uu = acc[ai][1][m][n][j]; r[n][j] = gg * sigmoid_f(gg) * uu; }
                *(u32x4*)(ACT + (size_t)(row0 + ai * HALF + m * 16) * DFF + col0) = pack8(r[0], r[1]); }
    }
};

struct EpiY {
    static constexpr bool PERM = true, MIDK = false;
    bf16_t* Y;
    __device__ __forceinline__ void operator()(AccRef acc, const Unit& u, int wr, int wc, int fr_, int fq_) const {
        int fr = fr_, fq = fq_; asm volatile("" : "+v"(fr), "+v"(fq));
        const int row0 = u.pm * BM + wr * 64 + fr, col0 = (u.pn & 3) * BM + wc * 32 + 8 * fq;
#pragma unroll
        for (int ai = 0; ai < 2; ++ai)
#pragma unroll
            for (int m = 0; m < 4; ++m) { bf16_t* rowp = Y + (size_t)(row0 + ai * HALF + m * 16) * DM + col0;
#pragma unroll
                for (int bj = 0; bj < 2; ++bj) *(u32x4*)(rowp + bj * HALF) = pack8(acc[ai][bj][m][0], acc[ai][bj][m][1]); }
    }
};
}

__device__ __forceinline__ int dimA(int bj, int r) { return r < 8 ? r + 8 * bj : 16 + (r - 8) + 24 * bj; }
__device__ __forceinline__ int dimB(int bj, int r) { return r < 16 ? r + 16 * bj : 32 + (r - 16) + 16 * bj; }
__device__ __forceinline__ int inproj_srccol(int P) {
    const int pn = P >> 8, p = P & 255, bj = p >> 7, wc = (p >> 5) & 3, r = p & 31;
    if (pn < 2) return 64 * (4 * pn + wc) + dimA(bj, r);
    if (pn < 4) return 512 + 64 * (4 * (pn - 2) + wc) + dimA(bj, r);
    if (pn < 6) return 1024 + 256 * (pn - 4) + p;
    if (pn < 8) return 1536 + 64 * (4 * (pn - 6) + wc) + dimB(bj, r);
    if (pn == 8) return wc < 2 ? 2048 + 64 * wc + dimB(bj, r) : 2176 + 64 * (wc - 2) + 32 * bj + r;
    return 2304 + 256 * (pn - 9) + p;
}

namespace att {
constexpr int KSTR = 144, VSTR = 192;
constexpr int KTILE = 64 * KSTR, VTILE = 64 * VSTR;
constexpr int K_OFF = 0, V_OFF = 2 * KTILE;
constexpr int PRIV_OFF = 0;
__device__ __forceinline__ s16x4 vtr(LAS const char* p) { typedef short v4i16_t __attribute__((ext_vector_type(4)));
    return __builtin_bit_cast(s16x4, __builtin_amdgcn_ds_read_tr16_b64_v4i16((LAS v4i16_t*)p)); }
__device__ __forceinline__ int clamp_tok(int t) { return t < 0 ? 0 : (t > SEQ - 1 ? SEQ - 1 : t); }

__device__ __forceinline__ void qk_tile(f32x16& p0, f32x16& p1, const bf16x8 (&kf)[8], const bf16x8 (&qr)[4]) {
    const f32x16 z = {0.f, 0.f, 0.f, 0.f, 0.f, 0.f, 0.f, 0.f, 0.f, 0.f, 0.f, 0.f, 0.f, 0.f, 0.f, 0.f};
    p0 = __builtin_amdgcn_mfma_f32_32x32x16_bf16(kf[0], qr[0], z, 0, 0, 0); p1 = __builtin_amdgcn_mfma_f32_32x32x16_bf16(kf[1], qr[0], z, 0, 0, 0);
#pragma unroll
    for (int d0 = 1; d0 < 4; ++d0) { p0 = __builtin_amdgcn_mfma_f32_32x32x16_bf16(kf[2 * d0], qr[d0], p0, 0, 0, 0); p1 = __builtin_amdgcn_mfma_f32_32x32x16_bf16(kf[2 * d0 + 1], qr[d0], p1, 0, 0, 0); }
}
template <bool MASK>
__device__ __forceinline__ void exp_tile(const f32x16& p0, const f32x16& p1, float& lsum, bf16x8 (&pf)[2][2], int mbase, int mR, int dk) {
    float e0[16], e1[16]; float ls = 0.f;
#pragma unroll
    for (int r = 0; r < 16; ++r) {
        e0[r] = __builtin_amdgcn_exp2f(p0[r]); e1[r] = __builtin_amdgcn_exp2f(p1[r]);
        if (MASK) {
            const int c0 = (r & 3) + 8 * (r >> 2);
            e0[r] = ((unsigned)(mbase + dk * c0) <= (unsigned)mR) ? e0[r] : 0.f;
            e1[r] = ((unsigned)(mbase + dk * (c0 + 32)) <= (unsigned)mR) ? e1[r] : 0.f;
        }
        ls += e0[r] + e1[r];
    }
    lsum += ls;
#pragma unroll
    for (int s = 0; s < 2; ++s) {
        u32x4 w0, w1;
        w0.x = cvt_pk_bf16(e0[8 * s + 0], e0[8 * s + 1]); w0.y = cvt_pk_bf16(e0[8 * s + 2], e0[8 * s + 3]); w0.z = cvt_pk_bf16(e0[8 * s + 4], e0[8 * s + 5]); w0.w = cvt_pk_bf16(e0[8 * s + 6], e0[8 * s + 7]);
        w1.x = cvt_pk_bf16(e1[8 * s + 0], e1[8 * s + 1]); w1.y = cvt_pk_bf16(e1[8 * s + 2], e1[8 * s + 3]); w1.z = cvt_pk_bf16(e1[8 * s + 4], e1[8 * s + 5]); w1.w = cvt_pk_bf16(e1[8 * s + 6], e1[8 * s + 7]);
        pf[0][s] = __builtin_bit_cast(bf16x8, w0); pf[1][s] = __builtin_bit_cast(bf16x8, w1);
    }
}
__device__ __forceinline__ void vread(bf16x8 (&vf)[4], LAS const char* vb, int d0) {
#pragma unroll
    for (int blk = 0; blk < 2; ++blk)
#pragma unroll
        for (int s = 0; s < 2; ++s) {
            const s16x4 lo = vtr(vb + (32 * blk + 16 * s) * VSTR + 64 * d0), hi = vtr(vb + (32 * blk + 16 * s + 8) * VSTR + 64 * d0);
            vf[2 * blk + s] = (bf16x8){lo[0], lo[1], lo[2], lo[3], hi[0], hi[1], hi[2], hi[3]};
        }
}
__device__ __forceinline__ void pv_half(f32x16& od, const bf16x8 (&vf)[4], const bf16x8 (&pf)[2][2]) {
#pragma unroll
    for (int blk = 0; blk < 2; ++blk)
#pragma unroll
        for (int s = 0; s < 2; ++s) od = __builtin_amdgcn_mfma_f32_32x32x16_bf16(vf[2 * blk + s], pf[blk][s], od, 0, 0, 0);
}
__device__ __forceinline__ void mask_params(int dk, int tk0, int tq, int hi, int& mbase, int& mR) {
    const int dlo = (-64 * dk > -tq) ? -64 * dk : -tq, dhi = (64 * dk < SEQ - 1 - tq) ? 64 * dk : SEQ - 1 - tq;
    const int dA = tk0 + 4 * dk * hi - tq;
    mR = dhi - dlo; mbase = ((dA & (dk - 1)) == 0) ? dA - dlo : 0x7fffffff;
}

template <bool MASKED>
__device__ __forceinline__ void dense64_loop(LAS char* lds, const bf16_t* Kg, const bf16_t* Vg, int ld, int tok0, int ntiles,
                                             const bf16x8 (&qr)[2][4], f32x16 (&o)[2][2], float (&lsum)[2], int tq0, int tq1, int lane_, int wave) {
    constexpr int V2_OFF = 2 * KTILE;
    u32x4 kreg, vreg;
#define D64_LANE() int ln_ = lane_; asm volatile("" : "+v"(ln_)); const int tid_ = wave * 64 + ln_, srow = tid_ >> 3, sch = tid_ & 7
#define D64_LD(t) do { D64_LANE(); int tk_ = tok0 + 64 * (t) + srow; if (MASKED) tk_ = clamp_tok(tk_); kreg = *(const u32x4*)(Kg + (size_t)tk_ * ld + sch * 8); vreg = *(const u32x4*)(Vg + (size_t)tk_ * ld + sch * 8); } while (0)
#define D64_ST(t) do { D64_LANE(); *(LAS u32x4*)(lds + ((t) & 1) * KTILE + srow * KSTR + sch * 16) = kreg; *(LAS u32x4*)(lds + V2_OFF + ((t) & 1) * VTILE + srow * VSTR + sch * 16) = vreg; } while (0)
    D64_LD(0); D64_ST(0); D64_LD(1);
    for (int t = 0; t < ntiles; ++t) {
        __syncthreads();
        if (t + 1 < ntiles) D64_ST(t + 1);
        if (t + 2 < ntiles) D64_LD(t + 2);
        int lane = lane_; asm volatile("" : "+v"(lane));
        const int hi = lane >> 5;
        const int vlane = (4 * hi + ((lane & 15) >> 2)) * VSTR + (16 * ((lane >> 4) & 1) + 4 * (lane & 3)) * 2;
        const int klane = (lane & 31) * KSTR + 16 * hi;
        bf16x8 kf[8];
        { LAS const char* kb_ = lds + (t & 1) * KTILE + klane;
#pragma unroll
          for (int d0 = 0; d0 < 4; ++d0)
#pragma unroll
              for (int blk = 0; blk < 2; ++blk) kf[2 * d0 + blk] = *(const LAS bf16x8*)(kb_ + 32 * blk * KSTR + 32 * d0); }
        f32x16 p[2][2];
        bf16x8 vfa[4], vfb[4];
        LAS const char* vb_ = lds + V2_OFF + (t & 1) * VTILE + vlane;
        vread(vfa, vb_, 0); vread(vfb, vb_, 1);
        __builtin_amdgcn_sched_barrier(0);
        qk_tile(p[0][0], p[0][1], kf, qr[0]);
        qk_tile(p[1][0], p[1][1], kf, qr[1]);
#pragma unroll
        for (int g = 0; g < 2; ++g) {
            bf16x8 pf[2][2]; int mb = 0, mr = 0;
            if (MASKED) mask_params(1, tok0 + 64 * t, g ? tq1 : tq0, hi, mb, mr);
            exp_tile<MASKED>(p[g][0], p[g][1], lsum[g], pf, mb, mr, 1);
            pv_half(o[g][0], vfa, pf); pv_half(o[g][1], vfb, pf);
        }
    }
#undef D64_LANE
#undef D64_LD
#undef D64_ST
}
__device__ __forceinline__ void dense64_lag_loop(LAS char* lds, const bf16_t* Kg, const bf16_t* Vg, int ld, int ntiles,
                                                 const bf16x8 (&qr)[2][4], f32x16 (&o)[2][2], float (&lsum)[2], int lane_, int wave, const bool lag) {
    constexpr int V2_OFF = 2 * KTILE;
    u32x4 kreg, vreg;
#define D64_LANE() int ln_ = lane_; asm volatile("" : "+v"(ln_)); const int tid_ = wave * 64 + ln_, srow = tid_ >> 3, sch = tid_ & 7
#define D64_LD(t) do { D64_LANE(); const int tk_ = 64 * (t) + srow; kreg = *(const u32x4*)(Kg + (size_t)tk_ * ld + sch * 8); vreg = *(const u32x4*)(Vg + (size_t)tk_ * ld + sch * 8); } while (0)
#define D64_ST(t) do { D64_LANE(); *(LAS u32x4*)(lds + ((t) & 1) * KTILE + srow * KSTR + sch * 16) = kreg; *(LAS u32x4*)(lds + V2_OFF + ((t) % 3) * VTILE + srow * VSTR + sch * 16) = vreg; } while (0)
#define D64_QK(t) do { int lane = lane_; asm volatile("" : "+v"(lane)); const int klane = (lane & 31) * KSTR + 16 * (lane >> 5); bf16x8 kf[8]; LAS const char* kb_ = lds + ((t) & 1) * KTILE + klane; \
        _Pragma("unroll") for (int d0 = 0; d0 < 4; ++d0) _Pragma("unroll") for (int blk = 0; blk < 2; ++blk) kf[2 * d0 + blk] = *(const LAS bf16x8*)(kb_ + 32 * blk * KSTR + 32 * d0); \
        qk_tile(p[0][0], p[0][1], kf, qr[0]); qk_tile(p[1][0], p[1][1], kf, qr[1]); } while (0)
#define D64_PV(t) do { int lane = lane_; asm volatile("" : "+v"(lane)); const int hi = lane >> 5; const int vlane = (4 * hi + ((lane & 15) >> 2)) * VSTR + (16 * ((lane >> 4) & 1) + 4 * (lane & 3)) * 2; \
        bf16x8 vfa[4], vfb[4]; LAS const char* vb_ = lds + V2_OFF + ((t) % 3) * VTILE + vlane; vread(vfa, vb_, 0); vread(vfb, vb_, 1); \
        _Pragma("unroll") for (int g = 0; g < 2; ++g) { bf16x8 pf[2][2]; exp_tile<false>(p[g][0], p[g][1], lsum[g], pf, 0, 0, 0); pv_half(o[g][0], vfa, pf); pv_half(o[g][1], vfb, pf); } } while (0)
    f32x16 p[2][2];
    D64_LD(0); D64_ST(0);
    if (!lag) {
        D64_LD(1);
        for (int t = 0; t < ntiles; ++t) {
            __syncthreads();
            if (t + 1 < ntiles) D64_ST(t + 1);
            if (t + 2 < ntiles) D64_LD(t + 2);
            D64_QK(t);
            D64_PV(t);
        }
        __syncthreads();
    } else {
        D64_LD(1);
        __syncthreads();
        D64_ST(1); D64_LD(2);
        D64_QK(0);
        for (int t = 1; t < ntiles; ++t) {
            __syncthreads();
            if (t + 1 < ntiles) D64_ST(t + 1);
            if (t + 2 < ntiles) D64_LD(t + 2);
            D64_PV(t - 1);
            __builtin_amdgcn_sched_barrier(0);
            D64_QK(t);
        }
        __syncthreads();
        D64_PV(ntiles - 1);
    }
#undef D64_LANE
#undef D64_LD
#undef D64_ST
#undef D64_QK
#undef D64_PV
}
__device__ __forceinline__ void priv_kload(bf16x8 (&kf)[8], const bf16_t* Kg, int ld, int tk0, int dk, int lane_) {
    int lane = lane_; asm volatile("" : "+v"(lane));
    const int hi = lane >> 5;
#pragma unroll
    for (int blk = 0; blk < 2; ++blk) { const int tk = clamp_tok(tk0 + dk * (32 * blk + (lane & 31)));
#pragma unroll
        for (int d0 = 0; d0 < 4; ++d0) kf[2 * d0 + blk] = *(const bf16x8*)(Kg + (size_t)tk * ld + 16 * d0 + 8 * hi); }
}
__device__ __forceinline__ void priv2_step(bf16x8 (&kf)[8], LAS char* vpriv, const bf16_t* Kg, const bf16_t* Vg, int ld, int tk0, int dk, bool g0, bool g1,
                                           bool has_next, int tk0n, int dkn, const bf16x8 (&qr)[2][4], f32x16 (&o)[2][2], float (&lsum)[2], int tq0, int tq1, int lane_) {
    int lane = lane_; asm volatile("" : "+v"(lane));
    const int hi = lane >> 5;
    const int vlane = (4 * hi + ((lane & 15) >> 2)) * VSTR + (16 * ((lane >> 4) & 1) + 4 * (lane & 3)) * 2;
    u32x4 vr[8];
#pragma unroll
    for (int i = 0; i < 8; ++i) { const int idx = i * 64 + lane, row = idx >> 3, ch = idx & 7; const int tk = clamp_tok(tk0 + dk * row); vr[i] = *(const u32x4*)(Vg + (size_t)tk * ld + ch * 8); }
    const int gfirst = g0 ? 0 : 1, glast = g1 ? 1 : 0;
    f32x16 p0, p1; bf16x8 pf[2][2]; int mb, mr;
    if (gfirst == 0) qk_tile(p0, p1, kf, qr[0]); else qk_tile(p0, p1, kf, qr[1]);
    __builtin_amdgcn_sched_barrier(0);
#pragma unroll
    for (int i = 0; i < 8; ++i) { const int idx = i * 64 + lane; *(LAS u32x4*)(vpriv + (idx >> 3) * VSTR + (idx & 7) * 16) = vr[i]; }
    if (glast == gfirst) { __builtin_amdgcn_sched_barrier(0); if (has_next) priv_kload(kf, Kg, ld, tk0n, dkn, lane); __builtin_amdgcn_sched_barrier(0); }
    mask_params(dk, tk0, gfirst ? tq1 : tq0, hi, mb, mr);
    if (gfirst == 0) exp_tile<true>(p0, p1, lsum[0], pf, mb, mr, dk); else exp_tile<true>(p0, p1, lsum[1], pf, mb, mr, dk);
    { bf16x8 vfa[4], vfb[4]; vread(vfa, vpriv + vlane, 0); vread(vfb, vpriv + vlane, 1);
      if (gfirst == 0) { pv_half(o[0][0], vfa, pf); pv_half(o[0][1], vfb, pf); } else { pv_half(o[1][0], vfa, pf); pv_half(o[1][1], vfb, pf); } }
    if (glast != gfirst) {
        qk_tile(p0, p1, kf, qr[1]);
        __builtin_amdgcn_sched_barrier(0);
        if (has_next) priv_kload(kf, Kg, ld, tk0n, dkn, lane);
        __builtin_amdgcn_sched_barrier(0);
        mask_params(dk, tk0, tq1, hi, mb, mr);
        exp_tile<true>(p0, p1, lsum[1], pf, mb, mr, dk);
        bf16x8 vfa[4], vfb[4]; vread(vfa, vpriv + vlane, 0); vread(vfb, vpriv + vlane, 1);
        pv_half(o[1][0], vfa, pf); pv_half(o[1][1], vfb, pf);
    }
}
__device__ __forceinline__ void store_out(const f32x16 (&o)[2], float lsum, bf16_t* dst  , int lane_) {
    int lane = lane_; asm volatile("" : "+v"(lane));
    const int hi = lane >> 5;
    float l = lsum + shx(lsum, 32, lane);
    const float inv = 1.0f / l;
#pragma unroll
    for (int d0 = 0; d0 < 2; ++d0)
#pragma unroll
        for (int g4 = 0; g4 < 4; ++g4) {
            u32x2 w; w.x = cvt_pk_bf16(o[d0][4 * g4] * inv, o[d0][4 * g4 + 1] * inv); w.y = cvt_pk_bf16(o[d0][4 * g4 + 2] * inv, o[d0][4 * g4 + 3] * inv);
            *(u32x2*)(dst + 32 * d0 + 8 * g4 + 4 * hi) = w;
        }
}
}

struct Args { const float* in[18]; float* out; unsigned char* ws; int ph_lo, ph_hi; };
constexpr int PH_PRO = 0, PH_L0 = 1, PH_PER_LAYER = 9, PH_FINAL = PH_L0 + 2 * PH_PER_LAYER, NPH = PH_FINAL + 1;
enum { P_NORM1 = 0, P_INPROJ, P_ATTN, P_PAB, P_OUT, P_NORM2, P_PLACE, P_GU, P_DOWN };

template <bool MAPPED>
__device__ __forceinline__ void transpose_item(const float* W, int N, int col0, bf16_t* dst, int dst_row0, int K, int k0, LAS float* scr, int lane, int dk0 = 0  ) {
    const int sc = MAPPED ? inproj_srccol(col0 + lane) : col0 + lane;
    const float* src = W + (size_t)k0 * N + sc;
#pragma unroll 16
    for (int i = 0; i < 64; ++i) scr[i * 65 + lane] = src[(size_t)i * N];
    asm volatile("s_waitcnt lgkmcnt(0)" ::: "memory");
    const int c = lane & 7, nn = lane >> 3;
#pragma unroll
    for (int j = 0; j < 8; ++j) { const int n = nn + 8 * j; const LAS float* s = scr + (8 * c) * 65 + n;
        u32x4 w; w.x = cvt_pk_bf16(s[0], s[65]); w.y = cvt_pk_bf16(s[2 * 65], s[3 * 65]); w.z = cvt_pk_bf16(s[4 * 65], s[5 * 65]); w.w = cvt_pk_bf16(s[6 * 65], s[7 * 65]);
        *(u32x4*)(dst + (size_t)(dst_row0 + n) * K + dk0 + k0 + 8 * c) = w; }
    asm volatile("s_waitcnt lgkmcnt(0)" ::: "memory");
}


template <bool XF32, bool COMBINE, bool NORM, bool ROUTER, bool OUTF32>
__device__ __forceinline__ void row_phase(LAS unsigned char* lds, int tid, int lane, int wave, int G, int bx, const float* xf, bf16_t* xb, float* outf, const float* gv,
                                          const float* modl, int sh_off, int sc_off, const float* modprev, bf16_t* Hh, const bf16_t* Ym, const int* Pos, float* Tw,
                                          const bf16_t* Wr, int* Te, int* Trk, int* Cnt) {
    constexpr int RB = COMBINE ? 2 : ROWB;
    LAS float* lgs = (LAS float*)lds;
    LAS int* lcnt = (LAS int*)(lds + 40960);
    asm volatile("" : "+v"(tid), "+v"(lane));
    for (int chunk = bx; chunk < 256; chunk += G) {
        const int b = chunk >> 3;
        if (ROUTER) { if (tid < 32) lcnt[tid] = 0; }
        f32x4 pre[4], shv[4], g2[4];
#pragma unroll
        for (int j = 0; j < 4; ++j) { const int col = 512 * (j >> 1) + 8 * lane + 4 * (j & 1);
            if (NORM) { const f32x4 gg = *(const f32x4*)(gv + col), sc = *(const f32x4*)(modl + (size_t)b * MODW + sc_off + col);
                pre[j] = gg * (1.0f + sc); shv[j] = *(const f32x4*)(modl + (size_t)b * MODW + sh_off + col); }
            if (COMBINE) g2[j] = *(const f32x4*)(modprev + (size_t)b * MODW + 5 * DM + col); }
        f32x4 rawf[XF32 ? RB : 1][4]; u32x4 rawb[XF32 ? 1 : RB][2]; int pp[COMBINE ? RB : 1][2]; float pw[COMBINE ? RB : 1][2];
#define ROW_LOAD(rb_) do { _Pragma("unroll") for (int i = 0; i < RB; ++i) { const size_t ro = (size_t)((rb_) + i) * DM; \
            if (XF32) { _Pragma("unroll") for (int j = 0; j < 4; ++j) rawf[XF32 ? i : 0][j] = *(const f32x4*)(xf + ro + 512 * (j >> 1) + 8 * lane + 4 * (j & 1)); } \
            else { _Pragma("unroll") for (int h = 0; h < 2; ++h) rawb[XF32 ? 0 : i][h] = *(const u32x4*)(xb + ro + 512 * h + 8 * lane); } \
            if (COMBINE) { pp[COMBINE ? i : 0][0] = Pos[2 * ((rb_) + i)]; pp[COMBINE ? i : 0][1] = Pos[2 * ((rb_) + i) + 1]; pw[COMBINE ? i : 0][0] = Tw[2 * ((rb_) + i)]; pw[COMBINE ? i : 0][1] = Tw[2 * ((rb_) + i) + 1]; } } } while (0)
        ROW_LOAD(chunk * 256 + wave * 32);
#pragma unroll 1
        for (int r0 = 0; r0 < 32; r0 += RB) {
            const int rowb = chunk * 256 + wave * 32 + r0;
            f32x4 v[RB][4]; int cp[COMBINE ? RB : 1][2]; float cw[COMBINE ? RB : 1][2];
#pragma unroll
            for (int i = 0; i < RB; ++i) {
                if (XF32) {
#pragma unroll
                    for (int j = 0; j < 4; ++j) v[i][j] = rawf[XF32 ? i : 0][j];
                } else {
#pragma unroll
                    for (int h = 0; h < 2; ++h) { const u32x4 w = rawb[XF32 ? 0 : i][h];
                        v[i][2 * h] = (f32x4){bf_lo(w.x), bf_hi(w.x), bf_lo(w.y), bf_hi(w.y)}; v[i][2 * h + 1] = (f32x4){bf_lo(w.z), bf_hi(w.z), bf_lo(w.w), bf_hi(w.w)}; }
                }
                if (COMBINE) { cp[i][0] = pp[i][0]; cp[i][1] = pp[i][1]; cw[i][0] = pw[i][0]; cw[i][1] = pw[i][1]; }
            }
            u32x4 ya[COMBINE ? RB : 1][2], yc[COMBINE ? RB : 1][2];
            if (COMBINE) {
#pragma unroll
                for (int i = 0; i < RB; ++i)
#pragma unroll
                    for (int h = 0; h < 2; ++h) { ya[i][h] = *(const u32x4*)(Ym + (size_t)cp[i][0] * DM + 512 * h + 8 * lane); yc[i][h] = *(const u32x4*)(Ym + (size_t)cp[i][1] * DM + 512 * h + 8 * lane); }
            }
            if (r0 + RB < 32) ROW_LOAD(rowb + RB);
            if (COMBINE) {
#pragma unroll
                for (int i = 0; i < RB; ++i) {
                    const int row = rowb + i; const float w0 = cw[i][0], w1 = cw[i][1];
#pragma unroll
                    for (int h = 0; h < 2; ++h) { const u32x4 a = ya[i][h], c = yc[i][h];
                        const f32x4 m0 = {w0 * bf_lo(a.x) + w1 * bf_lo(c.x), w0 * bf_hi(a.x) + w1 * bf_hi(c.x), w0 * bf_lo(a.y) + w1 * bf_lo(c.y), w0 * bf_hi(a.y) + w1 * bf_hi(c.y)};
                        const f32x4 m1 = {w0 * bf_lo(a.z) + w1 * bf_lo(c.z), w0 * bf_hi(a.z) + w1 * bf_hi(c.z), w0 * bf_lo(a.w) + w1 * bf_lo(c.w), w0 * bf_hi(a.w) + w1 * bf_hi(c.w)};
                        v[i][2 * h] = v[i][2 * h] + g2[2 * h] * m0; v[i][2 * h + 1] = v[i][2 * h + 1] + g2[2 * h + 1] * m1;
                        if (OUTF32) { *(f32x4*)(outf + (size_t)row * DM + 512 * h + 8 * lane) = v[i][2 * h]; *(f32x4*)(outf + (size_t)row * DM + 512 * h + 8 * lane + 4) = v[i][2 * h + 1]; }
                        else *(u32x4*)(xb + (size_t)row * DM + 512 * h + 8 * lane) = pg8::pack8(v[i][2 * h], v[i][2 * h + 1]); }
                }
            }
            if (NORM) {
                float ss[RB];
#pragma unroll
                for (int i = 0; i < RB; ++i) { ss[i] = 0.f;
#pragma unroll
                    for (int j = 0; j < 4; ++j) { const f32x4 q = v[i][j] * v[i][j]; ss[i] += (q[0] + q[1]) + (q[2] + q[3]); } }
#pragma unroll
                for (int o = 1; o < 64; o <<= 1)
#pragma unroll
                    for (int i = 0; i < RB; ++i) ss[i] += shx(ss[i], o, lane);
#pragma unroll
                for (int i = 0; i < RB; ++i) { const float rstd = __builtin_amdgcn_rsqf(ss[i] * (1.0f / DM) + 1e-6f);
#pragma unroll
                    for (int h = 0; h < 2; ++h) *(u32x4*)(Hh + (size_t)(rowb + i) * DM + 512 * h + 8 * lane) = pg8::pack8(v[i][2 * h] * rstd * pre[2 * h] + shv[2 * h], v[i][2 * h + 1] * rstd * pre[2 * h + 1] + shv[2 * h + 1]); }
            }
        }
#undef ROW_LOAD
        if (ROUTER) {
            __syncthreads();
            const int row0 = chunk * 256 + wave * 32;
            f32x4 ra[2][2];
#pragma unroll
            for (int mt = 0; mt < 2; ++mt)
#pragma unroll
                for (int et = 0; et < 2; ++et) ra[mt][et] = (f32x4){0.f, 0.f, 0.f, 0.f};
#pragma unroll 4
            for (int kk = 0; kk < 32; ++kk) {
                bf16x8 a[2], bb[2];
#pragma unroll
                for (int mt = 0; mt < 2; ++mt) a[mt] = *(const bf16x8*)(Hh + (size_t)(row0 + 16 * mt + (lane & 15)) * DM + 32 * kk + 8 * (lane >> 4));
#pragma unroll
                for (int et = 0; et < 2; ++et) bb[et] = *(const bf16x8*)(Wr + (size_t)(16 * et + (lane & 15)) * DM + 32 * kk + 8 * (lane >> 4));
#pragma unroll
                for (int mt = 0; mt < 2; ++mt)
#pragma unroll
                    for (int et = 0; et < 2; ++et) ra[mt][et] = __builtin_amdgcn_mfma_f32_16x16x32_bf16(a[mt], bb[et], ra[mt][et], 0, 0, 0);
            }
#pragma unroll
            for (int mt = 0; mt < 2; ++mt)
#pragma unroll
                for (int et = 0; et < 2; ++et)
#pragma unroll
                    for (int r = 0; r < 4; ++r) lgs[(wave * 32 + 16 * mt + 4 * (lane >> 4) + r) * 33 + 16 * et + (lane & 15)] = ra[mt][et][r];
            asm volatile("s_waitcnt lgkmcnt(0)" ::: "memory");
            if (lane < 32) {
                const int tl = wave * 32 + lane, tok = chunk * 256 + tl;
                float lg[32]; float M = -3.0e38f;
#pragma unroll
                for (int e = 0; e < 32; ++e) { lg[e] = lgs[tl * 33 + e]; M = fmaxf(M, lg[e]); }
                float bm1 = 0.f, bm2 = 0.f, bsc = -1.f; int bi1 = 0, bi2 = 0, bg = 0;
#pragma unroll
                for (int g = 0; g < 4; ++g) {
                    float m1 = -3.0e38f, m2 = -3.0e38f; int i1 = 0, i2 = 0;
#pragma unroll
                    for (int j = 0; j < 8; ++j) { const float vv = lg[8 * g + j];
                        if (vv > m1) { m2 = m1; i2 = i1; m1 = vv; i1 = j; } else if (vv > m2) { m2 = vv; i2 = j; } }
                    const float sc = expf(m1 - M) + expf(m2 - M);
                    if (sc > bsc) { bsc = sc; bg = g; bm1 = m1; bm2 = m2; bi1 = i1; bi2 = i2; }
                }
                const int e0 = 8 * bg + bi1, e1 = 8 * bg + bi2;
                const float w0 = 1.0f / (1.0f + expf(bm2 - bm1)), w1 = 1.0f - w0;
                const int r0 = __hip_atomic_fetch_add(&lcnt[e0], 1, __ATOMIC_RELAXED, __HIP_MEMORY_SCOPE_WORKGROUP);
                const int r1 = __hip_atomic_fetch_add(&lcnt[e1], 1, __ATOMIC_RELAXED, __HIP_MEMORY_SCOPE_WORKGROUP);
                Te[2 * tok] = e0; Te[2 * tok + 1] = e1; Trk[2 * tok] = r0; Trk[2 * tok + 1] = r1; Tw[2 * tok] = w0; Tw[2 * tok + 1] = w1;
            }
            __syncthreads();
            if (tid < 32) Cnt[chunk * 32 + tid] = lcnt[tid];
            __syncthreads();
        }
    }
}

#define x_in ((const float*)(const GAS float*)args.in[0])
#define c_in ((const float*)(const GAS float*)args.in[1])
#define w_ada ((const float*)(const GAS float*)args.in[2])
#define b_ada ((const float*)(const GAS float*)args.in[3])
#define g_mix ((const float*)(const GAS float*)args.in[4])
#define w_in ((const float*)(const GAS float*)args.in[5])
#define qn_a ((const float*)(const GAS float*)args.in[6])
#define kn_a ((const float*)(const GAS float*)args.in[7])
#define qn_b ((const float*)(const GAS float*)args.in[8])
#define kn_b ((const float*)(const GAS float*)args.in[9])
#define w_pa ((const float*)(const GAS float*)args.in[10])
#define w_pb ((const float*)(const GAS float*)args.in[11])
#define w_out ((const float*)(const GAS float*)args.in[12])
#define g_ffn ((const float*)(const GAS float*)args.in[13])
#define w_router ((const float*)(const GAS float*)args.in[14])
#define w_gate ((const float*)(const GAS float*)args.in[15])
#define w_up ((const float*)(const GAS float*)args.in[16])
#define w_down ((const float*)(const GAS float*)args.in[17])
#define MOD ((float*)(GAS float*)(ws + WS_MOD))
#define XB ((bf16_t*)(GAS bf16_t*)(ws + WS_XB))
#define TE ((int*)(GAS int*)(ws + WS_TE))
#define TRK ((int*)(GAS int*)(ws + WS_TRK))
#define TW ((float*)(GAS float*)(ws + WS_TW))
#define POS ((int*)(GAS int*)(ws + WS_POS))
#define CNT ((int*)(GAS int*)(ws + WS_CNT))
#define BLKE ((int*)(GAS int*)(ws + WS_BLKE))
#define BTOK ((int*)(GAS int*)(ws + WS_BTOK))
#define WR ((bf16_t*)(bf16_t*)(GAS bf16_t*)(ws + WS_WR))
#define H ((bf16_t*)(bf16_t*)(GAS bf16_t*)(ws + WS_H))
#define YAB ((bf16_t*)(GAS bf16_t*)(ws + WS_H))
#define YA ((bf16_t*)(bf16_t*)(GAS bf16_t*)(ws + WS_H))
#define YB ((bf16_t*)(bf16_t*)(GAS bf16_t*)(ws + WS_H + 64 * MiB))
#define QA ((bf16_t*)(bf16_t*)(GAS bf16_t*)(ws + WS_QKV))
#define KA ((bf16_t*)(bf16_t*)(GAS bf16_t*)(ws + WS_QKV + 64 * MiB))
#define VA ((bf16_t*)(bf16_t*)(GAS bf16_t*)(ws + WS_QKV + 128 * MiB))
#define QB ((bf16_t*)(bf16_t*)(GAS bf16_t*)(ws + WS_QKV + 192 * MiB))
#define KB ((bf16_t*)(bf16_t*)(GAS bf16_t*)(ws + WS_QKV + 256 * MiB))
#define VB ((bf16_t*)(bf16_t*)(GAS bf16_t*)(ws + WS_QKV + 272 * MiB))
#define MERGED ((bf16_t*)(bf16_t*)(GAS bf16_t*)(ws + WS_QKV))
#define YM ((bf16_t*)(bf16_t*)(GAS bf16_t*)(ws + WS_QKV))
#define SA ((bf16_t*)(bf16_t*)(GAS bf16_t*)(ws + WS_GATE))
#define SB ((bf16_t*)(bf16_t*)(GAS bf16_t*)(ws + WS_GATE + 128 * MiB))
#define ACT ((bf16_t*)(bf16_t*)(GAS bf16_t*)(ws + WS_GATE))
#define PHASE_ENTER() int lane; asm volatile("v_mbcnt_lo_u32_b32 %0, -1, 0\n\tv_mbcnt_hi_u32_b32 %0, -1, %0" : "=v"(lane)); const int tid = wave * 64 + lane; GAS unsigned char* ws = ws0; int bx = bx0, vcu = vcu0; asm volatile("" : "+s"(ws), "+s"(bx), "+s"(vcu))

__device__ __forceinline__ bool in_phase(int lo, int hi, int k) { asm volatile("" : "+s"(lo), "+s"(hi)); return lo <= k && k < hi; }
#define PGATE_A SA
#define PGATE_B SB
__global__ void __launch_bounds__(512, 2) fwd_kernel(Args args) {
    extern __shared__ __attribute__((aligned(16))) unsigned char lds_raw[];
    LAS unsigned char* lds = (LAS unsigned char*)lds_raw;
    volatile LAS unsigned* MISC = (volatile LAS unsigned*)(lds + MISC_OFF);
    const int tid0 = threadIdx.x, lane0 = tid0 & 63, wave = __builtin_amdgcn_readfirstlane(tid0 >> 6);
    const int G = gridDim.x, bx0 = blockIdx.x;
    const int vcu0 = (G % 8 == 0) ? (bx0 % 8) * (G / 8) + bx0 / 8 : bx0;
    GAS unsigned char* ws0 = (GAS unsigned char*)args.ws;
    float* out = (float*)(GAS float*)args.out;
    for (int u = tid0; u < 256; u += 512) ((LAS unsigned*)(lds + MISC_OFF))[u] = 0u;
    __syncthreads();
#if MK_ONE_LAUNCH
    XcdBarrier bar = xcd_barrier_post((unsigned*)((GAS unsigned*)(ws0 + WS_CTL) + CW_BAR), MISC + 8);
#define GRID_BAR() do { int l_; asm volatile("v_mbcnt_lo_u32_b32 %0, -1, 0\n\tv_mbcnt_hi_u32_b32 %0, -1, %0" : "=v"(l_)); xcd_barrier(bar, (wave == 0) && (l_ == 0)); } while (0)
#else
#define GRID_BAR() do {} while (0)
#endif
#ifndef PHMASK
#define PHMASK 0xFFFFFFFFu
#endif
#if MK_ONE_LAUNCH
#define IN(k) true
#else
#define IN(k) in_phase(args.ph_lo, args.ph_hi, (k))
#endif
#define EN(bit) ((PHMASK >> (bit)) & 1u)
#define SEAM(k) do { if (IN(k) && IN((k) + 1)) GRID_BAR(); } while (0)

    if (EN(0) && IN(PH_PRO)) {
        PHASE_ENTER();
#pragma unroll 1
        for (int rep = 0; rep < REP_PRO; ++rep) {
        LAS float* scr = (LAS float*)(lds + wave * 16640);
        const int gw = vcu * 8 + wave, NGW = G * 8;
        constexpr int I_IN = 68 * 16, I_PA = 16 * 8, I_OUT = 16 * 16, I_GU = 32 * 2 * 8 * 16, I_DN = 32 * 16 * 8;
        constexpr int I_LAYER = I_IN + 2 * I_PA + I_OUT + I_GU + I_DN;
        for (int it = gw; it < 2 * I_LAYER; it += NGW) {
            const int l = it / I_LAYER; int r = it % I_LAYER;
            if (r < I_IN) { const int nb = r / 16, kb = r % 16;
                transpose_item<true>(w_in + (size_t)l * DM * NC, NC, 64 * nb, (bf16_t*)(GAS bf16_t*)(ws + WS_WIN + l * WIN_BYTES), 64 * nb, DM, 64 * kb, scr, lane); continue; } r -= I_IN;
            if (r < I_PA) { const int nb = r / 8, kb = r % 8;
                transpose_item<false>(w_pa + (size_t)l * 512 * DM, DM, 64 * nb, (bf16_t*)(GAS bf16_t*)(ws + WS_WPA + l * 2 * MiB), 64 * nb, DM, 64 * kb, scr, lane, 0); continue; } r -= I_PA;
            if (r < I_PA) { const int nb = r / 8, kb = r % 8;
                transpose_item<false>(w_pb + (size_t)l * 512 * DM, DM, 64 * nb, (bf16_t*)(GAS bf16_t*)(ws + WS_WPA + l * 2 * MiB), 64 * nb, DM, 64 * kb, scr, lane, 512); continue; } r -= I_PA;
            if (r < I_OUT) { const int nb = r / 16, kb = r % 16;
                transpose_item<false>(w_out + (size_t)l * DM * DM, DM, 64 * nb, (bf16_t*)(GAS bf16_t*)(ws + WS_WOUT + l * 2 * MiB), 64 * nb, DM, 64 * kb, scr, lane); continue; } r -= I_OUT;
            if (r < I_GU) { const int e = r / 256, q = r % 256, up = q / 128, nb = (q % 128) / 16, kb = q % 16;
                const float* src = (up ? w_up : w_gate) + ((size_t)l * NEXP + e) * DM * DFF;
                const int c0 = 64 * nb, drow = 256 * (c0 >> 7) + 128 * up + (c0 & 127);
                transpose_item<false>(src, DFF, c0, (bf16_t*)(GAS bf16_t*)(ws + WS_WGU + ((size_t)l * NEXP + e) * 2 * MiB), drow, DM, 64 * kb, scr, lane); continue; } r -= I_GU;
            { const int e = r / 128, q = r % 128, nb = q / 8, kb = q % 8;
                transpose_item<false>(w_down + ((size_t)l * NEXP + e) * DFF * DM, DM, 64 * nb, (bf16_t*)(GAS bf16_t*)(ws + WS_WDN + ((size_t)l * NEXP + e) * MiB), 64 * nb, DFF, 64 * kb, scr, lane); }
        }
        for (int i = (vcu * 512 + tid); i < 32 * DM; i += G * 512) { const int e = i >> 10, k = i & 1023; WR[i] = (bf16_t)(cvt_pk_bf16(w_router[(size_t)k * NEXP + e], 0.f) & 0xffffu); }
        __syncthreads();
        if (vcu * 8 < 384) {
            LAS float* cond = (LAS float*)lds;
            for (int i = tid; i < NB * DM; i += 512) { const int b = i >> 10, k = i & 1023; const float cv = c_in[i]; cond[k * 32 + b] = cv / (1.0f + expf(-cv)); }
            __syncthreads();
            for (int it = gw; it < 384; it += NGW) {
                const int l = it / 192, n0 = (it % 192) * 32;
                const float* wp = w_ada + (size_t)l * DM * MODW + n0 + (lane & 31) + (size_t)(lane >> 5) * MODW;
                const LAS float* cp = cond + (lane >> 5) * 32 + (lane & 31);
                f32x16 acc;
#pragma unroll
                for (int r = 0; r < 16; ++r) acc[r] = 0.f;
#pragma unroll 16
                for (int k0 = 0; k0 < DM; k0 += 2) acc = __builtin_amdgcn_mfma_f32_32x32x2f32(cp[k0 * 32], wp[(size_t)k0 * MODW], acc, 0, 0, 0);
                const float bias = b_ada[l * MODW + n0 + (lane & 31)];
#pragma unroll
                for (int r = 0; r < 16; ++r) { const int b = (r & 3) + 8 * (r >> 2) + 4 * (lane >> 5); MOD[((size_t)l * NB + b) * MODW + n0 + (lane & 31)] = acc[r] + bias; }
            }
        }
        __syncthreads();
        }
    }
    SEAM(PH_PRO);

    for (int l = 0; l < 2; ++l) {
        const int pb = PH_L0 + l * PH_PER_LAYER;
        if (EN(1) && IN(pb + P_NORM1)) { PHASE_ENTER(); const float* modl = MOD + (size_t)l * NB * MODW;
            if (l == 0) {
#pragma unroll 1
                for (int rep = 0; rep < REP_NORM1; ++rep)
                    row_phase<true, false, true, false, false>(lds, tid, lane, wave, G, bx, x_in, XB, out, g_mix, modl, 0, DM, MOD, H, YM, POS, TW, WR, TE, TRK, CNT);
            } else row_phase<false, true, true, false, false>(lds, tid, lane, wave, G, bx, x_in, XB, out, g_mix + DM, modl, 0, DM, MOD, H, YM, POS, TW, WR, TE, TRK, CNT); }
            {
                SEAM(pb + P_NORM1);
                if (EN(2) && IN(pb + P_INPROJ)) {
                    PHASE_ENTER();
                    pg8::Gemm g{H, (const bf16_t*)(const GAS bf16_t*)(ws + WS_WIN + l * WIN_BYTES), DM}; pg8::StaticOrder S; S.init(TT, NC, G, bx); S.wgm = INPROJ_WGM;
                    LAS float* normw = (LAS float*)(lds + MISC_OFF + 1024);
                    if (tid < 256) { const int sel = tid >> 6, d = tid & 63; const float* srcw = (sel == 0) ? qn_a : (sel == 1) ? kn_a : (sel == 2) ? qn_b : kn_b; normw[tid] = srcw[l * 64 + d]; }
                    __syncthreads();
                    pg8::EpiInProj E{QA, KA, VA, QB, KB, VB, SA, SB, normw};
#pragma unroll 1
                    for (int rep = 0; rep < REP_INPROJ; ++rep)
                    pg8::gemm_phase<pg8::EpiInProj, pg8::StaticOrder>(lds, g, S, E, wave);
                }
                SEAM(pb + P_INPROJ);
                if (EN(3) && IN(pb + P_ATTN)) {
                    PHASE_ENTER(); (void)lane;
                    LAS char* ring = (LAS char*)lds;
#pragma unroll 1
                    for (int rep = 0; rep < REP_ATTB; ++rep)
                    for (int L = vcu; L < NB * 32; L += G) {
                        int lane; asm volatile("v_mbcnt_lo_u32_b32 %0, -1, 0\n\tv_mbcnt_hi_u32_b32 %0, -1, %0" : "=v"(lane)); const int hi = lane >> 5;
                        const int b = L >> 5, kvh = (L >> 4) & 1, qh = 4 * kvh + ((L >> 2) & 3), qb2 = L & 3;
                        const int tq0 = 512 * qb2 + 64 * wave + (lane & 31);
                        bf16x8 qr[2][4];
#pragma unroll
                        for (int g = 0; g < 2; ++g)
#pragma unroll
                            for (int d0 = 0; d0 < 4; ++d0) qr[g][d0] = *(const bf16x8*)(QB + ((size_t)b * SEQ + tq0 + 32 * g) * 512 + qh * 64 + 16 * d0 + 8 * hi);
                        f32x16 o[2][2]; float lsum[2] = {0.f, 0.f};
#pragma unroll
                        for (int r = 0; r < 16; ++r) { o[0][0][r] = 0.f; o[0][1][r] = 0.f; o[1][0][r] = 0.f; o[1][1][r] = 0.f; }
                        __syncthreads();
                        att::dense64_lag_loop(ring, KB + (size_t)b * SEQ * 128 + kvh * 64, VB + (size_t)b * SEQ * 128 + kvh * 64, 128, 32, qr, o, lsum, lane, wave, wave >= 4);
                        { int l2; asm volatile("v_mbcnt_lo_u32_b32 %0, -1, 0\n\tv_mbcnt_hi_u32_b32 %0, -1, %0" : "=v"(l2)); const int tqs = 512 * qb2 + 64 * wave + (l2 & 31);
#pragma unroll
                          for (int g = 0; g < 2; ++g) att::store_out(o[g], lsum[g], YAB + ((size_t)b * SEQ + tqs + 32 * g) * DM + 512 + qh * 64, l2); }
                    }
#pragma unroll 1
                    for (int rep = 0; rep < REP_ATTA; ++rep)
                    for (int L = vcu; L < NB * 32; L += G) {
                        int lane; asm volatile("v_mbcnt_lo_u32_b32 %0, -1, 0\n\tv_mbcnt_hi_u32_b32 %0, -1, %0" : "=v"(lane)); const int hi = lane >> 5;
                        const int b = L >> 5, h = (L >> 2) & 7, tb2 = L & 3, base = 512 * tb2;
                        const int tq0 = base + 16 * (lane & 31) + wave, tq1 = tq0 + 8;
                        const bf16_t* Kg = KA + (size_t)b * SEQ * 512 + h * 64; const bf16_t* Vg = VA + (size_t)b * SEQ * 512 + h * 64;
                        bf16x8 qr[2][4];
#pragma unroll
                        for (int g = 0; g < 2; ++g)
#pragma unroll
                            for (int d0 = 0; d0 < 4; ++d0) qr[g][d0] = *(const bf16x8*)(QA + ((size_t)b * SEQ + tq0 + 8 * g) * 512 + h * 64 + 16 * d0 + 8 * hi);
                        f32x16 o[2][2]; float lsum[2] = {0.f, 0.f};
#pragma unroll
                        for (int r = 0; r < 16; ++r) { o[0][0][r] = 0.f; o[0][1][r] = 0.f; o[1][0][r] = 0.f; o[1][1][r] = 0.f; }
                        __syncthreads();
                        att::dense64_loop<true>(ring, Kg, Vg, 512, base - 64, 10, qr, o, lsum, tq0, tq1, lane, wave);
                        __syncthreads();
                        {
                            LAS char* vpriv = ring + att::PRIV_OFF + wave * att::VTILE;
#define A_TK0(j) ((j) < 4 ? base + wave - 256 + 256 * (j) : wave + 8 * (((j) - 4) >> 1) + 1024 * (((j) - 4) & 1))
#define A_DK(j) ((j) < 4 ? 4 : 16)
                            bf16x8 kf[8];
                            att::priv_kload(kf, Kg, 512, A_TK0(0), 4, lane);
#pragma unroll 1
                            for (int j = 0; j < 8; ++j) {
                                const bool p2 = j < 4; const int g = (j - 4) >> 1;
                                att::priv2_step(kf, vpriv, Kg, Vg, 512, A_TK0(j), A_DK(j), p2 || g == 0, p2 || g == 1, j + 1 < 8, A_TK0(j + 1), A_DK(j + 1), qr, o, lsum, tq0, tq1, lane);
                            }
#undef A_TK0
#undef A_DK
                        }
                        { int l2; asm volatile("v_mbcnt_lo_u32_b32 %0, -1, 0\n\tv_mbcnt_hi_u32_b32 %0, -1, %0" : "=v"(l2)); const int tqs = base + 16 * (l2 & 31) + wave;
#pragma unroll
                          for (int g = 0; g < 2; ++g) att::store_out(o[g], lsum[g], YAB + ((size_t)b * SEQ + tqs + 8 * g) * DM + h * 64, l2); }
                    }
                    __syncthreads();
                }
                SEAM(pb + P_ATTN);
                if (EN(4) && IN(pb + P_PAB)) {
                    PHASE_ENTER();
                    pg8::StaticOrder S; S.init(TT, DM, G, bx); S.wgm = N1K_WGM;
                    pg8::Gemm g{YAB, (const bf16_t*)(const GAS bf16_t*)(ws + WS_WPA + l * 2 * MiB), DM}; pg8::EpiMergeFused E{MERGED, PGATE_A, PGATE_B};
#pragma unroll 1
                    for (int rep = 0; rep < REP_PAB; ++rep)
                    pg8::gemm_phase<pg8::EpiMergeFused, pg8::StaticOrder>(lds, g, S, E, wave);
                }
                SEAM(pb + P_PAB);
                if (EN(5) && IN(pb + P_OUT)) {
                    PHASE_ENTER(); const float* modl = MOD + (size_t)l * NB * MODW;
                    pg8::Gemm g{MERGED, (const bf16_t*)(const GAS bf16_t*)(ws + WS_WOUT + l * 2 * MiB), DM}; pg8::StaticOrder S; S.init(TT, DM, G, bx); S.rowmajor = OUT_ROWMAJOR; S.wgm = N1K_WGM;
                    pg8::EpiResidB E{(l == 0) ? x_in : (const float*)nullptr, XB, XB, modl + 2 * DM};
#pragma unroll 1
                    for (int rep = 0; rep < ((l == 0) ? REP_OUT : 1); ++rep)
                    pg8::gemm_phase<pg8::EpiResidB, pg8::StaticOrder>(lds, g, S, E, wave);
                }
                SEAM(pb + P_OUT);
            }
        if (EN(6) && IN(pb + P_NORM2)) { PHASE_ENTER(); const float* modl = MOD + (size_t)l * NB * MODW;
#pragma unroll 1
            for (int rep = 0; rep < REP_NORM2; ++rep)
            row_phase<false, false, true, true, false>(lds, tid, lane, wave, G, bx, x_in, XB, out, g_ffn + l * DM, modl, 3 * DM, 4 * DM, MOD, H, YM, POS, TW, WR, TE, TRK, CNT); }
        SEAM(pb + P_NORM2);
        if (EN(7) && IN(pb + P_PLACE)) {
            PHASE_ENTER();
            LAS int* part_tot = (LAS int*)lds;
            LAS int* part_pre = part_tot + 512;
            LAS int* basee = part_pre + 512;
            LAS int* pstart = basee + 32;
            LAS int* pend = pstart + 32;
            LAS int* tote = pend + 32;
            for (int chunk = bx; chunk < 256; chunk += G) {
                { const int e = tid & 31, part = tid >> 5; int st = 0, sp = 0;
                    for (int q = 0; q < 16; ++q) { const int ch = part * 16 + q; const int v = CNT[ch * 32 + e]; st += v; sp += (ch < chunk) ? v : 0; }
                    part_tot[part * 32 + e] = st; part_pre[part * 32 + e] = sp; }
                __syncthreads();
                if (tid < 32) { int st = 0, sp = 0; for (int q = 0; q < 16; ++q) { st += part_tot[q * 32 + tid]; sp += part_pre[q * 32 + tid]; } tote[tid] = st; basee[tid] = sp; }
                __syncthreads();
                if (tid == 0) { int run = 0; for (int e = 0; e < 32; ++e) { const int padded = (tote[e] + 255) & ~255; pstart[e] = run; basee[e] += run; run += padded; pend[e] = run; } }
                __syncthreads();
                { const int tok = chunk * 256 + (tid >> 1), slot = tid & 1; const int e = TE[2 * tok + slot], rk = TRK[2 * tok + slot]; const int dest = basee[e] + rk;
                    BTOK[dest] = tok; POS[2 * tok + slot] = dest; }
                if (chunk < 32) { const int e = chunk; const int from = pstart[e] + tote[e], n = pend[e] - from; if (tid < n) BTOK[from + tid] = 0; }
                if (chunk == 0) {
                    for (int blk = tid; blk < NBLK; blk += 512) { int e = 0; for (int q = 0; q < 32; ++q) e += (pend[q] <= blk * 256) ? 1 : 0; BLKE[blk] = e > 31 ? 31 : e; }
                    if (tid == 0) BLKE[1000] = pend[31] >> 8;
                }
                __syncthreads();
            }
        }
        SEAM(pb + P_PLACE);
        if (EN(8) && IN(pb + P_GU)) {
            PHASE_ENTER();
            const int nused = BLKE[1000];
            pg8::Gemm g{H, (const bf16_t*)(const GAS bf16_t*)(ws + WS_WGU + (size_t)l * NEXP * 2 * MiB), DM};
            pg8::MoeOrder S{BLKE, BTOK, 4 * nused, G, bx};
            pg8::EpiSwiGLU E{ACT};
#pragma unroll 1
            for (int rep = 0; rep < REP_GU; ++rep)
            pg8::gemm_phase<pg8::EpiSwiGLU, pg8::MoeOrder>(lds, g, S, E, wave);
        }
        SEAM(pb + P_GU);
        if (EN(9) && IN(pb + P_DOWN)) {
            PHASE_ENTER();
            const int nused = BLKE[1000];
            pg8::Gemm g{ACT, (const bf16_t*)(const GAS bf16_t*)(ws + WS_WDN + (size_t)l * NEXP * MiB), DFF};
            pg8::MoeOrder S{BLKE, nullptr, 4 * nused, G, bx};
            pg8::EpiY E{YM};
#pragma unroll 1
            for (int rep = 0; rep < REP_DOWN; ++rep)
            pg8::gemm_phase<pg8::EpiY, pg8::MoeOrder>(lds, g, S, E, wave);
        }
        SEAM(pb + P_DOWN);
    }
    if (EN(10) && IN(PH_FINAL)) {
        PHASE_ENTER();
        row_phase<false, true, false, false, true>(lds, tid, lane, wave, G, bx, x_in, XB, out, g_ffn, MOD, 0, 0, MOD + (size_t)NB * MODW, H, YM, POS, TW, WR, TE, TRK, CNT);
    }
#undef IN
#undef SEAM
#undef GRID_BAR
}

extern "C" void kernel_launch(void* const* d_in, const int* in_sizes, int n_in, void* d_out, int out_size, void* d_ws, size_t ws_size, hipStream_t stream) {
    static int grid = 0;
    if (grid == 0) {
        if (n_in != 18 || in_sizes[0] != TT * DM || out_size != TT * DM || ws_size < WS_END) { fprintf(stderr, "kernel_launch: unexpected shapes / workspace (n_in %d, ws %zu); nothing launched\n", n_in, ws_size); grid = -1; return; }
        int dev = 0, cus = 0, per_cu = 0;
        if (hipGetDevice(&dev) != hipSuccess || hipDeviceGetAttribute(&cus, hipDeviceAttributeMultiprocessorCount, dev) != hipSuccess) { grid = -1; return; }
        if (hipFuncSetAttribute((const void*)fwd_kernel, hipFuncAttributeMaxDynamicSharedMemorySize, LDS_BYTES) != hipSuccess) { fprintf(stderr, "kernel_launch: hipFuncSetAttribute failed\n"); grid = -1; return; }
        if (hipOccupancyMaxActiveBlocksPerMultiprocessor(&per_cu, (const void*)fwd_kernel, 512, LDS_BYTES) != hipSuccess || per_cu < 1) { fprintf(stderr, "kernel_launch: occupancy query says %d\n", per_cu); per_cu = 1; }
        (void)hipGetLastError();
        grid = cus;
    }
    if (grid < 0) return;
    (void)hipMemsetAsync((char*)d_ws + WS_CTL, 0, CTL_ZERO_BYTES, stream);
    Args a{};
    for (int i = 0; i < 18; ++i) a.in[i] = (const float*)d_in[i];
    a.out = (float*)d_out; a.ws = (unsigned char*)d_ws;
#if MK_ONE_LAUNCH
    a.ph_lo = 0; a.ph_hi = NPH;
    hipLaunchKernelGGL(fwd_kernel, dim3(grid), dim3(512), LDS_BYTES, stream, a);
#else
    for (int p = 0; p < NPH; ++p) { a.ph_lo = p; a.ph_hi = p + 1; hipLaunchKernelGGL(fwd_kernel, dim3(grid), dim3(512), LDS_BYTES, stream, a); }
#endif
}
```

```cpp
#include <hip/hip_runtime.h>
#include <cstdio>
#include <cstdint>

#ifndef INPROJ_WGM
#define INPROJ_WGM 4
#endif
#ifndef GEMM_ALIGN
#define GEMM_ALIGN 1
#endif
#ifndef ROWB
#define ROWB 4
#endif
#ifndef N1K_WGM
#define N1K_WGM 8
#endif
#ifndef OUT_ROWMAJOR
#define OUT_ROWMAJOR 0
#endif
#ifndef REP_PRO
#define REP_PRO 1
#endif
#ifndef REP_ATTB
#define REP_ATTB 1
#endif
#ifndef REP_ATTA
#define REP_ATTA 1
#endif
#ifndef REP_INPROJ
#define REP_INPROJ 1
#endif
#ifndef REP_NORM1
#define REP_NORM1 1
#endif
#ifndef REP_GU
#define REP_GU 1
#endif
#ifndef REP_PAB
#define REP_PAB 1
#endif
#ifndef REP_OUT
#define REP_OUT 1
#endif
#ifndef REP_DOWN
#define REP_DOWN 1
#endif
#ifndef REP_NORM2
#define REP_NORM2 1
#endif
#ifndef MK_ONE_LAUNCH
#define MK_ONE_LAUNCH 1
#endif

#define LAS __attribute__((address_space(3)))
#define GAS __attribute__((address_space(1)))
typedef unsigned short bf16_t;
typedef short bf16x8 __attribute__((ext_vector_type(8)));
typedef short s16x4 __attribute__((ext_vector_type(4)));
typedef float f32x4 __attribute__((ext_vector_type(4)));
typedef float f32x16 __attribute__((ext_vector_type(16)));
typedef unsigned u32x4 __attribute__((ext_vector_type(4)));
typedef unsigned u32x2 __attribute__((ext_vector_type(2)));

constexpr int NB = 32, SEQ = 2048, DM = 1024, TT = NB * SEQ;
constexpr int NC = 4352;
constexpr int NEXP = 32, DFF = 512, NPAD = 139264, NBLK = 544;
constexpr int MODW = 6 * DM;
constexpr float QSCALE = 0.125f * 1.4426950408889634f;

constexpr size_t MiB = 1u << 20;
constexpr size_t WS_CTL = 0, CTL_ZERO_BYTES = 64 * 1024;
constexpr size_t WS_MOD = 1 * MiB;
constexpr size_t WS_TE = 2 * MiB + 512 * 1024, WS_TRK = 3 * MiB, WS_TW = 3 * MiB + 512 * 1024, WS_POS = 4 * MiB;
constexpr size_t WS_CNT = 4 * MiB + 512 * 1024;
constexpr size_t WS_BLKE = WS_CNT + 64 * 1024;
constexpr size_t WS_BTOK = WS_CNT + 128 * 1024;
constexpr size_t WS_WR = 5 * MiB + 256 * 1024;
constexpr size_t WS_WIN = 6 * MiB;
constexpr size_t WIN_BYTES = (size_t)NC * DM * 2;
constexpr size_t WS_WPA = 23 * MiB, WS_WPB = 25 * MiB, WS_WOUT = 27 * MiB;
constexpr size_t WS_WGU = 31 * MiB;
constexpr size_t WS_WDN = 159 * MiB;
constexpr size_t WS_H = 223 * MiB;
constexpr size_t WS_QKV = 351 * MiB;
constexpr size_t WS_GATE = 639 * MiB;
constexpr size_t WS_XB = 896 * MiB;
constexpr size_t WS_END = 1024 * MiB;
constexpr int CW_BAR = 4096;

constexpr int RING_BYTES = 133120;
constexpr int MISC_OFF = RING_BYTES;
constexpr int LDS_BYTES = 147456;

#define RLX_AGENT __ATOMIC_RELAXED, __HIP_MEMORY_SCOPE_AGENT
typedef float f32x2_t __attribute__((ext_vector_type(2))); typedef __bf16 bf16x2_t __attribute__((ext_vector_type(2)));
__device__ __forceinline__ unsigned cvt_pk_bf16(float lo, float hi) { const f32x2_t v = {lo, hi}; const bf16x2_t b = __builtin_convertvector(v, bf16x2_t); return __builtin_bit_cast(unsigned, b); }
typedef float f32x2v __attribute__((ext_vector_type(2)));
__device__ __forceinline__ unsigned pack4_fp8(float a, float b, float c, float d) { unsigned w = 0; w = __builtin_amdgcn_cvt_pk_fp8_f32(a, b, w, false); w = __builtin_amdgcn_cvt_pk_fp8_f32(c, d, w, true); return w; }
__device__ __forceinline__ void unpack8_fp8(u32x2 w, float (&o)[8]) { const f32x2v a = __builtin_amdgcn_cvt_pk_f32_fp8(w.x, false), b = __builtin_amdgcn_cvt_pk_f32_fp8(w.x, true), c = __builtin_amdgcn_cvt_pk_f32_fp8(w.y, false), d = __builtin_amdgcn_cvt_pk_f32_fp8(w.y, true);
    o[0] = a.x; o[1] = a.y; o[2] = b.x; o[3] = b.y; o[4] = c.x; o[5] = c.y; o[6] = d.x; o[7] = d.y; }
__device__ __forceinline__ float bf_lo(unsigned w) { return __uint_as_float(w << 16); }
__device__ __forceinline__ float bf_hi(unsigned w) { return __uint_as_float(w & 0xffff0000u); }
__device__ __forceinline__ float shx(float v, int mask, int lane) { return __int_as_float(__builtin_amdgcn_ds_bpermute((lane ^ mask) << 2, __float_as_int(v))); }
__device__ __forceinline__ float wave_sum(float v, int lane) {
#pragma unroll
    for (int o = 1; o < 64; o <<= 1) v += shx(v, o, lane);
    return v;
}
__device__ __forceinline__ float wave_max(float v, int lane) {
#pragma unroll
    for (int o = 1; o < 64; o <<= 1) v = fmaxf(v, shx(v, o, lane));
    return v;
}
__device__ __forceinline__ float sigmoid_f(float x) { return __builtin_amdgcn_rcpf(1.0f + __builtin_amdgcn_exp2f(-1.4426950408889634f * x)); }

#define XB_TMO      128
#define XB_XCNT(j)  (256  + 64 * (j))
#define XB_XSUB(j)  (1280 + 64 * (j))
#define XB_XGEN(j)  (2304 + 64 * (j))
#define XB_TOP      3328
#define XB_TOPGEN   3392
#define XCD_BAR_WORDS 3456
#define XB_SPIN_CAP (1u << 18)

__device__ __forceinline__ unsigned xb_ld(unsigned* p)              { return __hip_atomic_load(p, __ATOMIC_RELAXED, __HIP_MEMORY_SCOPE_AGENT); }
__device__ __forceinline__ unsigned xb_add(unsigned* p, unsigned v) { return __hip_atomic_fetch_add(p, v, __ATOMIC_RELAXED, __HIP_MEMORY_SCOPE_AGENT); }
__device__ __forceinline__ unsigned xb_xcc_id() { return (unsigned)__builtin_amdgcn_s_getreg((3 << 11) | 20) & 0xFu; }
#define XB_SPIN(cond, bar) do { unsigned _sp = 0; while (cond) { __builtin_amdgcn_s_sleep(1); \
    if ((++_sp & 255u) == 0u) { if (xb_ld(&(bar)[XB_TMO])) break; if (_sp > XB_SPIN_CAP) { atomicAdd(&(bar)[XB_TMO], 1u); break; } } } } while (0)

struct XcdBarrier { unsigned* bar; unsigned x; volatile LAS unsigned* st; };

__device__ __forceinline__ XcdBarrier xcd_barrier_post(unsigned* bar, volatile LAS unsigned* st) {
    XcdBarrier b; b.bar = bar; b.x = xb_xcc_id(); b.st = st;
    if (threadIdx.x == 0) (void)xb_add(&bar[XB_XCNT(b.x)], 1u);
    return b;
}
__device__ __forceinline__ void xcd_barrier_complete(unsigned* bar, unsigned x, unsigned& nloc, unsigned& nx) {
    const unsigned G = gridDim.x * gridDim.y * gridDim.z;
    unsigned sum, cnt, mine, sp = 0u;
    for (;;) {
        sum = 0u; cnt = 0u; mine = 0u;
#pragma unroll
        for (unsigned j = 0; j < 16; ++j) { const unsigned c = xb_ld(&bar[XB_XCNT(j)]); sum += c; cnt += (c > 0u) ? 1u : 0u; mine = (j == x) ? c : mine; }
        if (sum == G) break;
        __builtin_amdgcn_s_sleep(1);
        if ((++sp & 255u) == 0u) { if (xb_ld(&bar[XB_TMO])) break; if (sp > XB_SPIN_CAP) { atomicAdd(&bar[XB_TMO], 1u); break; } }
    }
    nloc = mine > 0u ? mine : 1u; nx = cnt > 0u ? cnt : 1u;
}
__device__ __forceinline__ void xcd_barrier(const XcdBarrier& b, const bool is_t0  ) {
    asm volatile("s_waitcnt vmcnt(0)" ::: "memory");
    __syncthreads();
    if (is_t0) {
        unsigned* bar = b.bar; unsigned bx_ = b.x;
        asm volatile("" : "+s"(bar), "+s"(bx_));
        __builtin_amdgcn_s_waitcnt(0);
        unsigned nloc = b.st[0], nx = b.st[1];
        if (nloc == 0u) { xcd_barrier_complete(bar, bx_, nloc, nx); b.st[0] = nloc; b.st[1] = nx; }
        const unsigned old = xb_add(&bar[XB_XSUB(bx_)], 1u);
        const unsigned gen = old / nloc;
        if (old + 1u == (gen + 1u) * nloc) {
            __builtin_amdgcn_fence(__ATOMIC_RELEASE, "agent");
            asm volatile("s_waitcnt vmcnt(0)" ::: "memory");
            const unsigned og = xb_add(&bar[XB_TOP], 1u);
            const unsigned tg = og / nx;
            if (og + 1u == (tg + 1u) * nx) xb_add(&bar[XB_TOPGEN], 1u);
            else XB_SPIN(xb_ld(&bar[XB_TOPGEN]) == tg, bar);
            __builtin_amdgcn_fence(__ATOMIC_ACQUIRE, "agent");
            xb_add(&bar[XB_XGEN(bx_)], 1u);
            asm volatile("s_waitcnt vmcnt(0)" ::: "memory");
        } else {
            XB_SPIN(xb_ld(&bar[XB_XGEN(bx_)]) == gen, bar);
            __builtin_amdgcn_fence(__ATOMIC_ACQUIRE, "agent");
            asm volatile("s_waitcnt vmcnt(0)" ::: "memory");
        }
    }
    __syncthreads();
}

namespace pg8 {
constexpr int BM = 256, BK = 64, HALF = 128, HTB = HALF * BK * 2, STAGE_BYTES = 8 * HTB, NXCD = 8, WGM = 8;
__host__ __device__ __forceinline__ int lds_byte(int r, int c) { const int st = (r >> 4) * 2 + (c >> 5), rr = r & 15, cc = c & 31, ob = rr * 64 + cc * 2; return st * 1024 + (ob ^ (((ob >> 9) & 1) << 5)); }
__host__ __device__ __forceinline__ void stage_rc(int b, int& R, int& C) { const int st = b / 1024, sb = b % 1024, swz = sb ^ (((sb >> 9) & 1) << 5); R = (st >> 1) * 16 + swz / 64; C = (st & 1) * 32 + (swz % 64) / 2; }
__host__ __device__ __forceinline__ int perm32(int rho) { const int n = rho >> 4, i = rho & 15; return 8 * (i >> 2) + 4 * n + (i & 3); }

struct Unit { int pm, pn; };
struct Gemm { const bf16_t* A; const bf16_t* Bt; int K; };

struct StaticOrder {
    static constexpr bool GATHER = false;
    int nM, nN, nwg, G, c, wgm = WGM;
    __device__ void init(int M, int N, int G_, int c_) { asm volatile("" : "+s"(c_));     nM = M / BM; nN = N / BM; nwg = nM * nN; G = G_; c = c_; }
    int rowmajor = 0;
    __device__ __forceinline__ bool next(int i, Unit& u) const {
        if (rowmajor) { const int upw = (nwg + G - 1) / G, k = c * upw + i; if (i >= upw || k >= nwg) return false; u.pm = k / nN; u.pn = k % nN; return true; }
        const long L = (long)i * G + c; if (L >= nwg) return false;
        int wgid = (int)L; { const int q = nwg / NXCD, r = nwg % NXCD, xcd = wgid % NXCD, off = wgid / NXCD; wgid = (xcd < r ? xcd * (q + 1) : r * (q + 1) + (xcd - r) * q) + off; }
        const int nig = wgm * nN, gid = wgid / nig, fm = gid * wgm, gsz = (nM - fm) < wgm ? (nM - fm) : wgm;
        u.pm = fm + ((wgid % nig) % gsz); u.pn = (wgid % nig) / gsz; return true;
    }
    __device__ __forceinline__ void aoff(const Unit&, const int (&)[2], const unsigned (&)[2], int, unsigned (&)[2][2]) const {}
};
struct MoeOrder {
    static constexpr bool GATHER = true;
    const int* blk_e; const int* rowidx; int nunits, G, c;
    __device__ __forceinline__ bool next(int i, Unit& u) const {
        const int L = i * G + c; if (L >= nunits) return false;
        const int blk = L >> 2; const int e = blk_e[blk]; u.pm = blk; u.pn = 4 * e + (L & 3); return true;
    }
    __device__ __forceinline__ void aoff(const Unit& u, const int (&RA)[2], const unsigned (&CA2)[2], int K, unsigned (&o)[2][2]) const {
#pragma unroll
        for (int h = 0; h < 2; ++h)
#pragma unroll
            for (int i = 0; i < 2; ++i) { const int r = u.pm * BM + h * HALF + RA[i]; const int src = rowidx ? rowidx[r] : r; o[h][i] = (unsigned)src * (unsigned)(K * 2) + CA2[i]; }
    }
};

template <class Epi, class Sched>
__device__ __forceinline__ void gemm_phase(LAS unsigned char* lds, const Gemm g, const Sched& S, const Epi& E, const int wid) {
    int lane_; asm volatile("v_mbcnt_lo_u32_b32 %0, -1, 0\n\tv_mbcnt_hi_u32_b32 %0, -1, %0" : "=v"(lane_));
    const int lane = lane_, tid = wid * 64 + lane, wr = wid >> 2, wc = wid & 3, fr = lane & 15, fq = lane >> 4;
    const int K = g.K, nt = K / BK;
    unsigned voffA[2], voffB[2], CA2[2]; int RA[2];
#pragma unroll
    for (int i = 0; i < 2; ++i) { int R, C; stage_rc(tid * 16 + i * 8192, R, C); const int Rb = Epi::PERM ? ((R & ~31) + perm32(R & 31)) : R;
        RA[i] = R; CA2[i] = (unsigned)C * 2u; voffA[i] = (unsigned)(R * K + C) * 2u; voffB[i] = (unsigned)(Rb * K + C) * 2u; }
    const size_t kstep = (size_t)(BK * 2);
    const size_t hstep = (size_t)HALF * K * 2;
    const size_t tstep = 2 * hstep;
    const unsigned ldsw = (unsigned)wid * 1024u;
    const int aoff = lds_byte(wr * 64 + fr, fq * 8), boff = lds_byte(wc * 32 + fr, fq * 8);
    const char* Ab = (const char*)g.A;
#define PG8_SA(b, h) (((b) * 2 + (h)) * HTB)
#define PG8_SB(b, h) ((4 + (b) * 2 + (h)) * HTB)
#define PG8_STAGEB(bufoff, gbase, voff) do { _Pragma("unroll") for (int _i = 0; _i < 2; ++_i) \
        __builtin_amdgcn_global_load_lds((const unsigned*)((const char*)(gbase) + (voff)[_i]), (LAS unsigned*)(lds + (bufoff) + ldsw + _i * 8192), 16, 0, 0); } while (0)
#define PG8_STAGEA(bufoff, H_, kb, NEXT) do { if constexpr (Sched::GATHER) { _Pragma("unroll") for (int _i = 0; _i < 2; ++_i) { const unsigned _o = (NEXT) ? na[H_][_i] : ca[H_][_i]; \
            __builtin_amdgcn_global_load_lds((const unsigned*)(Ab + (size_t)_o + (size_t)(kb)), (LAS unsigned*)(lds + (bufoff) + ldsw + _i * 8192), 16, 0, 0); } } \
        else { const char* _b = Ab + ((NEXT) ? nU : cU) + (size_t)(H_) * hstep + (size_t)(kb); _Pragma("unroll") for (int _i = 0; _i < 2; ++_i) \
            __builtin_amdgcn_global_load_lds((const unsigned*)(_b + voffA[_i]), (LAS unsigned*)(lds + (bufoff) + ldsw + _i * 8192), 16, 0, 0); } } while (0)
#define PG8_LDA(dst, b, h) do { _Pragma("unroll") for (int m = 0; m < 4; ++m) _Pragma("unroll") for (int k = 0; k < 2; ++k) dst[m][k] = *(const LAS bf16x8*)(lds + PG8_SA(b, h) + aoff + m * 2048 + k * 1024); } while (0)
#define PG8_LDB(dst, b, h) do { _Pragma("unroll") for (int n = 0; n < 2; ++n) _Pragma("unroll") for (int k = 0; k < 2; ++k) dst[n][k] = *(const LAS bf16x8*)(lds + PG8_SB(b, h) + boff + n * 2048 + k * 1024); } while (0)
#define PG8_MMA(ai, bj, At, Bt) do { __builtin_amdgcn_s_setprio(1); _Pragma("unroll") for (int m = 0; m < 4; ++m) _Pragma("unroll") for (int n = 0; n < 2; ++n) _Pragma("unroll") for (int k = 0; k < 2; ++k) \
        acc[ai][bj][m][n] = __builtin_amdgcn_mfma_f32_16x16x32_bf16(Bt[n][k], At[m][k], acc[ai][bj][m][n], 0, 0, 0); __builtin_amdgcn_s_setprio(0); } while (0)
#define PG8_WAIT_V(n) asm volatile("s_waitcnt vmcnt(" #n ")" ::: "memory")
#define PG8_WAIT_L(n) asm volatile("s_waitcnt lgkmcnt(" #n ")" ::: "memory")
#define PG8_BAR __builtin_amdgcn_s_barrier()
#define PG8_SCHED __builtin_amdgcn_sched_barrier(0)
    Unit cur, nxt; int ui = 0;
    if (!S.next(0, cur)) return;
    f32x4 acc[2][2][4][2];
#pragma unroll
    for (int a = 0; a < 2; ++a)
#pragma unroll
        for (int b = 0; b < 2; ++b)
#pragma unroll
            for (int m = 0; m < 4; ++m)
#pragma unroll
                for (int n = 0; n < 2; ++n) acc[a][b][m][n] = (f32x4){0.f, 0.f, 0.f, 0.f};
    bf16x8 At[4][2], B0[2][2], B1[2][2];
    unsigned ca[2][2], na[2][2];
    size_t cU = 0, nU = 0;
    if constexpr (Sched::GATHER) S.aoff(cur, RA, CA2, K, ca); else cU = (size_t)cur.pm * tstep;
    const char* cB = (const char*)g.Bt + (size_t)cur.pn * tstep;
    PG8_STAGEB(PG8_SB(0, 0), cB, voffB); PG8_STAGEB(PG8_SB(0, 1), cB + hstep, voffB); PG8_STAGEA(PG8_SA(0, 0), 0, 0, false); PG8_STAGEA(PG8_SA(0, 1), 1, 0, false);
    if (wr == 1) PG8_BAR;
    PG8_WAIT_V(2); PG8_BAR;
    PG8_STAGEB(PG8_SB(1, 0), cB + kstep, voffB); PG8_STAGEA(PG8_SA(1, 0), 0, kstep, false); PG8_STAGEB(PG8_SB(1, 1), cB + hstep + kstep, voffB);
    PG8_WAIT_V(6); PG8_BAR;
    for (;;) {
        const bool has_next = S.next(ui + 1, nxt);
        if constexpr (Sched::GATHER) {
            if (has_next) S.aoff(nxt, RA, CA2, K, na);
            else {
#pragma unroll
                for (int h = 0; h < 2; ++h)
#pragma unroll
                    for (int i = 0; i < 2; ++i) na[h][i] = ca[h][i];
            }
        } else nU = has_next ? (size_t)nxt.pm * tstep : cU;
        const char* nB = has_next ? (const char*)g.Bt + (size_t)nxt.pn * tstep : cB;
        for (int t = 0; t < nt; t += 2) {
            const bool last = (t == nt - 2);
            const size_t kb1 = (size_t)(t + 1) * kstep;
            const size_t kb2 = last ? 0 : (size_t)(t + 2) * kstep, kb3 = kb2 + kstep;
            const char* b2 = last ? nB : cB + (size_t)(t + 2) * kstep; const char* b3 = b2 + kstep;
            PG8_LDB(B0, 0, 0); PG8_LDB(B1, 0, 1); PG8_SCHED; PG8_LDA(At, 0, 0); PG8_STAGEA(PG8_SA(1, 1), 1, kb1, false);
            PG8_WAIT_V(8); PG8_WAIT_L(0); PG8_BAR; PG8_MMA(0, 0, At, B0); PG8_MMA(0, 1, At, B1); PG8_BAR; PG8_SCHED;
            PG8_LDA(At, 0, 1); PG8_STAGEB(PG8_SB(0, 0), b2, voffB); PG8_STAGEB(PG8_SB(0, 1), b2 + hstep, voffB); PG8_STAGEA(PG8_SA(0, 0), 0, kb2, last);
            PG8_WAIT_V(8); PG8_WAIT_L(0); PG8_BAR; PG8_MMA(1, 0, At, B0); PG8_MMA(1, 1, At, B1); PG8_BAR; PG8_SCHED;
            PG8_LDB(B0, 1, 0); PG8_LDB(B1, 1, 1); PG8_SCHED; PG8_LDA(At, 1, 0); PG8_STAGEA(PG8_SA(0, 1), 1, kb2, last);
            PG8_WAIT_V(8); PG8_WAIT_L(0); PG8_BAR; PG8_MMA(0, 0, At, B0); PG8_MMA(0, 1, At, B1); PG8_BAR; PG8_SCHED;
            PG8_LDA(At, 1, 1); PG8_STAGEB(PG8_SB(1, 0), b3, voffB); PG8_STAGEB(PG8_SB(1, 1), b3 + hstep, voffB); PG8_STAGEA(PG8_SA(1, 0), 0, kb3, last);
            PG8_WAIT_V(8); PG8_WAIT_L(0); PG8_BAR; PG8_MMA(1, 0, At, B0); PG8_MMA(1, 1, At, B1); PG8_BAR; PG8_SCHED;
            if constexpr (Epi::MIDK) { if (t + 2 == nt / 2) E.mid(acc, cur, wr, wc, fr, fq); }
        }
#if GEMM_ALIGN
        if (wr == 0) PG8_BAR;
#endif
        E(acc, cur, wr, wc, fr, fq);
        if (!has_next) break;
#pragma unroll
        for (int a = 0; a < 2; ++a)
#pragma unroll
            for (int b = 0; b < 2; ++b)
#pragma unroll
                for (int m = 0; m < 4; ++m)
#pragma unroll
                    for (int n = 0; n < 2; ++n) acc[a][b][m][n] = (f32x4){0.f, 0.f, 0.f, 0.f};
        cur = nxt; cB = nB; cU = nU; ++ui;
        if constexpr (Sched::GATHER) {
#pragma unroll
            for (int h = 0; h < 2; ++h)
#pragma unroll
                for (int i = 0; i < 2; ++i) ca[h][i] = na[h][i];
        }
#if GEMM_ALIGN
        if (wr == 1) PG8_BAR;
#endif
    }
    PG8_WAIT_V(0);
#if !GEMM_ALIGN
    if (wr == 0) PG8_BAR;
#endif
    PG8_BAR;
#undef PG8_SA
#undef PG8_SB
#undef PG8_STAGEA
#undef PG8_STAGEB
#undef PG8_LDA
#undef PG8_LDB
#undef PG8_MMA
#undef PG8_WAIT_V
#undef PG8_WAIT_L
#undef PG8_BAR
#undef PG8_SCHED
}

typedef const f32x4 (&AccRef)[2][2][4][2];

__device__ __forceinline__ u32x4 pack8(const f32x4& a, const f32x4& b) { u32x4 w; w.x = cvt_pk_bf16(a[0], a[1]); w.y = cvt_pk_bf16(a[2], a[3]); w.z = cvt_pk_bf16(b[0], b[1]); w.w = cvt_pk_bf16(b[2], b[3]); return w; }

struct EpiInProj {
    static constexpr bool PERM = true, MIDK = false;
    bf16_t *QA, *KA, *VA, *QB, *KB, *VB, *SA, *SB;
    const LAS float* normw;
    template <int ROPE>
    __device__ __forceinline__ void head_tile(AccRef acc, bf16_t* dst, int ld, int hcol, int gsel, float scale, int row0, int fr, int fq) const {
        int d0[2];
#pragma unroll
        for (int bj = 0; bj < 2; ++bj) d0[bj] = (ROPE == 1) ? (fq == 0 ? 8 * bj : 8 + 8 * fq + 24 * bj) : (fq < 2 ? 8 * fq + 16 * bj : 16 + 8 * fq + 16 * bj);
        f32x4 g[2][2];
#pragma unroll
        for (int bj = 0; bj < 2; ++bj)
#pragma unroll
            for (int n = 0; n < 2; ++n) g[bj][n] = *(const LAS f32x4*)(normw + gsel * 64 + d0[bj] + 4 * n);
        constexpr float FA[8] = {1.591549431e-01f, 3.086376340e-02f, 5.985185713e-03f, 1.160663641e-03f, 2.250790790e-04f, 4.364795279e-05f, 8.464330808e-06f, 1.641426263e-06f};
        constexpr float FB[16] = {1.591549431e-01f, 8.949940161e-02f, 5.032921210e-02f, 2.830219583e-02f, 1.591549431e-02f, 8.949940161e-03f, 5.032921210e-03f, 2.830219583e-03f,
                                  1.591549431e-03f, 8.949940161e-04f, 5.032921210e-04f, 2.830219583e-04f, 1.591549431e-04f, 8.949940161e-05f, 5.032921210e-05f, 2.830219583e-05f};
        float fq8[8];
#pragma unroll
        for (int k = 0; k < 8; ++k) fq8[k] = (ROPE == 1) ? FA[k] : ((fq & 1) ? FB[8 + k] : FB[k]);
        const bool rot = (ROPE == 2) || (fq == 0);
#pragma unroll
        for (int ai = 0; ai < 2; ++ai)
#pragma unroll
            for (int m = 0; m < 4; ++m) {
                const int row = row0 + ai * HALF + m * 16; const int s = row & (SEQ - 1);
                f32x4 y[2][2]; float ss = 0.f;
#pragma unroll
                for (int bj = 0; bj < 2; ++bj)
#pragma unroll
                    for (int n = 0; n < 2; ++n) { y[bj][n] = acc[ai][bj][m][n]; const f32x4 q = y[bj][n] * y[bj][n]; ss += (q[0] + q[1]) + (q[2] + q[3]); }
                ss += shx(ss, 16, fr + 16 * fq); ss += shx(ss, 32, fr + 16 * fq);
                const float rinv = __builtin_amdgcn_rsqf(ss * (1.0f / 64.0f) + 1e-6f);
#pragma unroll
                for (int bj = 0; bj < 2; ++bj)
#pragma unroll
                    for (int n = 0; n < 2; ++n) y[bj][n] = y[bj][n] * rinv * g[bj][n];
                if (ROPE != 0) {
                    const float pos = (float)((ROPE == 1) ? s : (fq < 2 ? (s >> 6) : (s & 63)));
#pragma unroll
                    for (int n = 0; n < 2; ++n)
#pragma unroll
                        for (int j = 0; j < 4; ++j) {
                            const float xr = __builtin_amdgcn_fractf(pos * fq8[4 * n + j]);
                            const float c = rot ? __builtin_amdgcn_cosf(xr) : 1.0f, s_ = rot ? __builtin_amdgcn_sinf(xr) : 0.0f;
                            const float x1 = y[0][n][j], x2 = y[1][n][j];
                            y[0][n][j] = x1 * c - x2 * s_; y[1][n][j] = x2 * c + x1 * s_;
                        }
                }
                bf16_t* rowp = dst + (size_t)row * ld + hcol + 8 * fq;
#pragma unroll
                for (int bj = 0; bj < 2; ++bj) *(u32x4*)(rowp + 32 * bj) = pack8(y[bj][0] * scale, y[bj][1] * scale);
            }
    }
    __device__ __forceinline__ void operator()(AccRef acc, const Unit& u, int wr, int wc, int fr_, int fq_) const {
        int fr = fr_, fq = fq_; asm volatile("" : "+v"(fr), "+v"(fq));
        const int pn = u.pn; const int row0 = u.pm * BM + wr * 64 + fr;
        if (pn >= 9) {
            unsigned char* base = (unsigned char*)((pn < 13) ? SA : SB); const int colt = ((pn - 9) & 3) * 256 + wc * 64 + 16 * fq;
#pragma unroll
            for (int ai = 0; ai < 2; ++ai)
#pragma unroll
                for (int m = 0; m < 4; ++m) { u32x4 w;
#pragma unroll
                    for (int bj = 0; bj < 2; ++bj) { f32x4 v0 = acc[ai][bj][m][0], v1 = acc[ai][bj][m][1];
#pragma unroll
                        for (int j = 0; j < 4; ++j) { v0[j] = sigmoid_f(v0[j]); v1[j] = sigmoid_f(v1[j]); }
                        const unsigned lo = pack4_fp8(v0[0], v0[1], v0[2], v0[3]), hi = pack4_fp8(v1[0], v1[1], v1[2], v1[3]);
                        if (bj == 0) { w.x = lo; w.y = hi; } else { w.z = lo; w.w = hi; } }
                    *(u32x4*)(base + (size_t)(row0 + ai * HALF + m * 16) * DM + colt) = w; }
        } else if (pn == 4 || pn == 5) {
            const int colt = (pn - 4) * 256 + wc * 32 + 8 * fq;
#pragma unroll
            for (int ai = 0; ai < 2; ++ai)
#pragma unroll
                for (int m = 0; m < 4; ++m) { bf16_t* rowp = VA + (size_t)(row0 + ai * HALF + m * 16) * 512 + colt;
#pragma unroll
                    for (int bj = 0; bj < 2; ++bj) *(u32x4*)(rowp + bj * HALF) = pack8(acc[ai][bj][m][0], acc[ai][bj][m][1]); }
        } else if (pn < 2)  head_tile<1>(acc, QA, 512, 64 * (4 * pn + wc), 0, QSCALE, row0, fr, fq);
        else if (pn < 4)    head_tile<1>(acc, KA, 512, 64 * (4 * (pn - 2) + wc), 1, 1.0f, row0, fr, fq);
        else if (pn < 8)    head_tile<2>(acc, QB, 512, 64 * (4 * (pn - 6) + wc), 2, QSCALE, row0, fr, fq);
        else if (wc < 2)    head_tile<2>(acc, KB, 128, 64 * wc, 3, 1.0f, row0, fr, fq);
        else {
#pragma unroll
            for (int ai = 0; ai < 2; ++ai)
#pragma unroll
                for (int m = 0; m < 4; ++m) { bf16_t* rowp = VB + (size_t)(row0 + ai * HALF + m * 16) * 128 + 64 * (wc - 2) + 8 * fq;
#pragma unroll
                    for (int bj = 0; bj < 2; ++bj) *(u32x4*)(rowp + 32 * bj) = pack8(acc[ai][bj][m][0], acc[ai][bj][m][1]); }
        }
    }
};

struct EpiMergeFused {
    static constexpr bool PERM = true, MIDK = true;
    bf16_t* MG; const bf16_t* GA; const bf16_t* GB;
    __device__ __forceinline__ void mid(f32x4 (&acc)[2][2][4][2], const Unit& u, int wr, int wc, int fr_, int fq_) const {
        int fr = fr_, fq = fq_; asm volatile("" : "+v"(fr), "+v"(fq));
        const int row0 = u.pm * BM + wr * 64 + fr, col0 = u.pn * BM + wc * 32 + 8 * fq;
#pragma unroll
        for (int ai = 0; ai < 2; ++ai)
#pragma unroll
            for (int m = 0; m < 4; ++m) { const size_t ro = (size_t)(row0 + ai * HALF + m * 16) * DM + col0;
#pragma unroll
                for (int bj = 0; bj < 2; ++bj) {
                    float sa[8], sb[8]; unpack8_fp8(*(const u32x2*)((const unsigned char*)GA + ro + bj * HALF), sa); unpack8_fp8(*(const u32x2*)((const unsigned char*)GB + ro + bj * HALF), sb);
#pragma unroll
                    for (int n = 0; n < 2; ++n)
#pragma unroll
                        for (int j = 0; j < 4; ++j) acc[ai][bj][m][n][j] *= sa[4 * n + j] * __builtin_amdgcn_rcpf(fmaxf(sb[4 * n + j], 1e-12f));
                } }
    }
    __device__ __forceinline__ void operator()(AccRef acc, const Unit& u, int wr, int wc, int fr_, int fq_) const {
        int fr = fr_, fq = fq_; asm volatile("" : "+v"(fr), "+v"(fq));
        const int row0 = u.pm * BM + wr * 64 + fr, col0 = u.pn * BM + wc * 32 + 8 * fq;
#pragma unroll
        for (int ai = 0; ai < 2; ++ai)
#pragma unroll
            for (int m = 0; m < 4; ++m) { const size_t ro = (size_t)(row0 + ai * HALF + m * 16) * DM + col0;
#pragma unroll
                for (int bj = 0; bj < 2; ++bj) {
                    float sb[8]; unpack8_fp8(*(const u32x2*)((const unsigned char*)GB + ro + bj * HALF), sb);
                    f32x4 v0 = acc[ai][bj][m][0], v1 = acc[ai][bj][m][1];
#pragma unroll
                    for (int j = 0; j < 4; ++j) { v0[j] *= fmaxf(sb[j], 1e-12f); v1[j] *= fmaxf(sb[4 + j], 1e-12f); }
                    *(u32x4*)(MG + ro + bj * HALF) = pack8(v0, v1); } }
    }
};

struct EpiResidB {
    static constexpr bool PERM = true, MIDK = false;
    const float* Xf; const bf16_t* Xb; bf16_t* O; const float* gate;
    __device__ __forceinline__ void operator()(AccRef acc, const Unit& u, int wr, int wc, int fr_, int fq_) const {
        int fr = fr_, fq = fq_; asm volatile("" : "+v"(fr), "+v"(fq));
        const int row0 = u.pm * BM + wr * 64 + fr, col0 = u.pn * BM + wc * 32 + 8 * fq; const int b = (u.pm * BM) >> 11;
        f32x4 gt[2][2];
#pragma unroll
        for (int bj = 0; bj < 2; ++bj)
#pragma unroll
            for (int n = 0; n < 2; ++n) gt[bj][n] = *(const f32x4*)(gate + (size_t)b * MODW + col0 + bj * HALF + 4 * n);
#pragma unroll
        for (int ai = 0; ai < 2; ++ai)
#pragma unroll
            for (int m = 0; m < 4; ++m) { const size_t ro = (size_t)(row0 + ai * HALF + m * 16) * DM + col0;
#pragma unroll
                for (int bj = 0; bj < 2; ++bj) {
                    f32x4 x0, x1;
                    if (Xf) { x0 = *(const f32x4*)(Xf + ro + bj * HALF); x1 = *(const f32x4*)(Xf + ro + bj * HALF + 4); }
                    else { const u32x4 w = *(const u32x4*)(Xb + ro + bj * HALF); x0 = (f32x4){bf_lo(w.x), bf_hi(w.x), bf_lo(w.y), bf_hi(w.y)}; x1 = (f32x4){bf_lo(w.z), bf_hi(w.z), bf_lo(w.w), bf_hi(w.w)}; }
                    *(u32x4*)(O + ro + bj * HALF) = pack8(x0 + gt[bj][0] * acc[ai][bj][m][0], x1 + gt[bj][1] * acc[ai][bj][m][1]); } }
    }
};
struct EpiSwiGLU {
    static constexpr bool PERM = true, MIDK = false;
    bf16_t* ACT;
    __device__ __forceinline__ void operator()(AccRef acc, const Unit& u, int wr, int wc, int fr_, int fq_) const {
        int fr = fr_, fq = fq_; asm volatile("" : "+v"(fr), "+v"(fq));
        const int row0 = u.pm * BM + wr * 64 + fr, col0 = (u.pn & 3) * HALF + wc * 32 + 8 * fq;
#pragma unroll
        for (int ai = 0; ai < 2; ++ai)
#pragma unroll
            for (int m = 0; m < 4; ++m) { f32x4 r[2];
#pragma unroll
                for (int n = 0; n < 2; ++n)
#pragma unroll
                    for (int j = 0; j < 4; ++j) { const float gg = acc[ai][0][m][n][j], uu = acc[ai][1][m][n][j]; r[n][j] = gg * sigmoid_f(gg) * uu; }
                *(u32x4*)(ACT + (size_t)(row0 + ai * HALF + m * 16) * DFF + col0) = pack8(r[0], r[1]); }
    }
};

struct EpiY {
    static constexpr bool PERM = true, MIDK = false;
    bf16_t* Y;
    __device__ __forceinline__ void operator()(AccRef acc, const Unit& u, int wr, int wc, int fr_, int fq_) const {
        int fr = fr_, fq = fq_; asm volatile("" : "+v"(fr), "+v"(fq));
        const int row0 = u.pm * BM + wr * 64 + fr, col0 = (u.pn & 3) * BM + wc * 32 + 8 * fq;
#pragma unroll
        for (int ai = 0; ai < 2; ++ai)
#pragma unroll
            for (int m = 0; m < 4; ++m) { bf16_t* rowp = Y + (size_t)(row0 + ai * HALF + m * 16) * DM + col0;
#pragma unroll
                for (int bj = 0; bj < 2; ++bj) *(u32x4*)(rowp + bj * HALF) = pack8(acc[ai][bj][m][0], acc[ai][bj][m][1]); }
    }
};
}

__device__ __forceinline__ int dimA(int bj, int r) { return r < 8 ? r + 8 * bj : 16 + (r - 8) + 24 * bj; }
__device__ __forceinline__ int dimB(int bj, int r) { return r < 16 ? r + 16 * bj : 32 + (r - 16) + 16 * bj; }
__device__ __forceinline__ int inproj_srccol(int P) {
    const int pn = P >> 8, p = P & 255, bj = p >> 7, wc = (p >> 5) & 3, r = p & 31;
    if (pn < 2) return 64 * (4 * pn + wc) + dimA(bj, r);
    if (pn < 4) return 512 + 64 * (4 * (pn - 2) + wc) + dimA(bj, r);
    if (pn < 6) return 1024 + 256 * (pn - 4) + p;
    if (pn < 8) return 1536 + 64 * (4 * (pn - 6) + wc) + dimB(bj, r);
    if (pn == 8) return wc < 2 ? 2048 + 64 * wc + dimB(bj, r) : 2176 + 64 * (wc - 2) + 32 * bj + r;
    { const int fq = (p >> 3) & 3, r8 = p & 7; return 2304 + 256 * (pn - 9) + 64 * wc + 16 * fq + 8 * bj + r8; }
}

namespace att {
constexpr int KSTR = 144, VSTR = 192;
constexpr int KTILE = 64 * KSTR, VTILE = 64 * VSTR;
constexpr int K_OFF = 0, V_OFF = 2 * KTILE;
constexpr int PRIV_OFF = 0;
__device__ __forceinline__ s16x4 vtr(LAS const char* p) { typedef short v4i16_t __attribute__((ext_vector_type(4)));
    return __builtin_bit_cast(s16x4, __builtin_amdgcn_ds_read_tr16_b64_v4i16((LAS v4i16_t*)p)); }
__device__ __forceinline__ int clamp_tok(int t) { return t < 0 ? 0 : (t > SEQ - 1 ? SEQ - 1 : t); }

__device__ __forceinline__ void qk_tile(f32x16& p0, f32x16& p1, const bf16x8 (&kf)[8], const bf16x8 (&qr)[4]) {
    const f32x16 z = {0.f, 0.f, 0.f, 0.f, 0.f, 0.f, 0.f, 0.f, 0.f, 0.f, 0.f, 0.f, 0.f, 0.f, 0.f, 0.f};
    p0 = __builtin_amdgcn_mfma_f32_32x32x16_bf16(kf[0], qr[0], z, 0, 0, 0); p1 = __builtin_amdgcn_mfma_f32_32x32x16_bf16(kf[1], qr[0], z, 0, 0, 0);
#pragma unroll
    for (int d0 = 1; d0 < 4; ++d0) { p0 = __builtin_amdgcn_mfma_f32_32x32x16_bf16(kf[2 * d0], qr[d0], p0, 0, 0, 0); p1 = __builtin_amdgcn_mfma_f32_32x32x16_bf16(kf[2 * d0 + 1], qr[d0], p1, 0, 0, 0); }
}
template <bool MASK>
__device__ __forceinline__ void exp_tile(const f32x16& p0, const f32x16& p1, float& lsum, bf16x8 (&pf)[2][2], int mbase, int mR, int dk) {
    float e0[16], e1[16]; float ls = 0.f;
#pragma unroll
    for (int r = 0; r < 16; ++r) {
        e0[r] = __builtin_amdgcn_exp2f(p0[r]); e1[r] = __builtin_amdgcn_exp2f(p1[r]);
        if (MASK) {
            const int c0 = (r & 3) + 8 * (r >> 2);
            e0[r] = ((unsigned)(mbase + dk * c0) <= (unsigned)mR) ? e0[r] : 0.f;
            e1[r] = ((unsigned)(mbase + dk * (c0 + 32)) <= (unsigned)mR) ? e1[r] : 0.f;
        }
        ls += e0[r] + e1[r];
    }
    lsum += ls;
#pragma unroll
    for (int s = 0; s < 2; ++s) {
        u32x4 w0, w1;
        w0.x = cvt_pk_bf16(e0[8 * s + 0], e0[8 * s + 1]); w0.y = cvt_pk_bf16(e0[8 * s + 2], e0[8 * s + 3]); w0.z = cvt_pk_bf16(e0[8 * s + 4], e0[8 * s + 5]); w0.w = cvt_pk_bf16(e0[8 * s + 6], e0[8 * s + 7]);
        w1.x = cvt_pk_bf16(e1[8 * s + 0], e1[8 * s + 1]); w1.y = cvt_pk_bf16(e1[8 * s + 2], e1[8 * s + 3]); w1.z = cvt_pk_bf16(e1[8 * s + 4], e1[8 * s + 5]); w1.w = cvt_pk_bf16(e1[8 * s + 6], e1[8 * s + 7]);
        pf[0][s] = __builtin_bit_cast(bf16x8, w0); pf[1][s] = __builtin_bit_cast(bf16x8, w1);
    }
}
__device__ __forceinline__ void vread(bf16x8 (&vf)[4], LAS const char* vb, int d0) {
#pragma unroll
    for (int blk = 0; blk < 2; ++blk)
#pragma unroll
        for (int s = 0; s < 2; ++s) {
            const s16x4 lo = vtr(vb + (32 * blk + 16 * s) * VSTR + 64 * d0), hi = vtr(vb + (32 * blk + 16 * s + 8) * VSTR + 64 * d0);
            vf[2 * blk + s] = (bf16x8){lo[0], lo[1], lo[2], lo[3], hi[0], hi[1], hi[2], hi[3]};
        }
}
__device__ __forceinline__ void pv_half(f32x16& od, const bf16x8 (&vf)[4], const bf16x8 (&pf)[2][2]) {
#pragma unroll
    for (int blk = 0; blk < 2; ++blk)
#pragma unroll
        for (int s = 0; s < 2; ++s) od = __builtin_amdgcn_mfma_f32_32x32x16_bf16(vf[2 * blk + s], pf[blk][s], od, 0, 0, 0);
}
__device__ __forceinline__ void mask_params(int dk, int tk0, int tq, int hi, int& mbase, int& mR) {
    const int dlo = (-64 * dk > -tq) ? -64 * dk : -tq, dhi = (64 * dk < SEQ - 1 - tq) ? 64 * dk : SEQ - 1 - tq;
    const int dA = tk0 + 4 * dk * hi - tq;
    mR = dhi - dlo; mbase = ((dA & (dk - 1)) == 0) ? dA - dlo : 0x7fffffff;
}

template <bool MASKED>
__device__ __forceinline__ void dense64_loop(LAS char* lds, const bf16_t* Kg, const bf16_t* Vg, int ld, int tok0, int ntiles,
                                             const bf16x8 (&qr)[2][4], f32x16 (&o)[2][2], float (&lsum)[2], int tq0, int tq1, int lane_, int wave) {
    constexpr int V2_OFF = 2 * KTILE;
    u32x4 kreg, vreg;
#define D64_LANE() int ln_ = lane_; asm volatile("" : "+v"(ln_)); const int tid_ = wave * 64 + ln_, srow = tid_ >> 3, sch = tid_ & 7
#define D64_LD(t) do { D64_LANE(); int tk_ = tok0 + 64 * (t) + srow; if (MASKED) tk_ = clamp_tok(tk_); kreg = *(const u32x4*)(Kg + (size_t)tk_ * ld + sch * 8); vreg = *(const u32x4*)(Vg + (size_t)tk_ * ld + sch * 8); } while (0)
#define D64_ST(t) do { D64_LANE(); *(LAS u32x4*)(lds + ((t) & 1) * KTILE + srow * KSTR + sch * 16) = kreg; *(LAS u32x4*)(lds + V2_OFF + ((t) & 1) * VTILE + srow * VSTR + sch * 16) = vreg; } while (0)
    D64_LD(0); D64_ST(0); D64_LD(1);
    for (int t = 0; t < ntiles; ++t) {
        __syncthreads();
        if (t + 1 < ntiles) D64_ST(t + 1);
        if (t + 2 < ntiles) D64_LD(t + 2);
        int lane = lane_; asm volatile("" : "+v"(lane));
        const int hi = lane >> 5;
        const int vlane = (4 * hi + ((lane & 15) >> 2)) * VSTR + (16 * ((lane >> 4) & 1) + 4 * (lane & 3)) * 2;
        const int klane = (lane & 31) * KSTR + 16 * hi;
        bf16x8 kf[8];
        { LAS const char* kb_ = lds + (t & 1) * KTILE + klane;
#pragma unroll
          for (int d0 = 0; d0 < 4; ++d0)
#pragma unroll
              for (int blk = 0; blk < 2; ++blk) kf[2 * d0 + blk] = *(const LAS bf16x8*)(kb_ + 32 * blk * KSTR + 32 * d0); }
        f32x16 p[2][2];
        bf16x8 vfa[4], vfb[4];
        LAS const char* vb_ = lds + V2_OFF + (t & 1) * VTILE + vlane;
        vread(vfa, vb_, 0); vread(vfb, vb_, 1);
        __builtin_amdgcn_sched_barrier(0);
        qk_tile(p[0][0], p[0][1], kf, qr[0]);
        qk_tile(p[1][0], p[1][1], kf, qr[1]);
#pragma unroll
        for (int g = 0; g < 2; ++g) {
            bf16x8 pf[2][2]; int mb = 0, mr = 0;
            if (MASKED) mask_params(1, tok0 + 64 * t, g ? tq1 : tq0, hi, mb, mr);
            exp_tile<MASKED>(p[g][0], p[g][1], lsum[g], pf, mb, mr, 1);
            pv_half(o[g][0], vfa, pf); pv_half(o[g][1], vfb, pf);
        }
    }
#undef D64_LANE
#undef D64_LD
#undef D64_ST
}
__device__ __forceinline__ void dense64_lag_loop(LAS char* lds, const bf16_t* Kg, const bf16_t* Vg, int ld, int ntiles,
                                                 const bf16x8 (&qr)[2][4], f32x16 (&o)[2][2], float (&lsum)[2], int lane_, int wave, const bool lag) {
    constexpr int V2_OFF = 2 * KTILE;
    u32x4 kreg, vreg;
#define D64_LANE() int ln_ = lane_; asm volatile("" : "+v"(ln_)); const int tid_ = wave * 64 + ln_, srow = tid_ >> 3, sch = tid_ & 7
#define D64_LD(t) do { D64_LANE(); const int tk_ = 64 * (t) + srow; kreg = *(const u32x4*)(Kg + (size_t)tk_ * ld + sch * 8); vreg = *(const u32x4*)(Vg + (size_t)tk_ * ld + sch * 8); } while (0)
#define D64_ST(t) do { D64_LANE(); *(LAS u32x4*)(lds + ((t) & 1) * KTILE + srow * KSTR + sch * 16) = kreg; *(LAS u32x4*)(lds + V2_OFF + ((t) % 3) * VTILE + srow * VSTR + sch * 16) = vreg; } while (0)
#define D64_QK(t) do { int lane = lane_; asm volatile("" : "+v"(lane)); const int klane = (lane & 31) * KSTR + 16 * (lane >> 5); bf16x8 kf[8]; LAS const char* kb_ = lds + ((t) & 1) * KTILE + klane; \
        _Pragma("unroll") for (int d0 = 0; d0 < 4; ++d0) _Pragma("unroll") for (int blk = 0; blk < 2; ++blk) kf[2 * d0 + blk] = *(const LAS bf16x8*)(kb_ + 32 * blk * KSTR + 32 * d0); \
        qk_tile(p[0][0], p[0][1], kf, qr[0]); qk_tile(p[1][0], p[1][1], kf, qr[1]); } while (0)
#define D64_PV(t) do { int lane = lane_; asm volatile("" : "+v"(lane)); const int hi = lane >> 5; const int vlane = (4 * hi + ((lane & 15) >> 2)) * VSTR + (16 * ((lane >> 4) & 1) + 4 * (lane & 3)) * 2; \
        bf16x8 vfa[4], vfb[4]; LAS const char* vb_ = lds + V2_OFF + ((t) % 3) * VTILE + vlane; vread(vfa, vb_, 0); vread(vfb, vb_, 1); \
        _Pragma("unroll") for (int g = 0; g < 2; ++g) { bf16x8 pf[2][2]; exp_tile<false>(p[g][0], p[g][1], lsum[g], pf, 0, 0, 0); pv_half(o[g][0], vfa, pf); pv_half(o[g][1], vfb, pf); } } while (0)
    f32x16 p[2][2];
    D64_LD(0); D64_ST(0);
    if (!lag) {
        D64_LD(1);
        for (int t = 0; t < ntiles; ++t) {
            __syncthreads();
            if (t + 1 < ntiles) D64_ST(t + 1);
            if (t + 2 < ntiles) D64_LD(t + 2);
            D64_QK(t);
            D64_PV(t);
        }
        __syncthreads();
    } else {
        D64_LD(1);
        __syncthreads();
        D64_ST(1); D64_LD(2);
        D64_QK(0);
        for (int t = 1; t < ntiles; ++t) {
            __syncthreads();
            if (t + 1 < ntiles) D64_ST(t + 1);
            if (t + 2 < ntiles) D64_LD(t + 2);
            D64_PV(t - 1);
            __builtin_amdgcn_sched_barrier(0);
            D64_QK(t);
        }
        __syncthreads();
        D64_PV(ntiles - 1);
    }
#undef D64_LANE
#undef D64_LD
#undef D64_ST
#undef D64_QK
#undef D64_PV
}
__device__ __forceinline__ void priv_kload(bf16x8 (&kf)[8], const bf16_t* Kg, int ld, int tk0, int dk, int lane_) {
    int lane = lane_; asm volatile("" : "+v"(lane));
    const int hi = lane >> 5;
#pragma unroll
    for (int blk = 0; blk < 2; ++blk) { const int tk = clamp_tok(tk0 + dk * (32 * blk + (lane & 31)));
#pragma unroll
        for (int d0 = 0; d0 < 4; ++d0) kf[2 * d0 + blk] = *(const bf16x8*)(Kg + (size_t)tk * ld + 16 * d0 + 8 * hi); }
}
__device__ __forceinline__ void priv2_step(bf16x8 (&kf)[8], LAS char* vpriv, const bf16_t* Kg, const bf16_t* Vg, int ld, int tk0, int dk, bool g0, bool g1,
                                           bool has_next, int tk0n, int dkn, const bf16x8 (&qr)[2][4], f32x16 (&o)[2][2], float (&lsum)[2], int tq0, int tq1, int lane_) {
    int lane = lane_; asm volatile("" : "+v"(lane));
    const int hi = lane >> 5;
    const int vlane = (4 * hi + ((lane & 15) >> 2)) * VSTR + (16 * ((lane >> 4) & 1) + 4 * (lane & 3)) * 2;
    u32x4 vr[8];
#pragma unroll
    for (int i = 0; i < 8; ++i) { const int idx = i * 64 + lane, row = idx >> 3, ch = idx & 7; const int tk = clamp_tok(tk0 + dk * row); vr[i] = *(const u32x4*)(Vg + (size_t)tk * ld + ch * 8); }
    const int gfirst = g0 ? 0 : 1, glast = g1 ? 1 : 0;
    f32x16 p0, p1; bf16x8 pf[2][2]; int mb, mr;
    if (gfirst == 0) qk_tile(p0, p1, kf, qr[0]); else qk_tile(p0, p1, kf, qr[1]);
    __builtin_amdgcn_sched_barrier(0);
#pragma unroll
    for (int i = 0; i < 8; ++i) { const int idx = i * 64 + lane; *(LAS u32x4*)(vpriv + (idx >> 3) * VSTR + (idx & 7) * 16) = vr[i]; }
    if (glast == gfirst) { __builtin_amdgcn_sched_barrier(0); if (has_next) priv_kload(kf, Kg, ld, tk0n, dkn, lane); __builtin_amdgcn_sched_barrier(0); }
    mask_params(dk, tk0, gfirst ? tq1 : tq0, hi, mb, mr);
    if (gfirst == 0) exp_tile<true>(p0, p1, lsum[0], pf, mb, mr, dk); else exp_tile<true>(p0, p1, lsum[1], pf, mb, mr, dk);
    { bf16x8 vfa[4], vfb[4]; vread(vfa, vpriv + vlane, 0); vread(vfb, vpriv + vlane, 1);
      if (gfirst == 0) { pv_half(o[0][0], vfa, pf); pv_half(o[0][1], vfb, pf); } else { pv_half(o[1][0], vfa, pf); pv_half(o[1][1], vfb, pf); } }
    if (glast != gfirst) {
        qk_tile(p0, p1, kf, qr[1]);
        __builtin_amdgcn_sched_barrier(0);
        if (has_next) priv_kload(kf, Kg, ld, tk0n, dkn, lane);
        __builtin_amdgcn_sched_barrier(0);
        mask_params(dk, tk0, tq1, hi, mb, mr);
        exp_tile<true>(p0, p1, lsum[1], pf, mb, mr, dk);
        bf16x8 vfa[4], vfb[4]; vread(vfa, vpriv + vlane, 0); vread(vfb, vpriv + vlane, 1);
        pv_half(o[1][0], vfa, pf); pv_half(o[1][1], vfb, pf);
    }
}
__device__ __forceinline__ void store_out(const f32x16 (&o)[2], float lsum, bf16_t* dst  , int lane_) {
    int lane = lane_; asm volatile("" : "+v"(lane));
    const int hi = lane >> 5;
    float l = lsum + shx(lsum, 32, lane);
    const float inv = 1.0f / l;
#pragma unroll
    for (int d0 = 0; d0 < 2; ++d0)
#pragma unroll
        for (int g4 = 0; g4 < 4; ++g4) {
            u32x2 w; w.x = cvt_pk_bf16(o[d0][4 * g4] * inv, o[d0][4 * g4 + 1] * inv); w.y = cvt_pk_bf16(o[d0][4 * g4 + 2] * inv, o[d0][4 * g4 + 3] * inv);
            *(u32x2*)(dst + 32 * d0 + 8 * g4 + 4 * hi) = w;
        }
}
}

struct Args { const float* in[18]; float* out; unsigned char* ws; int ph_lo, ph_hi; };
constexpr int PH_PRO = 0, PH_L0 = 1, PH_PER_LAYER = 9, PH_FINAL = PH_L0 + 2 * PH_PER_LAYER, NPH = PH_FINAL + 1;
enum { P_NORM1 = 0, P_INPROJ, P_ATTN, P_PAB, P_OUT, P_NORM2, P_PLACE, P_GU, P_DOWN };

template <bool MAPPED>
__device__ __forceinline__ void transpose_item(const float* W, int N, int col0, bf16_t* dst, int dst_row0, int K, int k0, LAS float* scr, int lane, int dk0 = 0  ) {
    const int sc = MAPPED ? inproj_srccol(col0 + lane) : col0 + lane;
    const float* src = W + (size_t)k0 * N + sc;
#pragma unroll 16
    for (int i = 0; i < 64; ++i) scr[i * 65 + lane] = src[(size_t)i * N];
    asm volatile("s_waitcnt lgkmcnt(0)" ::: "memory");
    const int c = lane & 7, nn = lane >> 3;
#pragma unroll
    for (int j = 0; j < 8; ++j) { const int n = nn + 8 * j; const LAS float* s = scr + (8 * c) * 65 + n;
        u32x4 w; w.x = cvt_pk_bf16(s[0], s[65]); w.y = cvt_pk_bf16(s[2 * 65], s[3 * 65]); w.z = cvt_pk_bf16(s[4 * 65], s[5 * 65]); w.w = cvt_pk_bf16(s[6 * 65], s[7 * 65]);
        *(u32x4*)(dst + (size_t)(dst_row0 + n) * K + dk0 + k0 + 8 * c) = w; }
    asm volatile("s_waitcnt lgkmcnt(0)" ::: "memory");
}


template <bool XF32, bool COMBINE, bool NORM, bool ROUTER, bool OUTF32>
__device__ __forceinline__ void row_phase(LAS unsigned char* lds, int tid, int lane, int wave, int G, int bx, const float* xf, bf16_t* xb, float* outf, const float* gv,
                                          const float* modl, int sh_off, int sc_off, const float* modprev, bf16_t* Hh, const bf16_t* Ym, const int* Pos, float* Tw,
                                          const bf16_t* Wr, int* Te, int* Trk, int* Cnt) {
    constexpr int RB = COMBINE ? 2 : ROWB;
    LAS float* lgs = (LAS float*)lds;
    LAS int* lcnt = (LAS int*)(lds + 40960);
    asm volatile("" : "+v"(tid), "+v"(lane));
    for (int chunk = bx; chunk < 256; chunk += G) {
        const int b = chunk >> 3;
        if (ROUTER) { if (tid < 32) lcnt[tid] = 0; }
        f32x4 pre[4], shv[4], g2[4];
#pragma unroll
        for (int j = 0; j < 4; ++j) { const int col = 512 * (j >> 1) + 8 * lane + 4 * (j & 1);
            if (NORM) { const f32x4 gg = *(const f32x4*)(gv + col), sc = *(const f32x4*)(modl + (size_t)b * MODW + sc_off + col);
                pre[j] = gg * (1.0f + sc); shv[j] = *(const f32x4*)(modl + (size_t)b * MODW + sh_off + col); }
            if (COMBINE) g2[j] = *(const f32x4*)(modprev + (size_t)b * MODW + 5 * DM + col); }
        f32x4 rawf[XF32 ? RB : 1][4]; u32x4 rawb[XF32 ? 1 : RB][2]; int pp[COMBINE ? RB : 1][2]; float pw[COMBINE ? RB : 1][2];
#define ROW_LOAD(rb_) do { _Pragma("unroll") for (int i = 0; i < RB; ++i) { const size_t ro = (size_t)((rb_) + i) * DM; \
            if (XF32) { _Pragma("unroll") for (int j = 0; j < 4; ++j) rawf[XF32 ? i : 0][j] = *(const f32x4*)(xf + ro + 512 * (j >> 1) + 8 * lane + 4 * (j & 1)); } \
            else { _Pragma("unroll") for (int h = 0; h < 2; ++h) rawb[XF32 ? 0 : i][h] = *(const u32x4*)(xb + ro + 512 * h + 8 * lane); } \
            if (COMBINE) { pp[COMBINE ? i : 0][0] = Pos[2 * ((rb_) + i)]; pp[COMBINE ? i : 0][1] = Pos[2 * ((rb_) + i) + 1]; pw[COMBINE ? i : 0][0] = Tw[2 * ((rb_) + i)]; pw[COMBINE ? i : 0][1] = Tw[2 * ((rb_) + i) + 1]; } } } while (0)
        ROW_LOAD(chunk * 256 + wave * 32);
#pragma unroll 1
        for (int r0 = 0; r0 < 32; r0 += RB) {
            const int rowb = chunk * 256 + wave * 32 + r0;
            f32x4 v[RB][4]; int cp[COMBINE ? RB : 1][2]; float cw[COMBINE ? RB : 1][2];
#pragma unroll
            for (int i = 0; i < RB; ++i) {
                if (XF32) {
#pragma unroll
                    for (int j = 0; j < 4; ++j) v[i][j] = rawf[XF32 ? i : 0][j];
                } else {
#pragma unroll
                    for (int h = 0; h < 2; ++h) { const u32x4 w = rawb[XF32 ? 0 : i][h];
                        v[i][2 * h] = (f32x4){bf_lo(w.x), bf_hi(w.x), bf_lo(w.y), bf_hi(w.y)}; v[i][2 * h + 1] = (f32x4){bf_lo(w.z), bf_hi(w.z), bf_lo(w.w), bf_hi(w.w)}; }
                }
                if (COMBINE) { cp[i][0] = pp[i][0]; cp[i][1] = pp[i][1]; cw[i][0] = pw[i][0]; cw[i][1] = pw[i][1]; }
            }
            u32x4 ya[COMBINE ? RB : 1][2], yc[COMBINE ? RB : 1][2];
            if (COMBINE) {
#pragma unroll
                for (int i = 0; i < RB; ++i)
#pragma unroll
                    for (int h = 0; h < 2; ++h) { ya[i][h] = *(const u32x4*)(Ym + (size_t)cp[i][0] * DM + 512 * h + 8 * lane); yc[i][h] = *(const u32x4*)(Ym + (size_t)cp[i][1] * DM + 512 * h + 8 * lane); }
            }
            if (r0 + RB < 32) ROW_LOAD(rowb + RB);
            if (COMBINE) {
#pragma unroll
                for (int i = 0; i < RB; ++i) {
                    const int row = rowb + i; const float w0 = cw[i][0], w1 = cw[i][1];
#pragma unroll
                    for (int h = 0; h < 2; ++h) { const u32x4 a = ya[i][h], c = yc[i][h];
                        const f32x4 m0 = {w0 * bf_lo(a.x) + w1 * bf_lo(c.x), w0 * bf_hi(a.x) + w1 * bf_hi(c.x), w0 * bf_lo(a.y) + w1 * bf_lo(c.y), w0 * bf_hi(a.y) + w1 * bf_hi(c.y)};
                        const f32x4 m1 = {w0 * bf_lo(a.z) + w1 * bf_lo(c.z), w0 * bf_hi(a.z) + w1 * bf_hi(c.z), w0 * bf_lo(a.w) + w1 * bf_lo(c.w), w0 * bf_hi(a.w) + w1 * bf_hi(c.w)};
                        v[i][2 * h] = v[i][2 * h] + g2[2 * h] * m0; v[i][2 * h + 1] = v[i][2 * h + 1] + g2[2 * h + 1] * m1;
                        if (OUTF32) { *(f32x4*)(outf + (size_t)row * DM + 512 * h + 8 * lane) = v[i][2 * h]; *(f32x4*)(outf + (size_t)row * DM + 512 * h + 8 * lane + 4) = v[i][2 * h + 1]; }
                        else *(u32x4*)(xb + (size_t)row * DM + 512 * h + 8 * lane) = pg8::pack8(v[i][2 * h], v[i][2 * h + 1]); }
                }
            }
            if (NORM) {
                float ss[RB];
#pragma unroll
                for (int i = 0; i < RB; ++i) { ss[i] = 0.f;
#pragma unroll
                    for (int j = 0; j < 4; ++j) { const f32x4 q = v[i][j] * v[i][j]; ss[i] += (q[0] + q[1]) + (q[2] + q[3]); } }
#pragma unroll
                for (int o = 1; o < 64; o <<= 1)
#pragma unroll
                    for (int i = 0; i < RB; ++i) ss[i] += shx(ss[i], o, lane);
#pragma unroll
                for (int i = 0; i < RB; ++i) { const float rstd = __builtin_amdgcn_rsqf(ss[i] * (1.0f / DM) + 1e-6f);
#pragma unroll
                    for (int h = 0; h < 2; ++h) *(u32x4*)(Hh + (size_t)(rowb + i) * DM + 512 * h + 8 * lane) = pg8::pack8(v[i][2 * h] * rstd * pre[2 * h] + shv[2 * h], v[i][2 * h + 1] * rstd * pre[2 * h + 1] + shv[2 * h + 1]); }
            }
        }
#undef ROW_LOAD
        if (ROUTER) {
            __syncthreads();
            const int row0 = chunk * 256 + wave * 32;
            f32x4 ra[2][2];
#pragma unroll
            for (int mt = 0; mt < 2; ++mt)
#pragma unroll
                for (int et = 0; et < 2; ++et) ra[mt][et] = (f32x4){0.f, 0.f, 0.f, 0.f};
#pragma unroll 4
            for (int kk = 0; kk < 32; ++kk) {
                bf16x8 a[2], bb[2];
#pragma unroll
                for (int mt = 0; mt < 2; ++mt) a[mt] = *(const bf16x8*)(Hh + (size_t)(row0 + 16 * mt + (lane & 15)) * DM + 32 * kk + 8 * (lane >> 4));
#pragma unroll
                for (int et = 0; et < 2; ++et) bb[et] = *(const bf16x8*)(Wr + (size_t)(16 * et + (lane & 15)) * DM + 32 * kk + 8 * (lane >> 4));
#pragma unroll
                for (int mt = 0; mt < 2; ++mt)
#pragma unroll
                    for (int et = 0; et < 2; ++et) ra[mt][et] = __builtin_amdgcn_mfma_f32_16x16x32_bf16(a[mt], bb[et], ra[mt][et], 0, 0, 0);
            }
#pragma unroll
            for (int mt = 0; mt < 2; ++mt)
#pragma unroll
                for (int et = 0; et < 2; ++et)
#pragma unroll
                    for (int r = 0; r < 4; ++r) lgs[(wave * 32 + 16 * mt + 4 * (lane >> 4) + r) * 33 + 16 * et + (lane & 15)] = ra[mt][et][r];
            asm volatile("s_waitcnt lgkmcnt(0)" ::: "memory");
            if (lane < 32) {
                const int tl = wave * 32 + lane, tok = chunk * 256 + tl;
                float lg[32]; float M = -3.0e38f;
#pragma unroll
                for (int e = 0; e < 32; ++e) { lg[e] = lgs[tl * 33 + e]; M = fmaxf(M, lg[e]); }
                float bm1 = 0.f, bm2 = 0.f, bsc = -1.f; int bi1 = 0, bi2 = 0, bg = 0;
#pragma unroll
                for (int g = 0; g < 4; ++g) {
                    float m1 = -3.0e38f, m2 = -3.0e38f; int i1 = 0, i2 = 0;
#pragma unroll
                    for (int j = 0; j < 8; ++j) { const float vv = lg[8 * g + j];
                        if (vv > m1) { m2 = m1; i2 = i1; m1 = vv; i1 = j; } else if (vv > m2) { m2 = vv; i2 = j; } }
                    const float sc = expf(m1 - M) + expf(m2 - M);
                    if (sc > bsc) { bsc = sc; bg = g; bm1 = m1; bm2 = m2; bi1 = i1; bi2 = i2; }
                }
                const int e0 = 8 * bg + bi1, e1 = 8 * bg + bi2;
                const float w0 = 1.0f / (1.0f + expf(bm2 - bm1)), w1 = 1.0f - w0;
                const int r0 = __hip_atomic_fetch_add(&lcnt[e0], 1, __ATOMIC_RELAXED, __HIP_MEMORY_SCOPE_WORKGROUP);
                const int r1 = __hip_atomic_fetch_add(&lcnt[e1], 1, __ATOMIC_RELAXED, __HIP_MEMORY_SCOPE_WORKGROUP);
                Te[2 * tok] = e0; Te[2 * tok + 1] = e1; Trk[2 * tok] = r0; Trk[2 * tok + 1] = r1; Tw[2 * tok] = w0; Tw[2 * tok + 1] = w1;
            }
            __syncthreads();
            if (tid < 32) Cnt[chunk * 32 + tid] = lcnt[tid];
            __syncthreads();
        }
    }
}

#define x_in ((const float*)(const GAS float*)args.in[0])
#define c_in ((const float*)(const GAS float*)args.in[1])
#define w_ada ((const float*)(const GAS float*)args.in[2])
#define b_ada ((const float*)(const GAS float*)args.in[3])
#define g_mix ((const float*)(const GAS float*)args.in[4])
#define w_in ((const float*)(const GAS float*)args.in[5])
#define qn_a ((const float*)(const GAS float*)args.in[6])
#define kn_a ((const float*)(const GAS float*)args.in[7])
#define qn_b ((const float*)(const GAS float*)args.in[8])
#define kn_b ((const float*)(const GAS float*)args.in[9])
#define w_pa ((const float*)(const GAS float*)args.in[10])
#define w_pb ((const float*)(const GAS float*)args.in[11])
#define w_out ((const float*)(const GAS float*)args.in[12])
#define g_ffn ((const float*)(const GAS float*)args.in[13])
#define w_router ((const float*)(const GAS float*)args.in[14])
#define w_gate ((const float*)(const GAS float*)args.in[15])
#define w_up ((const float*)(const GAS float*)args.in[16])
#define w_down ((const float*)(const GAS float*)args.in[17])
#define MOD ((float*)(GAS float*)(ws + WS_MOD))
#define XB ((bf16_t*)(GAS bf16_t*)(ws + WS_XB))
#define TE ((int*)(GAS int*)(ws + WS_TE))
#define TRK ((int*)(GAS int*)(ws + WS_TRK))
#define TW ((float*)(GAS float*)(ws + WS_TW))
#define POS ((int*)(GAS int*)(ws + WS_POS))
#define CNT ((int*)(GAS int*)(ws + WS_CNT))
#define BLKE ((int*)(GAS int*)(ws + WS_BLKE))
#define BTOK ((int*)(GAS int*)(ws + WS_BTOK))
#define WR ((bf16_t*)(bf16_t*)(GAS bf16_t*)(ws + WS_WR))
#define H ((bf16_t*)(bf16_t*)(GAS bf16_t*)(ws + WS_H))
#define YAB ((bf16_t*)(GAS bf16_t*)(ws + WS_H))
#define YA ((bf16_t*)(bf16_t*)(GAS bf16_t*)(ws + WS_H))
#define YB ((bf16_t*)(bf16_t*)(GAS bf16_t*)(ws + WS_H + 64 * MiB))
#define QA ((bf16_t*)(bf16_t*)(GAS bf16_t*)(ws + WS_QKV))
#define KA ((bf16_t*)(bf16_t*)(GAS bf16_t*)(ws + WS_QKV + 64 * MiB))
#define VA ((bf16_t*)(bf16_t*)(GAS bf16_t*)(ws + WS_QKV + 128 * MiB))
#define QB ((bf16_t*)(bf16_t*)(GAS bf16_t*)(ws + WS_QKV + 192 * MiB))
#define KB ((bf16_t*)(bf16_t*)(GAS bf16_t*)(ws + WS_QKV + 256 * MiB))
#define VB ((bf16_t*)(bf16_t*)(GAS bf16_t*)(ws + WS_QKV + 272 * MiB))
#define MERGED ((bf16_t*)(bf16_t*)(GAS bf16_t*)(ws + WS_QKV))
#define YM ((bf16_t*)(bf16_t*)(GAS bf16_t*)(ws + WS_QKV))
#define SA ((bf16_t*)(bf16_t*)(GAS bf16_t*)(ws + WS_GATE))
#define SB ((bf16_t*)(bf16_t*)(GAS bf16_t*)(ws + WS_GATE + 128 * MiB))
#define ACT ((bf16_t*)(bf16_t*)(GAS bf16_t*)(ws + WS_GATE))
#define PHASE_ENTER() int lane; asm volatile("v_mbcnt_lo_u32_b32 %0, -1, 0\n\tv_mbcnt_hi_u32_b32 %0, -1, %0" : "=v"(lane)); const int tid = wave * 64 + lane; GAS unsigned char* ws = ws0; int bx = bx0, vcu = vcu0; asm volatile("" : "+s"(ws), "+s"(bx), "+s"(vcu))

__device__ __forceinline__ bool in_phase(int lo, int hi, int k) { asm volatile("" : "+s"(lo), "+s"(hi)); return lo <= k && k < hi; }
#define PGATE_A SA
#define PGATE_B SB
__global__ void __launch_bounds__(512, 2) fwd_kernel(Args args) {
    extern __shared__ __attribute__((aligned(16))) unsigned char lds_raw[];
    LAS unsigned char* lds = (LAS unsigned char*)lds_raw;
    volatile LAS unsigned* MISC = (volatile LAS unsigned*)(lds + MISC_OFF);
    const int tid0 = threadIdx.x, lane0 = tid0 & 63, wave = __builtin_amdgcn_readfirstlane(tid0 >> 6);
    const int G = gridDim.x, bx0 = blockIdx.x;
    const int vcu0 = (G % 8 == 0) ? (bx0 % 8) * (G / 8) + bx0 / 8 : bx0;
    GAS unsigned char* ws0 = (GAS unsigned char*)args.ws;
    float* out = (float*)(GAS float*)args.out;
    for (int u = tid0; u < 256; u += 512) ((LAS unsigned*)(lds + MISC_OFF))[u] = 0u;
    __syncthreads();
#if MK_ONE_LAUNCH
    XcdBarrier bar = xcd_barrier_post((unsigned*)((GAS unsigned*)(ws0 + WS_CTL) + CW_BAR), MISC + 8);
#define GRID_BAR() do { int l_; asm volatile("v_mbcnt_lo_u32_b32 %0, -1, 0\n\tv_mbcnt_hi_u32_b32 %0, -1, %0" : "=v"(l_)); xcd_barrier(bar, (wave == 0) && (l_ == 0)); } while (0)
#else
#define GRID_BAR() do {} while (0)
#endif
#ifndef PHMASK
#define PHMASK 0xFFFFFFFFu
#endif
#if MK_ONE_LAUNCH
#define IN(k) true
#else
#define IN(k) in_phase(args.ph_lo, args.ph_hi, (k))
#endif
#define EN(bit) ((PHMASK >> (bit)) & 1u)
#define SEAM(k) do { if (IN(k) && IN((k) + 1)) GRID_BAR(); } while (0)

    if (EN(0) && IN(PH_PRO)) {
        PHASE_ENTER();
#pragma unroll 1
        for (int rep = 0; rep < REP_PRO; ++rep) {
        LAS float* scr = (LAS float*)(lds + wave * 16640);
        const int gw = vcu * 8 + wave, NGW = G * 8;
        constexpr int I_IN = 68 * 16, I_PA = 16 * 8, I_OUT = 16 * 16, I_GU = 32 * 2 * 8 * 16, I_DN = 32 * 16 * 8;
        constexpr int I_LAYER = I_IN + 2 * I_PA + I_OUT + I_GU + I_DN;
        for (int it = gw; it < 2 * I_LAYER; it += NGW) {
            const int l = it / I_LAYER; int r = it % I_LAYER;
            if (r < I_IN) { const int nb = r / 16, kb = r % 16;
                transpose_item<true>(w_in + (size_t)l * DM * NC, NC, 64 * nb, (bf16_t*)(GAS bf16_t*)(ws + WS_WIN + l * WIN_BYTES), 64 * nb, DM, 64 * kb, scr, lane); continue; } r -= I_IN;
            if (r < I_PA) { const int nb = r / 8, kb = r % 8;
                transpose_item<false>(w_pa + (size_t)l * 512 * DM, DM, 64 * nb, (bf16_t*)(GAS bf16_t*)(ws + WS_WPA + l * 2 * MiB), 64 * nb, DM, 64 * kb, scr, lane, 0); continue; } r -= I_PA;
            if (r < I_PA) { const int nb = r / 8, kb = r % 8;
                transpose_item<false>(w_pb + (size_t)l * 512 * DM, DM, 64 * nb, (bf16_t*)(GAS bf16_t*)(ws + WS_WPA + l * 2 * MiB), 64 * nb, DM, 64 * kb, scr, lane, 512); continue; } r -= I_PA;
            if (r < I_OUT) { const int nb = r / 16, kb = r % 16;
                transpose_item<false>(w_out + (size_t)l * DM * DM, DM, 64 * nb, (bf16_t*)(GAS bf16_t*)(ws + WS_WOUT + l * 2 * MiB), 64 * nb, DM, 64 * kb, scr, lane); continue; } r -= I_OUT;
            if (r < I_GU) { const int e = r / 256, q = r % 256, up = q / 128, nb = (q % 128) / 16, kb = q % 16;
                const float* src = (up ? w_up : w_gate) + ((size_t)l * NEXP + e) * DM * DFF;
                const int c0 = 64 * nb, drow = 256 * (c0 >> 7) + 128 * up + (c0 & 127);
                transpose_item<false>(src, DFF, c0, (bf16_t*)(GAS bf16_t*)(ws + WS_WGU + ((size_t)l * NEXP + e) * 2 * MiB), drow, DM, 64 * kb, scr, lane); continue; } r -= I_GU;
            { const int e = r / 128, q = r % 128, nb = q / 8, kb = q % 8;
                transpose_item<false>(w_down + ((size_t)l * NEXP + e) * DFF * DM, DM, 64 * nb, (bf16_t*)(GAS bf16_t*)(ws + WS_WDN + ((size_t)l * NEXP + e) * MiB), 64 * nb, DFF, 64 * kb, scr, lane); }
        }
        for (int i = (vcu * 512 + tid); i < 32 * DM; i += G * 512) { const int e = i >> 10, k = i & 1023; WR[i] = (bf16_t)(cvt_pk_bf16(w_router[(size_t)k * NEXP + e], 0.f) & 0xffffu); }
        __syncthreads();
        if (vcu * 8 < 384) {
            LAS float* cond = (LAS float*)lds;
            for (int i = tid; i < NB * DM; i += 512) { const int b = i >> 10, k = i & 1023; const float cv = c_in[i]; cond[k * 32 + b] = cv / (1.0f + expf(-cv)); }
            __syncthreads();
            for (int it = gw; it < 384; it += NGW) {
                const int l = it / 192, n0 = (it % 192) * 32;
                const float* wp = w_ada + (size_t)l * DM * MODW + n0 + (lane & 31) + (size_t)(lane >> 5) * MODW;
                const LAS float* cp = cond + (lane >> 5) * 32 + (lane & 31);
                f32x16 acc;
#pragma unroll
                for (int r = 0; r < 16; ++r) acc[r] = 0.f;
#pragma unroll 16
                for (int k0 = 0; k0 < DM; k0 += 2) acc = __builtin_amdgcn_mfma_f32_32x32x2f32(cp[k0 * 32], wp[(size_t)k0 * MODW], acc, 0, 0, 0);
                const float bias = b_ada[l * MODW + n0 + (lane & 31)];
#pragma unroll
                for (int r = 0; r < 16; ++r) { const int b = (r & 3) + 8 * (r >> 2) + 4 * (lane >> 5); MOD[((size_t)l * NB + b) * MODW + n0 + (lane & 31)] = acc[r] + bias; }
            }
        }
        __syncthreads();
        }
    }
    SEAM(PH_PRO);

    for (int l = 0; l < 2; ++l) {
        const int pb = PH_L0 + l * PH_PER_LAYER;
        if (EN(1) && IN(pb + P_NORM1)) { PHASE_ENTER(); const float* modl = MOD + (size_t)l * NB * MODW;
            if (l == 0) {
#pragma unroll 1
                for (int rep = 0; rep < REP_NORM1; ++rep)
                    row_phase<true, false, true, false, false>(lds, tid, lane, wave, G, bx, x_in, XB, out, g_mix, modl, 0, DM, MOD, H, YM, POS, TW, WR, TE, TRK, CNT);
            } else row_phase<false, true, true, false, false>(lds, tid, lane, wave, G, bx, x_in, XB, out, g_mix + DM, modl, 0, DM, MOD, H, YM, POS, TW, WR, TE, TRK, CNT); }
            {
                SEAM(pb + P_NORM1);
                if (EN(2) && IN(pb + P_INPROJ)) {
                    PHASE_ENTER();
                    pg8::Gemm g{H, (const bf16_t*)(const GAS bf16_t*)(ws + WS_WIN + l * WIN_BYTES), DM}; pg8::StaticOrder S; S.init(TT, NC, G, bx); S.wgm = INPROJ_WGM;
                    LAS float* normw = (LAS float*)(lds + MISC_OFF + 1024);
                    if (tid < 256) { const int sel = tid >> 6, d = tid & 63; const float* srcw = (sel == 0) ? qn_a : (sel == 1) ? kn_a : (sel == 2) ? qn_b : kn_b; normw[tid] = srcw[l * 64 + d]; }
                    __syncthreads();
                    pg8::EpiInProj E{QA, KA, VA, QB, KB, VB, SA, SB, normw};
#pragma unroll 1
                    for (int rep = 0; rep < REP_INPROJ; ++rep)
                    pg8::gemm_phase<pg8::EpiInProj, pg8::StaticOrder>(lds, g, S, E, wave);
                }
                SEAM(pb + P_INPROJ);
                if (EN(3) && IN(pb + P_ATTN)) {
                    PHASE_ENTER(); (void)lane;
                    LAS char* ring = (LAS char*)lds;
#pragma unroll 1
                    for (int rep = 0; rep < REP_ATTB; ++rep)
                    for (int L = vcu; L < NB * 32; L += G) {
                        int lane; asm volatile("v_mbcnt_lo_u32_b32 %0, -1, 0\n\tv_mbcnt_hi_u32_b32 %0, -1, %0" : "=v"(lane)); const int hi = lane >> 5;
                        const int b = L >> 5, kvh = (L >> 4) & 1, qh = 4 * kvh + ((L >> 2) & 3), qb2 = L & 3;
                        const int tq0 = 512 * qb2 + 64 * wave + (lane & 31);
                        bf16x8 qr[2][4];
#pragma unroll
                        for (int g = 0; g < 2; ++g)
#pragma unroll
                            for (int d0 = 0; d0 < 4; ++d0) qr[g][d0] = *(const bf16x8*)(QB + ((size_t)b * SEQ + tq0 + 32 * g) * 512 + qh * 64 + 16 * d0 + 8 * hi);
                        f32x16 o[2][2]; float lsum[2] = {0.f, 0.f};
#pragma unroll
                        for (int r = 0; r < 16; ++r) { o[0][0][r] = 0.f; o[0][1][r] = 0.f; o[1][0][r] = 0.f; o[1][1][r] = 0.f; }
                        __syncthreads();
                        att::dense64_lag_loop(ring, KB + (size_t)b * SEQ * 128 + kvh * 64, VB + (size_t)b * SEQ * 128 + kvh * 64, 128, 32, qr, o, lsum, lane, wave, wave >= 4);
                        { int l2; asm volatile("v_mbcnt_lo_u32_b32 %0, -1, 0\n\tv_mbcnt_hi_u32_b32 %0, -1, %0" : "=v"(l2)); const int tqs = 512 * qb2 + 64 * wave + (l2 & 31);
#pragma unroll
                          for (int g = 0; g < 2; ++g) att::store_out(o[g], lsum[g], YAB + ((size_t)b * SEQ + tqs + 32 * g) * DM + 512 + qh * 64, l2); }
                    }
#pragma unroll 1
                    for (int rep = 0; rep < REP_ATTA; ++rep)
                    for (int L = vcu; L < NB * 32; L += G) {
                        int lane; asm volatile("v_mbcnt_lo_u32_b32 %0, -1, 0\n\tv_mbcnt_hi_u32_b32 %0, -1, %0" : "=v"(lane)); const int hi = lane >> 5;
                        const int b = L >> 5, h = (L >> 2) & 7, tb2 = L & 3, base = 512 * tb2;
                        const int tq0 = base + 16 * (lane & 31) + wave, tq1 = tq0 + 8;
                        const bf16_t* Kg = KA + (size_t)b * SEQ * 512 + h * 64; const bf16_t* Vg = VA + (size_t)b * SEQ * 512 + h * 64;
                        bf16x8 qr[2][4];
#pragma unroll
                        for (int g = 0; g < 2; ++g)
#pragma unroll
                            for (int d0 = 0; d0 < 4; ++d0) qr[g][d0] = *(const bf16x8*)(QA + ((size_t)b * SEQ + tq0 + 8 * g) * 512 + h * 64 + 16 * d0 + 8 * hi);
                        f32x16 o[2][2]; float lsum[2] = {0.f, 0.f};
#pragma unroll
                        for (int r = 0; r < 16; ++r) { o[0][0][r] = 0.f; o[0][1][r] = 0.f; o[1][0][r] = 0.f; o[1][1][r] = 0.f; }
                        __syncthreads();
                        att::dense64_loop<true>(ring, Kg, Vg, 512, base - 64, 10, qr, o, lsum, tq0, tq1, lane, wave);
                        __syncthreads();
                        {
                            LAS char* vpriv = ring + att::PRIV_OFF + wave * att::VTILE;
#define A_TK0(j) ((j) < 4 ? base + wave - 256 + 256 * (j) : wave + 8 * (((j) - 4) >> 1) + 1024 * (((j) - 4) & 1))
#define A_DK(j) ((j) < 4 ? 4 : 16)
                            bf16x8 kf[8];
                            att::priv_kload(kf, Kg, 512, A_TK0(0), 4, lane);
#pragma unroll 1
                            for (int j = 0; j < 8; ++j) {
                                const bool p2 = j < 4; const int g = (j - 4) >> 1;
                                att::priv2_step(kf, vpriv, Kg, Vg, 512, A_TK0(j), A_DK(j), p2 || g == 0, p2 || g == 1, j + 1 < 8, A_TK0(j + 1), A_DK(j + 1), qr, o, lsum, tq0, tq1, lane);
                            }
#undef A_TK0
#undef A_DK
                        }
                        { int l2; asm volatile("v_mbcnt_lo_u32_b32 %0, -1, 0\n\tv_mbcnt_hi_u32_b32 %0, -1, %0" : "=v"(l2)); const int tqs = base + 16 * (l2 & 31) + wave;
#pragma unroll
                          for (int g = 0; g < 2; ++g) att::store_out(o[g], lsum[g], YAB + ((size_t)b * SEQ + tqs + 8 * g) * DM + h * 64, l2); }
                    }
                    __syncthreads();
                }
                SEAM(pb + P_ATTN);
                if (EN(4) && IN(pb + P_PAB)) {
                    PHASE_ENTER();
                    pg8::StaticOrder S; S.init(TT, DM, G, bx); S.wgm = N1K_WGM;
                    pg8::Gemm g{YAB, (const bf16_t*)(const GAS bf16_t*)(ws + WS_WPA + l * 2 * MiB), DM}; pg8::EpiMergeFused E{MERGED, PGATE_A, PGATE_B};
#pragma unroll 1
                    for (int rep = 0; rep < REP_PAB; ++rep)
                    pg8::gemm_phase<pg8::EpiMergeFused, pg8::StaticOrder>(lds, g, S, E, wave);
                }
                SEAM(pb + P_PAB);
                if (EN(5) && IN(pb + P_OUT)) {
                    PHASE_ENTER(); const float* modl = MOD + (size_t)l * NB * MODW;
                    pg8::Gemm g{MERGED, (const bf16_t*)(const GAS bf16_t*)(ws + WS_WOUT + l * 2 * MiB), DM}; pg8::StaticOrder S; S.init(TT, DM, G, bx); S.rowmajor = OUT_ROWMAJOR; S.wgm = N1K_WGM;
                    pg8::EpiResidB E{(l == 0) ? x_in : (const float*)nullptr, XB, XB, modl + 2 * DM};
#pragma unroll 1
                    for (int rep = 0; rep < ((l == 0) ? REP_OUT : 1); ++rep)
                    pg8::gemm_phase<pg8::EpiResidB, pg8::StaticOrder>(lds, g, S, E, wave);
                }
                SEAM(pb + P_OUT);
            }
        if (EN(6) && IN(pb + P_NORM2)) { PHASE_ENTER(); const float* modl = MOD + (size_t)l * NB * MODW;
#pragma unroll 1
            for (int rep = 0; rep < REP_NORM2; ++rep)
            row_phase<false, false, true, true, false>(lds, tid, lane, wave, G, bx, x_in, XB, out, g_ffn + l * DM, modl, 3 * DM, 4 * DM, MOD, H, YM, POS, TW, WR, TE, TRK, CNT); }
        SEAM(pb + P_NORM2);
        if (EN(7) && IN(pb + P_PLACE)) {
            PHASE_ENTER();
            LAS int* part_tot = (LAS int*)lds;
            LAS int* part_pre = part_tot + 512;
            LAS int* basee = part_pre + 512;
            LAS int* pstart = basee + 32;
            LAS int* pend = pstart + 32;
            LAS int* tote = pend + 32;
            for (int chunk = bx; chunk < 256; chunk += G) {
                { const int e = tid & 31, part = tid >> 5; int st = 0, sp = 0;
                    for (int q = 0; q < 16; ++q) { const int ch = part * 16 + q; const int v = CNT[ch * 32 + e]; st += v; sp += (ch < chunk) ? v : 0; }
                    part_tot[part * 32 + e] = st; part_pre[part * 32 + e] = sp; }
                __syncthreads();
                if (tid < 32) { int st = 0, sp = 0; for (int q = 0; q < 16; ++q) { st += part_tot[q * 32 + tid]; sp += part_pre[q * 32 + tid]; } tote[tid] = st; basee[tid] = sp; }
                __syncthreads();
                if (tid == 0) { int run = 0; for (int e = 0; e < 32; ++e) { const int padded = (tote[e] + 255) & ~255; pstart[e] = run; basee[e] += run; run += padded; pend[e] = run; } }
                __syncthreads();
                { const int tok = chunk * 256 + (tid >> 1), slot = tid & 1; const int e = TE[2 * tok + slot], rk = TRK[2 * tok + slot]; const int dest = basee[e] + rk;
                    BTOK[dest] = tok; POS[2 * tok + slot] = dest; }
                if (chunk < 32) { const int e = chunk; const int from = pstart[e] + tote[e], n = pend[e] - from; if (tid < n) BTOK[from + tid] = 0; }
                if (chunk == 0) {
                    for (int blk = tid; blk < NBLK; blk += 512) { int e = 0; for (int q = 0; q < 32; ++q) e += (pend[q] <= blk * 256) ? 1 : 0; BLKE[blk] = e > 31 ? 31 : e; }
                    if (tid == 0) BLKE[1000] = pend[31] >> 8;
                }
                __syncthreads();
            }
        }
        SEAM(pb + P_PLACE);
        if (EN(8) && IN(pb + P_GU)) {
            PHASE_ENTER();
            const int nused = BLKE[1000];
            pg8::Gemm g{H, (const bf16_t*)(const GAS bf16_t*)(ws + WS_WGU + (size_t)l * NEXP * 2 * MiB), DM};
            pg8::MoeOrder S{BLKE, BTOK, 4 * nused, G, vcu};
            pg8::EpiSwiGLU E{ACT};
#pragma unroll 1
            for (int rep = 0; rep < REP_GU; ++rep)
            pg8::gemm_phase<pg8::EpiSwiGLU, pg8::MoeOrder>(lds, g, S, E, wave);
        }
        SEAM(pb + P_GU);
        if (EN(9) && IN(pb + P_DOWN)) {
            PHASE_ENTER();
            const int nused = BLKE[1000];
            pg8::Gemm g{ACT, (const bf16_t*)(const GAS bf16_t*)(ws + WS_WDN + (size_t)l * NEXP * MiB), DFF};
            pg8::MoeOrder S{BLKE, nullptr, 4 * nused, G, vcu};
            pg8::EpiY E{YM};
#pragma unroll 1
            for (int rep = 0; rep < REP_DOWN; ++rep)
            pg8::gemm_phase<pg8::EpiY, pg8::MoeOrder>(lds, g, S, E, wave);
        }
        SEAM(pb + P_DOWN);
    }
    if (EN(10) && IN(PH_FINAL)) {
        PHASE_ENTER();
        row_phase<false, true, false, false, true>(lds, tid, lane, wave, G, bx, x_in, XB, out, g_ffn, MOD, 0, 0, MOD + (size_t)NB * MODW, H, YM, POS, TW, WR, TE, TRK, CNT);
    }
#undef IN
#undef SEAM
#undef GRID_BAR
}

extern "C" void kernel_launch(void* const* d_in, const int* in_sizes, int n_in, void* d_out, int out_size, void* d_ws, size_t ws_size, hipStream_t stream) {
    static int grid = 0;
    if (grid == 0) {
        if (n_in != 18 || in_sizes[0] != TT * DM || out_size != TT * DM || ws_size < WS_END) { fprintf(stderr, "kernel_launch: unexpected shapes / workspace (n_in %d, ws %zu); nothing launched\n", n_in, ws_size); grid = -1; return; }
        int dev = 0, cus = 0, per_cu = 0;
        if (hipGetDevice(&dev) != hipSuccess || hipDeviceGetAttribute(&cus, hipDeviceAttributeMultiprocessorCount, dev) != hipSuccess) { grid = -1; return; }
        if (hipFuncSetAttribute((const void*)fwd_kernel, hipFuncAttributeMaxDynamicSharedMemorySize, LDS_BYTES) != hipSuccess) { fprintf(stderr, "kernel_launch: hipFuncSetAttribute failed\n"); grid = -1; return; }
        if (hipOccupancyMaxActiveBlocksPerMultiprocessor(&per_cu, (const void*)fwd_kernel, 512, LDS_BYTES) != hipSuccess || per_cu < 1) { fprintf(stderr, "kernel_launch: occupancy query says %d\n", per_cu); per_cu = 1; }
        (void)hipGetLastError();
        grid = cus;
    }
    if (grid < 0) return;
    (void)hipMemsetAsync((char*)d_ws + WS_CTL, 0, CTL_ZERO_BYTES, stream);
    Args a{};
    for (int i = 0; i < 18; ++i) a.in[i] = (const float*)d_in[i];
    a.out = (float*)d_out; a.ws = (unsigned char*)d_ws;
#if MK_ONE_LAUNCH
    a.ph_lo = 0; a.ph_hi = NPH;
    hipLaunchKernelGGL(fwd_kernel, dim3(grid), dim3(512), LDS_BYTES, stream, a);
#else
    for (int p = 0; p < NPH; ++p) { a.ph_lo = p; a.ph_hi = p + 1; hipLaunchKernelGGL(fwd_kernel, dim3(grid), dim3(512), LDS_BYTES, stream, a); }
#endif
}
```

```cpp
#include <hip/hip_runtime.h>
#include <cstdio>
#include <cstdint>

#ifndef INPROJ_WGM
#define INPROJ_WGM 4
#endif
#ifndef GEMM_ALIGN
#define GEMM_ALIGN 1
#endif
#ifndef ROWB
#define ROWB 4
#endif
#ifndef N1K_WGM
#define N1K_WGM 8
#endif
#ifndef OUT_ROWMAJOR
#define OUT_ROWMAJOR 0
#endif
#ifndef REP_PRO
#define REP_PRO 1
#endif
#ifndef REP_ATTB
#define REP_ATTB 1
#endif
#ifndef REP_ATTA
#define REP_ATTA 1
#endif
#ifndef REP_INPROJ
#define REP_INPROJ 1
#endif
#ifndef REP_NORM1
#define REP_NORM1 1
#endif
#ifndef REP_GU
#define REP_GU 1
#endif
#ifndef REP_PAB
#define REP_PAB 1
#endif
#ifndef REP_OUT
#define REP_OUT 1
#endif
#ifndef REP_DOWN
#define REP_DOWN 1
#endif
#ifndef REP_NORM2
#define REP_NORM2 1
#endif
#ifndef MK_ONE_LAUNCH
#define MK_ONE_LAUNCH 1
#endif

#define LAS __attribute__((address_space(3)))
#define GAS __attribute__((address_space(1)))
typedef unsigned short bf16_t;
typedef short bf16x8 __attribute__((ext_vector_type(8)));
typedef short s16x4 __attribute__((ext_vector_type(4)));
typedef float f32x4 __attribute__((ext_vector_type(4)));
typedef float f32x16 __attribute__((ext_vector_type(16)));
typedef unsigned u32x4 __attribute__((ext_vector_type(4)));
typedef unsigned u32x2 __attribute__((ext_vector_type(2)));

constexpr int NB = 32, SEQ = 2048, DM = 1024, TT = NB * SEQ;
constexpr int NC = 4352;
constexpr int NEXP = 32, DFF = 512, NPAD = 139264, NBLK = 544;
constexpr int MODW = 6 * DM;
constexpr float QSCALE = 0.125f * 1.4426950408889634f;

constexpr size_t MiB = 1u << 20;
constexpr size_t WS_CTL = 0, CTL_ZERO_BYTES = 64 * 1024;
constexpr size_t WS_MOD = 1 * MiB;
constexpr size_t WS_TE = 2 * MiB + 512 * 1024, WS_TRK = 3 * MiB, WS_TW = 3 * MiB + 512 * 1024, WS_POS = 4 * MiB;
constexpr size_t WS_CNT = 4 * MiB + 512 * 1024;
constexpr size_t WS_BLKE = WS_CNT + 64 * 1024;
constexpr size_t WS_BTOK = WS_CNT + 128 * 1024;
constexpr size_t WS_WR = 5 * MiB + 256 * 1024;
constexpr size_t WS_WIN = 6 * MiB;
constexpr size_t WIN_BYTES = (size_t)NC * DM * 2;
constexpr size_t WS_WPA = 23 * MiB, WS_WPB = 25 * MiB, WS_WOUT = 27 * MiB;
constexpr size_t WS_WGU = 31 * MiB;
constexpr size_t WS_WDN = 159 * MiB;
constexpr size_t WS_H = 223 * MiB;
constexpr size_t WS_QKV = 351 * MiB;
constexpr size_t WS_GATE = 639 * MiB;
constexpr size_t WS_XB = 896 * MiB;
constexpr size_t WS_END = 1024 * MiB;
constexpr int CW_BAR = 4096;

constexpr int RING_BYTES = 133120;
constexpr int MISC_OFF = RING_BYTES;
constexpr int LDS_BYTES = 147456;

#define RLX_AGENT __ATOMIC_RELAXED, __HIP_MEMORY_SCOPE_AGENT
typedef float f32x2_t __attribute__((ext_vector_type(2))); typedef __bf16 bf16x2_t __attribute__((ext_vector_type(2)));
__device__ __forceinline__ unsigned cvt_pk_bf16(float lo, float hi) { const f32x2_t v = {lo, hi}; const bf16x2_t b = __builtin_convertvector(v, bf16x2_t); return __builtin_bit_cast(unsigned, b); }
typedef float f32x2v __attribute__((ext_vector_type(2)));
__device__ __forceinline__ unsigned pack4_fp8(float a, float b, float c, float d) { unsigned w = 0; w = __builtin_amdgcn_cvt_pk_fp8_f32(a, b, w, false); w = __builtin_amdgcn_cvt_pk_fp8_f32(c, d, w, true); return w; }
__device__ __forceinline__ void unpack8_fp8(u32x2 w, float (&o)[8]) { const f32x2v a = __builtin_amdgcn_cvt_pk_f32_fp8(w.x, false), b = __builtin_amdgcn_cvt_pk_f32_fp8(w.x, true), c = __builtin_amdgcn_cvt_pk_f32_fp8(w.y, false), d = __builtin_amdgcn_cvt_pk_f32_fp8(w.y, true);
    o[0] = a.x; o[1] = a.y; o[2] = b.x; o[3] = b.y; o[4] = c.x; o[5] = c.y; o[6] = d.x; o[7] = d.y; }
__device__ __forceinline__ float bf_lo(unsigned w) { return __uint_as_float(w << 16); }
__device__ __forceinline__ float bf_hi(unsigned w) { return __uint_as_float(w & 0xffff0000u); }
__device__ __forceinline__ float shx(float v, int mask, int lane) { return __int_as_float(__builtin_amdgcn_ds_bpermute((lane ^ mask) << 2, __float_as_int(v))); }
__device__ __forceinline__ float wave_sum(float v, int lane) {
#pragma unroll
    for (int o = 1; o < 64; o <<= 1) v += shx(v, o, lane);
    return v;
}
__device__ __forceinline__ float wave_max(float v, int lane) {
#pragma unroll
    for (int o = 1; o < 64; o <<= 1) v = fmaxf(v, shx(v, o, lane));
    return v;
}
__device__ __forceinline__ float sigmoid_f(float x) { return __builtin_amdgcn_rcpf(1.0f + __builtin_amdgcn_exp2f(-1.4426950408889634f * x)); }

#define XB_TMO      128
#define XB_XCNT(j)  (256  + 64 * (j))
#define XB_XSUB(j)  (1280 + 64 * (j))
#define XB_XGEN(j)  (2304 + 64 * (j))
#define XB_TOP      3328
#define XB_TOPGEN   3392
#define XCD_BAR_WORDS 3456
#define XB_SPIN_CAP (1u << 18)

__device__ __forceinline__ unsigned xb_ld(unsigned* p)              { return __hip_atomic_load(p, __ATOMIC_RELAXED, __HIP_MEMORY_SCOPE_AGENT); }
__device__ __forceinline__ unsigned xb_add(unsigned* p, unsigned v) { return __hip_atomic_fetch_add(p, v, __ATOMIC_RELAXED, __HIP_MEMORY_SCOPE_AGENT); }
__device__ __forceinline__ unsigned xb_xcc_id() { return (unsigned)__builtin_amdgcn_s_getreg((3 << 11) | 20) & 0xFu; }
#define XB_SPIN(cond, bar) do { unsigned _sp = 0; while (cond) { __builtin_amdgcn_s_sleep(1); \
    if ((++_sp & 255u) == 0u) { if (xb_ld(&(bar)[XB_TMO])) break; if (_sp > XB_SPIN_CAP) { atomicAdd(&(bar)[XB_TMO], 1u); break; } } } } while (0)

struct XcdBarrier { unsigned* bar; unsigned x; volatile LAS unsigned* st; };

__device__ __forceinline__ XcdBarrier xcd_barrier_post(unsigned* bar, volatile LAS unsigned* st) {
    XcdBarrier b; b.bar = bar; b.x = xb_xcc_id(); b.st = st;
    if (threadIdx.x == 0) (void)xb_add(&bar[XB_XCNT(b.x)], 1u);
    return b;
}
__device__ __forceinline__ void xcd_barrier_complete(unsigned* bar, unsigned x, unsigned& nloc, unsigned& nx) {
    const unsigned G = gridDim.x * gridDim.y * gridDim.z;
    unsigned sum, cnt, mine, sp = 0u;
    for (;;) {
        sum = 0u; cnt = 0u; mine = 0u;
#pragma unroll
        for (unsigned j = 0; j < 16; ++j) { const unsigned c = xb_ld(&bar[XB_XCNT(j)]); sum += c; cnt += (c > 0u) ? 1u : 0u; mine = (j == x) ? c : mine; }
        if (sum == G) break;
        __builtin_amdgcn_s_sleep(1);
        if ((++sp & 255u) == 0u) { if (xb_ld(&bar[XB_TMO])) break; if (sp > XB_SPIN_CAP) { atomicAdd(&bar[XB_TMO], 1u); break; } }
    }
    nloc = mine > 0u ? mine : 1u; nx = cnt > 0u ? cnt : 1u;
}
__device__ __forceinline__ void xcd_barrier(const XcdBarrier& b, const bool is_t0  ) {
    asm volatile("s_waitcnt vmcnt(0)" ::: "memory");
    __syncthreads();
    if (is_t0) {
        unsigned* bar = b.bar; unsigned bx_ = b.x;
        asm volatile("" : "+s"(bar), "+s"(bx_));
        __builtin_amdgcn_s_waitcnt(0);
        unsigned nloc = b.st[0], nx = b.st[1];
        if (nloc == 0u) { xcd_barrier_complete(bar, bx_, nloc, nx); b.st[0] = nloc; b.st[1] = nx; }
        const unsigned old = xb_add(&bar[XB_XSUB(bx_)], 1u);
        const unsigned gen = old / nloc;
        if (old + 1u == (gen + 1u) * nloc) {
            __builtin_amdgcn_fence(__ATOMIC_RELEASE, "agent");
            asm volatile("s_waitcnt vmcnt(0)" ::: "memory");
            const unsigned og = xb_add(&bar[XB_TOP], 1u);
            const unsigned tg = og / nx;
            if (og + 1u == (tg + 1u) * nx) xb_add(&bar[XB_TOPGEN], 1u);
            else XB_SPIN(xb_ld(&bar[XB_TOPGEN]) == tg, bar);
            __builtin_amdgcn_fence(__ATOMIC_ACQUIRE, "agent");
            xb_add(&bar[XB_XGEN(bx_)], 1u);
            asm volatile("s_waitcnt vmcnt(0)" ::: "memory");
        } else {
            XB_SPIN(xb_ld(&bar[XB_XGEN(bx_)]) == gen, bar);
            __builtin_amdgcn_fence(__ATOMIC_ACQUIRE, "agent");
            asm volatile("s_waitcnt vmcnt(0)" ::: "memory");
        }
    }
    __syncthreads();
}

namespace pg8 {
constexpr int BM = 256, BK = 64, HALF = 128, HTB = HALF * BK * 2, STAGE_BYTES = 8 * HTB, NXCD = 8, WGM = 8;
__host__ __device__ __forceinline__ int lds_byte(int r, int c) { const int st = (r >> 4) * 2 + (c >> 5), rr = r & 15, cc = c & 31, ob = rr * 64 + cc * 2; return st * 1024 + (ob ^ (((ob >> 9) & 1) << 5)); }
__host__ __device__ __forceinline__ void stage_rc(int b, int& R, int& C) { const int st = b / 1024, sb = b % 1024, swz = sb ^ (((sb >> 9) & 1) << 5); R = (st >> 1) * 16 + swz / 64; C = (st & 1) * 32 + (swz % 64) / 2; }
__host__ __device__ __forceinline__ int perm32(int rho) { const int n = rho >> 4, i = rho & 15; return 8 * (i >> 2) + 4 * n + (i & 3); }

struct Unit { int pm, pn; };
struct Gemm { const bf16_t* A; const bf16_t* Bt; int K; };

struct StaticOrder {
    static constexpr bool GATHER = false;
    int nM, nN, nwg, G, c, wgm = WGM;
    __device__ void init(int M, int N, int G_, int c_) { asm volatile("" : "+s"(c_));     nM = M / BM; nN = N / BM; nwg = nM * nN; G = G_; c = c_; }
    int rowmajor = 0;
    __device__ __forceinline__ bool next(int i, Unit& u) const {
        if (rowmajor) { const int upw = (nwg + G - 1) / G, k = c * upw + i; if (i >= upw || k >= nwg) return false; u.pm = k / nN; u.pn = k % nN; return true; }
        const long L = (long)i * G + c; if (L >= nwg) return false;
        int wgid = (int)L; { const int q = nwg / NXCD, r = nwg % NXCD, xcd = wgid % NXCD, off = wgid / NXCD; wgid = (xcd < r ? xcd * (q + 1) : r * (q + 1) + (xcd - r) * q) + off; }
        const int nig = wgm * nN, gid = wgid / nig, fm = gid * wgm, gsz = (nM - fm) < wgm ? (nM - fm) : wgm;
        u.pm = fm + ((wgid % nig) % gsz); u.pn = (wgid % nig) / gsz; return true;
    }
    __device__ __forceinline__ void aoff(const Unit&, const int (&)[2], const unsigned (&)[2], int, unsigned (&)[2][2]) const {}
};
struct MoeOrder {
    static constexpr bool GATHER = true;
    const int* blk_e; const int* rowidx; int nunits, G, c;
    __device__ __forceinline__ bool next(int i, Unit& u) const {
        const int L = i * G + c; if (L >= nunits) return false;
        const int blk = L >> 2; const int e = blk_e[blk]; u.pm = blk; u.pn = 4 * e + (L & 3); return true;
    }
    __device__ __forceinline__ void aoff(const Unit& u, const int (&RA)[2], const unsigned (&CA2)[2], int K, unsigned (&o)[2][2]) const {
#pragma unroll
        for (int h = 0; h < 2; ++h)
#pragma unroll
            for (int i = 0; i < 2; ++i) { const int r = u.pm * BM + h * HALF + RA[i]; const int src = rowidx ? rowidx[r] : r; o[h][i] = (unsigned)src * (unsigned)(K * 2) + CA2[i]; }
    }
};

template <class Epi, class Sched>
__device__ __forceinline__ void gemm_phase(LAS unsigned char* lds, const Gemm g, const Sched& S, const Epi& E, const int wid) {
    int lane_; asm volatile("v_mbcnt_lo_u32_b32 %0, -1, 0\n\tv_mbcnt_hi_u32_b32 %0, -1, %0" : "=v"(lane_));
    const int lane = lane_, tid = wid * 64 + lane, wr = wid >> 2, wc = wid & 3, fr = lane & 15, fq = lane >> 4;
    const int K = g.K, nt = K / BK;
    unsigned voffA[2], voffB[2], CA2[2]; int RA[2];
#pragma unroll
    for (int i = 0; i < 2; ++i) { int R, C; stage_rc(tid * 16 + i * 8192, R, C); const int Rb = Epi::PERM ? ((R & ~31) + perm32(R & 31)) : R;
        RA[i] = R; CA2[i] = (unsigned)C * 2u; voffA[i] = (unsigned)(R * K + C) * 2u; voffB[i] = (unsigned)(Rb * K + C) * 2u; }
    const size_t kstep = (size_t)(BK * 2);
    const size_t hstep = (size_t)HALF * K * 2;
    const size_t tstep = 2 * hstep;
    const unsigned ldsw = (unsigned)wid * 1024u;
    const int aoff = lds_byte(wr * 64 + fr, fq * 8), boff = lds_byte(wc * 32 + fr, fq * 8);
    const char* Ab = (const char*)g.A;
#define PG8_SA(b, h) (((b) * 2 + (h)) * HTB)
#define PG8_SB(b, h) ((4 + (b) * 2 + (h)) * HTB)
#define PG8_STAGEB(bufoff, gbase, voff) do { _Pragma("unroll") for (int _i = 0; _i < 2; ++_i) \
        __builtin_amdgcn_global_load_lds((const unsigned*)((const char*)(gbase) + (voff)[_i]), (LAS unsigned*)(lds + (bufoff) + ldsw + _i * 8192), 16, 0, 0); } while (0)
#define PG8_STAGEA(bufoff, H_, kb, NEXT) do { if constexpr (Sched::GATHER) { _Pragma("unroll") for (int _i = 0; _i < 2; ++_i) { const unsigned _o = (NEXT) ? na[H_][_i] : ca[H_][_i]; \
            __builtin_amdgcn_global_load_lds((const unsigned*)(Ab + (size_t)_o + (size_t)(kb)), (LAS unsigned*)(lds + (bufoff) + ldsw + _i * 8192), 16, 0, 0); } } \
        else { const char* _b = Ab + ((NEXT) ? nU : cU) + (size_t)(H_) * hstep + (size_t)(kb); _Pragma("unroll") for (int _i = 0; _i < 2; ++_i) \
            __builtin_amdgcn_global_load_lds((const unsigned*)(_b + voffA[_i]), (LAS unsigned*)(lds + (bufoff) + ldsw + _i * 8192), 16, 0, 0); } } while (0)
#define PG8_LDA(dst, b, h) do { _Pragma("unroll") for (int m = 0; m < 4; ++m) _Pragma("unroll") for (int k = 0; k < 2; ++k) dst[m][k] = *(const LAS bf16x8*)(lds + PG8_SA(b, h) + aoff + m * 2048 + k * 1024); } while (0)
#define PG8_LDB(dst, b, h) do { _Pragma("unroll") for (int n = 0; n < 2; ++n) _Pragma("unroll") for (int k = 0; k < 2; ++k) dst[n][k] = *(const LAS bf16x8*)(lds + PG8_SB(b, h) + boff + n * 2048 + k * 1024); } while (0)
#define PG8_MMA(ai, bj, At, Bt) do { __builtin_amdgcn_s_setprio(1); _Pragma("unroll") for (int m = 0; m < 4; ++m) _Pragma("unroll") for (int n = 0; n < 2; ++n) _Pragma("unroll") for (int k = 0; k < 2; ++k) \
        acc[ai][bj][m][n] = __builtin_amdgcn_mfma_f32_16x16x32_bf16(Bt[n][k], At[m][k], acc[ai][bj][m][n], 0, 0, 0); __builtin_amdgcn_s_setprio(0); } while (0)
#define PG8_WAIT_V(n) asm volatile("s_waitcnt vmcnt(" #n ")" ::: "memory")
#define PG8_WAIT_L(n) asm volatile("s_waitcnt lgkmcnt(" #n ")" ::: "memory")
#define PG8_BAR __builtin_amdgcn_s_barrier()
#define PG8_SCHED __builtin_amdgcn_sched_barrier(0)
    Unit cur, nxt; int ui = 0;
    if (!S.next(0, cur)) return;
    f32x4 acc[2][2][4][2];
#pragma unroll
    for (int a = 0; a < 2; ++a)
#pragma unroll
        for (int b = 0; b < 2; ++b)
#pragma unroll
            for (int m = 0; m < 4; ++m)
#pragma unroll
                for (int n = 0; n < 2; ++n) acc[a][b][m][n] = (f32x4){0.f, 0.f, 0.f, 0.f};
    bf16x8 At[4][2], B0[2][2], B1[2][2];
    unsigned ca[2][2], na[2][2];
    size_t cU = 0, nU = 0;
    if constexpr (Sched::GATHER) S.aoff(cur, RA, CA2, K, ca); else cU = (size_t)cur.pm * tstep;
    const char* cB = (const char*)g.Bt + (size_t)cur.pn * tstep;
    PG8_STAGEB(PG8_SB(0, 0), cB, voffB); PG8_STAGEB(PG8_SB(0, 1), cB + hstep, voffB); PG8_STAGEA(PG8_SA(0, 0), 0, 0, false); PG8_STAGEA(PG8_SA(0, 1), 1, 0, false);
    if (wr == 1) PG8_BAR;
    PG8_WAIT_V(2); PG8_BAR;
    PG8_STAGEB(PG8_SB(1, 0), cB + kstep, voffB); PG8_STAGEA(PG8_SA(1, 0), 0, kstep, false); PG8_STAGEB(PG8_SB(1, 1), cB + hstep + kstep, voffB);
    PG8_WAIT_V(6); PG8_BAR;
    for (;;) {
        const bool has_next = S.next(ui + 1, nxt);
        if constexpr (Sched::GATHER) {
            if (has_next) S.aoff(nxt, RA, CA2, K, na);
            else {
#pragma unroll
                for (int h = 0; h < 2; ++h)
#pragma unroll
                    for (int i = 0; i < 2; ++i) na[h][i] = ca[h][i];
            }
        } else nU = has_next ? (size_t)nxt.pm * tstep : cU;
        const char* nB = has_next ? (const char*)g.Bt + (size_t)nxt.pn * tstep : cB;
        for (int t = 0; t < nt; t += 2) {
            const bool last = (t == nt - 2);
            const size_t kb1 = (size_t)(t + 1) * kstep;
            const size_t kb2 = last ? 0 : (size_t)(t + 2) * kstep, kb3 = kb2 + kstep;
            const char* b2 = last ? nB : cB + (size_t)(t + 2) * kstep; const char* b3 = b2 + kstep;
            PG8_LDB(B0, 0, 0); PG8_LDB(B1, 0, 1); PG8_SCHED; PG8_LDA(At, 0, 0); PG8_STAGEA(PG8_SA(1, 1), 1, kb1, false);
            PG8_WAIT_V(8); PG8_WAIT_L(0); PG8_BAR; PG8_MMA(0, 0, At, B0); PG8_MMA(0, 1, At, B1); PG8_BAR; PG8_SCHED;
            PG8_LDA(At, 0, 1); PG8_STAGEB(PG8_SB(0, 0), b2, voffB); PG8_STAGEB(PG8_SB(0, 1), b2 + hstep, voffB); PG8_STAGEA(PG8_SA(0, 0), 0, kb2, last);
            PG8_WAIT_V(8); PG8_WAIT_L(0); PG8_BAR; PG8_MMA(1, 0, At, B0); PG8_MMA(1, 1, At, B1); PG8_BAR; PG8_SCHED;
            PG8_LDB(B0, 1, 0); PG8_LDB(B1, 1, 1); PG8_SCHED; PG8_LDA(At, 1, 0); PG8_STAGEA(PG8_SA(0, 1), 1, kb2, last);
            PG8_WAIT_V(8); PG8_WAIT_L(0); PG8_BAR; PG8_MMA(0, 0, At, B0); PG8_MMA(0, 1, At, B1); PG8_BAR; PG8_SCHED;
            PG8_LDA(At, 1, 1); PG8_STAGEB(PG8_SB(1, 0), b3, voffB); PG8_STAGEB(PG8_SB(1, 1), b3 + hstep, voffB); PG8_STAGEA(PG8_SA(1, 0), 0, kb3, last);
            PG8_WAIT_V(8); PG8_WAIT_L(0); PG8_BAR; PG8_MMA(1, 0, At, B0); PG8_MMA(1, 1, At, B1); PG8_BAR; PG8_SCHED;
            if constexpr (Epi::MIDK) { if (t + 2 == nt / 2) E.mid(acc, cur, wr, wc, fr, fq); }
        }
#if GEMM_ALIGN
        if (wr == 0) PG8_BAR;
#endif
        E(acc, cur, wr, wc, fr, fq);
        if (!has_next) break;
#pragma unroll
        for (int a = 0; a < 2; ++a)
#pragma unroll
            for (int b = 0; b < 2; ++b)
#pragma unroll
                for (int m = 0; m < 4; ++m)
#pragma unroll
                    for (int n = 0; n < 2; ++n) acc[a][b][m][n] = (f32x4){0.f, 0.f, 0.f, 0.f};
        cur = nxt; cB = nB; cU = nU; ++ui;
        if constexpr (Sched::GATHER) {
#pragma unroll
            for (int h = 0; h < 2; ++h)
#pragma unroll
                for (int i = 0; i < 2; ++i) ca[h][i] = na[h][i];
        }
#if GEMM_ALIGN
        if (wr == 1) PG8_BAR;
#endif
    }
    PG8_WAIT_V(0);
#if !GEMM_ALIGN
    if (wr == 0) PG8_BAR;
#endif
    PG8_BAR;
#undef PG8_SA
#undef PG8_SB
#undef PG8_STAGEA
#undef PG8_STAGEB
#undef PG8_LDA
#undef PG8_LDB
#undef PG8_MMA
#undef PG8_WAIT_V
#undef PG8_WAIT_L
#undef PG8_BAR
#undef PG8_SCHED
}

typedef const f32x4 (&AccRef)[2][2][4][2];

__device__ __forceinline__ u32x4 pack8(const f32x4& a, const f32x4& b) { u32x4 w; w.x = cvt_pk_bf16(a[0], a[1]); w.y = cvt_pk_bf16(a[2], a[3]); w.z = cvt_pk_bf16(b[0], b[1]); w.w = cvt_pk_bf16(b[2], b[3]); return w; }

struct EpiInProj {
    static constexpr bool PERM = true, MIDK = false;
    bf16_t *QA, *KA, *VA, *QB, *KB, *VB, *SA, *SB;
    const LAS float* normw;
    template <int ROPE>
    __device__ __forceinline__ void head_tile(AccRef acc, bf16_t* dst, int ld, int hcol, int gsel, float scale, int row0, int fr, int fq) const {
        int d0[2];
#pragma unroll
        for (int bj = 0; bj < 2; ++bj) d0[bj] = (ROPE == 1) ? (fq == 0 ? 8 * bj : 8 + 8 * fq + 24 * bj) : (fq < 2 ? 8 * fq + 16 * bj : 16 + 8 * fq + 16 * bj);
        f32x4 g[2][2];
#pragma unroll
        for (int bj = 0; bj < 2; ++bj)
#pragma unroll
            for (int n = 0; n < 2; ++n) g[bj][n] = *(const LAS f32x4*)(normw + gsel * 64 + d0[bj] + 4 * n);
        constexpr float FA[8] = {1.591549431e-01f, 3.086376340e-02f, 5.985185713e-03f, 1.160663641e-03f, 2.250790790e-04f, 4.364795279e-05f, 8.464330808e-06f, 1.641426263e-06f};
        constexpr float FB[16] = {1.591549431e-01f, 8.949940161e-02f, 5.032921210e-02f, 2.830219583e-02f, 1.591549431e-02f, 8.949940161e-03f, 5.032921210e-03f, 2.830219583e-03f,
                                  1.591549431e-03f, 8.949940161e-04f, 5.032921210e-04f, 2.830219583e-04f, 1.591549431e-04f, 8.949940161e-05f, 5.032921210e-05f, 2.830219583e-05f};
        float fq8[8];
#pragma unroll
        for (int k = 0; k < 8; ++k) fq8[k] = (ROPE == 1) ? FA[k] : ((fq & 1) ? FB[8 + k] : FB[k]);
        const bool rot = (ROPE == 2) || (fq == 0);
#pragma unroll
        for (int ai = 0; ai < 2; ++ai)
#pragma unroll
            for (int m = 0; m < 4; ++m) {
                const int row = row0 + ai * HALF + m * 16; const int s = row & (SEQ - 1);
                f32x4 y[2][2]; float ss = 0.f;
#pragma unroll
                for (int bj = 0; bj < 2; ++bj)
#pragma unroll
                    for (int n = 0; n < 2; ++n) { y[bj][n] = acc[ai][bj][m][n]; const f32x4 q = y[bj][n] * y[bj][n]; ss += (q[0] + q[1]) + (q[2] + q[3]); }
                ss += shx(ss, 16, fr + 16 * fq); ss += shx(ss, 32, fr + 16 * fq);
                const float rinv = __builtin_amdgcn_rsqf(ss * (1.0f / 64.0f) + 1e-6f);
#pragma unroll
                for (int bj = 0; bj < 2; ++bj)
#pragma unroll
                    for (int n = 0; n < 2; ++n) y[bj][n] = y[bj][n] * rinv * g[bj][n];
                if (ROPE != 0) {
                    const float pos = (float)((ROPE == 1) ? s : (fq < 2 ? (s >> 6) : (s & 63)));
#pragma unroll
                    for (int n = 0; n < 2; ++n)
#pragma unroll
                        for (int j = 0; j < 4; ++j) {
                            const float xr = __builtin_amdgcn_fractf(pos * fq8[4 * n + j]);
                            const float c = rot ? __builtin_amdgcn_cosf(xr) : 1.0f, s_ = rot ? __builtin_amdgcn_sinf(xr) : 0.0f;
                            const float x1 = y[0][n][j], x2 = y[1][n][j];
                            y[0][n][j] = x1 * c - x2 * s_; y[1][n][j] = x2 * c + x1 * s_;
                        }
                }
                bf16_t* rowp = dst + (size_t)row * ld + hcol + 8 * fq;
#pragma unroll
                for (int bj = 0; bj < 2; ++bj) *(u32x4*)(rowp + 32 * bj) = pack8(y[bj][0] * scale, y[bj][1] * scale);
            }
    }
    __device__ __forceinline__ void operator()(AccRef acc, const Unit& u, int wr, int wc, int fr_, int fq_) const {
        int fr = fr_, fq = fq_; asm volatile("" : "+v"(fr), "+v"(fq));
        const int pn = u.pn; const int row0 = u.pm * BM + wr * 64 + fr;
        if (pn >= 9) {
            unsigned char* base = (unsigned char*)((pn < 13) ? SA : SB); const int colt = ((pn - 9) & 3) * 256 + wc * 64 + 16 * fq;
#pragma unroll
            for (int ai = 0; ai < 2; ++ai)
#pragma unroll
                for (int m = 0; m < 4; ++m) { u32x4 w;
#pragma unroll
                    for (int bj = 0; bj < 2; ++bj) { f32x4 v0 = acc[ai][bj][m][0], v1 = acc[ai][bj][m][1];
#pragma unroll
                        for (int j = 0; j < 4; ++j) { v0[j] = sigmoid_f(v0[j]); v1[j] = sigmoid_f(v1[j]); }
                        const unsigned lo = pack4_fp8(v0[0], v0[1], v0[2], v0[3]), hi = pack4_fp8(v1[0], v1[1], v1[2], v1[3]);
                        if (bj == 0) { w.x = lo; w.y = hi; } else { w.z = lo; w.w = hi; } }
                    *(u32x4*)(base + (size_t)(row0 + ai * HALF + m * 16) * DM + colt) = w; }
        } else if (pn == 4 || pn == 5) {
            const int colt = (pn - 4) * 256 + wc * 64 + 16 * fq;
#pragma unroll
            for (int ai = 0; ai < 2; ++ai)
#pragma unroll
                for (int m = 0; m < 4; ++m) { bf16_t* rowp = VA + (size_t)(row0 + ai * HALF + m * 16) * 512 + colt;
#pragma unroll
                    for (int bj = 0; bj < 2; ++bj) *(u32x4*)(rowp + 8 * bj) = pack8(acc[ai][bj][m][0], acc[ai][bj][m][1]); }
        } else if (pn < 2)  head_tile<1>(acc, QA, 512, 64 * (4 * pn + wc), 0, QSCALE, row0, fr, fq);
        else if (pn < 4)    head_tile<1>(acc, KA, 512, 64 * (4 * (pn - 2) + wc), 1, 1.0f, row0, fr, fq);
        else if (pn < 8)    head_tile<2>(acc, QB, 512, 64 * (4 * (pn - 6) + wc), 2, QSCALE, row0, fr, fq);
        else if (wc < 2)    head_tile<2>(acc, KB, 128, 64 * wc, 3, 1.0f, row0, fr, fq);
        else {
#pragma unroll
            for (int ai = 0; ai < 2; ++ai)
#pragma unroll
                for (int m = 0; m < 4; ++m) { bf16_t* rowp = VB + (size_t)(row0 + ai * HALF + m * 16) * 128 + 64 * (wc - 2) + 8 * fq;
#pragma unroll
                    for (int bj = 0; bj < 2; ++bj) *(u32x4*)(rowp + 32 * bj) = pack8(acc[ai][bj][m][0], acc[ai][bj][m][1]); }
        }
    }
};

struct EpiMergeFused {
    static constexpr bool PERM = true, MIDK = true;
    bf16_t* MG; const unsigned char* GA; const unsigned char* GB;
    __device__ __forceinline__ void mid(f32x4 (&acc)[2][2][4][2], const Unit& u, int wr, int wc, int fr_, int fq_) const {
        int fr = fr_, fq = fq_; asm volatile("" : "+v"(fr), "+v"(fq));
        const int row0 = u.pm * BM + wr * 64 + fr, col0 = u.pn * BM + wc * 64 + 16 * fq;
#pragma unroll
        for (int ai = 0; ai < 2; ++ai)
#pragma unroll
            for (int m = 0; m < 4; ++m) { const size_t ro = (size_t)(row0 + ai * HALF + m * 16) * DM + col0;
                const u32x4 a = *(const u32x4*)(GA + ro), b = *(const u32x4*)(GB + ro);
#pragma unroll
                for (int bj = 0; bj < 2; ++bj) {
                    float sa[8], sb[8]; unpack8_fp8(bj ? (u32x2){a.z, a.w} : (u32x2){a.x, a.y}, sa); unpack8_fp8(bj ? (u32x2){b.z, b.w} : (u32x2){b.x, b.y}, sb);
#pragma unroll
                    for (int n = 0; n < 2; ++n)
#pragma unroll
                        for (int j = 0; j < 4; ++j) acc[ai][bj][m][n][j] *= sa[4 * n + j] * __builtin_amdgcn_rcpf(fmaxf(sb[4 * n + j], 1e-12f));
                } }
    }
    __device__ __forceinline__ void operator()(AccRef acc, const Unit& u, int wr, int wc, int fr_, int fq_) const {
        int fr = fr_, fq = fq_; asm volatile("" : "+v"(fr), "+v"(fq));
        const int row0 = u.pm * BM + wr * 64 + fr, col0 = u.pn * BM + wc * 64 + 16 * fq;
#pragma unroll
        for (int ai = 0; ai < 2; ++ai)
#pragma unroll
            for (int m = 0; m < 4; ++m) { const size_t ro = (size_t)(row0 + ai * HALF + m * 16) * DM + col0;
                const u32x4 b = *(const u32x4*)(GB + ro);
#pragma unroll
                for (int bj = 0; bj < 2; ++bj) {
                    float sb[8]; unpack8_fp8(bj ? (u32x2){b.z, b.w} : (u32x2){b.x, b.y}, sb);
                    f32x4 v0 = acc[ai][bj][m][0], v1 = acc[ai][bj][m][1];
#pragma unroll
                    for (int j = 0; j < 4; ++j) { v0[j] *= fmaxf(sb[j], 1e-12f); v1[j] *= fmaxf(sb[4 + j], 1e-12f); }
                    *(u32x4*)(MG + ro + 8 * bj) = pack8(v0, v1); } }
    }
};

struct EpiResidB {
    static constexpr bool PERM = true, MIDK = false;
    const float* Xf; const bf16_t* Xb; bf16_t* O; const float* gate;
    __device__ __forceinline__ void operator()(AccRef acc, const Unit& u, int wr, int wc, int fr_, int fq_) const {
        int fr = fr_, fq = fq_; asm volatile("" : "+v"(fr), "+v"(fq));
        const int row0 = u.pm * BM + wr * 64 + fr, col0 = u.pn * BM + wc * 64 + 16 * fq; const int b = (u.pm * BM) >> 11;
        f32x4 gt[2][2];
#pragma unroll
        for (int bj = 0; bj < 2; ++bj)
#pragma unroll
            for (int n = 0; n < 2; ++n) gt[bj][n] = *(const f32x4*)(gate + (size_t)b * MODW + col0 + 8 * bj + 4 * n);
#pragma unroll
        for (int ai = 0; ai < 2; ++ai)
#pragma unroll
            for (int m = 0; m < 4; ++m) { const size_t ro = (size_t)(row0 + ai * HALF + m * 16) * DM + col0;
#pragma unroll
                for (int bj = 0; bj < 2; ++bj) {
                    f32x4 x0, x1;
                    if (Xf) { x0 = *(const f32x4*)(Xf + ro + 8 * bj); x1 = *(const f32x4*)(Xf + ro + 8 * bj + 4); }
                    else { const u32x4 w = *(const u32x4*)(Xb + ro + 8 * bj); x0 = (f32x4){bf_lo(w.x), bf_hi(w.x), bf_lo(w.y), bf_hi(w.y)}; x1 = (f32x4){bf_lo(w.z), bf_hi(w.z), bf_lo(w.w), bf_hi(w.w)}; }
                    *(u32x4*)(O + ro + 8 * bj) = pack8(x0 + gt[bj][0] * acc[ai][bj][m][0], x1 + gt[bj][1] * acc[ai][bj][m][1]); } }
    }
};

struct EpiSwiGLU {
    static constexpr bool PERM = true, MIDK = false;
    bf16_t* ACT;
    __device__ __forceinline__ void operator()(AccRef acc, const Unit& u, int wr, int wc, int fr_, int fq_) const {
        int fr = fr_, fq = fq_; asm volatile("" : "+v"(fr), "+v"(fq));
        const int row0 = u.pm * BM + wr * 64 + fr, col0 = (u.pn & 3) * HALF + wc * 32 + 8 * fq;
#pragma unroll
        for (int ai = 0; ai < 2; ++ai)
#pragma unroll
            for (int m = 0; m < 4; ++m) { f32x4 r[2];
#pragma unroll
                for (int n = 0; n < 2; ++n)
#pragma unroll
                    for (int j = 0; j < 4; ++j) { const float gg = acc[ai][0][m][n][j], uu = acc[ai][1][m][n][j]; r[n][j] = gg * sigmoid_f(gg) * uu; }
                *(u32x4*)(ACT + (size_t)(row0 + ai * HALF + m * 16) * DFF + col0) = pack8(r[0], r[1]); }
    }
};

struct EpiY {
    static constexpr bool PERM = true, MIDK = false;
    bf16_t* Y;
    __device__ __forceinline__ void operator()(AccRef acc, const Unit& u, int wr, int wc, int fr_, int fq_) const {
        int fr = fr_, fq = fq_; asm volatile("" : "+v"(fr), "+v"(fq));
        const int row0 = u.pm * BM + wr * 64 + fr, col0 = (u.pn & 3) * BM + wc * 64 + 16 * fq;
#pragma unroll
        for (int ai = 0; ai < 2; ++ai)
#pragma unroll
            for (int m = 0; m < 4; ++m) { bf16_t* rowp = Y + (size_t)(row0 + ai * HALF + m * 16) * DM + col0;
#pragma unroll
                for (int bj = 0; bj < 2; ++bj) *(u32x4*)(rowp + 8 * bj) = pack8(acc[ai][bj][m][0], acc[ai][bj][m][1]); }
    }
};
}

__device__ __forceinline__ int dimA(int bj, int r) { return r < 8 ? r + 8 * bj : 16 + (r - 8) + 24 * bj; }
__device__ __forceinline__ int dimB(int bj, int r) { return r < 16 ? r + 16 * bj : 32 + (r - 16) + 16 * bj; }
__device__ __forceinline__ int inproj_srccol(int P) {
    const int pn = P >> 8, p = P & 255, bj = p >> 7, wc = (p >> 5) & 3, r = p & 31;
    if (pn < 2) return 64 * (4 * pn + wc) + dimA(bj, r);
    if (pn < 4) return 512 + 64 * (4 * (pn - 2) + wc) + dimA(bj, r);
    if (pn < 6) return 1024 + 256 * (pn - 4) + 64 * wc + 16 * ((p >> 3) & 3) + 8 * bj + (p & 7);
    if (pn < 8) return 1536 + 64 * (4 * (pn - 6) + wc) + dimB(bj, r);
    if (pn == 8) return wc < 2 ? 2048 + 64 * wc + dimB(bj, r) : 2176 + 64 * (wc - 2) + 32 * bj + r;
    { const int fq = (p >> 3) & 3, r8 = p & 7; return 2304 + 256 * (pn - 9) + 64 * wc + 16 * fq + 8 * bj + r8; }
}

namespace att {
constexpr int KSTR = 144, VSTR = 192;
constexpr int KTILE = 64 * KSTR, VTILE = 64 * VSTR;
constexpr int K_OFF = 0, V_OFF = 2 * KTILE;
constexpr int PRIV_OFF = 0;
__device__ __forceinline__ s16x4 vtr(LAS const char* p) { typedef short v4i16_t __attribute__((ext_vector_type(4)));
    return __builtin_bit_cast(s16x4, __builtin_amdgcn_ds_read_tr16_b64_v4i16((LAS v4i16_t*)p)); }
__device__ __forceinline__ int clamp_tok(int t) { return t < 0 ? 0 : (t > SEQ - 1 ? SEQ - 1 : t); }

__device__ __forceinline__ void qk_tile(f32x16& p0, f32x16& p1, const bf16x8 (&kf)[8], const bf16x8 (&qr)[4]) {
    const f32x16 z = {0.f, 0.f, 0.f, 0.f, 0.f, 0.f, 0.f, 0.f, 0.f, 0.f, 0.f, 0.f, 0.f, 0.f, 0.f, 0.f};
    p0 = __builtin_amdgcn_mfma_f32_32x32x16_bf16(kf[0], qr[0], z, 0, 0, 0); p1 = __builtin_amdgcn_mfma_f32_32x32x16_bf16(kf[1], qr[0], z, 0, 0, 0);
#pragma unroll
    for (int d0 = 1; d0 < 4; ++d0) { p0 = __builtin_amdgcn_mfma_f32_32x32x16_bf16(kf[2 * d0], qr[d0], p0, 0, 0, 0); p1 = __builtin_amdgcn_mfma_f32_32x32x16_bf16(kf[2 * d0 + 1], qr[d0], p1, 0, 0, 0); }
}
template <bool MASK>
__device__ __forceinline__ void exp_tile(const f32x16& p0, const f32x16& p1, float& lsum, bf16x8 (&pf)[2][2], int mbase, int mR, int dk) {
    float e0[16], e1[16]; float ls = 0.f;
#pragma unroll
    for (int r = 0; r < 16; ++r) {
        e0[r] = __builtin_amdgcn_exp2f(p0[r]); e1[r] = __builtin_amdgcn_exp2f(p1[r]);
        if (MASK) {
            const int c0 = (r & 3) + 8 * (r >> 2);
            e0[r] = ((unsigned)(mbase + dk * c0) <= (unsigned)mR) ? e0[r] : 0.f;
            e1[r] = ((unsigned)(mbase + dk * (c0 + 32)) <= (unsigned)mR) ? e1[r] : 0.f;
        }
        ls += e0[r] + e1[r];
    }
    lsum += ls;
#pragma unroll
    for (int s = 0; s < 2; ++s) {
        u32x4 w0, w1;
        w0.x = cvt_pk_bf16(e0[8 * s + 0], e0[8 * s + 1]); w0.y = cvt_pk_bf16(e0[8 * s + 2], e0[8 * s + 3]); w0.z = cvt_pk_bf16(e0[8 * s + 4], e0[8 * s + 5]); w0.w = cvt_pk_bf16(e0[8 * s + 6], e0[8 * s + 7]);
        w1.x = cvt_pk_bf16(e1[8 * s + 0], e1[8 * s + 1]); w1.y = cvt_pk_bf16(e1[8 * s + 2], e1[8 * s + 3]); w1.z = cvt_pk_bf16(e1[8 * s + 4], e1[8 * s + 5]); w1.w = cvt_pk_bf16(e1[8 * s + 6], e1[8 * s + 7]);
        pf[0][s] = __builtin_bit_cast(bf16x8, w0); pf[1][s] = __builtin_bit_cast(bf16x8, w1);
    }
}
__device__ __forceinline__ void vread(bf16x8 (&vf)[4], LAS const char* vb, int d0) {
#pragma unroll
    for (int blk = 0; blk < 2; ++blk)
#pragma unroll
        for (int s = 0; s < 2; ++s) {
            const s16x4 lo = vtr(vb + (32 * blk + 16 * s) * VSTR + 64 * d0), hi = vtr(vb + (32 * blk + 16 * s + 8) * VSTR + 64 * d0);
            vf[2 * blk + s] = (bf16x8){lo[0], lo[1], lo[2], lo[3], hi[0], hi[1], hi[2], hi[3]};
        }
}
__device__ __forceinline__ void pv_half(f32x16& od, const bf16x8 (&vf)[4], const bf16x8 (&pf)[2][2]) {
#pragma unroll
    for (int blk = 0; blk < 2; ++blk)
#pragma unroll
        for (int s = 0; s < 2; ++s) od = __builtin_amdgcn_mfma_f32_32x32x16_bf16(vf[2 * blk + s], pf[blk][s], od, 0, 0, 0);
}
__device__ __forceinline__ void mask_params(int dk, int tk0, int tq, int hi, int& mbase, int& mR) {
    const int dlo = (-64 * dk > -tq) ? -64 * dk : -tq, dhi = (64 * dk < SEQ - 1 - tq) ? 64 * dk : SEQ - 1 - tq;
    const int dA = tk0 + 4 * dk * hi - tq;
    mR = dhi - dlo; mbase = ((dA & (dk - 1)) == 0) ? dA - dlo : 0x7fffffff;
}

template <bool MASKED>
__device__ __forceinline__ void dense64_loop(LAS char* lds, const bf16_t* Kg, const bf16_t* Vg, int ld, int tok0, int ntiles,
                                             const bf16x8 (&qr)[2][4], f32x16 (&o)[2][2], float (&lsum)[2], int tq0, int tq1, int lane_, int wave) {
    constexpr int V2_OFF = 2 * KTILE;
    u32x4 kreg, vreg;
#define D64_LANE() int ln_ = lane_; asm volatile("" : "+v"(ln_)); const int tid_ = wave * 64 + ln_, srow = tid_ >> 3, sch = tid_ & 7
#define D64_LD(t) do { D64_LANE(); int tk_ = tok0 + 64 * (t) + srow; if (MASKED) tk_ = clamp_tok(tk_); kreg = *(const u32x4*)(Kg + (size_t)tk_ * ld + sch * 8); vreg = *(const u32x4*)(Vg + (size_t)tk_ * ld + sch * 8); } while (0)
#define D64_ST(t) do { D64_LANE(); *(LAS u32x4*)(lds + ((t) & 1) * KTILE + srow * KSTR + sch * 16) = kreg; *(LAS u32x4*)(lds + V2_OFF + ((t) & 1) * VTILE + srow * VSTR + sch * 16) = vreg; } while (0)
    D64_LD(0); D64_ST(0); D64_LD(1);
    for (int t = 0; t < ntiles; ++t) {
        __syncthreads();
        if (t + 1 < ntiles) D64_ST(t + 1);
        if (t + 2 < ntiles) D64_LD(t + 2);
        int lane = lane_; asm volatile("" : "+v"(lane));
        const int hi = lane >> 5;
        const int vlane = (4 * hi + ((lane & 15) >> 2)) * VSTR + (16 * ((lane >> 4) & 1) + 4 * (lane & 3)) * 2;
        const int klane = (lane & 31) * KSTR + 16 * hi;
        bf16x8 kf[8];
        { LAS const char* kb_ = lds + (t & 1) * KTILE + klane;
#pragma unroll
          for (int d0 = 0; d0 < 4; ++d0)
#pragma unroll
              for (int blk = 0; blk < 2; ++blk) kf[2 * d0 + blk] = *(const LAS bf16x8*)(kb_ + 32 * blk * KSTR + 32 * d0); }
        f32x16 p[2][2];
        bf16x8 vfa[4], vfb[4];
        LAS const char* vb_ = lds + V2_OFF + (t & 1) * VTILE + vlane;
        vread(vfa, vb_, 0); vread(vfb, vb_, 1);
        __builtin_amdgcn_sched_barrier(0);
        qk_tile(p[0][0], p[0][1], kf, qr[0]);
        qk_tile(p[1][0], p[1][1], kf, qr[1]);
#pragma unroll
        for (int g = 0; g < 2; ++g) {
            bf16x8 pf[2][2]; int mb = 0, mr = 0;
            if (MASKED) mask_params(1, tok0 + 64 * t, g ? tq1 : tq0, hi, mb, mr);
            exp_tile<MASKED>(p[g][0], p[g][1], lsum[g], pf, mb, mr, 1);
            pv_half(o[g][0], vfa, pf); pv_half(o[g][1], vfb, pf);
        }
    }
#undef D64_LANE
#undef D64_LD
#undef D64_ST
}
__device__ __forceinline__ void dense64_lag_loop(LAS char* lds, const bf16_t* Kg, const bf16_t* Vg, int ld, int ntiles,
                                                 const bf16x8 (&qr)[2][4], f32x16 (&o)[2][2], float (&lsum)[2], int lane_, int wave, const bool lag) {
    constexpr int V2_OFF = 2 * KTILE;
    u32x4 kreg, vreg;
#define D64_LANE() int ln_ = lane_; asm volatile("" : "+v"(ln_)); const int tid_ = wave * 64 + ln_, srow = tid_ >> 3, sch = tid_ & 7
#define D64_LD(t) do { D64_LANE(); const int tk_ = 64 * (t) + srow; kreg = *(const u32x4*)(Kg + (size_t)tk_ * ld + sch * 8); vreg = *(const u32x4*)(Vg + (size_t)tk_ * ld + sch * 8); } while (0)
#define D64_ST(t) do { D64_LANE(); *(LAS u32x4*)(lds + ((t) & 1) * KTILE + srow * KSTR + sch * 16) = kreg; *(LAS u32x4*)(lds + V2_OFF + ((t) % 3) * VTILE + srow * VSTR + sch * 16) = vreg; } while (0)
#define D64_QK(t) do { int lane = lane_; asm volatile("" : "+v"(lane)); const int klane = (lane & 31) * KSTR + 16 * (lane >> 5); bf16x8 kf[8]; LAS const char* kb_ = lds + ((t) & 1) * KTILE + klane; \
        _Pragma("unroll") for (int d0 = 0; d0 < 4; ++d0) _Pragma("unroll") for (int blk = 0; blk < 2; ++blk) kf[2 * d0 + blk] = *(const LAS bf16x8*)(kb_ + 32 * blk * KSTR + 32 * d0); \
        qk_tile(p[0][0], p[0][1], kf, qr[0]); qk_tile(p[1][0], p[1][1], kf, qr[1]); } while (0)
#define D64_PV(t) do { int lane = lane_; asm volatile("" : "+v"(lane)); const int hi = lane >> 5; const int vlane = (4 * hi + ((lane & 15) >> 2)) * VSTR + (16 * ((lane >> 4) & 1) + 4 * (lane & 3)) * 2; \
        bf16x8 vfa[4], vfb[4]; LAS const char* vb_ = lds + V2_OFF + ((t) % 3) * VTILE + vlane; vread(vfa, vb_, 0); vread(vfb, vb_, 1); \
        _Pragma("unroll") for (int g = 0; g < 2; ++g) { bf16x8 pf[2][2]; exp_tile<false>(p[g][0], p[g][1], lsum[g], pf, 0, 0, 0); pv_half(o[g][0], vfa, pf); pv_half(o[g][1], vfb, pf); } } while (0)
    f32x16 p[2][2];
    D64_LD(0); D64_ST(0);
    if (!lag) {
        D64_LD(1);
        for (int t = 0; t < ntiles; ++t) {
            __syncthreads();
            if (t + 1 < ntiles) D64_ST(t + 1);
            if (t + 2 < ntiles) D64_LD(t + 2);
            D64_QK(t);
            D64_PV(t);
        }
        __syncthreads();
    } else {
        D64_LD(1);
        __syncthreads();
        D64_ST(1); D64_LD(2);
        D64_QK(0);
        for (int t = 1; t < ntiles; ++t) {
            __syncthreads();
            if (t + 1 < ntiles) D64_ST(t + 1);
            if (t + 2 < ntiles) D64_LD(t + 2);
            D64_PV(t - 1);
            __builtin_amdgcn_sched_barrier(0);
            D64_QK(t);
        }
        __syncthreads();
        D64_PV(ntiles - 1);
    }
#undef D64_LANE
#undef D64_LD
#undef D64_ST
#undef D64_QK
#undef D64_PV
}
__device__ __forceinline__ void priv_kload(bf16x8 (&kf)[8], const bf16_t* Kg, int ld, int tk0, int dk, int lane_) {
    int lane = lane_; asm volatile("" : "+v"(lane));
    const int hi = lane >> 5;
#pragma unroll
    for (int blk = 0; blk < 2; ++blk) { const int tk = clamp_tok(tk0 + dk * (32 * blk + (lane & 31)));
#pragma unroll
        for (int d0 = 0; d0 < 4; ++d0) kf[2 * d0 + blk] = *(const bf16x8*)(Kg + (size_t)tk * ld + 16 * d0 + 8 * hi); }
}
__device__ __forceinline__ void priv2_step(bf16x8 (&kf)[8], LAS char* vpriv, const bf16_t* Kg, const bf16_t* Vg, int ld, int tk0, int dk, bool g0, bool g1,
                                           bool has_next, int tk0n, int dkn, const bf16x8 (&qr)[2][4], f32x16 (&o)[2][2], float (&lsum)[2], int tq0, int tq1, int lane_) {
    int lane = lane_; asm volatile("" : "+v"(lane));
    const int hi = lane >> 5;
    const int vlane = (4 * hi + ((lane & 15) >> 2)) * VSTR + (16 * ((lane >> 4) & 1) + 4 * (lane & 3)) * 2;
    u32x4 vr[8];
#pragma unroll
    for (int i = 0; i < 8; ++i) { const int idx = i * 64 + lane, row = idx >> 3, ch = idx & 7; const int tk = clamp_tok(tk0 + dk * row); vr[i] = *(const u32x4*)(Vg + (size_t)tk * ld + ch * 8); }
    const int gfirst = g0 ? 0 : 1, glast = g1 ? 1 : 0;
    f32x16 p0, p1; bf16x8 pf[2][2]; int mb, mr;
    if (gfirst == 0) qk_tile(p0, p1, kf, qr[0]); else qk_tile(p0, p1, kf, qr[1]);
    __builtin_amdgcn_sched_barrier(0);
#pragma unroll
    for (int i = 0; i < 8; ++i) { const int idx = i * 64 + lane; *(LAS u32x4*)(vpriv + (idx >> 3) * VSTR + (idx & 7) * 16) = vr[i]; }
    if (glast == gfirst) { __builtin_amdgcn_sched_barrier(0); if (has_next) priv_kload(kf, Kg, ld, tk0n, dkn, lane); __builtin_amdgcn_sched_barrier(0); }
    mask_params(dk, tk0, gfirst ? tq1 : tq0, hi, mb, mr);
    if (gfirst == 0) exp_tile<true>(p0, p1, lsum[0], pf, mb, mr, dk); else exp_tile<true>(p0, p1, lsum[1], pf, mb, mr, dk);
    { bf16x8 vfa[4], vfb[4]; vread(vfa, vpriv + vlane, 0); vread(vfb, vpriv + vlane, 1);
      if (gfirst == 0) { pv_half(o[0][0], vfa, pf); pv_half(o[0][1], vfb, pf); } else { pv_half(o[1][0], vfa, pf); pv_half(o[1][1], vfb, pf); } }
    if (glast != gfirst) {
        qk_tile(p0, p1, kf, qr[1]);
        __builtin_amdgcn_sched_barrier(0);
        if (has_next) priv_kload(kf, Kg, ld, tk0n, dkn, lane);
        __builtin_amdgcn_sched_barrier(0);
        mask_params(dk, tk0, tq1, hi, mb, mr);
        exp_tile<true>(p0, p1, lsum[1], pf, mb, mr, dk);
        bf16x8 vfa[4], vfb[4]; vread(vfa, vpriv + vlane, 0); vread(vfb, vpriv + vlane, 1);
        pv_half(o[1][0], vfa, pf); pv_half(o[1][1], vfb, pf);
    }
}
__device__ __forceinline__ void store_out(const f32x16 (&o)[2], float lsum, bf16_t* dst  , int lane_) {
    int lane = lane_; asm volatile("" : "+v"(lane));
    const int hi = lane >> 5;
    float l = lsum + shx(lsum, 32, lane);
    const float inv = 1.0f / l;
#pragma unroll
    for (int d0 = 0; d0 < 2; ++d0)
#pragma unroll
        for (int g4 = 0; g4 < 4; ++g4) {
            u32x2 w; w.x = cvt_pk_bf16(o[d0][4 * g4] * inv, o[d0][4 * g4 + 1] * inv); w.y = cvt_pk_bf16(o[d0][4 * g4 + 2] * inv, o[d0][4 * g4 + 3] * inv);
            *(u32x2*)(dst + 32 * d0 + 8 * g4 + 4 * hi) = w;
        }
}
}

struct Args { const float* in[18]; float* out; unsigned char* ws; int ph_lo, ph_hi; };
constexpr int PH_PRO = 0, PH_L0 = 1, PH_PER_LAYER = 9, PH_FINAL = PH_L0 + 2 * PH_PER_LAYER, NPH = PH_FINAL + 1;
enum { P_NORM1 = 0, P_INPROJ, P_ATTN, P_PAB, P_OUT, P_NORM2, P_PLACE, P_GU, P_DOWN };

__device__ __forceinline__ int tile256_srccol(int P) { const int p = P & 255; return (P & ~255) + 64 * ((p >> 5) & 3) + 16 * ((p >> 3) & 3) + 8 * (p >> 7) + (p & 7); }
template <int MAP>
__device__ __forceinline__ void transpose_item(const float* W, int N, int col0, bf16_t* dst, int dst_row0, int K, int k0, LAS float* scr, int lane, int dk0 = 0  ) {
    const int sc = (MAP == 1) ? inproj_srccol(col0 + lane) : (MAP == 2) ? tile256_srccol(col0 + lane) : col0 + lane;
    const float* src = W + (size_t)k0 * N + sc;
#pragma unroll 16
    for (int i = 0; i < 64; ++i) scr[i * 65 + lane] = src[(size_t)i * N];
    asm volatile("s_waitcnt lgkmcnt(0)" ::: "memory");
    const int c = lane & 7, nn = lane >> 3;
#pragma unroll
    for (int j = 0; j < 8; ++j) { const int n = nn + 8 * j; const LAS float* s = scr + (8 * c) * 65 + n;
        u32x4 w; w.x = cvt_pk_bf16(s[0], s[65]); w.y = cvt_pk_bf16(s[2 * 65], s[3 * 65]); w.z = cvt_pk_bf16(s[4 * 65], s[5 * 65]); w.w = cvt_pk_bf16(s[6 * 65], s[7 * 65]);
        *(u32x4*)(dst + (size_t)(dst_row0 + n) * K + dk0 + k0 + 8 * c) = w; }
    asm volatile("s_waitcnt lgkmcnt(0)" ::: "memory");
}


template <bool XF32, bool COMBINE, bool NORM, bool ROUTER, bool OUTF32>
__device__ __forceinline__ void row_phase(LAS unsigned char* lds, int tid, int lane, int wave, int G, int bx, const float* xf, bf16_t* xb, float* outf, const float* gv,
                                          const float* modl, int sh_off, int sc_off, const float* modprev, bf16_t* Hh, const bf16_t* Ym, const int* Pos, float* Tw,
                                          const bf16_t* Wr, int* Te, int* Trk, int* Cnt) {
    constexpr int RB = COMBINE ? 2 : ROWB;
    LAS float* lgs = (LAS float*)lds;
    LAS int* lcnt = (LAS int*)(lds + 40960);
    asm volatile("" : "+v"(tid), "+v"(lane));
    for (int chunk = bx; chunk < 256; chunk += G) {
        const int b = chunk >> 3;
        if (ROUTER) { if (tid < 32) lcnt[tid] = 0; }
        f32x4 pre[4], shv[4], g2[4];
#pragma unroll
        for (int j = 0; j < 4; ++j) { const int col = 512 * (j >> 1) + 8 * lane + 4 * (j & 1);
            if (NORM) { const f32x4 gg = *(const f32x4*)(gv + col), sc = *(const f32x4*)(modl + (size_t)b * MODW + sc_off + col);
                pre[j] = gg * (1.0f + sc); shv[j] = *(const f32x4*)(modl + (size_t)b * MODW + sh_off + col); }
            if (COMBINE) g2[j] = *(const f32x4*)(modprev + (size_t)b * MODW + 5 * DM + col); }
        f32x4 rawf[XF32 ? RB : 1][4]; u32x4 rawb[XF32 ? 1 : RB][2]; int pp[COMBINE ? RB : 1][2]; float pw[COMBINE ? RB : 1][2];
#define ROW_LOAD(rb_) do { _Pragma("unroll") for (int i = 0; i < RB; ++i) { const size_t ro = (size_t)((rb_) + i) * DM; \
            if (XF32) { _Pragma("unroll") for (int j = 0; j < 4; ++j) rawf[XF32 ? i : 0][j] = *(const f32x4*)(xf + ro + 512 * (j >> 1) + 8 * lane + 4 * (j & 1)); } \
            else { _Pragma("unroll") for (int h = 0; h < 2; ++h) rawb[XF32 ? 0 : i][h] = *(const u32x4*)(xb + ro + 512 * h + 8 * lane); } \
            if (COMBINE) { pp[COMBINE ? i : 0][0] = Pos[2 * ((rb_) + i)]; pp[COMBINE ? i : 0][1] = Pos[2 * ((rb_) + i) + 1]; pw[COMBINE ? i : 0][0] = Tw[2 * ((rb_) + i)]; pw[COMBINE ? i : 0][1] = Tw[2 * ((rb_) + i) + 1]; } } } while (0)
        ROW_LOAD(chunk * 256 + wave * 32);
#pragma unroll 1
        for (int r0 = 0; r0 < 32; r0 += RB) {
            const int rowb = chunk * 256 + wave * 32 + r0;
            f32x4 v[RB][4]; int cp[COMBINE ? RB : 1][2]; float cw[COMBINE ? RB : 1][2];
#pragma unroll
            for (int i = 0; i < RB; ++i) {
                if (XF32) {
#pragma unroll
                    for (int j = 0; j < 4; ++j) v[i][j] = rawf[XF32 ? i : 0][j];
                } else {
#pragma unroll
                    for (int h = 0; h < 2; ++h) { const u32x4 w = rawb[XF32 ? 0 : i][h];
                        v[i][2 * h] = (f32x4){bf_lo(w.x), bf_hi(w.x), bf_lo(w.y), bf_hi(w.y)}; v[i][2 * h + 1] = (f32x4){bf_lo(w.z), bf_hi(w.z), bf_lo(w.w), bf_hi(w.w)}; }
                }
                if (COMBINE) { cp[i][0] = pp[i][0]; cp[i][1] = pp[i][1]; cw[i][0] = pw[i][0]; cw[i][1] = pw[i][1]; }
            }
            u32x4 ya[COMBINE ? RB : 1][2], yc[COMBINE ? RB : 1][2];
            if (COMBINE) {
#pragma unroll
                for (int i = 0; i < RB; ++i)
#pragma unroll
                    for (int h = 0; h < 2; ++h) { ya[i][h] = *(const u32x4*)(Ym + (size_t)cp[i][0] * DM + 512 * h + 8 * lane); yc[i][h] = *(const u32x4*)(Ym + (size_t)cp[i][1] * DM + 512 * h + 8 * lane); }
            }
            if (r0 + RB < 32) ROW_LOAD(rowb + RB);
            if (COMBINE) {
#pragma unroll
                for (int i = 0; i < RB; ++i) {
                    const int row = rowb + i; const float w0 = cw[i][0], w1 = cw[i][1];
#pragma unroll
                    for (int h = 0; h < 2; ++h) { const u32x4 a = ya[i][h], c = yc[i][h];
                        const f32x4 m0 = {w0 * bf_lo(a.x) + w1 * bf_lo(c.x), w0 * bf_hi(a.x) + w1 * bf_hi(c.x), w0 * bf_lo(a.y) + w1 * bf_lo(c.y), w0 * bf_hi(a.y) + w1 * bf_hi(c.y)};
                        const f32x4 m1 = {w0 * bf_lo(a.z) + w1 * bf_lo(c.z), w0 * bf_hi(a.z) + w1 * bf_hi(c.z), w0 * bf_lo(a.w) + w1 * bf_lo(c.w), w0 * bf_hi(a.w) + w1 * bf_hi(c.w)};
                        v[i][2 * h] = v[i][2 * h] + g2[2 * h] * m0; v[i][2 * h + 1] = v[i][2 * h + 1] + g2[2 * h + 1] * m1;
                        if (OUTF32) { *(f32x4*)(outf + (size_t)row * DM + 512 * h + 8 * lane) = v[i][2 * h]; *(f32x4*)(outf + (size_t)row * DM + 512 * h + 8 * lane + 4) = v[i][2 * h + 1]; }
                        else *(u32x4*)(xb + (size_t)row * DM + 512 * h + 8 * lane) = pg8::pack8(v[i][2 * h], v[i][2 * h + 1]); }
                }
            }
            if (NORM) {
                float ss[RB];
#pragma unroll
                for (int i = 0; i < RB; ++i) { ss[i] = 0.f;
#pragma unroll
                    for (int j = 0; j < 4; ++j) { const f32x4 q = v[i][j] * v[i][j]; ss[i] += (q[0] + q[1]) + (q[2] + q[3]); } }
#pragma unroll
                for (int o = 1; o < 64; o <<= 1)
#pragma unroll
                    for (int i = 0; i < RB; ++i) ss[i] += shx(ss[i], o, lane);
#pragma unroll
                for (int i = 0; i < RB; ++i) { const float rstd = __builtin_amdgcn_rsqf(ss[i] * (1.0f / DM) + 1e-6f);
#pragma unroll
                    for (int h = 0; h < 2; ++h) *(u32x4*)(Hh + (size_t)(rowb + i) * DM + 512 * h + 8 * lane) = pg8::pack8(v[i][2 * h] * rstd * pre[2 * h] + shv[2 * h], v[i][2 * h + 1] * rstd * pre[2 * h + 1] + shv[2 * h + 1]); }
            }
        }
#undef ROW_LOAD
        if (ROUTER) {
            __syncthreads();
            const int row0 = chunk * 256 + wave * 32;
            f32x4 ra[2][2];
#pragma unroll
            for (int mt = 0; mt < 2; ++mt)
#pragma unroll
                for (int et = 0; et < 2; ++et) ra[mt][et] = (f32x4){0.f, 0.f, 0.f, 0.f};
#pragma unroll 4
            for (int kk = 0; kk < 32; ++kk) {
                bf16x8 a[2], bb[2];
#pragma unroll
                for (int mt = 0; mt < 2; ++mt) a[mt] = *(const bf16x8*)(Hh + (size_t)(row0 + 16 * mt + (lane & 15)) * DM + 32 * kk + 8 * (lane >> 4));
#pragma unroll
                for (int et = 0; et < 2; ++et) bb[et] = *(const bf16x8*)(Wr + (size_t)(16 * et + (lane & 15)) * DM + 32 * kk + 8 * (lane >> 4));
#pragma unroll
                for (int mt = 0; mt < 2; ++mt)
#pragma unroll
                    for (int et = 0; et < 2; ++et) ra[mt][et] = __builtin_amdgcn_mfma_f32_16x16x32_bf16(a[mt], bb[et], ra[mt][et], 0, 0, 0);
            }
#pragma unroll
            for (int mt = 0; mt < 2; ++mt)
#pragma unroll
                for (int et = 0; et < 2; ++et)
#pragma unroll
                    for (int r = 0; r < 4; ++r) lgs[(wave * 32 + 16 * mt + 4 * (lane >> 4) + r) * 33 + 16 * et + (lane & 15)] = ra[mt][et][r];
            asm volatile("s_waitcnt lgkmcnt(0)" ::: "memory");
            if (lane < 32) {
                const int tl = wave * 32 + lane, tok = chunk * 256 + tl;
                float lg[32]; float M = -3.0e38f;
#pragma unroll
                for (int e = 0; e < 32; ++e) { lg[e] = lgs[tl * 33 + e]; M = fmaxf(M, lg[e]); }
                float bm1 = 0.f, bm2 = 0.f, bsc = -1.f; int bi1 = 0, bi2 = 0, bg = 0;
#pragma unroll
                for (int g = 0; g < 4; ++g) {
                    float m1 = -3.0e38f, m2 = -3.0e38f; int i1 = 0, i2 = 0;
#pragma unroll
                    for (int j = 0; j < 8; ++j) { const float vv = lg[8 * g + j];
                        if (vv > m1) { m2 = m1; i2 = i1; m1 = vv; i1 = j; } else if (vv > m2) { m2 = vv; i2 = j; } }
                    const float sc = expf(m1 - M) + expf(m2 - M);
                    if (sc > bsc) { bsc = sc; bg = g; bm1 = m1; bm2 = m2; bi1 = i1; bi2 = i2; }
                }
                const int e0 = 8 * bg + bi1, e1 = 8 * bg + bi2;
                const float w0 = 1.0f / (1.0f + expf(bm2 - bm1)), w1 = 1.0f - w0;
                const int r0 = __hip_atomic_fetch_add(&lcnt[e0], 1, __ATOMIC_RELAXED, __HIP_MEMORY_SCOPE_WORKGROUP);
                const int r1 = __hip_atomic_fetch_add(&lcnt[e1], 1, __ATOMIC_RELAXED, __HIP_MEMORY_SCOPE_WORKGROUP);
                Te[2 * tok] = e0; Te[2 * tok + 1] = e1; Trk[2 * tok] = r0; Trk[2 * tok + 1] = r1; Tw[2 * tok] = w0; Tw[2 * tok + 1] = w1;
            }
            __syncthreads();
            if (tid < 32) Cnt[chunk * 32 + tid] = lcnt[tid];
            __syncthreads();
        }
    }
}

#define x_in ((const float*)(const GAS float*)args.in[0])
#define c_in ((const float*)(const GAS float*)args.in[1])
#define w_ada ((const float*)(const GAS float*)args.in[2])
#define b_ada ((const float*)(const GAS float*)args.in[3])
#define g_mix ((const float*)(const GAS float*)args.in[4])
#define w_in ((const float*)(const GAS float*)args.in[5])
#define qn_a ((const float*)(const GAS float*)args.in[6])
#define kn_a ((const float*)(const GAS float*)args.in[7])
#define qn_b ((const float*)(const GAS float*)args.in[8])
#define kn_b ((const float*)(const GAS float*)args.in[9])
#define w_pa ((const float*)(const GAS float*)args.in[10])
#define w_pb ((const float*)(const GAS float*)args.in[11])
#define w_out ((const float*)(const GAS float*)args.in[12])
#define g_ffn ((const float*)(const GAS float*)args.in[13])
#define w_router ((const float*)(const GAS float*)args.in[14])
#define w_gate ((const float*)(const GAS float*)args.in[15])
#define w_up ((const float*)(const GAS float*)args.in[16])
#define w_down ((const float*)(const GAS float*)args.in[17])
#define MOD ((float*)(GAS float*)(ws + WS_MOD))
#define XB ((bf16_t*)(GAS bf16_t*)(ws + WS_XB))
#define TE ((int*)(GAS int*)(ws + WS_TE))
#define TRK ((int*)(GAS int*)(ws + WS_TRK))
#define TW ((float*)(GAS float*)(ws + WS_TW))
#define POS ((int*)(GAS int*)(ws + WS_POS))
#define CNT ((int*)(GAS int*)(ws + WS_CNT))
#define BLKE ((int*)(GAS int*)(ws + WS_BLKE))
#define BTOK ((int*)(GAS int*)(ws + WS_BTOK))
#define WR ((bf16_t*)(bf16_t*)(GAS bf16_t*)(ws + WS_WR))
#define H ((bf16_t*)(bf16_t*)(GAS bf16_t*)(ws + WS_H))
#define YAB ((bf16_t*)(GAS bf16_t*)(ws + WS_H))
#define YA ((bf16_t*)(bf16_t*)(GAS bf16_t*)(ws + WS_H))
#define YB ((bf16_t*)(bf16_t*)(GAS bf16_t*)(ws + WS_H + 64 * MiB))
#define QA ((bf16_t*)(bf16_t*)(GAS bf16_t*)(ws + WS_QKV))
#define KA ((bf16_t*)(bf16_t*)(GAS bf16_t*)(ws + WS_QKV + 64 * MiB))
#define VA ((bf16_t*)(bf16_t*)(GAS bf16_t*)(ws + WS_QKV + 128 * MiB))
#define QB ((bf16_t*)(bf16_t*)(GAS bf16_t*)(ws + WS_QKV + 192 * MiB))
#define KB ((bf16_t*)(bf16_t*)(GAS bf16_t*)(ws + WS_QKV + 256 * MiB))
#define VB ((bf16_t*)(bf16_t*)(GAS bf16_t*)(ws + WS_QKV + 272 * MiB))
#define MERGED ((bf16_t*)(bf16_t*)(GAS bf16_t*)(ws + WS_QKV))
#define YM ((bf16_t*)(bf16_t*)(GAS bf16_t*)(ws + WS_QKV))
#define SA ((bf16_t*)(bf16_t*)(GAS bf16_t*)(ws + WS_GATE))
#define SB ((bf16_t*)(bf16_t*)(GAS bf16_t*)(ws + WS_GATE + 128 * MiB))
#define ACT ((bf16_t*)(bf16_t*)(GAS bf16_t*)(ws + WS_GATE))
#define PHASE_ENTER() int lane; asm volatile("v_mbcnt_lo_u32_b32 %0, -1, 0\n\tv_mbcnt_hi_u32_b32 %0, -1, %0" : "=v"(lane)); const int tid = wave * 64 + lane; GAS unsigned char* ws = ws0; int bx = bx0, vcu = vcu0; asm volatile("" : "+s"(ws), "+s"(bx), "+s"(vcu))

__device__ __forceinline__ bool in_phase(int lo, int hi, int k) { asm volatile("" : "+s"(lo), "+s"(hi)); return lo <= k && k < hi; }
#define PGATE_A SA
#define PGATE_B SB
__global__ void __launch_bounds__(512, 2) fwd_kernel(Args args) {
    extern __shared__ __attribute__((aligned(16))) unsigned char lds_raw[];
    LAS unsigned char* lds = (LAS unsigned char*)lds_raw;
    volatile LAS unsigned* MISC = (volatile LAS unsigned*)(lds + MISC_OFF);
    const int tid0 = threadIdx.x, lane0 = tid0 & 63, wave = __builtin_amdgcn_readfirstlane(tid0 >> 6);
    const int G = gridDim.x, bx0 = blockIdx.x;
    const int vcu0 = (G % 8 == 0) ? (bx0 % 8) * (G / 8) + bx0 / 8 : bx0;
    GAS unsigned char* ws0 = (GAS unsigned char*)args.ws;
    float* out = (float*)(GAS float*)args.out;
    for (int u = tid0; u < 256; u += 512) ((LAS unsigned*)(lds + MISC_OFF))[u] = 0u;
    __syncthreads();
#if MK_ONE_LAUNCH
    XcdBarrier bar = xcd_barrier_post((unsigned*)((GAS unsigned*)(ws0 + WS_CTL) + CW_BAR), MISC + 8);
#define GRID_BAR() do { int l_; asm volatile("v_mbcnt_lo_u32_b32 %0, -1, 0\n\tv_mbcnt_hi_u32_b32 %0, -1, %0" : "=v"(l_)); xcd_barrier(bar, (wave == 0) && (l_ == 0)); } while (0)
#else
#define GRID_BAR() do {} while (0)
#endif
#ifndef PHMASK
#define PHMASK 0xFFFFFFFFu
#endif
#if MK_ONE_LAUNCH
#define IN(k) true
#else
#define IN(k) in_phase(args.ph_lo, args.ph_hi, (k))
#endif
#define EN(bit) ((PHMASK >> (bit)) & 1u)
#define SEAM(k) do { if (IN(k) && IN((k) + 1)) GRID_BAR(); } while (0)

    if (EN(0) && IN(PH_PRO)) {
        PHASE_ENTER();
#pragma unroll 1
        for (int rep = 0; rep < REP_PRO; ++rep) {
        LAS float* scr = (LAS float*)(lds + wave * 16640);
        const int gw = vcu * 8 + wave, NGW = G * 8;
        constexpr int I_IN = 68 * 16, I_PA = 16 * 8, I_OUT = 16 * 16, I_GU = 32 * 2 * 8 * 16, I_DN = 32 * 16 * 8;
        constexpr int I_LAYER = I_IN + 2 * I_PA + I_OUT + I_GU + I_DN;
        for (int it = gw; it < 2 * I_LAYER; it += NGW) {
            const int l = it / I_LAYER; int r = it % I_LAYER;
            if (r < I_IN) { const int nb = r / 16, kb = r % 16;
                transpose_item<1>(w_in + (size_t)l * DM * NC, NC, 64 * nb, (bf16_t*)(GAS bf16_t*)(ws + WS_WIN + l * WIN_BYTES), 64 * nb, DM, 64 * kb, scr, lane); continue; } r -= I_IN;
            if (r < I_PA) { const int nb = r / 8, kb = r % 8;
                transpose_item<2>(w_pa + (size_t)l * 512 * DM, DM, 64 * nb, (bf16_t*)(GAS bf16_t*)(ws + WS_WPA + l * 2 * MiB), 64 * nb, DM, 64 * kb, scr, lane, 0); continue; } r -= I_PA;
            if (r < I_PA) { const int nb = r / 8, kb = r % 8;
                transpose_item<2>(w_pb + (size_t)l * 512 * DM, DM, 64 * nb, (bf16_t*)(GAS bf16_t*)(ws + WS_WPA + l * 2 * MiB), 64 * nb, DM, 64 * kb, scr, lane, 512); continue; } r -= I_PA;
            if (r < I_OUT) { const int nb = r / 16, kb = r % 16;
                transpose_item<2>(w_out + (size_t)l * DM * DM, DM, 64 * nb, (bf16_t*)(GAS bf16_t*)(ws + WS_WOUT + l * 2 * MiB), 64 * nb, DM, 64 * kb, scr, lane); continue; } r -= I_OUT;
            if (r < I_GU) { const int e = r / 256, q = r % 256, up = q / 128, nb = (q % 128) / 16, kb = q % 16;
                const float* src = (up ? w_up : w_gate) + ((size_t)l * NEXP + e) * DM * DFF;
                const int c0 = 64 * nb, drow = 256 * (c0 >> 7) + 128 * up + (c0 & 127);
                transpose_item<0>(src, DFF, c0, (bf16_t*)(GAS bf16_t*)(ws + WS_WGU + ((size_t)l * NEXP + e) * 2 * MiB), drow, DM, 64 * kb, scr, lane); continue; } r -= I_GU;
            { const int e = r / 128, q = r % 128, nb = q / 8, kb = q % 8;
                transpose_item<2>(w_down + ((size_t)l * NEXP + e) * DFF * DM, DM, 64 * nb, (bf16_t*)(GAS bf16_t*)(ws + WS_WDN + ((size_t)l * NEXP + e) * MiB), 64 * nb, DFF, 64 * kb, scr, lane); }
        }
        for (int i = (vcu * 512 + tid); i < 32 * DM; i += G * 512) { const int e = i >> 10, k = i & 1023; WR[i] = (bf16_t)(cvt_pk_bf16(w_router[(size_t)k * NEXP + e], 0.f) & 0xffffu); }
        __syncthreads();
        if (vcu * 8 < 384) {
            LAS float* cond = (LAS float*)lds;
            for (int i = tid; i < NB * DM; i += 512) { const int b = i >> 10, k = i & 1023; const float cv = c_in[i]; cond[k * 32 + b] = cv / (1.0f + expf(-cv)); }
            __syncthreads();
            for (int it = gw; it < 384; it += NGW) {
                const int l = it / 192, n0 = (it % 192) * 32;
                const float* wp = w_ada + (size_t)l * DM * MODW + n0 + (lane & 31) + (size_t)(lane >> 5) * MODW;
                const LAS float* cp = cond + (lane >> 5) * 32 + (lane & 31);
                f32x16 acc;
#pragma unroll
                for (int r = 0; r < 16; ++r) acc[r] = 0.f;
#pragma unroll 16
                for (int k0 = 0; k0 < DM; k0 += 2) acc = __builtin_amdgcn_mfma_f32_32x32x2f32(cp[k0 * 32], wp[(size_t)k0 * MODW], acc, 0, 0, 0);
                const float bias = b_ada[l * MODW + n0 + (lane & 31)];
#pragma unroll
                for (int r = 0; r < 16; ++r) { const int b = (r & 3) + 8 * (r >> 2) + 4 * (lane >> 5); MOD[((size_t)l * NB + b) * MODW + n0 + (lane & 31)] = acc[r] + bias; }
            }
        }
        __syncthreads();
        }
    }
    SEAM(PH_PRO);

    for (int l = 0; l < 2; ++l) {
        const int pb = PH_L0 + l * PH_PER_LAYER;
        if (EN(1) && IN(pb + P_NORM1)) { PHASE_ENTER(); const float* modl = MOD + (size_t)l * NB * MODW;
            if (l == 0) {
#pragma unroll 1
                for (int rep = 0; rep < REP_NORM1; ++rep)
                    row_phase<true, false, true, false, false>(lds, tid, lane, wave, G, bx, x_in, XB, out, g_mix, modl, 0, DM, MOD, H, YM, POS, TW, WR, TE, TRK, CNT);
            } else row_phase<false, true, true, false, false>(lds, tid, lane, wave, G, bx, x_in, XB, out, g_mix + DM, modl, 0, DM, MOD, H, YM, POS, TW, WR, TE, TRK, CNT); }
            {
                SEAM(pb + P_NORM1);
                if (EN(2) && IN(pb + P_INPROJ)) {
                    PHASE_ENTER();
                    pg8::Gemm g{H, (const bf16_t*)(const GAS bf16_t*)(ws + WS_WIN + l * WIN_BYTES), DM}; pg8::StaticOrder S; S.init(TT, NC, G, bx); S.wgm = INPROJ_WGM;
                    LAS float* normw = (LAS float*)(lds + MISC_OFF + 1024);
                    if (tid < 256) { const int sel = tid >> 6, d = tid & 63; const float* srcw = (sel == 0) ? qn_a : (sel == 1) ? kn_a : (sel == 2) ? qn_b : kn_b; normw[tid] = srcw[l * 64 + d]; }
                    __syncthreads();
                    pg8::EpiInProj E{QA, KA, VA, QB, KB, VB, SA, SB, normw};
#pragma unroll 1
                    for (int rep = 0; rep < REP_INPROJ; ++rep)
                    pg8::gemm_phase<pg8::EpiInProj, pg8::StaticOrder>(lds, g, S, E, wave);
                }
                SEAM(pb + P_INPROJ);
                if (EN(3) && IN(pb + P_ATTN)) {
                    PHASE_ENTER(); (void)lane;
                    LAS char* ring = (LAS char*)lds;
#pragma unroll 1
                    for (int rep = 0; rep < REP_ATTB; ++rep)
                    for (int L = vcu; L < NB * 32; L += G) {
                        int lane; asm volatile("v_mbcnt_lo_u32_b32 %0, -1, 0\n\tv_mbcnt_hi_u32_b32 %0, -1, %0" : "=v"(lane)); const int hi = lane >> 5;
                        const int b = L >> 5, kvh = (L >> 4) & 1, qh = 4 * kvh + ((L >> 2) & 3), qb2 = L & 3;
                        const int tq0 = 512 * qb2 + 64 * wave + (lane & 31);
                        bf16x8 qr[2][4];
#pragma unroll
                        for (int g = 0; g < 2; ++g)
#pragma unroll
                            for (int d0 = 0; d0 < 4; ++d0) qr[g][d0] = *(const bf16x8*)(QB + ((size_t)b * SEQ + tq0 + 32 * g) * 512 + qh * 64 + 16 * d0 + 8 * hi);
                        f32x16 o[2][2]; float lsum[2] = {0.f, 0.f};
#pragma unroll
                        for (int r = 0; r < 16; ++r) { o[0][0][r] = 0.f; o[0][1][r] = 0.f; o[1][0][r] = 0.f; o[1][1][r] = 0.f; }
                        __syncthreads();
                        att::dense64_lag_loop(ring, KB + (size_t)b * SEQ * 128 + kvh * 64, VB + (size_t)b * SEQ * 128 + kvh * 64, 128, 32, qr, o, lsum, lane, wave, wave >= 4);
                        { int l2; asm volatile("v_mbcnt_lo_u32_b32 %0, -1, 0\n\tv_mbcnt_hi_u32_b32 %0, -1, %0" : "=v"(l2)); const int tqs = 512 * qb2 + 64 * wave + (l2 & 31);
#pragma unroll
                          for (int g = 0; g < 2; ++g) att::store_out(o[g], lsum[g], YAB + ((size_t)b * SEQ + tqs + 32 * g) * DM + 512 + qh * 64, l2); }
                    }
#pragma unroll 1
                    for (int rep = 0; rep < REP_ATTA; ++rep)
                    for (int L = vcu; L < NB * 32; L += G) {
                        int lane; asm volatile("v_mbcnt_lo_u32_b32 %0, -1, 0\n\tv_mbcnt_hi_u32_b32 %0, -1, %0" : "=v"(lane)); const int hi = lane >> 5;
                        const int b = L >> 5, h = (L >> 2) & 7, tb2 = L & 3, base = 512 * tb2;
                        const int tq0 = base + 16 * (lane & 31) + wave, tq1 = tq0 + 8;
                        const bf16_t* Kg = KA + (size_t)b * SEQ * 512 + h * 64; const bf16_t* Vg = VA + (size_t)b * SEQ * 512 + h * 64;
                        bf16x8 qr[2][4];
#pragma unroll
                        for (int g = 0; g < 2; ++g)
#pragma unroll
                            for (int d0 = 0; d0 < 4; ++d0) qr[g][d0] = *(const bf16x8*)(QA + ((size_t)b * SEQ + tq0 + 8 * g) * 512 + h * 64 + 16 * d0 + 8 * hi);
                        f32x16 o[2][2]; float lsum[2] = {0.f, 0.f};
#pragma unroll
                        for (int r = 0; r < 16; ++r) { o[0][0][r] = 0.f; o[0][1][r] = 0.f; o[1][0][r] = 0.f; o[1][1][r] = 0.f; }
                        __syncthreads();
                        att::dense64_loop<true>(ring, Kg, Vg, 512, base - 64, 10, qr, o, lsum, tq0, tq1, lane, wave);
                        __syncthreads();
                        {
                            LAS char* vpriv = ring + att::PRIV_OFF + wave * att::VTILE;
#define A_TK0(j) ((j) < 4 ? base + wave - 256 + 256 * (j) : wave + 8 * (((j) - 4) >> 1) + 1024 * (((j) - 4) & 1))
#define A_DK(j) ((j) < 4 ? 4 : 16)
                            bf16x8 kf[8];
                            att::priv_kload(kf, Kg, 512, A_TK0(0), 4, lane);
#pragma unroll 1
                            for (int j = 0; j < 8; ++j) {
                                const bool p2 = j < 4; const int g = (j - 4) >> 1;
                                att::priv2_step(kf, vpriv, Kg, Vg, 512, A_TK0(j), A_DK(j), p2 || g == 0, p2 || g == 1, j + 1 < 8, A_TK0(j + 1), A_DK(j + 1), qr, o, lsum, tq0, tq1, lane);
                            }
#undef A_TK0
#undef A_DK
                        }
                        { int l2; asm volatile("v_mbcnt_lo_u32_b32 %0, -1, 0\n\tv_mbcnt_hi_u32_b32 %0, -1, %0" : "=v"(l2)); const int tqs = base + 16 * (l2 & 31) + wave;
#pragma unroll
                          for (int g = 0; g < 2; ++g) att::store_out(o[g], lsum[g], YAB + ((size_t)b * SEQ + tqs + 8 * g) * DM + h * 64, l2); }
                    }
                    __syncthreads();
                }
                SEAM(pb + P_ATTN);
                if (EN(4) && IN(pb + P_PAB)) {
                    PHASE_ENTER();
                    pg8::StaticOrder S; S.init(TT, DM, G, bx); S.wgm = N1K_WGM;
                    pg8::Gemm g{YAB, (const bf16_t*)(const GAS bf16_t*)(ws + WS_WPA + l * 2 * MiB), DM}; pg8::EpiMergeFused E{MERGED, (const unsigned char*)PGATE_A, (const unsigned char*)PGATE_B};
#pragma unroll 1
                    for (int rep = 0; rep < REP_PAB; ++rep)
                    pg8::gemm_phase<pg8::EpiMergeFused, pg8::StaticOrder>(lds, g, S, E, wave);
                }
                SEAM(pb + P_PAB);
                if (EN(5) && IN(pb + P_OUT)) {
                    PHASE_ENTER(); const float* modl = MOD + (size_t)l * NB * MODW;
                    pg8::Gemm g{MERGED, (const bf16_t*)(const GAS bf16_t*)(ws + WS_WOUT + l * 2 * MiB), DM}; pg8::StaticOrder S; S.init(TT, DM, G, bx); S.rowmajor = OUT_ROWMAJOR; S.wgm = N1K_WGM;
                    pg8::EpiResidB E{(l == 0) ? x_in : (const float*)nullptr, XB, XB, modl + 2 * DM};
#pragma unroll 1
                    for (int rep = 0; rep < ((l == 0) ? REP_OUT : 1); ++rep)
                    pg8::gemm_phase<pg8::EpiResidB, pg8::StaticOrder>(lds, g, S, E, wave);
                }
                SEAM(pb + P_OUT);
            }
        if (EN(6) && IN(pb + P_NORM2)) { PHASE_ENTER(); const float* modl = MOD + (size_t)l * NB * MODW;
#pragma unroll 1
            for (int rep = 0; rep < REP_NORM2; ++rep)
            row_phase<false, false, true, true, false>(lds, tid, lane, wave, G, bx, x_in, XB, out, g_ffn + l * DM, modl, 3 * DM, 4 * DM, MOD, H, YM, POS, TW, WR, TE, TRK, CNT); }
        SEAM(pb + P_NORM2);
        if (EN(7) && IN(pb + P_PLACE)) {
            PHASE_ENTER();
            LAS int* part_tot = (LAS int*)lds;
            LAS int* part_pre = part_tot + 512;
            LAS int* basee = part_pre + 512;
            LAS int* pstart = basee + 32;
            LAS int* pend = pstart + 32;
            LAS int* tote = pend + 32;
            for (int chunk = bx; chunk < 256; chunk += G) {
                { const int e = tid & 31, part = tid >> 5; int st = 0, sp = 0;
                    for (int q = 0; q < 16; ++q) { const int ch = part * 16 + q; const int v = CNT[ch * 32 + e]; st += v; sp += (ch < chunk) ? v : 0; }
                    part_tot[part * 32 + e] = st; part_pre[part * 32 + e] = sp; }
                __syncthreads();
                if (tid < 32) { int st = 0, sp = 0; for (int q = 0; q < 16; ++q) { st += part_tot[q * 32 + tid]; sp += part_pre[q * 32 + tid]; } tote[tid] = st; basee[tid] = sp; }
                __syncthreads();
                if (tid == 0) { int run = 0; for (int e = 0; e < 32; ++e) { const int padded = (tote[e] + 255) & ~255; pstart[e] = run; basee[e] += run; run += padded; pend[e] = run; } }
                __syncthreads();
                { const int tok = chunk * 256 + (tid >> 1), slot = tid & 1; const int e = TE[2 * tok + slot], rk = TRK[2 * tok + slot]; const int dest = basee[e] + rk;
                    BTOK[dest] = tok; POS[2 * tok + slot] = dest; }
                if (chunk < 32) { const int e = chunk; const int from = pstart[e] + tote[e], n = pend[e] - from; if (tid < n) BTOK[from + tid] = 0; }
                if (chunk == 0) {
                    for (int blk = tid; blk < NBLK; blk += 512) { int e = 0; for (int q = 0; q < 32; ++q) e += (pend[q] <= blk * 256) ? 1 : 0; BLKE[blk] = e > 31 ? 31 : e; }
                    if (tid == 0) BLKE[1000] = pend[31] >> 8;
                }
                __syncthreads();
            }
        }
        SEAM(pb + P_PLACE);
        if (EN(8) && IN(pb + P_GU)) {
            PHASE_ENTER();
            const int nused = BLKE[1000];
            pg8::Gemm g{H, (const bf16_t*)(const GAS bf16_t*)(ws + WS_WGU + (size_t)l * NEXP * 2 * MiB), DM};
            pg8::MoeOrder S{BLKE, BTOK, 4 * nused, G, vcu};
            pg8::EpiSwiGLU E{ACT};
#pragma unroll 1
            for (int rep = 0; rep < REP_GU; ++rep)
            pg8::gemm_phase<pg8::EpiSwiGLU, pg8::MoeOrder>(lds, g, S, E, wave);
        }
        SEAM(pb + P_GU);
        if (EN(9) && IN(pb + P_DOWN)) {
            PHASE_ENTER();
            const int nused = BLKE[1000];
            pg8::Gemm g{ACT, (const bf16_t*)(const GAS bf16_t*)(ws + WS_WDN + (size_t)l * NEXP * MiB), DFF};
            pg8::MoeOrder S{BLKE, nullptr, 4 * nused, G, vcu};
            pg8::EpiY E{YM};
#pragma unroll 1
            for (int rep = 0; rep < REP_DOWN; ++rep)
            pg8::gemm_phase<pg8::EpiY, pg8::MoeOrder>(lds, g, S, E, wave);
        }
        SEAM(pb + P_DOWN);
    }
    if (EN(10) && IN(PH_FINAL)) {
        PHASE_ENTER();
        row_phase<false, true, false, false, true>(lds, tid, lane, wave, G, bx, x_in, XB, out, g_ffn, MOD, 0, 0, MOD + (size_t)NB * MODW, H, YM, POS, TW, WR, TE, TRK, CNT);
    }
#undef IN
#undef SEAM
#undef GRID_BAR
}

extern "C" void kernel_launch(void* const* d_in, const int* in_sizes, int n_in, void* d_out, int out_size, void* d_ws, size_t ws_size, hipStream_t stream) {
    static int grid = 0;
    if (grid == 0) {
        if (n_in != 18 || in_sizes[0] != TT * DM || out_size != TT * DM || ws_size < WS_END) { fprintf(stderr, "kernel_launch: unexpected shapes / workspace (n_in %d, ws %zu); nothing launched\n", n_in, ws_size); grid = -1; return; }
        int dev = 0, cus = 0, per_cu = 0;
        if (hipGetDevice(&dev) != hipSuccess || hipDeviceGetAttribute(&cus, hipDeviceAttributeMultiprocessorCount, dev) != hipSuccess) { grid = -1; return; }
        if (hipFuncSetAttribute((const void*)fwd_kernel, hipFuncAttributeMaxDynamicSharedMemorySize, LDS_BYTES) != hipSuccess) { fprintf(stderr, "kernel_launch: hipFuncSetAttribute failed\n"); grid = -1; return; }
        if (hipOccupancyMaxActiveBlocksPerMultiprocessor(&per_cu, (const void*)fwd_kernel, 512, LDS_BYTES) != hipSuccess || per_cu < 1) { fprintf(stderr, "kernel_launch: occupancy query says %d\n", per_cu); per_cu = 1; }
        (void)hipGetLastError();
        grid = cus;
    }
    if (grid < 0) return;
    (void)hipMemsetAsync((char*)d_ws + WS_CTL, 0, CTL_ZERO_BYTES, stream);
    Args a{};
    for (int i = 0; i < 18; ++i) a.in[i] = (const float*)d_in[i];
    a.out = (float*)d_out; a.ws = (unsigned char*)d_ws;
#if MK_ONE_LAUNCH
    a.ph_lo = 0; a.ph_hi = NPH;
    hipLaunchKernelGGL(fwd_kernel, dim3(grid), dim3(512), LDS_BYTES, stream, a);
#else
    for (int p = 0; p < NPH; ++p) { a.ph_lo = p; a.ph_hi = p + 1; hipLaunchKernelGGL(fwd_kernel, dim3(grid), dim3(512), LDS_BYTES, stream, a); }
#endif
}
```

```cpp
#include <hip/hip_runtime.h>
#include <cstdio>
#include <cstdint>

#ifndef INPROJ_WGM
#define INPROJ_WGM 4
#endif
#ifndef GEMM_ALIGN
#define GEMM_ALIGN 1
#endif
#ifndef ROWB
#define ROWB 4
#endif
#ifndef N1K_WGM
#define N1K_WGM 8
#endif
#ifndef OUT_ROWMAJOR
#define OUT_ROWMAJOR 0
#endif
#ifndef REP_PRO
#define REP_PRO 1
#endif
#ifndef REP_ATTB
#define REP_ATTB 1
#endif
#ifndef REP_ATTA
#define REP_ATTA 1
#endif
#ifndef REP_INPROJ
#define REP_INPROJ 1
#endif
#ifndef REP_NORM1
#define REP_NORM1 1
#endif
#ifndef REP_GU
#define REP_GU 1
#endif
#ifndef REP_PAB
#define REP_PAB 1
#endif
#ifndef REP_OUT
#define REP_OUT 1
#endif
#ifndef REP_DOWN
#define REP_DOWN 1
#endif
#ifndef REP_NORM2
#define REP_NORM2 1
#endif
#ifndef MK_ONE_LAUNCH
#define MK_ONE_LAUNCH 1
#endif

#define LAS __attribute__((address_space(3)))
#define GAS __attribute__((address_space(1)))
typedef unsigned short bf16_t;
typedef short bf16x8 __attribute__((ext_vector_type(8)));
typedef short s16x4 __attribute__((ext_vector_type(4)));
typedef float f32x4 __attribute__((ext_vector_type(4)));
typedef float f32x16 __attribute__((ext_vector_type(16)));
typedef unsigned u32x4 __attribute__((ext_vector_type(4)));
typedef unsigned u32x2 __attribute__((ext_vector_type(2)));

constexpr int NB = 32, SEQ = 2048, DM = 1024, TT = NB * SEQ;
constexpr int NC = 4352;
constexpr int NEXP = 32, DFF = 512, NPAD = 139264, NBLK = 544;
constexpr int MODW = 6 * DM;
constexpr float QSCALE = 0.125f * 1.4426950408889634f;

constexpr size_t MiB = 1u << 20;
constexpr size_t WS_CTL = 0, CTL_ZERO_BYTES = 64 * 1024;
constexpr size_t WS_MOD = 1 * MiB;
constexpr size_t WS_TE = 2 * MiB + 512 * 1024, WS_TRK = 3 * MiB, WS_TW = 3 * MiB + 512 * 1024, WS_POS = 4 * MiB;
constexpr size_t WS_CNT = 4 * MiB + 512 * 1024;
constexpr size_t WS_BLKE = WS_CNT + 64 * 1024;
constexpr size_t WS_BTOK = WS_CNT + 128 * 1024;
constexpr size_t WS_WR = 5 * MiB + 256 * 1024;
constexpr size_t WS_WIN = 6 * MiB;
constexpr size_t WIN_BYTES = (size_t)NC * DM * 2;
constexpr size_t WS_WPA = 23 * MiB, WS_WPB = 25 * MiB, WS_WOUT = 27 * MiB;
constexpr size_t WS_WGU = 31 * MiB;
constexpr size_t WS_WDN = 159 * MiB;
constexpr size_t WS_H = 223 * MiB;
constexpr size_t WS_QKV = 351 * MiB;
constexpr size_t WS_GATE = 639 * MiB;
constexpr size_t WS_XB = 896 * MiB;
constexpr size_t WS_END = 1024 * MiB;
constexpr int CW_BAR = 4096;

constexpr int RING_BYTES = 133120;
constexpr int MISC_OFF = RING_BYTES;
constexpr int LDS_BYTES = 147456;

#define RLX_AGENT __ATOMIC_RELAXED, __HIP_MEMORY_SCOPE_AGENT
typedef float f32x2_t __attribute__((ext_vector_type(2))); typedef __bf16 bf16x2_t __attribute__((ext_vector_type(2)));
__device__ __forceinline__ unsigned cvt_pk_bf16(float lo, float hi) { const f32x2_t v = {lo, hi}; const bf16x2_t b = __builtin_convertvector(v, bf16x2_t); return __builtin_bit_cast(unsigned, b); }
typedef float f32x2v __attribute__((ext_vector_type(2)));
__device__ __forceinline__ unsigned pack4_fp8(float a, float b, float c, float d) { unsigned w = 0; w = __builtin_amdgcn_cvt_pk_fp8_f32(a, b, w, false); w = __builtin_amdgcn_cvt_pk_fp8_f32(c, d, w, true); return w; }
__device__ __forceinline__ void unpack8_fp8(u32x2 w, float (&o)[8]) { const f32x2v a = __builtin_amdgcn_cvt_pk_f32_fp8(w.x, false), b = __builtin_amdgcn_cvt_pk_f32_fp8(w.x, true), c = __builtin_amdgcn_cvt_pk_f32_fp8(w.y, false), d = __builtin_amdgcn_cvt_pk_f32_fp8(w.y, true);
    o[0] = a.x; o[1] = a.y; o[2] = b.x; o[3] = b.y; o[4] = c.x; o[5] = c.y; o[6] = d.x; o[7] = d.y; }
__device__ __forceinline__ float bf_lo(unsigned w) { return __uint_as_float(w << 16); }
__device__ __forceinline__ float bf_hi(unsigned w) { return __uint_as_float(w & 0xffff0000u); }
__device__ __forceinline__ float shx(float v, int mask, int lane) { return __int_as_float(__builtin_amdgcn_ds_bpermute((lane ^ mask) << 2, __float_as_int(v))); }
__device__ __forceinline__ float wave_sum(float v, int lane) {
#pragma unroll
    for (int o = 1; o < 64; o <<= 1) v += shx(v, o, lane);
    return v;
}
__device__ __forceinline__ float wave_max(float v, int lane) {
#pragma unroll
    for (int o = 1; o < 64; o <<= 1) v = fmaxf(v, shx(v, o, lane));
    return v;
}
__device__ __forceinline__ float sigmoid_f(float x) { return __builtin_amdgcn_rcpf(1.0f + __builtin_amdgcn_exp2f(-1.4426950408889634f * x)); }

#define XB_TMO      128
#define XB_XCNT(j)  (256  + 64 * (j))
#define XB_XSUB(j)  (1280 + 64 * (j))
#define XB_XGEN(j)  (2304 + 64 * (j))
#define XB_TOP      3328
#define XB_TOPGEN   3392
#define XCD_BAR_WORDS 3456
#define XB_SPIN_CAP (1u << 18)

__device__ __forceinline__ unsigned xb_ld(unsigned* p)              { return __hip_atomic_load(p, __ATOMIC_RELAXED, __HIP_MEMORY_SCOPE_AGENT); }
__device__ __forceinline__ unsigned xb_add(unsigned* p, unsigned v) { return __hip_atomic_fetch_add(p, v, __ATOMIC_RELAXED, __HIP_MEMORY_SCOPE_AGENT); }
__device__ __forceinline__ unsigned xb_xcc_id() { return (unsigned)__builtin_amdgcn_s_getreg((3 << 11) | 20) & 0xFu; }
#define XB_SPIN(cond, bar) do { unsigned _sp = 0; while (cond) { __builtin_amdgcn_s_sleep(1); \
    if ((++_sp & 255u) == 0u) { if (xb_ld(&(bar)[XB_TMO])) break; if (_sp > XB_SPIN_CAP) { atomicAdd(&(bar)[XB_TMO], 1u); break; } } } } while (0)

struct XcdBarrier { unsigned* bar; unsigned x; volatile LAS unsigned* st; };

__device__ __forceinline__ XcdBarrier xcd_barrier_post(unsigned* bar, volatile LAS unsigned* st) {
    XcdBarrier b; b.bar = bar; b.x = xb_xcc_id(); b.st = st;
    if (threadIdx.x == 0) (void)xb_add(&bar[XB_XCNT(b.x)], 1u);
    return b;
}
__device__ __forceinline__ void xcd_barrier_complete(unsigned* bar, unsigned x, unsigned& nloc, unsigned& nx) {
    const unsigned G = gridDim.x * gridDim.y * gridDim.z;
    unsigned sum, cnt, mine, sp = 0u;
    for (;;) {
        sum = 0u; cnt = 0u; mine = 0u;
#pragma unroll
        for (unsigned j = 0; j < 16; ++j) { const unsigned c = xb_ld(&bar[XB_XCNT(j)]); sum += c; cnt += (c > 0u) ? 1u : 0u; mine = (j == x) ? c : mine; }
        if (sum == G) break;
        __builtin_amdgcn_s_sleep(1);
        if ((++sp & 255u) == 0u) { if (xb_ld(&bar[XB_TMO])) break; if (sp > XB_SPIN_CAP) { atomicAdd(&bar[XB_TMO], 1u); break; } }
    }
    nloc = mine > 0u ? mine : 1u; nx = cnt > 0u ? cnt : 1u;
}
__device__ __forceinline__ void xcd_barrier(const XcdBarrier& b, const bool is_t0  ) {
    asm volatile("s_waitcnt vmcnt(0)" ::: "memory");
    __syncthreads();
    if (is_t0) {
        unsigned* bar = b.bar; unsigned bx_ = b.x;
        asm volatile("" : "+s"(bar), "+s"(bx_));
        __builtin_amdgcn_s_waitcnt(0);
        unsigned nloc = b.st[0], nx = b.st[1];
        if (nloc == 0u) { xcd_barrier_complete(bar, bx_, nloc, nx); b.st[0] = nloc; b.st[1] = nx; }
        const unsigned old = xb_add(&bar[XB_XSUB(bx_)], 1u);
        const unsigned gen = old / nloc;
        if (old + 1u == (gen + 1u) * nloc) {
            __builtin_amdgcn_fence(__ATOMIC_RELEASE, "agent");
            asm volatile("s_waitcnt vmcnt(0)" ::: "memory");
            const unsigned og = xb_add(&bar[XB_TOP], 1u);
            const unsigned tg = og / nx;
            if (og + 1u == (tg + 1u) * nx) xb_add(&bar[XB_TOPGEN], 1u);
            else XB_SPIN(xb_ld(&bar[XB_TOPGEN]) == tg, bar);
            __builtin_amdgcn_fence(__ATOMIC_ACQUIRE, "agent");
            xb_add(&bar[XB_XGEN(bx_)], 1u);
            asm volatile("s_waitcnt vmcnt(0)" ::: "memory");
        } else {
            XB_SPIN(xb_ld(&bar[XB_XGEN(bx_)]) == gen, bar);
            __builtin_amdgcn_fence(__ATOMIC_ACQUIRE, "agent");
            asm volatile("s_waitcnt vmcnt(0)" ::: "memory");
        }
    }
    __syncthreads();
}

namespace pg8 {
constexpr int BM = 256, BK = 64, HALF = 128, HTB = HALF * BK * 2, STAGE_BYTES = 8 * HTB, NXCD = 8, WGM = 8;
__host__ __device__ __forceinline__ int lds_byte(int r, int c) { const int st = (r >> 4) * 2 + (c >> 5), rr = r & 15, cc = c & 31, ob = rr * 64 + cc * 2; return st * 1024 + (ob ^ (((ob >> 9) & 1) << 5)); }
__host__ __device__ __forceinline__ void stage_rc(int b, int& R, int& C) { const int st = b / 1024, sb = b % 1024, swz = sb ^ (((sb >> 9) & 1) << 5); R = (st >> 1) * 16 + swz / 64; C = (st & 1) * 32 + (swz % 64) / 2; }
__host__ __device__ __forceinline__ int perm32(int rho) { const int n = rho >> 4, i = rho & 15; return 8 * (i >> 2) + 4 * n + (i & 3); }

struct Unit { int pm, pn; };
struct Gemm { const bf16_t* A; const bf16_t* Bt; int K; };

struct StaticOrder {
    static constexpr bool GATHER = false;
    int nM, nN, nwg, G, c, wgm = WGM;
    __device__ void init(int M, int N, int G_, int c_) { asm volatile("" : "+s"(c_));     nM = M / BM; nN = N / BM; nwg = nM * nN; G = G_; c = c_; }
    int rowmajor = 0;
    __device__ __forceinline__ bool next(int i, Unit& u) const {
        if (rowmajor) { const int upw = (nwg + G - 1) / G, k = c * upw + i; if (i >= upw || k >= nwg) return false; u.pm = k / nN; u.pn = k % nN; return true; }
        const long L = (long)i * G + c; if (L >= nwg) return false;
        int wgid = (int)L; { const int q = nwg / NXCD, r = nwg % NXCD, xcd = wgid % NXCD, off = wgid / NXCD; wgid = (xcd < r ? xcd * (q + 1) : r * (q + 1) + (xcd - r) * q) + off; }
        const int nig = wgm * nN, gid = wgid / nig, fm = gid * wgm, gsz = (nM - fm) < wgm ? (nM - fm) : wgm;
        u.pm = fm + ((wgid % nig) % gsz); u.pn = (wgid % nig) / gsz; return true;
    }
    __device__ __forceinline__ void aoff(const Unit&, const int (&)[2], const unsigned (&)[2], int, unsigned (&)[2][2]) const {}
};
struct MoeOrder {
    static constexpr bool GATHER = true;
    const int* blk_e; const int* rowidx; int nunits, G, c;
    __device__ __forceinline__ bool next(int i, Unit& u) const {
        const int L = i * G + c; if (L >= nunits) return false;
        const int blk = L >> 2; const int e = blk_e[blk]; u.pm = blk; u.pn = 4 * e + (L & 3); return true;
    }
    __device__ __forceinline__ void aoff(const Unit& u, const int (&RA)[2], const unsigned (&CA2)[2], int K, unsigned (&o)[2][2]) const {
#pragma unroll
        for (int h = 0; h < 2; ++h)
#pragma unroll
            for (int i = 0; i < 2; ++i) { const int r = u.pm * BM + h * HALF + RA[i]; const int src = rowidx ? rowidx[r] : r; o[h][i] = (unsigned)src * (unsigned)(K * 2) + CA2[i]; }
    }
};

template <class Epi, class Sched>
__device__ __forceinline__ void gemm_phase(LAS unsigned char* lds, const Gemm g, const Sched& S, const Epi& E, const int wid) {
    int lane_; asm volatile("v_mbcnt_lo_u32_b32 %0, -1, 0\n\tv_mbcnt_hi_u32_b32 %0, -1, %0" : "=v"(lane_));
    const int lane = lane_, tid = wid * 64 + lane, wr = wid >> 2, wc = wid & 3, fr = lane & 15, fq = lane >> 4;
    const int K = g.K, nt = K / BK;
    unsigned voffA[2], voffB[2], CA2[2]; int RA[2];
#pragma unroll
    for (int i = 0; i < 2; ++i) { int R, C; stage_rc(tid * 16 + i * 8192, R, C); const int Rb = Epi::PERM ? ((R & ~31) + perm32(R & 31)) : R;
        RA[i] = R; CA2[i] = (unsigned)C * 2u; voffA[i] = (unsigned)(R * K + C) * 2u; voffB[i] = (unsigned)(Rb * K + C) * 2u; }
    const size_t kstep = (size_t)(BK * 2);
    const size_t hstep = (size_t)HALF * K * 2;
    const size_t tstep = 2 * hstep;
    const unsigned ldsw = (unsigned)wid * 1024u;
    const int aoff = lds_byte(wr * 64 + fr, fq * 8), boff = lds_byte(wc * 32 + fr, fq * 8);
    const char* Ab = (const char*)g.A;
#define PG8_SA(b, h) (((b) * 2 + (h)) * HTB)
#define PG8_SB(b, h) ((4 + (b) * 2 + (h)) * HTB)
#define PG8_STAGEB(bufoff, gbase, voff) do { _Pragma("unroll") for (int _i = 0; _i < 2; ++_i) \
        __builtin_amdgcn_global_load_lds((const unsigned*)((const char*)(gbase) + (voff)[_i]), (LAS unsigned*)(lds + (bufoff) + ldsw + _i * 8192), 16, 0, 0); } while (0)
#define PG8_STAGEA(bufoff, H_, kb, NEXT) do { if constexpr (Sched::GATHER) { _Pragma("unroll") for (int _i = 0; _i < 2; ++_i) { const unsigned _o = (NEXT) ? na[H_][_i] : ca[H_][_i]; \
            __builtin_amdgcn_global_load_lds((const unsigned*)(Ab + (size_t)_o + (size_t)(kb)), (LAS unsigned*)(lds + (bufoff) + ldsw + _i * 8192), 16, 0, 0); } } \
        else { const char* _b = Ab + ((NEXT) ? nU : cU) + (size_t)(H_) * hstep + (size_t)(kb); _Pragma("unroll") for (int _i = 0; _i < 2; ++_i) \
            __builtin_amdgcn_global_load_lds((const unsigned*)(_b + voffA[_i]), (LAS unsigned*)(lds + (bufoff) + ldsw + _i * 8192), 16, 0, 0); } } while (0)
#define PG8_LDA(dst, b, h) do { _Pragma("unroll") for (int m = 0; m < 4; ++m) _Pragma("unroll") for (int k = 0; k < 2; ++k) dst[m][k] = *(const LAS bf16x8*)(lds + PG8_SA(b, h) + aoff + m * 2048 + k * 1024); } while (0)
#define PG8_LDB(dst, b, h) do { _Pragma("unroll") for (int n = 0; n < 2; ++n) _Pragma("unroll") for (int k = 0; k < 2; ++k) dst[n][k] = *(const LAS bf16x8*)(lds + PG8_SB(b, h) + boff + n * 2048 + k * 1024); } while (0)
#define PG8_MMA(ai, bj, At, Bt) do { __builtin_amdgcn_s_setprio(1); _Pragma("unroll") for (int m = 0; m < 4; ++m) _Pragma("unroll") for (int n = 0; n < 2; ++n) _Pragma("unroll") for (int k = 0; k < 2; ++k) \
        acc[ai][bj][m][n] = __builtin_amdgcn_mfma_f32_16x16x32_bf16(Bt[n][k], At[m][k], acc[ai][bj][m][n], 0, 0, 0); __builtin_amdgcn_s_setprio(0); } while (0)
#define PG8_WAIT_V(n) asm volatile("s_waitcnt vmcnt(" #n ")" ::: "memory")
#define PG8_WAIT_L(n) asm volatile("s_waitcnt lgkmcnt(" #n ")" ::: "memory")
#define PG8_BAR __builtin_amdgcn_s_barrier()
#define PG8_SCHED __builtin_amdgcn_sched_barrier(0)
    Unit cur, nxt; int ui = 0;
    if (!S.next(0, cur)) return;
    f32x4 acc[2][2][4][2];
#pragma unroll
    for (int a = 0; a < 2; ++a)
#pragma unroll
        for (int b = 0; b < 2; ++b)
#pragma unroll
            for (int m = 0; m < 4; ++m)
#pragma unroll
                for (int n = 0; n < 2; ++n) acc[a][b][m][n] = (f32x4){0.f, 0.f, 0.f, 0.f};
    bf16x8 At[4][2], B0[2][2], B1[2][2];
    unsigned ca[2][2], na[2][2];
    size_t cU = 0, nU = 0;
    if constexpr (Sched::GATHER) S.aoff(cur, RA, CA2, K, ca); else cU = (size_t)cur.pm * tstep;
    const char* cB = (const char*)g.Bt + (size_t)cur.pn * tstep;
    PG8_STAGEB(PG8_SB(0, 0), cB, voffB); PG8_STAGEB(PG8_SB(0, 1), cB + hstep, voffB); PG8_STAGEA(PG8_SA(0, 0), 0, 0, false); PG8_STAGEA(PG8_SA(0, 1), 1, 0, false);
    if (wr == 1) PG8_BAR;
    PG8_WAIT_V(2); PG8_BAR;
    PG8_STAGEB(PG8_SB(1, 0), cB + kstep, voffB); PG8_STAGEA(PG8_SA(1, 0), 0, kstep, false); PG8_STAGEB(PG8_SB(1, 1), cB + hstep + kstep, voffB);
    PG8_WAIT_V(6); PG8_BAR;
    for (;;) {
        const bool has_next = S.next(ui + 1, nxt);
        if constexpr (Sched::GATHER) {
            if (has_next) S.aoff(nxt, RA, CA2, K, na);
            else {
#pragma unroll
                for (int h = 0; h < 2; ++h)
#pragma unroll
                    for (int i = 0; i < 2; ++i) na[h][i] = ca[h][i];
            }
        } else nU = has_next ? (size_t)nxt.pm * tstep : cU;
        const char* nB = has_next ? (const char*)g.Bt + (size_t)nxt.pn * tstep : cB;
        for (int t = 0; t < nt; t += 2) {
            const bool last = (t == nt - 2);
            const size_t kb1 = (size_t)(t + 1) * kstep;
            const size_t kb2 = last ? 0 : (size_t)(t + 2) * kstep, kb3 = kb2 + kstep;
            const char* b2 = last ? nB : cB + (size_t)(t + 2) * kstep; const char* b3 = b2 + kstep;
            PG8_LDB(B0, 0, 0); PG8_LDB(B1, 0, 1); PG8_SCHED; PG8_LDA(At, 0, 0); PG8_STAGEA(PG8_SA(1, 1), 1, kb1, false);
            PG8_WAIT_V(8); PG8_WAIT_L(0); PG8_BAR; PG8_MMA(0, 0, At, B0); PG8_MMA(0, 1, At, B1); PG8_BAR; PG8_SCHED;
            PG8_LDA(At, 0, 1); PG8_STAGEB(PG8_SB(0, 0), b2, voffB); PG8_STAGEB(PG8_SB(0, 1), b2 + hstep, voffB); PG8_STAGEA(PG8_SA(0, 0), 0, kb2, last);
            PG8_WAIT_V(8); PG8_WAIT_L(0); PG8_BAR; PG8_MMA(1, 0, At, B0); PG8_MMA(1, 1, At, B1); PG8_BAR; PG8_SCHED;
            PG8_LDB(B0, 1, 0); PG8_LDB(B1, 1, 1); PG8_SCHED; PG8_LDA(At, 1, 0); PG8_STAGEA(PG8_SA(0, 1), 1, kb2, last);
            PG8_WAIT_V(8); PG8_WAIT_L(0); PG8_BAR; PG8_MMA(0, 0, At, B0); PG8_MMA(0, 1, At, B1); PG8_BAR; PG8_SCHED;
            PG8_LDA(At, 1, 1); PG8_STAGEB(PG8_SB(1, 0), b3, voffB); PG8_STAGEB(PG8_SB(1, 1), b3 + hstep, voffB); PG8_STAGEA(PG8_SA(1, 0), 0, kb3, last);
            PG8_WAIT_V(8); PG8_WAIT_L(0); PG8_BAR; PG8_MMA(1, 0, At, B0); PG8_MMA(1, 1, At, B1); PG8_BAR; PG8_SCHED;
            if constexpr (Epi::MIDK) { if (t + 2 == nt / 2) E.mid(acc, cur, wr, wc, fr, fq); }
        }
#if GEMM_ALIGN
        if (wr == 0) PG8_BAR;
#endif
        E(acc, cur, wr, wc, fr, fq);
        if (!has_next) break;
#pragma unroll
        for (int a = 0; a < 2; ++a)
#pragma unroll
            for (int b = 0; b < 2; ++b)
#pragma unroll
                for (int m = 0; m < 4; ++m)
#pragma unroll
                    for (int n = 0; n < 2; ++n) acc[a][b][m][n] = (f32x4){0.f, 0.f, 0.f, 0.f};
        cur = nxt; cB = nB; cU = nU; ++ui;
        if constexpr (Sched::GATHER) {
#pragma unroll
            for (int h = 0; h < 2; ++h)
#pragma unroll
                for (int i = 0; i < 2; ++i) ca[h][i] = na[h][i];
        }
#if GEMM_ALIGN
        if (wr == 1) PG8_BAR;
#endif
    }
    PG8_WAIT_V(0);
#if !GEMM_ALIGN
    if (wr == 0) PG8_BAR;
#endif
    PG8_BAR;
#undef PG8_SA
#undef PG8_SB
#undef PG8_STAGEA
#undef PG8_STAGEB
#undef PG8_LDA
#undef PG8_LDB
#undef PG8_MMA
#undef PG8_WAIT_V
#undef PG8_WAIT_L
#undef PG8_BAR
#undef PG8_SCHED
}

typedef const f32x4 (&AccRef)[2][2][4][2];

__device__ __forceinline__ u32x4 pack8(const f32x4& a, const f32x4& b) { u32x4 w; w.x = cvt_pk_bf16(a[0], a[1]); w.y = cvt_pk_bf16(a[2], a[3]); w.z = cvt_pk_bf16(b[0], b[1]); w.w = cvt_pk_bf16(b[2], b[3]); return w; }

struct EpiInProj {
    static constexpr bool PERM = true, MIDK = false;
    bf16_t *QA, *KA, *VA, *QB, *KB, *VB, *SA, *SB;
    const LAS float* normw;
    template <int ROPE>
    __device__ __forceinline__ void head_tile(AccRef acc, bf16_t* dst, int ld, int hcol, int gsel, float scale, int row0, int fr, int fq) const {
        int d0[2];
#pragma unroll
        for (int bj = 0; bj < 2; ++bj) d0[bj] = (ROPE == 1) ? (fq == 0 ? 8 * bj : 8 + 8 * fq + 24 * bj) : (fq < 2 ? 8 * fq + 16 * bj : 16 + 8 * fq + 16 * bj);
        f32x4 g[2][2];
#pragma unroll
        for (int bj = 0; bj < 2; ++bj)
#pragma unroll
            for (int n = 0; n < 2; ++n) g[bj][n] = *(const LAS f32x4*)(normw + gsel * 64 + d0[bj] + 4 * n);
        constexpr float FA[8] = {1.591549431e-01f, 3.086376340e-02f, 5.985185713e-03f, 1.160663641e-03f, 2.250790790e-04f, 4.364795279e-05f, 8.464330808e-06f, 1.641426263e-06f};
        constexpr float FB[16] = {1.591549431e-01f, 8.949940161e-02f, 5.032921210e-02f, 2.830219583e-02f, 1.591549431e-02f, 8.949940161e-03f, 5.032921210e-03f, 2.830219583e-03f,
                                  1.591549431e-03f, 8.949940161e-04f, 5.032921210e-04f, 2.830219583e-04f, 1.591549431e-04f, 8.949940161e-05f, 5.032921210e-05f, 2.830219583e-05f};
        float fq8[8];
#pragma unroll
        for (int k = 0; k < 8; ++k) fq8[k] = (ROPE == 1) ? FA[k] : ((fq & 1) ? FB[8 + k] : FB[k]);
        const bool rot = (ROPE == 2) || (fq == 0);
#pragma unroll
        for (int ai = 0; ai < 2; ++ai)
#pragma unroll
            for (int m = 0; m < 4; ++m) {
                const int row = row0 + ai * HALF + m * 16; const int s = row & (SEQ - 1);
                f32x4 y[2][2]; float ss = 0.f;
#pragma unroll
                for (int bj = 0; bj < 2; ++bj)
#pragma unroll
                    for (int n = 0; n < 2; ++n) { y[bj][n] = acc[ai][bj][m][n]; const f32x4 q = y[bj][n] * y[bj][n]; ss += (q[0] + q[1]) + (q[2] + q[3]); }
                ss += shx(ss, 16, fr + 16 * fq); ss += shx(ss, 32, fr + 16 * fq);
                const float rinv = __builtin_amdgcn_rsqf(ss * (1.0f / 64.0f) + 1e-6f);
#pragma unroll
                for (int bj = 0; bj < 2; ++bj)
#pragma unroll
                    for (int n = 0; n < 2; ++n) y[bj][n] = y[bj][n] * rinv * g[bj][n];
                if (ROPE != 0) {
                    const float pos = (float)((ROPE == 1) ? s : (fq < 2 ? (s >> 6) : (s & 63)));
#pragma unroll
                    for (int n = 0; n < 2; ++n)
#pragma unroll
                        for (int j = 0; j < 4; ++j) {
                            const float xr = __builtin_amdgcn_fractf(pos * fq8[4 * n + j]);
                            const float c = rot ? __builtin_amdgcn_cosf(xr) : 1.0f, s_ = rot ? __builtin_amdgcn_sinf(xr) : 0.0f;
                            const float x1 = y[0][n][j], x2 = y[1][n][j];
                            y[0][n][j] = x1 * c - x2 * s_; y[1][n][j] = x2 * c + x1 * s_;
                        }
                }
                bf16_t* rowp = dst + (size_t)row * ld + hcol + 8 * fq;
#pragma unroll
                for (int bj = 0; bj < 2; ++bj) *(u32x4*)(rowp + 32 * bj) = pack8(y[bj][0] * scale, y[bj][1] * scale);
            }
    }
    __device__ __forceinline__ void operator()(AccRef acc, const Unit& u, int wr, int wc, int fr_, int fq_) const {
        int fr = fr_, fq = fq_; asm volatile("" : "+v"(fr), "+v"(fq));
        const int pn = u.pn; const int row0 = u.pm * BM + wr * 64 + fr;
        if (pn >= 9) {
            unsigned char* base = (unsigned char*)((pn < 13) ? SA : SB); const int colt = ((pn - 9) & 3) * 256 + wc * 64 + 16 * fq;
#pragma unroll
            for (int ai = 0; ai < 2; ++ai)
#pragma unroll
                for (int m = 0; m < 4; ++m) { u32x4 w;
#pragma unroll
                    for (int bj = 0; bj < 2; ++bj) { f32x4 v0 = acc[ai][bj][m][0], v1 = acc[ai][bj][m][1];
#pragma unroll
                        for (int j = 0; j < 4; ++j) { v0[j] = sigmoid_f(v0[j]); v1[j] = sigmoid_f(v1[j]); }
                        const unsigned lo = pack4_fp8(v0[0], v0[1], v0[2], v0[3]), hi = pack4_fp8(v1[0], v1[1], v1[2], v1[3]);
                        if (bj == 0) { w.x = lo; w.y = hi; } else { w.z = lo; w.w = hi; } }
                    *(u32x4*)(base + (size_t)(row0 + ai * HALF + m * 16) * DM + colt) = w; }
        } else if (pn == 4 || pn == 5) {
            const int colt = (pn - 4) * 256 + wc * 64 + 16 * fq;
#pragma unroll
            for (int ai = 0; ai < 2; ++ai)
#pragma unroll
                for (int m = 0; m < 4; ++m) { bf16_t* rowp = VA + (size_t)(row0 + ai * HALF + m * 16) * 512 + colt;
#pragma unroll
                    for (int bj = 0; bj < 2; ++bj) *(u32x4*)(rowp + 8 * bj) = pack8(acc[ai][bj][m][0], acc[ai][bj][m][1]); }
        } else if (pn < 2)  head_tile<1>(acc, QA, 512, 64 * (4 * pn + wc), 0, QSCALE, row0, fr, fq);
        else if (pn < 4)    head_tile<1>(acc, KA, 512, 64 * (4 * (pn - 2) + wc), 1, 1.0f, row0, fr, fq);
        else if (pn < 8)    head_tile<2>(acc, QB, 512, 64 * (4 * (pn - 6) + wc), 2, QSCALE, row0, fr, fq);
        else if (wc < 2)    head_tile<2>(acc, KB, 128, 64 * wc, 3, 1.0f, row0, fr, fq);
        else {
#pragma unroll
            for (int ai = 0; ai < 2; ++ai)
#pragma unroll
                for (int m = 0; m < 4; ++m) { bf16_t* rowp = VB + (size_t)(row0 + ai * HALF + m * 16) * 128 + 64 * (wc - 2) + 8 * fq;
#pragma unroll
                    for (int bj = 0; bj < 2; ++bj) *(u32x4*)(rowp + 32 * bj) = pack8(acc[ai][bj][m][0], acc[ai][bj][m][1]); }
        }
    }
};

struct EpiMergeFused {
    static constexpr bool PERM = true, MIDK = true;
    bf16_t* MG; const unsigned char* GA; const unsigned char* GB;
    __device__ __forceinline__ void mid(f32x4 (&acc)[2][2][4][2], const Unit& u, int wr, int wc, int fr_, int fq_) const {
        int fr = fr_, fq = fq_; asm volatile("" : "+v"(fr), "+v"(fq));
        const int row0 = u.pm * BM + wr * 64 + fr, col0 = u.pn * BM + wc * 64 + 16 * fq;
#pragma unroll
        for (int ai = 0; ai < 2; ++ai)
#pragma unroll
            for (int m = 0; m < 4; ++m) { const size_t ro = (size_t)(row0 + ai * HALF + m * 16) * DM + col0;
                const u32x4 a = *(const u32x4*)(GA + ro), b = *(const u32x4*)(GB + ro);
#pragma unroll
                for (int bj = 0; bj < 2; ++bj) {
                    float sa[8], sb[8]; unpack8_fp8(bj ? (u32x2){a.z, a.w} : (u32x2){a.x, a.y}, sa); unpack8_fp8(bj ? (u32x2){b.z, b.w} : (u32x2){b.x, b.y}, sb);
#pragma unroll
                    for (int n = 0; n < 2; ++n)
#pragma unroll
                        for (int j = 0; j < 4; ++j) acc[ai][bj][m][n][j] *= sa[4 * n + j] * __builtin_amdgcn_rcpf(fmaxf(sb[4 * n + j], 1e-12f));
                } }
    }
    __device__ __forceinline__ void operator()(AccRef acc, const Unit& u, int wr, int wc, int fr_, int fq_) const {
        int fr = fr_, fq = fq_; asm volatile("" : "+v"(fr), "+v"(fq));
        const int row0 = u.pm * BM + wr * 64 + fr, col0 = u.pn * BM + wc * 64 + 16 * fq;
#pragma unroll
        for (int ai = 0; ai < 2; ++ai)
#pragma unroll
            for (int m = 0; m < 4; ++m) { const size_t ro = (size_t)(row0 + ai * HALF + m * 16) * DM + col0;
                const u32x4 b = *(const u32x4*)(GB + ro);
#pragma unroll
                for (int bj = 0; bj < 2; ++bj) {
                    float sb[8]; unpack8_fp8(bj ? (u32x2){b.z, b.w} : (u32x2){b.x, b.y}, sb);
                    f32x4 v0 = acc[ai][bj][m][0], v1 = acc[ai][bj][m][1];
#pragma unroll
                    for (int j = 0; j < 4; ++j) { v0[j] *= fmaxf(sb[j], 1e-12f); v1[j] *= fmaxf(sb[4 + j], 1e-12f); }
                    *(u32x4*)(MG + ro + 8 * bj) = pack8(v0, v1); } }
    }
};

struct EpiResidB {
    static constexpr bool PERM = true, MIDK = false;
    const float* Xf; const bf16_t* Xb; bf16_t* O; const float* gate;
    __device__ __forceinline__ void operator()(AccRef acc, const Unit& u, int wr, int wc, int fr_, int fq_) const {
        int fr = fr_, fq = fq_; asm volatile("" : "+v"(fr), "+v"(fq));
        const int row0 = u.pm * BM + wr * 64 + fr, col0 = u.pn * BM + wc * 64 + 16 * fq; const int b = (u.pm * BM) >> 11;
        f32x4 gt[2][2];
#pragma unroll
        for (int bj = 0; bj < 2; ++bj)
#pragma unroll
            for (int n = 0; n < 2; ++n) gt[bj][n] = *(const f32x4*)(gate + (size_t)b * MODW + col0 + 8 * bj + 4 * n);
#pragma unroll
        for (int ai = 0; ai < 2; ++ai)
#pragma unroll
            for (int m = 0; m < 4; ++m) { const size_t ro = (size_t)(row0 + ai * HALF + m * 16) * DM + col0;
#pragma unroll
                for (int bj = 0; bj < 2; ++bj) {
                    f32x4 x0, x1;
                    if (Xf) { x0 = *(const f32x4*)(Xf + ro + 8 * bj); x1 = *(const f32x4*)(Xf + ro + 8 * bj + 4); }
                    else { const u32x4 w = *(const u32x4*)(Xb + ro + 8 * bj); x0 = (f32x4){bf_lo(w.x), bf_hi(w.x), bf_lo(w.y), bf_hi(w.y)}; x1 = (f32x4){bf_lo(w.z), bf_hi(w.z), bf_lo(w.w), bf_hi(w.w)}; }
                    *(u32x4*)(O + ro + 8 * bj) = pack8(x0 + gt[bj][0] * acc[ai][bj][m][0], x1 + gt[bj][1] * acc[ai][bj][m][1]); } }
    }
};

struct EpiSwiGLU {
    static constexpr bool PERM = true, MIDK = false;
    bf16_t* ACT;
    __device__ __forceinline__ void operator()(AccRef acc, const Unit& u, int wr, int wc, int fr_, int fq_) const {
        int fr = fr_, fq = fq_; asm volatile("" : "+v"(fr), "+v"(fq));
        const int row0 = u.pm * BM + wr * 64 + fr, col0 = (u.pn & 3) * HALF + wc * 32 + 8 * fq;
#pragma unroll
        for (int ai = 0; ai < 2; ++ai)
#pragma unroll
            for (int m = 0; m < 4; ++m) { f32x4 r[2];
#pragma unroll
                for (int n = 0; n < 2; ++n)
#pragma unroll
                    for (int j = 0; j < 4; ++j) { const float gg = acc[ai][0][m][n][j], uu = acc[ai][1][m][n][j]; r[n][j] = gg * sigmoid_f(gg) * uu; }
                *(u32x4*)(ACT + (size_t)(row0 + ai * HALF + m * 16) * DFF + col0) = pack8(r[0], r[1]); }
    }
};

struct EpiY {
    static constexpr bool PERM = true, MIDK = false;
    bf16_t* Y;
    __device__ __forceinline__ void operator()(AccRef acc, const Unit& u, int wr, int wc, int fr_, int fq_) const {
        int fr = fr_, fq = fq_; asm volatile("" : "+v"(fr), "+v"(fq));
        const int row0 = u.pm * BM + wr * 64 + fr, col0 = (u.pn & 3) * BM + wc * 64 + 16 * fq;
#pragma unroll
        for (int ai = 0; ai < 2; ++ai)
#pragma unroll
            for (int m = 0; m < 4; ++m) { bf16_t* rowp = Y + (size_t)(row0 + ai * HALF + m * 16) * DM + col0;
#pragma unroll
                for (int bj = 0; bj < 2; ++bj) *(u32x4*)(rowp + 8 * bj) = pack8(acc[ai][bj][m][0], acc[ai][bj][m][1]); }
    }
};
}

__device__ __forceinline__ int dimA(int bj, int r) { return r < 8 ? r + 8 * bj : 16 + (r - 8) + 24 * bj; }
__device__ __forceinline__ int dimB(int bj, int r) { return r < 16 ? r + 16 * bj : 32 + (r - 16) + 16 * bj; }
__device__ __forceinline__ int inproj_srccol(int P) {
    const int pn = P >> 8, p = P & 255, bj = p >> 7, wc = (p >> 5) & 3, r = p & 31;
    if (pn < 2) return 64 * (4 * pn + wc) + dimA(bj, r);
    if (pn < 4) return 512 + 64 * (4 * (pn - 2) + wc) + dimA(bj, r);
    if (pn < 6) return 1024 + 256 * (pn - 4) + 64 * wc + 16 * ((p >> 3) & 3) + 8 * bj + (p & 7);
    if (pn < 8) return 1536 + 64 * (4 * (pn - 6) + wc) + dimB(bj, r);
    if (pn == 8) return wc < 2 ? 2048 + 64 * wc + dimB(bj, r) : 2176 + 64 * (wc - 2) + 32 * bj + r;
    { const int fq = (p >> 3) & 3, r8 = p & 7; return 2304 + 256 * (pn - 9) + 64 * wc + 16 * fq + 8 * bj + r8; }
}

namespace att {
constexpr int KSTR = 144, VSTR = 192;
constexpr int KTILE = 64 * KSTR, VTILE = 64 * VSTR;
constexpr int K_OFF = 0, V_OFF = 2 * KTILE;
constexpr int PRIV_OFF = 0;
__device__ __forceinline__ s16x4 vtr(LAS const char* p) { typedef short v4i16_t __attribute__((ext_vector_type(4)));
    return __builtin_bit_cast(s16x4, __builtin_amdgcn_ds_read_tr16_b64_v4i16((LAS v4i16_t*)p)); }
__device__ __forceinline__ int clamp_tok(int t) { return t < 0 ? 0 : (t > SEQ - 1 ? SEQ - 1 : t); }

__device__ __forceinline__ void qk_tile(f32x16& p0, f32x16& p1, const bf16x8 (&kf)[8], const bf16x8 (&qr)[4]) {
    const f32x16 z = {0.f, 0.f, 0.f, 0.f, 0.f, 0.f, 0.f, 0.f, 0.f, 0.f, 0.f, 0.f, 0.f, 0.f, 0.f, 0.f};
    p0 = __builtin_amdgcn_mfma_f32_32x32x16_bf16(kf[0], qr[0], z, 0, 0, 0); p1 = __builtin_amdgcn_mfma_f32_32x32x16_bf16(kf[1], qr[0], z, 0, 0, 0);
#pragma unroll
    for (int d0 = 1; d0 < 4; ++d0) { p0 = __builtin_amdgcn_mfma_f32_32x32x16_bf16(kf[2 * d0], qr[d0], p0, 0, 0, 0); p1 = __builtin_amdgcn_mfma_f32_32x32x16_bf16(kf[2 * d0 + 1], qr[d0], p1, 0, 0, 0); }
}
template <bool MASK>
__device__ __forceinline__ void exp_tile(const f32x16& p0, const f32x16& p1, float& lsum, bf16x8 (&pf)[2][2], int mbase, int mR, int dk) {
    float e0[16], e1[16]; float ls = 0.f;
#pragma unroll
    for (int r = 0; r < 16; ++r) {
        e0[r] = __builtin_amdgcn_exp2f(p0[r]); e1[r] = __builtin_amdgcn_exp2f(p1[r]);
        if (MASK) {
            const int c0 = (r & 3) + 8 * (r >> 2);
            e0[r] = ((unsigned)(mbase + dk * c0) <= (unsigned)mR) ? e0[r] : 0.f;
            e1[r] = ((unsigned)(mbase + dk * (c0 + 32)) <= (unsigned)mR) ? e1[r] : 0.f;
        }
        ls += e0[r] + e1[r];
    }
    lsum += ls;
#pragma unroll
    for (int s = 0; s < 2; ++s) {
        u32x4 w0, w1;
        w0.x = cvt_pk_bf16(e0[8 * s + 0], e0[8 * s + 1]); w0.y = cvt_pk_bf16(e0[8 * s + 2], e0[8 * s + 3]); w0.z = cvt_pk_bf16(e0[8 * s + 4], e0[8 * s + 5]); w0.w = cvt_pk_bf16(e0[8 * s + 6], e0[8 * s + 7]);
        w1.x = cvt_pk_bf16(e1[8 * s + 0], e1[8 * s + 1]); w1.y = cvt_pk_bf16(e1[8 * s + 2], e1[8 * s + 3]); w1.z = cvt_pk_bf16(e1[8 * s + 4], e1[8 * s + 5]); w1.w = cvt_pk_bf16(e1[8 * s + 6], e1[8 * s + 7]);
        pf[0][s] = __builtin_bit_cast(bf16x8, w0); pf[1][s] = __builtin_bit_cast(bf16x8, w1);
    }
}
__device__ __forceinline__ void vread(bf16x8 (&vf)[4], LAS const char* vb, int d0) {
#pragma unroll
    for (int blk = 0; blk < 2; ++blk)
#pragma unroll
        for (int s = 0; s < 2; ++s) {
            const s16x4 lo = vtr(vb + (32 * blk + 16 * s) * VSTR + 64 * d0), hi = vtr(vb + (32 * blk + 16 * s + 8) * VSTR + 64 * d0);
            vf[2 * blk + s] = (bf16x8){lo[0], lo[1], lo[2], lo[3], hi[0], hi[1], hi[2], hi[3]};
        }
}
__device__ __forceinline__ void pv_half(f32x16& od, const bf16x8 (&vf)[4], const bf16x8 (&pf)[2][2]) {
#pragma unroll
    for (int blk = 0; blk < 2; ++blk)
#pragma unroll
        for (int s = 0; s < 2; ++s) od = __builtin_amdgcn_mfma_f32_32x32x16_bf16(vf[2 * blk + s], pf[blk][s], od, 0, 0, 0);
}
__device__ __forceinline__ void mask_params(int dk, int tk0, int tq, int hi, int& mbase, int& mR) {
    const int dlo = (-64 * dk > -tq) ? -64 * dk : -tq, dhi = (64 * dk < SEQ - 1 - tq) ? 64 * dk : SEQ - 1 - tq;
    const int dA = tk0 + 4 * dk * hi - tq;
    mR = dhi - dlo; mbase = ((dA & (dk - 1)) == 0) ? dA - dlo : 0x7fffffff;
}

template <bool MASKED>
__device__ __forceinline__ void dense64_loop(LAS char* lds, const bf16_t* Kg, const bf16_t* Vg, int ld, int tok0, int ntiles,
                                             const bf16x8 (&qr)[2][4], f32x16 (&o)[2][2], float (&lsum)[2], int tq0, int tq1, int lane_, int wave) {
    constexpr int V2_OFF = 2 * KTILE;
    u32x4 kreg, vreg;
#define D64_LANE() int ln_ = lane_; asm volatile("" : "+v"(ln_)); const int tid_ = wave * 64 + ln_, srow = tid_ >> 3, sch = tid_ & 7
#define D64_LD(t) do { D64_LANE(); int tk_ = tok0 + 64 * (t) + srow; if (MASKED) tk_ = clamp_tok(tk_); kreg = *(const u32x4*)(Kg + (size_t)tk_ * ld + sch * 8); vreg = *(const u32x4*)(Vg + (size_t)tk_ * ld + sch * 8); } while (0)
#define D64_ST(t) do { D64_LANE(); *(LAS u32x4*)(lds + ((t) & 1) * KTILE + srow * KSTR + sch * 16) = kreg; *(LAS u32x4*)(lds + V2_OFF + ((t) & 1) * VTILE + srow * VSTR + sch * 16) = vreg; } while (0)
    D64_LD(0); D64_ST(0); D64_LD(1);
    for (int t = 0; t < ntiles; ++t) {
        __syncthreads();
        if (t + 1 < ntiles) D64_ST(t + 1);
        if (t + 2 < ntiles) D64_LD(t + 2);
        int lane = lane_; asm volatile("" : "+v"(lane));
        const int hi = lane >> 5;
        const int vlane = (4 * hi + ((lane & 15) >> 2)) * VSTR + (16 * ((lane >> 4) & 1) + 4 * (lane & 3)) * 2;
        const int klane = (lane & 31) * KSTR + 16 * hi;
        bf16x8 kf[8];
        { LAS const char* kb_ = lds + (t & 1) * KTILE + klane;
#pragma unroll
          for (int d0 = 0; d0 < 4; ++d0)
#pragma unroll
              for (int blk = 0; blk < 2; ++blk) kf[2 * d0 + blk] = *(const LAS bf16x8*)(kb_ + 32 * blk * KSTR + 32 * d0); }
        f32x16 p[2][2];
        bf16x8 vfa[4], vfb[4];
        LAS const char* vb_ = lds + V2_OFF + (t & 1) * VTILE + vlane;
        vread(vfa, vb_, 0); vread(vfb, vb_, 1);
        __builtin_amdgcn_sched_barrier(0);
        qk_tile(p[0][0], p[0][1], kf, qr[0]);
        qk_tile(p[1][0], p[1][1], kf, qr[1]);
#pragma unroll
        for (int g = 0; g < 2; ++g) {
            bf16x8 pf[2][2]; int mb = 0, mr = 0;
            if (MASKED) mask_params(1, tok0 + 64 * t, g ? tq1 : tq0, hi, mb, mr);
            exp_tile<MASKED>(p[g][0], p[g][1], lsum[g], pf, mb, mr, 1);
            pv_half(o[g][0], vfa, pf); pv_half(o[g][1], vfb, pf);
        }
    }
#undef D64_LANE
#undef D64_LD
#undef D64_ST
}
__device__ __forceinline__ void dense64_lag_loop(LAS char* lds, const bf16_t* Kg, const bf16_t* Vg, int ld, int ntiles,
                                                 const bf16x8 (&qr)[2][4], f32x16 (&o)[2][2], float (&lsum)[2], int lane_, int wave, const bool lag) {
    constexpr int V2_OFF = 2 * KTILE;
    u32x4 kreg, vreg;
#define D64_LANE() int ln_ = lane_; asm volatile("" : "+v"(ln_)); const int tid_ = wave * 64 + ln_, srow = tid_ >> 3, sch = tid_ & 7
#define D64_LD(t) do { D64_LANE(); const int tk_ = 64 * (t) + srow; kreg = *(const u32x4*)(Kg + (size_t)tk_ * ld + sch * 8); vreg = *(const u32x4*)(Vg + (size_t)tk_ * ld + sch * 8); } while (0)
#define D64_ST(t) do { D64_LANE(); *(LAS u32x4*)(lds + ((t) & 1) * KTILE + srow * KSTR + sch * 16) = kreg; *(LAS u32x4*)(lds + V2_OFF + ((t) % 3) * VTILE + srow * VSTR + sch * 16) = vreg; } while (0)
#define D64_QK(t) do { int lane = lane_; asm volatile("" : "+v"(lane)); const int klane = (lane & 31) * KSTR + 16 * (lane >> 5); bf16x8 kf[8]; LAS const char* kb_ = lds + ((t) & 1) * KTILE + klane; \
        _Pragma("unroll") for (int d0 = 0; d0 < 4; ++d0) _Pragma("unroll") for (int blk = 0; blk < 2; ++blk) kf[2 * d0 + blk] = *(const LAS bf16x8*)(kb_ + 32 * blk * KSTR + 32 * d0); \
        qk_tile(p[0][0], p[0][1], kf, qr[0]); qk_tile(p[1][0], p[1][1], kf, qr[1]); } while (0)
#define D64_PV(t) do { int lane = lane_; asm volatile("" : "+v"(lane)); const int hi = lane >> 5; const int vlane = (4 * hi + ((lane & 15) >> 2)) * VSTR + (16 * ((lane >> 4) & 1) + 4 * (lane & 3)) * 2; \
        bf16x8 vfa[4], vfb[4]; LAS const char* vb_ = lds + V2_OFF + ((t) % 3) * VTILE + vlane; vread(vfa, vb_, 0); vread(vfb, vb_, 1); \
        _Pragma("unroll") for (int g = 0; g < 2; ++g) { bf16x8 pf[2][2]; exp_tile<false>(p[g][0], p[g][1], lsum[g], pf, 0, 0, 0); pv_half(o[g][0], vfa, pf); pv_half(o[g][1], vfb, pf); } } while (0)
    f32x16 p[2][2];
    D64_LD(0); D64_ST(0);
    if (!lag) {
        D64_LD(1);
        for (int t = 0; t < ntiles; ++t) {
            __syncthreads();
            if (t + 1 < ntiles) D64_ST(t + 1);
            if (t + 2 < ntiles) D64_LD(t + 2);
            D64_QK(t);
            D64_PV(t);
        }
        __syncthreads();
    } else {
        D64_LD(1);
        __syncthreads();
        D64_ST(1); D64_LD(2);
        D64_QK(0);
        for (int t = 1; t < ntiles; ++t) {
            __syncthreads();
            if (t + 1 < ntiles) D64_ST(t + 1);
            if (t + 2 < ntiles) D64_LD(t + 2);
            D64_PV(t - 1);
            __builtin_amdgcn_sched_barrier(0);
            D64_QK(t);
        }
        __syncthreads();
        D64_PV(ntiles - 1);
    }
#undef D64_LANE
#undef D64_LD
#undef D64_ST
#undef D64_QK
#undef D64_PV
}
__device__ __forceinline__ void priv_kload(bf16x8 (&kf)[8], const bf16_t* Kg, int ld, int tk0, int dk, int lane_) {
    int lane = lane_; asm volatile("" : "+v"(lane));
    const int hi = lane >> 5;
#pragma unroll
    for (int blk = 0; blk < 2; ++blk) { const int tk = clamp_tok(tk0 + dk * (32 * blk + (lane & 31)));
#pragma unroll
        for (int d0 = 0; d0 < 4; ++d0) kf[2 * d0 + blk] = *(const bf16x8*)(Kg + (size_t)tk * ld + 16 * d0 + 8 * hi); }
}
__device__ __forceinline__ void priv2_step(bf16x8 (&kf)[8], LAS char* vpriv, const bf16_t* Kg, const bf16_t* Vg, int ld, int tk0, int dk, bool g0, bool g1,
                                           bool has_next, int tk0n, int dkn, const bf16x8 (&qr)[2][4], f32x16 (&o)[2][2], float (&lsum)[2], int tq0, int tq1, int lane_) {
    int lane = lane_; asm volatile("" : "+v"(lane));
    const int hi = lane >> 5;
    const int vlane = (4 * hi + ((lane & 15) >> 2)) * VSTR + (16 * ((lane >> 4) & 1) + 4 * (lane & 3)) * 2;
    u32x4 vr[8];
#pragma unroll
    for (int i = 0; i < 8; ++i) { const int idx = i * 64 + lane, row = idx >> 3, ch = idx & 7; const int tk = clamp_tok(tk0 + dk * row); vr[i] = *(const u32x4*)(Vg + (size_t)tk * ld + ch * 8); }
    const int gfirst = g0 ? 0 : 1, glast = g1 ? 1 : 0;
    f32x16 p0, p1; bf16x8 pf[2][2]; int mb, mr;
    if (gfirst == 0) qk_tile(p0, p1, kf, qr[0]); else qk_tile(p0, p1, kf, qr[1]);
    __builtin_amdgcn_sched_barrier(0);
#pragma unroll
    for (int i = 0; i < 8; ++i) { const int idx = i * 64 + lane; *(LAS u32x4*)(vpriv + (idx >> 3) * VSTR + (idx & 7) * 16) = vr[i]; }
    if (glast == gfirst) { __builtin_amdgcn_sched_barrier(0); if (has_next) priv_kload(kf, Kg, ld, tk0n, dkn, lane); __builtin_amdgcn_sched_barrier(0); }
    mask_params(dk, tk0, gfirst ? tq1 : tq0, hi, mb, mr);
    if (gfirst == 0) exp_tile<true>(p0, p1, lsum[0], pf, mb, mr, dk); else exp_tile<true>(p0, p1, lsum[1], pf, mb, mr, dk);
    { bf16x8 vfa[4], vfb[4]; vread(vfa, vpriv + vlane, 0); vread(vfb, vpriv + vlane, 1);
      if (gfirst == 0) { pv_half(o[0][0], vfa, pf); pv_half(o[0][1], vfb, pf); } else { pv_half(o[1][0], vfa, pf); pv_half(o[1][1], vfb, pf); } }
    if (glast != gfirst) {
        qk_tile(p0, p1, kf, qr[1]);
        __builtin_amdgcn_sched_barrier(0);
        if (has_next) priv_kload(kf, Kg, ld, tk0n, dkn, lane);
        __builtin_amdgcn_sched_barrier(0);
        mask_params(dk, tk0, tq1, hi, mb, mr);
        exp_tile<true>(p0, p1, lsum[1], pf, mb, mr, dk);
        bf16x8 vfa[4], vfb[4]; vread(vfa, vpriv + vlane, 0); vread(vfb, vpriv + vlane, 1);
        pv_half(o[1][0], vfa, pf); pv_half(o[1][1], vfb, pf);
    }
}
__device__ __forceinline__ void store_out(const f32x16 (&o)[2], float lsum, bf16_t* dst  , int lane_) {
    int lane = lane_; asm volatile("" : "+v"(lane));
    const int hi = lane >> 5;
    float l = lsum + shx(lsum, 32, lane);
    const float inv = 1.0f / l;
#pragma unroll
    for (int d0 = 0; d0 < 2; ++d0)
#pragma unroll
        for (int gp = 0; gp < 2; ++gp) {
            const int ga = 2 * gp, gb = 2 * gp + 1;
            unsigned a0 = cvt_pk_bf16(o[d0][4 * ga] * inv, o[d0][4 * ga + 1] * inv), a1 = cvt_pk_bf16(o[d0][4 * ga + 2] * inv, o[d0][4 * ga + 3] * inv);
            unsigned b0 = cvt_pk_bf16(o[d0][4 * gb] * inv, o[d0][4 * gb + 1] * inv), b1 = cvt_pk_bf16(o[d0][4 * gb + 2] * inv, o[d0][4 * gb + 3] * inv);
            const auto s0 = __builtin_amdgcn_permlane32_swap(a0, b0, false, false), s1 = __builtin_amdgcn_permlane32_swap(a1, b1, false, false);
            u32x4 w; w.x = s0[0]; w.y = s1[0]; w.z = s0[1]; w.w = s1[1];
            *(u32x4*)(dst + 32 * d0 + 16 * gp + 8 * hi) = w;
        }
}
}

struct Args { const float* in[18]; float* out; unsigned char* ws; int ph_lo, ph_hi; };
constexpr int PH_PRO = 0, PH_L0 = 1, PH_PER_LAYER = 9, PH_FINAL = PH_L0 + 2 * PH_PER_LAYER, NPH = PH_FINAL + 1;
enum { P_NORM1 = 0, P_INPROJ, P_ATTN, P_PAB, P_OUT, P_NORM2, P_PLACE, P_GU, P_DOWN };

__device__ __forceinline__ int tile256_srccol(int P) { const int p = P & 255; return (P & ~255) + 64 * ((p >> 5) & 3) + 16 * ((p >> 3) & 3) + 8 * (p >> 7) + (p & 7); }
template <int MAP>
__device__ __forceinline__ void transpose_item(const float* W, int N, int col0, bf16_t* dst, int dst_row0, int K, int k0, LAS float* scr, int lane, int dk0 = 0  ) {
    const int sc = (MAP == 1) ? inproj_srccol(col0 + lane) : (MAP == 2) ? tile256_srccol(col0 + lane) : col0 + lane;
    const float* src = W + (size_t)k0 * N + sc;
#pragma unroll 16
    for (int i = 0; i < 64; ++i) scr[i * 65 + lane] = src[(size_t)i * N];
    asm volatile("s_waitcnt lgkmcnt(0)" ::: "memory");
    const int c = lane & 7, nn = lane >> 3;
#pragma unroll
    for (int j = 0; j < 8; ++j) { const int n = nn + 8 * j; const LAS float* s = scr + (8 * c) * 65 + n;
        u32x4 w; w.x = cvt_pk_bf16(s[0], s[65]); w.y = cvt_pk_bf16(s[2 * 65], s[3 * 65]); w.z = cvt_pk_bf16(s[4 * 65], s[5 * 65]); w.w = cvt_pk_bf16(s[6 * 65], s[7 * 65]);
        *(u32x4*)(dst + (size_t)(dst_row0 + n) * K + dk0 + k0 + 8 * c) = w; }
    asm volatile("s_waitcnt lgkmcnt(0)" ::: "memory");
}


template <bool XF32, bool COMBINE, bool NORM, bool ROUTER, bool OUTF32>
__device__ __forceinline__ void row_phase(LAS unsigned char* lds, int tid, int lane, int wave, int G, int bx, const float* xf, bf16_t* xb, float* outf, const float* gv,
                                          const float* modl, int sh_off, int sc_off, const float* modprev, bf16_t* Hh, const bf16_t* Ym, const int* Pos, float* Tw,
                                          const bf16_t* Wr, int* Te, int* Trk, int* Cnt) {
    constexpr int RB = COMBINE ? 2 : ROWB;
    LAS float* lgs = (LAS float*)lds;
    LAS int* lcnt = (LAS int*)(lds + 40960);
    asm volatile("" : "+v"(tid), "+v"(lane));
    for (int chunk = bx; chunk < 256; chunk += G) {
        const int b = chunk >> 3;
        if (ROUTER) { if (tid < 32) lcnt[tid] = 0; }
        f32x4 pre[4], shv[4], g2[4];
#pragma unroll
        for (int j = 0; j < 4; ++j) { const int col = 512 * (j >> 1) + 8 * lane + 4 * (j & 1);
            if (NORM) { const f32x4 gg = *(const f32x4*)(gv + col), sc = *(const f32x4*)(modl + (size_t)b * MODW + sc_off + col);
                pre[j] = gg * (1.0f + sc); shv[j] = *(const f32x4*)(modl + (size_t)b * MODW + sh_off + col); }
            if (COMBINE) g2[j] = *(const f32x4*)(modprev + (size_t)b * MODW + 5 * DM + col); }
        f32x4 rawf[XF32 ? RB : 1][4]; u32x4 rawb[XF32 ? 1 : RB][2]; int pp[COMBINE ? RB : 1][2]; float pw[COMBINE ? RB : 1][2];
#define ROW_LOAD(rb_) do { _Pragma("unroll") for (int i = 0; i < RB; ++i) { const size_t ro = (size_t)((rb_) + i) * DM; \
            if (XF32) { _Pragma("unroll") for (int j = 0; j < 4; ++j) rawf[XF32 ? i : 0][j] = *(const f32x4*)(xf + ro + 512 * (j >> 1) + 8 * lane + 4 * (j & 1)); } \
            else { _Pragma("unroll") for (int h = 0; h < 2; ++h) rawb[XF32 ? 0 : i][h] = *(const u32x4*)(xb + ro + 512 * h + 8 * lane); } \
            if (COMBINE) { pp[COMBINE ? i : 0][0] = Pos[2 * ((rb_) + i)]; pp[COMBINE ? i : 0][1] = Pos[2 * ((rb_) + i) + 1]; pw[COMBINE ? i : 0][0] = Tw[2 * ((rb_) + i)]; pw[COMBINE ? i : 0][1] = Tw[2 * ((rb_) + i) + 1]; } } } while (0)
        ROW_LOAD(chunk * 256 + wave * 32);
#pragma unroll 1
        for (int r0 = 0; r0 < 32; r0 += RB) {
            const int rowb = chunk * 256 + wave * 32 + r0;
            f32x4 v[RB][4]; int cp[COMBINE ? RB : 1][2]; float cw[COMBINE ? RB : 1][2];
#pragma unroll
            for (int i = 0; i < RB; ++i) {
                if (XF32) {
#pragma unroll
                    for (int j = 0; j < 4; ++j) v[i][j] = rawf[XF32 ? i : 0][j];
                } else {
#pragma unroll
                    for (int h = 0; h < 2; ++h) { const u32x4 w = rawb[XF32 ? 0 : i][h];
                        v[i][2 * h] = (f32x4){bf_lo(w.x), bf_hi(w.x), bf_lo(w.y), bf_hi(w.y)}; v[i][2 * h + 1] = (f32x4){bf_lo(w.z), bf_hi(w.z), bf_lo(w.w), bf_hi(w.w)}; }
                }
                if (COMBINE) { cp[i][0] = pp[i][0]; cp[i][1] = pp[i][1]; cw[i][0] = pw[i][0]; cw[i][1] = pw[i][1]; }
            }
            u32x4 ya[COMBINE ? RB : 1][2], yc[COMBINE ? RB : 1][2];
            if (COMBINE) {
#pragma unroll
                for (int i = 0; i < RB; ++i)
#pragma unroll
                    for (int h = 0; h < 2; ++h) { ya[i][h] = *(const u32x4*)(Ym + (size_t)cp[i][0] * DM + 512 * h + 8 * lane); yc[i][h] = *(const u32x4*)(Ym + (size_t)cp[i][1] * DM + 512 * h + 8 * lane); }
            }
            if (r0 + RB < 32) ROW_LOAD(rowb + RB);
            if (COMBINE) {
#pragma unroll
                for (int i = 0; i < RB; ++i) {
                    const int row = rowb + i; const float w0 = cw[i][0], w1 = cw[i][1];
#pragma unroll
                    for (int h = 0; h < 2; ++h) { const u32x4 a = ya[i][h], c = yc[i][h];
                        const f32x4 m0 = {w0 * bf_lo(a.x) + w1 * bf_lo(c.x), w0 * bf_hi(a.x) + w1 * bf_hi(c.x), w0 * bf_lo(a.y) + w1 * bf_lo(c.y), w0 * bf_hi(a.y) + w1 * bf_hi(c.y)};
                        const f32x4 m1 = {w0 * bf_lo(a.z) + w1 * bf_lo(c.z), w0 * bf_hi(a.z) + w1 * bf_hi(c.z), w0 * bf_lo(a.w) + w1 * bf_lo(c.w), w0 * bf_hi(a.w) + w1 * bf_hi(c.w)};
                        v[i][2 * h] = v[i][2 * h] + g2[2 * h] * m0; v[i][2 * h + 1] = v[i][2 * h + 1] + g2[2 * h + 1] * m1;
                        if (OUTF32) { *(f32x4*)(outf + (size_t)row * DM + 512 * h + 8 * lane) = v[i][2 * h]; *(f32x4*)(outf + (size_t)row * DM + 512 * h + 8 * lane + 4) = v[i][2 * h + 1]; }
                        else *(u32x4*)(xb + (size_t)row * DM + 512 * h + 8 * lane) = pg8::pack8(v[i][2 * h], v[i][2 * h + 1]); }
                }
            }
            if (NORM) {
                float ss[RB];
#pragma unroll
                for (int i = 0; i < RB; ++i) { ss[i] = 0.f;
#pragma unroll
                    for (int j = 0; j < 4; ++j) { const f32x4 q = v[i][j] * v[i][j]; ss[i] += (q[0] + q[1]) + (q[2] + q[3]); } }
#pragma unroll
                for (int o = 1; o < 64; o <<= 1)
#pragma unroll
                    for (int i = 0; i < RB; ++i) ss[i] += shx(ss[i], o, lane);
#pragma unroll
                for (int i = 0; i < RB; ++i) { const float rstd = __builtin_amdgcn_rsqf(ss[i] * (1.0f / DM) + 1e-6f);
#pragma unroll
                    for (int h = 0; h < 2; ++h) *(u32x4*)(Hh + (size_t)(rowb + i) * DM + 512 * h + 8 * lane) = pg8::pack8(v[i][2 * h] * rstd * pre[2 * h] + shv[2 * h], v[i][2 * h + 1] * rstd * pre[2 * h + 1] + shv[2 * h + 1]); }
            }
        }
#undef ROW_LOAD
        if (ROUTER) {
            __syncthreads();
            const int row0 = chunk * 256 + wave * 32;
            f32x4 ra[2][2];
#pragma unroll
            for (int mt = 0; mt < 2; ++mt)
#pragma unroll
                for (int et = 0; et < 2; ++et) ra[mt][et] = (f32x4){0.f, 0.f, 0.f, 0.f};
#pragma unroll 4
            for (int kk = 0; kk < 32; ++kk) {
                bf16x8 a[2], bb[2];
#pragma unroll
                for (int mt = 0; mt < 2; ++mt) a[mt] = *(const bf16x8*)(Hh + (size_t)(row0 + 16 * mt + (lane & 15)) * DM + 32 * kk + 8 * (lane >> 4));
#pragma unroll
                for (int et = 0; et < 2; ++et) bb[et] = *(const bf16x8*)(Wr + (size_t)(16 * et + (lane & 15)) * DM + 32 * kk + 8 * (lane >> 4));
#pragma unroll
                for (int mt = 0; mt < 2; ++mt)
#pragma unroll
                    for (int et = 0; et < 2; ++et) ra[mt][et] = __builtin_amdgcn_mfma_f32_16x16x32_bf16(a[mt], bb[et], ra[mt][et], 0, 0, 0);
            }
#pragma unroll
            for (int mt = 0; mt < 2; ++mt)
#pragma unroll
                for (int et = 0; et < 2; ++et)
#pragma unroll
                    for (int r = 0; r < 4; ++r) lgs[(wave * 32 + 16 * mt + 4 * (lane >> 4) + r) * 33 + 16 * et + (lane & 15)] = ra[mt][et][r];
            asm volatile("s_waitcnt lgkmcnt(0)" ::: "memory");
            if (lane < 32) {
                const int tl = wave * 32 + lane, tok = chunk * 256 + tl;
                float lg[32]; float M = -3.0e38f;
#pragma unroll
                for (int e = 0; e < 32; ++e) { lg[e] = lgs[tl * 33 + e]; M = fmaxf(M, lg[e]); }
                float bm1 = 0.f, bm2 = 0.f, bsc = -1.f; int bi1 = 0, bi2 = 0, bg = 0;
#pragma unroll
                for (int g = 0; g < 4; ++g) {
                    float m1 = -3.0e38f, m2 = -3.0e38f; int i1 = 0, i2 = 0;
#pragma unroll
                    for (int j = 0; j < 8; ++j) { const float vv = lg[8 * g + j];
                        if (vv > m1) { m2 = m1; i2 = i1; m1 = vv; i1 = j; } else if (vv > m2) { m2 = vv; i2 = j; } }
                    const float sc = expf(m1 - M) + expf(m2 - M);
                    if (sc > bsc) { bsc = sc; bg = g; bm1 = m1; bm2 = m2; bi1 = i1; bi2 = i2; }
                }
                const int e0 = 8 * bg + bi1, e1 = 8 * bg + bi2;
                const float w0 = 1.0f / (1.0f + expf(bm2 - bm1)), w1 = 1.0f - w0;
                const int r0 = __hip_atomic_fetch_add(&lcnt[e0], 1, __ATOMIC_RELAXED, __HIP_MEMORY_SCOPE_WORKGROUP);
                const int r1 = __hip_atomic_fetch_add(&lcnt[e1], 1, __ATOMIC_RELAXED, __HIP_MEMORY_SCOPE_WORKGROUP);
                Te[2 * tok] = e0; Te[2 * tok + 1] = e1; Trk[2 * tok] = r0; Trk[2 * tok + 1] = r1; Tw[2 * tok] = w0; Tw[2 * tok + 1] = w1;
            }
            __syncthreads();
            if (tid < 32) Cnt[chunk * 32 + tid] = lcnt[tid];
            __syncthreads();
        }
    }
}

#define x_in ((const float*)(const GAS float*)args.in[0])
#define c_in ((const float*)(const GAS float*)args.in[1])
#define w_ada ((const float*)(const GAS float*)args.in[2])
#define b_ada ((const float*)(const GAS float*)args.in[3])
#define g_mix ((const float*)(const GAS float*)args.in[4])
#define w_in ((const float*)(const GAS float*)args.in[5])
#define qn_a ((const float*)(const GAS float*)args.in[6])
#define kn_a ((const float*)(const GAS float*)args.in[7])
#define qn_b ((const float*)(const GAS float*)args.in[8])
#define kn_b ((const float*)(const GAS float*)args.in[9])
#define w_pa ((const float*)(const GAS float*)args.in[10])
#define w_pb ((const float*)(const GAS float*)args.in[11])
#define w_out ((const float*)(const GAS float*)args.in[12])
#define g_ffn ((const float*)(const GAS float*)args.in[13])
#define w_router ((const float*)(const GAS float*)args.in[14])
#define w_gate ((const float*)(const GAS float*)args.in[15])
#define w_up ((const float*)(const GAS float*)args.in[16])
#define w_down ((const float*)(const GAS float*)args.in[17])
#define MOD ((float*)(GAS float*)(ws + WS_MOD))
#define XB ((bf16_t*)(GAS bf16_t*)(ws + WS_XB))
#define TE ((int*)(GAS int*)(ws + WS_TE))
#define TRK ((int*)(GAS int*)(ws + WS_TRK))
#define TW ((float*)(GAS float*)(ws + WS_TW))
#define POS ((int*)(GAS int*)(ws + WS_POS))
#define CNT ((int*)(GAS int*)(ws + WS_CNT))
#define BLKE ((int*)(GAS int*)(ws + WS_BLKE))
#define BTOK ((int*)(GAS int*)(ws + WS_BTOK))
#define WR ((bf16_t*)(bf16_t*)(GAS bf16_t*)(ws + WS_WR))
#define H ((bf16_t*)(bf16_t*)(GAS bf16_t*)(ws + WS_H))
#define YAB ((bf16_t*)(GAS bf16_t*)(ws + WS_H))
#define YA ((bf16_t*)(bf16_t*)(GAS bf16_t*)(ws + WS_H))
#define YB ((bf16_t*)(bf16_t*)(GAS bf16_t*)(ws + WS_H + 64 * MiB))
#define QA ((bf16_t*)(bf16_t*)(GAS bf16_t*)(ws + WS_QKV))
#define KA ((bf16_t*)(bf16_t*)(GAS bf16_t*)(ws + WS_QKV + 64 * MiB))
#define VA ((bf16_t*)(bf16_t*)(GAS bf16_t*)(ws + WS_QKV + 128 * MiB))
#define QB ((bf16_t*)(bf16_t*)(GAS bf16_t*)(ws + WS_QKV + 192 * MiB))
#define KB ((bf16_t*)(bf16_t*)(GAS bf16_t*)(ws + WS_QKV + 256 * MiB))
#define VB ((bf16_t*)(bf16_t*)(GAS bf16_t*)(ws + WS_QKV + 272 * MiB))
#define MERGED ((bf16_t*)(bf16_t*)(GAS bf16_t*)(ws + WS_QKV))
#define YM ((bf16_t*)(bf16_t*)(GAS bf16_t*)(ws + WS_QKV))
#define SA ((bf16_t*)(bf16_t*)(GAS bf16_t*)(ws + WS_GATE))
#define SB ((bf16_t*)(bf16_t*)(GAS bf16_t*)(ws + WS_GATE + 128 * MiB))
#define ACT ((bf16_t*)(bf16_t*)(GAS bf16_t*)(ws + WS_GATE))
#define PHASE_ENTER() int lane; asm volatile("v_mbcnt_lo_u32_b32 %0, -1, 0\n\tv_mbcnt_hi_u32_b32 %0, -1, %0" : "=v"(lane)); const int tid = wave * 64 + lane; GAS unsigned char* ws = ws0; int bx = bx0, vcu = vcu0; asm volatile("" : "+s"(ws), "+s"(bx), "+s"(vcu))

__device__ __forceinline__ bool in_phase(int lo, int hi, int k) { asm volatile("" : "+s"(lo), "+s"(hi)); return lo <= k && k < hi; }
#define PGATE_A SA
#define PGATE_B SB
__global__ void __launch_bounds__(512, 2) fwd_kernel(Args args) {
    extern __shared__ __attribute__((aligned(16))) unsigned char lds_raw[];
    LAS unsigned char* lds = (LAS unsigned char*)lds_raw;
    volatile LAS unsigned* MISC = (volatile LAS unsigned*)(lds + MISC_OFF);
    const int tid0 = threadIdx.x, lane0 = tid0 & 63, wave = __builtin_amdgcn_readfirstlane(tid0 >> 6);
    const int G = gridDim.x, bx0 = blockIdx.x;
    const int vcu0 = (G % 8 == 0) ? (bx0 % 8) * (G / 8) + bx0 / 8 : bx0;
    GAS unsigned char* ws0 = (GAS unsigned char*)args.ws;
    float* out = (float*)(GAS float*)args.out;
    for (int u = tid0; u < 256; u += 512) ((LAS unsigned*)(lds + MISC_OFF))[u] = 0u;
    __syncthreads();
#if MK_ONE_LAUNCH
    XcdBarrier bar = xcd_barrier_post((unsigned*)((GAS unsigned*)(ws0 + WS_CTL) + CW_BAR), MISC + 8);
#define GRID_BAR() do { int l_; asm volatile("v_mbcnt_lo_u32_b32 %0, -1, 0\n\tv_mbcnt_hi_u32_b32 %0, -1, %0" : "=v"(l_)); xcd_barrier(bar, (wave == 0) && (l_ == 0)); } while (0)
#else
#define GRID_BAR() do {} while (0)
#endif
#ifndef PHMASK
#define PHMASK 0xFFFFFFFFu
#endif
#if MK_ONE_LAUNCH
#define IN(k) true
#else
#define IN(k) in_phase(args.ph_lo, args.ph_hi, (k))
#endif
#define EN(bit) ((PHMASK >> (bit)) & 1u)
#define SEAM(k) do { if (IN(k) && IN((k) + 1)) GRID_BAR(); } while (0)

    if (EN(0) && IN(PH_PRO)) {
        PHASE_ENTER();
#pragma unroll 1
        for (int rep = 0; rep < REP_PRO; ++rep) {
        LAS float* scr = (LAS float*)(lds + wave * 16640);
        const int gw = vcu * 8 + wave, NGW = G * 8;
        constexpr int I_IN = 68 * 16, I_PA = 16 * 8, I_OUT = 16 * 16, I_GU = 32 * 2 * 8 * 16, I_DN = 32 * 16 * 8;
        constexpr int I_LAYER = I_IN + 2 * I_PA + I_OUT + I_GU + I_DN;
        for (int it = gw; it < 2 * I_LAYER; it += NGW) {
            const int l = it / I_LAYER; int r = it % I_LAYER;
            if (r < I_IN) { const int nb = r / 16, kb = r % 16;
                transpose_item<1>(w_in + (size_t)l * DM * NC, NC, 64 * nb, (bf16_t*)(GAS bf16_t*)(ws + WS_WIN + l * WIN_BYTES), 64 * nb, DM, 64 * kb, scr, lane); continue; } r -= I_IN;
            if (r < I_PA) { const int nb = r / 8, kb = r % 8;
                transpose_item<2>(w_pa + (size_t)l * 512 * DM, DM, 64 * nb, (bf16_t*)(GAS bf16_t*)(ws + WS_WPA + l * 2 * MiB), 64 * nb, DM, 64 * kb, scr, lane, 0); continue; } r -= I_PA;
            if (r < I_PA) { const int nb = r / 8, kb = r % 8;
                transpose_item<2>(w_pb + (size_t)l * 512 * DM, DM, 64 * nb, (bf16_t*)(GAS bf16_t*)(ws + WS_WPA + l * 2 * MiB), 64 * nb, DM, 64 * kb, scr, lane, 512); continue; } r -= I_PA;
            if (r < I_OUT) { const int nb = r / 16, kb = r % 16;
                transpose_item<2>(w_out + (size_t)l * DM * DM, DM, 64 * nb, (bf16_t*)(GAS bf16_t*)(ws + WS_WOUT + l * 2 * MiB), 64 * nb, DM, 64 * kb, scr, lane); continue; } r -= I_OUT;
            if (r < I_GU) { const int e = r / 256, q = r % 256, up = q / 128, nb = (q % 128) / 16, kb = q % 16;
                const float* src = (up ? w_up : w_gate) + ((size_t)l * NEXP + e) * DM * DFF;
                const int c0 = 64 * nb, drow = 256 * (c0 >> 7) + 128 * up + (c0 & 127);
                transpose_item<0>(src, DFF, c0, (bf16_t*)(GAS bf16_t*)(ws + WS_WGU + ((size_t)l * NEXP + e) * 2 * MiB), drow, DM, 64 * kb, scr, lane); continue; } r -= I_GU;
            { const int e = r / 128, q = r % 128, nb = q / 8, kb = q % 8;
                transpose_item<2>(w_down + ((size_t)l * NEXP + e) * DFF * DM, DM, 64 * nb, (bf16_t*)(GAS bf16_t*)(ws + WS_WDN + ((size_t)l * NEXP + e) * MiB), 64 * nb, DFF, 64 * kb, scr, lane); }
        }
        for (int i = (vcu * 512 + tid); i < 32 * DM; i += G * 512) { const int e = i >> 10, k = i & 1023; WR[i] = (bf16_t)(cvt_pk_bf16(w_router[(size_t)k * NEXP + e], 0.f) & 0xffffu); }
        __syncthreads();
        if (vcu * 8 < 384) {
            LAS float* cond = (LAS float*)lds;
            for (int i = tid; i < NB * DM; i += 512) { const int b = i >> 10, k = i & 1023; const float cv = c_in[i]; cond[k * 32 + b] = cv / (1.0f + expf(-cv)); }
            __syncthreads();
            for (int it = gw; it < 384; it += NGW) {
                const int l = it / 192, n0 = (it % 192) * 32;
                const float* wp = w_ada + (size_t)l * DM * MODW + n0 + (lane & 31) + (size_t)(lane >> 5) * MODW;
                const LAS float* cp = cond + (lane >> 5) * 32 + (lane & 31);
                f32x16 acc;
#pragma unroll
                for (int r = 0; r < 16; ++r) acc[r] = 0.f;
#pragma unroll 16
                for (int k0 = 0; k0 < DM; k0 += 2) acc = __builtin_amdgcn_mfma_f32_32x32x2f32(cp[k0 * 32], wp[(size_t)k0 * MODW], acc, 0, 0, 0);
                const float bias = b_ada[l * MODW + n0 + (lane & 31)];
#pragma unroll
                for (int r = 0; r < 16; ++r) { const int b = (r & 3) + 8 * (r >> 2) + 4 * (lane >> 5); MOD[((size_t)l * NB + b) * MODW + n0 + (lane & 31)] = acc[r] + bias; }
            }
        }
        __syncthreads();
        }
    }
    SEAM(PH_PRO);

    for (int l = 0; l < 2; ++l) {
        const int pb = PH_L0 + l * PH_PER_LAYER;
        if (EN(1) && IN(pb + P_NORM1)) { PHASE_ENTER(); const float* modl = MOD + (size_t)l * NB * MODW;
            if (l == 0) {
#pragma unroll 1
                for (int rep = 0; rep < REP_NORM1; ++rep)
                    row_phase<true, false, true, false, false>(lds, tid, lane, wave, G, bx, x_in, XB, out, g_mix, modl, 0, DM, MOD, H, YM, POS, TW, WR, TE, TRK, CNT);
            } else row_phase<false, true, true, false, false>(lds, tid, lane, wave, G, bx, x_in, XB, out, g_mix + DM, modl, 0, DM, MOD, H, YM, POS, TW, WR, TE, TRK, CNT); }
            {
                SEAM(pb + P_NORM1);
                if (EN(2) && IN(pb + P_INPROJ)) {
                    PHASE_ENTER();
                    pg8::Gemm g{H, (const bf16_t*)(const GAS bf16_t*)(ws + WS_WIN + l * WIN_BYTES), DM}; pg8::StaticOrder S; S.init(TT, NC, G, bx); S.wgm = INPROJ_WGM;
                    LAS float* normw = (LAS float*)(lds + MISC_OFF + 1024);
                    if (tid < 256) { const int sel = tid >> 6, d = tid & 63; const float* srcw = (sel == 0) ? qn_a : (sel == 1) ? kn_a : (sel == 2) ? qn_b : kn_b; normw[tid] = srcw[l * 64 + d]; }
                    __syncthreads();
                    pg8::EpiInProj E{QA, KA, VA, QB, KB, VB, SA, SB, normw};
#pragma unroll 1
                    for (int rep = 0; rep < REP_INPROJ; ++rep)
                    pg8::gemm_phase<pg8::EpiInProj, pg8::StaticOrder>(lds, g, S, E, wave);
                }
                SEAM(pb + P_INPROJ);
                if (EN(3) && IN(pb + P_ATTN)) {
                    PHASE_ENTER(); (void)lane;
                    LAS char* ring = (LAS char*)lds;
#pragma unroll 1
                    for (int rep = 0; rep < REP_ATTB; ++rep)
                    for (int L = vcu; L < NB * 32; L += G) {
                        int lane; asm volatile("v_mbcnt_lo_u32_b32 %0, -1, 0\n\tv_mbcnt_hi_u32_b32 %0, -1, %0" : "=v"(lane)); const int hi = lane >> 5;
                        const int b = L >> 5, kvh = (L >> 4) & 1, qh = 4 * kvh + ((L >> 2) & 3), qb2 = L & 3;
                        const int tq0 = 512 * qb2 + 64 * wave + (lane & 31);
                        bf16x8 qr[2][4];
#pragma unroll
                        for (int g = 0; g < 2; ++g)
#pragma unroll
                            for (int d0 = 0; d0 < 4; ++d0) qr[g][d0] = *(const bf16x8*)(QB + ((size_t)b * SEQ + tq0 + 32 * g) * 512 + qh * 64 + 16 * d0 + 8 * hi);
                        f32x16 o[2][2]; float lsum[2] = {0.f, 0.f};
#pragma unroll
                        for (int r = 0; r < 16; ++r) { o[0][0][r] = 0.f; o[0][1][r] = 0.f; o[1][0][r] = 0.f; o[1][1][r] = 0.f; }
                        __syncthreads();
                        att::dense64_lag_loop(ring, KB + (size_t)b * SEQ * 128 + kvh * 64, VB + (size_t)b * SEQ * 128 + kvh * 64, 128, 32, qr, o, lsum, lane, wave, wave >= 4);
                        { int l2; asm volatile("v_mbcnt_lo_u32_b32 %0, -1, 0\n\tv_mbcnt_hi_u32_b32 %0, -1, %0" : "=v"(l2)); const int tqs = 512 * qb2 + 64 * wave + (l2 & 31);
#pragma unroll
                          for (int g = 0; g < 2; ++g) att::store_out(o[g], lsum[g], YAB + ((size_t)b * SEQ + tqs + 32 * g) * DM + 512 + qh * 64, l2); }
                    }
#pragma unroll 1
                    for (int rep = 0; rep < REP_ATTA; ++rep)
                    for (int L = vcu; L < NB * 32; L += G) {
                        int lane; asm volatile("v_mbcnt_lo_u32_b32 %0, -1, 0\n\tv_mbcnt_hi_u32_b32 %0, -1, %0" : "=v"(lane)); const int hi = lane >> 5;
                        const int b = L >> 5, h = (L >> 2) & 7, tb2 = L & 3, base = 512 * tb2;
                        const int tq0 = base + 16 * (lane & 31) + wave, tq1 = tq0 + 8;
                        const bf16_t* Kg = KA + (size_t)b * SEQ * 512 + h * 64; const bf16_t* Vg = VA + (size_t)b * SEQ * 512 + h * 64;
                        bf16x8 qr[2][4];
#pragma unroll
                        for (int g = 0; g < 2; ++g)
#pragma unroll
                            for (int d0 = 0; d0 < 4; ++d0) qr[g][d0] = *(const bf16x8*)(QA + ((size_t)b * SEQ + tq0 + 8 * g) * 512 + h * 64 + 16 * d0 + 8 * hi);
                        f32x16 o[2][2]; float lsum[2] = {0.f, 0.f};
#pragma unroll
                        for (int r = 0; r < 16; ++r) { o[0][0][r] = 0.f; o[0][1][r] = 0.f; o[1][0][r] = 0.f; o[1][1][r] = 0.f; }
                        __syncthreads();
                        att::dense64_loop<true>(ring, Kg, Vg, 512, base - 64, 10, qr, o, lsum, tq0, tq1, lane, wave);
                        __syncthreads();
                        {
                            LAS char* vpriv = ring + att::PRIV_OFF + wave * att::VTILE;
#define A_TK0(j) ((j) < 4 ? base + wave - 256 + 256 * (j) : wave + 8 * (((j) - 4) >> 1) + 1024 * (((j) - 4) & 1))
#define A_DK(j) ((j) < 4 ? 4 : 16)
                            bf16x8 kf[8];
                            att::priv_kload(kf, Kg, 512, A_TK0(0), 4, lane);
#pragma unroll 1
                            for (int j = 0; j < 8; ++j) {
                                const bool p2 = j < 4; const int g = (j - 4) >> 1;
                                att::priv2_step(kf, vpriv, Kg, Vg, 512, A_TK0(j), A_DK(j), p2 || g == 0, p2 || g == 1, j + 1 < 8, A_TK0(j + 1), A_DK(j + 1), qr, o, lsum, tq0, tq1, lane);
                            }
#undef A_TK0
#undef A_DK
                        }
                        { int l2; asm volatile("v_mbcnt_lo_u32_b32 %0, -1, 0\n\tv_mbcnt_hi_u32_b32 %0, -1, %0" : "=v"(l2)); const int tqs = base + 16 * (l2 & 31) + wave;
#pragma unroll
                          for (int g = 0; g < 2; ++g) att::store_out(o[g], lsum[g], YAB + ((size_t)b * SEQ + tqs + 8 * g) * DM + h * 64, l2); }
                    }
                    __syncthreads();
                }
                SEAM(pb + P_ATTN);
                if (EN(4) && IN(pb + P_PAB)) {
                    PHASE_ENTER();
                    pg8::StaticOrder S; S.init(TT, DM, G, bx); S.wgm = N1K_WGM;
                    pg8::Gemm g{YAB, (const bf16_t*)(const GAS bf16_t*)(ws + WS_WPA + l * 2 * MiB), DM}; pg8::EpiMergeFused E{MERGED, (const unsigned char*)PGATE_A, (const unsigned char*)PGATE_B};
#pragma unroll 1
                    for (int rep = 0; rep < REP_PAB; ++rep)
                    pg8::gemm_phase<pg8::EpiMergeFused, pg8::StaticOrder>(lds, g, S, E, wave);
                }
                SEAM(pb + P_PAB);
                if (EN(5) && IN(pb + P_OUT)) {
                    PHASE_ENTER(); const float* modl = MOD + (size_t)l * NB * MODW;
                    pg8::Gemm g{MERGED, (const bf16_t*)(const GAS bf16_t*)(ws + WS_WOUT + l * 2 * MiB), DM}; pg8::StaticOrder S; S.init(TT, DM, G, bx); S.rowmajor = OUT_ROWMAJOR; S.wgm = N1K_WGM;
                    pg8::EpiResidB E{(l == 0) ? x_in : (const float*)nullptr, XB, XB, modl + 2 * DM};
#pragma unroll 1
                    for (int rep = 0; rep < ((l == 0) ? REP_OUT : 1); ++rep)
                    pg8::gemm_phase<pg8::EpiResidB, pg8::StaticOrder>(lds, g, S, E, wave);
                }
                SEAM(pb + P_OUT);
            }
        if (EN(6) && IN(pb + P_NORM2)) { PHASE_ENTER(); const float* modl = MOD + (size_t)l * NB * MODW;
#pragma unroll 1
            for (int rep = 0; rep < REP_NORM2; ++rep)
            row_phase<false, false, true, true, false>(lds, tid, lane, wave, G, bx, x_in, XB, out, g_ffn + l * DM, modl, 3 * DM, 4 * DM, MOD, H, YM, POS, TW, WR, TE, TRK, CNT); }
        SEAM(pb + P_NORM2);
        if (EN(7) && IN(pb + P_PLACE)) {
            PHASE_ENTER();
            LAS int* part_tot = (LAS int*)lds;
            LAS int* part_pre = part_tot + 512;
            LAS int* basee = part_pre + 512;
            LAS int* pstart = basee + 32;
            LAS int* pend = pstart + 32;
            LAS int* tote = pend + 32;
            for (int chunk = bx; chunk < 256; chunk += G) {
                { const int e = tid & 31, part = tid >> 5; int st = 0, sp = 0;
                    for (int q = 0; q < 16; ++q) { const int ch = part * 16 + q; const int v = CNT[ch * 32 + e]; st += v; sp += (ch < chunk) ? v : 0; }
                    part_tot[part * 32 + e] = st; part_pre[part * 32 + e] = sp; }
                __syncthreads();
                if (tid < 32) { int st = 0, sp = 0; for (int q = 0; q < 16; ++q) { st += part_tot[q * 32 + tid]; sp += part_pre[q * 32 + tid]; } tote[tid] = st; basee[tid] = sp; }
                __syncthreads();
                if (tid == 0) { int run = 0; for (int e = 0; e < 32; ++e) { const int padded = (tote[e] + 255) & ~255; pstart[e] = run; basee[e] += run; run += padded; pend[e] = run; } }
                __syncthreads();
                { const int tok = chunk * 256 + (tid >> 1), slot = tid & 1; const int e = TE[2 * tok + slot], rk = TRK[2 * tok + slot]; const int dest = basee[e] + rk;
                    BTOK[dest] = tok; POS[2 * tok + slot] = dest; }
                if (chunk < 32) { const int e = chunk; const int from = pstart[e] + tote[e], n = pend[e] - from; if (tid < n) BTOK[from + tid] = 0; }
                if (chunk == 0) {
                    for (int blk = tid; blk < NBLK; blk += 512) { int e = 0; for (int q = 0; q < 32; ++q) e += (pend[q] <= blk * 256) ? 1 : 0; BLKE[blk] = e > 31 ? 31 : e; }
                    if (tid == 0) BLKE[1000] = pend[31] >> 8;
                }
                __syncthreads();
            }
        }
        SEAM(pb + P_PLACE);
        if (EN(8) && IN(pb + P_GU)) {
            PHASE_ENTER();
            const int nused = BLKE[1000];
            pg8::Gemm g{H, (const bf16_t*)(const GAS bf16_t*)(ws + WS_WGU + (size_t)l * NEXP * 2 * MiB), DM};
            pg8::MoeOrder S{BLKE, BTOK, 4 * nused, G, vcu};
            pg8::EpiSwiGLU E{ACT};
#pragma unroll 1
            for (int rep = 0; rep < REP_GU; ++rep)
            pg8::gemm_phase<pg8::EpiSwiGLU, pg8::MoeOrder>(lds, g, S, E, wave);
        }
        SEAM(pb + P_GU);
        if (EN(9) && IN(pb + P_DOWN)) {
            PHASE_ENTER();
            const int nused = BLKE[1000];
            pg8::Gemm g{ACT, (const bf16_t*)(const GAS bf16_t*)(ws + WS_WDN + (size_t)l * NEXP * MiB), DFF};
            pg8::MoeOrder S{BLKE, nullptr, 4 * nused, G, vcu};
            pg8::EpiY E{YM};
#pragma unroll 1
            for (int rep = 0; rep < REP_DOWN; ++rep)
            pg8::gemm_phase<pg8::EpiY, pg8::MoeOrder>(lds, g, S, E, wave);
        }
        SEAM(pb + P_DOWN);
    }
    if (EN(10) && IN(PH_FINAL)) {
        PHASE_ENTER();
        row_phase<false, true, false, false, true>(lds, tid, lane, wave, G, bx, x_in, XB, out, g_ffn, MOD, 0, 0, MOD + (size_t)NB * MODW, H, YM, POS, TW, WR, TE, TRK, CNT);
    }
#undef IN
#undef SEAM
#undef GRID_BAR
}

extern "C" void kernel_launch(void* const* d_in, const int* in_sizes, int n_in, void* d_out, int out_size, void* d_ws, size_t ws_size, hipStream_t stream) {
    static int grid = 0;
    if (grid == 0) {
        if (n_in != 18 || in_sizes[0] != TT * DM || out_size != TT * DM || ws_size < WS_END) { fprintf(stderr, "kernel_launch: unexpected shapes / workspace (n_in %d, ws %zu); nothing launched\n", n_in, ws_size); grid = -1; return; }
        int dev = 0, cus = 0, per_cu = 0;
        if (hipGetDevice(&dev) != hipSuccess || hipDeviceGetAttribute(&cus, hipDeviceAttributeMultiprocessorCount, dev) != hipSuccess) { grid = -1; return; }
        if (hipFuncSetAttribute((const void*)fwd_kernel, hipFuncAttributeMaxDynamicSharedMemorySize, LDS_BYTES) != hipSuccess) { fprintf(stderr, "kernel_launch: hipFuncSetAttribute failed\n"); grid = -1; return; }
        if (hipOccupancyMaxActiveBlocksPerMultiprocessor(&per_cu, (const void*)fwd_kernel, 512, LDS_BYTES) != hipSuccess || per_cu < 1) { fprintf(stderr, "kernel_launch: occupancy query says %d\n", per_cu); per_cu = 1; }
        (void)hipGetLastError();
        grid = cus;
    }
    if (grid < 0) return;
    (void)hipMemsetAsync((char*)d_ws + WS_CTL, 0, CTL_ZERO_BYTES, stream);
    Args a{};
    for (int i = 0; i < 18; ++i) a.in[i] = (const float*)d_in[i];
    a.out = (float*)d_out; a.ws = (unsigned char*)d_ws;
#if MK_ONE_LAUNCH
    a.ph_lo = 0; a.ph_hi = NPH;
    hipLaunchKernelGGL(fwd_kernel, dim3(grid), dim3(512), LDS_BYTES, stream, a);
#else
    for (int p = 0; p < NPH; ++p) { a.ph_lo = p; a.ph_hi = p + 1; hipLaunchKernelGGL(fwd_kernel, dim3(grid), dim3(512), LDS_BYTES, stream, a); }
#endif
}
```

```cpp
#include <hip/hip_runtime.h>
#include <cstdio>
#include <cstdint>

#ifndef INPROJ_WGM
#define INPROJ_WGM 4
#endif
#ifndef GEMM_ALIGN
#define GEMM_ALIGN 1
#endif
#ifndef ROWB
#define ROWB 4
#endif
#ifndef N1K_WGM
#define N1K_WGM 8
#endif
#ifndef OUT_ROWMAJOR
#define OUT_ROWMAJOR 0
#endif
#ifndef REP_PRO
#define REP_PRO 1
#endif
#ifndef REP_ATTB
#define REP_ATTB 1
#endif
#ifndef REP_ATTA
#define REP_ATTA 1
#endif
#ifndef REP_INPROJ
#define REP_INPROJ 1
#endif
#ifndef REP_NORM1
#define REP_NORM1 1
#endif
#ifndef REP_GU
#define REP_GU 1
#endif
#ifndef REP_PAB
#define REP_PAB 1
#endif
#ifndef REP_OUT
#define REP_OUT 1
#endif
#ifndef REP_DOWN
#define REP_DOWN 1
#endif
#ifndef REP_NORM2
#define REP_NORM2 1
#endif
#ifndef MK_ONE_LAUNCH
#define MK_ONE_LAUNCH 1
#endif

#define LAS __attribute__((address_space(3)))
#define GAS __attribute__((address_space(1)))
typedef unsigned short bf16_t;
typedef short bf16x8 __attribute__((ext_vector_type(8)));
typedef short s16x4 __attribute__((ext_vector_type(4)));
typedef float f32x4 __attribute__((ext_vector_type(4)));
typedef float f32x16 __attribute__((ext_vector_type(16)));
typedef unsigned u32x4 __attribute__((ext_vector_type(4)));
typedef unsigned u32x2 __attribute__((ext_vector_type(2)));

constexpr int NB = 32, SEQ = 2048, DM = 1024, TT = NB * SEQ;
constexpr int NC = 4352;
constexpr int NEXP = 32, DFF = 512, NPAD = 139264, NBLK = 544;
constexpr int MODW = 6 * DM;
constexpr float QSCALE = 0.125f * 1.4426950408889634f;

constexpr size_t MiB = 1u << 20;
constexpr size_t WS_CTL = 0, CTL_ZERO_BYTES = 64 * 1024;
constexpr size_t WS_MOD = 1 * MiB;
constexpr size_t WS_TE = 2 * MiB + 512 * 1024, WS_TRK = 3 * MiB, WS_TW = 3 * MiB + 512 * 1024, WS_POS = 4 * MiB;
constexpr size_t WS_CNT = 4 * MiB + 512 * 1024;
constexpr size_t WS_BLKE = WS_CNT + 64 * 1024;
constexpr size_t WS_BTOK = WS_CNT + 128 * 1024;
constexpr size_t WS_WR = 5 * MiB + 256 * 1024;
constexpr size_t WS_WIN = 6 * MiB;
constexpr size_t WIN_BYTES = (size_t)NC * DM * 2;
constexpr size_t WS_WPA = 23 * MiB, WS_WPB = 25 * MiB, WS_WOUT = 27 * MiB;
constexpr size_t WS_WGU = 31 * MiB;
constexpr size_t WS_WDN = 159 * MiB;
constexpr size_t WS_H = 223 * MiB;
constexpr size_t WS_QKV = 351 * MiB;
constexpr size_t WS_GATE = 639 * MiB;
constexpr size_t WS_XB = 896 * MiB;
constexpr size_t WS_END = 1024 * MiB;
constexpr int CW_BAR = 4096;

constexpr int RING_BYTES = 133120;
constexpr int MISC_OFF = RING_BYTES;
constexpr int LDS_BYTES = 147456;

#define RLX_AGENT __ATOMIC_RELAXED, __HIP_MEMORY_SCOPE_AGENT
typedef float f32x2_t __attribute__((ext_vector_type(2))); typedef __bf16 bf16x2_t __attribute__((ext_vector_type(2)));
__device__ __forceinline__ unsigned cvt_pk_bf16(float lo, float hi) { const f32x2_t v = {lo, hi}; const bf16x2_t b = __builtin_convertvector(v, bf16x2_t); return __builtin_bit_cast(unsigned, b); }
typedef float f32x2v __attribute__((ext_vector_type(2)));
__device__ __forceinline__ unsigned pack4_fp8(float a, float b, float c, float d) { unsigned w = 0; w = __builtin_amdgcn_cvt_pk_fp8_f32(a, b, w, false); w = __builtin_amdgcn_cvt_pk_fp8_f32(c, d, w, true); return w; }
__device__ __forceinline__ void unpack8_fp8(u32x2 w, float (&o)[8]) { const f32x2v a = __builtin_amdgcn_cvt_pk_f32_fp8(w.x, false), b = __builtin_amdgcn_cvt_pk_f32_fp8(w.x, true), c = __builtin_amdgcn_cvt_pk_f32_fp8(w.y, false), d = __builtin_amdgcn_cvt_pk_f32_fp8(w.y, true);
    o[0] = a.x; o[1] = a.y; o[2] = b.x; o[3] = b.y; o[4] = c.x; o[5] = c.y; o[6] = d.x; o[7] = d.y; }
__device__ __forceinline__ float bf_lo(unsigned w) { return __uint_as_float(w << 16); }
__device__ __forceinline__ float bf_hi(unsigned w) { return __uint_as_float(w & 0xffff0000u); }
__device__ __forceinline__ float shx(float v, int mask, int lane) { return __int_as_float(__builtin_amdgcn_ds_bpermute((lane ^ mask) << 2, __float_as_int(v))); }
__device__ __forceinline__ float wave_sum(float v, int lane) {
#pragma unroll
    for (int o = 1; o < 64; o <<= 1) v += shx(v, o, lane);
    return v;
}
__device__ __forceinline__ float wave_max(float v, int lane) {
#pragma unroll
    for (int o = 1; o < 64; o <<= 1) v = fmaxf(v, shx(v, o, lane));
    return v;
}
__device__ __forceinline__ float sigmoid_f(float x) { return __builtin_amdgcn_rcpf(1.0f + __builtin_amdgcn_exp2f(-1.4426950408889634f * x)); }

#define XB_TMO      128
#define XB_XCNT(j)  (256  + 64 * (j))
#define XB_XSUB(j)  (1280 + 64 * (j))
#define XB_XGEN(j)  (2304 + 64 * (j))
#define XB_TOP      3328
#define XB_TOPGEN   3392
#define XCD_BAR_WORDS 3456
#define XB_SPIN_CAP (1u << 18)

__device__ __forceinline__ unsigned xb_ld(unsigned* p)              { return __hip_atomic_load(p, __ATOMIC_RELAXED, __HIP_MEMORY_SCOPE_AGENT); }
__device__ __forceinline__ unsigned xb_add(unsigned* p, unsigned v) { return __hip_atomic_fetch_add(p, v, __ATOMIC_RELAXED, __HIP_MEMORY_SCOPE_AGENT); }
__device__ __forceinline__ unsigned xb_xcc_id() { return (unsigned)__builtin_amdgcn_s_getreg((3 << 11) | 20) & 0xFu; }
#define XB_SPIN(cond, bar) do { unsigned _sp = 0; while (cond) { __builtin_amdgcn_s_sleep(1); \
    if ((++_sp & 255u) == 0u) { if (xb_ld(&(bar)[XB_TMO])) break; if (_sp > XB_SPIN_CAP) { atomicAdd(&(bar)[XB_TMO], 1u); break; } } } } while (0)

struct XcdBarrier { unsigned* bar; unsigned x; volatile LAS unsigned* st; };

__device__ __forceinline__ XcdBarrier xcd_barrier_post(unsigned* bar, volatile LAS unsigned* st) {
    XcdBarrier b; b.bar = bar; b.x = xb_xcc_id(); b.st = st;
    if (threadIdx.x == 0) (void)xb_add(&bar[XB_XCNT(b.x)], 1u);
    return b;
}
__device__ __forceinline__ void xcd_barrier_complete(unsigned* bar, unsigned x, unsigned& nloc, unsigned& nx) {
    const unsigned G = gridDim.x * gridDim.y * gridDim.z;
    unsigned sum, cnt, mine, sp = 0u;
    for (;;) {
        sum = 0u; cnt = 0u; mine = 0u;
#pragma unroll
        for (unsigned j = 0; j < 16; ++j) { const unsigned c = xb_ld(&bar[XB_XCNT(j)]); sum += c; cnt += (c > 0u) ? 1u : 0u; mine = (j == x) ? c : mine; }
        if (sum == G) break;
        __builtin_amdgcn_s_sleep(1);
        if ((++sp & 255u) == 0u) { if (xb_ld(&bar[XB_TMO])) break; if (sp > XB_SPIN_CAP) { atomicAdd(&bar[XB_TMO], 1u); break; } }
    }
    nloc = mine > 0u ? mine : 1u; nx = cnt > 0u ? cnt : 1u;
}
__device__ __forceinline__ void xcd_barrier(const XcdBarrier& b, const bool is_t0  ) {
    asm volatile("s_waitcnt vmcnt(0)" ::: "memory");
    __syncthreads();
    if (is_t0) {
        unsigned* bar = b.bar; unsigned bx_ = b.x;
        asm volatile("" : "+s"(bar), "+s"(bx_));
        __builtin_amdgcn_s_waitcnt(0);
        unsigned nloc = b.st[0], nx = b.st[1];
        if (nloc == 0u) { xcd_barrier_complete(bar, bx_, nloc, nx); b.st[0] = nloc; b.st[1] = nx; }
        const unsigned old = xb_add(&bar[XB_XSUB(bx_)], 1u);
        const unsigned gen = old / nloc;
        if (old + 1u == (gen + 1u) * nloc) {
            __builtin_amdgcn_fence(__ATOMIC_RELEASE, "agent");
            asm volatile("s_waitcnt vmcnt(0)" ::: "memory");
            const unsigned og = xb_add(&bar[XB_TOP], 1u);
            const unsigned tg = og / nx;
            if (og + 1u == (tg + 1u) * nx) xb_add(&bar[XB_TOPGEN], 1u);
            else XB_SPIN(xb_ld(&bar[XB_TOPGEN]) == tg, bar);
            __builtin_amdgcn_fence(__ATOMIC_ACQUIRE, "agent");
            xb_add(&bar[XB_XGEN(bx_)], 1u);
            asm volatile("s_waitcnt vmcnt(0)" ::: "memory");
        } else {
            XB_SPIN(xb_ld(&bar[XB_XGEN(bx_)]) == gen, bar);
            __builtin_amdgcn_fence(__ATOMIC_ACQUIRE, "agent");
            asm volatile("s_waitcnt vmcnt(0)" ::: "memory");
        }
    }
    __syncthreads();
}

namespace pg8 {
constexpr int BM = 256, BK = 64, HALF = 128, HTB = HALF * BK * 2, STAGE_BYTES = 8 * HTB, NXCD = 8, WGM = 8;
__host__ __device__ __forceinline__ int lds_byte(int r, int c) { const int st = (r >> 4) * 2 + (c >> 5), rr = r & 15, cc = c & 31, ob = rr * 64 + cc * 2; return st * 1024 + (ob ^ (((ob >> 9) & 1) << 5)); }
__host__ __device__ __forceinline__ void stage_rc(int b, int& R, int& C) { const int st = b / 1024, sb = b % 1024, swz = sb ^ (((sb >> 9) & 1) << 5); R = (st >> 1) * 16 + swz / 64; C = (st & 1) * 32 + (swz % 64) / 2; }
__host__ __device__ __forceinline__ int perm32(int rho) { const int n = rho >> 4, i = rho & 15; return 8 * (i >> 2) + 4 * n + (i & 3); }

struct Unit { int pm, pn; };
struct Gemm { const bf16_t* A; const bf16_t* Bt; int K; };

struct StaticOrder {
    static constexpr bool GATHER = false;
    int nM, nN, nwg, G, c, wgm = WGM;
    __device__ void init(int M, int N, int G_, int c_) { asm volatile("" : "+s"(c_));     nM = M / BM; nN = N / BM; nwg = nM * nN; G = G_; c = c_; }
    int rowmajor = 0;
    __device__ __forceinline__ bool next(int i, Unit& u) const {
        if (rowmajor) { const int upw = (nwg + G - 1) / G, k = c * upw + i; if (i >= upw || k >= nwg) return false; u.pm = k / nN; u.pn = k % nN; return true; }
        const long L = (long)i * G + c; if (L >= nwg) return false;
        int wgid = (int)L; { const int q = nwg / NXCD, r = nwg % NXCD, xcd = wgid % NXCD, off = wgid / NXCD; wgid = (xcd < r ? xcd * (q + 1) : r * (q + 1) + (xcd - r) * q) + off; }
        const int nig = wgm * nN, gid = wgid / nig, fm = gid * wgm, gsz = (nM - fm) < wgm ? (nM - fm) : wgm;
        u.pm = fm + ((wgid % nig) % gsz); u.pn = (wgid % nig) / gsz; return true;
    }
    __device__ __forceinline__ void aoff(const Unit&, const int (&)[2], const unsigned (&)[2], int, unsigned (&)[2][2]) const {}
};
struct MoeOrder {
    static constexpr bool GATHER = true;
    const int* blk_e; const int* rowidx; int nunits, G, c;
    __device__ __forceinline__ bool next(int i, Unit& u) const {
        const int L = i * G + c; if (L >= nunits) return false;
        const int blk = L >> 2; const int e = blk_e[blk]; u.pm = blk; u.pn = 4 * e + (L & 3); return true;
    }
    __device__ __forceinline__ void aoff(const Unit& u, const int (&RA)[2], const unsigned (&CA2)[2], int K, unsigned (&o)[2][2]) const {
#pragma unroll
        for (int h = 0; h < 2; ++h)
#pragma unroll
            for (int i = 0; i < 2; ++i) { const int r = u.pm * BM + h * HALF + RA[i]; const int src = rowidx ? rowidx[r] : r; o[h][i] = (unsigned)src * (unsigned)(K * 2) + CA2[i]; }
    }
};

template <class Epi, class Sched>
__device__ __forceinline__ void gemm_phase(LAS unsigned char* lds, const Gemm g, const Sched& S, const Epi& E, const int wid) {
    int lane_; asm volatile("v_mbcnt_lo_u32_b32 %0, -1, 0\n\tv_mbcnt_hi_u32_b32 %0, -1, %0" : "=v"(lane_));
    const int lane = lane_, tid = wid * 64 + lane, wr = wid >> 2, wc = wid & 3, fr = lane & 15, fq = lane >> 4;
    const int K = g.K, nt = K / BK;
    unsigned voffA[2], voffB[2], CA2[2]; int RA[2];
#pragma unroll
    for (int i = 0; i < 2; ++i) { int R, C; stage_rc(tid * 16 + i * 8192, R, C); const int Rb = Epi::PERM ? ((R & ~31) + perm32(R & 31)) : R;
        RA[i] = R; CA2[i] = (unsigned)C * 2u; voffA[i] = (unsigned)(R * K + C) * 2u; voffB[i] = (unsigned)(Rb * K + C) * 2u; }
    const size_t kstep = (size_t)(BK * 2);
    const size_t hstep = (size_t)HALF * K * 2;
    const size_t tstep = 2 * hstep;
    const unsigned ldsw = (unsigned)wid * 1024u;
    const int aoff = lds_byte(wr * 64 + fr, fq * 8), boff = lds_byte(wc * 32 + fr, fq * 8);
    const char* Ab = (const char*)g.A;
#define PG8_SA(b, h) (((b) * 2 + (h)) * HTB)
#define PG8_SB(b, h) ((4 + (b) * 2 + (h)) * HTB)
#define PG8_STAGEB(bufoff, gbase, voff) do { _Pragma("unroll") for (int _i = 0; _i < 2; ++_i) \
        __builtin_amdgcn_global_load_lds((const unsigned*)((const char*)(gbase) + (voff)[_i]), (LAS unsigned*)(lds + (bufoff) + ldsw + _i * 8192), 16, 0, 0); } while (0)
#define PG8_STAGEA(bufoff, H_, kb, NEXT) do { if constexpr (Sched::GATHER) { _Pragma("unroll") for (int _i = 0; _i < 2; ++_i) { const unsigned _o = (NEXT) ? na[H_][_i] : ca[H_][_i]; \
            __builtin_amdgcn_global_load_lds((const unsigned*)(Ab + (size_t)_o + (size_t)(kb)), (LAS unsigned*)(lds + (bufoff) + ldsw + _i * 8192), 16, 0, 0); } } \
        else { const char* _b = Ab + ((NEXT) ? nU : cU) + (size_t)(H_) * hstep + (size_t)(kb); _Pragma("unroll") for (int _i = 0; _i < 2; ++_i) \
            __builtin_amdgcn_global_load_lds((const unsigned*)(_b + voffA[_i]), (LAS unsigned*)(lds + (bufoff) + ldsw + _i * 8192), 16, 0, 0); } } while (0)
#define PG8_LDA(dst, b, h) do { _Pragma("unroll") for (int m = 0; m < 4; ++m) _Pragma("unroll") for (int k = 0; k < 2; ++k) dst[m][k] = *(const LAS bf16x8*)(lds + PG8_SA(b, h) + aoff + m * 2048 + k * 1024); } while (0)
#define PG8_LDB(dst, b, h) do { _Pragma("unroll") for (int n = 0; n < 2; ++n) _Pragma("unroll") for (int k = 0; k < 2; ++k) dst[n][k] = *(const LAS bf16x8*)(lds + PG8_SB(b, h) + boff + n * 2048 + k * 1024); } while (0)
#define PG8_MMA(ai, bj, At, Bt) do { __builtin_amdgcn_s_setprio(1); _Pragma("unroll") for (int m = 0; m < 4; ++m) _Pragma("unroll") for (int n = 0; n < 2; ++n) _Pragma("unroll") for (int k = 0; k < 2; ++k) \
        acc[ai][bj][m][n] = __builtin_amdgcn_mfma_f32_16x16x32_bf16(Bt[n][k], At[m][k], acc[ai][bj][m][n], 0, 0, 0); __builtin_amdgcn_s_setprio(0); } while (0)
#define PG8_WAIT_V(n) asm volatile("s_waitcnt vmcnt(" #n ")" ::: "memory")
#define PG8_WAIT_L(n) asm volatile("s_waitcnt lgkmcnt(" #n ")" ::: "memory")
#define PG8_BAR __builtin_amdgcn_s_barrier()
#define PG8_SCHED __builtin_amdgcn_sched_barrier(0)
    Unit cur, nxt; int ui = 0;
    if (!S.next(0, cur)) return;
    f32x4 acc[2][2][4][2];
#pragma unroll
    for (int a = 0; a < 2; ++a)
#pragma unroll
        for (int b = 0; b < 2; ++b)
#pragma unroll
            for (int m = 0; m < 4; ++m)
#pragma unroll
                for (int n = 0; n < 2; ++n) acc[a][b][m][n] = (f32x4){0.f, 0.f, 0.f, 0.f};
    bf16x8 At[4][2], B0[2][2], B1[2][2];
    unsigned ca[2][2], na[2][2];
    size_t cU = 0, nU = 0;
    if constexpr (Sched::GATHER) S.aoff(cur, RA, CA2, K, ca); else cU = (size_t)cur.pm * tstep;
    const char* cB = (const char*)g.Bt + (size_t)cur.pn * tstep;
    PG8_STAGEB(PG8_SB(0, 0), cB, voffB); PG8_STAGEB(PG8_SB(0, 1), cB + hstep, voffB); PG8_STAGEA(PG8_SA(0, 0), 0, 0, false); PG8_STAGEA(PG8_SA(0, 1), 1, 0, false);
    if (wr == 1) PG8_BAR;
    PG8_WAIT_V(2); PG8_BAR;
    PG8_STAGEB(PG8_SB(1, 0), cB + kstep, voffB); PG8_STAGEA(PG8_SA(1, 0), 0, kstep, false); PG8_STAGEB(PG8_SB(1, 1), cB + hstep + kstep, voffB);
    PG8_WAIT_V(6); PG8_BAR;
    for (;;) {
        const bool has_next = S.next(ui + 1, nxt);
        if constexpr (Sched::GATHER) {
            if (has_next) S.aoff(nxt, RA, CA2, K, na);
            else {
#pragma unroll
                for (int h = 0; h < 2; ++h)
#pragma unroll
                    for (int i = 0; i < 2; ++i) na[h][i] = ca[h][i];
            }
        } else nU = has_next ? (size_t)nxt.pm * tstep : cU;
        const char* nB = has_next ? (const char*)g.Bt + (size_t)nxt.pn * tstep : cB;
        for (int t = 0; t < nt; t += 2) {
            const bool last = (t == nt - 2);
            const size_t kb1 = (size_t)(t + 1) * kstep;
            const size_t kb2 = last ? 0 : (size_t)(t + 2) * kstep, kb3 = kb2 + kstep;
            const char* b2 = last ? nB : cB + (size_t)(t + 2) * kstep; const char* b3 = b2 + kstep;
            PG8_LDB(B0, 0, 0); PG8_LDB(B1, 0, 1); PG8_SCHED; PG8_LDA(At, 0, 0); PG8_STAGEA(PG8_SA(1, 1), 1, kb1, false);
            PG8_WAIT_V(8); PG8_WAIT_L(0); PG8_BAR; PG8_MMA(0, 0, At, B0); PG8_MMA(0, 1, At, B1); PG8_BAR; PG8_SCHED;
            PG8_LDA(At, 0, 1); PG8_STAGEB(PG8_SB(0, 0), b2, voffB); PG8_STAGEB(PG8_SB(0, 1), b2 + hstep, voffB); PG8_STAGEA(PG8_SA(0, 0), 0, kb2, last);
            PG8_WAIT_V(8); PG8_WAIT_L(0); PG8_BAR; PG8_MMA(1, 0, At, B0); PG8_MMA(1, 1, At, B1); PG8_BAR; PG8_SCHED;
            PG8_LDB(B0, 1, 0); PG8_LDB(B1, 1, 1); PG8_SCHED; PG8_LDA(At, 1, 0); PG8_STAGEA(PG8_SA(0, 1), 1, kb2, last);
            PG8_WAIT_V(8); PG8_WAIT_L(0); PG8_BAR; PG8_MMA(0, 0, At, B0); PG8_MMA(0, 1, At, B1); PG8_BAR; PG8_SCHED;
            PG8_LDA(At, 1, 1); PG8_STAGEB(PG8_SB(1, 0), b3, voffB); PG8_STAGEB(PG8_SB(1, 1), b3 + hstep, voffB); PG8_STAGEA(PG8_SA(1, 0), 0, kb3, last);
            PG8_WAIT_V(8); PG8_WAIT_L(0); PG8_BAR; PG8_MMA(1, 0, At, B0); PG8_MMA(1, 1, At, B1); PG8_BAR; PG8_SCHED;
            if constexpr (Epi::MIDK) { if (t + 2 == nt / 2) E.mid(acc, cur, wr, wc, fr, fq); }
        }
#if GEMM_ALIGN
        if (wr == 0) PG8_BAR;
#endif
        E(acc, cur, wr, wc, fr, fq);
        if (!has_next) break;
#pragma unroll
        for (int a = 0; a < 2; ++a)
#pragma unroll
            for (int b = 0; b < 2; ++b)
#pragma unroll
                for (int m = 0; m < 4; ++m)
#pragma unroll
                    for (int n = 0; n < 2; ++n) acc[a][b][m][n] = (f32x4){0.f, 0.f, 0.f, 0.f};
        cur = nxt; cB = nB; cU = nU; ++ui;
        if constexpr (Sched::GATHER) {
#pragma unroll
            for (int h = 0; h < 2; ++h)
#pragma unroll
                for (int i = 0; i < 2; ++i) ca[h][i] = na[h][i];
        }
#if GEMM_ALIGN
        if (wr == 1) PG8_BAR;
#endif
    }
    PG8_WAIT_V(0);
#if !GEMM_ALIGN
    if (wr == 0) PG8_BAR;
#endif
    PG8_BAR;
#undef PG8_SA
#undef PG8_SB
#undef PG8_STAGEA
#undef PG8_STAGEB
#undef PG8_LDA
#undef PG8_LDB
#undef PG8_MMA
#undef PG8_WAIT_V
#undef PG8_WAIT_L
#undef PG8_BAR
#undef PG8_SCHED
}

typedef const f32x4 (&AccRef)[2][2][4][2];

__device__ __forceinline__ u32x4 pack8(const f32x4& a, const f32x4& b) { u32x4 w; w.x = cvt_pk_bf16(a[0], a[1]); w.y = cvt_pk_bf16(a[2], a[3]); w.z = cvt_pk_bf16(b[0], b[1]); w.w = cvt_pk_bf16(b[2], b[3]); return w; }

struct EpiInProj {
    static constexpr bool PERM = true, MIDK = false;
    bf16_t *QA, *KA, *VA, *QB, *KB, *VB, *SA, *SB;
    const LAS float* normw;
    template <int ROPE>
    __device__ __forceinline__ void head_tile(AccRef acc, bf16_t* dst, int ld, int hcol, int gsel, float scale, int row0, int fr, int fq) const {
        int d0[2];
#pragma unroll
        for (int bj = 0; bj < 2; ++bj) d0[bj] = (ROPE == 1) ? (fq == 0 ? 8 * bj : 8 + 8 * fq + 24 * bj) : (fq < 2 ? 8 * fq + 16 * bj : 16 + 8 * fq + 16 * bj);
        f32x4 g[2][2];
#pragma unroll
        for (int bj = 0; bj < 2; ++bj)
#pragma unroll
            for (int n = 0; n < 2; ++n) g[bj][n] = *(const LAS f32x4*)(normw + gsel * 64 + d0[bj] + 4 * n);
        constexpr float FA[8] = {1.591549431e-01f, 3.086376340e-02f, 5.985185713e-03f, 1.160663641e-03f, 2.250790790e-04f, 4.364795279e-05f, 8.464330808e-06f, 1.641426263e-06f};
        constexpr float FB[16] = {1.591549431e-01f, 8.949940161e-02f, 5.032921210e-02f, 2.830219583e-02f, 1.591549431e-02f, 8.949940161e-03f, 5.032921210e-03f, 2.830219583e-03f,
                                  1.591549431e-03f, 8.949940161e-04f, 5.032921210e-04f, 2.830219583e-04f, 1.591549431e-04f, 8.949940161e-05f, 5.032921210e-05f, 2.830219583e-05f};
        float fq8[8];
#pragma unroll
        for (int k = 0; k < 8; ++k) fq8[k] = (ROPE == 1) ? FA[k] : ((fq & 1) ? FB[8 + k] : FB[k]);
        const bool rot = (ROPE == 2) || (fq == 0);
#pragma unroll
        for (int ai = 0; ai < 2; ++ai)
#pragma unroll
            for (int m = 0; m < 4; ++m) {
                const int row = row0 + ai * HALF + m * 16; const int s = row & (SEQ - 1);
                f32x4 y[2][2]; float ss = 0.f;
#pragma unroll
                for (int bj = 0; bj < 2; ++bj)
#pragma unroll
                    for (int n = 0; n < 2; ++n) { y[bj][n] = acc[ai][bj][m][n]; const f32x4 q = y[bj][n] * y[bj][n]; ss += (q[0] + q[1]) + (q[2] + q[3]); }
                ss += shx(ss, 16, fr + 16 * fq); ss += shx(ss, 32, fr + 16 * fq);
                const float rinv = __builtin_amdgcn_rsqf(ss * (1.0f / 64.0f) + 1e-6f);
#pragma unroll
                for (int bj = 0; bj < 2; ++bj)
#pragma unroll
                    for (int n = 0; n < 2; ++n) y[bj][n] = y[bj][n] * rinv * g[bj][n];
                if (ROPE != 0) {
                    const float pos = (float)((ROPE == 1) ? s : (fq < 2 ? (s >> 6) : (s & 63)));
#pragma unroll
                    for (int n = 0; n < 2; ++n)
#pragma unroll
                        for (int j = 0; j < 4; ++j) {
                            const float xr = __builtin_amdgcn_fractf(pos * fq8[4 * n + j]);
                            const float c = rot ? __builtin_amdgcn_cosf(xr) : 1.0f, s_ = rot ? __builtin_amdgcn_sinf(xr) : 0.0f;
                            const float x1 = y[0][n][j], x2 = y[1][n][j];
                            y[0][n][j] = x1 * c - x2 * s_; y[1][n][j] = x2 * c + x1 * s_;
                        }
                }
                bf16_t* rowp = dst + (size_t)row * ld + hcol + 8 * fq;
#pragma unroll
                for (int bj = 0; bj < 2; ++bj) *(u32x4*)(rowp + 32 * bj) = pack8(y[bj][0] * scale, y[bj][1] * scale);
            }
    }
    __device__ __forceinline__ void operator()(AccRef acc, const Unit& u, int wr, int wc, int fr_, int fq_) const {
        int fr = fr_, fq = fq_; asm volatile("" : "+v"(fr), "+v"(fq));
        const int pn = u.pn; const int row0 = u.pm * BM + wr * 64 + fr;
        if (pn >= 9) {
            unsigned char* base = (unsigned char*)((pn < 13) ? SA : SB); const int colt = ((pn - 9) & 3) * 256 + wc * 64 + 16 * fq;
#pragma unroll
            for (int ai = 0; ai < 2; ++ai)
#pragma unroll
                for (int m = 0; m < 4; ++m) { u32x4 w;
#pragma unroll
                    for (int bj = 0; bj < 2; ++bj) { f32x4 v0 = acc[ai][bj][m][0], v1 = acc[ai][bj][m][1];
#pragma unroll
                        for (int j = 0; j < 4; ++j) { v0[j] = sigmoid_f(v0[j]); v1[j] = sigmoid_f(v1[j]); }
                        const unsigned lo = pack4_fp8(v0[0], v0[1], v0[2], v0[3]), hi = pack4_fp8(v1[0], v1[1], v1[2], v1[3]);
                        if (bj == 0) { w.x = lo; w.y = hi; } else { w.z = lo; w.w = hi; } }
                    *(u32x4*)(base + (size_t)(row0 + ai * HALF + m * 16) * DM + colt) = w; }
        } else if (pn == 4 || pn == 5) {
            const int colt = (pn - 4) * 256 + wc * 64 + 16 * fq;
#pragma unroll
            for (int ai = 0; ai < 2; ++ai)
#pragma unroll
                for (int m = 0; m < 4; ++m) { bf16_t* rowp = VA + (size_t)(row0 + ai * HALF + m * 16) * 512 + colt;
#pragma unroll
                    for (int bj = 0; bj < 2; ++bj) *(u32x4*)(rowp + 8 * bj) = pack8(acc[ai][bj][m][0], acc[ai][bj][m][1]); }
        } else if (pn < 2)  head_tile<1>(acc, QA, 512, 64 * (4 * pn + wc), 0, QSCALE, row0, fr, fq);
        else if (pn < 4)    head_tile<1>(acc, KA, 512, 64 * (4 * (pn - 2) + wc), 1, 1.0f, row0, fr, fq);
        else if (pn < 8)    head_tile<2>(acc, QB, 512, 64 * (4 * (pn - 6) + wc), 2, QSCALE, row0, fr, fq);
        else if (wc < 2)    head_tile<2>(acc, KB, 128, 64 * wc, 3, 1.0f, row0, fr, fq);
        else {
#pragma unroll
            for (int ai = 0; ai < 2; ++ai)
#pragma unroll
                for (int m = 0; m < 4; ++m) { bf16_t* rowp = VB + (size_t)(row0 + ai * HALF + m * 16) * 128 + 64 * (wc - 2) + 8 * fq;
#pragma unroll
                    for (int bj = 0; bj < 2; ++bj) *(u32x4*)(rowp + 32 * bj) = pack8(acc[ai][bj][m][0], acc[ai][bj][m][1]); }
        }
    }
};

struct EpiMergeFused {
    static constexpr bool PERM = true, MIDK = true;
    bf16_t* MG; const unsigned char* GA; const unsigned char* GB;
    __device__ __forceinline__ void mid(f32x4 (&acc)[2][2][4][2], const Unit& u, int wr, int wc, int fr_, int fq_) const {
        int fr = fr_, fq = fq_; asm volatile("" : "+v"(fr), "+v"(fq));
        const int row0 = u.pm * BM + wr * 64 + fr, col0 = u.pn * BM + wc * 64 + 16 * fq;
#pragma unroll
        for (int ai = 0; ai < 2; ++ai)
#pragma unroll
            for (int m = 0; m < 4; ++m) { const size_t ro = (size_t)(row0 + ai * HALF + m * 16) * DM + col0;
                const u32x4 a = *(const u32x4*)(GA + ro), b = *(const u32x4*)(GB + ro);
#pragma unroll
                for (int bj = 0; bj < 2; ++bj) {
                    float sa[8], sb[8]; unpack8_fp8(bj ? (u32x2){a.z, a.w} : (u32x2){a.x, a.y}, sa); unpack8_fp8(bj ? (u32x2){b.z, b.w} : (u32x2){b.x, b.y}, sb);
#pragma unroll
                    for (int n = 0; n < 2; ++n)
#pragma unroll
                        for (int j = 0; j < 4; ++j) acc[ai][bj][m][n][j] *= sa[4 * n + j] * __builtin_amdgcn_rcpf(fmaxf(sb[4 * n + j], 1e-12f));
                } }
    }
    __device__ __forceinline__ void operator()(AccRef acc, const Unit& u, int wr, int wc, int fr_, int fq_) const {
        int fr = fr_, fq = fq_; asm volatile("" : "+v"(fr), "+v"(fq));
        const int row0 = u.pm * BM + wr * 64 + fr, col0 = u.pn * BM + wc * 64 + 16 * fq;
#pragma unroll
        for (int ai = 0; ai < 2; ++ai)
#pragma unroll
            for (int m = 0; m < 4; ++m) { const size_t ro = (size_t)(row0 + ai * HALF + m * 16) * DM + col0;
                const u32x4 b = *(const u32x4*)(GB + ro);
#pragma unroll
                for (int bj = 0; bj < 2; ++bj) {
                    float sb[8]; unpack8_fp8(bj ? (u32x2){b.z, b.w} : (u32x2){b.x, b.y}, sb);
                    f32x4 v0 = acc[ai][bj][m][0], v1 = acc[ai][bj][m][1];
#pragma unroll
                    for (int j = 0; j < 4; ++j) { v0[j] *= fmaxf(sb[j], 1e-12f); v1[j] *= fmaxf(sb[4 + j], 1e-12f); }
                    *(u32x4*)(MG + ro + 8 * bj) = pack8(v0, v1); } }
    }
};

struct EpiResidB {
    static constexpr bool PERM = true, MIDK = false;
    const float* Xf; const bf16_t* Xb; bf16_t* O; const float* gate;
    __device__ __forceinline__ void operator()(AccRef acc, const Unit& u, int wr, int wc, int fr_, int fq_) const {
        int fr = fr_, fq = fq_; asm volatile("" : "+v"(fr), "+v"(fq));
        const int row0 = u.pm * BM + wr * 64 + fr, col0 = u.pn * BM + wc * 64 + 16 * fq; const int b = (u.pm * BM) >> 11;
        f32x4 gt[2][2];
#pragma unroll
        for (int bj = 0; bj < 2; ++bj)
#pragma unroll
            for (int n = 0; n < 2; ++n) gt[bj][n] = *(const f32x4*)(gate + (size_t)b * MODW + col0 + 8 * bj + 4 * n);
#pragma unroll
        for (int ai = 0; ai < 2; ++ai)
#pragma unroll
            for (int m = 0; m < 4; ++m) { const size_t ro = (size_t)(row0 + ai * HALF + m * 16) * DM + col0;
#pragma unroll
                for (int bj = 0; bj < 2; ++bj) {
                    f32x4 x0, x1;
                    if (Xf) { x0 = *(const f32x4*)(Xf + ro + 8 * bj); x1 = *(const f32x4*)(Xf + ro + 8 * bj + 4); }
                    else { const u32x4 w = *(const u32x4*)(Xb + ro + 8 * bj); x0 = (f32x4){bf_lo(w.x), bf_hi(w.x), bf_lo(w.y), bf_hi(w.y)}; x1 = (f32x4){bf_lo(w.z), bf_hi(w.z), bf_lo(w.w), bf_hi(w.w)}; }
                    *(u32x4*)(O + ro + 8 * bj) = pack8(x0 + gt[bj][0] * acc[ai][bj][m][0], x1 + gt[bj][1] * acc[ai][bj][m][1]); } }
    }
};

struct EpiSwiGLU {
    static constexpr bool PERM = true, MIDK = false;
    bf16_t* ACT;
    __device__ __forceinline__ void operator()(AccRef acc, const Unit& u, int wr, int wc, int fr_, int fq_) const {
        int fr = fr_, fq = fq_; asm volatile("" : "+v"(fr), "+v"(fq));
        const int row0 = u.pm * BM + wr * 64 + fr, col0 = (u.pn & 3) * HALF + wc * 32 + 8 * fq;
#pragma unroll
        for (int ai = 0; ai < 2; ++ai)
#pragma unroll
            for (int m = 0; m < 4; ++m) { f32x4 r[2];
#pragma unroll
                for (int n = 0; n < 2; ++n)
#pragma unroll
                    for (int j = 0; j < 4; ++j) { const float gg = acc[ai][0][m][n][j], uu = acc[ai][1][m][n][j]; r[n][j] = gg * sigmoid_f(gg) * uu; }
                *(u32x4*)(ACT + (size_t)(row0 + ai * HALF + m * 16) * DFF + col0) = pack8(r[0], r[1]); }
    }
};

struct EpiY {
    static constexpr bool PERM = true, MIDK = false;
    unsigned char* Y;
    __device__ __forceinline__ void operator()(AccRef acc, const Unit& u, int wr, int wc, int fr_, int fq_) const {
        int fr = fr_, fq = fq_; asm volatile("" : "+v"(fr), "+v"(fq));
        const int row0 = u.pm * BM + wr * 64 + fr, col0 = (u.pn & 3) * BM + wc * 64 + 16 * fq;
#pragma unroll
        for (int ai = 0; ai < 2; ++ai)
#pragma unroll
            for (int m = 0; m < 4; ++m) { u32x4 w;
                { const f32x4 a = acc[ai][0][m][0], b = acc[ai][0][m][1]; w.x = pack4_fp8(a[0], a[1], a[2], a[3]); w.y = pack4_fp8(b[0], b[1], b[2], b[3]); }
                { const f32x4 a = acc[ai][1][m][0], b = acc[ai][1][m][1]; w.z = pack4_fp8(a[0], a[1], a[2], a[3]); w.w = pack4_fp8(b[0], b[1], b[2], b[3]); }
                *(u32x4*)(Y + (size_t)(row0 + ai * HALF + m * 16) * DM + col0) = w; }
    }
};
}

__device__ __forceinline__ int dimA(int bj, int r) { return r < 8 ? r + 8 * bj : 16 + (r - 8) + 24 * bj; }
__device__ __forceinline__ int dimB(int bj, int r) { return r < 16 ? r + 16 * bj : 32 + (r - 16) + 16 * bj; }
__device__ __forceinline__ int inproj_srccol(int P) {
    const int pn = P >> 8, p = P & 255, bj = p >> 7, wc = (p >> 5) & 3, r = p & 31;
    if (pn < 2) return 64 * (4 * pn + wc) + dimA(bj, r);
    if (pn < 4) return 512 + 64 * (4 * (pn - 2) + wc) + dimA(bj, r);
    if (pn < 6) return 1024 + 256 * (pn - 4) + 64 * wc + 16 * ((p >> 3) & 3) + 8 * bj + (p & 7);
    if (pn < 8) return 1536 + 64 * (4 * (pn - 6) + wc) + dimB(bj, r);
    if (pn == 8) return wc < 2 ? 2048 + 64 * wc + dimB(bj, r) : 2176 + 64 * (wc - 2) + 32 * bj + r;
    { const int fq = (p >> 3) & 3, r8 = p & 7; return 2304 + 256 * (pn - 9) + 64 * wc + 16 * fq + 8 * bj + r8; }
}

namespace att {
constexpr int KSTR = 144, VSTR = 192;
constexpr int KTILE = 64 * KSTR, VTILE = 64 * VSTR;
constexpr int K_OFF = 0, V_OFF = 2 * KTILE;
constexpr int PRIV_OFF = 0;
__device__ __forceinline__ s16x4 vtr(LAS const char* p) { typedef short v4i16_t __attribute__((ext_vector_type(4)));
    return __builtin_bit_cast(s16x4, __builtin_amdgcn_ds_read_tr16_b64_v4i16((LAS v4i16_t*)p)); }
__device__ __forceinline__ int clamp_tok(int t) { return t < 0 ? 0 : (t > SEQ - 1 ? SEQ - 1 : t); }

__device__ __forceinline__ void qk_tile(f32x16& p0, f32x16& p1, const bf16x8 (&kf)[8], const bf16x8 (&qr)[4]) {
    const f32x16 z = {0.f, 0.f, 0.f, 0.f, 0.f, 0.f, 0.f, 0.f, 0.f, 0.f, 0.f, 0.f, 0.f, 0.f, 0.f, 0.f};
    p0 = __builtin_amdgcn_mfma_f32_32x32x16_bf16(kf[0], qr[0], z, 0, 0, 0); p1 = __builtin_amdgcn_mfma_f32_32x32x16_bf16(kf[1], qr[0], z, 0, 0, 0);
#pragma unroll
    for (int d0 = 1; d0 < 4; ++d0) { p0 = __builtin_amdgcn_mfma_f32_32x32x16_bf16(kf[2 * d0], qr[d0], p0, 0, 0, 0); p1 = __builtin_amdgcn_mfma_f32_32x32x16_bf16(kf[2 * d0 + 1], qr[d0], p1, 0, 0, 0); }
}
template <bool MASK>
__device__ __forceinline__ void exp_tile(const f32x16& p0, const f32x16& p1, float& lsum, bf16x8 (&pf)[2][2], int mbase, int mR, int dk) {
    float e0[16], e1[16]; float ls = 0.f;
#pragma unroll
    for (int r = 0; r < 16; ++r) {
        e0[r] = __builtin_amdgcn_exp2f(p0[r]); e1[r] = __builtin_amdgcn_exp2f(p1[r]);
        if (MASK) {
            const int c0 = (r & 3) + 8 * (r >> 2);
            e0[r] = ((unsigned)(mbase + dk * c0) <= (unsigned)mR) ? e0[r] : 0.f;
            e1[r] = ((unsigned)(mbase + dk * (c0 + 32)) <= (unsigned)mR) ? e1[r] : 0.f;
        }
        ls += e0[r] + e1[r];
    }
    lsum += ls;
#pragma unroll
    for (int s = 0; s < 2; ++s) {
        u32x4 w0, w1;
        w0.x = cvt_pk_bf16(e0[8 * s + 0], e0[8 * s + 1]); w0.y = cvt_pk_bf16(e0[8 * s + 2], e0[8 * s + 3]); w0.z = cvt_pk_bf16(e0[8 * s + 4], e0[8 * s + 5]); w0.w = cvt_pk_bf16(e0[8 * s + 6], e0[8 * s + 7]);
        w1.x = cvt_pk_bf16(e1[8 * s + 0], e1[8 * s + 1]); w1.y = cvt_pk_bf16(e1[8 * s + 2], e1[8 * s + 3]); w1.z = cvt_pk_bf16(e1[8 * s + 4], e1[8 * s + 5]); w1.w = cvt_pk_bf16(e1[8 * s + 6], e1[8 * s + 7]);
        pf[0][s] = __builtin_bit_cast(bf16x8, w0); pf[1][s] = __builtin_bit_cast(bf16x8, w1);
    }
}
__device__ __forceinline__ void vread(bf16x8 (&vf)[4], LAS const char* vb, int d0) {
#pragma unroll
    for (int blk = 0; blk < 2; ++blk)
#pragma unroll
        for (int s = 0; s < 2; ++s) {
            const s16x4 lo = vtr(vb + (32 * blk + 16 * s) * VSTR + 64 * d0), hi = vtr(vb + (32 * blk + 16 * s + 8) * VSTR + 64 * d0);
            vf[2 * blk + s] = (bf16x8){lo[0], lo[1], lo[2], lo[3], hi[0], hi[1], hi[2], hi[3]};
        }
}
__device__ __forceinline__ void pv_half(f32x16& od, const bf16x8 (&vf)[4], const bf16x8 (&pf)[2][2]) {
#pragma unroll
    for (int blk = 0; blk < 2; ++blk)
#pragma unroll
        for (int s = 0; s < 2; ++s) od = __builtin_amdgcn_mfma_f32_32x32x16_bf16(vf[2 * blk + s], pf[blk][s], od, 0, 0, 0);
}
__device__ __forceinline__ void mask_params(int dk, int tk0, int tq, int hi, int& mbase, int& mR) {
    const int dlo = (-64 * dk > -tq) ? -64 * dk : -tq, dhi = (64 * dk < SEQ - 1 - tq) ? 64 * dk : SEQ - 1 - tq;
    const int dA = tk0 + 4 * dk * hi - tq;
    mR = dhi - dlo; mbase = ((dA & (dk - 1)) == 0) ? dA - dlo : 0x7fffffff;
}

template <bool MASKED>
__device__ __forceinline__ void dense64_loop(LAS char* lds, const bf16_t* Kg, const bf16_t* Vg, int ld, int tok0, int ntiles,
                                             const bf16x8 (&qr)[2][4], f32x16 (&o)[2][2], float (&lsum)[2], int tq0, int tq1, int lane_, int wave) {
    constexpr int V2_OFF = 2 * KTILE;
    u32x4 kreg, vreg;
#define D64_LANE() int ln_ = lane_; asm volatile("" : "+v"(ln_)); const int tid_ = wave * 64 + ln_, srow = tid_ >> 3, sch = tid_ & 7
#define D64_LD(t) do { D64_LANE(); int tk_ = tok0 + 64 * (t) + srow; if (MASKED) tk_ = clamp_tok(tk_); kreg = *(const u32x4*)(Kg + (size_t)tk_ * ld + sch * 8); vreg = *(const u32x4*)(Vg + (size_t)tk_ * ld + sch * 8); } while (0)
#define D64_ST(t) do { D64_LANE(); *(LAS u32x4*)(lds + ((t) & 1) * KTILE + srow * KSTR + sch * 16) = kreg; *(LAS u32x4*)(lds + V2_OFF + ((t) & 1) * VTILE + srow * VSTR + sch * 16) = vreg; } while (0)
    D64_LD(0); D64_ST(0); D64_LD(1);
    for (int t = 0; t < ntiles; ++t) {
        __syncthreads();
        if (t + 1 < ntiles) D64_ST(t + 1);
        if (t + 2 < ntiles) D64_LD(t + 2);
        int lane = lane_; asm volatile("" : "+v"(lane));
        const int hi = lane >> 5;
        const int vlane = (4 * hi + ((lane & 15) >> 2)) * VSTR + (16 * ((lane >> 4) & 1) + 4 * (lane & 3)) * 2;
        const int klane = (lane & 31) * KSTR + 16 * hi;
        bf16x8 kf[8];
        { LAS const char* kb_ = lds + (t & 1) * KTILE + klane;
#pragma unroll
          for (int d0 = 0; d0 < 4; ++d0)
#pragma unroll
              for (int blk = 0; blk < 2; ++blk) kf[2 * d0 + blk] = *(const LAS bf16x8*)(kb_ + 32 * blk * KSTR + 32 * d0); }
        f32x16 p[2][2];
        bf16x8 vfa[4], vfb[4];
        LAS const char* vb_ = lds + V2_OFF + (t & 1) * VTILE + vlane;
        vread(vfa, vb_, 0); vread(vfb, vb_, 1);
        __builtin_amdgcn_sched_barrier(0);
        qk_tile(p[0][0], p[0][1], kf, qr[0]);
        qk_tile(p[1][0], p[1][1], kf, qr[1]);
#pragma unroll
        for (int g = 0; g < 2; ++g) {
            bf16x8 pf[2][2]; int mb = 0, mr = 0;
            if (MASKED) mask_params(1, tok0 + 64 * t, g ? tq1 : tq0, hi, mb, mr);
            exp_tile<MASKED>(p[g][0], p[g][1], lsum[g], pf, mb, mr, 1);
            pv_half(o[g][0], vfa, pf); pv_half(o[g][1], vfb, pf);
        }
    }
#undef D64_LANE
#undef D64_LD
#undef D64_ST
}
__device__ __forceinline__ void dense64_lag_loop(LAS char* lds, const bf16_t* Kg, const bf16_t* Vg, int ld, int ntiles,
                                                 const bf16x8 (&qr)[2][4], f32x16 (&o)[2][2], float (&lsum)[2], int lane_, int wave, const bool lag) {
    constexpr int V2_OFF = 2 * KTILE;
    u32x4 kreg, vreg;
#define D64_LANE() int ln_ = lane_; asm volatile("" : "+v"(ln_)); const int tid_ = wave * 64 + ln_, srow = tid_ >> 3, sch = tid_ & 7
#define D64_LD(t) do { D64_LANE(); const int tk_ = 64 * (t) + srow; kreg = *(const u32x4*)(Kg + (size_t)tk_ * ld + sch * 8); vreg = *(const u32x4*)(Vg + (size_t)tk_ * ld + sch * 8); } while (0)
#define D64_ST(t) do { D64_LANE(); *(LAS u32x4*)(lds + ((t) & 1) * KTILE + srow * KSTR + sch * 16) = kreg; *(LAS u32x4*)(lds + V2_OFF + ((t) % 3) * VTILE + srow * VSTR + sch * 16) = vreg; } while (0)
#define D64_QK(t) do { int lane = lane_; asm volatile("" : "+v"(lane)); const int klane = (lane & 31) * KSTR + 16 * (lane >> 5); bf16x8 kf[8]; LAS const char* kb_ = lds + ((t) & 1) * KTILE + klane; \
        _Pragma("unroll") for (int d0 = 0; d0 < 4; ++d0) _Pragma("unroll") for (int blk = 0; blk < 2; ++blk) kf[2 * d0 + blk] = *(const LAS bf16x8*)(kb_ + 32 * blk * KSTR + 32 * d0); \
        qk_tile(p[0][0], p[0][1], kf, qr[0]); qk_tile(p[1][0], p[1][1], kf, qr[1]); } while (0)
#define D64_PV(t) do { int lane = lane_; asm volatile("" : "+v"(lane)); const int hi = lane >> 5; const int vlane = (4 * hi + ((lane & 15) >> 2)) * VSTR + (16 * ((lane >> 4) & 1) + 4 * (lane & 3)) * 2; \
        bf16x8 vfa[4], vfb[4]; LAS const char* vb_ = lds + V2_OFF + ((t) % 3) * VTILE + vlane; vread(vfa, vb_, 0); vread(vfb, vb_, 1); \
        _Pragma("unroll") for (int g = 0; g < 2; ++g) { bf16x8 pf[2][2]; exp_tile<false>(p[g][0], p[g][1], lsum[g], pf, 0, 0, 0); pv_half(o[g][0], vfa, pf); pv_half(o[g][1], vfb, pf); } } while (0)
    f32x16 p[2][2];
    D64_LD(0); D64_ST(0);
    if (!lag) {
        D64_LD(1);
        for (int t = 0; t < ntiles; ++t) {
            __syncthreads();
            if (t + 1 < ntiles) D64_ST(t + 1);
            if (t + 2 < ntiles) D64_LD(t + 2);
            D64_QK(t);
            D64_PV(t);
        }
        __syncthreads();
    } else {
        D64_LD(1);
        __syncthreads();
        D64_ST(1); D64_LD(2);
        D64_QK(0);
        for (int t = 1; t < ntiles; ++t) {
            __syncthreads();
            if (t + 1 < ntiles) D64_ST(t + 1);
            if (t + 2 < ntiles) D64_LD(t + 2);
            D64_PV(t - 1);
            __builtin_amdgcn_sched_barrier(0);
            D64_QK(t);
        }
        __syncthreads();
        D64_PV(ntiles - 1);
    }
#undef D64_LANE
#undef D64_LD
#undef D64_ST
#undef D64_QK
#undef D64_PV
}
__device__ __forceinline__ void priv_kload(bf16x8 (&kf)[8], const bf16_t* Kg, int ld, int tk0, int dk, int lane_) {
    int lane = lane_; asm volatile("" : "+v"(lane));
    const int hi = lane >> 5;
#pragma unroll
    for (int blk = 0; blk < 2; ++blk) { const int tk = clamp_tok(tk0 + dk * (32 * blk + (lane & 31)));
#pragma unroll
        for (int d0 = 0; d0 < 4; ++d0) kf[2 * d0 + blk] = *(const bf16x8*)(Kg + (size_t)tk * ld + 16 * d0 + 8 * hi); }
}
__device__ __forceinline__ void priv2_step(bf16x8 (&kf)[8], LAS char* vpriv, const bf16_t* Kg, const bf16_t* Vg, int ld, int tk0, int dk, bool g0, bool g1,
                                           bool has_next, int tk0n, int dkn, const bf16x8 (&qr)[2][4], f32x16 (&o)[2][2], float (&lsum)[2], int tq0, int tq1, int lane_) {
    int lane = lane_; asm volatile("" : "+v"(lane));
    const int hi = lane >> 5;
    const int vlane = (4 * hi + ((lane & 15) >> 2)) * VSTR + (16 * ((lane >> 4) & 1) + 4 * (lane & 3)) * 2;
    u32x4 vr[8];
#pragma unroll
    for (int i = 0; i < 8; ++i) { const int idx = i * 64 + lane, row = idx >> 3, ch = idx & 7; const int tk = clamp_tok(tk0 + dk * row); vr[i] = *(const u32x4*)(Vg + (size_t)tk * ld + ch * 8); }
    const int gfirst = g0 ? 0 : 1, glast = g1 ? 1 : 0;
    f32x16 p0, p1; bf16x8 pf[2][2]; int mb, mr;
    if (gfirst == 0) qk_tile(p0, p1, kf, qr[0]); else qk_tile(p0, p1, kf, qr[1]);
    __builtin_amdgcn_sched_barrier(0);
#pragma unroll
    for (int i = 0; i < 8; ++i) { const int idx = i * 64 + lane; *(LAS u32x4*)(vpriv + (idx >> 3) * VSTR + (idx & 7) * 16) = vr[i]; }
    if (glast == gfirst) { __builtin_amdgcn_sched_barrier(0); if (has_next) priv_kload(kf, Kg, ld, tk0n, dkn, lane); __builtin_amdgcn_sched_barrier(0); }
    mask_params(dk, tk0, gfirst ? tq1 : tq0, hi, mb, mr);
    if (gfirst == 0) exp_tile<true>(p0, p1, lsum[0], pf, mb, mr, dk); else exp_tile<true>(p0, p1, lsum[1], pf, mb, mr, dk);
    { bf16x8 vfa[4], vfb[4]; vread(vfa, vpriv + vlane, 0); vread(vfb, vpriv + vlane, 1);
      if (gfirst == 0) { pv_half(o[0][0], vfa, pf); pv_half(o[0][1], vfb, pf); } else { pv_half(o[1][0], vfa, pf); pv_half(o[1][1], vfb, pf); } }
    if (glast != gfirst) {
        qk_tile(p0, p1, kf, qr[1]);
        __builtin_amdgcn_sched_barrier(0);
        if (has_next) priv_kload(kf, Kg, ld, tk0n, dkn, lane);
        __builtin_amdgcn_sched_barrier(0);
        mask_params(dk, tk0, tq1, hi, mb, mr);
        exp_tile<true>(p0, p1, lsum[1], pf, mb, mr, dk);
        bf16x8 vfa[4], vfb[4]; vread(vfa, vpriv + vlane, 0); vread(vfb, vpriv + vlane, 1);
        pv_half(o[1][0], vfa, pf); pv_half(o[1][1], vfb, pf);
    }
}
__device__ __forceinline__ void store_out(const f32x16 (&o)[2], float lsum, bf16_t* dst  , int lane_) {
    int lane = lane_; asm volatile("" : "+v"(lane));
    const int hi = lane >> 5;
    float l = lsum + shx(lsum, 32, lane);
    const float inv = 1.0f / l;
#pragma unroll
    for (int d0 = 0; d0 < 2; ++d0)
#pragma unroll
        for (int gp = 0; gp < 2; ++gp) {
            const int ga = 2 * gp, gb = 2 * gp + 1;
            unsigned a0 = cvt_pk_bf16(o[d0][4 * ga] * inv, o[d0][4 * ga + 1] * inv), a1 = cvt_pk_bf16(o[d0][4 * ga + 2] * inv, o[d0][4 * ga + 3] * inv);
            unsigned b0 = cvt_pk_bf16(o[d0][4 * gb] * inv, o[d0][4 * gb + 1] * inv), b1 = cvt_pk_bf16(o[d0][4 * gb + 2] * inv, o[d0][4 * gb + 3] * inv);
            const auto s0 = __builtin_amdgcn_permlane32_swap(a0, b0, false, false), s1 = __builtin_amdgcn_permlane32_swap(a1, b1, false, false);
            u32x4 w; w.x = s0[0]; w.y = s1[0]; w.z = s0[1]; w.w = s1[1];
            *(u32x4*)(dst + 32 * d0 + 16 * gp + 8 * hi) = w;
        }
}
}

struct Args { const float* in[18]; float* out; unsigned char* ws; int ph_lo, ph_hi; };
constexpr int PH_PRO = 0, PH_L0 = 1, PH_PER_LAYER = 9, PH_FINAL = PH_L0 + 2 * PH_PER_LAYER, NPH = PH_FINAL + 1;
enum { P_NORM1 = 0, P_INPROJ, P_ATTN, P_PAB, P_OUT, P_NORM2, P_PLACE, P_GU, P_DOWN };

__device__ __forceinline__ int tile256_srccol(int P) { const int p = P & 255; return (P & ~255) + 64 * ((p >> 5) & 3) + 16 * ((p >> 3) & 3) + 8 * (p >> 7) + (p & 7); }
template <int MAP>
__device__ __forceinline__ void transpose_item(const float* W, int N, int col0, bf16_t* dst, int dst_row0, int K, int k0, LAS float* scr, int lane, int dk0 = 0  ) {
    const int sc = (MAP == 1) ? inproj_srccol(col0 + lane) : (MAP == 2) ? tile256_srccol(col0 + lane) : col0 + lane;
    const float* src = W + (size_t)k0 * N + sc;
#pragma unroll 16
    for (int i = 0; i < 64; ++i) scr[i * 65 + lane] = src[(size_t)i * N];
    asm volatile("s_waitcnt lgkmcnt(0)" ::: "memory");
    const int c = lane & 7, nn = lane >> 3;
#pragma unroll
    for (int j = 0; j < 8; ++j) { const int n = nn + 8 * j; const LAS float* s = scr + (8 * c) * 65 + n;
        u32x4 w; w.x = cvt_pk_bf16(s[0], s[65]); w.y = cvt_pk_bf16(s[2 * 65], s[3 * 65]); w.z = cvt_pk_bf16(s[4 * 65], s[5 * 65]); w.w = cvt_pk_bf16(s[6 * 65], s[7 * 65]);
        *(u32x4*)(dst + (size_t)(dst_row0 + n) * K + dk0 + k0 + 8 * c) = w; }
    asm volatile("s_waitcnt lgkmcnt(0)" ::: "memory");
}


template <bool XF32, bool COMBINE, bool NORM, bool ROUTER, bool OUTF32>
__device__ __forceinline__ void row_phase(LAS unsigned char* lds, int tid, int lane, int wave, int G, int bx, const float* xf, bf16_t* xb, float* outf, const float* gv,
                                          const float* modl, int sh_off, int sc_off, const float* modprev, bf16_t* Hh, const unsigned char* Ym, const int* Pos, float* Tw,
                                          const bf16_t* Wr, int* Te, int* Trk, int* Cnt) {
    constexpr int RB = COMBINE ? 2 : ROWB;
    LAS float* lgs = (LAS float*)lds;
    LAS int* lcnt = (LAS int*)(lds + 40960);
    asm volatile("" : "+v"(tid), "+v"(lane));
    for (int chunk = bx; chunk < 256; chunk += G) {
        const int b = chunk >> 3;
        if (ROUTER) { if (tid < 32) lcnt[tid] = 0; }
        f32x4 pre[4], shv[4], g2[4];
#pragma unroll
        for (int j = 0; j < 4; ++j) { const int col = 512 * (j >> 1) + 8 * lane + 4 * (j & 1);
            if (NORM) { const f32x4 gg = *(const f32x4*)(gv + col), sc = *(const f32x4*)(modl + (size_t)b * MODW + sc_off + col);
                pre[j] = gg * (1.0f + sc); shv[j] = *(const f32x4*)(modl + (size_t)b * MODW + sh_off + col); }
            if (COMBINE) g2[j] = *(const f32x4*)(modprev + (size_t)b * MODW + 5 * DM + col); }
        f32x4 rawf[XF32 ? RB : 1][4]; u32x4 rawb[XF32 ? 1 : RB][2]; int pp[COMBINE ? RB : 1][2]; float pw[COMBINE ? RB : 1][2];
#define ROW_LOAD(rb_) do { _Pragma("unroll") for (int i = 0; i < RB; ++i) { const size_t ro = (size_t)((rb_) + i) * DM; \
            if (XF32) { _Pragma("unroll") for (int j = 0; j < 4; ++j) rawf[XF32 ? i : 0][j] = *(const f32x4*)(xf + ro + 512 * (j >> 1) + 8 * lane + 4 * (j & 1)); } \
            else { _Pragma("unroll") for (int h = 0; h < 2; ++h) rawb[XF32 ? 0 : i][h] = *(const u32x4*)(xb + ro + 512 * h + 8 * lane); } \
            if (COMBINE) { pp[COMBINE ? i : 0][0] = Pos[2 * ((rb_) + i)]; pp[COMBINE ? i : 0][1] = Pos[2 * ((rb_) + i) + 1]; pw[COMBINE ? i : 0][0] = Tw[2 * ((rb_) + i)]; pw[COMBINE ? i : 0][1] = Tw[2 * ((rb_) + i) + 1]; } } } while (0)
        ROW_LOAD(chunk * 256 + wave * 32);
#pragma unroll 1
        for (int r0 = 0; r0 < 32; r0 += RB) {
            const int rowb = chunk * 256 + wave * 32 + r0;
            f32x4 v[RB][4]; int cp[COMBINE ? RB : 1][2]; float cw[COMBINE ? RB : 1][2];
#pragma unroll
            for (int i = 0; i < RB; ++i) {
                if (XF32) {
#pragma unroll
                    for (int j = 0; j < 4; ++j) v[i][j] = rawf[XF32 ? i : 0][j];
                } else {
#pragma unroll
                    for (int h = 0; h < 2; ++h) { const u32x4 w = rawb[XF32 ? 0 : i][h];
                        v[i][2 * h] = (f32x4){bf_lo(w.x), bf_hi(w.x), bf_lo(w.y), bf_hi(w.y)}; v[i][2 * h + 1] = (f32x4){bf_lo(w.z), bf_hi(w.z), bf_lo(w.w), bf_hi(w.w)}; }
                }
                if (COMBINE) { cp[i][0] = pp[i][0]; cp[i][1] = pp[i][1]; cw[i][0] = pw[i][0]; cw[i][1] = pw[i][1]; }
            }
            u32x2 ya[COMBINE ? RB : 1][2], yc[COMBINE ? RB : 1][2];
            if (COMBINE) {
#pragma unroll
                for (int i = 0; i < RB; ++i)
#pragma unroll
                    for (int h = 0; h < 2; ++h) { ya[i][h] = *(const u32x2*)(Ym + (size_t)cp[i][0] * DM + 512 * h + 8 * lane); yc[i][h] = *(const u32x2*)(Ym + (size_t)cp[i][1] * DM + 512 * h + 8 * lane); }
            }
            if (r0 + RB < 32) ROW_LOAD(rowb + RB);
            if (COMBINE) {
#pragma unroll
                for (int i = 0; i < RB; ++i) {
                    const int row = rowb + i; const float w0 = cw[i][0], w1 = cw[i][1];
#pragma unroll
                    for (int h = 0; h < 2; ++h) { float fa[8], fc[8]; unpack8_fp8(ya[i][h], fa); unpack8_fp8(yc[i][h], fc);
                        const f32x4 m0 = {w0 * fa[0] + w1 * fc[0], w0 * fa[1] + w1 * fc[1], w0 * fa[2] + w1 * fc[2], w0 * fa[3] + w1 * fc[3]};
                        const f32x4 m1 = {w0 * fa[4] + w1 * fc[4], w0 * fa[5] + w1 * fc[5], w0 * fa[6] + w1 * fc[6], w0 * fa[7] + w1 * fc[7]};
                        v[i][2 * h] = v[i][2 * h] + g2[2 * h] * m0; v[i][2 * h + 1] = v[i][2 * h + 1] + g2[2 * h + 1] * m1;
                        if (OUTF32) { *(f32x4*)(outf + (size_t)row * DM + 512 * h + 8 * lane) = v[i][2 * h]; *(f32x4*)(outf + (size_t)row * DM + 512 * h + 8 * lane + 4) = v[i][2 * h + 1]; }
                        else *(u32x4*)(xb + (size_t)row * DM + 512 * h + 8 * lane) = pg8::pack8(v[i][2 * h], v[i][2 * h + 1]); }
                }
            }
            if (NORM) {
                float ss[RB];
#pragma unroll
                for (int i = 0; i < RB; ++i) { ss[i] = 0.f;
#pragma unroll
                    for (int j = 0; j < 4; ++j) { const f32x4 q = v[i][j] * v[i][j]; ss[i] += (q[0] + q[1]) + (q[2] + q[3]); } }
#pragma unroll
                for (int o = 1; o < 64; o <<= 1)
#pragma unroll
                    for (int i = 0; i < RB; ++i) ss[i] += shx(ss[i], o, lane);
#pragma unroll
                for (int i = 0; i < RB; ++i) { const float rstd = __builtin_amdgcn_rsqf(ss[i] * (1.0f / DM) + 1e-6f);
#pragma unroll
                    for (int h = 0; h < 2; ++h) *(u32x4*)(Hh + (size_t)(rowb + i) * DM + 512 * h + 8 * lane) = pg8::pack8(v[i][2 * h] * rstd * pre[2 * h] + shv[2 * h], v[i][2 * h + 1] * rstd * pre[2 * h + 1] + shv[2 * h + 1]); }
            }
        }
#undef ROW_LOAD
        if (ROUTER) {
            __syncthreads();
            const int row0 = chunk * 256 + wave * 32;
            f32x4 ra[2][2];
#pragma unroll
            for (int mt = 0; mt < 2; ++mt)
#pragma unroll
                for (int et = 0; et < 2; ++et) ra[mt][et] = (f32x4){0.f, 0.f, 0.f, 0.f};
#pragma unroll 4
            for (int kk = 0; kk < 32; ++kk) {
                bf16x8 a[2], bb[2];
#pragma unroll
                for (int mt = 0; mt < 2; ++mt) a[mt] = *(const bf16x8*)(Hh + (size_t)(row0 + 16 * mt + (lane & 15)) * DM + 32 * kk + 8 * (lane >> 4));
#pragma unroll
                for (int et = 0; et < 2; ++et) bb[et] = *(const bf16x8*)(Wr + (size_t)(16 * et + (lane & 15)) * DM + 32 * kk + 8 * (lane >> 4));
#pragma unroll
                for (int mt = 0; mt < 2; ++mt)
#pragma unroll
                    for (int et = 0; et < 2; ++et) ra[mt][et] = __builtin_amdgcn_mfma_f32_16x16x32_bf16(a[mt], bb[et], ra[mt][et], 0, 0, 0);
            }
#pragma unroll
            for (int mt = 0; mt < 2; ++mt)
#pragma unroll
                for (int et = 0; et < 2; ++et)
#pragma unroll
                    for (int r = 0; r < 4; ++r) lgs[(wave * 32 + 16 * mt + 4 * (lane >> 4) + r) * 33 + 16 * et + (lane & 15)] = ra[mt][et][r];
            asm volatile("s_waitcnt lgkmcnt(0)" ::: "memory");
            if (lane < 32) {
                const int tl = wave * 32 + lane, tok = chunk * 256 + tl;
                float lg[32]; float M = -3.0e38f;
#pragma unroll
                for (int e = 0; e < 32; ++e) { lg[e] = lgs[tl * 33 + e]; M = fmaxf(M, lg[e]); }
                float bm1 = 0.f, bm2 = 0.f, bsc = -1.f; int bi1 = 0, bi2 = 0, bg = 0;
#pragma unroll
                for (int g = 0; g < 4; ++g) {
                    float m1 = -3.0e38f, m2 = -3.0e38f; int i1 = 0, i2 = 0;
#pragma unroll
                    for (int j = 0; j < 8; ++j) { const float vv = lg[8 * g + j];
                        if (vv > m1) { m2 = m1; i2 = i1; m1 = vv; i1 = j; } else if (vv > m2) { m2 = vv; i2 = j; } }
                    const float sc = expf(m1 - M) + expf(m2 - M);
                    if (sc > bsc) { bsc = sc; bg = g; bm1 = m1; bm2 = m2; bi1 = i1; bi2 = i2; }
                }
                const int e0 = 8 * bg + bi1, e1 = 8 * bg + bi2;
                const float w0 = 1.0f / (1.0f + expf(bm2 - bm1)), w1 = 1.0f - w0;
                const int r0 = __hip_atomic_fetch_add(&lcnt[e0], 1, __ATOMIC_RELAXED, __HIP_MEMORY_SCOPE_WORKGROUP);
                const int r1 = __hip_atomic_fetch_add(&lcnt[e1], 1, __ATOMIC_RELAXED, __HIP_MEMORY_SCOPE_WORKGROUP);
                Te[2 * tok] = e0; Te[2 * tok + 1] = e1; Trk[2 * tok] = r0; Trk[2 * tok + 1] = r1; Tw[2 * tok] = w0; Tw[2 * tok + 1] = w1;
            }
            __syncthreads();
            if (tid < 32) Cnt[chunk * 32 + tid] = lcnt[tid];
            __syncthreads();
        }
    }
}

#define x_in ((const float*)(const GAS float*)args.in[0])
#define c_in ((const float*)(const GAS float*)args.in[1])
#define w_ada ((const float*)(const GAS float*)args.in[2])
#define b_ada ((const float*)(const GAS float*)args.in[3])
#define g_mix ((const float*)(const GAS float*)args.in[4])
#define w_in ((const float*)(const GAS float*)args.in[5])
#define qn_a ((const float*)(const GAS float*)args.in[6])
#define kn_a ((const float*)(const GAS float*)args.in[7])
#define qn_b ((const float*)(const GAS float*)args.in[8])
#define kn_b ((const float*)(const GAS float*)args.in[9])
#define w_pa ((const float*)(const GAS float*)args.in[10])
#define w_pb ((const float*)(const GAS float*)args.in[11])
#define w_out ((const float*)(const GAS float*)args.in[12])
#define g_ffn ((const float*)(const GAS float*)args.in[13])
#define w_router ((const float*)(const GAS float*)args.in[14])
#define w_gate ((const float*)(const GAS float*)args.in[15])
#define w_up ((const float*)(const GAS float*)args.in[16])
#define w_down ((const float*)(const GAS float*)args.in[17])
#define MOD ((float*)(GAS float*)(ws + WS_MOD))
#define XB ((bf16_t*)(GAS bf16_t*)(ws + WS_XB))
#define TE ((int*)(GAS int*)(ws + WS_TE))
#define TRK ((int*)(GAS int*)(ws + WS_TRK))
#define TW ((float*)(GAS float*)(ws + WS_TW))
#define POS ((int*)(GAS int*)(ws + WS_POS))
#define CNT ((int*)(GAS int*)(ws + WS_CNT))
#define BLKE ((int*)(GAS int*)(ws + WS_BLKE))
#define BTOK ((int*)(GAS int*)(ws + WS_BTOK))
#define WR ((bf16_t*)(bf16_t*)(GAS bf16_t*)(ws + WS_WR))
#define H ((bf16_t*)(bf16_t*)(GAS bf16_t*)(ws + WS_H))
#define YAB ((bf16_t*)(GAS bf16_t*)(ws + WS_H))
#define YA ((bf16_t*)(bf16_t*)(GAS bf16_t*)(ws + WS_H))
#define YB ((bf16_t*)(bf16_t*)(GAS bf16_t*)(ws + WS_H + 64 * MiB))
#define QA ((bf16_t*)(bf16_t*)(GAS bf16_t*)(ws + WS_QKV))
#define KA ((bf16_t*)(bf16_t*)(GAS bf16_t*)(ws + WS_QKV + 64 * MiB))
#define VA ((bf16_t*)(bf16_t*)(GAS bf16_t*)(ws + WS_QKV + 128 * MiB))
#define QB ((bf16_t*)(bf16_t*)(GAS bf16_t*)(ws + WS_QKV + 192 * MiB))
#define KB ((bf16_t*)(bf16_t*)(GAS bf16_t*)(ws + WS_QKV + 256 * MiB))
#define VB ((bf16_t*)(bf16_t*)(GAS bf16_t*)(ws + WS_QKV + 272 * MiB))
#define MERGED ((bf16_t*)(bf16_t*)(GAS bf16_t*)(ws + WS_QKV))
#define YM ((unsigned char*)(GAS unsigned char*)(ws + WS_QKV))
#define SA ((bf16_t*)(bf16_t*)(GAS bf16_t*)(ws + WS_GATE))
#define SB ((bf16_t*)(bf16_t*)(GAS bf16_t*)(ws + WS_GATE + 128 * MiB))
#define ACT ((bf16_t*)(bf16_t*)(GAS bf16_t*)(ws + WS_GATE))
#define PHASE_ENTER() int lane; asm volatile("v_mbcnt_lo_u32_b32 %0, -1, 0\n\tv_mbcnt_hi_u32_b32 %0, -1, %0" : "=v"(lane)); const int tid = wave * 64 + lane; GAS unsigned char* ws = ws0; int bx = bx0, vcu = vcu0; asm volatile("" : "+s"(ws), "+s"(bx), "+s"(vcu))

__device__ __forceinline__ bool in_phase(int lo, int hi, int k) { asm volatile("" : "+s"(lo), "+s"(hi)); return lo <= k && k < hi; }
#define PGATE_A SA
#define PGATE_B SB
__global__ void __launch_bounds__(512, 2) fwd_kernel(Args args) {
    extern __shared__ __attribute__((aligned(16))) unsigned char lds_raw[];
    LAS unsigned char* lds = (LAS unsigned char*)lds_raw;
    volatile LAS unsigned* MISC = (volatile LAS unsigned*)(lds + MISC_OFF);
    const int tid0 = threadIdx.x, lane0 = tid0 & 63, wave = __builtin_amdgcn_readfirstlane(tid0 >> 6);
    const int G = gridDim.x, bx0 = blockIdx.x;
    const int vcu0 = (G % 8 == 0) ? (bx0 % 8) * (G / 8) + bx0 / 8 : bx0;
    GAS unsigned char* ws0 = (GAS unsigned char*)args.ws;
    float* out = (float*)(GAS float*)args.out;
    for (int u = tid0; u < 256; u += 512) ((LAS unsigned*)(lds + MISC_OFF))[u] = 0u;
    __syncthreads();
#if MK_ONE_LAUNCH
    XcdBarrier bar = xcd_barrier_post((unsigned*)((GAS unsigned*)(ws0 + WS_CTL) + CW_BAR), MISC + 8);
#define GRID_BAR() do { int l_; asm volatile("v_mbcnt_lo_u32_b32 %0, -1, 0\n\tv_mbcnt_hi_u32_b32 %0, -1, %0" : "=v"(l_)); xcd_barrier(bar, (wave == 0) && (l_ == 0)); } while (0)
#else
#define GRID_BAR() do {} while (0)
#endif
#ifndef PHMASK
#define PHMASK 0xFFFFFFFFu
#endif
#if MK_ONE_LAUNCH
#define IN(k) true
#else
#define IN(k) in_phase(args.ph_lo, args.ph_hi, (k))
#endif
#define EN(bit) ((PHMASK >> (bit)) & 1u)
#define SEAM(k) do { if (IN(k) && IN((k) + 1)) GRID_BAR(); } while (0)

    if (EN(0) && IN(PH_PRO)) {
        PHASE_ENTER();
#pragma unroll 1
        for (int rep = 0; rep < REP_PRO; ++rep) {
        LAS float* scr = (LAS float*)(lds + wave * 16640);
        const int gw = vcu * 8 + wave, NGW = G * 8;
        constexpr int I_IN = 68 * 16, I_PA = 16 * 8, I_OUT = 16 * 16, I_GU = 32 * 2 * 8 * 16, I_DN = 32 * 16 * 8;
        constexpr int I_LAYER = I_IN + 2 * I_PA + I_OUT + I_GU + I_DN;
        for (int it = gw; it < 2 * I_LAYER; it += NGW) {
            const int l = it / I_LAYER; int r = it % I_LAYER;
            if (r < I_IN) { const int nb = r / 16, kb = r % 16;
                transpose_item<1>(w_in + (size_t)l * DM * NC, NC, 64 * nb, (bf16_t*)(GAS bf16_t*)(ws + WS_WIN + l * WIN_BYTES), 64 * nb, DM, 64 * kb, scr, lane); continue; } r -= I_IN;
            if (r < I_PA) { const int nb = r / 8, kb = r % 8;
                transpose_item<2>(w_pa + (size_t)l * 512 * DM, DM, 64 * nb, (bf16_t*)(GAS bf16_t*)(ws + WS_WPA + l * 2 * MiB), 64 * nb, DM, 64 * kb, scr, lane, 0); continue; } r -= I_PA;
            if (r < I_PA) { const int nb = r / 8, kb = r % 8;
                transpose_item<2>(w_pb + (size_t)l * 512 * DM, DM, 64 * nb, (bf16_t*)(GAS bf16_t*)(ws + WS_WPA + l * 2 * MiB), 64 * nb, DM, 64 * kb, scr, lane, 512); continue; } r -= I_PA;
            if (r < I_OUT) { const int nb = r / 16, kb = r % 16;
                transpose_item<2>(w_out + (size_t)l * DM * DM, DM, 64 * nb, (bf16_t*)(GAS bf16_t*)(ws + WS_WOUT + l * 2 * MiB), 64 * nb, DM, 64 * kb, scr, lane); continue; } r -= I_OUT;
            if (r < I_GU) { const int e = r / 256, q = r % 256, up = q / 128, nb = (q % 128) / 16, kb = q % 16;
                const float* src = (up ? w_up : w_gate) + ((size_t)l * NEXP + e) * DM * DFF;
                const int c0 = 64 * nb, drow = 256 * (c0 >> 7) + 128 * up + (c0 & 127);
                transpose_item<0>(src, DFF, c0, (bf16_t*)(GAS bf16_t*)(ws + WS_WGU + ((size_t)l * NEXP + e) * 2 * MiB), drow, DM, 64 * kb, scr, lane); continue; } r -= I_GU;
            { const int e = r / 128, q = r % 128, nb = q / 8, kb = q % 8;
                transpose_item<2>(w_down + ((size_t)l * NEXP + e) * DFF * DM, DM, 64 * nb, (bf16_t*)(GAS bf16_t*)(ws + WS_WDN + ((size_t)l * NEXP + e) * MiB), 64 * nb, DFF, 64 * kb, scr, lane); }
        }
        for (int i = (vcu * 512 + tid); i < 32 * DM; i += G * 512) { const int e = i >> 10, k = i & 1023; WR[i] = (bf16_t)(cvt_pk_bf16(w_router[(size_t)k * NEXP + e], 0.f) & 0xffffu); }
        __syncthreads();
        if (vcu * 8 < 384) {
            LAS float* cond = (LAS float*)lds;
            for (int i = tid; i < NB * DM; i += 512) { const int b = i >> 10, k = i & 1023; const float cv = c_in[i]; cond[k * 32 + b] = cv / (1.0f + expf(-cv)); }
            __syncthreads();
            for (int it = gw; it < 384; it += NGW) {
                const int l = it / 192, n0 = (it % 192) * 32;
                const float* wp = w_ada + (size_t)l * DM * MODW + n0 + (lane & 31) + (size_t)(lane >> 5) * MODW;
                const LAS float* cp = cond + (lane >> 5) * 32 + (lane & 31);
                f32x16 acc;
#pragma unroll
                for (int r = 0; r < 16; ++r) acc[r] = 0.f;
#pragma unroll 16
                for (int k0 = 0; k0 < DM; k0 += 2) acc = __builtin_amdgcn_mfma_f32_32x32x2f32(cp[k0 * 32], wp[(size_t)k0 * MODW], acc, 0, 0, 0);
                const float bias = b_ada[l * MODW + n0 + (lane & 31)];
#pragma unroll
                for (int r = 0; r < 16; ++r) { const int b = (r & 3) + 8 * (r >> 2) + 4 * (lane >> 5); MOD[((size_t)l * NB + b) * MODW + n0 + (lane & 31)] = acc[r] + bias; }
            }
        }
        __syncthreads();
        }
    }
    SEAM(PH_PRO);

    for (int l = 0; l < 2; ++l) {
        const int pb = PH_L0 + l * PH_PER_LAYER;
        if (EN(1) && IN(pb + P_NORM1)) { PHASE_ENTER(); const float* modl = MOD + (size_t)l * NB * MODW;
            if (l == 0) {
#pragma unroll 1
                for (int rep = 0; rep < REP_NORM1; ++rep)
                    row_phase<true, false, true, false, false>(lds, tid, lane, wave, G, bx, x_in, XB, out, g_mix, modl, 0, DM, MOD, H, YM, POS, TW, WR, TE, TRK, CNT);
            } else row_phase<false, true, true, false, false>(lds, tid, lane, wave, G, bx, x_in, XB, out, g_mix + DM, modl, 0, DM, MOD, H, YM, POS, TW, WR, TE, TRK, CNT); }
            {
                SEAM(pb + P_NORM1);
                if (EN(2) && IN(pb + P_INPROJ)) {
                    PHASE_ENTER();
                    pg8::Gemm g{H, (const bf16_t*)(const GAS bf16_t*)(ws + WS_WIN + l * WIN_BYTES), DM}; pg8::StaticOrder S; S.init(TT, NC, G, bx); S.wgm = INPROJ_WGM;
                    LAS float* normw = (LAS float*)(lds + MISC_OFF + 1024);
                    if (tid < 256) { const int sel = tid >> 6, d = tid & 63; const float* srcw = (sel == 0) ? qn_a : (sel == 1) ? kn_a : (sel == 2) ? qn_b : kn_b; normw[tid] = srcw[l * 64 + d]; }
                    __syncthreads();
                    pg8::EpiInProj E{QA, KA, VA, QB, KB, VB, SA, SB, normw};
#pragma unroll 1
                    for (int rep = 0; rep < REP_INPROJ; ++rep)
                    pg8::gemm_phase<pg8::EpiInProj, pg8::StaticOrder>(lds, g, S, E, wave);
                }
                SEAM(pb + P_INPROJ);
                if (EN(3) && IN(pb + P_ATTN)) {
                    PHASE_ENTER(); (void)lane;
                    LAS char* ring = (LAS char*)lds;
#pragma unroll 1
                    for (int rep = 0; rep < REP_ATTB; ++rep)
                    for (int L = vcu; L < NB * 32; L += G) {
                        int lane; asm volatile("v_mbcnt_lo_u32_b32 %0, -1, 0\n\tv_mbcnt_hi_u32_b32 %0, -1, %0" : "=v"(lane)); const int hi = lane >> 5;
                        const int b = L >> 5, kvh = (L >> 4) & 1, qh = 4 * kvh + ((L >> 2) & 3), qb2 = L & 3;
                        const int tq0 = 512 * qb2 + 64 * wave + (lane & 31);
                        bf16x8 qr[2][4];
#pragma unroll
                        for (int g = 0; g < 2; ++g)
#pragma unroll
                            for (int d0 = 0; d0 < 4; ++d0) qr[g][d0] = *(const bf16x8*)(QB + ((size_t)b * SEQ + tq0 + 32 * g) * 512 + qh * 64 + 16 * d0 + 8 * hi);
                        f32x16 o[2][2]; float lsum[2] = {0.f, 0.f};
#pragma unroll
                        for (int r = 0; r < 16; ++r) { o[0][0][r] = 0.f; o[0][1][r] = 0.f; o[1][0][r] = 0.f; o[1][1][r] = 0.f; }
                        __syncthreads();
                        att::dense64_lag_loop(ring, KB + (size_t)b * SEQ * 128 + kvh * 64, VB + (size_t)b * SEQ * 128 + kvh * 64, 128, 32, qr, o, lsum, lane, wave, wave >= 4);
                        { int l2; asm volatile("v_mbcnt_lo_u32_b32 %0, -1, 0\n\tv_mbcnt_hi_u32_b32 %0, -1, %0" : "=v"(l2)); const int tqs = 512 * qb2 + 64 * wave + (l2 & 31);
#pragma unroll
                          for (int g = 0; g < 2; ++g) att::store_out(o[g], lsum[g], YAB + ((size_t)b * SEQ + tqs + 32 * g) * DM + 512 + qh * 64, l2); }
                    }
#pragma unroll 1
                    for (int rep = 0; rep < REP_ATTA; ++rep)
                    for (int L = vcu; L < NB * 32; L += G) {
                        int lane; asm volatile("v_mbcnt_lo_u32_b32 %0, -1, 0\n\tv_mbcnt_hi_u32_b32 %0, -1, %0" : "=v"(lane)); const int hi = lane >> 5;
                        const int b = L >> 5, h = (L >> 2) & 7, tb2 = L & 3, base = 512 * tb2;
                        const int tq0 = base + 16 * (lane & 31) + wave, tq1 = tq0 + 8;
                        const bf16_t* Kg = KA + (size_t)b * SEQ * 512 + h * 64; const bf16_t* Vg = VA + (size_t)b * SEQ * 512 + h * 64;
                        bf16x8 qr[2][4];
#pragma unroll
                        for (int g = 0; g < 2; ++g)
#pragma unroll
                            for (int d0 = 0; d0 < 4; ++d0) qr[g][d0] = *(const bf16x8*)(QA + ((size_t)b * SEQ + tq0 + 8 * g) * 512 + h * 64 + 16 * d0 + 8 * hi);
                        f32x16 o[2][2]; float lsum[2] = {0.f, 0.f};
#pragma unroll
                        for (int r = 0; r < 16; ++r) { o[0][0][r] = 0.f; o[0][1][r] = 0.f; o[1][0][r] = 0.f; o[1][1][r] = 0.f; }
                        __syncthreads();
                        att::dense64_loop<true>(ring, Kg, Vg, 512, base - 64, 10, qr, o, lsum, tq0, tq1, lane, wave);
                        __syncthreads();
                        {
                            LAS char* vpriv = ring + att::PRIV_OFF + wave * att::VTILE;
#define A_TK0(j) ((j) < 4 ? base + wave - 256 + 256 * (j) : wave + 8 * (((j) - 4) >> 1) + 1024 * (((j) - 4) & 1))
#define A_DK(j) ((j) < 4 ? 4 : 16)
                            bf16x8 kf[8];
                            att::priv_kload(kf, Kg, 512, A_TK0(0), 4, lane);
#pragma unroll 1
                            for (int j = 0; j < 8; ++j) {
                                const bool p2 = j < 4; const int g = (j - 4) >> 1;
                                att::priv2_step(kf, vpriv, Kg, Vg, 512, A_TK0(j), A_DK(j), p2 || g == 0, p2 || g == 1, j + 1 < 8, A_TK0(j + 1), A_DK(j + 1), qr, o, lsum, tq0, tq1, lane);
                            }
#undef A_TK0
#undef A_DK
                        }
                        { int l2; asm volatile("v_mbcnt_lo_u32_b32 %0, -1, 0\n\tv_mbcnt_hi_u32_b32 %0, -1, %0" : "=v"(l2)); const int tqs = base + 16 * (l2 & 31) + wave;
#pragma unroll
                          for (int g = 0; g < 2; ++g) att::store_out(o[g], lsum[g], YAB + ((size_t)b * SEQ + tqs + 8 * g) * DM + h * 64, l2); }
                    }
                    __syncthreads();
                }
                SEAM(pb + P_ATTN);
                if (EN(4) && IN(pb + P_PAB)) {
                    PHASE_ENTER();
                    pg8::StaticOrder S; S.init(TT, DM, G, bx); S.wgm = N1K_WGM;
                    pg8::Gemm g{YAB, (const bf16_t*)(const GAS bf16_t*)(ws + WS_WPA + l * 2 * MiB), DM}; pg8::EpiMergeFused E{MERGED, (const unsigned char*)PGATE_A, (const unsigned char*)PGATE_B};
#pragma unroll 1
                    for (int rep = 0; rep < REP_PAB; ++rep)
                    pg8::gemm_phase<pg8::EpiMergeFused, pg8::StaticOrder>(lds, g, S, E, wave);
                }
                SEAM(pb + P_PAB);
                if (EN(5) && IN(pb + P_OUT)) {
                    PHASE_ENTER(); const float* modl = MOD + (size_t)l * NB * MODW;
                    pg8::Gemm g{MERGED, (const bf16_t*)(const GAS bf16_t*)(ws + WS_WOUT + l * 2 * MiB), DM}; pg8::StaticOrder S; S.init(TT, DM, G, bx); S.rowmajor = OUT_ROWMAJOR; S.wgm = N1K_WGM;
                    pg8::EpiResidB E{(l == 0) ? x_in : (const float*)nullptr, XB, XB, modl + 2 * DM};
#pragma unroll 1
                    for (int rep = 0; rep < ((l == 0) ? REP_OUT : 1); ++rep)
                    pg8::gemm_phase<pg8::EpiResidB, pg8::StaticOrder>(lds, g, S, E, wave);
                }
                SEAM(pb + P_OUT);
            }
        if (EN(6) && IN(pb + P_NORM2)) { PHASE_ENTER(); const float* modl = MOD + (size_t)l * NB * MODW;
#pragma unroll 1
            for (int rep = 0; rep < REP_NORM2; ++rep)
            row_phase<false, false, true, true, false>(lds, tid, lane, wave, G, bx, x_in, XB, out, g_ffn + l * DM, modl, 3 * DM, 4 * DM, MOD, H, YM, POS, TW, WR, TE, TRK, CNT); }
        SEAM(pb + P_NORM2);
        if (EN(7) && IN(pb + P_PLACE)) {
            PHASE_ENTER();
            LAS int* part_tot = (LAS int*)lds;
            LAS int* part_pre = part_tot + 512;
            LAS int* basee = part_pre + 512;
            LAS int* pstart = basee + 32;
            LAS int* pend = pstart + 32;
            LAS int* tote = pend + 32;
            for (int chunk = bx; chunk < 256; chunk += G) {
                { const int e = tid & 31, part = tid >> 5; int st = 0, sp = 0;
                    for (int q = 0; q < 16; ++q) { const int ch = part * 16 + q; const int v = CNT[ch * 32 + e]; st += v; sp += (ch < chunk) ? v : 0; }
                    part_tot[part * 32 + e] = st; part_pre[part * 32 + e] = sp; }
                __syncthreads();
                if (tid < 32) { int st = 0, sp = 0; for (int q = 0; q < 16; ++q) { st += part_tot[q * 32 + tid]; sp += part_pre[q * 32 + tid]; } tote[tid] = st; basee[tid] = sp; }
                __syncthreads();
                if (tid == 0) { int run = 0; for (int e = 0; e < 32; ++e) { const int padded = (tote[e] + 255) & ~255; pstart[e] = run; basee[e] += run; run += padded; pend[e] = run; } }
                __syncthreads();
                { const int tok = chunk * 256 + (tid >> 1), slot = tid & 1; const int e = TE[2 * tok + slot], rk = TRK[2 * tok + slot]; const int dest = basee[e] + rk;
                    BTOK[dest] = tok; POS[2 * tok + slot] = dest; }
                if (chunk < 32) { const int e = chunk; const int from = pstart[e] + tote[e], n = pend[e] - from; if (tid < n) BTOK[from + tid] = 0; }
                if (chunk == 0) {
                    for (int blk = tid; blk < NBLK; blk += 512) { int e = 0; for (int q = 0; q < 32; ++q) e += (pend[q] <= blk * 256) ? 1 : 0; BLKE[blk] = e > 31 ? 31 : e; }
                    if (tid == 0) BLKE[1000] = pend[31] >> 8;
                }
                __syncthreads();
            }
        }
        SEAM(pb + P_PLACE);
        if (EN(8) && IN(pb + P_GU)) {
            PHASE_ENTER();
            const int nused = BLKE[1000];
            pg8::Gemm g{H, (const bf16_t*)(const GAS bf16_t*)(ws + WS_WGU + (size_t)l * NEXP * 2 * MiB), DM};
            pg8::MoeOrder S{BLKE, BTOK, 4 * nused, G, vcu};
            pg8::EpiSwiGLU E{ACT};
#pragma unroll 1
            for (int rep = 0; rep < REP_GU; ++rep)
            pg8::gemm_phase<pg8::EpiSwiGLU, pg8::MoeOrder>(lds, g, S, E, wave);
        }
        SEAM(pb + P_GU);
        if (EN(9) && IN(pb + P_DOWN)) {
            PHASE_ENTER();
            const int nused = BLKE[1000];
            pg8::Gemm g{ACT, (const bf16_t*)(const GAS bf16_t*)(ws + WS_WDN + (size_t)l * NEXP * MiB), DFF};
            pg8::MoeOrder S{BLKE, nullptr, 4 * nused, G, vcu};
            pg8::EpiY E{YM};
#pragma unroll 1
            for (int rep = 0; rep < REP_DOWN; ++rep)
            pg8::gemm_phase<pg8::EpiY, pg8::MoeOrder>(lds, g, S, E, wave);
        }
        SEAM(pb + P_DOWN);
    }
    if (EN(10) && IN(PH_FINAL)) {
        PHASE_ENTER();
        row_phase<false, true, false, false, true>(lds, tid, lane, wave, G, bx, x_in, XB, out, g_ffn, MOD, 0, 0, MOD + (size_t)NB * MODW, H, YM, POS, TW, WR, TE, TRK, CNT);
    }
#undef IN
#undef SEAM
#undef GRID_BAR
}

extern "C" void kernel_launch(void* const* d_in, const int* in_sizes, int n_in, void* d_out, int out_size, void* d_ws, size_t ws_size, hipStream_t stream) {
    static int grid = 0;
    if (grid == 0) {
        if (n_in != 18 || in_sizes[0] != TT * DM || out_size != TT * DM || ws_size < WS_END) { fprintf(stderr, "kernel_launch: unexpected shapes / workspace (n_in %d, ws %zu); nothing launched\n", n_in, ws_size); grid = -1; return; }
        int dev = 0, cus = 0, per_cu = 0;
        if (hipGetDevice(&dev) != hipSuccess || hipDeviceGetAttribute(&cus, hipDeviceAttributeMultiprocessorCount, dev) != hipSuccess) { grid = -1; return; }
        if (hipFuncSetAttribute((const void*)fwd_kernel, hipFuncAttributeMaxDynamicSharedMemorySize, LDS_BYTES) != hipSuccess) { fprintf(stderr, "kernel_launch: hipFuncSetAttribute failed\n"); grid = -1; return; }
        if (hipOccupancyMaxActiveBlocksPerMultiprocessor(&per_cu, (const void*)fwd_kernel, 512, LDS_BYTES) != hipSuccess || per_cu < 1) { fprintf(stderr, "kernel_launch: occupancy query says %d\n", per_cu); per_cu = 1; }
        (void)hipGetLastError();
        grid = cus;
    }
    if (grid < 0) return;
    (void)hipMemsetAsync((char*)d_ws + WS_CTL, 0, CTL_ZERO_BYTES, stream);
    Args a{};
    for (int i = 0; i < 18; ++i) a.in[i] = (const float*)d_in[i];
    a.out = (float*)d_out; a.ws = (unsigned char*)d_ws;
#if MK_ONE_LAUNCH
    a.ph_lo = 0; a.ph_hi = NPH;
    hipLaunchKernelGGL(fwd_kernel, dim3(grid), dim3(512), LDS_BYTES, stream, a);
#else
    for (int p = 0; p < NPH; ++p) { a.ph_lo = p; a.ph_hi = p + 1; hipLaunchKernelGGL(fwd_kernel, dim3(grid), dim3(512), LDS_BYTES, stream, a); }
#endif
}
```

```cpp
#include <hip/hip_runtime.h>
#include <cstdio>
#include <cstdint>

#ifndef INPROJ_WGM
#define INPROJ_WGM 4
#endif
#ifndef GEMM_ALIGN
#define GEMM_ALIGN 1
#endif
#ifndef ROWB
#define ROWB 4
#endif
#ifndef N1K_WGM
#define N1K_WGM 8
#endif
#ifndef OUT_ROWMAJOR
#define OUT_ROWMAJOR 0
#endif
#ifndef REP_PRO
#define REP_PRO 1
#endif
#ifndef REP_ATTB
#define REP_ATTB 1
#endif
#ifndef REP_ATTA
#define REP_ATTA 1
#endif
#ifndef REP_INPROJ
#define REP_INPROJ 1
#endif
#ifndef REP_NORM1
#define REP_NORM1 1
#endif
#ifndef REP_GU
#define REP_GU 1
#endif
#ifndef REP_PAB
#define REP_PAB 1
#endif
#ifndef REP_OUT
#define REP_OUT 1
#endif
#ifndef REP_DOWN
#define REP_DOWN 1
#endif
#ifndef REP_NORM2
#define REP_NORM2 1
#endif
#ifndef MK_ONE_LAUNCH
#define MK_ONE_LAUNCH 1
#endif

#define LAS __attribute__((address_space(3)))
#define GAS __attribute__((address_space(1)))
typedef unsigned short bf16_t;
typedef short bf16x8 __attribute__((ext_vector_type(8)));
typedef short s16x4 __attribute__((ext_vector_type(4)));
typedef float f32x4 __attribute__((ext_vector_type(4)));
typedef float f32x16 __attribute__((ext_vector_type(16)));
typedef unsigned u32x4 __attribute__((ext_vector_type(4)));
typedef unsigned u32x2 __attribute__((ext_vector_type(2)));

constexpr int NB = 32, SEQ = 2048, DM = 1024, TT = NB * SEQ;
constexpr int NC = 4352;
constexpr int NEXP = 32, DFF = 512, NPAD = 139264, NBLK = 544;
constexpr int MODW = 6 * DM;
constexpr float QSCALE = 0.125f * 1.4426950408889634f;

constexpr size_t MiB = 1u << 20;
constexpr size_t WS_CTL = 0, CTL_ZERO_BYTES = 64 * 1024;
constexpr size_t WS_MOD = 1 * MiB;
constexpr size_t WS_TE = 2 * MiB + 512 * 1024, WS_TRK = 3 * MiB, WS_TW = 3 * MiB + 512 * 1024, WS_POS = 4 * MiB;
constexpr size_t WS_CNT = 4 * MiB + 512 * 1024;
constexpr size_t WS_BLKE = WS_CNT + 64 * 1024;
constexpr size_t WS_BTOK = WS_CNT + 128 * 1024;
constexpr size_t WS_WR = 5 * MiB + 256 * 1024;
constexpr size_t WS_WIN = 6 * MiB;
constexpr size_t WIN_BYTES = (size_t)NC * DM * 2;
constexpr size_t WS_WPA = 23 * MiB, WS_WPB = 25 * MiB, WS_WOUT = 27 * MiB;
constexpr size_t WS_WGU = 31 * MiB;
constexpr size_t WS_WDN = 159 * MiB;
constexpr size_t WS_H = 223 * MiB;
constexpr size_t WS_QKV = 351 * MiB;
constexpr size_t WS_GATE = 639 * MiB;
constexpr size_t WS_XB = 896 * MiB;
constexpr size_t WS_END = 1024 * MiB;
constexpr int CW_BAR = 4096;

constexpr int RING_BYTES = 133120;
constexpr int MISC_OFF = RING_BYTES;
constexpr int LDS_BYTES = 147456;

#define RLX_AGENT __ATOMIC_RELAXED, __HIP_MEMORY_SCOPE_AGENT
typedef float f32x2_t __attribute__((ext_vector_type(2))); typedef __bf16 bf16x2_t __attribute__((ext_vector_type(2)));
__device__ __forceinline__ unsigned cvt_pk_bf16(float lo, float hi) { const f32x2_t v = {lo, hi}; const bf16x2_t b = __builtin_convertvector(v, bf16x2_t); return __builtin_bit_cast(unsigned, b); }
typedef float f32x2v __attribute__((ext_vector_type(2)));
__device__ __forceinline__ unsigned pack4_fp8(float a, float b, float c, float d) { unsigned w = 0; w = __builtin_amdgcn_cvt_pk_fp8_f32(a, b, w, false); w = __builtin_amdgcn_cvt_pk_fp8_f32(c, d, w, true); return w; }
__device__ __forceinline__ void unpack8_fp8(u32x2 w, float (&o)[8]) { const f32x2v a = __builtin_amdgcn_cvt_pk_f32_fp8(w.x, false), b = __builtin_amdgcn_cvt_pk_f32_fp8(w.x, true), c = __builtin_amdgcn_cvt_pk_f32_fp8(w.y, false), d = __builtin_amdgcn_cvt_pk_f32_fp8(w.y, true);
    o[0] = a.x; o[1] = a.y; o[2] = b.x; o[3] = b.y; o[4] = c.x; o[5] = c.y; o[6] = d.x; o[7] = d.y; }
__device__ __forceinline__ float bf_lo(unsigned w) { return __uint_as_float(w << 16); }
__device__ __forceinline__ float bf_hi(unsigned w) { return __uint_as_float(w & 0xffff0000u); }
__device__ __forceinline__ float shx(float v, int mask, int lane) { return __int_as_float(__builtin_amdgcn_ds_bpermute((lane ^ mask) << 2, __float_as_int(v))); }
__device__ __forceinline__ float wave_sum(float v, int lane) {
#pragma unroll
    for (int o = 1; o < 64; o <<= 1) v += shx(v, o, lane);
    return v;
}
__device__ __forceinline__ float wave_max(float v, int lane) {
#pragma unroll
    for (int o = 1; o < 64; o <<= 1) v = fmaxf(v, shx(v, o, lane));
    return v;
}
__device__ __forceinline__ float sigmoid_f(float x) { return __builtin_amdgcn_rcpf(1.0f + __builtin_amdgcn_exp2f(-1.4426950408889634f * x)); }

#define XB_TMO      128
#define XB_XCNT(j)  (256  + 64 * (j))
#define XB_XSUB(j)  (1280 + 64 * (j))
#define XB_XGEN(j)  (2304 + 64 * (j))
#define XB_TOP      3328
#define XB_TOPGEN   3392
#define XCD_BAR_WORDS 3456
#define XB_SPIN_CAP (1u << 18)

__device__ __forceinline__ unsigned xb_ld(unsigned* p)              { return __hip_atomic_load(p, __ATOMIC_RELAXED, __HIP_MEMORY_SCOPE_AGENT); }
__device__ __forceinline__ unsigned xb_add(unsigned* p, unsigned v) { return __hip_atomic_fetch_add(p, v, __ATOMIC_RELAXED, __HIP_MEMORY_SCOPE_AGENT); }
__device__ __forceinline__ unsigned xb_xcc_id() { return (unsigned)__builtin_amdgcn_s_getreg((3 << 11) | 20) & 0xFu; }
#define XB_SPIN(cond, bar) do { unsigned _sp = 0; while (cond) { __builtin_amdgcn_s_sleep(1); \
    if ((++_sp & 255u) == 0u) { if (xb_ld(&(bar)[XB_TMO])) break; if (_sp > XB_SPIN_CAP) { atomicAdd(&(bar)[XB_TMO], 1u); break; } } } } while (0)

struct XcdBarrier { unsigned* bar; unsigned x; volatile LAS unsigned* st; };

__device__ __forceinline__ XcdBarrier xcd_barrier_post(unsigned* bar, volatile LAS unsigned* st) {
    XcdBarrier b; b.bar = bar; b.x = xb_xcc_id(); b.st = st;
    if (threadIdx.x == 0) (void)xb_add(&bar[XB_XCNT(b.x)], 1u);
    return b;
}
__device__ __forceinline__ void xcd_barrier_complete(unsigned* bar, unsigned x, unsigned& nloc, unsigned& nx) {
    const unsigned G = gridDim.x * gridDim.y * gridDim.z;
    unsigned sum, cnt, mine, sp = 0u;
    for (;;) {
        sum = 0u; cnt = 0u; mine = 0u;
#pragma unroll
        for (unsigned j = 0; j < 16; ++j) { const unsigned c = xb_ld(&bar[XB_XCNT(j)]); sum += c; cnt += (c > 0u) ? 1u : 0u; mine = (j == x) ? c : mine; }
        if (sum == G) break;
        __builtin_amdgcn_s_sleep(1);
        if ((++sp & 255u) == 0u) { if (xb_ld(&bar[XB_TMO])) break; if (sp > XB_SPIN_CAP) { atomicAdd(&bar[XB_TMO], 1u); break; } }
    }
    nloc = mine > 0u ? mine : 1u; nx = cnt > 0u ? cnt : 1u;
}
__device__ __forceinline__ void xcd_barrier(const XcdBarrier& b, const bool is_t0  ) {
    asm volatile("s_waitcnt vmcnt(0)" ::: "memory");
    __syncthreads();
    if (is_t0) {
        unsigned* bar = b.bar; unsigned bx_ = b.x;
        asm volatile("" : "+s"(bar), "+s"(bx_));
        __builtin_amdgcn_s_waitcnt(0);
        unsigned nloc = b.st[0], nx = b.st[1];
        if (nloc == 0u) { xcd_barrier_complete(bar, bx_, nloc, nx); b.st[0] = nloc; b.st[1] = nx; }
        const unsigned old = xb_add(&bar[XB_XSUB(bx_)], 1u);
        const unsigned gen = old / nloc;
        if (old + 1u == (gen + 1u) * nloc) {
            __builtin_amdgcn_fence(__ATOMIC_RELEASE, "agent");
            asm volatile("s_waitcnt vmcnt(0)" ::: "memory");
            const unsigned og = xb_add(&bar[XB_TOP], 1u);
            const unsigned tg = og / nx;
            if (og + 1u == (tg + 1u) * nx) xb_add(&bar[XB_TOPGEN], 1u);
            else XB_SPIN(xb_ld(&bar[XB_TOPGEN]) == tg, bar);
            __builtin_amdgcn_fence(__ATOMIC_ACQUIRE, "agent");
            xb_add(&bar[XB_XGEN(bx_)], 1u);
            asm volatile("s_waitcnt vmcnt(0)" ::: "memory");
        } else {
            XB_SPIN(xb_ld(&bar[XB_XGEN(bx_)]) == gen, bar);
            __builtin_amdgcn_fence(__ATOMIC_ACQUIRE, "agent");
            asm volatile("s_waitcnt vmcnt(0)" ::: "memory");
        }
    }
    __syncthreads();
}

namespace pg8 {
constexpr int BM = 256, BK = 64, HALF = 128, HTB = HALF * BK * 2, STAGE_BYTES = 8 * HTB, NXCD = 8, WGM = 8;
__host__ __device__ __forceinline__ int lds_byte(int r, int c) { const int st = (r >> 4) * 2 + (c >> 5), rr = r & 15, cc = c & 31, ob = rr * 64 + cc * 2; return st * 1024 + (ob ^ (((ob >> 9) & 1) << 5)); }
__host__ __device__ __forceinline__ void stage_rc(int b, int& R, int& C) { const int st = b / 1024, sb = b % 1024, swz = sb ^ (((sb >> 9) & 1) << 5); R = (st >> 1) * 16 + swz / 64; C = (st & 1) * 32 + (swz % 64) / 2; }
__host__ __device__ __forceinline__ int perm32(int rho) { const int n = rho >> 4, i = rho & 15; return 8 * (i >> 2) + 4 * n + (i & 3); }

struct Unit { int pm, pn; };
struct Gemm { const bf16_t* A; const bf16_t* Bt; int K; };

struct StaticOrder {
    static constexpr bool GATHER = false;
    int nM, nN, nwg, G, c, wgm = WGM;
    __device__ void init(int M, int N, int G_, int c_) { asm volatile("" : "+s"(c_));     nM = M / BM; nN = N / BM; nwg = nM * nN; G = G_; c = c_; }
    int rowmajor = 0;
    __device__ __forceinline__ bool next(int i, Unit& u) const {
        if (rowmajor) { const int upw = (nwg + G - 1) / G, k = c * upw + i; if (i >= upw || k >= nwg) return false; u.pm = k / nN; u.pn = k % nN; return true; }
        const long L = (long)i * G + c; if (L >= nwg) return false;
        int wgid = (int)L; { const int q = nwg / NXCD, r = nwg % NXCD, xcd = wgid % NXCD, off = wgid / NXCD; wgid = (xcd < r ? xcd * (q + 1) : r * (q + 1) + (xcd - r) * q) + off; }
        const int nig = wgm * nN, gid = wgid / nig, fm = gid * wgm, gsz = (nM - fm) < wgm ? (nM - fm) : wgm;
        u.pm = fm + ((wgid % nig) % gsz); u.pn = (wgid % nig) / gsz; return true;
    }
    __device__ __forceinline__ void aoff(const Unit&, const int (&)[2], const unsigned (&)[2], int, unsigned (&)[2][2]) const {}
};
struct MoeOrder {
    static constexpr bool GATHER = true;
    const int* blk_e; const int* rowidx; int nunits, G, c;
    __device__ __forceinline__ bool next(int i, Unit& u) const {
        const int L = i * G + c; if (L >= nunits) return false;
        const int blk = L >> 2; const int e = blk_e[blk]; u.pm = blk; u.pn = 4 * e + (L & 3); return true;
    }
    __device__ __forceinline__ void aoff(const Unit& u, const int (&RA)[2], const unsigned (&CA2)[2], int K, unsigned (&o)[2][2]) const {
#pragma unroll
        for (int h = 0; h < 2; ++h)
#pragma unroll
            for (int i = 0; i < 2; ++i) { const int r = u.pm * BM + h * HALF + RA[i]; const int src = rowidx ? rowidx[r] : r; o[h][i] = (unsigned)src * (unsigned)(K * 2) + CA2[i]; }
    }
};

template <class Epi, class Sched>
__device__ __forceinline__ void gemm_phase(LAS unsigned char* lds, const Gemm g, const Sched& S, const Epi& E, const int wid) {
    int lane_; asm volatile("v_mbcnt_lo_u32_b32 %0, -1, 0\n\tv_mbcnt_hi_u32_b32 %0, -1, %0" : "=v"(lane_));
    const int lane = lane_, tid = wid * 64 + lane, wr = wid >> 2, wc = wid & 3, fr = lane & 15, fq = lane >> 4;
    const int K = g.K, nt = K / BK;
    unsigned voffA[2], voffB[2], CA2[2]; int RA[2];
#pragma unroll
    for (int i = 0; i < 2; ++i) { int R, C; stage_rc(tid * 16 + i * 8192, R, C); const int Rb = Epi::PERM ? ((R & ~31) + perm32(R & 31)) : R;
        RA[i] = R; CA2[i] = (unsigned)C * 2u; voffA[i] = (unsigned)(R * K + C) * 2u; voffB[i] = (unsigned)(Rb * K + C) * 2u; }
    const size_t kstep = (size_t)(BK * 2);
    const size_t hstep = (size_t)HALF * K * 2;
    const size_t tstep = 2 * hstep;
    const unsigned ldsw = (unsigned)wid * 1024u;
    const int aoff = lds_byte(wr * 64 + fr, fq * 8), boff = lds_byte(wc * 32 + fr, fq * 8);
    const char* Ab = (const char*)g.A;
#define PG8_SA(b, h) (((b) * 2 + (h)) * HTB)
#define PG8_SB(b, h) ((4 + (b) * 2 + (h)) * HTB)
#define PG8_STAGEB(bufoff, gbase, voff) do { _Pragma("unroll") for (int _i = 0; _i < 2; ++_i) \
        __builtin_amdgcn_global_load_lds((const unsigned*)((const char*)(gbase) + (voff)[_i]), (LAS unsigned*)(lds + (bufoff) + ldsw + _i * 8192), 16, 0, 0); } while (0)
#define PG8_STAGEA(bufoff, H_, kb, NEXT) do { if constexpr (Sched::GATHER) { _Pragma("unroll") for (int _i = 0; _i < 2; ++_i) { const unsigned _o = (NEXT) ? na[H_][_i] : ca[H_][_i]; \
            __builtin_amdgcn_global_load_lds((const unsigned*)(Ab + (size_t)_o + (size_t)(kb)), (LAS unsigned*)(lds + (bufoff) + ldsw + _i * 8192), 16, 0, 0); } } \
        else { const char* _b = Ab + ((NEXT) ? nU : cU) + (size_t)(H_) * hstep + (size_t)(kb); _Pragma("unroll") for (int _i = 0; _i < 2; ++_i) \
            __builtin_amdgcn_global_load_lds((const unsigned*)(_b + voffA[_i]), (LAS unsigned*)(lds + (bufoff) + ldsw + _i * 8192), 16, 0, 0); } } while (0)
#define PG8_LDA(dst, b, h) do { _Pragma("unroll") for (int m = 0; m < 4; ++m) _Pragma("unroll") for (int k = 0; k < 2; ++k) dst[m][k] = *(const LAS bf16x8*)(lds + PG8_SA(b, h) + aoff + m * 2048 + k * 1024); } while (0)
#define PG8_LDB(dst, b, h) do { _Pragma("unroll") for (int n = 0; n < 2; ++n) _Pragma("unroll") for (int k = 0; k < 2; ++k) dst[n][k] = *(const LAS bf16x8*)(lds + PG8_SB(b, h) + boff + n * 2048 + k * 1024); } while (0)
#define PG8_MMA(ai, bj, At, Bt) do { __builtin_amdgcn_s_setprio(1); _Pragma("unroll") for (int m = 0; m < 4; ++m) _Pragma("unroll") for (int n = 0; n < 2; ++n) _Pragma("unroll") for (int k = 0; k < 2; ++k) \
        acc[ai][bj][m][n] = __builtin_amdgcn_mfma_f32_16x16x32_bf16(Bt[n][k], At[m][k], acc[ai][bj][m][n], 0, 0, 0); __builtin_amdgcn_s_setprio(0); } while (0)
#define PG8_WAIT_V(n) asm volatile("s_waitcnt vmcnt(" #n ")" ::: "memory")
#define PG8_WAIT_L(n) asm volatile("s_waitcnt lgkmcnt(" #n ")" ::: "memory")
#define PG8_BAR __builtin_amdgcn_s_barrier()
#define PG8_SCHED __builtin_amdgcn_sched_barrier(0)
    Unit cur, nxt; int ui = 0;
    if (!S.next(0, cur)) return;
    f32x4 acc[2][2][4][2];
#pragma unroll
    for (int a = 0; a < 2; ++a)
#pragma unroll
        for (int b = 0; b < 2; ++b)
#pragma unroll
            for (int m = 0; m < 4; ++m)
#pragma unroll
                for (int n = 0; n < 2; ++n) acc[a][b][m][n] = (f32x4){0.f, 0.f, 0.f, 0.f};
    bf16x8 At[4][2], B0[2][2], B1[2][2];
    unsigned ca[2][2], na[2][2];
    size_t cU = 0, nU = 0;
    if constexpr (Sched::GATHER) S.aoff(cur, RA, CA2, K, ca); else cU = (size_t)cur.pm * tstep;
    const char* cB = (const char*)g.Bt + (size_t)cur.pn * tstep;
    PG8_STAGEB(PG8_SB(0, 0), cB, voffB); PG8_STAGEB(PG8_SB(0, 1), cB + hstep, voffB); PG8_STAGEA(PG8_SA(0, 0), 0, 0, false); PG8_STAGEA(PG8_SA(0, 1), 1, 0, false);
    if (wr == 1) PG8_BAR;
    PG8_WAIT_V(2); PG8_BAR;
    PG8_STAGEB(PG8_SB(1, 0), cB + kstep, voffB); PG8_STAGEA(PG8_SA(1, 0), 0, kstep, false); PG8_STAGEB(PG8_SB(1, 1), cB + hstep + kstep, voffB);
    PG8_WAIT_V(6); PG8_BAR;
    for (;;) {
        const bool has_next = S.next(ui + 1, nxt);
        if constexpr (Sched::GATHER) {
            if (has_next) S.aoff(nxt, RA, CA2, K, na);
            else {
#pragma unroll
                for (int h = 0; h < 2; ++h)
#pragma unroll
                    for (int i = 0; i < 2; ++i) na[h][i] = ca[h][i];
            }
        } else nU = has_next ? (size_t)nxt.pm * tstep : cU;
        const char* nB = has_next ? (const char*)g.Bt + (size_t)nxt.pn * tstep : cB;
        for (int t = 0; t < nt; t += 2) {
            const bool last = (t == nt - 2);
            const size_t kb1 = (size_t)(t + 1) * kstep;
            const size_t kb2 = last ? 0 : (size_t)(t + 2) * kstep, kb3 = kb2 + kstep;
            const char* b2 = last ? nB : cB + (size_t)(t + 2) * kstep; const char* b3 = b2 + kstep;
            PG8_LDB(B0, 0, 0); PG8_LDB(B1, 0, 1); PG8_SCHED; PG8_LDA(At, 0, 0); PG8_STAGEA(PG8_SA(1, 1), 1, kb1, false);
            PG8_WAIT_V(8); PG8_WAIT_L(0); PG8_BAR; PG8_MMA(0, 0, At, B0); PG8_MMA(0, 1, At, B1); PG8_BAR; PG8_SCHED;
            PG8_LDA(At, 0, 1); PG8_STAGEB(PG8_SB(0, 0), b2, voffB); PG8_STAGEB(PG8_SB(0, 1), b2 + hstep, voffB); PG8_STAGEA(PG8_SA(0, 0), 0, kb2, last);
            PG8_WAIT_V(8); PG8_WAIT_L(0); PG8_BAR; PG8_MMA(1, 0, At, B0); PG8_MMA(1, 1, At, B1); PG8_BAR; PG8_SCHED;
            PG8_LDB(B0, 1, 0); PG8_LDB(B1, 1, 1); PG8_SCHED; PG8_LDA(At, 1, 0); PG8_STAGEA(PG8_SA(0, 1), 1, kb2, last);
            PG8_WAIT_V(8); PG8_WAIT_L(0); PG8_BAR; PG8_MMA(0, 0, At, B0); PG8_MMA(0, 1, At, B1); PG8_BAR; PG8_SCHED;
            PG8_LDA(At, 1, 1); PG8_STAGEB(PG8_SB(1, 0), b3, voffB); PG8_STAGEB(PG8_SB(1, 1), b3 + hstep, voffB); PG8_STAGEA(PG8_SA(1, 0), 0, kb3, last);
            PG8_WAIT_V(8); PG8_WAIT_L(0); PG8_BAR; PG8_MMA(1, 0, At, B0); PG8_MMA(1, 1, At, B1); PG8_BAR; PG8_SCHED;
            if constexpr (Epi::MIDK) { if (t + 2 == nt / 2) E.mid(acc, cur, wr, wc, fr, fq); }
        }
#if GEMM_ALIGN
        if (wr == 0) PG8_BAR;
#endif
        E(acc, cur, wr, wc, fr, fq);
        if (!has_next) break;
#pragma unroll
        for (int a = 0; a < 2; ++a)
#pragma unroll
            for (int b = 0; b < 2; ++b)
#pragma unroll
                for (int m = 0; m < 4; ++m)
#pragma unroll
                    for (int n = 0; n < 2; ++n) acc[a][b][m][n] = (f32x4){0.f, 0.f, 0.f, 0.f};
        cur = nxt; cB = nB; cU = nU; ++ui;
        if constexpr (Sched::GATHER) {
#pragma unroll
            for (int h = 0; h < 2; ++h)
#pragma unroll
                for (int i = 0; i < 2; ++i) ca[h][i] = na[h][i];
        }
#if GEMM_ALIGN
        if (wr == 1) PG8_BAR;
#endif
    }
    PG8_WAIT_V(0);
#if !GEMM_ALIGN
    if (wr == 0) PG8_BAR;
#endif
    PG8_BAR;
#undef PG8_SA
#undef PG8_SB
#undef PG8_STAGEA
#undef PG8_STAGEB
#undef PG8_LDA
#undef PG8_LDB
#undef PG8_MMA
#undef PG8_WAIT_V
#undef PG8_WAIT_L
#undef PG8_BAR
#undef PG8_SCHED
}

typedef const f32x4 (&AccRef)[2][2][4][2];

__device__ __forceinline__ u32x4 pack8(const f32x4& a, const f32x4& b) { u32x4 w; w.x = cvt_pk_bf16(a[0], a[1]); w.y = cvt_pk_bf16(a[2], a[3]); w.z = cvt_pk_bf16(b[0], b[1]); w.w = cvt_pk_bf16(b[2], b[3]); return w; }

struct EpiInProj {
    static constexpr bool PERM = true, MIDK = false;
    bf16_t *QA, *KA, *VA, *QB, *KB, *VB, *SA, *SB;
    const LAS float* normw;
    template <int ROPE>
    __device__ __forceinline__ void head_tile(AccRef acc, bf16_t* dst_, int ld, int hcol, int gsel, float scale, int row0, int fr, int fq) const {
        unsigned char* dst = (unsigned char*)dst_;
        int d0[2];
#pragma unroll
        for (int bj = 0; bj < 2; ++bj) d0[bj] = (ROPE == 1) ? (fq == 0 ? 8 * bj : 8 + 8 * fq + 24 * bj) : (fq < 2 ? 8 * fq + 16 * bj : 16 + 8 * fq + 16 * bj);
        f32x4 g[2][2];
#pragma unroll
        for (int bj = 0; bj < 2; ++bj)
#pragma unroll
            for (int n = 0; n < 2; ++n) g[bj][n] = *(const LAS f32x4*)(normw + gsel * 64 + d0[bj] + 4 * n);
        constexpr float FA[8] = {1.591549431e-01f, 3.086376340e-02f, 5.985185713e-03f, 1.160663641e-03f, 2.250790790e-04f, 4.364795279e-05f, 8.464330808e-06f, 1.641426263e-06f};
        constexpr float FB[16] = {1.591549431e-01f, 8.949940161e-02f, 5.032921210e-02f, 2.830219583e-02f, 1.591549431e-02f, 8.949940161e-03f, 5.032921210e-03f, 2.830219583e-03f,
                                  1.591549431e-03f, 8.949940161e-04f, 5.032921210e-04f, 2.830219583e-04f, 1.591549431e-04f, 8.949940161e-05f, 5.032921210e-05f, 2.830219583e-05f};
        float fq8[8];
#pragma unroll
        for (int k = 0; k < 8; ++k) fq8[k] = (ROPE == 1) ? FA[k] : ((fq & 1) ? FB[8 + k] : FB[k]);
        const bool rot = (ROPE == 2) || (fq == 0);
#pragma unroll
        for (int ai = 0; ai < 2; ++ai)
#pragma unroll
            for (int m = 0; m < 4; ++m) {
                const int row = row0 + ai * HALF + m * 16; const int s = row & (SEQ - 1);
                f32x4 y[2][2]; float ss = 0.f;
#pragma unroll
                for (int bj = 0; bj < 2; ++bj)
#pragma unroll
                    for (int n = 0; n < 2; ++n) { y[bj][n] = acc[ai][bj][m][n]; const f32x4 q = y[bj][n] * y[bj][n]; ss += (q[0] + q[1]) + (q[2] + q[3]); }
                ss += shx(ss, 16, fr + 16 * fq); ss += shx(ss, 32, fr + 16 * fq);
                const float rinv = __builtin_amdgcn_rsqf(ss * (1.0f / 64.0f) + 1e-6f);
#pragma unroll
                for (int bj = 0; bj < 2; ++bj)
#pragma unroll
                    for (int n = 0; n < 2; ++n) y[bj][n] = y[bj][n] * rinv * g[bj][n];
                if (ROPE != 0) {
                    const float pos = (float)((ROPE == 1) ? s : (fq < 2 ? (s >> 6) : (s & 63)));
#pragma unroll
                    for (int n = 0; n < 2; ++n)
#pragma unroll
                        for (int j = 0; j < 4; ++j) {
                            const float xr = __builtin_amdgcn_fractf(pos * fq8[4 * n + j]);
                            const float c = rot ? __builtin_amdgcn_cosf(xr) : 1.0f, s_ = rot ? __builtin_amdgcn_sinf(xr) : 0.0f;
                            const float x1 = y[0][n][j], x2 = y[1][n][j];
                            y[0][n][j] = x1 * c - x2 * s_; y[1][n][j] = x2 * c + x1 * s_;
                        }
                }
                u32x4 w;
#pragma unroll
                for (int bj = 0; bj < 2; ++bj) { const f32x4 a = y[bj][0] * scale, c = y[bj][1] * scale;
                    const unsigned lo = pack4_fp8(a[0], a[1], a[2], a[3]), hi = pack4_fp8(c[0], c[1], c[2], c[3]);
                    if (bj == 0) { w.x = lo; w.y = hi; } else { w.z = lo; w.w = hi; } }
                *(u32x4*)(dst + (size_t)row * ld + hcol + 16 * fq) = w;
            }
    }
    __device__ __forceinline__ void operator()(AccRef acc, const Unit& u, int wr, int wc, int fr_, int fq_) const {
        int fr = fr_, fq = fq_; asm volatile("" : "+v"(fr), "+v"(fq));
        const int pn = u.pn; const int row0 = u.pm * BM + wr * 64 + fr;
        if (pn >= 9) {
            unsigned char* base = (unsigned char*)((pn < 13) ? SA : SB); const int colt = ((pn - 9) & 3) * 256 + wc * 64 + 16 * fq;
#pragma unroll
            for (int ai = 0; ai < 2; ++ai)
#pragma unroll
                for (int m = 0; m < 4; ++m) { u32x4 w;
#pragma unroll
                    for (int bj = 0; bj < 2; ++bj) { f32x4 v0 = acc[ai][bj][m][0], v1 = acc[ai][bj][m][1];
#pragma unroll
                        for (int j = 0; j < 4; ++j) { v0[j] = sigmoid_f(v0[j]); v1[j] = sigmoid_f(v1[j]); }
                        const unsigned lo = pack4_fp8(v0[0], v0[1], v0[2], v0[3]), hi = pack4_fp8(v1[0], v1[1], v1[2], v1[3]);
                        if (bj == 0) { w.x = lo; w.y = hi; } else { w.z = lo; w.w = hi; } }
                    *(u32x4*)(base + (size_t)(row0 + ai * HALF + m * 16) * DM + colt) = w; }
        } else if (pn == 4 || pn == 5) {
            const int colt = (pn - 4) * 256 + wc * 64 + 16 * fq;
#pragma unroll
            for (int ai = 0; ai < 2; ++ai)
#pragma unroll
                for (int m = 0; m < 4; ++m) { bf16_t* rowp = VA + (size_t)(row0 + ai * HALF + m * 16) * 512 + colt;
#pragma unroll
                    for (int bj = 0; bj < 2; ++bj) *(u32x4*)(rowp + 8 * bj) = pack8(acc[ai][bj][m][0], acc[ai][bj][m][1]); }
        } else if (pn < 2)  head_tile<1>(acc, QA, 512, 64 * (4 * pn + wc), 0, QSCALE, row0, fr, fq);
        else if (pn < 4)    head_tile<1>(acc, KA, 512, 64 * (4 * (pn - 2) + wc), 1, 1.0f, row0, fr, fq);
        else if (pn < 8)    head_tile<2>(acc, QB, 512, 64 * (4 * (pn - 6) + wc), 2, QSCALE, row0, fr, fq);
        else if (wc < 2)    head_tile<2>(acc, KB, 128, 64 * wc, 3, 1.0f, row0, fr, fq);
        else {
#pragma unroll
            for (int ai = 0; ai < 2; ++ai)
#pragma unroll
                for (int m = 0; m < 4; ++m) { bf16_t* rowp = VB + (size_t)(row0 + ai * HALF + m * 16) * 128 + 64 * (wc - 2) + 8 * fq;
#pragma unroll
                    for (int bj = 0; bj < 2; ++bj) *(u32x4*)(rowp + 32 * bj) = pack8(acc[ai][bj][m][0], acc[ai][bj][m][1]); }
        }
    }
};

struct EpiMergeFused {
    static constexpr bool PERM = true, MIDK = true;
    bf16_t* MG; const unsigned char* GA; const unsigned char* GB;
    __device__ __forceinline__ void mid(f32x4 (&acc)[2][2][4][2], const Unit& u, int wr, int wc, int fr_, int fq_) const {
        int fr = fr_, fq = fq_; asm volatile("" : "+v"(fr), "+v"(fq));
        const int row0 = u.pm * BM + wr * 64 + fr, col0 = u.pn * BM + wc * 64 + 16 * fq;
#pragma unroll
        for (int ai = 0; ai < 2; ++ai)
#pragma unroll
            for (int m = 0; m < 4; ++m) { const size_t ro = (size_t)(row0 + ai * HALF + m * 16) * DM + col0;
                const u32x4 a = *(const u32x4*)(GA + ro), b = *(const u32x4*)(GB + ro);
#pragma unroll
                for (int bj = 0; bj < 2; ++bj) {
                    float sa[8], sb[8]; unpack8_fp8(bj ? (u32x2){a.z, a.w} : (u32x2){a.x, a.y}, sa); unpack8_fp8(bj ? (u32x2){b.z, b.w} : (u32x2){b.x, b.y}, sb);
#pragma unroll
                    for (int n = 0; n < 2; ++n)
#pragma unroll
                        for (int j = 0; j < 4; ++j) acc[ai][bj][m][n][j] *= sa[4 * n + j] * __builtin_amdgcn_rcpf(fmaxf(sb[4 * n + j], 1e-12f));
                } }
    }
    __device__ __forceinline__ void operator()(AccRef acc, const Unit& u, int wr, int wc, int fr_, int fq_) const {
        int fr = fr_, fq = fq_; asm volatile("" : "+v"(fr), "+v"(fq));
        const int row0 = u.pm * BM + wr * 64 + fr, col0 = u.pn * BM + wc * 64 + 16 * fq;
#pragma unroll
        for (int ai = 0; ai < 2; ++ai)
#pragma unroll
            for (int m = 0; m < 4; ++m) { const size_t ro = (size_t)(row0 + ai * HALF + m * 16) * DM + col0;
                const u32x4 b = *(const u32x4*)(GB + ro);
#pragma unroll
                for (int bj = 0; bj < 2; ++bj) {
                    float sb[8]; unpack8_fp8(bj ? (u32x2){b.z, b.w} : (u32x2){b.x, b.y}, sb);
                    f32x4 v0 = acc[ai][bj][m][0], v1 = acc[ai][bj][m][1];
#pragma unroll
                    for (int j = 0; j < 4; ++j) { v0[j] *= fmaxf(sb[j], 1e-12f); v1[j] *= fmaxf(sb[4 + j], 1e-12f); }
                    *(u32x4*)(MG + ro + 8 * bj) = pack8(v0, v1); } }
    }
};

struct EpiResidB {
    static constexpr bool PERM = true, MIDK = false;
    const float* Xf; const bf16_t* Xb; bf16_t* O; const float* gate;
    __device__ __forceinline__ void operator()(AccRef acc, const Unit& u, int wr, int wc, int fr_, int fq_) const {
        int fr = fr_, fq = fq_; asm volatile("" : "+v"(fr), "+v"(fq));
        const int row0 = u.pm * BM + wr * 64 + fr, col0 = u.pn * BM + wc * 64 + 16 * fq; const int b = (u.pm * BM) >> 11;
        f32x4 gt[2][2];
#pragma unroll
        for (int bj = 0; bj < 2; ++bj)
#pragma unroll
            for (int n = 0; n < 2; ++n) gt[bj][n] = *(const f32x4*)(gate + (size_t)b * MODW + col0 + 8 * bj + 4 * n);
#pragma unroll
        for (int ai = 0; ai < 2; ++ai)
#pragma unroll
            for (int m = 0; m < 4; ++m) { const size_t ro = (size_t)(row0 + ai * HALF + m * 16) * DM + col0;
#pragma unroll
                for (int bj = 0; bj < 2; ++bj) {
                    f32x4 x0, x1;
                    if (Xf) { x0 = *(const f32x4*)(Xf + ro + 8 * bj); x1 = *(const f32x4*)(Xf + ro + 8 * bj + 4); }
                    else { const u32x4 w = *(const u32x4*)(Xb + ro + 8 * bj); x0 = (f32x4){bf_lo(w.x), bf_hi(w.x), bf_lo(w.y), bf_hi(w.y)}; x1 = (f32x4){bf_lo(w.z), bf_hi(w.z), bf_lo(w.w), bf_hi(w.w)}; }
                    *(u32x4*)(O + ro + 8 * bj) = pack8(x0 + gt[bj][0] * acc[ai][bj][m][0], x1 + gt[bj][1] * acc[ai][bj][m][1]); } }
    }
};

struct EpiSwiGLU {
    static constexpr bool PERM = true, MIDK = false;
    bf16_t* ACT;
    __device__ __forceinline__ void operator()(AccRef acc, const Unit& u, int wr, int wc, int fr_, int fq_) const {
        int fr = fr_, fq = fq_; asm volatile("" : "+v"(fr), "+v"(fq));
        const int row0 = u.pm * BM + wr * 64 + fr, col0 = (u.pn & 3) * HALF + wc * 32 + 8 * fq;
#pragma unroll
        for (int ai = 0; ai < 2; ++ai)
#pragma unroll
            for (int m = 0; m < 4; ++m) { f32x4 r[2];
#pragma unroll
                for (int n = 0; n < 2; ++n)
#pragma unroll
                    for (int j = 0; j < 4; ++j) { const float gg = acc[ai][0][m][n][j], uu = acc[ai][1][m][n][j]; r[n][j] = gg * sigmoid_f(gg) * uu; }
                *(u32x4*)(ACT + (size_t)(row0 + ai * HALF + m * 16) * DFF + col0) = pack8(r[0], r[1]); }
    }
};

struct EpiY {
    static constexpr bool PERM = true, MIDK = false;
    unsigned char* Y;
    __device__ __forceinline__ void operator()(AccRef acc, const Unit& u, int wr, int wc, int fr_, int fq_) const {
        int fr = fr_, fq = fq_; asm volatile("" : "+v"(fr), "+v"(fq));
        const int row0 = u.pm * BM + wr * 64 + fr, col0 = (u.pn & 3) * BM + wc * 64 + 16 * fq;
#pragma unroll
        for (int ai = 0; ai < 2; ++ai)
#pragma unroll
            for (int m = 0; m < 4; ++m) { u32x4 w;
                { const f32x4 a = acc[ai][0][m][0], b = acc[ai][0][m][1]; w.x = pack4_fp8(a[0], a[1], a[2], a[3]); w.y = pack4_fp8(b[0], b[1], b[2], b[3]); }
                { const f32x4 a = acc[ai][1][m][0], b = acc[ai][1][m][1]; w.z = pack4_fp8(a[0], a[1], a[2], a[3]); w.w = pack4_fp8(b[0], b[1], b[2], b[3]); }
                *(u32x4*)(Y + (size_t)(row0 + ai * HALF + m * 16) * DM + col0) = w; }
    }
};
}

__device__ __forceinline__ int dimA(int bj, int r) { return r < 8 ? r + 8 * bj : 16 + (r - 8) + 24 * bj; }
__device__ __forceinline__ int dimB(int bj, int r) { return r < 16 ? r + 16 * bj : 32 + (r - 16) + 16 * bj; }
__device__ __forceinline__ int inproj_srccol(int P) {
    const int pn = P >> 8, p = P & 255, bj = p >> 7, wc = (p >> 5) & 3, r = p & 31;
    if (pn < 2) return 64 * (4 * pn + wc) + dimA(bj, r);
    if (pn < 4) return 512 + 64 * (4 * (pn - 2) + wc) + dimA(bj, r);
    if (pn < 6) return 1024 + 256 * (pn - 4) + 64 * wc + 16 * ((p >> 3) & 3) + 8 * bj + (p & 7);
    if (pn < 8) return 1536 + 64 * (4 * (pn - 6) + wc) + dimB(bj, r);
    if (pn == 8) return wc < 2 ? 2048 + 64 * wc + dimB(bj, r) : 2176 + 64 * (wc - 2) + 32 * bj + r;
    { const int fq = (p >> 3) & 3, r8 = p & 7; return 2304 + 256 * (pn - 9) + 64 * wc + 16 * fq + 8 * bj + r8; }
}

namespace att {
constexpr int KSTR = 80, VSTR = 192;
constexpr int KTILE = 64 * KSTR, VTILE = 64 * VSTR;
constexpr int K_OFF = 0, V_OFF = 2 * KTILE;
constexpr int PRIV_OFF = 0;
__device__ __forceinline__ s16x4 vtr(LAS const char* p) { typedef short v4i16_t __attribute__((ext_vector_type(4)));
    return __builtin_bit_cast(s16x4, __builtin_amdgcn_ds_read_tr16_b64_v4i16((LAS v4i16_t*)p)); }
__device__ __forceinline__ int clamp_tok(int t) { return t < 0 ? 0 : (t > SEQ - 1 ? SEQ - 1 : t); }

__device__ __forceinline__ long mk64(unsigned lo, unsigned hi) { return (long)(((unsigned long long)hi << 32) | lo); }
__device__ __forceinline__ void qk_tile(f32x16& p0, f32x16& p1, const u32x4 (&kf)[2][2], const u32x4 (&qr)[2]) {
    const f32x16 z = {0.f, 0.f, 0.f, 0.f, 0.f, 0.f, 0.f, 0.f, 0.f, 0.f, 0.f, 0.f, 0.f, 0.f, 0.f, 0.f};
    p0 = __builtin_amdgcn_mfma_f32_32x32x16_fp8_fp8(mk64(kf[0][0].x, kf[0][0].y), mk64(qr[0].x, qr[0].y), z, 0, 0, 0);
    p1 = __builtin_amdgcn_mfma_f32_32x32x16_fp8_fp8(mk64(kf[1][0].x, kf[1][0].y), mk64(qr[0].x, qr[0].y), z, 0, 0, 0);
    p0 = __builtin_amdgcn_mfma_f32_32x32x16_fp8_fp8(mk64(kf[0][0].z, kf[0][0].w), mk64(qr[0].z, qr[0].w), p0, 0, 0, 0);
    p1 = __builtin_amdgcn_mfma_f32_32x32x16_fp8_fp8(mk64(kf[1][0].z, kf[1][0].w), mk64(qr[0].z, qr[0].w), p1, 0, 0, 0);
    p0 = __builtin_amdgcn_mfma_f32_32x32x16_fp8_fp8(mk64(kf[0][1].x, kf[0][1].y), mk64(qr[1].x, qr[1].y), p0, 0, 0, 0);
    p1 = __builtin_amdgcn_mfma_f32_32x32x16_fp8_fp8(mk64(kf[1][1].x, kf[1][1].y), mk64(qr[1].x, qr[1].y), p1, 0, 0, 0);
    p0 = __builtin_amdgcn_mfma_f32_32x32x16_fp8_fp8(mk64(kf[0][1].z, kf[0][1].w), mk64(qr[1].z, qr[1].w), p0, 0, 0, 0);
    p1 = __builtin_amdgcn_mfma_f32_32x32x16_fp8_fp8(mk64(kf[1][1].z, kf[1][1].w), mk64(qr[1].z, qr[1].w), p1, 0, 0, 0);
}
template <bool MASK>
__device__ __forceinline__ void exp_tile(const f32x16& p0, const f32x16& p1, float& lsum, bf16x8 (&pf)[2][2], int mbase, int mR, int dk) {
    float e0[16], e1[16]; float ls = 0.f;
#pragma unroll
    for (int r = 0; r < 16; ++r) {
        e0[r] = __builtin_amdgcn_exp2f(p0[r]); e1[r] = __builtin_amdgcn_exp2f(p1[r]);
        if (MASK) {
            const int c0 = (r & 3) + 8 * (r >> 2);
            e0[r] = ((unsigned)(mbase + dk * c0) <= (unsigned)mR) ? e0[r] : 0.f;
            e1[r] = ((unsigned)(mbase + dk * (c0 + 32)) <= (unsigned)mR) ? e1[r] : 0.f;
        }
        ls += e0[r] + e1[r];
    }
    lsum += ls;
#pragma unroll
    for (int s = 0; s < 2; ++s) {
        u32x4 w0, w1;
        w0.x = cvt_pk_bf16(e0[8 * s + 0], e0[8 * s + 1]); w0.y = cvt_pk_bf16(e0[8 * s + 2], e0[8 * s + 3]); w0.z = cvt_pk_bf16(e0[8 * s + 4], e0[8 * s + 5]); w0.w = cvt_pk_bf16(e0[8 * s + 6], e0[8 * s + 7]);
        w1.x = cvt_pk_bf16(e1[8 * s + 0], e1[8 * s + 1]); w1.y = cvt_pk_bf16(e1[8 * s + 2], e1[8 * s + 3]); w1.z = cvt_pk_bf16(e1[8 * s + 4], e1[8 * s + 5]); w1.w = cvt_pk_bf16(e1[8 * s + 6], e1[8 * s + 7]);
        pf[0][s] = __builtin_bit_cast(bf16x8, w0); pf[1][s] = __builtin_bit_cast(bf16x8, w1);
    }
}
__device__ __forceinline__ void vread(bf16x8 (&vf)[4], LAS const char* vb, int d0) {
#pragma unroll
    for (int blk = 0; blk < 2; ++blk)
#pragma unroll
        for (int s = 0; s < 2; ++s) {
            const s16x4 lo = vtr(vb + (32 * blk + 16 * s) * VSTR + 64 * d0), hi = vtr(vb + (32 * blk + 16 * s + 8) * VSTR + 64 * d0);
            vf[2 * blk + s] = (bf16x8){lo[0], lo[1], lo[2], lo[3], hi[0], hi[1], hi[2], hi[3]};
        }
}
__device__ __forceinline__ void pv_half(f32x16& od, const bf16x8 (&vf)[4], const bf16x8 (&pf)[2][2]) {
#pragma unroll
    for (int blk = 0; blk < 2; ++blk)
#pragma unroll
        for (int s = 0; s < 2; ++s) od = __builtin_amdgcn_mfma_f32_32x32x16_bf16(vf[2 * blk + s], pf[blk][s], od, 0, 0, 0);
}
__device__ __forceinline__ void mask_params(int dk, int tk0, int tq, int hi, int& mbase, int& mR) {
    const int dlo = (-64 * dk > -tq) ? -64 * dk : -tq, dhi = (64 * dk < SEQ - 1 - tq) ? 64 * dk : SEQ - 1 - tq;
    const int dA = tk0 + 4 * dk * hi - tq;
    mR = dhi - dlo; mbase = ((dA & (dk - 1)) == 0) ? dA - dlo : 0x7fffffff;
}

template <bool MASKED>
__device__ __forceinline__ void dense64_loop(LAS char* lds, const unsigned char* Kg, const bf16_t* Vg, int ld  , int tok0, int ntiles,
                                             const u32x4 (&qr)[2][2], f32x16 (&o)[2][2], float (&lsum)[2], int tq0, int tq1, int lane_, int wave) {
    constexpr int V2_OFF = 2 * KTILE;
    u32x2 kreg; u32x4 vreg;
#define D64_LANE() int ln_ = lane_; asm volatile("" : "+v"(ln_)); const int tid_ = wave * 64 + ln_, srow = tid_ >> 3, sch = tid_ & 7
#define D64_LD(t) do { D64_LANE(); int tk_ = tok0 + 64 * (t) + srow; if (MASKED) tk_ = clamp_tok(tk_); kreg = *(const u32x2*)(Kg + (size_t)tk_ * ld + sch * 8); vreg = *(const u32x4*)(Vg + (size_t)tk_ * ld + sch * 8); } while (0)
#define D64_ST(t) do { D64_LANE(); *(LAS u32x2*)(lds + ((t) & 1) * KTILE + srow * KSTR + sch * 8) = kreg; *(LAS u32x4*)(lds + V2_OFF + ((t) & 1) * VTILE + srow * VSTR + sch * 16) = vreg; } while (0)
    D64_LD(0); D64_ST(0); D64_LD(1);
    for (int t = 0; t < ntiles; ++t) {
        __syncthreads();
        if (t + 1 < ntiles) D64_ST(t + 1);
        if (t + 2 < ntiles) D64_LD(t + 2);
        int lane = lane_; asm volatile("" : "+v"(lane));
        const int hi = lane >> 5;
        const int vlane = (4 * hi + ((lane & 15) >> 2)) * VSTR + (16 * ((lane >> 4) & 1) + 4 * (lane & 3)) * 2;
        const int klane = (lane & 31) * KSTR + 32 * hi;
        u32x4 kf[2][2];
        { LAS const char* kb_ = lds + (t & 1) * KTILE + klane;
#pragma unroll
          for (int blk = 0; blk < 2; ++blk)
#pragma unroll
              for (int e = 0; e < 2; ++e) kf[blk][e] = *(const LAS u32x4*)(kb_ + 32 * blk * KSTR + 16 * e); }
        f32x16 p[2][2];
        bf16x8 vfa[4], vfb[4];
        LAS const char* vb_ = lds + V2_OFF + (t & 1) * VTILE + vlane;
        vread(vfa, vb_, 0); vread(vfb, vb_, 1);
        __builtin_amdgcn_sched_barrier(0);
        qk_tile(p[0][0], p[0][1], kf, qr[0]);
        qk_tile(p[1][0], p[1][1], kf, qr[1]);
#pragma unroll
        for (int g = 0; g < 2; ++g) {
            bf16x8 pf[2][2]; int mb = 0, mr = 0;
            if (MASKED) mask_params(1, tok0 + 64 * t, g ? tq1 : tq0, hi, mb, mr);
            exp_tile<MASKED>(p[g][0], p[g][1], lsum[g], pf, mb, mr, 1);
            pv_half(o[g][0], vfa, pf); pv_half(o[g][1], vfb, pf);
        }
    }
#undef D64_LANE
#undef D64_LD
#undef D64_ST
}
__device__ __forceinline__ void dense64_lag_loop(LAS char* lds, const unsigned char* Kg, const bf16_t* Vg, int ld  , int ntiles,
                                                 const u32x4 (&qr)[2][2], f32x16 (&o)[2][2], float (&lsum)[2], int lane_, int wave, const bool lag) {
    constexpr int V2_OFF = 2 * KTILE;
    u32x2 kreg; u32x4 vreg;
#define D64_LANE() int ln_ = lane_; asm volatile("" : "+v"(ln_)); const int tid_ = wave * 64 + ln_, srow = tid_ >> 3, sch = tid_ & 7
#define D64_LD(t) do { D64_LANE(); const int tk_ = 64 * (t) + srow; kreg = *(const u32x2*)(Kg + (size_t)tk_ * ld + sch * 8); vreg = *(const u32x4*)(Vg + (size_t)tk_ * ld + sch * 8); } while (0)
#define D64_ST(t) do { D64_LANE(); *(LAS u32x2*)(lds + ((t) & 1) * KTILE + srow * KSTR + sch * 8) = kreg; *(LAS u32x4*)(lds + V2_OFF + ((t) % 3) * VTILE + srow * VSTR + sch * 16) = vreg; } while (0)
#define D64_QK(t) do { int lane = lane_; asm volatile("" : "+v"(lane)); const int klane = (lane & 31) * KSTR + 32 * (lane >> 5); u32x4 kf[2][2]; LAS const char* kb_ = lds + ((t) & 1) * KTILE + klane; \
        _Pragma("unroll") for (int blk = 0; blk < 2; ++blk) _Pragma("unroll") for (int e = 0; e < 2; ++e) kf[blk][e] = *(const LAS u32x4*)(kb_ + 32 * blk * KSTR + 16 * e); \
        qk_tile(p[0][0], p[0][1], kf, qr[0]); qk_tile(p[1][0], p[1][1], kf, qr[1]); } while (0)
#define D64_PV(t) do { int lane = lane_; asm volatile("" : "+v"(lane)); const int hi = lane >> 5; const int vlane = (4 * hi + ((lane & 15) >> 2)) * VSTR + (16 * ((lane >> 4) & 1) + 4 * (lane & 3)) * 2; \
        bf16x8 vfa[4], vfb[4]; LAS const char* vb_ = lds + V2_OFF + ((t) % 3) * VTILE + vlane; vread(vfa, vb_, 0); vread(vfb, vb_, 1); \
        _Pragma("unroll") for (int g = 0; g < 2; ++g) { bf16x8 pf[2][2]; exp_tile<false>(p[g][0], p[g][1], lsum[g], pf, 0, 0, 0); pv_half(o[g][0], vfa, pf); pv_half(o[g][1], vfb, pf); } } while (0)
    f32x16 p[2][2];
    D64_LD(0); D64_ST(0);
    if (!lag) {
        D64_LD(1);
        for (int t = 0; t < ntiles; ++t) {
            __syncthreads();
            if (t + 1 < ntiles) D64_ST(t + 1);
            if (t + 2 < ntiles) D64_LD(t + 2);
            D64_QK(t);
            D64_PV(t);
        }
        __syncthreads();
    } else {
        D64_LD(1);
        __syncthreads();
        D64_ST(1); D64_LD(2);
        D64_QK(0);
        for (int t = 1; t < ntiles; ++t) {
            __syncthreads();
            if (t + 1 < ntiles) D64_ST(t + 1);
            if (t + 2 < ntiles) D64_LD(t + 2);
            D64_PV(t - 1);
            __builtin_amdgcn_sched_barrier(0);
            D64_QK(t);
        }
        __syncthreads();
        D64_PV(ntiles - 1);
    }
#undef D64_LANE
#undef D64_LD
#undef D64_ST
#undef D64_QK
#undef D64_PV
}
__device__ __forceinline__ void priv_kload(u32x4 (&kf)[2][2], const unsigned char* Kg, int ld, int tk0, int dk, int lane_) {
    int lane = lane_; asm volatile("" : "+v"(lane));
    const int hi = lane >> 5;
#pragma unroll
    for (int blk = 0; blk < 2; ++blk) { const int tk = clamp_tok(tk0 + dk * (32 * blk + (lane & 31)));
#pragma unroll
        for (int e = 0; e < 2; ++e) kf[blk][e] = *(const u32x4*)(Kg + (size_t)tk * ld + 32 * hi + 16 * e); }
}
__device__ __forceinline__ void priv2_step(u32x4 (&kf)[2][2], LAS char* vpriv, const unsigned char* Kg, const bf16_t* Vg, int ld, int tk0, int dk, bool g0, bool g1,
                                           bool has_next, int tk0n, int dkn, const u32x4 (&qr)[2][2], f32x16 (&o)[2][2], float (&lsum)[2], int tq0, int tq1, int lane_) {
    int lane = lane_; asm volatile("" : "+v"(lane));
    const int hi = lane >> 5;
    const int vlane = (4 * hi + ((lane & 15) >> 2)) * VSTR + (16 * ((lane >> 4) & 1) + 4 * (lane & 3)) * 2;
    u32x4 vr[8];
#pragma unroll
    for (int i = 0; i < 8; ++i) { const int idx = i * 64 + lane, row = idx >> 3, ch = idx & 7; const int tk = clamp_tok(tk0 + dk * row); vr[i] = *(const u32x4*)(Vg + (size_t)tk * ld + ch * 8); }
    const int gfirst = g0 ? 0 : 1, glast = g1 ? 1 : 0;
    f32x16 p0, p1; bf16x8 pf[2][2]; int mb, mr;
    if (gfirst == 0) qk_tile(p0, p1, kf, qr[0]); else qk_tile(p0, p1, kf, qr[1]);
    __builtin_amdgcn_sched_barrier(0);
#pragma unroll
    for (int i = 0; i < 8; ++i) { const int idx = i * 64 + lane; *(LAS u32x4*)(vpriv + (idx >> 3) * VSTR + (idx & 7) * 16) = vr[i]; }
    if (glast == gfirst) { __builtin_amdgcn_sched_barrier(0); if (has_next) priv_kload(kf, Kg, ld, tk0n, dkn, lane); __builtin_amdgcn_sched_barrier(0); }
    mask_params(dk, tk0, gfirst ? tq1 : tq0, hi, mb, mr);
    if (gfirst == 0) exp_tile<true>(p0, p1, lsum[0], pf, mb, mr, dk); else exp_tile<true>(p0, p1, lsum[1], pf, mb, mr, dk);
    { bf16x8 vfa[4], vfb[4]; vread(vfa, vpriv + vlane, 0); vread(vfb, vpriv + vlane, 1);
      if (gfirst == 0) { pv_half(o[0][0], vfa, pf); pv_half(o[0][1], vfb, pf); } else { pv_half(o[1][0], vfa, pf); pv_half(o[1][1], vfb, pf); } }
    if (glast != gfirst) {
        qk_tile(p0, p1, kf, qr[1]);
        __builtin_amdgcn_sched_barrier(0);
        if (has_next) priv_kload(kf, Kg, ld, tk0n, dkn, lane);
        __builtin_amdgcn_sched_barrier(0);
        mask_params(dk, tk0, tq1, hi, mb, mr);
        exp_tile<true>(p0, p1, lsum[1], pf, mb, mr, dk);
        bf16x8 vfa[4], vfb[4]; vread(vfa, vpriv + vlane, 0); vread(vfb, vpriv + vlane, 1);
        pv_half(o[1][0], vfa, pf); pv_half(o[1][1], vfb, pf);
    }
}
__device__ __forceinline__ void store_out(const f32x16 (&o)[2], float lsum, bf16_t* dst  , int lane_) {
    int lane = lane_; asm volatile("" : "+v"(lane));
    const int hi = lane >> 5;
    float l = lsum + shx(lsum, 32, lane);
    const float inv = 1.0f / l;
#pragma unroll
    for (int d0 = 0; d0 < 2; ++d0)
#pragma unroll
        for (int gp = 0; gp < 2; ++gp) {
            const int ga = 2 * gp, gb = 2 * gp + 1;
            unsigned a0 = cvt_pk_bf16(o[d0][4 * ga] * inv, o[d0][4 * ga + 1] * inv), a1 = cvt_pk_bf16(o[d0][4 * ga + 2] * inv, o[d0][4 * ga + 3] * inv);
            unsigned b0 = cvt_pk_bf16(o[d0][4 * gb] * inv, o[d0][4 * gb + 1] * inv), b1 = cvt_pk_bf16(o[d0][4 * gb + 2] * inv, o[d0][4 * gb + 3] * inv);
            const auto s0 = __builtin_amdgcn_permlane32_swap(a0, b0, false, false), s1 = __builtin_amdgcn_permlane32_swap(a1, b1, false, false);
            u32x4 w; w.x = s0[0]; w.y = s1[0]; w.z = s0[1]; w.w = s1[1];
            *(u32x4*)(dst + 32 * d0 + 16 * gp + 8 * hi) = w;
        }
}
}

struct Args { const float* in[18]; float* out; unsigned char* ws; int ph_lo, ph_hi; };
constexpr int PH_PRO = 0, PH_L0 = 1, PH_PER_LAYER = 9, PH_FINAL = PH_L0 + 2 * PH_PER_LAYER, NPH = PH_FINAL + 1;
enum { P_NORM1 = 0, P_INPROJ, P_ATTN, P_PAB, P_OUT, P_NORM2, P_PLACE, P_GU, P_DOWN };

__device__ __forceinline__ int tile256_srccol(int P) { const int p = P & 255; return (P & ~255) + 64 * ((p >> 5) & 3) + 16 * ((p >> 3) & 3) + 8 * (p >> 7) + (p & 7); }
template <int MAP>
__device__ __forceinline__ void transpose_item(const float* W, int N, int col0, bf16_t* dst, int dst_row0, int K, int k0, LAS float* scr, int lane, int dk0 = 0  ) {
    const int sc = (MAP == 1) ? inproj_srccol(col0 + lane) : (MAP == 2) ? tile256_srccol(col0 + lane) : col0 + lane;
    const float* src = W + (size_t)k0 * N + sc;
#pragma unroll 16
    for (int i = 0; i < 64; ++i) scr[i * 65 + lane] = src[(size_t)i * N];
    asm volatile("s_waitcnt lgkmcnt(0)" ::: "memory");
    const int c = lane & 7, nn = lane >> 3;
#pragma unroll
    for (int j = 0; j < 8; ++j) { const int n = nn + 8 * j; const LAS float* s = scr + (8 * c) * 65 + n;
        u32x4 w; w.x = cvt_pk_bf16(s[0], s[65]); w.y = cvt_pk_bf16(s[2 * 65], s[3 * 65]); w.z = cvt_pk_bf16(s[4 * 65], s[5 * 65]); w.w = cvt_pk_bf16(s[6 * 65], s[7 * 65]);
        *(u32x4*)(dst + (size_t)(dst_row0 + n) * K + dk0 + k0 + 8 * c) = w; }
    asm volatile("s_waitcnt lgkmcnt(0)" ::: "memory");
}


template <bool XF32, bool COMBINE, bool NORM, bool ROUTER, bool OUTF32>
__device__ __forceinline__ void row_phase(LAS unsigned char* lds, int tid, int lane, int wave, int G, int bx, const float* xf, bf16_t* xb, float* outf, const float* gv,
                                          const float* modl, int sh_off, int sc_off, const float* modprev, bf16_t* Hh, const unsigned char* Ym, const int* Pos, float* Tw,
                                          const bf16_t* Wr, int* Te, int* Trk, int* Cnt) {
    constexpr int RB = COMBINE ? 2 : ROWB;
    LAS float* lgs = (LAS float*)lds;
    LAS int* lcnt = (LAS int*)(lds + 40960);
    asm volatile("" : "+v"(tid), "+v"(lane));
    for (int chunk = bx; chunk < 256; chunk += G) {
        const int b = chunk >> 3;
        if (ROUTER) { if (tid < 32) lcnt[tid] = 0; }
        f32x4 pre[4], shv[4], g2[4];
#pragma unroll
        for (int j = 0; j < 4; ++j) { const int col = 512 * (j >> 1) + 8 * lane + 4 * (j & 1);
            if (NORM) { const f32x4 gg = *(const f32x4*)(gv + col), sc = *(const f32x4*)(modl + (size_t)b * MODW + sc_off + col);
                pre[j] = gg * (1.0f + sc); shv[j] = *(const f32x4*)(modl + (size_t)b * MODW + sh_off + col); }
            if (COMBINE) g2[j] = *(const f32x4*)(modprev + (size_t)b * MODW + 5 * DM + col); }
        f32x4 rawf[XF32 ? RB : 1][4]; u32x4 rawb[XF32 ? 1 : RB][2]; int pp[COMBINE ? RB : 1][2]; float pw[COMBINE ? RB : 1][2];
#define ROW_LOAD(rb_) do { _Pragma("unroll") for (int i = 0; i < RB; ++i) { const size_t ro = (size_t)((rb_) + i) * DM; \
            if (XF32) { _Pragma("unroll") for (int j = 0; j < 4; ++j) rawf[XF32 ? i : 0][j] = *(const f32x4*)(xf + ro + 512 * (j >> 1) + 8 * lane + 4 * (j & 1)); } \
            else { _Pragma("unroll") for (int h = 0; h < 2; ++h) rawb[XF32 ? 0 : i][h] = *(const u32x4*)(xb + ro + 512 * h + 8 * lane); } \
            if (COMBINE) { pp[COMBINE ? i : 0][0] = Pos[2 * ((rb_) + i)]; pp[COMBINE ? i : 0][1] = Pos[2 * ((rb_) + i) + 1]; pw[COMBINE ? i : 0][0] = Tw[2 * ((rb_) + i)]; pw[COMBINE ? i : 0][1] = Tw[2 * ((rb_) + i) + 1]; } } } while (0)
        ROW_LOAD(chunk * 256 + wave * 32);
#pragma unroll 1
        for (int r0 = 0; r0 < 32; r0 += RB) {
            const int rowb = chunk * 256 + wave * 32 + r0;
            f32x4 v[RB][4]; int cp[COMBINE ? RB : 1][2]; float cw[COMBINE ? RB : 1][2];
#pragma unroll
            for (int i = 0; i < RB; ++i) {
                if (XF32) {
#pragma unroll
                    for (int j = 0; j < 4; ++j) v[i][j] = rawf[XF32 ? i : 0][j];
                } else {
#pragma unroll
                    for (int h = 0; h < 2; ++h) { const u32x4 w = rawb[XF32 ? 0 : i][h];
                        v[i][2 * h] = (f32x4){bf_lo(w.x), bf_hi(w.x), bf_lo(w.y), bf_hi(w.y)}; v[i][2 * h + 1] = (f32x4){bf_lo(w.z), bf_hi(w.z), bf_lo(w.w), bf_hi(w.w)}; }
                }
                if (COMBINE) { cp[i][0] = pp[i][0]; cp[i][1] = pp[i][1]; cw[i][0] = pw[i][0]; cw[i][1] = pw[i][1]; }
            }
            u32x2 ya[COMBINE ? RB : 1][2], yc[COMBINE ? RB : 1][2];
            if (COMBINE) {
#pragma unroll
                for (int i = 0; i < RB; ++i)
#pragma unroll
                    for (int h = 0; h < 2; ++h) { ya[i][h] = *(const u32x2*)(Ym + (size_t)cp[i][0] * DM + 512 * h + 8 * lane); yc[i][h] = *(const u32x2*)(Ym + (size_t)cp[i][1] * DM + 512 * h + 8 * lane); }
            }
            if (r0 + RB < 32) ROW_LOAD(rowb + RB);
            if (COMBINE) {
#pragma unroll
                for (int i = 0; i < RB; ++i) {
                    const int row = rowb + i; const float w0 = cw[i][0], w1 = cw[i][1];
#pragma unroll
                    for (int h = 0; h < 2; ++h) { float fa[8], fc[8]; unpack8_fp8(ya[i][h], fa); unpack8_fp8(yc[i][h], fc);
                        const f32x4 m0 = {w0 * fa[0] + w1 * fc[0], w0 * fa[1] + w1 * fc[1], w0 * fa[2] + w1 * fc[2], w0 * fa[3] + w1 * fc[3]};
                        const f32x4 m1 = {w0 * fa[4] + w1 * fc[4], w0 * fa[5] + w1 * fc[5], w0 * fa[6] + w1 * fc[6], w0 * fa[7] + w1 * fc[7]};
                        v[i][2 * h] = v[i][2 * h] + g2[2 * h] * m0; v[i][2 * h + 1] = v[i][2 * h + 1] + g2[2 * h + 1] * m1;
                        if (OUTF32) { *(f32x4*)(outf + (size_t)row * DM + 512 * h + 8 * lane) = v[i][2 * h]; *(f32x4*)(outf + (size_t)row * DM + 512 * h + 8 * lane + 4) = v[i][2 * h + 1]; }
                        else *(u32x4*)(xb + (size_t)row * DM + 512 * h + 8 * lane) = pg8::pack8(v[i][2 * h], v[i][2 * h + 1]); }
                }
            }
            if (NORM) {
                float ss[RB];
#pragma unroll
                for (int i = 0; i < RB; ++i) { ss[i] = 0.f;
#pragma unroll
                    for (int j = 0; j < 4; ++j) { const f32x4 q = v[i][j] * v[i][j]; ss[i] += (q[0] + q[1]) + (q[2] + q[3]); } }
#pragma unroll
                for (int o = 1; o < 64; o <<= 1)
#pragma unroll
                    for (int i = 0; i < RB; ++i) ss[i] += shx(ss[i], o, lane);
#pragma unroll
                for (int i = 0; i < RB; ++i) { const float rstd = __builtin_amdgcn_rsqf(ss[i] * (1.0f / DM) + 1e-6f);
#pragma unroll
                    for (int h = 0; h < 2; ++h) *(u32x4*)(Hh + (size_t)(rowb + i) * DM + 512 * h + 8 * lane) = pg8::pack8(v[i][2 * h] * rstd * pre[2 * h] + shv[2 * h], v[i][2 * h + 1] * rstd * pre[2 * h + 1] + shv[2 * h + 1]); }
            }
        }
#undef ROW_LOAD
        if (ROUTER) {
            __syncthreads();
            const int row0 = chunk * 256 + wave * 32;
            f32x4 ra[2][2];
#pragma unroll
            for (int mt = 0; mt < 2; ++mt)
#pragma unroll
                for (int et = 0; et < 2; ++et) ra[mt][et] = (f32x4){0.f, 0.f, 0.f, 0.f};
#pragma unroll 4
            for (int kk = 0; kk < 32; ++kk) {
                bf16x8 a[2], bb[2];
#pragma unroll
                for (int mt = 0; mt < 2; ++mt) a[mt] = *(const bf16x8*)(Hh + (size_t)(row0 + 16 * mt + (lane & 15)) * DM + 32 * kk + 8 * (lane >> 4));
#pragma unroll
                for (int et = 0; et < 2; ++et) bb[et] = *(const bf16x8*)(Wr + (size_t)(16 * et + (lane & 15)) * DM + 32 * kk + 8 * (lane >> 4));
#pragma unroll
                for (int mt = 0; mt < 2; ++mt)
#pragma unroll
                    for (int et = 0; et < 2; ++et) ra[mt][et] = __builtin_amdgcn_mfma_f32_16x16x32_bf16(a[mt], bb[et], ra[mt][et], 0, 0, 0);
            }
#pragma unroll
            for (int mt = 0; mt < 2; ++mt)
#pragma unroll
                for (int et = 0; et < 2; ++et)
#pragma unroll
                    for (int r = 0; r < 4; ++r) lgs[(wave * 32 + 16 * mt + 4 * (lane >> 4) + r) * 33 + 16 * et + (lane & 15)] = ra[mt][et][r];
            asm volatile("s_waitcnt lgkmcnt(0)" ::: "memory");
            if (lane < 32) {
                const int tl = wave * 32 + lane, tok = chunk * 256 + tl;
                float lg[32]; float M = -3.0e38f;
#pragma unroll
                for (int e = 0; e < 32; ++e) { lg[e] = lgs[tl * 33 + e]; M = fmaxf(M, lg[e]); }
                float bm1 = 0.f, bm2 = 0.f, bsc = -1.f; int bi1 = 0, bi2 = 0, bg = 0;
#pragma unroll
                for (int g = 0; g < 4; ++g) {
                    float m1 = -3.0e38f, m2 = -3.0e38f; int i1 = 0, i2 = 0;
#pragma unroll
                    for (int j = 0; j < 8; ++j) { const float vv = lg[8 * g + j];
                        if (vv > m1) { m2 = m1; i2 = i1; m1 = vv; i1 = j; } else if (vv > m2) { m2 = vv; i2 = j; } }
                    const float sc = expf(m1 - M) + expf(m2 - M);
                    if (sc > bsc) { bsc = sc; bg = g; bm1 = m1; bm2 = m2; bi1 = i1; bi2 = i2; }
                }
                const int e0 = 8 * bg + bi1, e1 = 8 * bg + bi2;
                const float w0 = 1.0f / (1.0f + expf(bm2 - bm1)), w1 = 1.0f - w0;
                const int r0 = __hip_atomic_fetch_add(&lcnt[e0], 1, __ATOMIC_RELAXED, __HIP_MEMORY_SCOPE_WORKGROUP);
                const int r1 = __hip_atomic_fetch_add(&lcnt[e1], 1, __ATOMIC_RELAXED, __HIP_MEMORY_SCOPE_WORKGROUP);
                Te[2 * tok] = e0; Te[2 * tok + 1] = e1; Trk[2 * tok] = r0; Trk[2 * tok + 1] = r1; Tw[2 * tok] = w0; Tw[2 * tok + 1] = w1;
            }
            __syncthreads();
            if (tid < 32) Cnt[chunk * 32 + tid] = lcnt[tid];
            __syncthreads();
        }
    }
}

#define x_in ((const float*)(const GAS float*)args.in[0])
#define c_in ((const float*)(const GAS float*)args.in[1])
#define w_ada ((const float*)(const GAS float*)args.in[2])
#define b_ada ((const float*)(const GAS float*)args.in[3])
#define g_mix ((const float*)(const GAS float*)args.in[4])
#define w_in ((const float*)(const GAS float*)args.in[5])
#define qn_a ((const float*)(const GAS float*)args.in[6])
#define kn_a ((const float*)(const GAS float*)args.in[7])
#define qn_b ((const float*)(const GAS float*)args.in[8])
#define kn_b ((const float*)(const GAS float*)args.in[9])
#define w_pa ((const float*)(const GAS float*)args.in[10])
#define w_pb ((const float*)(const GAS float*)args.in[11])
#define w_out ((const float*)(const GAS float*)args.in[12])
#define g_ffn ((const float*)(const GAS float*)args.in[13])
#define w_router ((const float*)(const GAS float*)args.in[14])
#define w_gate ((const float*)(const GAS float*)args.in[15])
#define w_up ((const float*)(const GAS float*)args.in[16])
#define w_down ((const float*)(const GAS float*)args.in[17])
#define MOD ((float*)(GAS float*)(ws + WS_MOD))
#define XB ((bf16_t*)(GAS bf16_t*)(ws + WS_XB))
#define TE ((int*)(GAS int*)(ws + WS_TE))
#define TRK ((int*)(GAS int*)(ws + WS_TRK))
#define TW ((float*)(GAS float*)(ws + WS_TW))
#define POS ((int*)(GAS int*)(ws + WS_POS))
#define CNT ((int*)(GAS int*)(ws + WS_CNT))
#define BLKE ((int*)(GAS int*)(ws + WS_BLKE))
#define BTOK ((int*)(GAS int*)(ws + WS_BTOK))
#define WR ((bf16_t*)(bf16_t*)(GAS bf16_t*)(ws + WS_WR))
#define H ((bf16_t*)(bf16_t*)(GAS bf16_t*)(ws + WS_H))
#define YAB ((bf16_t*)(GAS bf16_t*)(ws + WS_H))
#define YA ((bf16_t*)(bf16_t*)(GAS bf16_t*)(ws + WS_H))
#define YB ((bf16_t*)(bf16_t*)(GAS bf16_t*)(ws + WS_H + 64 * MiB))
#define QA ((bf16_t*)(bf16_t*)(GAS bf16_t*)(ws + WS_QKV))
#define KA ((bf16_t*)(bf16_t*)(GAS bf16_t*)(ws + WS_QKV + 64 * MiB))
#define VA ((bf16_t*)(bf16_t*)(GAS bf16_t*)(ws + WS_QKV + 128 * MiB))
#define QB ((bf16_t*)(bf16_t*)(GAS bf16_t*)(ws + WS_QKV + 192 * MiB))
#define KB ((bf16_t*)(bf16_t*)(GAS bf16_t*)(ws + WS_QKV + 256 * MiB))
#define VB ((bf16_t*)(bf16_t*)(GAS bf16_t*)(ws + WS_QKV + 272 * MiB))
#define MERGED ((bf16_t*)(bf16_t*)(GAS bf16_t*)(ws + WS_QKV))
#define YM ((unsigned char*)(GAS unsigned char*)(ws + WS_QKV))
#define SA ((bf16_t*)(bf16_t*)(GAS bf16_t*)(ws + WS_GATE))
#define SB ((bf16_t*)(bf16_t*)(GAS bf16_t*)(ws + WS_GATE + 128 * MiB))
#define ACT ((bf16_t*)(bf16_t*)(GAS bf16_t*)(ws + WS_GATE))
#define PHASE_ENTER() int lane; asm volatile("v_mbcnt_lo_u32_b32 %0, -1, 0\n\tv_mbcnt_hi_u32_b32 %0, -1, %0" : "=v"(lane)); const int tid = wave * 64 + lane; GAS unsigned char* ws = ws0; int bx = bx0, vcu = vcu0; asm volatile("" : "+s"(ws), "+s"(bx), "+s"(vcu))

__device__ __forceinline__ bool in_phase(int lo, int hi, int k) { asm volatile("" : "+s"(lo), "+s"(hi)); return lo <= k && k < hi; }
#define PGATE_A SA
#define PGATE_B SB
__global__ void __launch_bounds__(512, 2) fwd_kernel(Args args) {
    extern __shared__ __attribute__((aligned(16))) unsigned char lds_raw[];
    LAS unsigned char* lds = (LAS unsigned char*)lds_raw;
    volatile LAS unsigned* MISC = (volatile LAS unsigned*)(lds + MISC_OFF);
    const int tid0 = threadIdx.x, lane0 = tid0 & 63, wave = __builtin_amdgcn_readfirstlane(tid0 >> 6);
    const int G = gridDim.x, bx0 = blockIdx.x;
    const int vcu0 = (G % 8 == 0) ? (bx0 % 8) * (G / 8) + bx0 / 8 : bx0;
    GAS unsigned char* ws0 = (GAS unsigned char*)args.ws;
    float* out = (float*)(GAS float*)args.out;
    for (int u = tid0; u < 256; u += 512) ((LAS unsigned*)(lds + MISC_OFF))[u] = 0u;
    __syncthreads();
#if MK_ONE_LAUNCH
    XcdBarrier bar = xcd_barrier_post((unsigned*)((GAS unsigned*)(ws0 + WS_CTL) + CW_BAR), MISC + 8);
#define GRID_BAR() do { int l_; asm volatile("v_mbcnt_lo_u32_b32 %0, -1, 0\n\tv_mbcnt_hi_u32_b32 %0, -1, %0" : "=v"(l_)); xcd_barrier(bar, (wave == 0) && (l_ == 0)); } while (0)
#else
#define GRID_BAR() do {} while (0)
#endif
#ifndef PHMASK
#define PHMASK 0xFFFFFFFFu
#endif
#if MK_ONE_LAUNCH
#define IN(k) true
#else
#define IN(k) in_phase(args.ph_lo, args.ph_hi, (k))
#endif
#define EN(bit) ((PHMASK >> (bit)) & 1u)
#define SEAM(k) do { if (IN(k) && IN((k) + 1)) GRID_BAR(); } while (0)

    if (EN(0) && IN(PH_PRO)) {
        PHASE_ENTER();
#pragma unroll 1
        for (int rep = 0; rep < REP_PRO; ++rep) {
        LAS float* scr = (LAS float*)(lds + wave * 16640);
        const int gw = vcu * 8 + wave, NGW = G * 8;
        constexpr int I_IN = 68 * 16, I_PA = 16 * 8, I_OUT = 16 * 16, I_GU = 32 * 2 * 8 * 16, I_DN = 32 * 16 * 8;
        constexpr int I_LAYER = I_IN + 2 * I_PA + I_OUT + I_GU + I_DN;
        for (int it = gw; it < 2 * I_LAYER; it += NGW) {
            const int l = it / I_LAYER; int r = it % I_LAYER;
            if (r < I_IN) { const int nb = r / 16, kb = r % 16;
                transpose_item<1>(w_in + (size_t)l * DM * NC, NC, 64 * nb, (bf16_t*)(GAS bf16_t*)(ws + WS_WIN + l * WIN_BYTES), 64 * nb, DM, 64 * kb, scr, lane); continue; } r -= I_IN;
            if (r < I_PA) { const int nb = r / 8, kb = r % 8;
                transpose_item<2>(w_pa + (size_t)l * 512 * DM, DM, 64 * nb, (bf16_t*)(GAS bf16_t*)(ws + WS_WPA + l * 2 * MiB), 64 * nb, DM, 64 * kb, scr, lane, 0); continue; } r -= I_PA;
            if (r < I_PA) { const int nb = r / 8, kb = r % 8;
                transpose_item<2>(w_pb + (size_t)l * 512 * DM, DM, 64 * nb, (bf16_t*)(GAS bf16_t*)(ws + WS_WPA + l * 2 * MiB), 64 * nb, DM, 64 * kb, scr, lane, 512); continue; } r -= I_PA;
            if (r < I_OUT) { const int nb = r / 16, kb = r % 16;
                transpose_item<2>(w_out + (size_t)l * DM * DM, DM, 64 * nb, (bf16_t*)(GAS bf16_t*)(ws + WS_WOUT + l * 2 * MiB), 64 * nb, DM, 64 * kb, scr, lane); continue; } r -= I_OUT;
            if (r < I_GU) { const int e = r / 256, q = r % 256, up = q / 128, nb = (q % 128) / 16, kb = q % 16;
                const float* src = (up ? w_up : w_gate) + ((size_t)l * NEXP + e) * DM * DFF;
                const int c0 = 64 * nb, drow = 256 * (c0 >> 7) + 128 * up + (c0 & 127);
                transpose_item<0>(src, DFF, c0, (bf16_t*)(GAS bf16_t*)(ws + WS_WGU + ((size_t)l * NEXP + e) * 2 * MiB), drow, DM, 64 * kb, scr, lane); continue; } r -= I_GU;
            { const int e = r / 128, q = r % 128, nb = q / 8, kb = q % 8;
                transpose_item<2>(w_down + ((size_t)l * NEXP + e) * DFF * DM, DM, 64 * nb, (bf16_t*)(GAS bf16_t*)(ws + WS_WDN + ((size_t)l * NEXP + e) * MiB), 64 * nb, DFF, 64 * kb, scr, lane); }
        }
        for (int i = (vcu * 512 + tid); i < 32 * DM; i += G * 512) { const int e = i >> 10, k = i & 1023; WR[i] = (bf16_t)(cvt_pk_bf16(w_router[(size_t)k * NEXP + e], 0.f) & 0xffffu); }
        __syncthreads();
        if (vcu * 8 < 384) {
            LAS float* cond = (LAS float*)lds;
            for (int i = tid; i < NB * DM; i += 512) { const int b = i >> 10, k = i & 1023; const float cv = c_in[i]; cond[k * 32 + b] = cv / (1.0f + expf(-cv)); }
            __syncthreads();
            for (int it = gw; it < 384; it += NGW) {
                const int l = it / 192, n0 = (it % 192) * 32;
                const float* wp = w_ada + (size_t)l * DM * MODW + n0 + (lane & 31) + (size_t)(lane >> 5) * MODW;
                const LAS float* cp = cond + (lane >> 5) * 32 + (lane & 31);
                f32x16 acc;
#pragma unroll
                for (int r = 0; r < 16; ++r) acc[r] = 0.f;
#pragma unroll 16
                for (int k0 = 0; k0 < DM; k0 += 2) acc = __builtin_amdgcn_mfma_f32_32x32x2f32(cp[k0 * 32], wp[(size_t)k0 * MODW], acc, 0, 0, 0);
                const float bias = b_ada[l * MODW + n0 + (lane & 31)];
#pragma unroll
                for (int r = 0; r < 16; ++r) { const int b = (r & 3) + 8 * (r >> 2) + 4 * (lane >> 5); MOD[((size_t)l * NB + b) * MODW + n0 + (lane & 31)] = acc[r] + bias; }
            }
        }
        __syncthreads();
        }
    }
    SEAM(PH_PRO);

    for (int l = 0; l < 2; ++l) {
        const int pb = PH_L0 + l * PH_PER_LAYER;
        if (EN(1) && IN(pb + P_NORM1)) { PHASE_ENTER(); const float* modl = MOD + (size_t)l * NB * MODW;
            if (l == 0) {
#pragma unroll 1
                for (int rep = 0; rep < REP_NORM1; ++rep)
                    row_phase<true, false, true, false, false>(lds, tid, lane, wave, G, bx, x_in, XB, out, g_mix, modl, 0, DM, MOD, H, YM, POS, TW, WR, TE, TRK, CNT);
            } else row_phase<false, true, true, false, false>(lds, tid, lane, wave, G, bx, x_in, XB, out, g_mix + DM, modl, 0, DM, MOD, H, YM, POS, TW, WR, TE, TRK, CNT); }
            {
                SEAM(pb + P_NORM1);
                if (EN(2) && IN(pb + P_INPROJ)) {
                    PHASE_ENTER();
                    pg8::Gemm g{H, (const bf16_t*)(const GAS bf16_t*)(ws + WS_WIN + l * WIN_BYTES), DM}; pg8::StaticOrder S; S.init(TT, NC, G, bx); S.wgm = INPROJ_WGM;
                    LAS float* normw = (LAS float*)(lds + MISC_OFF + 1024);
                    if (tid < 256) { const int sel = tid >> 6, d = tid & 63; const float* srcw = (sel == 0) ? qn_a : (sel == 1) ? kn_a : (sel == 2) ? qn_b : kn_b; normw[tid] = srcw[l * 64 + d]; }
                    __syncthreads();
                    pg8::EpiInProj E{QA, KA, VA, QB, KB, VB, SA, SB, normw};
#pragma unroll 1
                    for (int rep = 0; rep < REP_INPROJ; ++rep)
                    pg8::gemm_phase<pg8::EpiInProj, pg8::StaticOrder>(lds, g, S, E, wave);
                }
                SEAM(pb + P_INPROJ);
                if (EN(3) && IN(pb + P_ATTN)) {
                    PHASE_ENTER(); (void)lane;
                    LAS char* ring = (LAS char*)lds;
#pragma unroll 1
                    for (int rep = 0; rep < REP_ATTB; ++rep)
                    for (int L = vcu; L < NB * 32; L += G) {
                        int lane; asm volatile("v_mbcnt_lo_u32_b32 %0, -1, 0\n\tv_mbcnt_hi_u32_b32 %0, -1, %0" : "=v"(lane)); const int hi = lane >> 5;
                        const int b = L >> 5, kvh = (L >> 4) & 1, qh = 4 * kvh + ((L >> 2) & 3), qb2 = L & 3;
                        const int tq0 = 512 * qb2 + 64 * wave + (lane & 31);
                        u32x4 qr[2][2];
#pragma unroll
                        for (int g = 0; g < 2; ++g)
#pragma unroll
                            for (int e = 0; e < 2; ++e) qr[g][e] = *(const u32x4*)((const unsigned char*)QB + ((size_t)b * SEQ + tq0 + 32 * g) * 512 + qh * 64 + 32 * hi + 16 * e);
                        f32x16 o[2][2]; float lsum[2] = {0.f, 0.f};
#pragma unroll
                        for (int r = 0; r < 16; ++r) { o[0][0][r] = 0.f; o[0][1][r] = 0.f; o[1][0][r] = 0.f; o[1][1][r] = 0.f; }
                        __syncthreads();
                        att::dense64_lag_loop(ring, (const unsigned char*)KB + (size_t)b * SEQ * 128 + kvh * 64, VB + (size_t)b * SEQ * 128 + kvh * 64, 128, 32, qr, o, lsum, lane, wave, wave >= 4);
                        { int l2; asm volatile("v_mbcnt_lo_u32_b32 %0, -1, 0\n\tv_mbcnt_hi_u32_b32 %0, -1, %0" : "=v"(l2)); const int tqs = 512 * qb2 + 64 * wave + (l2 & 31);
#pragma unroll
                          for (int g = 0; g < 2; ++g) att::store_out(o[g], lsum[g], YAB + ((size_t)b * SEQ + tqs + 32 * g) * DM + 512 + qh * 64, l2); }
                    }
#pragma unroll 1
                    for (int rep = 0; rep < REP_ATTA; ++rep)
                    for (int L = vcu; L < NB * 32; L += G) {
                        int lane; asm volatile("v_mbcnt_lo_u32_b32 %0, -1, 0\n\tv_mbcnt_hi_u32_b32 %0, -1, %0" : "=v"(lane)); const int hi = lane >> 5;
                        const int b = L >> 5, h = (L >> 2) & 7, tb2 = L & 3, base = 512 * tb2;
                        const int tq0 = base + 16 * (lane & 31) + wave, tq1 = tq0 + 8;
                        const unsigned char* Kg = (const unsigned char*)KA + (size_t)b * SEQ * 512 + h * 64; const bf16_t* Vg = VA + (size_t)b * SEQ * 512 + h * 64;
                        u32x4 qr[2][2];
#pragma unroll
                        for (int g = 0; g < 2; ++g)
#pragma unroll
                            for (int e = 0; e < 2; ++e) qr[g][e] = *(const u32x4*)((const unsigned char*)QA + ((size_t)b * SEQ + tq0 + 8 * g) * 512 + h * 64 + 32 * hi + 16 * e);
                        f32x16 o[2][2]; float lsum[2] = {0.f, 0.f};
#pragma unroll
                        for (int r = 0; r < 16; ++r) { o[0][0][r] = 0.f; o[0][1][r] = 0.f; o[1][0][r] = 0.f; o[1][1][r] = 0.f; }
                        __syncthreads();
                        att::dense64_loop<true>(ring, Kg, Vg, 512, base - 64, 10, qr, o, lsum, tq0, tq1, lane, wave);
                        __syncthreads();
                        {
                            LAS char* vpriv = ring + att::PRIV_OFF + wave * att::VTILE;
#define A_TK0(j) ((j) < 4 ? base + wave - 256 + 256 * (j) : wave + 8 * (((j) - 4) >> 1) + 1024 * (((j) - 4) & 1))
#define A_DK(j) ((j) < 4 ? 4 : 16)
                            u32x4 kf[2][2];
                            att::priv_kload(kf, Kg, 512, A_TK0(0), 4, lane);
#pragma unroll 1
                            for (int j = 0; j < 8; ++j) {
                                const bool p2 = j < 4; const int g = (j - 4) >> 1;
                                att::priv2_step(kf, vpriv, Kg, Vg, 512, A_TK0(j), A_DK(j), p2 || g == 0, p2 || g == 1, j + 1 < 8, A_TK0(j + 1), A_DK(j + 1), qr, o, lsum, tq0, tq1, lane);
                            }
#undef A_TK0
#undef A_DK
                        }
                        { int l2; asm volatile("v_mbcnt_lo_u32_b32 %0, -1, 0\n\tv_mbcnt_hi_u32_b32 %0, -1, %0" : "=v"(l2)); const int tqs = base + 16 * (l2 & 31) + wave;
#pragma unroll
                          for (int g = 0; g < 2; ++g) att::store_out(o[g], lsum[g], YAB + ((size_t)b * SEQ + tqs + 8 * g) * DM + h * 64, l2); }
                    }
                    __syncthreads();
                }
                SEAM(pb + P_ATTN);
                if (EN(4) && IN(pb + P_PAB)) {
                    PHASE_ENTER();
                    pg8::StaticOrder S; S.init(TT, DM, G, bx); S.wgm = N1K_WGM;
                    pg8::Gemm g{YAB, (const bf16_t*)(const GAS bf16_t*)(ws + WS_WPA + l * 2 * MiB), DM}; pg8::EpiMergeFused E{MERGED, (const unsigned char*)PGATE_A, (const unsigned char*)PGATE_B};
#pragma unroll 1
                    for (int rep = 0; rep < REP_PAB; ++rep)
                    pg8::gemm_phase<pg8::EpiMergeFused, pg8::StaticOrder>(lds, g, S, E, wave);
                }
                SEAM(pb + P_PAB);
                if (EN(5) && IN(pb + P_OUT)) {
                    PHASE_ENTER(); const float* modl = MOD + (size_t)l * NB * MODW;
                    pg8::Gemm g{MERGED, (const bf16_t*)(const GAS bf16_t*)(ws + WS_WOUT + l * 2 * MiB), DM}; pg8::StaticOrder S; S.init(TT, DM, G, bx); S.rowmajor = OUT_ROWMAJOR; S.wgm = N1K_WGM;
                    pg8::EpiResidB E{(l == 0) ? x_in : (const float*)nullptr, XB, XB, modl + 2 * DM};
#pragma unroll 1
                    for (int rep = 0; rep < ((l == 0) ? REP_OUT : 1); ++rep)
                    pg8::gemm_phase<pg8::EpiResidB, pg8::StaticOrder>(lds, g, S, E, wave);
                }
                SEAM(pb + P_OUT);
            }
        if (EN(6) && IN(pb + P_NORM2)) { PHASE_ENTER(); const float* modl = MOD + (size_t)l * NB * MODW;
#pragma unroll 1
            for (int rep = 0; rep < REP_NORM2; ++rep)
            row_phase<false, false, true, true, false>(lds, tid, lane, wave, G, bx, x_in, XB, out, g_ffn + l * DM, modl, 3 * DM, 4 * DM, MOD, H, YM, POS, TW, WR, TE, TRK, CNT); }
        SEAM(pb + P_NORM2);
        if (EN(7) && IN(pb + P_PLACE)) {
            PHASE_ENTER();
            LAS int* part_tot = (LAS int*)lds;
            LAS int* part_pre = part_tot + 512;
            LAS int* basee = part_pre + 512;
            LAS int* pstart = basee + 32;
            LAS int* pend = pstart + 32;
            LAS int* tote = pend + 32;
            for (int chunk = bx; chunk < 256; chunk += G) {
                { const int e = tid & 31, part = tid >> 5; int st = 0, sp = 0;
                    for (int q = 0; q < 16; ++q) { const int ch = part * 16 + q; const int v = CNT[ch * 32 + e]; st += v; sp += (ch < chunk) ? v : 0; }
                    part_tot[part * 32 + e] = st; part_pre[part * 32 + e] = sp; }
                __syncthreads();
                if (tid < 32) { int st = 0, sp = 0; for (int q = 0; q < 16; ++q) { st += part_tot[q * 32 + tid]; sp += part_pre[q * 32 + tid]; } tote[tid] = st; basee[tid] = sp; }
                __syncthreads();
                if (tid == 0) { int run = 0; for (int e = 0; e < 32; ++e) { const int padded = (tote[e] + 255) & ~255; pstart[e] = run; basee[e] += run; run += padded; pend[e] = run; } }
                __syncthreads();
                { const int tok = chunk * 256 + (tid >> 1), slot = tid & 1; const int e = TE[2 * tok + slot], rk = TRK[2 * tok + slot]; const int dest = basee[e] + rk;
                    BTOK[dest] = tok; POS[2 * tok + slot] = dest; }
                if (chunk < 32) { const int e = chunk; const int from = pstart[e] + tote[e], n = pend[e] - from; if (tid < n) BTOK[from + tid] = 0; }
                if (chunk == 0) {
                    for (int blk = tid; blk < NBLK; blk += 512) { int e = 0; for (int q = 0; q < 32; ++q) e += (pend[q] <= blk * 256) ? 1 : 0; BLKE[blk] = e > 31 ? 31 : e; }
                    if (tid == 0) BLKE[1000] = pend[31] >> 8;
                }
                __syncthreads();
            }
        }
        SEAM(pb + P_PLACE);
        if (EN(8) && IN(pb + P_GU)) {
            PHASE_ENTER();
            const int nused = BLKE[1000];
            pg8::Gemm g{H, (const bf16_t*)(const GAS bf16_t*)(ws + WS_WGU + (size_t)l * NEXP * 2 * MiB), DM};
            pg8::MoeOrder S{BLKE, BTOK, 4 * nused, G, vcu};
            pg8::EpiSwiGLU E{ACT};
#pragma unroll 1
            for (int rep = 0; rep < REP_GU; ++rep)
            pg8::gemm_phase<pg8::EpiSwiGLU, pg8::MoeOrder>(lds, g, S, E, wave);
        }
        SEAM(pb + P_GU);
        if (EN(9) && IN(pb + P_DOWN)) {
            PHASE_ENTER();
            const int nused = BLKE[1000];
            pg8::Gemm g{ACT, (const bf16_t*)(const GAS bf16_t*)(ws + WS_WDN + (size_t)l * NEXP * MiB), DFF};
            pg8::MoeOrder S{BLKE, nullptr, 4 * nused, G, vcu};
            pg8::EpiY E{YM};
#pragma unroll 1
            for (int rep = 0; rep < REP_DOWN; ++rep)
            pg8::gemm_phase<pg8::EpiY, pg8::MoeOrder>(lds, g, S, E, wave);
        }
        SEAM(pb + P_DOWN);
    }
    if (EN(10) && IN(PH_FINAL)) {
        PHASE_ENTER();
        row_phase<false, true, false, false, true>(lds, tid, lane, wave, G, bx, x_in, XB, out, g_ffn, MOD, 0, 0, MOD + (size_t)NB * MODW, H, YM, POS, TW, WR, TE, TRK, CNT);
    }
#undef IN
#undef SEAM
#undef GRID_BAR
}

extern "C" void kernel_launch(void* const* d_in, const int* in_sizes, int n_in, void* d_out, int out_size, void* d_ws, size_t ws_size, hipStream_t stream) {
    static int grid = 0;
    if (grid == 0) {
        if (n_in != 18 || in_sizes[0] != TT * DM || out_size != TT * DM || ws_size < WS_END) { fprintf(stderr, "kernel_launch: unexpected shapes / workspace (n_in %d, ws %zu); nothing launched\n", n_in, ws_size); grid = -1; return; }
        int dev = 0, cus = 0, per_cu = 0;
        if (hipGetDevice(&dev) != hipSuccess || hipDeviceGetAttribute(&cus, hipDeviceAttributeMultiprocessorCount, dev) != hipSuccess) { grid = -1; return; }
        if (hipFuncSetAttribute((const void*)fwd_kernel, hipFuncAttributeMaxDynamicSharedMemorySize, LDS_BYTES) != hipSuccess) { fprintf(stderr, "kernel_launch: hipFuncSetAttribute failed\n"); grid = -1; return; }
        if (hipOccupancyMaxActiveBlocksPerMultiprocessor(&per_cu, (const void*)fwd_kernel, 512, LDS_BYTES) != hipSuccess || per_cu < 1) { fprintf(stderr, "kernel_launch: occupancy query says %d\n", per_cu); per_cu = 1; }
        (void)hipGetLastError();
        grid = cus;
    }
    if (grid < 0) return;
    (void)hipMemsetAsync((char*)d_ws + WS_CTL, 0, CTL_ZERO_BYTES, stream);
    Args a{};
    for (int i = 0; i < 18; ++i) a.in[i] = (const float*)d_in[i];
    a.out = (float*)d_out; a.ws = (unsigned char*)d_ws;
#if MK_ONE_LAUNCH
    a.ph_lo = 0; a.ph_hi = NPH;
    hipLaunchKernelGGL(fwd_kernel, dim3(grid), dim3(512), LDS_BYTES, stream, a);
#else
    for (int p = 0; p < NPH; ++p) { a.ph_lo = p; a.ph_hi = p + 1; hipLaunchKernelGGL(fwd_kernel, dim3(grid), dim3(512), LDS_BYTES, stream, a); }
#endif
}
```

```cpp
#include <hip/hip_runtime.h>
#include <cstdio>
#include <cstdint>

#ifndef INPROJ_WGM
#define INPROJ_WGM 4
#endif
#ifndef GEMM_ALIGN
#define GEMM_ALIGN 1
#endif
#ifndef ROWB
#define ROWB 4
#endif
#ifndef N1K_WGM
#define N1K_WGM 8
#endif
#ifndef OUT_ROWMAJOR
#define OUT_ROWMAJOR 0
#endif
#ifndef REP_PRO
#define REP_PRO 1
#endif
#ifndef REP_ATTB
#define REP_ATTB 1
#endif
#ifndef REP_ATTA
#define REP_ATTA 1
#endif
#ifndef REP_INPROJ
#define REP_INPROJ 1
#endif
#ifndef REP_NORM1
#define REP_NORM1 1
#endif
#ifndef REP_GU
#define REP_GU 1
#endif
#ifndef REP_PAB
#define REP_PAB 1
#endif
#ifndef REP_OUT
#define REP_OUT 1
#endif
#ifndef REP_DOWN
#define REP_DOWN 1
#endif
#ifndef REP_NORM2
#define REP_NORM2 1
#endif
#ifndef MK_ONE_LAUNCH
#define MK_ONE_LAUNCH 1
#endif

#define LAS __attribute__((address_space(3)))
#define GAS __attribute__((address_space(1)))
typedef unsigned short bf16_t;
typedef short bf16x8 __attribute__((ext_vector_type(8)));
typedef short s16x4 __attribute__((ext_vector_type(4)));
typedef float f32x4 __attribute__((ext_vector_type(4)));
typedef float f32x16 __attribute__((ext_vector_type(16)));
typedef unsigned u32x4 __attribute__((ext_vector_type(4)));
typedef unsigned u32x2 __attribute__((ext_vector_type(2)));

constexpr int NB = 32, SEQ = 2048, DM = 1024, TT = NB * SEQ;
constexpr int NC = 4352;
constexpr int NEXP = 32, DFF = 512, NPAD = 139264, NBLK = 544;
constexpr int MODW = 6 * DM;
constexpr float QSCALE = 0.125f * 1.4426950408889634f;

constexpr size_t MiB = 1u << 20;
constexpr size_t WS_CTL = 0, CTL_ZERO_BYTES = 64 * 1024;
constexpr size_t WS_MOD = 1 * MiB;
constexpr size_t WS_TE = 2 * MiB + 512 * 1024, WS_TRK = 3 * MiB, WS_TW = 3 * MiB + 512 * 1024, WS_POS = 4 * MiB;
constexpr size_t WS_CNT = 4 * MiB + 512 * 1024;
constexpr size_t WS_BLKE = WS_CNT + 64 * 1024;
constexpr size_t WS_BTOK = WS_CNT + 128 * 1024;
constexpr size_t WS_WR = 5 * MiB + 256 * 1024;
constexpr size_t WS_WIN = 6 * MiB;
constexpr size_t WIN_BYTES = (size_t)NC * DM * 2;
constexpr size_t WS_WPA = 23 * MiB, WS_WPB = 25 * MiB, WS_WOUT = 27 * MiB;
constexpr size_t WS_WGU = 31 * MiB;
constexpr size_t WS_WDN = 159 * MiB;
constexpr size_t WS_H = 223 * MiB;
constexpr size_t WS_QKV = 351 * MiB;
constexpr size_t WS_GATE = 639 * MiB;
constexpr size_t WS_XB = 896 * MiB;
constexpr size_t WS_END = 1024 * MiB;
constexpr int CW_BAR = 4096;

constexpr int RING_BYTES = 133120;
constexpr int MISC_OFF = RING_BYTES;
constexpr int LDS_BYTES = 147456;

#define RLX_AGENT __ATOMIC_RELAXED, __HIP_MEMORY_SCOPE_AGENT
typedef float f32x2_t __attribute__((ext_vector_type(2))); typedef __bf16 bf16x2_t __attribute__((ext_vector_type(2)));
__device__ __forceinline__ unsigned cvt_pk_bf16(float lo, float hi) { const f32x2_t v = {lo, hi}; const bf16x2_t b = __builtin_convertvector(v, bf16x2_t); return __builtin_bit_cast(unsigned, b); }
typedef float f32x2v __attribute__((ext_vector_type(2)));
__device__ __forceinline__ unsigned pack4_fp8(float a, float b, float c, float d) { unsigned w = 0; w = __builtin_amdgcn_cvt_pk_fp8_f32(a, b, w, false); w = __builtin_amdgcn_cvt_pk_fp8_f32(c, d, w, true); return w; }
__device__ __forceinline__ void unpack8_fp8(u32x2 w, float (&o)[8]) { const f32x2v a = __builtin_amdgcn_cvt_pk_f32_fp8(w.x, false), b = __builtin_amdgcn_cvt_pk_f32_fp8(w.x, true), c = __builtin_amdgcn_cvt_pk_f32_fp8(w.y, false), d = __builtin_amdgcn_cvt_pk_f32_fp8(w.y, true);
    o[0] = a.x; o[1] = a.y; o[2] = b.x; o[3] = b.y; o[4] = c.x; o[5] = c.y; o[6] = d.x; o[7] = d.y; }
constexpr float W8S = 64.f, W8I = 1.f / 64.f;
__device__ __forceinline__ float bf_lo(unsigned w) { return __uint_as_float(w << 16); }
__device__ __forceinline__ float bf_hi(unsigned w) { return __uint_as_float(w & 0xffff0000u); }
__device__ __forceinline__ float shx(float v, int mask, int lane) { return __int_as_float(__builtin_amdgcn_ds_bpermute((lane ^ mask) << 2, __float_as_int(v))); }
__device__ __forceinline__ float wave_sum(float v, int lane) {
#pragma unroll
    for (int o = 1; o < 64; o <<= 1) v += shx(v, o, lane);
    return v;
}
__device__ __forceinline__ float wave_max(float v, int lane) {
#pragma unroll
    for (int o = 1; o < 64; o <<= 1) v = fmaxf(v, shx(v, o, lane));
    return v;
}
__device__ __forceinline__ float sigmoid_f(float x) { return __builtin_amdgcn_rcpf(1.0f + __builtin_amdgcn_exp2f(-1.4426950408889634f * x)); }

#define XB_TMO      128
#define XB_XCNT(j)  (256  + 64 * (j))
#define XB_XSUB(j)  (1280 + 64 * (j))
#define XB_XGEN(j)  (2304 + 64 * (j))
#define XB_TOP      3328
#define XB_TOPGEN   3392
#define XCD_BAR_WORDS 3456
#define XB_SPIN_CAP (1u << 18)

__device__ __forceinline__ unsigned xb_ld(unsigned* p)              { return __hip_atomic_load(p, __ATOMIC_RELAXED, __HIP_MEMORY_SCOPE_AGENT); }
__device__ __forceinline__ unsigned xb_add(unsigned* p, unsigned v) { return __hip_atomic_fetch_add(p, v, __ATOMIC_RELAXED, __HIP_MEMORY_SCOPE_AGENT); }
__device__ __forceinline__ unsigned xb_xcc_id() { return (unsigned)__builtin_amdgcn_s_getreg((3 << 11) | 20) & 0xFu; }
#define XB_SPIN(cond, bar) do { unsigned _sp = 0; while (cond) { __builtin_amdgcn_s_sleep(1); \
    if ((++_sp & 255u) == 0u) { if (xb_ld(&(bar)[XB_TMO])) break; if (_sp > XB_SPIN_CAP) { atomicAdd(&(bar)[XB_TMO], 1u); break; } } } } while (0)

struct XcdBarrier { unsigned* bar; unsigned x; volatile LAS unsigned* st; };

__device__ __forceinline__ XcdBarrier xcd_barrier_post(unsigned* bar, volatile LAS unsigned* st) {
    XcdBarrier b; b.bar = bar; b.x = xb_xcc_id(); b.st = st;
    if (threadIdx.x == 0) (void)xb_add(&bar[XB_XCNT(b.x)], 1u);
    return b;
}
__device__ __forceinline__ void xcd_barrier_complete(unsigned* bar, unsigned x, unsigned& nloc, unsigned& nx) {
    const unsigned G = gridDim.x * gridDim.y * gridDim.z;
    unsigned sum, cnt, mine, sp = 0u;
    for (;;) {
        sum = 0u; cnt = 0u; mine = 0u;
#pragma unroll
        for (unsigned j = 0; j < 16; ++j) { const unsigned c = xb_ld(&bar[XB_XCNT(j)]); sum += c; cnt += (c > 0u) ? 1u : 0u; mine = (j == x) ? c : mine; }
        if (sum == G) break;
        __builtin_amdgcn_s_sleep(1);
        if ((++sp & 255u) == 0u) { if (xb_ld(&bar[XB_TMO])) break; if (sp > XB_SPIN_CAP) { atomicAdd(&bar[XB_TMO], 1u); break; } }
    }
    nloc = mine > 0u ? mine : 1u; nx = cnt > 0u ? cnt : 1u;
}
__device__ __forceinline__ void xcd_barrier(const XcdBarrier& b, const bool is_t0  ) {
    asm volatile("s_waitcnt vmcnt(0)" ::: "memory");
    __syncthreads();
    if (is_t0) {
        unsigned* bar = b.bar; unsigned bx_ = b.x;
        asm volatile("" : "+s"(bar), "+s"(bx_));
        __builtin_amdgcn_s_waitcnt(0);
        unsigned nloc = b.st[0], nx = b.st[1];
        if (nloc == 0u) { xcd_barrier_complete(bar, bx_, nloc, nx); b.st[0] = nloc; b.st[1] = nx; }
        const unsigned old = xb_add(&bar[XB_XSUB(bx_)], 1u);
        const unsigned gen = old / nloc;
        if (old + 1u == (gen + 1u) * nloc) {
            __builtin_amdgcn_fence(__ATOMIC_RELEASE, "agent");
            asm volatile("s_waitcnt vmcnt(0)" ::: "memory");
            const unsigned og = xb_add(&bar[XB_TOP], 1u);
            const unsigned tg = og / nx;
            if (og + 1u == (tg + 1u) * nx) xb_add(&bar[XB_TOPGEN], 1u);
            else XB_SPIN(xb_ld(&bar[XB_TOPGEN]) == tg, bar);
            __builtin_amdgcn_fence(__ATOMIC_ACQUIRE, "agent");
            xb_add(&bar[XB_XGEN(bx_)], 1u);
            asm volatile("s_waitcnt vmcnt(0)" ::: "memory");
        } else {
            XB_SPIN(xb_ld(&bar[XB_XGEN(bx_)]) == gen, bar);
            __builtin_amdgcn_fence(__ATOMIC_ACQUIRE, "agent");
            asm volatile("s_waitcnt vmcnt(0)" ::: "memory");
        }
    }
    __syncthreads();
}

namespace pg8 {
constexpr int BM = 256, BK = 64, HALF = 128, HTB = HALF * BK * 2, STAGE_BYTES = 8 * HTB, NXCD = 8, WGM = 8;
__host__ __device__ __forceinline__ int lds_byte(int r, int c) { const int st = (r >> 4) * 2 + (c >> 5), rr = r & 15, cc = c & 31, ob = rr * 64 + cc * 2; return st * 1024 + (ob ^ (((ob >> 9) & 1) << 5)); }
__host__ __device__ __forceinline__ void stage_rc(int b, int& R, int& C) { const int st = b / 1024, sb = b % 1024, swz = sb ^ (((sb >> 9) & 1) << 5); R = (st >> 1) * 16 + swz / 64; C = (st & 1) * 32 + (swz % 64) / 2; }
__host__ __device__ __forceinline__ int perm32(int rho) { const int n = rho >> 4, i = rho & 15; return 8 * (i >> 2) + 4 * n + (i & 3); }

struct Unit { int pm, pn; };
struct Gemm { const bf16_t* A; const bf16_t* Bt; int K; };

struct StaticOrder {
    static constexpr bool GATHER = false;
    int nM, nN, nwg, G, c, wgm = WGM;
    __device__ void init(int M, int N, int G_, int c_) { asm volatile("" : "+s"(c_));     nM = M / BM; nN = N / BM; nwg = nM * nN; G = G_; c = c_; }
    int rowmajor = 0;
    __device__ __forceinline__ bool next(int i, Unit& u) const {
        if (rowmajor) { const int upw = (nwg + G - 1) / G, k = c * upw + i; if (i >= upw || k >= nwg) return false; u.pm = k / nN; u.pn = k % nN; return true; }
        const long L = (long)i * G + c; if (L >= nwg) return false;
        int wgid = (int)L; { const int q = nwg / NXCD, r = nwg % NXCD, xcd = wgid % NXCD, off = wgid / NXCD; wgid = (xcd < r ? xcd * (q + 1) : r * (q + 1) + (xcd - r) * q) + off; }
        const int nig = wgm * nN, gid = wgid / nig, fm = gid * wgm, gsz = (nM - fm) < wgm ? (nM - fm) : wgm;
        u.pm = fm + ((wgid % nig) % gsz); u.pn = (wgid % nig) / gsz; return true;
    }
    __device__ __forceinline__ void aoff(const Unit&, const int (&)[2], const unsigned (&)[2], int, unsigned (&)[2][2]) const {}
};
struct MoeOrder {
    static constexpr bool GATHER = true;
    const int* blk_e; const int* rowidx; int nunits, G, c;
    __device__ __forceinline__ bool next(int i, Unit& u) const {
        const int L = i * G + c; if (L >= nunits) return false;
        const int blk = L >> 2; const int e = blk_e[blk]; u.pm = blk; u.pn = 4 * e + (L & 3); return true;
    }
    __device__ __forceinline__ void aoff(const Unit& u, const int (&RA)[2], const unsigned (&CA2)[2], int K, unsigned (&o)[2][2]) const {
#pragma unroll
        for (int h = 0; h < 2; ++h)
#pragma unroll
            for (int i = 0; i < 2; ++i) { const int r = u.pm * BM + h * HALF + RA[i]; const int src = rowidx ? rowidx[r] : r; o[h][i] = (unsigned)src * (unsigned)(K * 2) + CA2[i]; }
    }
};

typedef int i32x8 __attribute__((ext_vector_type(8))); typedef int i32x4 __attribute__((ext_vector_type(4)));
__device__ __forceinline__ i32x8 cat8(const bf16x8& a, const bf16x8& b) { return __builtin_shufflevector(__builtin_bit_cast(i32x4, a), __builtin_bit_cast(i32x4, b), 0, 1, 2, 3, 4, 5, 6, 7); }
template <class Epi, class Sched, bool F8 = false>
__device__ __forceinline__ void gemm_phase(LAS unsigned char* lds, const Gemm g, const Sched& S, const Epi& E, const int wid) {
    int lane_; asm volatile("v_mbcnt_lo_u32_b32 %0, -1, 0\n\tv_mbcnt_hi_u32_b32 %0, -1, %0" : "=v"(lane_));
    const int lane = lane_, tid = wid * 64 + lane, wr = wid >> 2, wc = wid & 3, fr = lane & 15, fq = lane >> 4;
    const int K = g.K, nt = K / BK;
    unsigned voffA[2], voffB[2], CA2[2]; int RA[2];
#pragma unroll
    for (int i = 0; i < 2; ++i) { int R, C; stage_rc(tid * 16 + i * 8192, R, C); const int Rb = Epi::PERM ? ((R & ~31) + perm32(R & 31)) : R;
        RA[i] = R; CA2[i] = (unsigned)C * 2u; voffA[i] = (unsigned)(R * K + C) * 2u; voffB[i] = (unsigned)(Rb * K + C) * 2u; }
    const size_t kstep = (size_t)(BK * 2);
    const size_t hstep = (size_t)HALF * K * 2;
    const size_t tstep = 2 * hstep;
    const unsigned ldsw = (unsigned)wid * 1024u;
    const int aoff = lds_byte(wr * 64 + fr, fq * 8), boff = lds_byte(wc * 32 + fr, fq * 8);
    const char* Ab = (const char*)g.A;
#define PG8_SA(b, h) (((b) * 2 + (h)) * HTB)
#define PG8_SB(b, h) ((4 + (b) * 2 + (h)) * HTB)
#define PG8_UNI(p) asm volatile("" : "+s"(p))
#define PG8_STAGEB(bufoff, gbase, voff) do { const char* _g = (const char*)(gbase); PG8_UNI(_g); _Pragma("unroll") for (int _i = 0; _i < 2; ++_i) \
        __builtin_amdgcn_global_load_lds((const unsigned*)(_g + (voff)[_i]), (LAS unsigned*)(lds + (bufoff) + ldsw + _i * 8192), 16, 0, 0); } while (0)
#define PG8_STAGEA(bufoff, H_, kb, NEXT) do { if constexpr (Sched::GATHER) { const char* _g = Ab + (size_t)(kb); PG8_UNI(_g); _Pragma("unroll") for (int _i = 0; _i < 2; ++_i) { const unsigned _o = (NEXT) ? na[H_][_i] : ca[H_][_i]; \
            __builtin_amdgcn_global_load_lds((const unsigned*)(_g + _o), (LAS unsigned*)(lds + (bufoff) + ldsw + _i * 8192), 16, 0, 0); } } \
        else { const char* _b = Ab + ((NEXT) ? nU : cU) + (size_t)(H_) * hstep + (size_t)(kb); PG8_UNI(_b); _Pragma("unroll") for (int _i = 0; _i < 2; ++_i) \
            __builtin_amdgcn_global_load_lds((const unsigned*)(_b + voffA[_i]), (LAS unsigned*)(lds + (bufoff) + ldsw + _i * 8192), 16, 0, 0); } } while (0)
#define PG8_LDA(dst, b, h) do { _Pragma("unroll") for (int m = 0; m < 4; ++m) _Pragma("unroll") for (int k = 0; k < 2; ++k) dst[m][k] = *(const LAS bf16x8*)(lds + PG8_SA(b, h) + aoff + m * 2048 + k * 1024); } while (0)
#define PG8_LDB(dst, b, h) do { _Pragma("unroll") for (int n = 0; n < 2; ++n) _Pragma("unroll") for (int k = 0; k < 2; ++k) dst[n][k] = *(const LAS bf16x8*)(lds + PG8_SB(b, h) + boff + n * 2048 + k * 1024); } while (0)
#define PG8_MMA(ai, bj, At, Bt) do { __builtin_amdgcn_s_setprio(1); _Pragma("unroll") for (int m = 0; m < 4; ++m) _Pragma("unroll") for (int n = 0; n < 2; ++n) { \
        if constexpr (F8) acc[ai][bj][m][n] = __builtin_amdgcn_mfma_scale_f32_16x16x128_f8f6f4(cat8(Bt[n][0], Bt[n][1]), cat8(At[m][0], At[m][1]), acc[ai][bj][m][n], 0, 0, 0, 0, 0, 0); \
        else { _Pragma("unroll") for (int k = 0; k < 2; ++k) acc[ai][bj][m][n] = __builtin_amdgcn_mfma_f32_16x16x32_bf16(Bt[n][k], At[m][k], acc[ai][bj][m][n], 0, 0, 0); } } \
        __builtin_amdgcn_s_setprio(0); } while (0)
#define PG8_WAIT_V(n) asm volatile("s_waitcnt vmcnt(" #n ")" ::: "memory")
#define PG8_WAIT_L(n) asm volatile("s_waitcnt lgkmcnt(" #n ")" ::: "memory")
#define PG8_BAR __builtin_amdgcn_s_barrier()
#define PG8_SCHED __builtin_amdgcn_sched_barrier(0)
    Unit cur, nxt; int ui = 0;
    if (!S.next(0, cur)) return;
    f32x4 acc[2][2][4][2];
#pragma unroll
    for (int a = 0; a < 2; ++a)
#pragma unroll
        for (int b = 0; b < 2; ++b)
#pragma unroll
            for (int m = 0; m < 4; ++m)
#pragma unroll
                for (int n = 0; n < 2; ++n) acc[a][b][m][n] = (f32x4){0.f, 0.f, 0.f, 0.f};
    bf16x8 At[4][2], B0[2][2], B1[2][2];
    unsigned ca[2][2], na[2][2];
    size_t cU = 0, nU = 0;
    if constexpr (Sched::GATHER) S.aoff(cur, RA, CA2, K, ca); else cU = (size_t)cur.pm * tstep;
    const char* cB = (const char*)g.Bt + (size_t)cur.pn * tstep;
    PG8_STAGEB(PG8_SB(0, 0), cB, voffB); PG8_STAGEB(PG8_SB(0, 1), cB + hstep, voffB); PG8_STAGEA(PG8_SA(0, 0), 0, 0, false); PG8_STAGEA(PG8_SA(0, 1), 1, 0, false);
    if (wr == 1) PG8_BAR;
    PG8_WAIT_V(2); PG8_BAR;
    PG8_STAGEB(PG8_SB(1, 0), cB + kstep, voffB); PG8_STAGEA(PG8_SA(1, 0), 0, kstep, false); PG8_STAGEB(PG8_SB(1, 1), cB + hstep + kstep, voffB);
    PG8_WAIT_V(6); PG8_BAR;
    for (;;) {
        const bool has_next = S.next(ui + 1, nxt);
        if constexpr (Sched::GATHER) {
            if (has_next) S.aoff(nxt, RA, CA2, K, na);
            else {
#pragma unroll
                for (int h = 0; h < 2; ++h)
#pragma unroll
                    for (int i = 0; i < 2; ++i) na[h][i] = ca[h][i];
            }
        } else nU = has_next ? (size_t)nxt.pm * tstep : cU;
        const char* nB = has_next ? (const char*)g.Bt + (size_t)nxt.pn * tstep : cB;
        for (int t = 0; t < nt; t += 2) {
            const bool last = (t == nt - 2);
            const size_t kb1 = (size_t)(t + 1) * kstep;
            const size_t kb2 = last ? 0 : (size_t)(t + 2) * kstep, kb3 = kb2 + kstep;
            const char* b2 = last ? nB : cB + (size_t)(t + 2) * kstep; const char* b3 = b2 + kstep;
            PG8_LDB(B0, 0, 0); PG8_LDB(B1, 0, 1); PG8_SCHED; PG8_LDA(At, 0, 0); PG8_STAGEA(PG8_SA(1, 1), 1, kb1, false);
            PG8_WAIT_V(8); PG8_WAIT_L(0); PG8_BAR; PG8_MMA(0, 0, At, B0); PG8_MMA(0, 1, At, B1); PG8_BAR; PG8_SCHED;
            PG8_LDA(At, 0, 1); PG8_STAGEB(PG8_SB(0, 0), b2, voffB); PG8_STAGEB(PG8_SB(0, 1), b2 + hstep, voffB); PG8_STAGEA(PG8_SA(0, 0), 0, kb2, last);
            PG8_WAIT_V(8); PG8_WAIT_L(0); PG8_BAR; PG8_MMA(1, 0, At, B0); PG8_MMA(1, 1, At, B1); PG8_BAR; PG8_SCHED;
            PG8_LDB(B0, 1, 0); PG8_LDB(B1, 1, 1); PG8_SCHED; PG8_LDA(At, 1, 0); PG8_STAGEA(PG8_SA(0, 1), 1, kb2, last);
            PG8_WAIT_V(8); PG8_WAIT_L(0); PG8_BAR; PG8_MMA(0, 0, At, B0); PG8_MMA(0, 1, At, B1); PG8_BAR; PG8_SCHED;
            PG8_LDA(At, 1, 1); PG8_STAGEB(PG8_SB(1, 0), b3, voffB); PG8_STAGEB(PG8_SB(1, 1), b3 + hstep, voffB); PG8_STAGEA(PG8_SA(1, 0), 0, kb3, last);
            PG8_WAIT_V(8); PG8_WAIT_L(0); PG8_BAR; PG8_MMA(1, 0, At, B0); PG8_MMA(1, 1, At, B1); PG8_BAR; PG8_SCHED;
            if constexpr (Epi::MIDK) { if (t + 2 == nt / 2) E.mid(acc, cur, wr, wc, fr, fq); }
        }
#if GEMM_ALIGN
        if (wr == 0) PG8_BAR;
#endif
        E(acc, cur, wr, wc, fr, fq);
        if (!has_next) break;
#pragma unroll
        for (int a = 0; a < 2; ++a)
#pragma unroll
            for (int b = 0; b < 2; ++b)
#pragma unroll
                for (int m = 0; m < 4; ++m)
#pragma unroll
                    for (int n = 0; n < 2; ++n) acc[a][b][m][n] = (f32x4){0.f, 0.f, 0.f, 0.f};
        cur = nxt; cB = nB; cU = nU; ++ui;
        if constexpr (Sched::GATHER) {
#pragma unroll
            for (int h = 0; h < 2; ++h)
#pragma unroll
                for (int i = 0; i < 2; ++i) ca[h][i] = na[h][i];
        }
#if GEMM_ALIGN
        if (wr == 1) PG8_BAR;
#endif
    }
    PG8_WAIT_V(0);
#if !GEMM_ALIGN
    if (wr == 0) PG8_BAR;
#endif
    PG8_BAR;
#undef PG8_SA
#undef PG8_SB
#undef PG8_STAGEA
#undef PG8_STAGEB
#undef PG8_UNI
#undef PG8_LDA
#undef PG8_LDB
#undef PG8_MMA
#undef PG8_WAIT_V
#undef PG8_WAIT_L
#undef PG8_BAR
#undef PG8_SCHED
}

typedef const f32x4 (&AccRef)[2][2][4][2];

__device__ __forceinline__ u32x4 pack8(const f32x4& a, const f32x4& b) { u32x4 w; w.x = cvt_pk_bf16(a[0], a[1]); w.y = cvt_pk_bf16(a[2], a[3]); w.z = cvt_pk_bf16(b[0], b[1]); w.w = cvt_pk_bf16(b[2], b[3]); return w; }

struct EpiInProj {
    static constexpr bool PERM = true, MIDK = false;
    bf16_t *QA, *KA, *VA, *QB, *KB, *VB, *SA, *SB;
    const LAS float* normw;
    template <int ROPE>
    __device__ __forceinline__ void head_tile(AccRef acc, bf16_t* dst_, int ld, int hcol, int gsel, float scale, int row0, int fr, int fq) const {
        unsigned char* dst = (unsigned char*)dst_;
        int d0[2];
#pragma unroll
        for (int bj = 0; bj < 2; ++bj) d0[bj] = (ROPE == 1) ? (fq == 0 ? 8 * bj : 8 + 8 * fq + 24 * bj) : (fq < 2 ? 8 * fq + 16 * bj : 16 + 8 * fq + 16 * bj);
        f32x4 g[2][2];
#pragma unroll
        for (int bj = 0; bj < 2; ++bj)
#pragma unroll
            for (int n = 0; n < 2; ++n) g[bj][n] = *(const LAS f32x4*)(normw + gsel * 64 + d0[bj] + 4 * n);
        constexpr float FA[8] = {1.591549431e-01f, 3.086376340e-02f, 5.985185713e-03f, 1.160663641e-03f, 2.250790790e-04f, 4.364795279e-05f, 8.464330808e-06f, 1.641426263e-06f};
        constexpr float FB[16] = {1.591549431e-01f, 8.949940161e-02f, 5.032921210e-02f, 2.830219583e-02f, 1.591549431e-02f, 8.949940161e-03f, 5.032921210e-03f, 2.830219583e-03f,
                                  1.591549431e-03f, 8.949940161e-04f, 5.032921210e-04f, 2.830219583e-04f, 1.591549431e-04f, 8.949940161e-05f, 5.032921210e-05f, 2.830219583e-05f};
        float fq8[8];
#pragma unroll
        for (int k = 0; k < 8; ++k) fq8[k] = (ROPE == 1) ? FA[k] : ((fq & 1) ? FB[8 + k] : FB[k]);
        const bool rot = (ROPE == 2) || (fq == 0);
#pragma unroll
        for (int ai = 0; ai < 2; ++ai)
#pragma unroll
            for (int m = 0; m < 4; ++m) {
                const int row = row0 + ai * HALF + m * 16; const int s = row & (SEQ - 1);
                f32x4 y[2][2]; float ss = 0.f;
#pragma unroll
                for (int bj = 0; bj < 2; ++bj)
#pragma unroll
                    for (int n = 0; n < 2; ++n) { y[bj][n] = acc[ai][bj][m][n]; const f32x4 q = y[bj][n] * y[bj][n]; ss += (q[0] + q[1]) + (q[2] + q[3]); }
                ss += shx(ss, 16, fr + 16 * fq); ss += shx(ss, 32, fr + 16 * fq);
                const float rinv = __builtin_amdgcn_rsqf(ss * (W8I * W8I / 64.0f) + 1e-6f) * W8I;
#pragma unroll
                for (int bj = 0; bj < 2; ++bj)
#pragma unroll
                    for (int n = 0; n < 2; ++n) y[bj][n] = y[bj][n] * rinv * g[bj][n];
                if (ROPE != 0) {
                    const float pos = (float)((ROPE == 1) ? s : (fq < 2 ? (s >> 6) : (s & 63)));
#pragma unroll
                    for (int n = 0; n < 2; ++n)
#pragma unroll
                        for (int j = 0; j < 4; ++j) {
                            const float xr = __builtin_amdgcn_fractf(pos * fq8[4 * n + j]);
                            const float c = rot ? __builtin_amdgcn_cosf(xr) : 1.0f, s_ = rot ? __builtin_amdgcn_sinf(xr) : 0.0f;
                            const float x1 = y[0][n][j], x2 = y[1][n][j];
                            y[0][n][j] = x1 * c - x2 * s_; y[1][n][j] = x2 * c + x1 * s_;
                        }
                }
                u32x4 w;
#pragma unroll
                for (int bj = 0; bj < 2; ++bj) { const f32x4 a = y[bj][0] * scale, c = y[bj][1] * scale;
                    const unsigned lo = pack4_fp8(a[0], a[1], a[2], a[3]), hi = pack4_fp8(c[0], c[1], c[2], c[3]);
                    if (bj == 0) { w.x = lo; w.y = hi; } else { w.z = lo; w.w = hi; } }
                *(u32x4*)(dst + (size_t)row * ld + hcol + 16 * fq) = w;
            }
    }
    __device__ __forceinline__ void operator()(AccRef acc, const Unit& u, int wr, int wc, int fr_, int fq_) const {
        int fr = fr_, fq = fq_; asm volatile("" : "+v"(fr), "+v"(fq));
        const int pn = u.pn; const int row0 = u.pm * BM + wr * 64 + fr;
        if (pn >= 9) {
            unsigned char* base = (unsigned char*)((pn < 13) ? SA : SB); const int colt = ((pn - 9) & 3) * 256 + wc * 64 + 16 * fq;
#pragma unroll
            for (int ai = 0; ai < 2; ++ai)
#pragma unroll
                for (int m = 0; m < 4; ++m) { u32x4 w;
#pragma unroll
                    for (int bj = 0; bj < 2; ++bj) { f32x4 v0 = acc[ai][bj][m][0], v1 = acc[ai][bj][m][1];
#pragma unroll
                        for (int j = 0; j < 4; ++j) { v0[j] = sigmoid_f(v0[j] * W8I); v1[j] = sigmoid_f(v1[j] * W8I); }
                        const unsigned lo = pack4_fp8(v0[0], v0[1], v0[2], v0[3]), hi = pack4_fp8(v1[0], v1[1], v1[2], v1[3]);
                        if (bj == 0) { w.x = lo; w.y = hi; } else { w.z = lo; w.w = hi; } }
                    *(u32x4*)(base + (size_t)(row0 + ai * HALF + m * 16) * DM + colt) = w; }
        } else if (pn == 4 || pn == 5) {
            const int colt = (pn - 4) * 256 + wc * 64 + 16 * fq;
#pragma unroll
            for (int ai = 0; ai < 2; ++ai)
#pragma unroll
                for (int m = 0; m < 4; ++m) { bf16_t* rowp = VA + (size_t)(row0 + ai * HALF + m * 16) * 512 + colt;
#pragma unroll
                    for (int bj = 0; bj < 2; ++bj) *(u32x4*)(rowp + 8 * bj) = pack8(acc[ai][bj][m][0] * W8I, acc[ai][bj][m][1] * W8I); }
        } else if (pn < 2)  head_tile<1>(acc, QA, 512, 64 * (4 * pn + wc), 0, QSCALE, row0, fr, fq);
        else if (pn < 4)    head_tile<1>(acc, KA, 512, 64 * (4 * (pn - 2) + wc), 1, 1.0f, row0, fr, fq);
        else if (pn < 8)    head_tile<2>(acc, QB, 512, 64 * (4 * (pn - 6) + wc), 2, QSCALE, row0, fr, fq);
        else if (wc < 2)    head_tile<2>(acc, KB, 128, 64 * wc, 3, 1.0f, row0, fr, fq);
        else {
#pragma unroll
            for (int ai = 0; ai < 2; ++ai)
#pragma unroll
                for (int m = 0; m < 4; ++m) { bf16_t* rowp = VB + (size_t)(row0 + ai * HALF + m * 16) * 128 + 64 * (wc - 2) + 8 * fq;
#pragma unroll
                    for (int bj = 0; bj < 2; ++bj) *(u32x4*)(rowp + 32 * bj) = pack8(acc[ai][bj][m][0] * W8I, acc[ai][bj][m][1] * W8I); }
        }
    }
};

struct EpiMergeFused {
    static constexpr bool PERM = true, MIDK = true;
    bf16_t* MG; const unsigned char* GA; const unsigned char* GB;
    __device__ __forceinline__ void mid(f32x4 (&acc)[2][2][4][2], const Unit& u, int wr, int wc, int fr_, int fq_) const {
        int fr = fr_, fq = fq_; asm volatile("" : "+v"(fr), "+v"(fq));
        const int row0 = u.pm * BM + wr * 64 + fr, col0 = u.pn * BM + wc * 64 + 16 * fq;
#pragma unroll
        for (int ai = 0; ai < 2; ++ai)
#pragma unroll
            for (int m = 0; m < 4; ++m) { const size_t ro = (size_t)(row0 + ai * HALF + m * 16) * DM + col0;
                const u32x4 a = *(const u32x4*)(GA + ro), b = *(const u32x4*)(GB + ro);
#pragma unroll
                for (int bj = 0; bj < 2; ++bj) {
                    float sa[8], sb[8]; unpack8_fp8(bj ? (u32x2){a.z, a.w} : (u32x2){a.x, a.y}, sa); unpack8_fp8(bj ? (u32x2){b.z, b.w} : (u32x2){b.x, b.y}, sb);
#pragma unroll
                    for (int n = 0; n < 2; ++n)
#pragma unroll
                        for (int j = 0; j < 4; ++j) acc[ai][bj][m][n][j] *= sa[4 * n + j] * __builtin_amdgcn_rcpf(fmaxf(sb[4 * n + j], 1e-12f));
                } }
    }
    __device__ __forceinline__ void operator()(AccRef acc, const Unit& u, int wr, int wc, int fr_, int fq_) const {
        int fr = fr_, fq = fq_; asm volatile("" : "+v"(fr), "+v"(fq));
        const int row0 = u.pm * BM + wr * 64 + fr, col0 = u.pn * BM + wc * 64 + 16 * fq;
#pragma unroll
        for (int ai = 0; ai < 2; ++ai)
#pragma unroll
            for (int m = 0; m < 4; ++m) { const size_t ro = (size_t)(row0 + ai * HALF + m * 16) * DM + col0;
                const u32x4 b = *(const u32x4*)(GB + ro);
#pragma unroll
                for (int bj = 0; bj < 2; ++bj) {
                    float sb[8]; unpack8_fp8(bj ? (u32x2){b.z, b.w} : (u32x2){b.x, b.y}, sb);
                    f32x4 v0 = acc[ai][bj][m][0], v1 = acc[ai][bj][m][1];
#pragma unroll
                    for (int j = 0; j < 4; ++j) { v0[j] *= fmaxf(sb[j], 1e-12f); v1[j] *= fmaxf(sb[4 + j], 1e-12f); }
                    *(u32x4*)(MG + ro + 8 * bj) = pack8(v0, v1); } }
    }
};

struct EpiResidB {
    static constexpr bool PERM = true, MIDK = false;
    const float* Xf; const bf16_t* Xb; bf16_t* O; const float* gate;
    __device__ __forceinline__ void operator()(AccRef acc, const Unit& u, int wr, int wc, int fr_, int fq_) const {
        int fr = fr_, fq = fq_; asm volatile("" : "+v"(fr), "+v"(fq));
        const int row0 = u.pm * BM + wr * 64 + fr, col0 = u.pn * BM + wc * 64 + 16 * fq; const int b = (u.pm * BM) >> 11;
        f32x4 gt[2][2];
#pragma unroll
        for (int bj = 0; bj < 2; ++bj)
#pragma unroll
            for (int n = 0; n < 2; ++n) gt[bj][n] = *(const f32x4*)(gate + (size_t)b * MODW + col0 + 8 * bj + 4 * n);
#pragma unroll
        for (int ai = 0; ai < 2; ++ai)
#pragma unroll
            for (int m = 0; m < 4; ++m) { const size_t ro = (size_t)(row0 + ai * HALF + m * 16) * DM + col0;
#pragma unroll
                for (int bj = 0; bj < 2; ++bj) {
                    f32x4 x0, x1;
                    if (Xf) { x0 = *(const f32x4*)(Xf + ro + 8 * bj); x1 = *(const f32x4*)(Xf + ro + 8 * bj + 4); }
                    else { const u32x4 w = *(const u32x4*)(Xb + ro + 8 * bj); x0 = (f32x4){bf_lo(w.x), bf_hi(w.x), bf_lo(w.y), bf_hi(w.y)}; x1 = (f32x4){bf_lo(w.z), bf_hi(w.z), bf_lo(w.w), bf_hi(w.w)}; }
                    *(u32x4*)(O + ro + 8 * bj) = pack8(x0 + gt[bj][0] * acc[ai][bj][m][0], x1 + gt[bj][1] * acc[ai][bj][m][1]); } }
    }
};

struct EpiSwiGLU {
    static constexpr bool PERM = true, MIDK = false;
    bf16_t* ACT;
    __device__ __forceinline__ void operator()(AccRef acc, const Unit& u, int wr, int wc, int fr_, int fq_) const {
        int fr = fr_, fq = fq_; asm volatile("" : "+v"(fr), "+v"(fq));
        const int row0 = u.pm * BM + wr * 64 + fr, col0 = (u.pn & 3) * HALF + wc * 32 + 8 * fq;
#pragma unroll
        for (int ai = 0; ai < 2; ++ai)
#pragma unroll
            for (int m = 0; m < 4; ++m) { f32x4 r[2];
#pragma unroll
                for (int n = 0; n < 2; ++n)
#pragma unroll
                    for (int j = 0; j < 4; ++j) { const float gg = acc[ai][0][m][n][j], uu = acc[ai][1][m][n][j]; r[n][j] = gg * sigmoid_f(gg) * uu; }
                *(u32x4*)(ACT + (size_t)(row0 + ai * HALF + m * 16) * DFF + col0) = pack8(r[0], r[1]); }
    }
};

struct EpiY {
    static constexpr bool PERM = true, MIDK = false;
    unsigned char* Y;
    __device__ __forceinline__ void operator()(AccRef acc, const Unit& u, int wr, int wc, int fr_, int fq_) const {
        int fr = fr_, fq = fq_; asm volatile("" : "+v"(fr), "+v"(fq));
        const int row0 = u.pm * BM + wr * 64 + fr, col0 = (u.pn & 3) * BM + wc * 64 + 16 * fq;
#pragma unroll
        for (int ai = 0; ai < 2; ++ai)
#pragma unroll
            for (int m = 0; m < 4; ++m) { u32x4 w;
                { const f32x4 a = acc[ai][0][m][0], b = acc[ai][0][m][1]; w.x = pack4_fp8(a[0], a[1], a[2], a[3]); w.y = pack4_fp8(b[0], b[1], b[2], b[3]); }
                { const f32x4 a = acc[ai][1][m][0], b = acc[ai][1][m][1]; w.z = pack4_fp8(a[0], a[1], a[2], a[3]); w.w = pack4_fp8(b[0], b[1], b[2], b[3]); }
                *(u32x4*)(Y + (size_t)(row0 + ai * HALF + m * 16) * DM + col0) = w; }
    }
};
}

__device__ __forceinline__ int dimA(int bj, int r) { return r < 8 ? r + 8 * bj : 16 + (r - 8) + 24 * bj; }
__device__ __forceinline__ int dimB(int bj, int r) { return r < 16 ? r + 16 * bj : 32 + (r - 16) + 16 * bj; }
__device__ __forceinline__ int inproj_srccol(int P) {
    const int pn = P >> 8, p = P & 255, bj = p >> 7, wc = (p >> 5) & 3, r = p & 31;
    if (pn < 2) return 64 * (4 * pn + wc) + dimA(bj, r);
    if (pn < 4) return 512 + 64 * (4 * (pn - 2) + wc) + dimA(bj, r);
    if (pn < 6) return 1024 + 256 * (pn - 4) + 64 * wc + 16 * ((p >> 3) & 3) + 8 * bj + (p & 7);
    if (pn < 8) return 1536 + 64 * (4 * (pn - 6) + wc) + dimB(bj, r);
    if (pn == 8) return wc < 2 ? 2048 + 64 * wc + dimB(bj, r) : 2176 + 64 * (wc - 2) + 32 * bj + r;
    { const int fq = (p >> 3) & 3, r8 = p & 7; return 2304 + 256 * (pn - 9) + 64 * wc + 16 * fq + 8 * bj + r8; }
}

namespace att {
constexpr int KSTR = 80, VSTR = 192;
constexpr int KTILE = 64 * KSTR, VTILE = 64 * VSTR;
constexpr int K_OFF = 0, V_OFF = 2 * KTILE;
constexpr int PRIV_OFF = 0;
__device__ __forceinline__ s16x4 vtr(LAS const char* p) { typedef short v4i16_t __attribute__((ext_vector_type(4)));
    return __builtin_bit_cast(s16x4, __builtin_amdgcn_ds_read_tr16_b64_v4i16((LAS v4i16_t*)p)); }
__device__ __forceinline__ int clamp_tok(int t) { return t < 0 ? 0 : (t > SEQ - 1 ? SEQ - 1 : t); }

__device__ __forceinline__ long mk64(unsigned lo, unsigned hi) { return (long)(((unsigned long long)hi << 32) | lo); }
__device__ __forceinline__ void qk_tile(f32x16& p0, f32x16& p1, const u32x4 (&kf)[2][2], const u32x4 (&qr)[2]) {
    const f32x16 z = {0.f, 0.f, 0.f, 0.f, 0.f, 0.f, 0.f, 0.f, 0.f, 0.f, 0.f, 0.f, 0.f, 0.f, 0.f, 0.f};
    p0 = __builtin_amdgcn_mfma_f32_32x32x16_fp8_fp8(mk64(kf[0][0].x, kf[0][0].y), mk64(qr[0].x, qr[0].y), z, 0, 0, 0);
    p1 = __builtin_amdgcn_mfma_f32_32x32x16_fp8_fp8(mk64(kf[1][0].x, kf[1][0].y), mk64(qr[0].x, qr[0].y), z, 0, 0, 0);
    p0 = __builtin_amdgcn_mfma_f32_32x32x16_fp8_fp8(mk64(kf[0][0].z, kf[0][0].w), mk64(qr[0].z, qr[0].w), p0, 0, 0, 0);
    p1 = __builtin_amdgcn_mfma_f32_32x32x16_fp8_fp8(mk64(kf[1][0].z, kf[1][0].w), mk64(qr[0].z, qr[0].w), p1, 0, 0, 0);
    p0 = __builtin_amdgcn_mfma_f32_32x32x16_fp8_fp8(mk64(kf[0][1].x, kf[0][1].y), mk64(qr[1].x, qr[1].y), p0, 0, 0, 0);
    p1 = __builtin_amdgcn_mfma_f32_32x32x16_fp8_fp8(mk64(kf[1][1].x, kf[1][1].y), mk64(qr[1].x, qr[1].y), p1, 0, 0, 0);
    p0 = __builtin_amdgcn_mfma_f32_32x32x16_fp8_fp8(mk64(kf[0][1].z, kf[0][1].w), mk64(qr[1].z, qr[1].w), p0, 0, 0, 0);
    p1 = __builtin_amdgcn_mfma_f32_32x32x16_fp8_fp8(mk64(kf[1][1].z, kf[1][1].w), mk64(qr[1].z, qr[1].w), p1, 0, 0, 0);
}
template <bool MASK>
__device__ __forceinline__ void exp_tile(const f32x16& p0, const f32x16& p1, float& lsum, bf16x8 (&pf)[2][2], int mbase, int mR, int dk) {
    float e0[16], e1[16]; float ls = 0.f;
#pragma unroll
    for (int r = 0; r < 16; ++r) {
        e0[r] = __builtin_amdgcn_exp2f(p0[r]); e1[r] = __builtin_amdgcn_exp2f(p1[r]);
        if (MASK) {
            const int c0 = (r & 3) + 8 * (r >> 2);
            e0[r] = ((unsigned)(mbase + dk * c0) <= (unsigned)mR) ? e0[r] : 0.f;
            e1[r] = ((unsigned)(mbase + dk * (c0 + 32)) <= (unsigned)mR) ? e1[r] : 0.f;
        }
        ls += e0[r] + e1[r];
    }
    lsum += ls;
#pragma unroll
    for (int s = 0; s < 2; ++s) {
        u32x4 w0, w1;
        w0.x = cvt_pk_bf16(e0[8 * s + 0], e0[8 * s + 1]); w0.y = cvt_pk_bf16(e0[8 * s + 2], e0[8 * s + 3]); w0.z = cvt_pk_bf16(e0[8 * s + 4], e0[8 * s + 5]); w0.w = cvt_pk_bf16(e0[8 * s + 6], e0[8 * s + 7]);
        w1.x = cvt_pk_bf16(e1[8 * s + 0], e1[8 * s + 1]); w1.y = cvt_pk_bf16(e1[8 * s + 2], e1[8 * s + 3]); w1.z = cvt_pk_bf16(e1[8 * s + 4], e1[8 * s + 5]); w1.w = cvt_pk_bf16(e1[8 * s + 6], e1[8 * s + 7]);
        pf[0][s] = __builtin_bit_cast(bf16x8, w0); pf[1][s] = __builtin_bit_cast(bf16x8, w1);
    }
}
__device__ __forceinline__ void vread(bf16x8 (&vf)[4], LAS const char* vb, int d0) {
#pragma unroll
    for (int blk = 0; blk < 2; ++blk)
#pragma unroll
        for (int s = 0; s < 2; ++s) {
            const s16x4 lo = vtr(vb + (32 * blk + 16 * s) * VSTR + 64 * d0), hi = vtr(vb + (32 * blk + 16 * s + 8) * VSTR + 64 * d0);
            vf[2 * blk + s] = (bf16x8){lo[0], lo[1], lo[2], lo[3], hi[0], hi[1], hi[2], hi[3]};
        }
}
__device__ __forceinline__ void pv_half(f32x16& od, const bf16x8 (&vf)[4], const bf16x8 (&pf)[2][2]) {
#pragma unroll
    for (int blk = 0; blk < 2; ++blk)
#pragma unroll
        for (int s = 0; s < 2; ++s) od = __builtin_amdgcn_mfma_f32_32x32x16_bf16(vf[2 * blk + s], pf[blk][s], od, 0, 0, 0);
}
__device__ __forceinline__ void mask_params(int dk, int tk0, int tq, int hi, int& mbase, int& mR) {
    const int dlo = (-64 * dk > -tq) ? -64 * dk : -tq, dhi = (64 * dk < SEQ - 1 - tq) ? 64 * dk : SEQ - 1 - tq;
    const int dA = tk0 + 4 * dk * hi - tq;
    mR = dhi - dlo; mbase = ((dA & (dk - 1)) == 0) ? dA - dlo : 0x7fffffff;
}

template <bool MASKED>
__device__ __forceinline__ void dense64_loop(LAS char* lds, const unsigned char* Kg, const bf16_t* Vg, int ld  , int tok0, int ntiles,
                                             const u32x4 (&qr)[2][2], f32x16 (&o)[2][2], float (&lsum)[2], int tq0, int tq1, int lane_, int wave) {
    constexpr int V2_OFF = 2 * KTILE;
    u32x2 kreg; u32x4 vreg;
#define D64_LANE() int ln_ = lane_; asm volatile("" : "+v"(ln_)); const int tid_ = wave * 64 + ln_, srow = tid_ >> 3, sch = tid_ & 7
#define D64_LD(t) do { D64_LANE(); int tk_ = tok0 + 64 * (t) + srow; if (MASKED) tk_ = clamp_tok(tk_); kreg = *(const u32x2*)(Kg + (size_t)tk_ * ld + sch * 8); vreg = *(const u32x4*)(Vg + (size_t)tk_ * ld + sch * 8); } while (0)
#define D64_ST(t) do { D64_LANE(); *(LAS u32x2*)(lds + ((t) & 1) * KTILE + srow * KSTR + sch * 8) = kreg; *(LAS u32x4*)(lds + V2_OFF + ((t) & 1) * VTILE + srow * VSTR + sch * 16) = vreg; } while (0)
    D64_LD(0); D64_ST(0); D64_LD(1);
    for (int t = 0; t < ntiles; ++t) {
        __syncthreads();
        if (t + 1 < ntiles) D64_ST(t + 1);
        if (t + 2 < ntiles) D64_LD(t + 2);
        int lane = lane_; asm volatile("" : "+v"(lane));
        const int hi = lane >> 5;
        const int vlane = (4 * hi + ((lane & 15) >> 2)) * VSTR + (16 * ((lane >> 4) & 1) + 4 * (lane & 3)) * 2;
        const int klane = (lane & 31) * KSTR + 32 * hi;
        u32x4 kf[2][2];
        { LAS const char* kb_ = lds + (t & 1) * KTILE + klane;
#pragma unroll
          for (int blk = 0; blk < 2; ++blk)
#pragma unroll
              for (int e = 0; e < 2; ++e) kf[blk][e] = *(const LAS u32x4*)(kb_ + 32 * blk * KSTR + 16 * e); }
        f32x16 p[2][2];
        bf16x8 vfa[4], vfb[4];
        LAS const char* vb_ = lds + V2_OFF + (t & 1) * VTILE + vlane;
        vread(vfa, vb_, 0); vread(vfb, vb_, 1);
        __builtin_amdgcn_sched_barrier(0);
        qk_tile(p[0][0], p[0][1], kf, qr[0]);
        qk_tile(p[1][0], p[1][1], kf, qr[1]);
#pragma unroll
        for (int g = 0; g < 2; ++g) {
            bf16x8 pf[2][2]; int mb = 0, mr = 0;
            if (MASKED) mask_params(1, tok0 + 64 * t, g ? tq1 : tq0, hi, mb, mr);
            exp_tile<MASKED>(p[g][0], p[g][1], lsum[g], pf, mb, mr, 1);
            pv_half(o[g][0], vfa, pf); pv_half(o[g][1], vfb, pf);
        }
    }
#undef D64_LANE
#undef D64_LD
#undef D64_ST
}
__device__ __forceinline__ void dense64_lag_loop(LAS char* lds, const unsigned char* Kg, const bf16_t* Vg, int ld  , int ntiles,
                                                 const u32x4 (&qr)[2][2], f32x16 (&o)[2][2], float (&lsum)[2], int lane_, int wave, const bool lag) {
    constexpr int V2_OFF = 2 * KTILE;
    u32x2 kreg; u32x4 vreg;
#define D64_LANE() int ln_ = lane_; asm volatile("" : "+v"(ln_)); const int tid_ = wave * 64 + ln_, srow = tid_ >> 3, sch = tid_ & 7
#define D64_LD(t) do { D64_LANE(); const int tk_ = 64 * (t) + srow; kreg = *(const u32x2*)(Kg + (size_t)tk_ * ld + sch * 8); vreg = *(const u32x4*)(Vg + (size_t)tk_ * ld + sch * 8); } while (0)
#define D64_ST(t) do { D64_LANE(); *(LAS u32x2*)(lds + ((t) & 1) * KTILE + srow * KSTR + sch * 8) = kreg; *(LAS u32x4*)(lds + V2_OFF + ((t) % 3) * VTILE + srow * VSTR + sch * 16) = vreg; } while (0)
#define D64_QK(t) do { int lane = lane_; asm volatile("" : "+v"(lane)); const int klane = (lane & 31) * KSTR + 32 * (lane >> 5); u32x4 kf[2][2]; LAS const char* kb_ = lds + ((t) & 1) * KTILE + klane; \
        _Pragma("unroll") for (int blk = 0; blk < 2; ++blk) _Pragma("unroll") for (int e = 0; e < 2; ++e) kf[blk][e] = *(const LAS u32x4*)(kb_ + 32 * blk * KSTR + 16 * e); \
        qk_tile(p[0][0], p[0][1], kf, qr[0]); qk_tile(p[1][0], p[1][1], kf, qr[1]); } while (0)
#define D64_PV(t) do { int lane = lane_; asm volatile("" : "+v"(lane)); const int hi = lane >> 5; const int vlane = (4 * hi + ((lane & 15) >> 2)) * VSTR + (16 * ((lane >> 4) & 1) + 4 * (lane & 3)) * 2; \
        bf16x8 vfa[4], vfb[4]; LAS const char* vb_ = lds + V2_OFF + ((t) % 3) * VTILE + vlane; vread(vfa, vb_, 0); vread(vfb, vb_, 1); \
        _Pragma("unroll") for (int g = 0; g < 2; ++g) { bf16x8 pf[2][2]; exp_tile<false>(p[g][0], p[g][1], lsum[g], pf, 0, 0, 0); pv_half(o[g][0], vfa, pf); pv_half(o[g][1], vfb, pf); } } while (0)
    f32x16 p[2][2];
    D64_LD(0); D64_ST(0);
    if (!lag) {
        D64_LD(1);
        for (int t = 0; t < ntiles; ++t) {
            __syncthreads();
            if (t + 1 < ntiles) D64_ST(t + 1);
            if (t + 2 < ntiles) D64_LD(t + 2);
            D64_QK(t);
            D64_PV(t);
        }
        __syncthreads();
    } else {
        D64_LD(1);
        __syncthreads();
        D64_ST(1); D64_LD(2);
        D64_QK(0);
        for (int t = 1; t < ntiles; ++t) {
            __syncthreads();
            if (t + 1 < ntiles) D64_ST(t + 1);
            if (t + 2 < ntiles) D64_LD(t + 2);
            D64_PV(t - 1);
            __builtin_amdgcn_sched_barrier(0);
            D64_QK(t);
        }
        __syncthreads();
        D64_PV(ntiles - 1);
    }
#undef D64_LANE
#undef D64_LD
#undef D64_ST
#undef D64_QK
#undef D64_PV
}
__device__ __forceinline__ void priv_kload(u32x4 (&kf)[2][2], const unsigned char* Kg, int ld, int tk0, int dk, int lane_) {
    int lane = lane_; asm volatile("" : "+v"(lane));
    const int hi = lane >> 5;
#pragma unroll
    for (int blk = 0; blk < 2; ++blk) { const int tk = clamp_tok(tk0 + dk * (32 * blk + (lane & 31)));
#pragma unroll
        for (int e = 0; e < 2; ++e) kf[blk][e] = *(const u32x4*)(Kg + (size_t)tk * ld + 32 * hi + 16 * e); }
}
__device__ __forceinline__ void priv2_step(u32x4 (&kf)[2][2], LAS char* vpriv, const unsigned char* Kg, const bf16_t* Vg, int ld, int tk0, int dk, bool g0, bool g1,
                                           bool has_next, int tk0n, int dkn, const u32x4 (&qr)[2][2], f32x16 (&o)[2][2], float (&lsum)[2], int tq0, int tq1, int lane_) {
    int lane = lane_; asm volatile("" : "+v"(lane));
    const int hi = lane >> 5;
    const int vlane = (4 * hi + ((lane & 15) >> 2)) * VSTR + (16 * ((lane >> 4) & 1) + 4 * (lane & 3)) * 2;
    u32x4 vr[8];
#pragma unroll
    for (int i = 0; i < 8; ++i) { const int idx = i * 64 + lane, row = idx >> 3, ch = idx & 7; const int tk = clamp_tok(tk0 + dk * row); vr[i] = *(const u32x4*)(Vg + (size_t)tk * ld + ch * 8); }
    const int gfirst = g0 ? 0 : 1, glast = g1 ? 1 : 0;
    f32x16 p0, p1; bf16x8 pf[2][2]; int mb, mr;
    if (gfirst == 0) qk_tile(p0, p1, kf, qr[0]); else qk_tile(p0, p1, kf, qr[1]);
    __builtin_amdgcn_sched_barrier(0);
#pragma unroll
    for (int i = 0; i < 8; ++i) { const int idx = i * 64 + lane; *(LAS u32x4*)(vpriv + (idx >> 3) * VSTR + (idx & 7) * 16) = vr[i]; }
    if (glast == gfirst) { __builtin_amdgcn_sched_barrier(0); if (has_next) priv_kload(kf, Kg, ld, tk0n, dkn, lane); __builtin_amdgcn_sched_barrier(0); }
    mask_params(dk, tk0, gfirst ? tq1 : tq0, hi, mb, mr);
    if (gfirst == 0) exp_tile<true>(p0, p1, lsum[0], pf, mb, mr, dk); else exp_tile<true>(p0, p1, lsum[1], pf, mb, mr, dk);
    { bf16x8 vfa[4], vfb[4]; vread(vfa, vpriv + vlane, 0); vread(vfb, vpriv + vlane, 1);
      if (gfirst == 0) { pv_half(o[0][0], vfa, pf); pv_half(o[0][1], vfb, pf); } else { pv_half(o[1][0], vfa, pf); pv_half(o[1][1], vfb, pf); } }
    if (glast != gfirst) {
        qk_tile(p0, p1, kf, qr[1]);
        __builtin_amdgcn_sched_barrier(0);
        if (has_next) priv_kload(kf, Kg, ld, tk0n, dkn, lane);
        __builtin_amdgcn_sched_barrier(0);
        mask_params(dk, tk0, tq1, hi, mb, mr);
        exp_tile<true>(p0, p1, lsum[1], pf, mb, mr, dk);
        bf16x8 vfa[4], vfb[4]; vread(vfa, vpriv + vlane, 0); vread(vfb, vpriv + vlane, 1);
        pv_half(o[1][0], vfa, pf); pv_half(o[1][1], vfb, pf);
    }
}
__device__ __forceinline__ void store_out(const f32x16 (&o)[2], float lsum, bf16_t* dst  , int lane_) {
    int lane = lane_; asm volatile("" : "+v"(lane));
    const int hi = lane >> 5;
    float l = lsum + shx(lsum, 32, lane);
    const float inv = 1.0f / l;
#pragma unroll
    for (int d0 = 0; d0 < 2; ++d0)
#pragma unroll
        for (int gp = 0; gp < 2; ++gp) {
            const int ga = 2 * gp, gb = 2 * gp + 1;
            unsigned a0 = cvt_pk_bf16(o[d0][4 * ga] * inv, o[d0][4 * ga + 1] * inv), a1 = cvt_pk_bf16(o[d0][4 * ga + 2] * inv, o[d0][4 * ga + 3] * inv);
            unsigned b0 = cvt_pk_bf16(o[d0][4 * gb] * inv, o[d0][4 * gb + 1] * inv), b1 = cvt_pk_bf16(o[d0][4 * gb + 2] * inv, o[d0][4 * gb + 3] * inv);
            const auto s0 = __builtin_amdgcn_permlane32_swap(a0, b0, false, false), s1 = __builtin_amdgcn_permlane32_swap(a1, b1, false, false);
            u32x4 w; w.x = s0[0]; w.y = s1[0]; w.z = s0[1]; w.w = s1[1];
            *(u32x4*)(dst + 32 * d0 + 16 * gp + 8 * hi) = w;
        }
}
}

struct Args { const float* in[18]; float* out; unsigned char* ws; int ph_lo, ph_hi; };
constexpr int PH_PRO = 0, PH_L0 = 1, PH_PER_LAYER = 9, PH_FINAL = PH_L0 + 2 * PH_PER_LAYER, NPH = PH_FINAL + 1;
enum { P_NORM1 = 0, P_INPROJ, P_ATTN, P_PAB, P_OUT, P_NORM2, P_PLACE, P_GU, P_DOWN };

__device__ __forceinline__ int tile256_srccol(int P) { const int p = P & 255; return (P & ~255) + 64 * ((p >> 5) & 3) + 16 * ((p >> 3) & 3) + 8 * (p >> 7) + (p & 7); }
template <int MAP, bool W8 = false>
__device__ __forceinline__ void transpose_item(const float* W, int N, int col0, bf16_t* dst, int dst_row0, int K, int k0, LAS float* scr, int lane, int dk0 = 0  ) {
    const int sc = (MAP == 1) ? inproj_srccol(col0 + lane) : (MAP == 2) ? tile256_srccol(col0 + lane) : col0 + lane;
    const float* src = W + (size_t)k0 * N + sc;
#pragma unroll 16
    for (int i = 0; i < 64; ++i) scr[i * 65 + lane] = src[(size_t)i * N];
    asm volatile("s_waitcnt lgkmcnt(0)" ::: "memory");
    const int c = lane & 7, nn = lane >> 3;
#pragma unroll
    for (int j = 0; j < 8; ++j) { const int n = nn + 8 * j; const LAS float* s = scr + (8 * c) * 65 + n;
        if (W8) { u32x2 w; w.x = pack4_fp8(s[0] * W8S, s[65] * W8S, s[2 * 65] * W8S, s[3 * 65] * W8S); w.y = pack4_fp8(s[4 * 65] * W8S, s[5 * 65] * W8S, s[6 * 65] * W8S, s[7 * 65] * W8S);
            *(u32x2*)((unsigned char*)dst + (size_t)(dst_row0 + n) * K + dk0 + k0 + 8 * c) = w; continue; }
        u32x4 w; w.x = cvt_pk_bf16(s[0], s[65]); w.y = cvt_pk_bf16(s[2 * 65], s[3 * 65]); w.z = cvt_pk_bf16(s[4 * 65], s[5 * 65]); w.w = cvt_pk_bf16(s[6 * 65], s[7 * 65]);
        *(u32x4*)(dst + (size_t)(dst_row0 + n) * K + dk0 + k0 + 8 * c) = w; }
    asm volatile("s_waitcnt lgkmcnt(0)" ::: "memory");
}


template <bool XF32, bool COMBINE, bool NORM, bool ROUTER, bool OUTF32, bool H8 = false>
__device__ __forceinline__ void row_phase(LAS unsigned char* lds, int tid, int lane, int wave, int G, int bx, const float* xf, bf16_t* xb, float* outf, const float* gv,
                                          const float* modl, int sh_off, int sc_off, const float* modprev, bf16_t* Hh, const unsigned char* Ym, const int* Pos, float* Tw,
                                          const bf16_t* Wr, int* Te, int* Trk, int* Cnt) {
    constexpr int RB = COMBINE ? 2 : ROWB;
    LAS float* lgs = (LAS float*)lds;
    LAS int* lcnt = (LAS int*)(lds + 40960);
    asm volatile("" : "+v"(tid), "+v"(lane));
    for (int chunk = bx; chunk < 256; chunk += G) {
        const int b = chunk >> 3;
        if (ROUTER) { if (tid < 32) lcnt[tid] = 0; }
        f32x4 pre[4], shv[4], g2[4];
#pragma unroll
        for (int j = 0; j < 4; ++j) { const int col = 512 * (j >> 1) + 8 * lane + 4 * (j & 1);
            if (NORM) { const f32x4 gg = *(const f32x4*)(gv + col), sc = *(const f32x4*)(modl + (size_t)b * MODW + sc_off + col);
                pre[j] = gg * (1.0f + sc); shv[j] = *(const f32x4*)(modl + (size_t)b * MODW + sh_off + col); }
            if (COMBINE) g2[j] = *(const f32x4*)(modprev + (size_t)b * MODW + 5 * DM + col); }
        f32x4 rawf[XF32 ? RB : 1][4]; u32x4 rawb[XF32 ? 1 : RB][2]; int pp[COMBINE ? RB : 1][2]; float pw[COMBINE ? RB : 1][2];
#define ROW_LOAD(rb_) do { _Pragma("unroll") for (int i = 0; i < RB; ++i) { const size_t ro = (size_t)((rb_) + i) * DM; \
            if (XF32) { _Pragma("unroll") for (int j = 0; j < 4; ++j) rawf[XF32 ? i : 0][j] = *(const f32x4*)(xf + ro + 512 * (j >> 1) + 8 * lane + 4 * (j & 1)); } \
            else { _Pragma("unroll") for (int h = 0; h < 2; ++h) rawb[XF32 ? 0 : i][h] = *(const u32x4*)(xb + ro + 512 * h + 8 * lane); } \
            if (COMBINE) { pp[COMBINE ? i : 0][0] = Pos[2 * ((rb_) + i)]; pp[COMBINE ? i : 0][1] = Pos[2 * ((rb_) + i) + 1]; pw[COMBINE ? i : 0][0] = Tw[2 * ((rb_) + i)]; pw[COMBINE ? i : 0][1] = Tw[2 * ((rb_) + i) + 1]; } } } while (0)
        ROW_LOAD(chunk * 256 + wave * 32);
#pragma unroll 1
        for (int r0 = 0; r0 < 32; r0 += RB) {
            const int rowb = chunk * 256 + wave * 32 + r0;
            f32x4 v[RB][4]; int cp[COMBINE ? RB : 1][2]; float cw[COMBINE ? RB : 1][2];
#pragma unroll
            for (int i = 0; i < RB; ++i) {
                if (XF32) {
#pragma unroll
                    for (int j = 0; j < 4; ++j) v[i][j] = rawf[XF32 ? i : 0][j];
                } else {
#pragma unroll
                    for (int h = 0; h < 2; ++h) { const u32x4 w = rawb[XF32 ? 0 : i][h];
                        v[i][2 * h] = (f32x4){bf_lo(w.x), bf_hi(w.x), bf_lo(w.y), bf_hi(w.y)}; v[i][2 * h + 1] = (f32x4){bf_lo(w.z), bf_hi(w.z), bf_lo(w.w), bf_hi(w.w)}; }
                }
                if (COMBINE) { cp[i][0] = pp[i][0]; cp[i][1] = pp[i][1]; cw[i][0] = pw[i][0]; cw[i][1] = pw[i][1]; }
            }
            u32x2 ya[COMBINE ? RB : 1][2], yc[COMBINE ? RB : 1][2];
            if (COMBINE) {
#pragma unroll
                for (int i = 0; i < RB; ++i)
#pragma unroll
                    for (int h = 0; h < 2; ++h) { ya[i][h] = *(const u32x2*)(Ym + (size_t)cp[i][0] * DM + 512 * h + 8 * lane); yc[i][h] = *(const u32x2*)(Ym + (size_t)cp[i][1] * DM + 512 * h + 8 * lane); }
            }
            if (r0 + RB < 32) ROW_LOAD(rowb + RB);
            if (COMBINE) {
#pragma unroll
                for (int i = 0; i < RB; ++i) {
                    const int row = rowb + i; const float w0 = cw[i][0], w1 = cw[i][1];
#pragma unroll
                    for (int h = 0; h < 2; ++h) { float fa[8], fc[8]; unpack8_fp8(ya[i][h], fa); unpack8_fp8(yc[i][h], fc);
                        const f32x4 m0 = {w0 * fa[0] + w1 * fc[0], w0 * fa[1] + w1 * fc[1], w0 * fa[2] + w1 * fc[2], w0 * fa[3] + w1 * fc[3]};
                        const f32x4 m1 = {w0 * fa[4] + w1 * fc[4], w0 * fa[5] + w1 * fc[5], w0 * fa[6] + w1 * fc[6], w0 * fa[7] + w1 * fc[7]};
                        v[i][2 * h] = v[i][2 * h] + g2[2 * h] * m0; v[i][2 * h + 1] = v[i][2 * h + 1] + g2[2 * h + 1] * m1;
                        if (OUTF32) { *(f32x4*)(outf + (size_t)row * DM + 512 * h + 8 * lane) = v[i][2 * h]; *(f32x4*)(outf + (size_t)row * DM + 512 * h + 8 * lane + 4) = v[i][2 * h + 1]; }
                        else *(u32x4*)(xb + (size_t)row * DM + 512 * h + 8 * lane) = pg8::pack8(v[i][2 * h], v[i][2 * h + 1]); }
                }
            }
            if (NORM) {
                float ss[RB];
#pragma unroll
                for (int i = 0; i < RB; ++i) { ss[i] = 0.f;
#pragma unroll
                    for (int j = 0; j < 4; ++j) { const f32x4 q = v[i][j] * v[i][j]; ss[i] += (q[0] + q[1]) + (q[2] + q[3]); } }
#pragma unroll
                for (int o = 1; o < 64; o <<= 1)
#pragma unroll
                    for (int i = 0; i < RB; ++i) ss[i] += shx(ss[i], o, lane);
#pragma unroll
                for (int i = 0; i < RB; ++i) { const float rstd = __builtin_amdgcn_rsqf(ss[i] * (1.0f / DM) + 1e-6f);
#pragma unroll
                    for (int h = 0; h < 2; ++h) { const f32x4 h0 = v[i][2 * h] * rstd * pre[2 * h] + shv[2 * h], h1 = v[i][2 * h + 1] * rstd * pre[2 * h + 1] + shv[2 * h + 1];
                        if (H8) *(u32x2*)((unsigned char*)Hh + (size_t)(rowb + i) * DM + 512 * h + 8 * lane) = (u32x2){pack4_fp8(h0[0], h0[1], h0[2], h0[3]), pack4_fp8(h1[0], h1[1], h1[2], h1[3])};
                        else *(u32x4*)(Hh + (size_t)(rowb + i) * DM + 512 * h + 8 * lane) = pg8::pack8(h0, h1); } }
            }
        }
#undef ROW_LOAD
        if (ROUTER) {
            __syncthreads();
            const int row0 = chunk * 256 + wave * 32;
            f32x4 ra[2][2];
#pragma unroll
            for (int mt = 0; mt < 2; ++mt)
#pragma unroll
                for (int et = 0; et < 2; ++et) ra[mt][et] = (f32x4){0.f, 0.f, 0.f, 0.f};
#pragma unroll 4
            for (int kk = 0; kk < 32; ++kk) {
                bf16x8 a[2], bb[2];
#pragma unroll
                for (int mt = 0; mt < 2; ++mt) a[mt] = *(const bf16x8*)(Hh + (size_t)(row0 + 16 * mt + (lane & 15)) * DM + 32 * kk + 8 * (lane >> 4));
#pragma unroll
                for (int et = 0; et < 2; ++et) bb[et] = *(const bf16x8*)(Wr + (size_t)(16 * et + (lane & 15)) * DM + 32 * kk + 8 * (lane >> 4));
#pragma unroll
                for (int mt = 0; mt < 2; ++mt)
#pragma unroll
                    for (int et = 0; et < 2; ++et) ra[mt][et] = __builtin_amdgcn_mfma_f32_16x16x32_bf16(a[mt], bb[et], ra[mt][et], 0, 0, 0);
            }
#pragma unroll
            for (int mt = 0; mt < 2; ++mt)
#pragma unroll
                for (int et = 0; et < 2; ++et)
#pragma unroll
                    for (int r = 0; r < 4; ++r) lgs[(wave * 32 + 16 * mt + 4 * (lane >> 4) + r) * 33 + 16 * et + (lane & 15)] = ra[mt][et][r];
            asm volatile("s_waitcnt lgkmcnt(0)" ::: "memory");
            if (lane < 32) {
                const int tl = wave * 32 + lane, tok = chunk * 256 + tl;
                float lg[32]; float M = -3.0e38f;
#pragma unroll
                for (int e = 0; e < 32; ++e) { lg[e] = lgs[tl * 33 + e]; M = fmaxf(M, lg[e]); }
                float bm1 = 0.f, bm2 = 0.f, bsc = -1.f; int bi1 = 0, bi2 = 0, bg = 0;
#pragma unroll
                for (int g = 0; g < 4; ++g) {
                    float m1 = -3.0e38f, m2 = -3.0e38f; int i1 = 0, i2 = 0;
#pragma unroll
                    for (int j = 0; j < 8; ++j) { const float vv = lg[8 * g + j];
                        if (vv > m1) { m2 = m1; i2 = i1; m1 = vv; i1 = j; } else if (vv > m2) { m2 = vv; i2 = j; } }
                    const float sc = expf(m1 - M) + expf(m2 - M);
                    if (sc > bsc) { bsc = sc; bg = g; bm1 = m1; bm2 = m2; bi1 = i1; bi2 = i2; }
                }
                const int e0 = 8 * bg + bi1, e1 = 8 * bg + bi2;
                const float w0 = 1.0f / (1.0f + expf(bm2 - bm1)), w1 = 1.0f - w0;
                const int r0 = __hip_atomic_fetch_add(&lcnt[e0], 1, __ATOMIC_RELAXED, __HIP_MEMORY_SCOPE_WORKGROUP);
                const int r1 = __hip_atomic_fetch_add(&lcnt[e1], 1, __ATOMIC_RELAXED, __HIP_MEMORY_SCOPE_WORKGROUP);
                Te[2 * tok] = e0; Te[2 * tok + 1] = e1; Trk[2 * tok] = r0; Trk[2 * tok + 1] = r1; Tw[2 * tok] = w0; Tw[2 * tok + 1] = w1;
            }
            __syncthreads();
            if (tid < 32) Cnt[chunk * 32 + tid] = lcnt[tid];
            __syncthreads();
        }
    }
}

#define x_in ((const float*)(const GAS float*)args.in[0])
#define c_in ((const float*)(const GAS float*)args.in[1])
#define w_ada ((const float*)(const GAS float*)args.in[2])
#define b_ada ((const float*)(const GAS float*)args.in[3])
#define g_mix ((const float*)(const GAS float*)args.in[4])
#define w_in ((const float*)(const GAS float*)args.in[5])
#define qn_a ((const float*)(const GAS float*)args.in[6])
#define kn_a ((const float*)(const GAS float*)args.in[7])
#define qn_b ((const float*)(const GAS float*)args.in[8])
#define kn_b ((const float*)(const GAS float*)args.in[9])
#define w_pa ((const float*)(const GAS float*)args.in[10])
#define w_pb ((const float*)(const GAS float*)args.in[11])
#define w_out ((const float*)(const GAS float*)args.in[12])
#define g_ffn ((const float*)(const GAS float*)args.in[13])
#define w_router ((const float*)(const GAS float*)args.in[14])
#define w_gate ((const float*)(const GAS float*)args.in[15])
#define w_up ((const float*)(const GAS float*)args.in[16])
#define w_down ((const float*)(const GAS float*)args.in[17])
#define MOD ((float*)(GAS float*)(ws + WS_MOD))
#define XB ((bf16_t*)(GAS bf16_t*)(ws + WS_XB))
#define TE ((int*)(GAS int*)(ws + WS_TE))
#define TRK ((int*)(GAS int*)(ws + WS_TRK))
#define TW ((float*)(GAS float*)(ws + WS_TW))
#define POS ((int*)(GAS int*)(ws + WS_POS))
#define CNT ((int*)(GAS int*)(ws + WS_CNT))
#define BLKE ((int*)(GAS int*)(ws + WS_BLKE))
#define BTOK ((int*)(GAS int*)(ws + WS_BTOK))
#define WR ((bf16_t*)(bf16_t*)(GAS bf16_t*)(ws + WS_WR))
#define H ((bf16_t*)(bf16_t*)(GAS bf16_t*)(ws + WS_H))
#define YAB ((bf16_t*)(GAS bf16_t*)(ws + WS_H))
#define YA ((bf16_t*)(bf16_t*)(GAS bf16_t*)(ws + WS_H))
#define YB ((bf16_t*)(bf16_t*)(GAS bf16_t*)(ws + WS_H + 64 * MiB))
#define QA ((bf16_t*)(bf16_t*)(GAS bf16_t*)(ws + WS_QKV))
#define KA ((bf16_t*)(bf16_t*)(GAS bf16_t*)(ws + WS_QKV + 64 * MiB))
#define VA ((bf16_t*)(bf16_t*)(GAS bf16_t*)(ws + WS_QKV + 128 * MiB))
#define QB ((bf16_t*)(bf16_t*)(GAS bf16_t*)(ws + WS_QKV + 192 * MiB))
#define KB ((bf16_t*)(bf16_t*)(GAS bf16_t*)(ws + WS_QKV + 256 * MiB))
#define VB ((bf16_t*)(bf16_t*)(GAS bf16_t*)(ws + WS_QKV + 272 * MiB))
#define MERGED ((bf16_t*)(bf16_t*)(GAS bf16_t*)(ws + WS_QKV))
#define YM ((unsigned char*)(GAS unsigned char*)(ws + WS_QKV))
#define SA ((bf16_t*)(bf16_t*)(GAS bf16_t*)(ws + WS_GATE))
#define SB ((bf16_t*)(bf16_t*)(GAS bf16_t*)(ws + WS_GATE + 128 * MiB))
#define ACT ((bf16_t*)(bf16_t*)(GAS bf16_t*)(ws + WS_GATE))
#define PHASE_ENTER() int lane; asm volatile("v_mbcnt_lo_u32_b32 %0, -1, 0\n\tv_mbcnt_hi_u32_b32 %0, -1, %0" : "=v"(lane)); const int tid = wave * 64 + lane; GAS unsigned char* ws = ws0; int bx = bx0, vcu = vcu0; asm volatile("" : "+s"(ws), "+s"(bx), "+s"(vcu))

__device__ __forceinline__ bool in_phase(int lo, int hi, int k) { asm volatile("" : "+s"(lo), "+s"(hi)); return lo <= k && k < hi; }
#define PGATE_A SA
#define PGATE_B SB
__global__ void __launch_bounds__(512, 2) fwd_kernel(Args args) {
    extern __shared__ __attribute__((aligned(16))) unsigned char lds_raw[];
    LAS unsigned char* lds = (LAS unsigned char*)lds_raw;
    volatile LAS unsigned* MISC = (volatile LAS unsigned*)(lds + MISC_OFF);
    const int tid0 = threadIdx.x, lane0 = tid0 & 63, wave = __builtin_amdgcn_readfirstlane(tid0 >> 6);
    const int G = gridDim.x, bx0 = blockIdx.x;
    const int vcu0 = (G % 8 == 0) ? (bx0 % 8) * (G / 8) + bx0 / 8 : bx0;
    GAS unsigned char* ws0 = (GAS unsigned char*)args.ws;
    float* out = (float*)(GAS float*)args.out;
    for (int u = tid0; u < 256; u += 512) ((LAS unsigned*)(lds + MISC_OFF))[u] = 0u;
    __syncthreads();
#if MK_ONE_LAUNCH
    XcdBarrier bar = xcd_barrier_post((unsigned*)((GAS unsigned*)(ws0 + WS_CTL) + CW_BAR), MISC + 8);
#define GRID_BAR() do { int l_; asm volatile("v_mbcnt_lo_u32_b32 %0, -1, 0\n\tv_mbcnt_hi_u32_b32 %0, -1, %0" : "=v"(l_)); xcd_barrier(bar, (wave == 0) && (l_ == 0)); } while (0)
#else
#define GRID_BAR() do {} while (0)
#endif
#ifndef PHMASK
#define PHMASK 0xFFFFFFFFu
#endif
#if MK_ONE_LAUNCH
#define IN(k) true
#else
#define IN(k) in_phase(args.ph_lo, args.ph_hi, (k))
#endif
#define EN(bit) ((PHMASK >> (bit)) & 1u)
#define SEAM(k) do { if (IN(k) && IN((k) + 1)) GRID_BAR(); } while (0)

    if (EN(0) && IN(PH_PRO)) {
        PHASE_ENTER();
#pragma unroll 1
        for (int rep = 0; rep < REP_PRO; ++rep) {
        LAS float* scr = (LAS float*)(lds + wave * 16640);
        const int gw = vcu * 8 + wave, NGW = G * 8;
        constexpr int I_IN = 68 * 16, I_PA = 16 * 8, I_OUT = 16 * 16, I_GU = 32 * 2 * 8 * 16, I_DN = 32 * 16 * 8;
        constexpr int I_LAYER = I_IN + 2 * I_PA + I_OUT + I_GU + I_DN;
        for (int it = gw; it < 2 * I_LAYER; it += NGW) {
            const int l = it / I_LAYER; int r = it % I_LAYER;
            if (r < I_IN) { const int nb = r / 16, kb = r % 16;
                transpose_item<1, true>(w_in + (size_t)l * DM * NC, NC, 64 * nb, (bf16_t*)(GAS bf16_t*)(ws + WS_WIN + l * WIN_BYTES), 64 * nb, DM, 64 * kb, scr, lane); continue; } r -= I_IN;
            if (r < I_PA) { const int nb = r / 8, kb = r % 8;
                transpose_item<2>(w_pa + (size_t)l * 512 * DM, DM, 64 * nb, (bf16_t*)(GAS bf16_t*)(ws + WS_WPA + l * 2 * MiB), 64 * nb, DM, 64 * kb, scr, lane, 0); continue; } r -= I_PA;
            if (r < I_PA) { const int nb = r / 8, kb = r % 8;
                transpose_item<2>(w_pb + (size_t)l * 512 * DM, DM, 64 * nb, (bf16_t*)(GAS bf16_t*)(ws + WS_WPA + l * 2 * MiB), 64 * nb, DM, 64 * kb, scr, lane, 512); continue; } r -= I_PA;
            if (r < I_OUT) { const int nb = r / 16, kb = r % 16;
                transpose_item<2>(w_out + (size_t)l * DM * DM, DM, 64 * nb, (bf16_t*)(GAS bf16_t*)(ws + WS_WOUT + l * 2 * MiB), 64 * nb, DM, 64 * kb, scr, lane); continue; } r -= I_OUT;
            if (r < I_GU) { const int e = r / 256, q = r % 256, up = q / 128, nb = (q % 128) / 16, kb = q % 16;
                const float* src = (up ? w_up : w_gate) + ((size_t)l * NEXP + e) * DM * DFF;
                const int c0 = 64 * nb, drow = 256 * (c0 >> 7) + 128 * up + (c0 & 127);
                transpose_item<0>(src, DFF, c0, (bf16_t*)(GAS bf16_t*)(ws + WS_WGU + ((size_t)l * NEXP + e) * 2 * MiB), drow, DM, 64 * kb, scr, lane); continue; } r -= I_GU;
            { const int e = r / 128, q = r % 128, nb = q / 8, kb = q % 8;
                transpose_item<2>(w_down + ((size_t)l * NEXP + e) * DFF * DM, DM, 64 * nb, (bf16_t*)(GAS bf16_t*)(ws + WS_WDN + ((size_t)l * NEXP + e) * MiB), 64 * nb, DFF, 64 * kb, scr, lane); }
        }
        for (int i = (vcu * 512 + tid); i < 32 * DM; i += G * 512) { const int e = i >> 10, k = i & 1023; WR[i] = (bf16_t)(cvt_pk_bf16(w_router[(size_t)k * NEXP + e], 0.f) & 0xffffu); }
        __syncthreads();
        if (vcu * 8 < 384) {
            LAS float* cond = (LAS float*)lds;
            for (int i = tid; i < NB * DM; i += 512) { const int b = i >> 10, k = i & 1023; const float cv = c_in[i]; cond[k * 32 + b] = cv / (1.0f + expf(-cv)); }
            __syncthreads();
            for (int it = gw; it < 384; it += NGW) {
                const int l = it / 192, n0 = (it % 192) * 32;
                const float* wp = w_ada + (size_t)l * DM * MODW + n0 + (lane & 31) + (size_t)(lane >> 5) * MODW;
                const LAS float* cp = cond + (lane >> 5) * 32 + (lane & 31);
                f32x16 acc;
#pragma unroll
                for (int r = 0; r < 16; ++r) acc[r] = 0.f;
#pragma unroll 16
                for (int k0 = 0; k0 < DM; k0 += 2) acc = __builtin_amdgcn_mfma_f32_32x32x2f32(cp[k0 * 32], wp[(size_t)k0 * MODW], acc, 0, 0, 0);
                const float bias = b_ada[l * MODW + n0 + (lane & 31)];
#pragma unroll
                for (int r = 0; r < 16; ++r) { const int b = (r & 3) + 8 * (r >> 2) + 4 * (lane >> 5); MOD[((size_t)l * NB + b) * MODW + n0 + (lane & 31)] = acc[r] + bias; }
            }
        }
        __syncthreads();
        }
    }
    SEAM(PH_PRO);

    for (int l = 0; l < 2; ++l) {
        const int pb = PH_L0 + l * PH_PER_LAYER;
        if (EN(1) && IN(pb + P_NORM1)) { PHASE_ENTER(); const float* modl = MOD + (size_t)l * NB * MODW;
            if (l == 0) {
#pragma unroll 1
                for (int rep = 0; rep < REP_NORM1; ++rep)
                    row_phase<true, false, true, false, false, true>(lds, tid, lane, wave, G, bx, x_in, XB, out, g_mix, modl, 0, DM, MOD, H, YM, POS, TW, WR, TE, TRK, CNT);
            } else row_phase<false, true, true, false, false, true>(lds, tid, lane, wave, G, bx, x_in, XB, out, g_mix + DM, modl, 0, DM, MOD, H, YM, POS, TW, WR, TE, TRK, CNT); }
            {
                SEAM(pb + P_NORM1);
                if (EN(2) && IN(pb + P_INPROJ)) {
                    PHASE_ENTER();
                    pg8::Gemm g{H, (const bf16_t*)(const GAS bf16_t*)(ws + WS_WIN + l * WIN_BYTES), DM / 2}; pg8::StaticOrder S; S.init(TT, NC, G, bx); S.wgm = INPROJ_WGM;
                    LAS float* normw = (LAS float*)(lds + MISC_OFF + 1024);
                    if (tid < 256) { const int sel = tid >> 6, d = tid & 63; const float* srcw = (sel == 0) ? qn_a : (sel == 1) ? kn_a : (sel == 2) ? qn_b : kn_b; normw[tid] = srcw[l * 64 + d]; }
                    __syncthreads();
                    pg8::EpiInProj E{QA, KA, VA, QB, KB, VB, SA, SB, normw};
#pragma unroll 1
                    for (int rep = 0; rep < REP_INPROJ; ++rep)
                    pg8::gemm_phase<pg8::EpiInProj, pg8::StaticOrder, true>(lds, g, S, E, wave);
                }
                SEAM(pb + P_INPROJ);
                if (EN(3) && IN(pb + P_ATTN)) {
                    PHASE_ENTER(); (void)lane;
                    LAS char* ring = (LAS char*)lds;
#pragma unroll 1
                    for (int rep = 0; rep < REP_ATTB; ++rep)
                    for (int L = vcu; L < NB * 32; L += G) {
                        int lane; asm volatile("v_mbcnt_lo_u32_b32 %0, -1, 0\n\tv_mbcnt_hi_u32_b32 %0, -1, %0" : "=v"(lane)); const int hi = lane >> 5;
                        const int b = L >> 5, kvh = (L >> 4) & 1, qh = 4 * kvh + ((L >> 2) & 3), qb2 = L & 3;
                        const int tq0 = 512 * qb2 + 64 * wave + (lane & 31);
                        u32x4 qr[2][2];
#pragma unroll
                        for (int g = 0; g < 2; ++g)
#pragma unroll
                            for (int e = 0; e < 2; ++e) qr[g][e] = *(const u32x4*)((const unsigned char*)QB + ((size_t)b * SEQ + tq0 + 32 * g) * 512 + qh * 64 + 32 * hi + 16 * e);
                        f32x16 o[2][2]; float lsum[2] = {0.f, 0.f};
#pragma unroll
                        for (int r = 0; r < 16; ++r) { o[0][0][r] = 0.f; o[0][1][r] = 0.f; o[1][0][r] = 0.f; o[1][1][r] = 0.f; }
                        __syncthreads();
                        att::dense64_lag_loop(ring, (const unsigned char*)KB + (size_t)b * SEQ * 128 + kvh * 64, VB + (size_t)b * SEQ * 128 + kvh * 64, 128, 32, qr, o, lsum, lane, wave, wave >= 4);
                        { int l2; asm volatile("v_mbcnt_lo_u32_b32 %0, -1, 0\n\tv_mbcnt_hi_u32_b32 %0, -1, %0" : "=v"(l2)); const int tqs = 512 * qb2 + 64 * wave + (l2 & 31);
#pragma unroll
                          for (int g = 0; g < 2; ++g) att::store_out(o[g], lsum[g], YAB + ((size_t)b * SEQ + tqs + 32 * g) * DM + 512 + qh * 64, l2); }
                    }
#pragma unroll 1
                    for (int rep = 0; rep < REP_ATTA; ++rep)
                    for (int L = vcu; L < NB * 32; L += G) {
                        int lane; asm volatile("v_mbcnt_lo_u32_b32 %0, -1, 0\n\tv_mbcnt_hi_u32_b32 %0, -1, %0" : "=v"(lane)); const int hi = lane >> 5;
                        const int b = L >> 5, h = (L >> 2) & 7, tb2 = L & 3, base = 512 * tb2;
                        const int tq0 = base + 16 * (lane & 31) + wave, tq1 = tq0 + 8;
                        const unsigned char* Kg = (const unsigned char*)KA + (size_t)b * SEQ * 512 + h * 64; const bf16_t* Vg = VA + (size_t)b * SEQ * 512 + h * 64;
                        u32x4 qr[2][2];
#pragma unroll
                        for (int g = 0; g < 2; ++g)
#pragma unroll
                            for (int e = 0; e < 2; ++e) qr[g][e] = *(const u32x4*)((const unsigned char*)QA + ((size_t)b * SEQ + tq0 + 8 * g) * 512 + h * 64 + 32 * hi + 16 * e);
                        f32x16 o[2][2]; float lsum[2] = {0.f, 0.f};
#pragma unroll
                        for (int r = 0; r < 16; ++r) { o[0][0][r] = 0.f; o[0][1][r] = 0.f; o[1][0][r] = 0.f; o[1][1][r] = 0.f; }
                        __syncthreads();
                        att::dense64_loop<true>(ring, Kg, Vg, 512, base - 64, 10, qr, o, lsum, tq0, tq1, lane, wave);
                        __syncthreads();
                        {
                            LAS char* vpriv = ring + att::PRIV_OFF + wave * att::VTILE;
#define A_TK0(j) ((j) < 4 ? base + wave - 256 + 256 * (j) : wave + 8 * (((j) - 4) >> 1) + 1024 * (((j) - 4) & 1))
#define A_DK(j) ((j) < 4 ? 4 : 16)
                            u32x4 kf[2][2];
                            att::priv_kload(kf, Kg, 512, A_TK0(0), 4, lane);
#pragma unroll 1
                            for (int j = 0; j < 8; ++j) {
                                const bool p2 = j < 4; const int g = (j - 4) >> 1;
                                att::priv2_step(kf, vpriv, Kg, Vg, 512, A_TK0(j), A_DK(j), p2 || g == 0, p2 || g == 1, j + 1 < 8, A_TK0(j + 1), A_DK(j + 1), qr, o, lsum, tq0, tq1, lane);
                            }
#undef A_TK0
#undef A_DK
                        }
                        { int l2; asm volatile("v_mbcnt_lo_u32_b32 %0, -1, 0\n\tv_mbcnt_hi_u32_b32 %0, -1, %0" : "=v"(l2)); const int tqs = base + 16 * (l2 & 31) + wave;
#pragma unroll
                          for (int g = 0; g < 2; ++g) att::store_out(o[g], lsum[g], YAB + ((size_t)b * SEQ + tqs + 8 * g) * DM + h * 64, l2); }
                    }
                    __syncthreads();
                }
                SEAM(pb + P_ATTN);
                if (EN(4) && IN(pb + P_PAB)) {
                    PHASE_ENTER();
                    pg8::StaticOrder S; S.init(TT, DM, G, bx); S.wgm = N1K_WGM;
                    pg8::Gemm g{YAB, (const bf16_t*)(const GAS bf16_t*)(ws + WS_WPA + l * 2 * MiB), DM}; pg8::EpiMergeFused E{MERGED, (const unsigned char*)PGATE_A, (const unsigned char*)PGATE_B};
#pragma unroll 1
                    for (int rep = 0; rep < REP_PAB; ++rep)
                    pg8::gemm_phase<pg8::EpiMergeFused, pg8::StaticOrder>(lds, g, S, E, wave);
                }
                SEAM(pb + P_PAB);
                if (EN(5) && IN(pb + P_OUT)) {
                    PHASE_ENTER(); const float* modl = MOD + (size_t)l * NB * MODW;
                    pg8::Gemm g{MERGED, (const bf16_t*)(const GAS bf16_t*)(ws + WS_WOUT + l * 2 * MiB), DM}; pg8::StaticOrder S; S.init(TT, DM, G, bx); S.rowmajor = OUT_ROWMAJOR; S.wgm = N1K_WGM;
                    pg8::EpiResidB E{(l == 0) ? x_in : (const float*)nullptr, XB, XB, modl + 2 * DM};
#pragma unroll 1
                    for (int rep = 0; rep < ((l == 0) ? REP_OUT : 1); ++rep)
                    pg8::gemm_phase<pg8::EpiResidB, pg8::StaticOrder>(lds, g, S, E, wave);
                }
                SEAM(pb + P_OUT);
            }
        if (EN(6) && IN(pb + P_NORM2)) { PHASE_ENTER(); const float* modl = MOD + (size_t)l * NB * MODW;
#pragma unroll 1
            for (int rep = 0; rep < REP_NORM2; ++rep)
            row_phase<false, false, true, true, false>(lds, tid, lane, wave, G, bx, x_in, XB, out, g_ffn + l * DM, modl, 3 * DM, 4 * DM, MOD, H, YM, POS, TW, WR, TE, TRK, CNT); }
        SEAM(pb + P_NORM2);
        if (EN(7) && IN(pb + P_PLACE)) {
            PHASE_ENTER();
            LAS int* part_tot = (LAS int*)lds;
            LAS int* part_pre = part_tot + 512;
            LAS int* basee = part_pre + 512;
            LAS int* pstart = basee + 32;
            LAS int* pend = pstart + 32;
            LAS int* tote = pend + 32;
            for (int chunk = bx; chunk < 256; chunk += G) {
                { const int e = tid & 31, part = tid >> 5; int st = 0, sp = 0;
                    for (int q = 0; q < 16; ++q) { const int ch = part * 16 + q; const int v = CNT[ch * 32 + e]; st += v; sp += (ch < chunk) ? v : 0; }
                    part_tot[part * 32 + e] = st; part_pre[part * 32 + e] = sp; }
                __syncthreads();
                if (tid < 32) { int st = 0, sp = 0; for (int q = 0; q < 16; ++q) { st += part_tot[q * 32 + tid]; sp += part_pre[q * 32 + tid]; } tote[tid] = st; basee[tid] = sp; }
                __syncthreads();
                if (tid == 0) { int run = 0; for (int e = 0; e < 32; ++e) { const int padded = (tote[e] + 255) & ~255; pstart[e] = run; basee[e] += run; run += padded; pend[e] = run; } }
                __syncthreads();
                { const int tok = chunk * 256 + (tid >> 1), slot = tid & 1; const int e = TE[2 * tok + slot], rk = TRK[2 * tok + slot]; const int dest = basee[e] + rk;
                    BTOK[dest] = tok; POS[2 * tok + slot] = dest; }
                if (chunk < 32) { const int e = chunk; const int from = pstart[e] + tote[e], n = pend[e] - from; if (tid < n) BTOK[from + tid] = 0; }
                if (chunk == 0) {
                    for (int blk = tid; blk < NBLK; blk += 512) { int e = 0; for (int q = 0; q < 32; ++q) e += (pend[q] <= blk * 256) ? 1 : 0; BLKE[blk] = e > 31 ? 31 : e; }
                    if (tid == 0) BLKE[1000] = pend[31] >> 8;
                }
                __syncthreads();
            }
        }
        SEAM(pb + P_PLACE);
        if (EN(8) && IN(pb + P_GU)) {
            PHASE_ENTER();
            const int nused = BLKE[1000];
            pg8::Gemm g{H, (const bf16_t*)(const GAS bf16_t*)(ws + WS_WGU + (size_t)l * NEXP * 2 * MiB), DM};
            pg8::MoeOrder S{BLKE, BTOK, 4 * nused, G, vcu};
            pg8::EpiSwiGLU E{ACT};
#pragma unroll 1
            for (int rep = 0; rep < REP_GU; ++rep)
            pg8::gemm_phase<pg8::EpiSwiGLU, pg8::MoeOrder>(lds, g, S, E, wave);
        }
        SEAM(pb + P_GU);
        if (EN(9) && IN(pb + P_DOWN)) {
            PHASE_ENTER();
            const int nused = BLKE[1000];
            pg8::Gemm g{ACT, (const bf16_t*)(const GAS bf16_t*)(ws + WS_WDN + (size_t)l * NEXP * MiB), DFF};
            pg8::MoeOrder S{BLKE, nullptr, 4 * nused, G, vcu};
            pg8::EpiY E{YM};
#pragma unroll 1
            for (int rep = 0; rep < REP_DOWN; ++rep)
            pg8::gemm_phase<pg8::EpiY, pg8::MoeOrder>(lds, g, S, E, wave);
        }
        SEAM(pb + P_DOWN);
    }
    if (EN(10) && IN(PH_FINAL)) {
        PHASE_ENTER();
        row_phase<false, true, false, false, true>(lds, tid, lane, wave, G, bx, x_in, XB, out, g_ffn, MOD, 0, 0, MOD + (size_t)NB * MODW, H, YM, POS, TW, WR, TE, TRK, CNT);
    }
#undef IN
#undef SEAM
#undef GRID_BAR
}

extern "C" void kernel_launch(void* const* d_in, const int* in_sizes, int n_in, void* d_out, int out_size, void* d_ws, size_t ws_size, hipStream_t stream) {
    static int grid = 0;
    if (grid == 0) {
        if (n_in != 18 || in_sizes[0] != TT * DM || out_size != TT * DM || ws_size < WS_END) { fprintf(stderr, "kernel_launch: unexpected shapes / workspace (n_in %d, ws %zu); nothing launched\n", n_in, ws_size); grid = -1; return; }
        int dev = 0, cus = 0, per_cu = 0;
        if (hipGetDevice(&dev) != hipSuccess || hipDeviceGetAttribute(&cus, hipDeviceAttributeMultiprocessorCount, dev) != hipSuccess) { grid = -1; return; }
        if (hipFuncSetAttribute((const void*)fwd_kernel, hipFuncAttributeMaxDynamicSharedMemorySize, LDS_BYTES) != hipSuccess) { fprintf(stderr, "kernel_launch: hipFuncSetAttribute failed\n"); grid = -1; return; }
        if (hipOccupancyMaxActiveBlocksPerMultiprocessor(&per_cu, (const void*)fwd_kernel, 512, LDS_BYTES) != hipSuccess || per_cu < 1) { fprintf(stderr, "kernel_launch: occupancy query says %d\n", per_cu); per_cu = 1; }
        (void)hipGetLastError();
        grid = cus;
    }
    if (grid < 0) return;
    (void)hipMemsetAsync((char*)d_ws + WS_CTL, 0, CTL_ZERO_BYTES, stream);
    Args a{};
    for (int i = 0; i < 18; ++i) a.in[i] = (const float*)d_in[i];
    a.out = (float*)d_out; a.ws = (unsigned char*)d_ws;
#if MK_ONE_LAUNCH
    a.ph_lo = 0; a.ph_hi = NPH;
    hipLaunchKernelGGL(fwd_kernel, dim3(grid), dim3(512), LDS_BYTES, stream, a);
#else
    for (int p = 0; p < NPH; ++p) { a.ph_lo = p; a.ph_hi = p + 1; hipLaunchKernelGGL(fwd_kernel, dim3(grid), dim3(512), LDS_BYTES, stream, a); }
#endif
}
```

```cpp
#include <hip/hip_runtime.h>
#include <cstdio>
#include <cstdint>

#ifndef INPROJ_WGM
#define INPROJ_WGM 4
#endif
#ifndef GEMM_ALIGN
#define GEMM_ALIGN 1
#endif
#ifndef ROWB
#define ROWB 4
#endif
#ifndef N1K_WGM
#define N1K_WGM 8
#endif
#ifndef OUT_ROWMAJOR
#define OUT_ROWMAJOR 0
#endif
#ifndef REP_PRO
#define REP_PRO 1
#endif
#ifndef REP_ATTB
#define REP_ATTB 1
#endif
#ifndef REP_ATTA
#define REP_ATTA 1
#endif
#ifndef REP_INPROJ
#define REP_INPROJ 1
#endif
#ifndef REP_NORM1
#define REP_NORM1 1
#endif
#ifndef REP_GU
#define REP_GU 1
#endif
#ifndef REP_PAB
#define REP_PAB 1
#endif
#ifndef REP_OUT
#define REP_OUT 1
#endif
#ifndef REP_DOWN
#define REP_DOWN 1
#endif
#ifndef REP_NORM2
#define REP_NORM2 1
#endif
#ifndef MK_ONE_LAUNCH
#define MK_ONE_LAUNCH 1
#endif

#define LAS __attribute__((address_space(3)))
#define GAS __attribute__((address_space(1)))
typedef unsigned short bf16_t;
typedef short bf16x8 __attribute__((ext_vector_type(8)));
typedef short s16x4 __attribute__((ext_vector_type(4)));
typedef float f32x4 __attribute__((ext_vector_type(4)));
typedef float f32x16 __attribute__((ext_vector_type(16)));
typedef unsigned u32x4 __attribute__((ext_vector_type(4)));
typedef unsigned u32x2 __attribute__((ext_vector_type(2)));

constexpr int NB = 32, SEQ = 2048, DM = 1024, TT = NB * SEQ;
constexpr int NC = 4352;
constexpr int NEXP = 32, DFF = 512, NPAD = 139264, NBLK = 544;
constexpr int MODW = 6 * DM;
constexpr float QSCALE = 0.125f * 1.4426950408889634f;

constexpr size_t MiB = 1u << 20;
constexpr size_t WS_CTL = 0, CTL_ZERO_BYTES = 64 * 1024;
constexpr size_t WS_MOD = 1 * MiB;
constexpr size_t WS_TE = 2 * MiB + 512 * 1024, WS_TRK = 3 * MiB, WS_TW = 3 * MiB + 512 * 1024, WS_POS = 4 * MiB;
constexpr size_t WS_CNT = 4 * MiB + 512 * 1024;
constexpr size_t WS_BLKE = WS_CNT + 64 * 1024;
constexpr size_t WS_BTOK = WS_CNT + 128 * 1024;
constexpr size_t WS_WR = 5 * MiB + 256 * 1024;
constexpr size_t WS_WIN = 6 * MiB;
constexpr size_t WIN_BYTES = (size_t)NC * DM * 2;
constexpr size_t WS_WPA = 23 * MiB, WS_WPB = 25 * MiB, WS_WOUT = 27 * MiB;
constexpr size_t WS_WGU = 31 * MiB;
constexpr size_t WS_WDN = 159 * MiB;
constexpr size_t WS_H = 223 * MiB;
constexpr size_t WS_QKV = 351 * MiB;
constexpr size_t WS_GATE = 639 * MiB;
constexpr size_t WS_XB = 896 * MiB;
constexpr size_t WS_END = 1024 * MiB;
constexpr int CW_BAR = 4096;

constexpr int RING_BYTES = 133120;
constexpr int MISC_OFF = RING_BYTES;
constexpr int LDS_BYTES = 147456;

#define RLX_AGENT __ATOMIC_RELAXED, __HIP_MEMORY_SCOPE_AGENT
typedef float f32x2_t __attribute__((ext_vector_type(2))); typedef __bf16 bf16x2_t __attribute__((ext_vector_type(2)));
__device__ __forceinline__ unsigned cvt_pk_bf16(float lo, float hi) { const f32x2_t v = {lo, hi}; const bf16x2_t b = __builtin_convertvector(v, bf16x2_t); return __builtin_bit_cast(unsigned, b); }
typedef float f32x2v __attribute__((ext_vector_type(2)));
__device__ __forceinline__ unsigned pack4_fp8(float a, float b, float c, float d) { unsigned w = 0; w = __builtin_amdgcn_cvt_pk_fp8_f32(a, b, w, false); w = __builtin_amdgcn_cvt_pk_fp8_f32(c, d, w, true); return w; }
__device__ __forceinline__ void unpack8_fp8(u32x2 w, float (&o)[8]) { const f32x2v a = __builtin_amdgcn_cvt_pk_f32_fp8(w.x, false), b = __builtin_amdgcn_cvt_pk_f32_fp8(w.x, true), c = __builtin_amdgcn_cvt_pk_f32_fp8(w.y, false), d = __builtin_amdgcn_cvt_pk_f32_fp8(w.y, true);
    o[0] = a.x; o[1] = a.y; o[2] = b.x; o[3] = b.y; o[4] = c.x; o[5] = c.y; o[6] = d.x; o[7] = d.y; }
constexpr float A8S = 4.f, A8I = 0.25f;
constexpr float W8S = 64.f, W8I = 1.f / 64.f;
__device__ __forceinline__ float bf_lo(unsigned w) { return __uint_as_float(w << 16); }
__device__ __forceinline__ float bf_hi(unsigned w) { return __uint_as_float(w & 0xffff0000u); }
__device__ __forceinline__ float shx(float v, int mask, int lane) { return __int_as_float(__builtin_amdgcn_ds_bpermute((lane ^ mask) << 2, __float_as_int(v))); }
__device__ __forceinline__ float wave_sum(float v, int lane) {
#pragma unroll
    for (int o = 1; o < 64; o <<= 1) v += shx(v, o, lane);
    return v;
}
__device__ __forceinline__ float wave_max(float v, int lane) {
#pragma unroll
    for (int o = 1; o < 64; o <<= 1) v = fmaxf(v, shx(v, o, lane));
    return v;
}
__device__ __forceinline__ float sigmoid_f(float x) { return __builtin_amdgcn_rcpf(1.0f + __builtin_amdgcn_exp2f(-1.4426950408889634f * x)); }

#define XB_TMO      128
#define XB_XCNT(j)  (256  + 64 * (j))
#define XB_XSUB(j)  (1280 + 64 * (j))
#define XB_XGEN(j)  (2304 + 64 * (j))
#define XB_TOP      3328
#define XB_TOPGEN   3392
#define XCD_BAR_WORDS 3456
#define XB_SPIN_CAP (1u << 18)

__device__ __forceinline__ unsigned xb_ld(unsigned* p)              { return __hip_atomic_load(p, __ATOMIC_RELAXED, __HIP_MEMORY_SCOPE_AGENT); }
__device__ __forceinline__ unsigned xb_add(unsigned* p, unsigned v) { return __hip_atomic_fetch_add(p, v, __ATOMIC_RELAXED, __HIP_MEMORY_SCOPE_AGENT); }
__device__ __forceinline__ unsigned xb_xcc_id() { return (unsigned)__builtin_amdgcn_s_getreg((3 << 11) | 20) & 0xFu; }
#define XB_SPIN(cond, bar) do { unsigned _sp = 0; while (cond) { __builtin_amdgcn_s_sleep(1); \
    if ((++_sp & 255u) == 0u) { if (xb_ld(&(bar)[XB_TMO])) break; if (_sp > XB_SPIN_CAP) { atomicAdd(&(bar)[XB_TMO], 1u); break; } } } } while (0)

struct XcdBarrier { unsigned* bar; unsigned x; volatile LAS unsigned* st; };

__device__ __forceinline__ XcdBarrier xcd_barrier_post(unsigned* bar, volatile LAS unsigned* st) {
    XcdBarrier b; b.bar = bar; b.x = xb_xcc_id(); b.st = st;
    if (threadIdx.x == 0) (void)xb_add(&bar[XB_XCNT(b.x)], 1u);
    return b;
}
__device__ __forceinline__ void xcd_barrier_complete(unsigned* bar, unsigned x, unsigned& nloc, unsigned& nx) {
    const unsigned G = gridDim.x * gridDim.y * gridDim.z;
    unsigned sum, cnt, mine, sp = 0u;
    for (;;) {
        sum = 0u; cnt = 0u; mine = 0u;
#pragma unroll
        for (unsigned j = 0; j < 16; ++j) { const unsigned c = xb_ld(&bar[XB_XCNT(j)]); sum += c; cnt += (c > 0u) ? 1u : 0u; mine = (j == x) ? c : mine; }
        if (sum == G) break;
        __builtin_amdgcn_s_sleep(1);
        if ((++sp & 255u) == 0u) { if (xb_ld(&bar[XB_TMO])) break; if (sp > XB_SPIN_CAP) { atomicAdd(&bar[XB_TMO], 1u); break; } }
    }
    nloc = mine > 0u ? mine : 1u; nx = cnt > 0u ? cnt : 1u;
}
__device__ __forceinline__ void xcd_barrier(const XcdBarrier& b, const bool is_t0  ) {
    asm volatile("s_waitcnt vmcnt(0)" ::: "memory");
    __syncthreads();
    if (is_t0) {
        unsigned* bar = b.bar; unsigned bx_ = b.x;
        asm volatile("" : "+s"(bar), "+s"(bx_));
        __builtin_amdgcn_s_waitcnt(0);
        unsigned nloc = b.st[0], nx = b.st[1];
        if (nloc == 0u) { xcd_barrier_complete(bar, bx_, nloc, nx); b.st[0] = nloc; b.st[1] = nx; }
        const unsigned old = xb_add(&bar[XB_XSUB(bx_)], 1u);
        const unsigned gen = old / nloc;
        if (old + 1u == (gen + 1u) * nloc) {
            __builtin_amdgcn_fence(__ATOMIC_RELEASE, "agent");
            asm volatile("s_waitcnt vmcnt(0)" ::: "memory");
            const unsigned og = xb_add(&bar[XB_TOP], 1u);
            const unsigned tg = og / nx;
            if (og + 1u == (tg + 1u) * nx) xb_add(&bar[XB_TOPGEN], 1u);
            else XB_SPIN(xb_ld(&bar[XB_TOPGEN]) == tg, bar);
            __builtin_amdgcn_fence(__ATOMIC_ACQUIRE, "agent");
            xb_add(&bar[XB_XGEN(bx_)], 1u);
            asm volatile("s_waitcnt vmcnt(0)" ::: "memory");
        } else {
            XB_SPIN(xb_ld(&bar[XB_XGEN(bx_)]) == gen, bar);
            __builtin_amdgcn_fence(__ATOMIC_ACQUIRE, "agent");
            asm volatile("s_waitcnt vmcnt(0)" ::: "memory");
        }
    }
    __syncthreads();
}

namespace pg8 {
constexpr int BM = 256, BK = 64, HALF = 128, HTB = HALF * BK * 2, STAGE_BYTES = 8 * HTB, NXCD = 8, WGM = 8;
__host__ __device__ __forceinline__ int lds_byte(int r, int c) { const int st = (r >> 4) * 2 + (c >> 5), rr = r & 15, cc = c & 31, ob = rr * 64 + cc * 2; return st * 1024 + (ob ^ (((ob >> 9) & 1) << 5)); }
__host__ __device__ __forceinline__ void stage_rc(int b, int& R, int& C) { const int st = b / 1024, sb = b % 1024, swz = sb ^ (((sb >> 9) & 1) << 5); R = (st >> 1) * 16 + swz / 64; C = (st & 1) * 32 + (swz % 64) / 2; }
__host__ __device__ __forceinline__ int perm32(int rho) { const int n = rho >> 4, i = rho & 15; return 8 * (i >> 2) + 4 * n + (i & 3); }

struct Unit { int pm, pn; };
struct Gemm { const bf16_t* A; const bf16_t* Bt; int K; };

struct StaticOrder {
    static constexpr bool GATHER = false;
    int nM, nN, nwg, G, c, wgm = WGM;
    __device__ void init(int M, int N, int G_, int c_) { asm volatile("" : "+s"(c_));     nM = M / BM; nN = N / BM; nwg = nM * nN; G = G_; c = c_; }
    int rowmajor = 0;
    __device__ __forceinline__ bool next(int i, Unit& u) const {
        if (rowmajor) { const int upw = (nwg + G - 1) / G, k = c * upw + i; if (i >= upw || k >= nwg) return false; u.pm = k / nN; u.pn = k % nN; return true; }
        const long L = (long)i * G + c; if (L >= nwg) return false;
        int wgid = (int)L; { const int q = nwg / NXCD, r = nwg % NXCD, xcd = wgid % NXCD, off = wgid / NXCD; wgid = (xcd < r ? xcd * (q + 1) : r * (q + 1) + (xcd - r) * q) + off; }
        const int nig = wgm * nN, gid = wgid / nig, fm = gid * wgm, gsz = (nM - fm) < wgm ? (nM - fm) : wgm;
        u.pm = fm + ((wgid % nig) % gsz); u.pn = (wgid % nig) / gsz; return true;
    }
    __device__ __forceinline__ void aoff(const Unit&, const int (&)[2], const unsigned (&)[2], int, unsigned (&)[2][2]) const {}
};
struct MoeOrder {
    static constexpr bool GATHER = true;
    const int* blk_e; const int* rowidx; int nunits, G, c;
    __device__ __forceinline__ bool next(int i, Unit& u) const {
        const int L = i * G + c; if (L >= nunits) return false;
        const int blk = L >> 2; const int e = blk_e[blk]; u.pm = blk; u.pn = 4 * e + (L & 3); return true;
    }
    __device__ __forceinline__ void aoff(const Unit& u, const int (&RA)[2], const unsigned (&CA2)[2], int K, unsigned (&o)[2][2]) const {
#pragma unroll
        for (int h = 0; h < 2; ++h)
#pragma unroll
            for (int i = 0; i < 2; ++i) { const int r = u.pm * BM + h * HALF + RA[i]; const int src = rowidx ? rowidx[r] : r; o[h][i] = (unsigned)src * (unsigned)(K * 2) + CA2[i]; }
    }
};

typedef int i32x8 __attribute__((ext_vector_type(8))); typedef int i32x4 __attribute__((ext_vector_type(4)));
__device__ __forceinline__ i32x8 cat8(const bf16x8& a, const bf16x8& b) { return __builtin_shufflevector(__builtin_bit_cast(i32x4, a), __builtin_bit_cast(i32x4, b), 0, 1, 2, 3, 4, 5, 6, 7); }
template <class Epi, class Sched, bool F8 = false>
__device__ __forceinline__ void gemm_phase(LAS unsigned char* lds, const Gemm g, const Sched& S, const Epi& E, const int wid) {
    int lane_; asm volatile("v_mbcnt_lo_u32_b32 %0, -1, 0\n\tv_mbcnt_hi_u32_b32 %0, -1, %0" : "=v"(lane_));
    const int lane = lane_, tid = wid * 64 + lane, wr = wid >> 2, wc = wid & 3, fr = lane & 15, fq = lane >> 4;
    const int K = g.K, nt = K / BK;
    unsigned voffA[2], voffB[2], CA2[2]; int RA[2];
#pragma unroll
    for (int i = 0; i < 2; ++i) { int R, C; stage_rc(tid * 16 + i * 8192, R, C); const int Rb = Epi::PERM ? ((R & ~31) + perm32(R & 31)) : R;
        RA[i] = R; CA2[i] = (unsigned)C * 2u; voffA[i] = (unsigned)(R * K + C) * 2u; voffB[i] = (unsigned)(Rb * K + C) * 2u; }
    const size_t kstep = (size_t)(BK * 2);
    const size_t hstep = (size_t)HALF * K * 2;
    const size_t tstep = 2 * hstep;
    const unsigned ldsw = (unsigned)wid * 1024u;
    const int aoff = lds_byte(wr * 64 + fr, fq * 8), boff = lds_byte(wc * 32 + fr, fq * 8);
    const char* Ab = (const char*)g.A;
#define PG8_SA(b, h) (((b) * 2 + (h)) * HTB)
#define PG8_SB(b, h) ((4 + (b) * 2 + (h)) * HTB)
#define PG8_UNI(p) asm volatile("" : "+s"(p))
#define PG8_STAGEB(bufoff, gbase, voff) do { const char* _g = (const char*)(gbase); PG8_UNI(_g); _Pragma("unroll") for (int _i = 0; _i < 2; ++_i) \
        __builtin_amdgcn_global_load_lds((const unsigned*)(_g + (voff)[_i]), (LAS unsigned*)(lds + (bufoff) + ldsw + _i * 8192), 16, 0, 0); } while (0)
#define PG8_STAGEA(bufoff, H_, kb, NEXT) do { if constexpr (Sched::GATHER) { const char* _g = Ab + (size_t)(kb); PG8_UNI(_g); _Pragma("unroll") for (int _i = 0; _i < 2; ++_i) { const unsigned _o = (NEXT) ? na[H_][_i] : ca[H_][_i]; \
            __builtin_amdgcn_global_load_lds((const unsigned*)(_g + _o), (LAS unsigned*)(lds + (bufoff) + ldsw + _i * 8192), 16, 0, 0); } } \
        else { const char* _b = Ab + ((NEXT) ? nU : cU) + (size_t)(H_) * hstep + (size_t)(kb); PG8_UNI(_b); _Pragma("unroll") for (int _i = 0; _i < 2; ++_i) \
            __builtin_amdgcn_global_load_lds((const unsigned*)(_b + voffA[_i]), (LAS unsigned*)(lds + (bufoff) + ldsw + _i * 8192), 16, 0, 0); } } while (0)
#define PG8_LDA(dst, b, h) do { _Pragma("unroll") for (int m = 0; m < 4; ++m) _Pragma("unroll") for (int k = 0; k < 2; ++k) dst[m][k] = *(const LAS bf16x8*)(lds + PG8_SA(b, h) + aoff + m * 2048 + k * 1024); } while (0)
#define PG8_LDB(dst, b, h) do { _Pragma("unroll") for (int n = 0; n < 2; ++n) _Pragma("unroll") for (int k = 0; k < 2; ++k) dst[n][k] = *(const LAS bf16x8*)(lds + PG8_SB(b, h) + boff + n * 2048 + k * 1024); } while (0)
#define PG8_MMA(ai, bj, At, Bt) do { __builtin_amdgcn_s_setprio(1); _Pragma("unroll") for (int m = 0; m < 4; ++m) _Pragma("unroll") for (int n = 0; n < 2; ++n) { \
        if constexpr (F8) acc[ai][bj][m][n] = __builtin_amdgcn_mfma_scale_f32_16x16x128_f8f6f4(cat8(Bt[n][0], Bt[n][1]), cat8(At[m][0], At[m][1]), acc[ai][bj][m][n], 0, 0, 0, 0, 0, 0); \
        else { _Pragma("unroll") for (int k = 0; k < 2; ++k) acc[ai][bj][m][n] = __builtin_amdgcn_mfma_f32_16x16x32_bf16(Bt[n][k], At[m][k], acc[ai][bj][m][n], 0, 0, 0); } } \
        __builtin_amdgcn_s_setprio(0); } while (0)
#define PG8_WAIT_V(n) asm volatile("s_waitcnt vmcnt(" #n ")" ::: "memory")
#define PG8_WAIT_L(n) asm volatile("s_waitcnt lgkmcnt(" #n ")" ::: "memory")
#define PG8_BAR __builtin_amdgcn_s_barrier()
#define PG8_SCHED __builtin_amdgcn_sched_barrier(0)
    Unit cur, nxt; int ui = 0;
    if (!S.next(0, cur)) return;
    f32x4 acc[2][2][4][2];
#pragma unroll
    for (int a = 0; a < 2; ++a)
#pragma unroll
        for (int b = 0; b < 2; ++b)
#pragma unroll
            for (int m = 0; m < 4; ++m)
#pragma unroll
                for (int n = 0; n < 2; ++n) acc[a][b][m][n] = (f32x4){0.f, 0.f, 0.f, 0.f};
    bf16x8 At[4][2], B0[2][2], B1[2][2];
    unsigned ca[2][2], na[2][2];
    size_t cU = 0, nU = 0;
    if constexpr (Sched::GATHER) S.aoff(cur, RA, CA2, K, ca); else cU = (size_t)cur.pm * tstep;
    const char* cB = (const char*)g.Bt + (size_t)cur.pn * tstep;
    PG8_STAGEB(PG8_SB(0, 0), cB, voffB); PG8_STAGEB(PG8_SB(0, 1), cB + hstep, voffB); PG8_STAGEA(PG8_SA(0, 0), 0, 0, false); PG8_STAGEA(PG8_SA(0, 1), 1, 0, false);
    if (wr == 1) PG8_BAR;
    PG8_WAIT_V(2); PG8_BAR;
    PG8_STAGEB(PG8_SB(1, 0), cB + kstep, voffB); PG8_STAGEA(PG8_SA(1, 0), 0, kstep, false); PG8_STAGEB(PG8_SB(1, 1), cB + hstep + kstep, voffB);
    PG8_WAIT_V(6); PG8_BAR;
    for (;;) {
        const bool has_next = S.next(ui + 1, nxt);
        if constexpr (Sched::GATHER) {
            if (has_next) S.aoff(nxt, RA, CA2, K, na);
            else {
#pragma unroll
                for (int h = 0; h < 2; ++h)
#pragma unroll
                    for (int i = 0; i < 2; ++i) na[h][i] = ca[h][i];
            }
        } else nU = has_next ? (size_t)nxt.pm * tstep : cU;
        const char* nB = has_next ? (const char*)g.Bt + (size_t)nxt.pn * tstep : cB;
        for (int t = 0; t < nt; t += 2) {
            const bool last = (t == nt - 2);
            const size_t kb1 = (size_t)(t + 1) * kstep;
            const size_t kb2 = last ? 0 : (size_t)(t + 2) * kstep, kb3 = kb2 + kstep;
            const char* b2 = last ? nB : cB + (size_t)(t + 2) * kstep; const char* b3 = b2 + kstep;
            PG8_LDB(B0, 0, 0); PG8_LDB(B1, 0, 1); PG8_SCHED; PG8_LDA(At, 0, 0); PG8_STAGEA(PG8_SA(1, 1), 1, kb1, false);
            PG8_WAIT_V(8); PG8_WAIT_L(0); PG8_BAR; PG8_MMA(0, 0, At, B0); PG8_MMA(0, 1, At, B1); PG8_BAR; PG8_SCHED;
            PG8_LDA(At, 0, 1); PG8_STAGEB(PG8_SB(0, 0), b2, voffB); PG8_STAGEB(PG8_SB(0, 1), b2 + hstep, voffB); PG8_STAGEA(PG8_SA(0, 0), 0, kb2, last);
            PG8_WAIT_V(8); PG8_WAIT_L(0); PG8_BAR; PG8_MMA(1, 0, At, B0); PG8_MMA(1, 1, At, B1); PG8_BAR; PG8_SCHED;
            PG8_LDB(B0, 1, 0); PG8_LDB(B1, 1, 1); PG8_SCHED; PG8_LDA(At, 1, 0); PG8_STAGEA(PG8_SA(0, 1), 1, kb2, last);
            PG8_WAIT_V(8); PG8_WAIT_L(0); PG8_BAR; PG8_MMA(0, 0, At, B0); PG8_MMA(0, 1, At, B1); PG8_BAR; PG8_SCHED;
            PG8_LDA(At, 1, 1); PG8_STAGEB(PG8_SB(1, 0), b3, voffB); PG8_STAGEB(PG8_SB(1, 1), b3 + hstep, voffB); PG8_STAGEA(PG8_SA(1, 0), 0, kb3, last);
            PG8_WAIT_V(8); PG8_WAIT_L(0); PG8_BAR; PG8_MMA(1, 0, At, B0); PG8_MMA(1, 1, At, B1); PG8_BAR; PG8_SCHED;
            if constexpr (Epi::MIDK) { if (t + 2 == nt / 2) E.mid(acc, cur, wr, wc, fr, fq); }
        }
#if GEMM_ALIGN
        if (wr == 0) PG8_BAR;
#endif
        E(acc, cur, wr, wc, fr, fq);
        if (!has_next) break;
#pragma unroll
        for (int a = 0; a < 2; ++a)
#pragma unroll
            for (int b = 0; b < 2; ++b)
#pragma unroll
                for (int m = 0; m < 4; ++m)
#pragma unroll
                    for (int n = 0; n < 2; ++n) acc[a][b][m][n] = (f32x4){0.f, 0.f, 0.f, 0.f};
        cur = nxt; cB = nB; cU = nU; ++ui;
        if constexpr (Sched::GATHER) {
#pragma unroll
            for (int h = 0; h < 2; ++h)
#pragma unroll
                for (int i = 0; i < 2; ++i) ca[h][i] = na[h][i];
        }
#if GEMM_ALIGN
        if (wr == 1) PG8_BAR;
#endif
    }
    PG8_WAIT_V(0);
#if !GEMM_ALIGN
    if (wr == 0) PG8_BAR;
#endif
    PG8_BAR;
#undef PG8_SA
#undef PG8_SB
#undef PG8_STAGEA
#undef PG8_STAGEB
#undef PG8_UNI
#undef PG8_LDA
#undef PG8_LDB
#undef PG8_MMA
#undef PG8_WAIT_V
#undef PG8_WAIT_L
#undef PG8_BAR
#undef PG8_SCHED
}

typedef const f32x4 (&AccRef)[2][2][4][2];

__device__ __forceinline__ u32x4 pack8(const f32x4& a, const f32x4& b) { u32x4 w; w.x = cvt_pk_bf16(a[0], a[1]); w.y = cvt_pk_bf16(a[2], a[3]); w.z = cvt_pk_bf16(b[0], b[1]); w.w = cvt_pk_bf16(b[2], b[3]); return w; }

struct EpiInProj {
    static constexpr bool PERM = true, MIDK = false;
    bf16_t *QA, *KA, *VA, *QB, *KB, *VB, *SA, *SB;
    const LAS float* normw;
    template <int ROPE>
    __device__ __forceinline__ void head_tile(AccRef acc, bf16_t* dst_, int ld, int hcol, int gsel, float scale, int row0, int fr, int fq) const {
        unsigned char* dst = (unsigned char*)dst_;
        int d0[2];
#pragma unroll
        for (int bj = 0; bj < 2; ++bj) d0[bj] = (ROPE == 1) ? (fq == 0 ? 8 * bj : 8 + 8 * fq + 24 * bj) : (fq < 2 ? 8 * fq + 16 * bj : 16 + 8 * fq + 16 * bj);
        f32x4 g[2][2];
#pragma unroll
        for (int bj = 0; bj < 2; ++bj)
#pragma unroll
            for (int n = 0; n < 2; ++n) g[bj][n] = *(const LAS f32x4*)(normw + gsel * 64 + d0[bj] + 4 * n);
        constexpr float FA[8] = {1.591549431e-01f, 3.086376340e-02f, 5.985185713e-03f, 1.160663641e-03f, 2.250790790e-04f, 4.364795279e-05f, 8.464330808e-06f, 1.641426263e-06f};
        constexpr float FB[16] = {1.591549431e-01f, 8.949940161e-02f, 5.032921210e-02f, 2.830219583e-02f, 1.591549431e-02f, 8.949940161e-03f, 5.032921210e-03f, 2.830219583e-03f,
                                  1.591549431e-03f, 8.949940161e-04f, 5.032921210e-04f, 2.830219583e-04f, 1.591549431e-04f, 8.949940161e-05f, 5.032921210e-05f, 2.830219583e-05f};
        float fq8[8];
#pragma unroll
        for (int k = 0; k < 8; ++k) fq8[k] = (ROPE == 1) ? FA[k] : ((fq & 1) ? FB[8 + k] : FB[k]);
        const bool rot = (ROPE == 2) || (fq == 0);
#pragma unroll
        for (int ai = 0; ai < 2; ++ai)
#pragma unroll
            for (int m = 0; m < 4; ++m) {
                const int row = row0 + ai * HALF + m * 16; const int s = row & (SEQ - 1);
                f32x4 y[2][2]; float ss = 0.f;
#pragma unroll
                for (int bj = 0; bj < 2; ++bj)
#pragma unroll
                    for (int n = 0; n < 2; ++n) { y[bj][n] = acc[ai][bj][m][n]; const f32x4 q = y[bj][n] * y[bj][n]; ss += (q[0] + q[1]) + (q[2] + q[3]); }
                ss += shx(ss, 16, fr + 16 * fq); ss += shx(ss, 32, fr + 16 * fq);
                const float rinv = __builtin_amdgcn_rsqf(ss * (W8I * W8I / 64.0f) + 1e-6f) * W8I;
#pragma unroll
                for (int bj = 0; bj < 2; ++bj)
#pragma unroll
                    for (int n = 0; n < 2; ++n) y[bj][n] = y[bj][n] * rinv * g[bj][n];
                if (ROPE != 0) {
                    const float pos = (float)((ROPE == 1) ? s : (fq < 2 ? (s >> 6) : (s & 63)));
#pragma unroll
                    for (int n = 0; n < 2; ++n)
#pragma unroll
                        for (int j = 0; j < 4; ++j) {
                            const float xr = __builtin_amdgcn_fractf(pos * fq8[4 * n + j]);
                            const float c = rot ? __builtin_amdgcn_cosf(xr) : 1.0f, s_ = rot ? __builtin_amdgcn_sinf(xr) : 0.0f;
                            const float x1 = y[0][n][j], x2 = y[1][n][j];
                            y[0][n][j] = x1 * c - x2 * s_; y[1][n][j] = x2 * c + x1 * s_;
                        }
                }
                u32x4 w;
#pragma unroll
                for (int bj = 0; bj < 2; ++bj) { const f32x4 a = y[bj][0] * scale, c = y[bj][1] * scale;
                    const unsigned lo = pack4_fp8(a[0], a[1], a[2], a[3]), hi = pack4_fp8(c[0], c[1], c[2], c[3]);
                    if (bj == 0) { w.x = lo; w.y = hi; } else { w.z = lo; w.w = hi; } }
                *(u32x4*)(dst + (size_t)row * ld + hcol + 16 * fq) = w;
            }
    }
    __device__ __forceinline__ void operator()(AccRef acc, const Unit& u, int wr, int wc, int fr_, int fq_) const {
        int fr = fr_, fq = fq_; asm volatile("" : "+v"(fr), "+v"(fq));
        const int pn = u.pn; const int row0 = u.pm * BM + wr * 64 + fr;
        if (pn >= 9) {
            unsigned char* base = (unsigned char*)((pn < 13) ? SA : SB); const int colt = ((pn - 9) & 3) * 256 + wc * 64 + 16 * fq;
#pragma unroll
            for (int ai = 0; ai < 2; ++ai)
#pragma unroll
                for (int m = 0; m < 4; ++m) { u32x4 w;
#pragma unroll
                    for (int bj = 0; bj < 2; ++bj) { f32x4 v0 = acc[ai][bj][m][0], v1 = acc[ai][bj][m][1];
#pragma unroll
                        for (int j = 0; j < 4; ++j) { v0[j] = sigmoid_f(v0[j] * W8I); v1[j] = sigmoid_f(v1[j] * W8I); }
                        const unsigned lo = pack4_fp8(v0[0], v0[1], v0[2], v0[3]), hi = pack4_fp8(v1[0], v1[1], v1[2], v1[3]);
                        if (bj == 0) { w.x = lo; w.y = hi; } else { w.z = lo; w.w = hi; } }
                    *(u32x4*)(base + (size_t)(row0 + ai * HALF + m * 16) * DM + colt) = w; }
        } else if (pn == 4 || pn == 5) {
            const int colt = (pn - 4) * 256 + wc * 64 + 16 * fq;
#pragma unroll
            for (int ai = 0; ai < 2; ++ai)
#pragma unroll
                for (int m = 0; m < 4; ++m) { bf16_t* rowp = VA + (size_t)(row0 + ai * HALF + m * 16) * 512 + colt;
#pragma unroll
                    for (int bj = 0; bj < 2; ++bj) *(u32x4*)(rowp + 8 * bj) = pack8(acc[ai][bj][m][0] * W8I, acc[ai][bj][m][1] * W8I); }
        } else if (pn < 2)  head_tile<1>(acc, QA, 512, 64 * (4 * pn + wc), 0, QSCALE, row0, fr, fq);
        else if (pn < 4)    head_tile<1>(acc, KA, 512, 64 * (4 * (pn - 2) + wc), 1, 1.0f, row0, fr, fq);
        else if (pn < 8)    head_tile<2>(acc, QB, 512, 64 * (4 * (pn - 6) + wc), 2, QSCALE, row0, fr, fq);
        else if (wc < 2)    head_tile<2>(acc, KB, 128, 64 * wc, 3, 1.0f, row0, fr, fq);
        else {
#pragma unroll
            for (int ai = 0; ai < 2; ++ai)
#pragma unroll
                for (int m = 0; m < 4; ++m) { bf16_t* rowp = VB + (size_t)(row0 + ai * HALF + m * 16) * 128 + 64 * (wc - 2) + 8 * fq;
#pragma unroll
                    for (int bj = 0; bj < 2; ++bj) *(u32x4*)(rowp + 32 * bj) = pack8(acc[ai][bj][m][0] * W8I, acc[ai][bj][m][1] * W8I); }
        }
    }
};

struct EpiMergeFused {
    static constexpr bool PERM = true, MIDK = true;
    bf16_t* MG; const unsigned char* GA; const unsigned char* GB;
    __device__ __forceinline__ void mid(f32x4 (&acc)[2][2][4][2], const Unit& u, int wr, int wc, int fr_, int fq_) const {
        int fr = fr_, fq = fq_; asm volatile("" : "+v"(fr), "+v"(fq));
        const int row0 = u.pm * BM + wr * 64 + fr, col0 = u.pn * BM + wc * 64 + 16 * fq;
#pragma unroll
        for (int ai = 0; ai < 2; ++ai)
#pragma unroll
            for (int m = 0; m < 4; ++m) { const size_t ro = (size_t)(row0 + ai * HALF + m * 16) * DM + col0;
                const u32x4 a = *(const u32x4*)(GA + ro), b = *(const u32x4*)(GB + ro);
#pragma unroll
                for (int bj = 0; bj < 2; ++bj) {
                    float sa[8], sb[8]; unpack8_fp8(bj ? (u32x2){a.z, a.w} : (u32x2){a.x, a.y}, sa); unpack8_fp8(bj ? (u32x2){b.z, b.w} : (u32x2){b.x, b.y}, sb);
#pragma unroll
                    for (int n = 0; n < 2; ++n)
#pragma unroll
                        for (int j = 0; j < 4; ++j) acc[ai][bj][m][n][j] *= sa[4 * n + j] * __builtin_amdgcn_rcpf(fmaxf(sb[4 * n + j], 1e-12f));
                } }
    }
    __device__ __forceinline__ void operator()(AccRef acc, const Unit& u, int wr, int wc, int fr_, int fq_) const {
        int fr = fr_, fq = fq_; asm volatile("" : "+v"(fr), "+v"(fq));
        const int row0 = u.pm * BM + wr * 64 + fr, col0 = u.pn * BM + wc * 64 + 16 * fq;
#pragma unroll
        for (int ai = 0; ai < 2; ++ai)
#pragma unroll
            for (int m = 0; m < 4; ++m) { const size_t ro = (size_t)(row0 + ai * HALF + m * 16) * DM + col0;
                const u32x4 b = *(const u32x4*)(GB + ro); u32x4 w;
#pragma unroll
                for (int bj = 0; bj < 2; ++bj) {
                    float sb[8]; unpack8_fp8(bj ? (u32x2){b.z, b.w} : (u32x2){b.x, b.y}, sb);
                    f32x4 v0 = acc[ai][bj][m][0], v1 = acc[ai][bj][m][1];
                    constexpr float CS = A8I * W8I * A8S;
#pragma unroll
                    for (int j = 0; j < 4; ++j) { v0[j] *= fmaxf(sb[j], 1e-12f) * CS; v1[j] *= fmaxf(sb[4 + j], 1e-12f) * CS; }
                    const unsigned lo = pack4_fp8(v0[0], v0[1], v0[2], v0[3]), hi = pack4_fp8(v1[0], v1[1], v1[2], v1[3]);
                    if (bj == 0) { w.x = lo; w.y = hi; } else { w.z = lo; w.w = hi; } }
                *(u32x4*)((unsigned char*)MG + ro) = w; }
    }
};

struct EpiResidB {
    static constexpr bool PERM = true, MIDK = false;
    const float* Xf; const bf16_t* Xb; bf16_t* O; const float* gate;
    __device__ __forceinline__ void operator()(AccRef acc, const Unit& u, int wr, int wc, int fr_, int fq_) const {
        int fr = fr_, fq = fq_; asm volatile("" : "+v"(fr), "+v"(fq));
        const int row0 = u.pm * BM + wr * 64 + fr, col0 = u.pn * BM + wc * 64 + 16 * fq; const int b = (u.pm * BM) >> 11;
        f32x4 gt[2][2];
#pragma unroll
        for (int bj = 0; bj < 2; ++bj)
#pragma unroll
            for (int n = 0; n < 2; ++n) gt[bj][n] = *(const f32x4*)(gate + (size_t)b * MODW + col0 + 8 * bj + 4 * n) * (A8I * W8I);
#pragma unroll
        for (int ai = 0; ai < 2; ++ai)
#pragma unroll
            for (int m = 0; m < 4; ++m) { const size_t ro = (size_t)(row0 + ai * HALF + m * 16) * DM + col0;
#pragma unroll
                for (int bj = 0; bj < 2; ++bj) {
                    f32x4 x0, x1;
                    if (Xf) { x0 = *(const f32x4*)(Xf + ro + 8 * bj); x1 = *(const f32x4*)(Xf + ro + 8 * bj + 4); }
                    else { const u32x4 w = *(const u32x4*)(Xb + ro + 8 * bj); x0 = (f32x4){bf_lo(w.x), bf_hi(w.x), bf_lo(w.y), bf_hi(w.y)}; x1 = (f32x4){bf_lo(w.z), bf_hi(w.z), bf_lo(w.w), bf_hi(w.w)}; }
                    *(u32x4*)(O + ro + 8 * bj) = pack8(x0 + gt[bj][0] * acc[ai][bj][m][0], x1 + gt[bj][1] * acc[ai][bj][m][1]); } }
    }
};

struct EpiSwiGLU {
    static constexpr bool PERM = true, MIDK = false;
    bf16_t* ACT;
    __device__ __forceinline__ void operator()(AccRef acc, const Unit& u, int wr, int wc, int fr_, int fq_) const {
        int fr = fr_, fq = fq_; asm volatile("" : "+v"(fr), "+v"(fq));
        const int row0 = u.pm * BM + wr * 64 + fr, col0 = (u.pn & 3) * HALF + wc * 32 + 8 * fq;
#pragma unroll
        for (int ai = 0; ai < 2; ++ai)
#pragma unroll
            for (int m = 0; m < 4; ++m) { f32x4 r[2];
#pragma unroll
                for (int n = 0; n < 2; ++n)
#pragma unroll
                    for (int j = 0; j < 4; ++j) { const float gg = acc[ai][0][m][n][j], uu = acc[ai][1][m][n][j]; r[n][j] = gg * sigmoid_f(gg) * uu; }
                *(u32x4*)(ACT + (size_t)(row0 + ai * HALF + m * 16) * DFF + col0) = pack8(r[0], r[1]); }
    }
};

struct EpiY {
    static constexpr bool PERM = true, MIDK = false;
    unsigned char* Y;
    __device__ __forceinline__ void operator()(AccRef acc, const Unit& u, int wr, int wc, int fr_, int fq_) const {
        int fr = fr_, fq = fq_; asm volatile("" : "+v"(fr), "+v"(fq));
        const int row0 = u.pm * BM + wr * 64 + fr, col0 = (u.pn & 3) * BM + wc * 64 + 16 * fq;
#pragma unroll
        for (int ai = 0; ai < 2; ++ai)
#pragma unroll
            for (int m = 0; m < 4; ++m) { u32x4 w;
                { const f32x4 a = acc[ai][0][m][0], b = acc[ai][0][m][1]; w.x = pack4_fp8(a[0], a[1], a[2], a[3]); w.y = pack4_fp8(b[0], b[1], b[2], b[3]); }
                { const f32x4 a = acc[ai][1][m][0], b = acc[ai][1][m][1]; w.z = pack4_fp8(a[0], a[1], a[2], a[3]); w.w = pack4_fp8(b[0], b[1], b[2], b[3]); }
                *(u32x4*)(Y + (size_t)(row0 + ai * HALF + m * 16) * DM + col0) = w; }
    }
};
}

__device__ __forceinline__ int dimA(int bj, int r) { return r < 8 ? r + 8 * bj : 16 + (r - 8) + 24 * bj; }
__device__ __forceinline__ int dimB(int bj, int r) { return r < 16 ? r + 16 * bj : 32 + (r - 16) + 16 * bj; }
__device__ __forceinline__ int inproj_srccol(int P) {
    const int pn = P >> 8, p = P & 255, bj = p >> 7, wc = (p >> 5) & 3, r = p & 31;
    if (pn < 2) return 64 * (4 * pn + wc) + dimA(bj, r);
    if (pn < 4) return 512 + 64 * (4 * (pn - 2) + wc) + dimA(bj, r);
    if (pn < 6) return 1024 + 256 * (pn - 4) + 64 * wc + 16 * ((p >> 3) & 3) + 8 * bj + (p & 7);
    if (pn < 8) return 1536 + 64 * (4 * (pn - 6) + wc) + dimB(bj, r);
    if (pn == 8) return wc < 2 ? 2048 + 64 * wc + dimB(bj, r) : 2176 + 64 * (wc - 2) + 32 * bj + r;
    { const int fq = (p >> 3) & 3, r8 = p & 7; return 2304 + 256 * (pn - 9) + 64 * wc + 16 * fq + 8 * bj + r8; }
}

namespace att {
constexpr int KSTR = 80, VSTR = 192;
constexpr int KTILE = 64 * KSTR, VTILE = 64 * VSTR;
constexpr int K_OFF = 0, V_OFF = 2 * KTILE;
constexpr int PRIV_OFF = 0;
__device__ __forceinline__ s16x4 vtr(LAS const char* p) { typedef short v4i16_t __attribute__((ext_vector_type(4)));
    return __builtin_bit_cast(s16x4, __builtin_amdgcn_ds_read_tr16_b64_v4i16((LAS v4i16_t*)p)); }
__device__ __forceinline__ int clamp_tok(int t) { return t < 0 ? 0 : (t > SEQ - 1 ? SEQ - 1 : t); }

__device__ __forceinline__ long mk64(unsigned lo, unsigned hi) { return (long)(((unsigned long long)hi << 32) | lo); }
__device__ __forceinline__ void qk_tile(f32x16& p0, f32x16& p1, const u32x4 (&kf)[2][2], const u32x4 (&qr)[2]) {
    const f32x16 z = {0.f, 0.f, 0.f, 0.f, 0.f, 0.f, 0.f, 0.f, 0.f, 0.f, 0.f, 0.f, 0.f, 0.f, 0.f, 0.f};
    p0 = __builtin_amdgcn_mfma_f32_32x32x16_fp8_fp8(mk64(kf[0][0].x, kf[0][0].y), mk64(qr[0].x, qr[0].y), z, 0, 0, 0);
    p1 = __builtin_amdgcn_mfma_f32_32x32x16_fp8_fp8(mk64(kf[1][0].x, kf[1][0].y), mk64(qr[0].x, qr[0].y), z, 0, 0, 0);
    p0 = __builtin_amdgcn_mfma_f32_32x32x16_fp8_fp8(mk64(kf[0][0].z, kf[0][0].w), mk64(qr[0].z, qr[0].w), p0, 0, 0, 0);
    p1 = __builtin_amdgcn_mfma_f32_32x32x16_fp8_fp8(mk64(kf[1][0].z, kf[1][0].w), mk64(qr[0].z, qr[0].w), p1, 0, 0, 0);
    p0 = __builtin_amdgcn_mfma_f32_32x32x16_fp8_fp8(mk64(kf[0][1].x, kf[0][1].y), mk64(qr[1].x, qr[1].y), p0, 0, 0, 0);
    p1 = __builtin_amdgcn_mfma_f32_32x32x16_fp8_fp8(mk64(kf[1][1].x, kf[1][1].y), mk64(qr[1].x, qr[1].y), p1, 0, 0, 0);
    p0 = __builtin_amdgcn_mfma_f32_32x32x16_fp8_fp8(mk64(kf[0][1].z, kf[0][1].w), mk64(qr[1].z, qr[1].w), p0, 0, 0, 0);
    p1 = __builtin_amdgcn_mfma_f32_32x32x16_fp8_fp8(mk64(kf[1][1].z, kf[1][1].w), mk64(qr[1].z, qr[1].w), p1, 0, 0, 0);
}
template <bool MASK>
__device__ __forceinline__ void exp_tile(const f32x16& p0, const f32x16& p1, float& lsum, bf16x8 (&pf)[2][2], int mbase, int mR, int dk) {
    float e0[16], e1[16]; float ls = 0.f;
#pragma unroll
    for (int r = 0; r < 16; ++r) {
        e0[r] = __builtin_amdgcn_exp2f(p0[r]); e1[r] = __builtin_amdgcn_exp2f(p1[r]);
        if (MASK) {
            const int c0 = (r & 3) + 8 * (r >> 2);
            e0[r] = ((unsigned)(mbase + dk * c0) <= (unsigned)mR) ? e0[r] : 0.f;
            e1[r] = ((unsigned)(mbase + dk * (c0 + 32)) <= (unsigned)mR) ? e1[r] : 0.f;
        }
        ls += e0[r] + e1[r];
    }
    lsum += ls;
#pragma unroll
    for (int s = 0; s < 2; ++s) {
        u32x4 w0, w1;
        w0.x = cvt_pk_bf16(e0[8 * s + 0], e0[8 * s + 1]); w0.y = cvt_pk_bf16(e0[8 * s + 2], e0[8 * s + 3]); w0.z = cvt_pk_bf16(e0[8 * s + 4], e0[8 * s + 5]); w0.w = cvt_pk_bf16(e0[8 * s + 6], e0[8 * s + 7]);
        w1.x = cvt_pk_bf16(e1[8 * s + 0], e1[8 * s + 1]); w1.y = cvt_pk_bf16(e1[8 * s + 2], e1[8 * s + 3]); w1.z = cvt_pk_bf16(e1[8 * s + 4], e1[8 * s + 5]); w1.w = cvt_pk_bf16(e1[8 * s + 6], e1[8 * s + 7]);
        pf[0][s] = __builtin_bit_cast(bf16x8, w0); pf[1][s] = __builtin_bit_cast(bf16x8, w1);
    }
}
__device__ __forceinline__ void vread(bf16x8 (&vf)[4], LAS const char* vb, int d0) {
#pragma unroll
    for (int blk = 0; blk < 2; ++blk)
#pragma unroll
        for (int s = 0; s < 2; ++s) {
            const s16x4 lo = vtr(vb + (32 * blk + 16 * s) * VSTR + 64 * d0), hi = vtr(vb + (32 * blk + 16 * s + 8) * VSTR + 64 * d0);
            vf[2 * blk + s] = (bf16x8){lo[0], lo[1], lo[2], lo[3], hi[0], hi[1], hi[2], hi[3]};
        }
}
__device__ __forceinline__ void pv_half(f32x16& od, const bf16x8 (&vf)[4], const bf16x8 (&pf)[2][2]) {
#pragma unroll
    for (int blk = 0; blk < 2; ++blk)
#pragma unroll
        for (int s = 0; s < 2; ++s) od = __builtin_amdgcn_mfma_f32_32x32x16_bf16(vf[2 * blk + s], pf[blk][s], od, 0, 0, 0);
}
__device__ __forceinline__ void mask_params(int dk, int tk0, int tq, int hi, int& mbase, int& mR) {
    const int dlo = (-64 * dk > -tq) ? -64 * dk : -tq, dhi = (64 * dk < SEQ - 1 - tq) ? 64 * dk : SEQ - 1 - tq;
    const int dA = tk0 + 4 * dk * hi - tq;
    mR = dhi - dlo; mbase = ((dA & (dk - 1)) == 0) ? dA - dlo : 0x7fffffff;
}

template <bool MASKED>
__device__ __forceinline__ void dense64_loop(LAS char* lds, const unsigned char* Kg, const bf16_t* Vg, int ld  , int tok0, int ntiles,
                                             const u32x4 (&qr)[2][2], f32x16 (&o)[2][2], float (&lsum)[2], int tq0, int tq1, int lane_, int wave) {
    constexpr int V2_OFF = 2 * KTILE;
    u32x2 kreg; u32x4 vreg;
#define D64_LANE() int ln_ = lane_; asm volatile("" : "+v"(ln_)); const int tid_ = wave * 64 + ln_, srow = tid_ >> 3, sch = tid_ & 7
#define D64_LD(t) do { D64_LANE(); int tk_ = tok0 + 64 * (t) + srow; if (MASKED) tk_ = clamp_tok(tk_); kreg = *(const u32x2*)(Kg + (size_t)tk_ * ld + sch * 8); vreg = *(const u32x4*)(Vg + (size_t)tk_ * ld + sch * 8); } while (0)
#define D64_ST(t) do { D64_LANE(); *(LAS u32x2*)(lds + ((t) & 1) * KTILE + srow * KSTR + sch * 8) = kreg; *(LAS u32x4*)(lds + V2_OFF + ((t) & 1) * VTILE + srow * VSTR + sch * 16) = vreg; } while (0)
    D64_LD(0); D64_ST(0); D64_LD(1);
    for (int t = 0; t < ntiles; ++t) {
        __syncthreads();
        if (t + 1 < ntiles) D64_ST(t + 1);
        if (t + 2 < ntiles) D64_LD(t + 2);
        int lane = lane_; asm volatile("" : "+v"(lane));
        const int hi = lane >> 5;
        const int vlane = (4 * hi + ((lane & 15) >> 2)) * VSTR + (16 * ((lane >> 4) & 1) + 4 * (lane & 3)) * 2;
        const int klane = (lane & 31) * KSTR + 32 * hi;
        u32x4 kf[2][2];
        { LAS const char* kb_ = lds + (t & 1) * KTILE + klane;
#pragma unroll
          for (int blk = 0; blk < 2; ++blk)
#pragma unroll
              for (int e = 0; e < 2; ++e) kf[blk][e] = *(const LAS u32x4*)(kb_ + 32 * blk * KSTR + 16 * e); }
        f32x16 p[2][2];
        bf16x8 vfa[4], vfb[4];
        LAS const char* vb_ = lds + V2_OFF + (t & 1) * VTILE + vlane;
        vread(vfa, vb_, 0); vread(vfb, vb_, 1);
        __builtin_amdgcn_sched_barrier(0);
        qk_tile(p[0][0], p[0][1], kf, qr[0]);
        qk_tile(p[1][0], p[1][1], kf, qr[1]);
#pragma unroll
        for (int g = 0; g < 2; ++g) {
            bf16x8 pf[2][2]; int mb = 0, mr = 0;
            if (MASKED) mask_params(1, tok0 + 64 * t, g ? tq1 : tq0, hi, mb, mr);
            exp_tile<MASKED>(p[g][0], p[g][1], lsum[g], pf, mb, mr, 1);
            pv_half(o[g][0], vfa, pf); pv_half(o[g][1], vfb, pf);
        }
    }
#undef D64_LANE
#undef D64_LD
#undef D64_ST
}
__device__ __forceinline__ void dense64_lag_loop(LAS char* lds, const unsigned char* Kg, const bf16_t* Vg, int ld  , int ntiles,
                                                 const u32x4 (&qr)[2][2], f32x16 (&o)[2][2], float (&lsum)[2], int lane_, int wave, const bool lag) {
    constexpr int V2_OFF = 2 * KTILE;
    u32x2 kreg; u32x4 vreg;
#define D64_LANE() int ln_ = lane_; asm volatile("" : "+v"(ln_)); const int tid_ = wave * 64 + ln_, srow = tid_ >> 3, sch = tid_ & 7
#define D64_LD(t) do { D64_LANE(); const int tk_ = 64 * (t) + srow; kreg = *(const u32x2*)(Kg + (size_t)tk_ * ld + sch * 8); vreg = *(const u32x4*)(Vg + (size_t)tk_ * ld + sch * 8); } while (0)
#define D64_ST(t) do { D64_LANE(); *(LAS u32x2*)(lds + ((t) & 1) * KTILE + srow * KSTR + sch * 8) = kreg; *(LAS u32x4*)(lds + V2_OFF + ((t) % 3) * VTILE + srow * VSTR + sch * 16) = vreg; } while (0)
#define D64_QK(t) do { int lane = lane_; asm volatile("" : "+v"(lane)); const int klane = (lane & 31) * KSTR + 32 * (lane >> 5); u32x4 kf[2][2]; LAS const char* kb_ = lds + ((t) & 1) * KTILE + klane; \
        _Pragma("unroll") for (int blk = 0; blk < 2; ++blk) _Pragma("unroll") for (int e = 0; e < 2; ++e) kf[blk][e] = *(const LAS u32x4*)(kb_ + 32 * blk * KSTR + 16 * e); \
        qk_tile(p[0][0], p[0][1], kf, qr[0]); qk_tile(p[1][0], p[1][1], kf, qr[1]); } while (0)
#define D64_PV(t) do { int lane = lane_; asm volatile("" : "+v"(lane)); const int hi = lane >> 5; const int vlane = (4 * hi + ((lane & 15) >> 2)) * VSTR + (16 * ((lane >> 4) & 1) + 4 * (lane & 3)) * 2; \
        bf16x8 vfa[4], vfb[4]; LAS const char* vb_ = lds + V2_OFF + ((t) % 3) * VTILE + vlane; vread(vfa, vb_, 0); vread(vfb, vb_, 1); \
        _Pragma("unroll") for (int g = 0; g < 2; ++g) { bf16x8 pf[2][2]; exp_tile<false>(p[g][0], p[g][1], lsum[g], pf, 0, 0, 0); pv_half(o[g][0], vfa, pf); pv_half(o[g][1], vfb, pf); } } while (0)
    f32x16 p[2][2];
    D64_LD(0); D64_ST(0);
    if (!lag) {
        D64_LD(1);
        for (int t = 0; t < ntiles; ++t) {
            __syncthreads();
            if (t + 1 < ntiles) D64_ST(t + 1);
            if (t + 2 < ntiles) D64_LD(t + 2);
            D64_QK(t);
            D64_PV(t);
        }
        __syncthreads();
    } else {
        D64_LD(1);
        __syncthreads();
        D64_ST(1); D64_LD(2);
        D64_QK(0);
        for (int t = 1; t < ntiles; ++t) {
            __syncthreads();
            if (t + 1 < ntiles) D64_ST(t + 1);
            if (t + 2 < ntiles) D64_LD(t + 2);
            D64_PV(t - 1);
            __builtin_amdgcn_sched_barrier(0);
            D64_QK(t);
        }
        __syncthreads();
        D64_PV(ntiles - 1);
    }
#undef D64_LANE
#undef D64_LD
#undef D64_ST
#undef D64_QK
#undef D64_PV
}
__device__ __forceinline__ void priv_kload(u32x4 (&kf)[2][2], const unsigned char* Kg, int ld, int tk0, int dk, int lane_) {
    int lane = lane_; asm volatile("" : "+v"(lane));
    const int hi = lane >> 5;
#pragma unroll
    for (int blk = 0; blk < 2; ++blk) { const int tk = clamp_tok(tk0 + dk * (32 * blk + (lane & 31)));
#pragma unroll
        for (int e = 0; e < 2; ++e) kf[blk][e] = *(const u32x4*)(Kg + (size_t)tk * ld + 32 * hi + 16 * e); }
}
__device__ __forceinline__ void priv2_step(u32x4 (&kf)[2][2], LAS char* vpriv, const unsigned char* Kg, const bf16_t* Vg, int ld, int tk0, int dk, bool g0, bool g1,
                                           bool has_next, int tk0n, int dkn, const u32x4 (&qr)[2][2], f32x16 (&o)[2][2], float (&lsum)[2], int tq0, int tq1, int lane_) {
    int lane = lane_; asm volatile("" : "+v"(lane));
    const int hi = lane >> 5;
    const int vlane = (4 * hi + ((lane & 15) >> 2)) * VSTR + (16 * ((lane >> 4) & 1) + 4 * (lane & 3)) * 2;
    u32x4 vr[8];
#pragma unroll
    for (int i = 0; i < 8; ++i) { const int idx = i * 64 + lane, row = idx >> 3, ch = idx & 7; const int tk = clamp_tok(tk0 + dk * row); vr[i] = *(const u32x4*)(Vg + (size_t)tk * ld + ch * 8); }
    const int gfirst = g0 ? 0 : 1, glast = g1 ? 1 : 0;
    f32x16 p0, p1; bf16x8 pf[2][2]; int mb, mr;
    if (gfirst == 0) qk_tile(p0, p1, kf, qr[0]); else qk_tile(p0, p1, kf, qr[1]);
    __builtin_amdgcn_sched_barrier(0);
#pragma unroll
    for (int i = 0; i < 8; ++i) { const int idx = i * 64 + lane; *(LAS u32x4*)(vpriv + (idx >> 3) * VSTR + (idx & 7) * 16) = vr[i]; }
    if (glast == gfirst) { __builtin_amdgcn_sched_barrier(0); if (has_next) priv_kload(kf, Kg, ld, tk0n, dkn, lane); __builtin_amdgcn_sched_barrier(0); }
    mask_params(dk, tk0, gfirst ? tq1 : tq0, hi, mb, mr);
    if (gfirst == 0) exp_tile<true>(p0, p1, lsum[0], pf, mb, mr, dk); else exp_tile<true>(p0, p1, lsum[1], pf, mb, mr, dk);
    { bf16x8 vfa[4], vfb[4]; vread(vfa, vpriv + vlane, 0); vread(vfb, vpriv + vlane, 1);
      if (gfirst == 0) { pv_half(o[0][0], vfa, pf); pv_half(o[0][1], vfb, pf); } else { pv_half(o[1][0], vfa, pf); pv_half(o[1][1], vfb, pf); } }
    if (glast != gfirst) {
        qk_tile(p0, p1, kf, qr[1]);
        __builtin_amdgcn_sched_barrier(0);
        if (has_next) priv_kload(kf, Kg, ld, tk0n, dkn, lane);
        __builtin_amdgcn_sched_barrier(0);
        mask_params(dk, tk0, tq1, hi, mb, mr);
        exp_tile<true>(p0, p1, lsum[1], pf, mb, mr, dk);
        bf16x8 vfa[4], vfb[4]; vread(vfa, vpriv + vlane, 0); vread(vfb, vpriv + vlane, 1);
        pv_half(o[1][0], vfa, pf); pv_half(o[1][1], vfb, pf);
    }
}
__device__ __forceinline__ void store_out(const f32x16 (&o)[2], float lsum, unsigned char* dst  , int lane_) {
    int lane = lane_; asm volatile("" : "+v"(lane));
    const int hi = lane >> 5;
    float l = lsum + shx(lsum, 32, lane);
    const float inv = A8S / l;
#pragma unroll
    for (int d0 = 0; d0 < 2; ++d0) {
        unsigned pc[4];
#pragma unroll
        for (int g = 0; g < 4; ++g) pc[g] = pack4_fp8(o[d0][4 * g] * inv, o[d0][4 * g + 1] * inv, o[d0][4 * g + 2] * inv, o[d0][4 * g + 3] * inv);
        const auto s0 = __builtin_amdgcn_permlane32_swap(pc[0], pc[2], false, false), s1 = __builtin_amdgcn_permlane32_swap(pc[1], pc[3], false, false);
        u32x4 w; w.x = s0[0]; w.y = s0[1]; w.z = s1[0]; w.w = s1[1];
        *(u32x4*)(dst + 32 * d0 + 16 * hi) = w;
    }
}
}

struct Args { const float* in[18]; float* out; unsigned char* ws; int ph_lo, ph_hi; };
constexpr int PH_PRO = 0, PH_L0 = 1, PH_PER_LAYER = 9, PH_FINAL = PH_L0 + 2 * PH_PER_LAYER, NPH = PH_FINAL + 1;
enum { P_NORM1 = 0, P_INPROJ, P_ATTN, P_PAB, P_OUT, P_NORM2, P_PLACE, P_GU, P_DOWN };

__device__ __forceinline__ int tile256_srccol(int P) { const int p = P & 255; return (P & ~255) + 64 * ((p >> 5) & 3) + 16 * ((p >> 3) & 3) + 8 * (p >> 7) + (p & 7); }
template <int MAP, bool W8 = false>
__device__ __forceinline__ void transpose_item(const float* W, int N, int col0, bf16_t* dst, int dst_row0, int K, int k0, LAS float* scr, int lane, int dk0 = 0  ) {
    const int sc = (MAP == 1) ? inproj_srccol(col0 + lane) : (MAP == 2) ? tile256_srccol(col0 + lane) : col0 + lane;
    const float* src = W + (size_t)k0 * N + sc;
#pragma unroll 16
    for (int i = 0; i < 64; ++i) scr[i * 65 + lane] = src[(size_t)i * N];
    asm volatile("s_waitcnt lgkmcnt(0)" ::: "memory");
    const int c = lane & 7, nn = lane >> 3;
#pragma unroll
    for (int j = 0; j < 8; ++j) { const int n = nn + 8 * j; const LAS float* s = scr + (8 * c) * 65 + n;
        if (W8) { u32x2 w; w.x = pack4_fp8(s[0] * W8S, s[65] * W8S, s[2 * 65] * W8S, s[3 * 65] * W8S); w.y = pack4_fp8(s[4 * 65] * W8S, s[5 * 65] * W8S, s[6 * 65] * W8S, s[7 * 65] * W8S);
            *(u32x2*)((unsigned char*)dst + (size_t)(dst_row0 + n) * K + dk0 + k0 + 8 * c) = w; continue; }
        u32x4 w; w.x = cvt_pk_bf16(s[0], s[65]); w.y = cvt_pk_bf16(s[2 * 65], s[3 * 65]); w.z = cvt_pk_bf16(s[4 * 65], s[5 * 65]); w.w = cvt_pk_bf16(s[6 * 65], s[7 * 65]);
        *(u32x4*)(dst + (size_t)(dst_row0 + n) * K + dk0 + k0 + 8 * c) = w; }
    asm volatile("s_waitcnt lgkmcnt(0)" ::: "memory");
}


template <bool XF32, bool COMBINE, bool NORM, bool ROUTER, bool OUTF32, bool H8 = false>
__device__ __forceinline__ void row_phase(LAS unsigned char* lds, int tid, int lane, int wave, int G, int bx, const float* xf, bf16_t* xb, float* outf, const float* gv,
                                          const float* modl, int sh_off, int sc_off, const float* modprev, bf16_t* Hh, const unsigned char* Ym, const int* Pos, float* Tw,
                                          const bf16_t* Wr, int* Te, int* Trk, int* Cnt) {
    constexpr int RB = COMBINE ? 2 : ROWB;
    LAS float* lgs = (LAS float*)lds;
    LAS int* lcnt = (LAS int*)(lds + 40960);
    asm volatile("" : "+v"(tid), "+v"(lane));
    for (int chunk = bx; chunk < 256; chunk += G) {
        const int b = chunk >> 3;
        if (ROUTER) { if (tid < 32) lcnt[tid] = 0; }
        f32x4 pre[4], shv[4], g2[4];
#pragma unroll
        for (int j = 0; j < 4; ++j) { const int col = 512 * (j >> 1) + 8 * lane + 4 * (j & 1);
            if (NORM) { const f32x4 gg = *(const f32x4*)(gv + col), sc = *(const f32x4*)(modl + (size_t)b * MODW + sc_off + col);
                pre[j] = gg * (1.0f + sc); shv[j] = *(const f32x4*)(modl + (size_t)b * MODW + sh_off + col); }
            if (COMBINE) g2[j] = *(const f32x4*)(modprev + (size_t)b * MODW + 5 * DM + col); }
        f32x4 rawf[XF32 ? RB : 1][4]; u32x4 rawb[XF32 ? 1 : RB][2]; int pp[COMBINE ? RB : 1][2]; float pw[COMBINE ? RB : 1][2];
#define ROW_LOAD(rb_) do { _Pragma("unroll") for (int i = 0; i < RB; ++i) { const size_t ro = (size_t)((rb_) + i) * DM; \
            if (XF32) { _Pragma("unroll") for (int j = 0; j < 4; ++j) rawf[XF32 ? i : 0][j] = *(const f32x4*)(xf + ro + 512 * (j >> 1) + 8 * lane + 4 * (j & 1)); } \
            else { _Pragma("unroll") for (int h = 0; h < 2; ++h) rawb[XF32 ? 0 : i][h] = *(const u32x4*)(xb + ro + 512 * h + 8 * lane); } \
            if (COMBINE) { pp[COMBINE ? i : 0][0] = Pos[2 * ((rb_) + i)]; pp[COMBINE ? i : 0][1] = Pos[2 * ((rb_) + i) + 1]; pw[COMBINE ? i : 0][0] = Tw[2 * ((rb_) + i)]; pw[COMBINE ? i : 0][1] = Tw[2 * ((rb_) + i) + 1]; } } } while (0)
        ROW_LOAD(chunk * 256 + wave * 32);
#pragma unroll 1
        for (int r0 = 0; r0 < 32; r0 += RB) {
            const int rowb = chunk * 256 + wave * 32 + r0;
            f32x4 v[RB][4]; int cp[COMBINE ? RB : 1][2]; float cw[COMBINE ? RB : 1][2];
#pragma unroll
            for (int i = 0; i < RB; ++i) {
                if (XF32) {
#pragma unroll
                    for (int j = 0; j < 4; ++j) v[i][j] = rawf[XF32 ? i : 0][j];
                } else {
#pragma unroll
                    for (int h = 0; h < 2; ++h) { const u32x4 w = rawb[XF32 ? 0 : i][h];
                        v[i][2 * h] = (f32x4){bf_lo(w.x), bf_hi(w.x), bf_lo(w.y), bf_hi(w.y)}; v[i][2 * h + 1] = (f32x4){bf_lo(w.z), bf_hi(w.z), bf_lo(w.w), bf_hi(w.w)}; }
                }
                if (COMBINE) { cp[i][0] = pp[i][0]; cp[i][1] = pp[i][1]; cw[i][0] = pw[i][0]; cw[i][1] = pw[i][1]; }
            }
            u32x2 ya[COMBINE ? RB : 1][2], yc[COMBINE ? RB : 1][2];
            if (COMBINE) {
#pragma unroll
                for (int i = 0; i < RB; ++i)
#pragma unroll
                    for (int h = 0; h < 2; ++h) { ya[i][h] = *(const u32x2*)(Ym + (size_t)cp[i][0] * DM + 512 * h + 8 * lane); yc[i][h] = *(const u32x2*)(Ym + (size_t)cp[i][1] * DM + 512 * h + 8 * lane); }
            }
            if (r0 + RB < 32) ROW_LOAD(rowb + RB);
            if (COMBINE) {
#pragma unroll
                for (int i = 0; i < RB; ++i) {
                    const int row = rowb + i; const float w0 = cw[i][0], w1 = cw[i][1];
#pragma unroll
                    for (int h = 0; h < 2; ++h) { float fa[8], fc[8]; unpack8_fp8(ya[i][h], fa); unpack8_fp8(yc[i][h], fc);
                        const f32x4 m0 = {w0 * fa[0] + w1 * fc[0], w0 * fa[1] + w1 * fc[1], w0 * fa[2] + w1 * fc[2], w0 * fa[3] + w1 * fc[3]};
                        const f32x4 m1 = {w0 * fa[4] + w1 * fc[4], w0 * fa[5] + w1 * fc[5], w0 * fa[6] + w1 * fc[6], w0 * fa[7] + w1 * fc[7]};
                        v[i][2 * h] = v[i][2 * h] + g2[2 * h] * m0; v[i][2 * h + 1] = v[i][2 * h + 1] + g2[2 * h + 1] * m1;
                        if (OUTF32) { *(f32x4*)(outf + (size_t)row * DM + 512 * h + 8 * lane) = v[i][2 * h]; *(f32x4*)(outf + (size_t)row * DM + 512 * h + 8 * lane + 4) = v[i][2 * h + 1]; }
                        else *(u32x4*)(xb + (size_t)row * DM + 512 * h + 8 * lane) = pg8::pack8(v[i][2 * h], v[i][2 * h + 1]); }
                }
            }
            if (NORM) {
                float ss[RB];
#pragma unroll
                for (int i = 0; i < RB; ++i) { ss[i] = 0.f;
#pragma unroll
                    for (int j = 0; j < 4; ++j) { const f32x4 q = v[i][j] * v[i][j]; ss[i] += (q[0] + q[1]) + (q[2] + q[3]); } }
#pragma unroll
                for (int o = 1; o < 64; o <<= 1)
#pragma unroll
                    for (int i = 0; i < RB; ++i) ss[i] += shx(ss[i], o, lane);
#pragma unroll
                for (int i = 0; i < RB; ++i) { const float rstd = __builtin_amdgcn_rsqf(ss[i] * (1.0f / DM) + 1e-6f);
#pragma unroll
                    for (int h = 0; h < 2; ++h) { const f32x4 h0 = v[i][2 * h] * rstd * pre[2 * h] + shv[2 * h], h1 = v[i][2 * h + 1] * rstd * pre[2 * h + 1] + shv[2 * h + 1];
                        if (H8) *(u32x2*)((unsigned char*)Hh + (size_t)(rowb + i) * DM + 512 * h + 8 * lane) = (u32x2){pack4_fp8(h0[0], h0[1], h0[2], h0[3]), pack4_fp8(h1[0], h1[1], h1[2], h1[3])};
                        else *(u32x4*)(Hh + (size_t)(rowb + i) * DM + 512 * h + 8 * lane) = pg8::pack8(h0, h1); } }
            }
        }
#undef ROW_LOAD
        if (ROUTER) {
            __syncthreads();
            const int row0 = chunk * 256 + wave * 32;
            f32x4 ra[2][2];
#pragma unroll
            for (int mt = 0; mt < 2; ++mt)
#pragma unroll
                for (int et = 0; et < 2; ++et) ra[mt][et] = (f32x4){0.f, 0.f, 0.f, 0.f};
#pragma unroll 4
            for (int kk = 0; kk < 32; ++kk) {
                bf16x8 a[2], bb[2];
#pragma unroll
                for (int mt = 0; mt < 2; ++mt) a[mt] = *(const bf16x8*)(Hh + (size_t)(row0 + 16 * mt + (lane & 15)) * DM + 32 * kk + 8 * (lane >> 4));
#pragma unroll
                for (int et = 0; et < 2; ++et) bb[et] = *(const bf16x8*)(Wr + (size_t)(16 * et + (lane & 15)) * DM + 32 * kk + 8 * (lane >> 4));
#pragma unroll
                for (int mt = 0; mt < 2; ++mt)
#pragma unroll
                    for (int et = 0; et < 2; ++et) ra[mt][et] = __builtin_amdgcn_mfma_f32_16x16x32_bf16(a[mt], bb[et], ra[mt][et], 0, 0, 0);
            }
#pragma unroll
            for (int mt = 0; mt < 2; ++mt)
#pragma unroll
                for (int et = 0; et < 2; ++et)
#pragma unroll
                    for (int r = 0; r < 4; ++r) lgs[(wave * 32 + 16 * mt + 4 * (lane >> 4) + r) * 33 + 16 * et + (lane & 15)] = ra[mt][et][r];
            asm volatile("s_waitcnt lgkmcnt(0)" ::: "memory");
            if (lane < 32) {
                const int tl = wave * 32 + lane, tok = chunk * 256 + tl;
                float lg[32]; float M = -3.0e38f;
#pragma unroll
                for (int e = 0; e < 32; ++e) { lg[e] = lgs[tl * 33 + e]; M = fmaxf(M, lg[e]); }
                float bm1 = 0.f, bm2 = 0.f, bsc = -1.f; int bi1 = 0, bi2 = 0, bg = 0;
#pragma unroll
                for (int g = 0; g < 4; ++g) {
                    float m1 = -3.0e38f, m2 = -3.0e38f; int i1 = 0, i2 = 0;
#pragma unroll
                    for (int j = 0; j < 8; ++j) { const float vv = lg[8 * g + j];
                        if (vv > m1) { m2 = m1; i2 = i1; m1 = vv; i1 = j; } else if (vv > m2) { m2 = vv; i2 = j; } }
                    const float sc = expf(m1 - M) + expf(m2 - M);
                    if (sc > bsc) { bsc = sc; bg = g; bm1 = m1; bm2 = m2; bi1 = i1; bi2 = i2; }
                }
                const int e0 = 8 * bg + bi1, e1 = 8 * bg + bi2;
                const float w0 = 1.0f / (1.0f + expf(bm2 - bm1)), w1 = 1.0f - w0;
                const int r0 = __hip_atomic_fetch_add(&lcnt[e0], 1, __ATOMIC_RELAXED, __HIP_MEMORY_SCOPE_WORKGROUP);
                const int r1 = __hip_atomic_fetch_add(&lcnt[e1], 1, __ATOMIC_RELAXED, __HIP_MEMORY_SCOPE_WORKGROUP);
                Te[2 * tok] = e0; Te[2 * tok + 1] = e1; Trk[2 * tok] = r0; Trk[2 * tok + 1] = r1; Tw[2 * tok] = w0; Tw[2 * tok + 1] = w1;
            }
            __syncthreads();
            if (tid < 32) Cnt[chunk * 32 + tid] = lcnt[tid];
            __syncthreads();
        }
    }
}

#define x_in ((const float*)(const GAS float*)args.in[0])
#define c_in ((const float*)(const GAS float*)args.in[1])
#define w_ada ((const float*)(const GAS float*)args.in[2])
#define b_ada ((const float*)(const GAS float*)args.in[3])
#define g_mix ((const float*)(const GAS float*)args.in[4])
#define w_in ((const float*)(const GAS float*)args.in[5])
#define qn_a ((const float*)(const GAS float*)args.in[6])
#define kn_a ((const float*)(const GAS float*)args.in[7])
#define qn_b ((const float*)(const GAS float*)args.in[8])
#define kn_b ((const float*)(const GAS float*)args.in[9])
#define w_pa ((const float*)(const GAS float*)args.in[10])
#define w_pb ((const float*)(const GAS float*)args.in[11])
#define w_out ((const float*)(const GAS float*)args.in[12])
#define g_ffn ((const float*)(const GAS float*)args.in[13])
#define w_router ((const float*)(const GAS float*)args.in[14])
#define w_gate ((const float*)(const GAS float*)args.in[15])
#define w_up ((const float*)(const GAS float*)args.in[16])
#define w_down ((const float*)(const GAS float*)args.in[17])
#define MOD ((float*)(GAS float*)(ws + WS_MOD))
#define XB ((bf16_t*)(GAS bf16_t*)(ws + WS_XB))
#define TE ((int*)(GAS int*)(ws + WS_TE))
#define TRK ((int*)(GAS int*)(ws + WS_TRK))
#define TW ((float*)(GAS float*)(ws + WS_TW))
#define POS ((int*)(GAS int*)(ws + WS_POS))
#define CNT ((int*)(GAS int*)(ws + WS_CNT))
#define BLKE ((int*)(GAS int*)(ws + WS_BLKE))
#define BTOK ((int*)(GAS int*)(ws + WS_BTOK))
#define WR ((bf16_t*)(bf16_t*)(GAS bf16_t*)(ws + WS_WR))
#define H ((bf16_t*)(bf16_t*)(GAS bf16_t*)(ws + WS_H))
#define YAB ((bf16_t*)(GAS bf16_t*)(ws + WS_H))
#define YA ((bf16_t*)(bf16_t*)(GAS bf16_t*)(ws + WS_H))
#define YB ((bf16_t*)(bf16_t*)(GAS bf16_t*)(ws + WS_H + 64 * MiB))
#define QA ((bf16_t*)(bf16_t*)(GAS bf16_t*)(ws + WS_QKV))
#define KA ((bf16_t*)(bf16_t*)(GAS bf16_t*)(ws + WS_QKV + 64 * MiB))
#define VA ((bf16_t*)(bf16_t*)(GAS bf16_t*)(ws + WS_QKV + 128 * MiB))
#define QB ((bf16_t*)(bf16_t*)(GAS bf16_t*)(ws + WS_QKV + 192 * MiB))
#define KB ((bf16_t*)(bf16_t*)(GAS bf16_t*)(ws + WS_QKV + 256 * MiB))
#define VB ((bf16_t*)(bf16_t*)(GAS bf16_t*)(ws + WS_QKV + 272 * MiB))
#define MERGED ((bf16_t*)(bf16_t*)(GAS bf16_t*)(ws + WS_QKV))
#define YM ((unsigned char*)(GAS unsigned char*)(ws + WS_QKV))
#define SA ((bf16_t*)(bf16_t*)(GAS bf16_t*)(ws + WS_GATE))
#define SB ((bf16_t*)(bf16_t*)(GAS bf16_t*)(ws + WS_GATE + 128 * MiB))
#define ACT ((bf16_t*)(bf16_t*)(GAS bf16_t*)(ws + WS_GATE))
#define PHASE_ENTER() int lane; asm volatile("v_mbcnt_lo_u32_b32 %0, -1, 0\n\tv_mbcnt_hi_u32_b32 %0, -1, %0" : "=v"(lane)); const int tid = wave * 64 + lane; GAS unsigned char* ws = ws0; int bx = bx0, vcu = vcu0; asm volatile("" : "+s"(ws), "+s"(bx), "+s"(vcu))

__device__ __forceinline__ bool in_phase(int lo, int hi, int k) { asm volatile("" : "+s"(lo), "+s"(hi)); return lo <= k && k < hi; }
#define PGATE_A SA
#define PGATE_B SB
__global__ void __launch_bounds__(512, 2) fwd_kernel(Args args) {
    extern __shared__ __attribute__((aligned(16))) unsigned char lds_raw[];
    LAS unsigned char* lds = (LAS unsigned char*)lds_raw;
    volatile LAS unsigned* MISC = (volatile LAS unsigned*)(lds + MISC_OFF);
    const int tid0 = threadIdx.x, lane0 = tid0 & 63, wave = __builtin_amdgcn_readfirstlane(tid0 >> 6);
    const int G = gridDim.x, bx0 = blockIdx.x;
    const int vcu0 = (G % 8 == 0) ? (bx0 % 8) * (G / 8) + bx0 / 8 : bx0;
    GAS unsigned char* ws0 = (GAS unsigned char*)args.ws;
    float* out = (float*)(GAS float*)args.out;
    for (int u = tid0; u < 256; u += 512) ((LAS unsigned*)(lds + MISC_OFF))[u] = 0u;
    __syncthreads();
#if MK_ONE_LAUNCH
    XcdBarrier bar = xcd_barrier_post((unsigned*)((GAS unsigned*)(ws0 + WS_CTL) + CW_BAR), MISC + 8);
#define GRID_BAR() do { int l_; asm volatile("v_mbcnt_lo_u32_b32 %0, -1, 0\n\tv_mbcnt_hi_u32_b32 %0, -1, %0" : "=v"(l_)); xcd_barrier(bar, (wave == 0) && (l_ == 0)); } while (0)
#else
#define GRID_BAR() do {} while (0)
#endif
#ifndef PHMASK
#define PHMASK 0xFFFFFFFFu
#endif
#if MK_ONE_LAUNCH
#define IN(k) true
#else
#define IN(k) in_phase(args.ph_lo, args.ph_hi, (k))
#endif
#define EN(bit) ((PHMASK >> (bit)) & 1u)
#define SEAM(k) do { if (IN(k) && IN((k) + 1)) GRID_BAR(); } while (0)

    if (EN(0) && IN(PH_PRO)) {
        PHASE_ENTER();
#pragma unroll 1
        for (int rep = 0; rep < REP_PRO; ++rep) {
        LAS float* scr = (LAS float*)(lds + wave * 16640);
        const int gw = vcu * 8 + wave, NGW = G * 8;
        constexpr int I_IN = 68 * 16, I_PA = 16 * 8, I_OUT = 16 * 16, I_GU = 32 * 2 * 8 * 16, I_DN = 32 * 16 * 8;
        constexpr int I_LAYER = I_IN + 2 * I_PA + I_OUT + I_GU + I_DN;
        for (int it = gw; it < 2 * I_LAYER; it += NGW) {
            const int l = it / I_LAYER; int r = it % I_LAYER;
            if (r < I_IN) { const int nb = r / 16, kb = r % 16;
                transpose_item<1, true>(w_in + (size_t)l * DM * NC, NC, 64 * nb, (bf16_t*)(GAS bf16_t*)(ws + WS_WIN + l * WIN_BYTES), 64 * nb, DM, 64 * kb, scr, lane); continue; } r -= I_IN;
            if (r < I_PA) { const int nb = r / 8, kb = r % 8;
                transpose_item<2, true>(w_pa + (size_t)l * 512 * DM, DM, 64 * nb, (bf16_t*)(GAS bf16_t*)(ws + WS_WPA + l * 2 * MiB), 64 * nb, DM, 64 * kb, scr, lane, 0); continue; } r -= I_PA;
            if (r < I_PA) { const int nb = r / 8, kb = r % 8;
                transpose_item<2, true>(w_pb + (size_t)l * 512 * DM, DM, 64 * nb, (bf16_t*)(GAS bf16_t*)(ws + WS_WPA + l * 2 * MiB), 64 * nb, DM, 64 * kb, scr, lane, 512); continue; } r -= I_PA;
            if (r < I_OUT) { const int nb = r / 16, kb = r % 16;
                transpose_item<2, true>(w_out + (size_t)l * DM * DM, DM, 64 * nb, (bf16_t*)(GAS bf16_t*)(ws + WS_WOUT + l * 2 * MiB), 64 * nb, DM, 64 * kb, scr, lane); continue; } r -= I_OUT;
            if (r < I_GU) { const int e = r / 256, q = r % 256, up = q / 128, nb = (q % 128) / 16, kb = q % 16;
                const float* src = (up ? w_up : w_gate) + ((size_t)l * NEXP + e) * DM * DFF;
                const int c0 = 64 * nb, drow = 256 * (c0 >> 7) + 128 * up + (c0 & 127);
                transpose_item<0>(src, DFF, c0, (bf16_t*)(GAS bf16_t*)(ws + WS_WGU + ((size_t)l * NEXP + e) * 2 * MiB), drow, DM, 64 * kb, scr, lane); continue; } r -= I_GU;
            { const int e = r / 128, q = r % 128, nb = q / 8, kb = q % 8;
                transpose_item<2>(w_down + ((size_t)l * NEXP + e) * DFF * DM, DM, 64 * nb, (bf16_t*)(GAS bf16_t*)(ws + WS_WDN + ((size_t)l * NEXP + e) * MiB), 64 * nb, DFF, 64 * kb, scr, lane); }
        }
        for (int i = (vcu * 512 + tid); i < 32 * DM; i += G * 512) { const int e = i >> 10, k = i & 1023; WR[i] = (bf16_t)(cvt_pk_bf16(w_router[(size_t)k * NEXP + e], 0.f) & 0xffffu); }
        __syncthreads();
        if (vcu * 8 < 384) {
            LAS float* cond = (LAS float*)lds;
            for (int i = tid; i < NB * DM; i += 512) { const int b = i >> 10, k = i & 1023; const float cv = c_in[i]; cond[k * 32 + b] = cv / (1.0f + expf(-cv)); }
            __syncthreads();
            for (int it = gw; it < 384; it += NGW) {
                const int l = it / 192, n0 = (it % 192) * 32;
                const float* wp = w_ada + (size_t)l * DM * MODW + n0 + (lane & 31) + (size_t)(lane >> 5) * MODW;
                const LAS float* cp = cond + (lane >> 5) * 32 + (lane & 31);
                f32x16 acc;
#pragma unroll
                for (int r = 0; r < 16; ++r) acc[r] = 0.f;
#pragma unroll 16
                for (int k0 = 0; k0 < DM; k0 += 2) acc = __builtin_amdgcn_mfma_f32_32x32x2f32(cp[k0 * 32], wp[(size_t)k0 * MODW], acc, 0, 0, 0);
                const float bias = b_ada[l * MODW + n0 + (lane & 31)];
#pragma unroll
                for (int r = 0; r < 16; ++r) { const int b = (r & 3) + 8 * (r >> 2) + 4 * (lane >> 5); MOD[((size_t)l * NB + b) * MODW + n0 + (lane & 31)] = acc[r] + bias; }
            }
        }
        __syncthreads();
        }
    }
    SEAM(PH_PRO);

    for (int l = 0; l < 2; ++l) {
        const int pb = PH_L0 + l * PH_PER_LAYER;
        if (EN(1) && IN(pb + P_NORM1)) { PHASE_ENTER(); const float* modl = MOD + (size_t)l * NB * MODW;
            if (l == 0) {
#pragma unroll 1
                for (int rep = 0; rep < REP_NORM1; ++rep)
                    row_phase<true, false, true, false, false, true>(lds, tid, lane, wave, G, bx, x_in, XB, out, g_mix, modl, 0, DM, MOD, H, YM, POS, TW, WR, TE, TRK, CNT);
            } else row_phase<false, true, true, false, false, true>(lds, tid, lane, wave, G, bx, x_in, XB, out, g_mix + DM, modl, 0, DM, MOD, H, YM, POS, TW, WR, TE, TRK, CNT); }
            {
                SEAM(pb + P_NORM1);
                if (EN(2) && IN(pb + P_INPROJ)) {
                    PHASE_ENTER();
                    pg8::Gemm g{H, (const bf16_t*)(const GAS bf16_t*)(ws + WS_WIN + l * WIN_BYTES), DM / 2}; pg8::StaticOrder S; S.init(TT, NC, G, bx); S.wgm = INPROJ_WGM;
                    LAS float* normw = (LAS float*)(lds + MISC_OFF + 1024);
                    if (tid < 256) { const int sel = tid >> 6, d = tid & 63; const float* srcw = (sel == 0) ? qn_a : (sel == 1) ? kn_a : (sel == 2) ? qn_b : kn_b; normw[tid] = srcw[l * 64 + d]; }
                    __syncthreads();
                    pg8::EpiInProj E{QA, KA, VA, QB, KB, VB, SA, SB, normw};
#pragma unroll 1
                    for (int rep = 0; rep < REP_INPROJ; ++rep)
                    pg8::gemm_phase<pg8::EpiInProj, pg8::StaticOrder, true>(lds, g, S, E, wave);
                }
                SEAM(pb + P_INPROJ);
                if (EN(3) && IN(pb + P_ATTN)) {
                    PHASE_ENTER(); (void)lane;
                    LAS char* ring = (LAS char*)lds;
#pragma unroll 1
                    for (int rep = 0; rep < REP_ATTB; ++rep)
                    for (int L = vcu; L < NB * 32; L += G) {
                        int lane; asm volatile("v_mbcnt_lo_u32_b32 %0, -1, 0\n\tv_mbcnt_hi_u32_b32 %0, -1, %0" : "=v"(lane)); const int hi = lane >> 5;
                        const int b = L >> 5, kvh = (L >> 4) & 1, qh = 4 * kvh + ((L >> 2) & 3), qb2 = L & 3;
                        const int tq0 = 512 * qb2 + 64 * wave + (lane & 31);
                        u32x4 qr[2][2];
#pragma unroll
                        for (int g = 0; g < 2; ++g)
#pragma unroll
                            for (int e = 0; e < 2; ++e) qr[g][e] = *(const u32x4*)((const unsigned char*)QB + ((size_t)b * SEQ + tq0 + 32 * g) * 512 + qh * 64 + 32 * hi + 16 * e);
                        f32x16 o[2][2]; float lsum[2] = {0.f, 0.f};
#pragma unroll
                        for (int r = 0; r < 16; ++r) { o[0][0][r] = 0.f; o[0][1][r] = 0.f; o[1][0][r] = 0.f; o[1][1][r] = 0.f; }
                        __syncthreads();
                        att::dense64_lag_loop(ring, (const unsigned char*)KB + (size_t)b * SEQ * 128 + kvh * 64, VB + (size_t)b * SEQ * 128 + kvh * 64, 128, 32, qr, o, lsum, lane, wave, wave >= 4);
                        { int l2; asm volatile("v_mbcnt_lo_u32_b32 %0, -1, 0\n\tv_mbcnt_hi_u32_b32 %0, -1, %0" : "=v"(l2)); const int tqs = 512 * qb2 + 64 * wave + (l2 & 31);
#pragma unroll
                          for (int g = 0; g < 2; ++g) att::store_out(o[g], lsum[g], (unsigned char*)YAB + ((size_t)b * SEQ + tqs + 32 * g) * DM + 512 + qh * 64, l2); }
                    }
#pragma unroll 1
                    for (int rep = 0; rep < REP_ATTA; ++rep)
                    for (int L = vcu; L < NB * 32; L += G) {
                        int lane; asm volatile("v_mbcnt_lo_u32_b32 %0, -1, 0\n\tv_mbcnt_hi_u32_b32 %0, -1, %0" : "=v"(lane)); const int hi = lane >> 5;
                        const int b = L >> 5, h = (L >> 2) & 7, tb2 = L & 3, base = 512 * tb2;
                        const int tq0 = base + 16 * (lane & 31) + wave, tq1 = tq0 + 8;
                        const unsigned char* Kg = (const unsigned char*)KA + (size_t)b * SEQ * 512 + h * 64; const bf16_t* Vg = VA + (size_t)b * SEQ * 512 + h * 64;
                        u32x4 qr[2][2];
#pragma unroll
                        for (int g = 0; g < 2; ++g)
#pragma unroll
                            for (int e = 0; e < 2; ++e) qr[g][e] = *(const u32x4*)((const unsigned char*)QA + ((size_t)b * SEQ + tq0 + 8 * g) * 512 + h * 64 + 32 * hi + 16 * e);
                        f32x16 o[2][2]; float lsum[2] = {0.f, 0.f};
#pragma unroll
                        for (int r = 0; r < 16; ++r) { o[0][0][r] = 0.f; o[0][1][r] = 0.f; o[1][0][r] = 0.f; o[1][1][r] = 0.f; }
                        __syncthreads();
                        att::dense64_loop<true>(ring, Kg, Vg, 512, base - 64, 10, qr, o, lsum, tq0, tq1, lane, wave);
                        __syncthreads();
                        {
                            LAS char* vpriv = ring + att::PRIV_OFF + wave * att::VTILE;
#define A_TK0(j) ((j) < 4 ? base + wave - 256 + 256 * (j) : wave + 8 * (((j) - 4) >> 1) + 1024 * (((j) - 4) & 1))
#define A_DK(j) ((j) < 4 ? 4 : 16)
                            u32x4 kf[2][2];
                            att::priv_kload(kf, Kg, 512, A_TK0(0), 4, lane);
#pragma unroll 1
                            for (int j = 0; j < 8; ++j) {
                                const bool p2 = j < 4; const int g = (j - 4) >> 1;
                                att::priv2_step(kf, vpriv, Kg, Vg, 512, A_TK0(j), A_DK(j), p2 || g == 0, p2 || g == 1, j + 1 < 8, A_TK0(j + 1), A_DK(j + 1), qr, o, lsum, tq0, tq1, lane);
                            }
#undef A_TK0
#undef A_DK
                        }
                        { int l2; asm volatile("v_mbcnt_lo_u32_b32 %0, -1, 0\n\tv_mbcnt_hi_u32_b32 %0, -1, %0" : "=v"(l2)); const int tqs = base + 16 * (l2 & 31) + wave;
#pragma unroll
                          for (int g = 0; g < 2; ++g) att::store_out(o[g], lsum[g], (unsigned char*)YAB + ((size_t)b * SEQ + tqs + 8 * g) * DM + h * 64, l2); }
                    }
                    __syncthreads();
                }
                SEAM(pb + P_ATTN);
                if (EN(4) && IN(pb + P_PAB)) {
                    PHASE_ENTER();
                    pg8::StaticOrder S; S.init(TT, DM, G, bx); S.wgm = N1K_WGM;
                    pg8::Gemm g{YAB, (const bf16_t*)(const GAS bf16_t*)(ws + WS_WPA + l * 2 * MiB), DM / 2}; pg8::EpiMergeFused E{MERGED, (const unsigned char*)PGATE_A, (const unsigned char*)PGATE_B};
#pragma unroll 1
                    for (int rep = 0; rep < REP_PAB; ++rep)
                    pg8::gemm_phase<pg8::EpiMergeFused, pg8::StaticOrder, true>(lds, g, S, E, wave);
                }
                SEAM(pb + P_PAB);
                if (EN(5) && IN(pb + P_OUT)) {
                    PHASE_ENTER(); const float* modl = MOD + (size_t)l * NB * MODW;
                    pg8::Gemm g{MERGED, (const bf16_t*)(const GAS bf16_t*)(ws + WS_WOUT + l * 2 * MiB), DM / 2}; pg8::StaticOrder S; S.init(TT, DM, G, bx); S.rowmajor = OUT_ROWMAJOR; S.wgm = N1K_WGM;
                    pg8::EpiResidB E{(l == 0) ? x_in : (const float*)nullptr, XB, XB, modl + 2 * DM};
#pragma unroll 1
                    for (int rep = 0; rep < ((l == 0) ? REP_OUT : 1); ++rep)
                    pg8::gemm_phase<pg8::EpiResidB, pg8::StaticOrder, true>(lds, g, S, E, wave);
                }
                SEAM(pb + P_OUT);
            }
        if (EN(6) && IN(pb + P_NORM2)) { PHASE_ENTER(); const float* modl = MOD + (size_t)l * NB * MODW;
#pragma unroll 1
            for (int rep = 0; rep < REP_NORM2; ++rep)
            row_phase<false, false, true, true, false>(lds, tid, lane, wave, G, bx, x_in, XB, out, g_ffn + l * DM, modl, 3 * DM, 4 * DM, MOD, H, YM, POS, TW, WR, TE, TRK, CNT); }
        SEAM(pb + P_NORM2);
        if (EN(7) && IN(pb + P_PLACE)) {
            PHASE_ENTER();
            LAS int* part_tot = (LAS int*)lds;
            LAS int* part_pre = part_tot + 512;
            LAS int* basee = part_pre + 512;
            LAS int* pstart = basee + 32;
            LAS int* pend = pstart + 32;
            LAS int* tote = pend + 32;
            for (int chunk = bx; chunk < 256; chunk += G) {
                { const int e = tid & 31, part = tid >> 5; int st = 0, sp = 0;
                    for (int q = 0; q < 16; ++q) { const int ch = part * 16 + q; const int v = CNT[ch * 32 + e]; st += v; sp += (ch < chunk) ? v : 0; }
                    part_tot[part * 32 + e] = st; part_pre[part * 32 + e] = sp; }
                __syncthreads();
                if (tid < 32) { int st = 0, sp = 0; for (int q = 0; q < 16; ++q) { st += part_tot[q * 32 + tid]; sp += part_pre[q * 32 + tid]; } tote[tid] = st; basee[tid] = sp; }
                __syncthreads();
                if (tid == 0) { int run = 0; for (int e = 0; e < 32; ++e) { const int padded = (tote[e] + 255) & ~255; pstart[e] = run; basee[e] += run; run += padded; pend[e] = run; } }
                __syncthreads();
                { const int tok = chunk * 256 + (tid >> 1), slot = tid & 1; const int e = TE[2 * tok + slot], rk = TRK[2 * tok + slot]; const int dest = basee[e] + rk;
                    BTOK[dest] = tok; POS[2 * tok + slot] = dest; }
                if (chunk < 32) { const int e = chunk; const int from = pstart[e] + tote[e], n = pend[e] - from; if (tid < n) BTOK[from + tid] = 0; }
                if (chunk == 0) {
                    for (int blk = tid; blk < NBLK; blk += 512) { int e = 0; for (int q = 0; q < 32; ++q) e += (pend[q] <= blk * 256) ? 1 : 0; BLKE[blk] = e > 31 ? 31 : e; }
                    if (tid == 0) BLKE[1000] = pend[31] >> 8;
                }
                __syncthreads();
            }
        }
        SEAM(pb + P_PLACE);
        if (EN(8) && IN(pb + P_GU)) {
            PHASE_ENTER();
            const int nused = BLKE[1000];
            pg8::Gemm g{H, (const bf16_t*)(const GAS bf16_t*)(ws + WS_WGU + (size_t)l * NEXP * 2 * MiB), DM};
            pg8::MoeOrder S{BLKE, BTOK, 4 * nused, G, vcu};
            pg8::EpiSwiGLU E{ACT};
#pragma unroll 1
            for (int rep = 0; rep < REP_GU; ++rep)
            pg8::gemm_phase<pg8::EpiSwiGLU, pg8::MoeOrder>(lds, g, S, E, wave);
        }
        SEAM(pb + P_GU);
        if (EN(9) && IN(pb + P_DOWN)) {
            PHASE_ENTER();
            const int nused = BLKE[1000];
            pg8::Gemm g{ACT, (const bf16_t*)(const GAS bf16_t*)(ws + WS_WDN + (size_t)l * NEXP * MiB), DFF};
            pg8::MoeOrder S{BLKE, nullptr, 4 * nused, G, vcu};
            pg8::EpiY E{YM};
#pragma unroll 1
            for (int rep = 0; rep < REP_DOWN; ++rep)
            pg8::gemm_phase<pg8::EpiY, pg8::MoeOrder>(lds, g, S, E, wave);
        }
        SEAM(pb + P_DOWN);
    }
    if (EN(10) && IN(PH_FINAL)) {
        PHASE_ENTER();
        row_phase<false, true, false, false, true>(lds, tid, lane, wave, G, bx, x_in, XB, out, g_ffn, MOD, 0, 0, MOD + (size_t)NB * MODW, H, YM, POS, TW, WR, TE, TRK, CNT);
    }
#undef IN
#undef SEAM
#undef GRID_BAR
}

extern "C" void kernel_launch(void* const* d_in, const int* in_sizes, int n_in, void* d_out, int out_size, void* d_ws, size_t ws_size, hipStream_t stream) {
    static int grid = 0;
    if (grid == 0) {
        if (n_in != 18 || in_sizes[0] != TT * DM || out_size != TT * DM || ws_size < WS_END) { fprintf(stderr, "kernel_launch: unexpected shapes / workspace (n_in %d, ws %zu); nothing launched\n", n_in, ws_size); grid = -1; return; }
        int dev = 0, cus = 0, per_cu = 0;
        if (hipGetDevice(&dev) != hipSuccess || hipDeviceGetAttribute(&cus, hipDeviceAttributeMultiprocessorCount, dev) != hipSuccess) { grid = -1; return; }
        if (hipFuncSetAttribute((const void*)fwd_kernel, hipFuncAttributeMaxDynamicSharedMemorySize, LDS_BYTES) != hipSuccess) { fprintf(stderr, "kernel_launch: hipFuncSetAttribute failed\n"); grid = -1; return; }
        if (hipOccupancyMaxActiveBlocksPerMultiprocessor(&per_cu, (const void*)fwd_kernel, 512, LDS_BYTES) != hipSuccess || per_cu < 1) { fprintf(stderr, "kernel_launch: occupancy query says %d\n", per_cu); per_cu = 1; }
        (void)hipGetLastError();
        grid = cus;
    }
    if (grid < 0) return;
    (void)hipMemsetAsync((char*)d_ws + WS_CTL, 0, CTL_ZERO_BYTES, stream);
    Args a{};
    for (int i = 0; i < 18; ++i) a.in[i] = (const float*)d_in[i];
    a.out = (float*)d_out; a.ws = (unsigned char*)d_ws;
#if MK_ONE_LAUNCH
    a.ph_lo = 0; a.ph_hi = NPH;
    hipLaunchKernelGGL(fwd_kernel, dim3(grid), dim3(512), LDS_BYTES, stream, a);
#else
    for (int p = 0; p < NPH; ++p) { a.ph_lo = p; a.ph_hi = p + 1; hipLaunchKernelGGL(fwd_kernel, dim3(grid), dim3(512), LDS_BYTES, stream, a); }
#endif
}
```

```cpp
#include <hip/hip_runtime.h>
#include <cstdio>
#include <cstdint>

#ifndef INPROJ_WGM
#define INPROJ_WGM 4
#endif
#ifndef GEMM_ALIGN
#define GEMM_ALIGN 1
#endif
#ifndef ROWB
#define ROWB 4
#endif
#ifndef N1K_WGM
#define N1K_WGM 8
#endif
#ifndef OUT_ROWMAJOR
#define OUT_ROWMAJOR 0
#endif
#ifndef REP_PRO
#define REP_PRO 1
#endif
#ifndef REP_ATTB
#define REP_ATTB 1
#endif
#ifndef REP_ATTA
#define REP_ATTA 1
#endif
#ifndef REP_INPROJ
#define REP_INPROJ 1
#endif
#ifndef REP_NORM1
#define REP_NORM1 1
#endif
#ifndef REP_GU
#define REP_GU 1
#endif
#ifndef REP_PAB
#define REP_PAB 1
#endif
#ifndef REP_OUT
#define REP_OUT 1
#endif
#ifndef REP_DOWN
#define REP_DOWN 1
#endif
#ifndef REP_NORM2
#define REP_NORM2 1
#endif
#ifndef GU_F8
#define GU_F8 1
#endif
#ifndef DN_F8
#define DN_F8 1
#endif
#ifndef MK_ONE_LAUNCH
#define MK_ONE_LAUNCH 1
#endif

#define LAS __attribute__((address_space(3)))
#define GAS __attribute__((address_space(1)))
typedef unsigned short bf16_t;
typedef short bf16x8 __attribute__((ext_vector_type(8)));
typedef short s16x4 __attribute__((ext_vector_type(4)));
typedef float f32x4 __attribute__((ext_vector_type(4)));
typedef float f32x16 __attribute__((ext_vector_type(16)));
typedef unsigned u32x4 __attribute__((ext_vector_type(4)));
typedef unsigned u32x2 __attribute__((ext_vector_type(2)));

constexpr int NB = 32, SEQ = 2048, DM = 1024, TT = NB * SEQ;
constexpr int NC = 4352;
constexpr int NEXP = 32, DFF = 512, NPAD = 139264, NBLK = 544;
constexpr int MODW = 6 * DM;
constexpr float QSCALE = 0.125f * 1.4426950408889634f;

constexpr size_t MiB = 1u << 20;
constexpr size_t WS_CTL = 0, CTL_ZERO_BYTES = 64 * 1024;
constexpr size_t WS_MOD = 1 * MiB;
constexpr size_t WS_TE = 2 * MiB + 512 * 1024, WS_TRK = 3 * MiB, WS_TW = 3 * MiB + 512 * 1024, WS_POS = 4 * MiB;
constexpr size_t WS_CNT = 4 * MiB + 512 * 1024;
constexpr size_t WS_BLKE = WS_CNT + 64 * 1024;
constexpr size_t WS_BTOK = WS_CNT + 128 * 1024;
constexpr size_t WS_WR = 5 * MiB + 256 * 1024;
constexpr size_t WS_WIN = 6 * MiB;
constexpr size_t WIN_BYTES = (size_t)NC * DM * 2;
constexpr size_t WS_WPA = 23 * MiB, WS_WPB = 25 * MiB, WS_WOUT = 27 * MiB;
constexpr size_t WS_WGU = 31 * MiB;
constexpr size_t WS_WDN = 159 * MiB;
constexpr size_t WS_H = 223 * MiB;
constexpr size_t WS_QKV = 351 * MiB;
constexpr size_t WS_GATE = 639 * MiB;
constexpr size_t WS_XB = 896 * MiB;
constexpr size_t WS_END = 1024 * MiB;
constexpr int CW_BAR = 4096;

constexpr int RING_BYTES = 133120;
constexpr int MISC_OFF = RING_BYTES;
constexpr int LDS_BYTES = 147456;

#define RLX_AGENT __ATOMIC_RELAXED, __HIP_MEMORY_SCOPE_AGENT
typedef float f32x2_t __attribute__((ext_vector_type(2))); typedef __bf16 bf16x2_t __attribute__((ext_vector_type(2)));
__device__ __forceinline__ unsigned cvt_pk_bf16(float lo, float hi) { const f32x2_t v = {lo, hi}; const bf16x2_t b = __builtin_convertvector(v, bf16x2_t); return __builtin_bit_cast(unsigned, b); }
typedef float f32x2v __attribute__((ext_vector_type(2)));
__device__ __forceinline__ unsigned pack4_fp8(float a, float b, float c, float d) { unsigned w = 0; w = __builtin_amdgcn_cvt_pk_fp8_f32(a, b, w, false); w = __builtin_amdgcn_cvt_pk_fp8_f32(c, d, w, true); return w; }
__device__ __forceinline__ void unpack8_fp8(u32x2 w, float (&o)[8]) { const f32x2v a = __builtin_amdgcn_cvt_pk_f32_fp8(w.x, false), b = __builtin_amdgcn_cvt_pk_f32_fp8(w.x, true), c = __builtin_amdgcn_cvt_pk_f32_fp8(w.y, false), d = __builtin_amdgcn_cvt_pk_f32_fp8(w.y, true);
    o[0] = a.x; o[1] = a.y; o[2] = b.x; o[3] = b.y; o[4] = c.x; o[5] = c.y; o[6] = d.x; o[7] = d.y; }
constexpr float A8S = 4.f, A8I = 0.25f;
constexpr float W8S = 64.f, W8I = 1.f / 64.f;
__device__ __forceinline__ float bf_lo(unsigned w) { return __uint_as_float(w << 16); }
__device__ __forceinline__ float bf_hi(unsigned w) { return __uint_as_float(w & 0xffff0000u); }
__device__ __forceinline__ float shx(float v, int mask, int lane) { return __int_as_float(__builtin_amdgcn_ds_bpermute((lane ^ mask) << 2, __float_as_int(v))); }
__device__ __forceinline__ float wave_sum(float v, int lane) {
#pragma unroll
    for (int o = 1; o < 64; o <<= 1) v += shx(v, o, lane);
    return v;
}
__device__ __forceinline__ float wave_max(float v, int lane) {
#pragma unroll
    for (int o = 1; o < 64; o <<= 1) v = fmaxf(v, shx(v, o, lane));
    return v;
}
__device__ __forceinline__ float sigmoid_f(float x) { return __builtin_amdgcn_rcpf(1.0f + __builtin_amdgcn_exp2f(-1.4426950408889634f * x)); }

#define XB_TMO      128
#define XB_XCNT(j)  (256  + 64 * (j))
#define XB_XSUB(j)  (1280 + 64 * (j))
#define XB_XGEN(j)  (2304 + 64 * (j))
#define XB_TOP      3328
#define XB_TOPGEN   3392
#define XCD_BAR_WORDS 3456
#define XB_SPIN_CAP (1u << 18)

__device__ __forceinline__ unsigned xb_ld(unsigned* p)              { return __hip_atomic_load(p, __ATOMIC_RELAXED, __HIP_MEMORY_SCOPE_AGENT); }
__device__ __forceinline__ unsigned xb_add(unsigned* p, unsigned v) { return __hip_atomic_fetch_add(p, v, __ATOMIC_RELAXED, __HIP_MEMORY_SCOPE_AGENT); }
__device__ __forceinline__ unsigned xb_xcc_id() { return (unsigned)__builtin_amdgcn_s_getreg((3 << 11) | 20) & 0xFu; }
#define XB_SPIN(cond, bar) do { unsigned _sp = 0; while (cond) { __builtin_amdgcn_s_sleep(1); \
    if ((++_sp & 255u) == 0u) { if (xb_ld(&(bar)[XB_TMO])) break; if (_sp > XB_SPIN_CAP) { atomicAdd(&(bar)[XB_TMO], 1u); break; } } } } while (0)

struct XcdBarrier { unsigned* bar; unsigned x; volatile LAS unsigned* st; };

__device__ __forceinline__ XcdBarrier xcd_barrier_post(unsigned* bar, volatile LAS unsigned* st) {
    XcdBarrier b; b.bar = bar; b.x = xb_xcc_id(); b.st = st;
    if (threadIdx.x == 0) (void)xb_add(&bar[XB_XCNT(b.x)], 1u);
    return b;
}
__device__ __forceinline__ void xcd_barrier_complete(unsigned* bar, unsigned x, unsigned& nloc, unsigned& nx) {
    const unsigned G = gridDim.x * gridDim.y * gridDim.z;
    unsigned sum, cnt, mine, sp = 0u;
    for (;;) {
        sum = 0u; cnt = 0u; mine = 0u;
#pragma unroll
        for (unsigned j = 0; j < 16; ++j) { const unsigned c = xb_ld(&bar[XB_XCNT(j)]); sum += c; cnt += (c > 0u) ? 1u : 0u; mine = (j == x) ? c : mine; }
        if (sum == G) break;
        __builtin_amdgcn_s_sleep(1);
        if ((++sp & 255u) == 0u) { if (xb_ld(&bar[XB_TMO])) break; if (sp > XB_SPIN_CAP) { atomicAdd(&bar[XB_TMO], 1u); break; } }
    }
    nloc = mine > 0u ? mine : 1u; nx = cnt > 0u ? cnt : 1u;
}
__device__ __forceinline__ void xcd_barrier(const XcdBarrier& b, const bool is_t0  ) {
    asm volatile("s_waitcnt vmcnt(0)" ::: "memory");
    __syncthreads();
    if (is_t0) {
        unsigned* bar = b.bar; unsigned bx_ = b.x;
        asm volatile("" : "+s"(bar), "+s"(bx_));
        __builtin_amdgcn_s_waitcnt(0);
        unsigned nloc = b.st[0], nx = b.st[1];
        if (nloc == 0u) { xcd_barrier_complete(bar, bx_, nloc, nx); b.st[0] = nloc; b.st[1] = nx; }
        const unsigned old = xb_add(&bar[XB_XSUB(bx_)], 1u);
        const unsigned gen = old / nloc;
        if (old + 1u == (gen + 1u) * nloc) {
            __builtin_amdgcn_fence(__ATOMIC_RELEASE, "agent");
            asm volatile("s_waitcnt vmcnt(0)" ::: "memory");
            const unsigned og = xb_add(&bar[XB_TOP], 1u);
            const unsigned tg = og / nx;
            if (og + 1u == (tg + 1u) * nx) xb_add(&bar[XB_TOPGEN], 1u);
            else XB_SPIN(xb_ld(&bar[XB_TOPGEN]) == tg, bar);
            __builtin_amdgcn_fence(__ATOMIC_ACQUIRE, "agent");
            xb_add(&bar[XB_XGEN(bx_)], 1u);
            asm volatile("s_waitcnt vmcnt(0)" ::: "memory");
        } else {
            XB_SPIN(xb_ld(&bar[XB_XGEN(bx_)]) == gen, bar);
            __builtin_amdgcn_fence(__ATOMIC_ACQUIRE, "agent");
            asm volatile("s_waitcnt vmcnt(0)" ::: "memory");
        }
    }
    __syncthreads();
}

namespace pg8 {
constexpr int BM = 256, BK = 64, HALF = 128, HTB = HALF * BK * 2, STAGE_BYTES = 8 * HTB, NXCD = 8, WGM = 8;
__host__ __device__ __forceinline__ int lds_byte(int r, int c) { const int st = (r >> 4) * 2 + (c >> 5), rr = r & 15, cc = c & 31, ob = rr * 64 + cc * 2; return st * 1024 + (ob ^ (((ob >> 9) & 1) << 5)); }
__host__ __device__ __forceinline__ void stage_rc(int b, int& R, int& C) { const int st = b / 1024, sb = b % 1024, swz = sb ^ (((sb >> 9) & 1) << 5); R = (st >> 1) * 16 + swz / 64; C = (st & 1) * 32 + (swz % 64) / 2; }
__host__ __device__ __forceinline__ int perm32(int rho) { const int n = rho >> 4, i = rho & 15; return 8 * (i >> 2) + 4 * n + (i & 3); }

struct Unit { int pm, pn; };
struct Gemm { const bf16_t* A; const bf16_t* Bt; int K; };

struct StaticOrder {
    static constexpr bool GATHER = false;
    int nM, nN, nwg, G, c, wgm = WGM;
    __device__ void init(int M, int N, int G_, int c_) { asm volatile("" : "+s"(c_));     nM = M / BM; nN = N / BM; nwg = nM * nN; G = G_; c = c_; }
    int rowmajor = 0;
    __device__ __forceinline__ bool next(int i, Unit& u) const {
        if (rowmajor) { const int upw = (nwg + G - 1) / G, k = c * upw + i; if (i >= upw || k >= nwg) return false; u.pm = k / nN; u.pn = k % nN; return true; }
        const long L = (long)i * G + c; if (L >= nwg) return false;
        int wgid = (int)L; { const int q = nwg / NXCD, r = nwg % NXCD, xcd = wgid % NXCD, off = wgid / NXCD; wgid = (xcd < r ? xcd * (q + 1) : r * (q + 1) + (xcd - r) * q) + off; }
        const int nig = wgm * nN, gid = wgid / nig, fm = gid * wgm, gsz = (nM - fm) < wgm ? (nM - fm) : wgm;
        u.pm = fm + ((wgid % nig) % gsz); u.pn = (wgid % nig) / gsz; return true;
    }
    __device__ __forceinline__ void aoff(const Unit&, int, int, unsigned (&)[2][2]) const {}
};
template <bool GATH>
struct MoeOrder {
    static constexpr bool GATHER = GATH;
    const int* blk_e; const int* rowidx; int nunits, G, c;
    __device__ __forceinline__ bool next(int i, Unit& u) const {
        const int L = i * G + c; if (L >= nunits) return false;
        const int blk = L >> 2; const int e = blk_e[blk]; u.pm = blk; u.pn = 4 * e + (L & 3); return true;
    }
    __device__ __forceinline__ void aoff(const Unit& u, int tid_, int K, unsigned (&o)[2][2]) const {
        int tid = tid_; asm volatile("" : "+v"(tid));
#pragma unroll
        for (int i = 0; i < 2; ++i) { int R, C; stage_rc(tid * 16 + i * 8192, R, C);
#pragma unroll
            for (int h = 0; h < 2; ++h) { const int r = u.pm * BM + h * HALF + R; const int src = rowidx ? rowidx[r] : r; o[h][i] = (unsigned)src * (unsigned)(K * 2) + (unsigned)C * 2u; } }
    }
};

typedef int i32x8 __attribute__((ext_vector_type(8))); typedef int i32x4 __attribute__((ext_vector_type(4)));
__device__ __forceinline__ i32x8 cat8(const bf16x8& a, const bf16x8& b) { return __builtin_shufflevector(__builtin_bit_cast(i32x4, a), __builtin_bit_cast(i32x4, b), 0, 1, 2, 3, 4, 5, 6, 7); }
template <class Epi, class Sched, bool F8 = false>
__device__ __forceinline__ void gemm_phase(LAS unsigned char* lds, const Gemm g, const Sched& S, const Epi& E, const int wid) {
    int lane_; asm volatile("v_mbcnt_lo_u32_b32 %0, -1, 0\n\tv_mbcnt_hi_u32_b32 %0, -1, %0" : "=v"(lane_));
    const int lane = lane_, tid = wid * 64 + lane, wr = wid >> 2, wc = wid & 3, fr = lane & 15, fq = lane >> 4;
    const int K = g.K, nt = K / BK;
    unsigned voffA[2], voffB[2];
#pragma unroll
    for (int i = 0; i < 2; ++i) { int R, C; stage_rc(tid * 16 + i * 8192, R, C); const int Rb = Epi::PERM ? ((R & ~31) + perm32(R & 31)) : R;
        voffA[i] = (unsigned)(R * K + C) * 2u; voffB[i] = (unsigned)(Rb * K + C) * 2u; }
    const size_t kstep = (size_t)(BK * 2);
    const size_t hstep = (size_t)HALF * K * 2;
    const size_t tstep = 2 * hstep;
    const unsigned ldsw = (unsigned)wid * 1024u;
    const int aoff = lds_byte(wr * 64 + fr, fq * 8), boff = lds_byte(wc * 32 + fr, fq * 8);
    const char* Ab = (const char*)g.A;
#define PG8_SA(b, h) (((b) * 2 + (h)) * HTB)
#define PG8_SB(b, h) ((4 + (b) * 2 + (h)) * HTB)
#define PG8_UNI(p) asm volatile("" : "+s"(p))
#define PG8_LOFF(v) asm volatile("" : "+v"(v))
#define PG8_STAGEB(bufoff, gbase, voff) do { const char* _g = (const char*)(gbase); PG8_UNI(_g); _Pragma("unroll") for (int _i = 0; _i < 2; ++_i) { unsigned _v = (voff)[_i]; PG8_LOFF(_v); \
        __builtin_amdgcn_global_load_lds((const unsigned*)(_g + _v), (LAS unsigned*)(lds + (bufoff) + ldsw + _i * 8192), 16, 0, 0); } } while (0)
#define PG8_STAGEA(bufoff, H_, kb, NEXT) do { if constexpr (Sched::GATHER) { const char* _g = Ab + (size_t)(kb); PG8_UNI(_g); _Pragma("unroll") for (int _i = 0; _i < 2; ++_i) { unsigned _o = (NEXT) ? na[H_][_i] : ca[H_][_i]; PG8_LOFF(_o); \
            __builtin_amdgcn_global_load_lds((const unsigned*)(_g + _o), (LAS unsigned*)(lds + (bufoff) + ldsw + _i * 8192), 16, 0, 0); } } \
        else { const char* _b = Ab + ((NEXT) ? nU : cU) + (size_t)(H_) * hstep + (size_t)(kb); PG8_UNI(_b); _Pragma("unroll") for (int _i = 0; _i < 2; ++_i) { unsigned _v = voffA[_i]; PG8_LOFF(_v); \
            __builtin_amdgcn_global_load_lds((const unsigned*)(_b + _v), (LAS unsigned*)(lds + (bufoff) + ldsw + _i * 8192), 16, 0, 0); } } } while (0)
#define PG8_LDA(dst, b, h) do { _Pragma("unroll") for (int m = 0; m < 4; ++m) _Pragma("unroll") for (int k = 0; k < 2; ++k) dst[m][k] = *(const LAS bf16x8*)(lds + PG8_SA(b, h) + aoff + m * 2048 + k * 1024); } while (0)
#define PG8_LDB(dst, b, h) do { _Pragma("unroll") for (int n = 0; n < 2; ++n) _Pragma("unroll") for (int k = 0; k < 2; ++k) dst[n][k] = *(const LAS bf16x8*)(lds + PG8_SB(b, h) + boff + n * 2048 + k * 1024); } while (0)
#define PG8_MMA(ai, bj, At, Bt) do { __builtin_amdgcn_s_setprio(1); _Pragma("unroll") for (int m = 0; m < 4; ++m) _Pragma("unroll") for (int n = 0; n < 2; ++n) { \
        if constexpr (F8) { const i32x8 b_ = cat8(Bt[n][0], Bt[n][1]), a_ = cat8(At[m][0], At[m][1]); \
            asm volatile("v_mfma_f32_16x16x128_f8f6f4 %0, %1, %2, %0" : "+v"(acc[ai][bj][m][n]) : "v"(b_), "v"(a_)); } \
        else { _Pragma("unroll") for (int k = 0; k < 2; ++k) acc[ai][bj][m][n] = __builtin_amdgcn_mfma_f32_16x16x32_bf16(Bt[n][k], At[m][k], acc[ai][bj][m][n], 0, 0, 0); } } \
        __builtin_amdgcn_s_setprio(0); } while (0)
#define PG8_MFMA_DRAIN asm volatile("s_nop 7\n\ts_nop 7\n\ts_nop 3" ::: "memory")
#define PG8_WAIT_V(n) asm volatile("s_waitcnt vmcnt(" #n ")" ::: "memory")
#define PG8_WAIT_L(n) asm volatile("s_waitcnt lgkmcnt(" #n ")" ::: "memory")
#define PG8_BAR __builtin_amdgcn_s_barrier()
#define PG8_SCHED __builtin_amdgcn_sched_barrier(0)
    Unit cur, nxt; int ui = 0;
    if (!S.next(0, cur)) return;
    f32x4 acc[2][2][4][2];
#pragma unroll
    for (int a = 0; a < 2; ++a)
#pragma unroll
        for (int b = 0; b < 2; ++b)
#pragma unroll
            for (int m = 0; m < 4; ++m)
#pragma unroll
                for (int n = 0; n < 2; ++n) acc[a][b][m][n] = (f32x4){0.f, 0.f, 0.f, 0.f};
    bf16x8 At[4][2], B0[2][2], B1[2][2];
    unsigned ca[2][2], na[2][2];
    size_t cU = 0, nU = 0;
    if constexpr (Sched::GATHER) S.aoff(cur, tid, K, ca); else cU = (size_t)cur.pm * tstep;
    const char* cB = (const char*)g.Bt + (size_t)cur.pn * tstep;
    PG8_STAGEB(PG8_SB(0, 0), cB, voffB); PG8_STAGEB(PG8_SB(0, 1), cB + hstep, voffB); PG8_STAGEA(PG8_SA(0, 0), 0, 0, false); PG8_STAGEA(PG8_SA(0, 1), 1, 0, false);
    if (wr == 1) PG8_BAR;
    PG8_WAIT_V(2); PG8_BAR;
    PG8_STAGEB(PG8_SB(1, 0), cB + kstep, voffB); PG8_STAGEA(PG8_SA(1, 0), 0, kstep, false); PG8_STAGEB(PG8_SB(1, 1), cB + hstep + kstep, voffB);
    PG8_WAIT_V(6); PG8_BAR;
    for (;;) {
        const bool has_next = S.next(ui + 1, nxt);
        if constexpr (Sched::GATHER) {
            if (has_next) S.aoff(nxt, tid, K, na);
            else {
#pragma unroll
                for (int h = 0; h < 2; ++h)
#pragma unroll
                    for (int i = 0; i < 2; ++i) na[h][i] = ca[h][i];
            }
        } else nU = has_next ? (size_t)nxt.pm * tstep : cU;
        const char* nB = has_next ? (const char*)g.Bt + (size_t)nxt.pn * tstep : cB;
#pragma unroll 1
        for (int t = 0; t < nt; t += 2) {
            const bool last = (t == nt - 2);
            const size_t kb1 = (size_t)(t + 1) * kstep;
            const size_t kb2 = last ? 0 : (size_t)(t + 2) * kstep, kb3 = kb2 + kstep;
            const char* b2 = last ? nB : cB + (size_t)(t + 2) * kstep; const char* b3 = b2 + kstep;
            PG8_LDB(B0, 0, 0); PG8_LDB(B1, 0, 1); PG8_SCHED; PG8_LDA(At, 0, 0); PG8_STAGEA(PG8_SA(1, 1), 1, kb1, false);
            PG8_WAIT_V(8); PG8_WAIT_L(0); PG8_BAR; PG8_MMA(0, 0, At, B0); PG8_MMA(0, 1, At, B1); PG8_BAR; PG8_SCHED;
            PG8_LDA(At, 0, 1); PG8_STAGEB(PG8_SB(0, 0), b2, voffB); PG8_STAGEB(PG8_SB(0, 1), b2 + hstep, voffB); PG8_STAGEA(PG8_SA(0, 0), 0, kb2, last);
            PG8_WAIT_V(8); PG8_WAIT_L(0); PG8_BAR; PG8_MMA(1, 0, At, B0); PG8_MMA(1, 1, At, B1); PG8_BAR; PG8_SCHED;
            PG8_LDB(B0, 1, 0); PG8_LDB(B1, 1, 1); PG8_SCHED; PG8_LDA(At, 1, 0); PG8_STAGEA(PG8_SA(0, 1), 1, kb2, last);
            PG8_WAIT_V(8); PG8_WAIT_L(0); PG8_BAR; PG8_MMA(0, 0, At, B0); PG8_MMA(0, 1, At, B1); PG8_BAR; PG8_SCHED;
            PG8_LDA(At, 1, 1); PG8_STAGEB(PG8_SB(1, 0), b3, voffB); PG8_STAGEB(PG8_SB(1, 1), b3 + hstep, voffB); PG8_STAGEA(PG8_SA(1, 0), 0, kb3, last);
            PG8_WAIT_V(8); PG8_WAIT_L(0); PG8_BAR; PG8_MMA(1, 0, At, B0); PG8_MMA(1, 1, At, B1); PG8_BAR; PG8_SCHED;
            if constexpr (Epi::MIDK) { if (t + 2 == nt / 2) { if constexpr (F8) PG8_MFMA_DRAIN; E.mid(acc, cur, wr, wc, fr, fq); if constexpr (F8) asm volatile("s_nop 3" ::: "memory"); } }
        }
#if GEMM_ALIGN
        if (wr == 0) PG8_BAR;
#endif
        if constexpr (F8) PG8_MFMA_DRAIN;
        E(acc, cur, wr, wc, fr, fq);
        if (!has_next) break;
#pragma unroll
        for (int a = 0; a < 2; ++a)
#pragma unroll
            for (int b = 0; b < 2; ++b)
#pragma unroll
                for (int m = 0; m < 4; ++m)
#pragma unroll
                    for (int n = 0; n < 2; ++n) acc[a][b][m][n] = (f32x4){0.f, 0.f, 0.f, 0.f};
        cur = nxt; cB = nB; cU = nU; ++ui;
        if constexpr (Sched::GATHER) {
#pragma unroll
            for (int h = 0; h < 2; ++h)
#pragma unroll
                for (int i = 0; i < 2; ++i) ca[h][i] = na[h][i];
        }
#if GEMM_ALIGN
        if (wr == 1) PG8_BAR;
#endif
    }
    PG8_WAIT_V(0);
#if !GEMM_ALIGN
    if (wr == 0) PG8_BAR;
#endif
    PG8_BAR;
#undef PG8_SA
#undef PG8_SB
#undef PG8_STAGEA
#undef PG8_STAGEB
#undef PG8_UNI
#undef PG8_LOFF
#undef PG8_LDA
#undef PG8_LDB
#undef PG8_MMA
#undef PG8_WAIT_V
#undef PG8_MFMA_DRAIN
#undef PG8_WAIT_L
#undef PG8_BAR
#undef PG8_SCHED
}

typedef const f32x4 (&AccRef)[2][2][4][2];

__device__ __forceinline__ u32x4 pack8(const f32x4& a, const f32x4& b) { u32x4 w; w.x = cvt_pk_bf16(a[0], a[1]); w.y = cvt_pk_bf16(a[2], a[3]); w.z = cvt_pk_bf16(b[0], b[1]); w.w = cvt_pk_bf16(b[2], b[3]); return w; }

struct EpiInProj {
    static constexpr bool PERM = true, MIDK = false;
    bf16_t *QA, *KA, *VA, *QB, *KB, *VB, *SA, *SB;
    const LAS float* normw;
    template <int ROPE>
    __device__ __forceinline__ void head_tile(AccRef acc, bf16_t* dst_, int ld, int hcol, int gsel, float scale, int row0, int fr, int fq) const {
        unsigned char* dst = (unsigned char*)dst_;
        int d0[2];
#pragma unroll
        for (int bj = 0; bj < 2; ++bj) d0[bj] = (ROPE == 1) ? (fq == 0 ? 8 * bj : 8 + 8 * fq + 24 * bj) : (fq < 2 ? 8 * fq + 16 * bj : 16 + 8 * fq + 16 * bj);
        f32x4 g[2][2];
#pragma unroll
        for (int bj = 0; bj < 2; ++bj)
#pragma unroll
            for (int n = 0; n < 2; ++n) g[bj][n] = *(const LAS f32x4*)(normw + gsel * 64 + d0[bj] + 4 * n);
        constexpr float FA[8] = {1.591549431e-01f, 3.086376340e-02f, 5.985185713e-03f, 1.160663641e-03f, 2.250790790e-04f, 4.364795279e-05f, 8.464330808e-06f, 1.641426263e-06f};
        constexpr float FB[16] = {1.591549431e-01f, 8.949940161e-02f, 5.032921210e-02f, 2.830219583e-02f, 1.591549431e-02f, 8.949940161e-03f, 5.032921210e-03f, 2.830219583e-03f,
                                  1.591549431e-03f, 8.949940161e-04f, 5.032921210e-04f, 2.830219583e-04f, 1.591549431e-04f, 8.949940161e-05f, 5.032921210e-05f, 2.830219583e-05f};
        float fq8[8];
#pragma unroll
        for (int k = 0; k < 8; ++k) fq8[k] = (ROPE == 1) ? FA[k] : ((fq & 1) ? FB[8 + k] : FB[k]);
        const bool rot = (ROPE == 2) || (fq == 0);
#pragma unroll
        for (int ai = 0; ai < 2; ++ai)
#pragma unroll
            for (int m = 0; m < 4; ++m) {
                const int row = row0 + ai * HALF + m * 16; const int s = row & (SEQ - 1);
                f32x4 y[2][2]; float ss = 0.f;
#pragma unroll
                for (int bj = 0; bj < 2; ++bj)
#pragma unroll
                    for (int n = 0; n < 2; ++n) { y[bj][n] = acc[ai][bj][m][n]; const f32x4 q = y[bj][n] * y[bj][n]; ss += (q[0] + q[1]) + (q[2] + q[3]); }
                ss += shx(ss, 16, fr + 16 * fq); ss += shx(ss, 32, fr + 16 * fq);
                const float rinv = __builtin_amdgcn_rsqf(ss * (W8I * W8I / 64.0f) + 1e-6f) * W8I;
#pragma unroll
                for (int bj = 0; bj < 2; ++bj)
#pragma unroll
                    for (int n = 0; n < 2; ++n) y[bj][n] = y[bj][n] * rinv * g[bj][n];
                if (ROPE != 0) {
                    const float pos = (float)((ROPE == 1) ? s : (fq < 2 ? (s >> 6) : (s & 63)));
#pragma unroll
                    for (int n = 0; n < 2; ++n)
#pragma unroll
                        for (int j = 0; j < 4; ++j) {
                            const float xr = __builtin_amdgcn_fractf(pos * fq8[4 * n + j]);
                            const float c = rot ? __builtin_amdgcn_cosf(xr) : 1.0f, s_ = rot ? __builtin_amdgcn_sinf(xr) : 0.0f;
                            const float x1 = y[0][n][j], x2 = y[1][n][j];
                            y[0][n][j] = x1 * c - x2 * s_; y[1][n][j] = x2 * c + x1 * s_;
                        }
                }
                u32x4 w;
#pragma unroll
                for (int bj = 0; bj < 2; ++bj) { const f32x4 a = y[bj][0] * scale, c = y[bj][1] * scale;
                    const unsigned lo = pack4_fp8(a[0], a[1], a[2], a[3]), hi = pack4_fp8(c[0], c[1], c[2], c[3]);
                    if (bj == 0) { w.x = lo; w.y = hi; } else { w.z = lo; w.w = hi; } }
                *(u32x4*)(dst + (size_t)row * ld + hcol + 16 * fq) = w;
            }
    }
    __device__ __forceinline__ void operator()(AccRef acc, const Unit& u, int wr, int wc, int fr_, int fq_) const {
        int fr = fr_, fq = fq_; asm volatile("" : "+v"(fr), "+v"(fq));
        const int pn = u.pn; const int row0 = u.pm * BM + wr * 64 + fr;
        if (pn >= 9) {
            unsigned char* base = (unsigned char*)((pn < 13) ? SA : SB); const int colt = ((pn - 9) & 3) * 256 + wc * 64 + 16 * fq;
#pragma unroll
            for (int ai = 0; ai < 2; ++ai)
#pragma unroll
                for (int m = 0; m < 4; ++m) { u32x4 w;
#pragma unroll
                    for (int bj = 0; bj < 2; ++bj) { f32x4 v0 = acc[ai][bj][m][0], v1 = acc[ai][bj][m][1];
#pragma unroll
                        for (int j = 0; j < 4; ++j) { v0[j] = sigmoid_f(v0[j] * W8I); v1[j] = sigmoid_f(v1[j] * W8I); }
                        const unsigned lo = pack4_fp8(v0[0], v0[1], v0[2], v0[3]), hi = pack4_fp8(v1[0], v1[1], v1[2], v1[3]);
                        if (bj == 0) { w.x = lo; w.y = hi; } else { w.z = lo; w.w = hi; } }
                    *(u32x4*)(base + (size_t)(row0 + ai * HALF + m * 16) * DM + colt) = w; }
        } else if (pn == 4 || pn == 5) {
            const int colt = (pn - 4) * 256 + wc * 64 + 16 * fq;
#pragma unroll
            for (int ai = 0; ai < 2; ++ai)
#pragma unroll
                for (int m = 0; m < 4; ++m) { bf16_t* rowp = VA + (size_t)(row0 + ai * HALF + m * 16) * 512 + colt;
#pragma unroll
                    for (int bj = 0; bj < 2; ++bj) *(u32x4*)(rowp + 8 * bj) = pack8(acc[ai][bj][m][0] * W8I, acc[ai][bj][m][1] * W8I); }
        } else if (pn < 2)  head_tile<1>(acc, QA, 512, 64 * (4 * pn + wc), 0, QSCALE, row0, fr, fq);
        else if (pn < 4)    head_tile<1>(acc, KA, 512, 64 * (4 * (pn - 2) + wc), 1, 1.0f, row0, fr, fq);
        else if (pn < 8)    head_tile<2>(acc, QB, 512, 64 * (4 * (pn - 6) + wc), 2, QSCALE, row0, fr, fq);
        else if (wc < 2)    head_tile<2>(acc, KB, 128, 64 * wc, 3, 1.0f, row0, fr, fq);
        else {
#pragma unroll
            for (int ai = 0; ai < 2; ++ai)
#pragma unroll
                for (int m = 0; m < 4; ++m) { bf16_t* rowp = VB + (size_t)(row0 + ai * HALF + m * 16) * 128 + 64 * (wc - 2) + 8 * fq;
#pragma unroll
                    for (int bj = 0; bj < 2; ++bj) *(u32x4*)(rowp + 32 * bj) = pack8(acc[ai][bj][m][0] * W8I, acc[ai][bj][m][1] * W8I); }
        }
    }
};

struct EpiMergeFused {
    static constexpr bool PERM = true, MIDK = true;
    bf16_t* MG; const unsigned char* GA; const unsigned char* GB;
    __device__ __forceinline__ void mid(f32x4 (&acc)[2][2][4][2], const Unit& u, int wr, int wc, int fr_, int fq_) const {
        int fr = fr_, fq = fq_; asm volatile("" : "+v"(fr), "+v"(fq));
        const int row0 = u.pm * BM + wr * 64 + fr, col0 = u.pn * BM + wc * 64 + 16 * fq;
#pragma unroll
        for (int ai = 0; ai < 2; ++ai)
#pragma unroll
            for (int m = 0; m < 4; ++m) { const size_t ro = (size_t)(row0 + ai * HALF + m * 16) * DM + col0;
                const u32x4 a = *(const u32x4*)(GA + ro), b = *(const u32x4*)(GB + ro);
#pragma unroll
                for (int bj = 0; bj < 2; ++bj) {
                    float sa[8], sb[8]; unpack8_fp8(bj ? (u32x2){a.z, a.w} : (u32x2){a.x, a.y}, sa); unpack8_fp8(bj ? (u32x2){b.z, b.w} : (u32x2){b.x, b.y}, sb);
#pragma unroll
                    for (int n = 0; n < 2; ++n)
#pragma unroll
                        for (int j = 0; j < 4; ++j) acc[ai][bj][m][n][j] *= sa[4 * n + j] * __builtin_amdgcn_rcpf(fmaxf(sb[4 * n + j], 1e-12f));
                } }
    }
    __device__ __forceinline__ void operator()(AccRef acc, const Unit& u, int wr, int wc, int fr_, int fq_) const {
        int fr = fr_, fq = fq_; asm volatile("" : "+v"(fr), "+v"(fq));
        const int row0 = u.pm * BM + wr * 64 + fr, col0 = u.pn * BM + wc * 64 + 16 * fq;
#pragma unroll
        for (int ai = 0; ai < 2; ++ai)
#pragma unroll
            for (int m = 0; m < 4; ++m) { const size_t ro = (size_t)(row0 + ai * HALF + m * 16) * DM + col0;
                const u32x4 b = *(const u32x4*)(GB + ro); u32x4 w;
#pragma unroll
                for (int bj = 0; bj < 2; ++bj) {
                    float sb[8]; unpack8_fp8(bj ? (u32x2){b.z, b.w} : (u32x2){b.x, b.y}, sb);
                    f32x4 v0 = acc[ai][bj][m][0], v1 = acc[ai][bj][m][1];
                    constexpr float CS = A8I * W8I * A8S;
#pragma unroll
                    for (int j = 0; j < 4; ++j) { v0[j] *= fmaxf(sb[j], 1e-12f) * CS; v1[j] *= fmaxf(sb[4 + j], 1e-12f) * CS; }
                    const unsigned lo = pack4_fp8(v0[0], v0[1], v0[2], v0[3]), hi = pack4_fp8(v1[0], v1[1], v1[2], v1[3]);
                    if (bj == 0) { w.x = lo; w.y = hi; } else { w.z = lo; w.w = hi; } }
                *(u32x4*)((unsigned char*)MG + ro) = w; }
    }
};

struct EpiResidB {
    static constexpr bool PERM = true, MIDK = false;
    const float* Xf; const bf16_t* Xb; bf16_t* O; const float* gate;
    __device__ __forceinline__ void operator()(AccRef acc, const Unit& u, int wr, int wc, int fr_, int fq_) const {
        int fr = fr_, fq = fq_; asm volatile("" : "+v"(fr), "+v"(fq));
        const int row0 = u.pm * BM + wr * 64 + fr, col0 = u.pn * BM + wc * 64 + 16 * fq; const int b = (u.pm * BM) >> 11;
        f32x4 gt[2][2];
#pragma unroll
        for (int bj = 0; bj < 2; ++bj)
#pragma unroll
            for (int n = 0; n < 2; ++n) gt[bj][n] = *(const f32x4*)(gate + (size_t)b * MODW + col0 + 8 * bj + 4 * n) * (A8I * W8I);
#pragma unroll
        for (int ai = 0; ai < 2; ++ai)
#pragma unroll
            for (int m = 0; m < 4; ++m) { const size_t ro = (size_t)(row0 + ai * HALF + m * 16) * DM + col0;
#pragma unroll
                for (int bj = 0; bj < 2; ++bj) {
                    f32x4 x0, x1;
                    if (Xf) { x0 = *(const f32x4*)(Xf + ro + 8 * bj); x1 = *(const f32x4*)(Xf + ro + 8 * bj + 4); }
                    else { const u32x4 w = *(const u32x4*)(Xb + ro + 8 * bj); x0 = (f32x4){bf_lo(w.x), bf_hi(w.x), bf_lo(w.y), bf_hi(w.y)}; x1 = (f32x4){bf_lo(w.z), bf_hi(w.z), bf_lo(w.w), bf_hi(w.w)}; }
                    *(u32x4*)(O + ro + 8 * bj) = pack8(x0 + gt[bj][0] * acc[ai][bj][m][0], x1 + gt[bj][1] * acc[ai][bj][m][1]); } }
    }
};

struct EpiSwiGLU {
    static constexpr bool PERM = true, MIDK = false;
    bf16_t* ACT;
    float cs;
    __device__ __forceinline__ void operator()(AccRef acc, const Unit& u, int wr, int wc, int fr_, int fq_) const {
        int fr = fr_, fq = fq_; asm volatile("" : "+v"(fr), "+v"(fq));
        const int row0 = u.pm * BM + wr * 64 + fr, col0 = (u.pn & 3) * HALF + wc * 32 + 8 * fq;
#pragma unroll
        for (int ai = 0; ai < 2; ++ai)
#pragma unroll
            for (int m = 0; m < 4; ++m) { f32x4 r[2];
#pragma unroll
                for (int n = 0; n < 2; ++n)
#pragma unroll
                    for (int j = 0; j < 4; ++j) { const float gg = acc[ai][0][m][n][j] * cs, uu = acc[ai][1][m][n][j] * (DN_F8 ? cs * A8S : cs); r[n][j] = gg * sigmoid_f(gg) * uu; }
                if (DN_F8) *(u32x2*)((unsigned char*)ACT + (size_t)(row0 + ai * HALF + m * 16) * DFF + col0) = (u32x2){pack4_fp8(r[0][0], r[0][1], r[0][2], r[0][3]), pack4_fp8(r[1][0], r[1][1], r[1][2], r[1][3])};
                else *(u32x4*)(ACT + (size_t)(row0 + ai * HALF + m * 16) * DFF + col0) = pack8(r[0], r[1]); }
    }
};

struct EpiY {
    static constexpr bool PERM = true, MIDK = false;
    unsigned char* Y;
    __device__ __forceinline__ void operator()(AccRef acc, const Unit& u, int wr, int wc, int fr_, int fq_) const {
        int fr = fr_, fq = fq_; asm volatile("" : "+v"(fr), "+v"(fq));
        const int row0 = u.pm * BM + wr * 64 + fr, col0 = (u.pn & 3) * BM + wc * 64 + 16 * fq;
#pragma unroll
        for (int ai = 0; ai < 2; ++ai)
#pragma unroll
            for (int m = 0; m < 4; ++m) { u32x4 w;
                constexpr float CS = DN_F8 ? A8I * W8I : 1.0f;
                { const f32x4 a = acc[ai][0][m][0] * CS, b = acc[ai][0][m][1] * CS; w.x = pack4_fp8(a[0], a[1], a[2], a[3]); w.y = pack4_fp8(b[0], b[1], b[2], b[3]); }
                { const f32x4 a = acc[ai][1][m][0] * CS, b = acc[ai][1][m][1] * CS; w.z = pack4_fp8(a[0], a[1], a[2], a[3]); w.w = pack4_fp8(b[0], b[1], b[2], b[3]); }
                *(u32x4*)(Y + (size_t)(row0 + ai * HALF + m * 16) * DM + col0) = w; }
    }
};
}

__device__ __forceinline__ int dimA(int bj, int r) { return r < 8 ? r + 8 * bj : 16 + (r - 8) + 24 * bj; }
__device__ __forceinline__ int dimB(int bj, int r) { return r < 16 ? r + 16 * bj : 32 + (r - 16) + 16 * bj; }
__device__ __forceinline__ int inproj_srccol(int P) {
    const int pn = P >> 8, p = P & 255, bj = p >> 7, wc = (p >> 5) & 3, r = p & 31;
    if (pn < 2) return 64 * (4 * pn + wc) + dimA(bj, r);
    if (pn < 4) return 512 + 64 * (4 * (pn - 2) + wc) + dimA(bj, r);
    if (pn < 6) return 1024 + 256 * (pn - 4) + 64 * wc + 16 * ((p >> 3) & 3) + 8 * bj + (p & 7);
    if (pn < 8) return 1536 + 64 * (4 * (pn - 6) + wc) + dimB(bj, r);
    if (pn == 8) return wc < 2 ? 2048 + 64 * wc + dimB(bj, r) : 2176 + 64 * (wc - 2) + 32 * bj + r;
    { const int fq = (p >> 3) & 3, r8 = p & 7; return 2304 + 256 * (pn - 9) + 64 * wc + 16 * fq + 8 * bj + r8; }
}

namespace att {
constexpr int KSTR = 80, VSTR = 192;
constexpr int KTILE = 64 * KSTR, VTILE = 64 * VSTR;
constexpr int K_OFF = 0, V_OFF = 2 * KTILE;
constexpr int PRIV_OFF = 0;
__device__ __forceinline__ s16x4 vtr(LAS const char* p) { typedef short v4i16_t __attribute__((ext_vector_type(4)));
    return __builtin_bit_cast(s16x4, __builtin_amdgcn_ds_read_tr16_b64_v4i16((LAS v4i16_t*)p)); }
__device__ __forceinline__ int clamp_tok(int t) { return t < 0 ? 0 : (t > SEQ - 1 ? SEQ - 1 : t); }

__device__ __forceinline__ long mk64(unsigned lo, unsigned hi) { return (long)(((unsigned long long)hi << 32) | lo); }
__device__ __forceinline__ void qk_tile(f32x16& p0, f32x16& p1, const u32x4 (&kf)[2][2], const u32x4 (&qr)[2]) {
    const f32x16 z = {0.f, 0.f, 0.f, 0.f, 0.f, 0.f, 0.f, 0.f, 0.f, 0.f, 0.f, 0.f, 0.f, 0.f, 0.f, 0.f};
    p0 = __builtin_amdgcn_mfma_f32_32x32x16_fp8_fp8(mk64(kf[0][0].x, kf[0][0].y), mk64(qr[0].x, qr[0].y), z, 0, 0, 0);
    p1 = __builtin_amdgcn_mfma_f32_32x32x16_fp8_fp8(mk64(kf[1][0].x, kf[1][0].y), mk64(qr[0].x, qr[0].y), z, 0, 0, 0);
    p0 = __builtin_amdgcn_mfma_f32_32x32x16_fp8_fp8(mk64(kf[0][0].z, kf[0][0].w), mk64(qr[0].z, qr[0].w), p0, 0, 0, 0);
    p1 = __builtin_amdgcn_mfma_f32_32x32x16_fp8_fp8(mk64(kf[1][0].z, kf[1][0].w), mk64(qr[0].z, qr[0].w), p1, 0, 0, 0);
    p0 = __builtin_amdgcn_mfma_f32_32x32x16_fp8_fp8(mk64(kf[0][1].x, kf[0][1].y), mk64(qr[1].x, qr[1].y), p0, 0, 0, 0);
    p1 = __builtin_amdgcn_mfma_f32_32x32x16_fp8_fp8(mk64(kf[1][1].x, kf[1][1].y), mk64(qr[1].x, qr[1].y), p1, 0, 0, 0);
    p0 = __builtin_amdgcn_mfma_f32_32x32x16_fp8_fp8(mk64(kf[0][1].z, kf[0][1].w), mk64(qr[1].z, qr[1].w), p0, 0, 0, 0);
    p1 = __builtin_amdgcn_mfma_f32_32x32x16_fp8_fp8(mk64(kf[1][1].z, kf[1][1].w), mk64(qr[1].z, qr[1].w), p1, 0, 0, 0);
}
template <bool MASK>
__device__ __forceinline__ void exp_tile(const f32x16& p0, const f32x16& p1, float& lsum, bf16x8 (&pf)[2][2], int mbase, int mR, int dk) {
    float e0[16], e1[16]; float ls = 0.f;
#pragma unroll
    for (int r = 0; r < 16; ++r) {
        e0[r] = __builtin_amdgcn_exp2f(p0[r]); e1[r] = __builtin_amdgcn_exp2f(p1[r]);
        if (MASK) {
            const int c0 = (r & 3) + 8 * (r >> 2);
            e0[r] = ((unsigned)(mbase + dk * c0) <= (unsigned)mR) ? e0[r] : 0.f;
            e1[r] = ((unsigned)(mbase + dk * (c0 + 32)) <= (unsigned)mR) ? e1[r] : 0.f;
        }
        ls += e0[r] + e1[r];
    }
    lsum += ls;
#pragma unroll
    for (int s = 0; s < 2; ++s) {
        u32x4 w0, w1;
        w0.x = cvt_pk_bf16(e0[8 * s + 0], e0[8 * s + 1]); w0.y = cvt_pk_bf16(e0[8 * s + 2], e0[8 * s + 3]); w0.z = cvt_pk_bf16(e0[8 * s + 4], e0[8 * s + 5]); w0.w = cvt_pk_bf16(e0[8 * s + 6], e0[8 * s + 7]);
        w1.x = cvt_pk_bf16(e1[8 * s + 0], e1[8 * s + 1]); w1.y = cvt_pk_bf16(e1[8 * s + 2], e1[8 * s + 3]); w1.z = cvt_pk_bf16(e1[8 * s + 4], e1[8 * s + 5]); w1.w = cvt_pk_bf16(e1[8 * s + 6], e1[8 * s + 7]);
        pf[0][s] = __builtin_bit_cast(bf16x8, w0); pf[1][s] = __builtin_bit_cast(bf16x8, w1);
    }
}
__device__ __forceinline__ void vread(bf16x8 (&vf)[4], LAS const char* vb, int d0) {
#pragma unroll
    for (int blk = 0; blk < 2; ++blk)
#pragma unroll
        for (int s = 0; s < 2; ++s) {
            const s16x4 lo = vtr(vb + (32 * blk + 16 * s) * VSTR + 64 * d0), hi = vtr(vb + (32 * blk + 16 * s + 8) * VSTR + 64 * d0);
            vf[2 * blk + s] = (bf16x8){lo[0], lo[1], lo[2], lo[3], hi[0], hi[1], hi[2], hi[3]};
        }
}
__device__ __forceinline__ void pv_half(f32x16& od, const bf16x8 (&vf)[4], const bf16x8 (&pf)[2][2]) {
#pragma unroll
    for (int blk = 0; blk < 2; ++blk)
#pragma unroll
        for (int s = 0; s < 2; ++s) od = __builtin_amdgcn_mfma_f32_32x32x16_bf16(vf[2 * blk + s], pf[blk][s], od, 0, 0, 0);
}
__device__ __forceinline__ void mask_params(int dk, int tk0, int tq, int hi, int& mbase, int& mR) {
    const int dlo = (-64 * dk > -tq) ? -64 * dk : -tq, dhi = (64 * dk < SEQ - 1 - tq) ? 64 * dk : SEQ - 1 - tq;
    const int dA = tk0 + 4 * dk * hi - tq;
    mR = dhi - dlo; mbase = ((dA & (dk - 1)) == 0) ? dA - dlo : 0x7fffffff;
}

template <bool MASKED>
__device__ __forceinline__ void dense64_loop(LAS char* lds, const unsigned char* Kg, const bf16_t* Vg, int ld  , int tok0, int ntiles,
                                             const u32x4 (&qr)[2][2], f32x16 (&o)[2][2], float (&lsum)[2], int tq0, int tq1, int lane_, int wave) {
    constexpr int V2_OFF = 2 * KTILE;
    u32x2 kreg; u32x4 vreg;
#define D64_LANE() int ln_ = lane_; asm volatile("" : "+v"(ln_)); const int tid_ = wave * 64 + ln_, srow = tid_ >> 3, sch = tid_ & 7
#define D64_LD(t) do { D64_LANE(); int tk_ = tok0 + 64 * (t) + srow; if (MASKED) tk_ = clamp_tok(tk_); kreg = *(const u32x2*)(Kg + (size_t)tk_ * ld + sch * 8); vreg = *(const u32x4*)(Vg + (size_t)tk_ * ld + sch * 8); } while (0)
#define D64_ST(t) do { D64_LANE(); *(LAS u32x2*)(lds + ((t) & 1) * KTILE + srow * KSTR + sch * 8) = kreg; *(LAS u32x4*)(lds + V2_OFF + ((t) & 1) * VTILE + srow * VSTR + sch * 16) = vreg; } while (0)
    D64_LD(0); D64_ST(0); D64_LD(1);
    for (int t = 0; t < ntiles; ++t) {
        __syncthreads();
        if (t + 1 < ntiles) D64_ST(t + 1);
        if (t + 2 < ntiles) D64_LD(t + 2);
        int lane = lane_; asm volatile("" : "+v"(lane));
        const int hi = lane >> 5;
        const int vlane = (4 * hi + ((lane & 15) >> 2)) * VSTR + (16 * ((lane >> 4) & 1) + 4 * (lane & 3)) * 2;
        const int klane = (lane & 31) * KSTR + 32 * hi;
        u32x4 kf[2][2];
        { LAS const char* kb_ = lds + (t & 1) * KTILE + klane;
#pragma unroll
          for (int blk = 0; blk < 2; ++blk)
#pragma unroll
              for (int e = 0; e < 2; ++e) kf[blk][e] = *(const LAS u32x4*)(kb_ + 32 * blk * KSTR + 16 * e); }
        f32x16 p[2][2];
        bf16x8 vfa[4], vfb[4];
        LAS const char* vb_ = lds + V2_OFF + (t & 1) * VTILE + vlane;
        vread(vfa, vb_, 0); vread(vfb, vb_, 1);
        __builtin_amdgcn_sched_barrier(0);
        qk_tile(p[0][0], p[0][1], kf, qr[0]);
        qk_tile(p[1][0], p[1][1], kf, qr[1]);
#pragma unroll
        for (int g = 0; g < 2; ++g) {
            bf16x8 pf[2][2]; int mb = 0, mr = 0;
            if (MASKED) mask_params(1, tok0 + 64 * t, g ? tq1 : tq0, hi, mb, mr);
            exp_tile<MASKED>(p[g][0], p[g][1], lsum[g], pf, mb, mr, 1);
            pv_half(o[g][0], vfa, pf); pv_half(o[g][1], vfb, pf);
        }
    }
#undef D64_LANE
#undef D64_LD
#undef D64_ST
}
__device__ __forceinline__ void dense64_lag_loop(LAS char* lds, const unsigned char* Kg, const bf16_t* Vg, int ld  , int ntiles,
                                                 const u32x4 (&qr)[2][2], f32x16 (&o)[2][2], float (&lsum)[2], int lane_, int wave, const bool lag) {
    constexpr int V2_OFF = 2 * KTILE;
    u32x2 kreg; u32x4 vreg;
#define D64_LANE() int ln_ = lane_; asm volatile("" : "+v"(ln_)); const int tid_ = wave * 64 + ln_, srow = tid_ >> 3, sch = tid_ & 7
#define D64_LD(t) do { D64_LANE(); const int tk_ = 64 * (t) + srow; kreg = *(const u32x2*)(Kg + (size_t)tk_ * ld + sch * 8); vreg = *(const u32x4*)(Vg + (size_t)tk_ * ld + sch * 8); } while (0)
#define D64_ST(t) do { D64_LANE(); *(LAS u32x2*)(lds + ((t) & 1) * KTILE + srow * KSTR + sch * 8) = kreg; *(LAS u32x4*)(lds + V2_OFF + ((t) % 3) * VTILE + srow * VSTR + sch * 16) = vreg; } while (0)
#define D64_QK(t) do { int lane = lane_; asm volatile("" : "+v"(lane)); const int klane = (lane & 31) * KSTR + 32 * (lane >> 5); u32x4 kf[2][2]; LAS const char* kb_ = lds + ((t) & 1) * KTILE + klane; \
        _Pragma("unroll") for (int blk = 0; blk < 2; ++blk) _Pragma("unroll") for (int e = 0; e < 2; ++e) kf[blk][e] = *(const LAS u32x4*)(kb_ + 32 * blk * KSTR + 16 * e); \
        qk_tile(p[0][0], p[0][1], kf, qr[0]); qk_tile(p[1][0], p[1][1], kf, qr[1]); } while (0)
#define D64_PV(t) do { int lane = lane_; asm volatile("" : "+v"(lane)); const int hi = lane >> 5; const int vlane = (4 * hi + ((lane & 15) >> 2)) * VSTR + (16 * ((lane >> 4) & 1) + 4 * (lane & 3)) * 2; \
        bf16x8 vfa[4], vfb[4]; LAS const char* vb_ = lds + V2_OFF + ((t) % 3) * VTILE + vlane; vread(vfa, vb_, 0); vread(vfb, vb_, 1); \
        _Pragma("unroll") for (int g = 0; g < 2; ++g) { bf16x8 pf[2][2]; exp_tile<false>(p[g][0], p[g][1], lsum[g], pf, 0, 0, 0); pv_half(o[g][0], vfa, pf); pv_half(o[g][1], vfb, pf); } } while (0)
    f32x16 p[2][2];
    D64_LD(0); D64_ST(0);
    if (!lag) {
        D64_LD(1);
        for (int t = 0; t < ntiles; ++t) {
            __syncthreads();
            if (t + 1 < ntiles) D64_ST(t + 1);
            if (t + 2 < ntiles) D64_LD(t + 2);
            D64_QK(t);
            D64_PV(t);
        }
        __syncthreads();
    } else {
        D64_LD(1);
        __syncthreads();
        D64_ST(1); D64_LD(2);
        D64_QK(0);
        for (int t = 1; t < ntiles; ++t) {
            __syncthreads();
            if (t + 1 < ntiles) D64_ST(t + 1);
            if (t + 2 < ntiles) D64_LD(t + 2);
            D64_PV(t - 1);
            __builtin_amdgcn_sched_barrier(0);
            D64_QK(t);
        }
        __syncthreads();
        D64_PV(ntiles - 1);
    }
#undef D64_LANE
#undef D64_LD
#undef D64_ST
#undef D64_QK
#undef D64_PV
}
__device__ __forceinline__ void priv_kload(u32x4 (&kf)[2][2], const unsigned char* Kg, int ld, int tk0, int dk, int lane_) {
    int lane = lane_; asm volatile("" : "+v"(lane));
    const int hi = lane >> 5;
#pragma unroll
    for (int blk = 0; blk < 2; ++blk) { const int tk = clamp_tok(tk0 + dk * (32 * blk + (lane & 31)));
#pragma unroll
        for (int e = 0; e < 2; ++e) kf[blk][e] = *(const u32x4*)(Kg + (size_t)tk * ld + 32 * hi + 16 * e); }
}
__device__ __forceinline__ void priv2_step(u32x4 (&kf)[2][2], LAS char* vpriv, const unsigned char* Kg, const bf16_t* Vg, int ld, int tk0, int dk, bool g0, bool g1,
                                           bool has_next, int tk0n, int dkn, const u32x4 (&qr)[2][2], f32x16 (&o)[2][2], float (&lsum)[2], int tq0, int tq1, int lane_) {
    int lane = lane_; asm volatile("" : "+v"(lane));
    const int hi = lane >> 5;
    const int vlane = (4 * hi + ((lane & 15) >> 2)) * VSTR + (16 * ((lane >> 4) & 1) + 4 * (lane & 3)) * 2;
    u32x4 vr[8];
#pragma unroll
    for (int i = 0; i < 8; ++i) { const int idx = i * 64 + lane, row = idx >> 3, ch = idx & 7; const int tk = clamp_tok(tk0 + dk * row); vr[i] = *(const u32x4*)(Vg + (size_t)tk * ld + ch * 8); }
    const int gfirst = g0 ? 0 : 1, glast = g1 ? 1 : 0;
    f32x16 p0, p1; bf16x8 pf[2][2]; int mb, mr;
    if (gfirst == 0) qk_tile(p0, p1, kf, qr[0]); else qk_tile(p0, p1, kf, qr[1]);
    __builtin_amdgcn_sched_barrier(0);
#pragma unroll
    for (int i = 0; i < 8; ++i) { const int idx = i * 64 + lane; *(LAS u32x4*)(vpriv + (idx >> 3) * VSTR + (idx & 7) * 16) = vr[i]; }
    if (glast == gfirst) { __builtin_amdgcn_sched_barrier(0); if (has_next) priv_kload(kf, Kg, ld, tk0n, dkn, lane); __builtin_amdgcn_sched_barrier(0); }
    mask_params(dk, tk0, gfirst ? tq1 : tq0, hi, mb, mr);
    if (gfirst == 0) exp_tile<true>(p0, p1, lsum[0], pf, mb, mr, dk); else exp_tile<true>(p0, p1, lsum[1], pf, mb, mr, dk);
    { bf16x8 vfa[4], vfb[4]; vread(vfa, vpriv + vlane, 0); vread(vfb, vpriv + vlane, 1);
      if (gfirst == 0) { pv_half(o[0][0], vfa, pf); pv_half(o[0][1], vfb, pf); } else { pv_half(o[1][0], vfa, pf); pv_half(o[1][1], vfb, pf); } }
    if (glast != gfirst) {
        qk_tile(p0, p1, kf, qr[1]);
        __builtin_amdgcn_sched_barrier(0);
        if (has_next) priv_kload(kf, Kg, ld, tk0n, dkn, lane);
        __builtin_amdgcn_sched_barrier(0);
        mask_params(dk, tk0, tq1, hi, mb, mr);
        exp_tile<true>(p0, p1, lsum[1], pf, mb, mr, dk);
        bf16x8 vfa[4], vfb[4]; vread(vfa, vpriv + vlane, 0); vread(vfb, vpriv + vlane, 1);
        pv_half(o[1][0], vfa, pf); pv_half(o[1][1], vfb, pf);
    }
}
__device__ __forceinline__ void store_out(const f32x16 (&o)[2], float lsum, unsigned char* dst  , int lane_) {
    int lane = lane_; asm volatile("" : "+v"(lane));
    const int hi = lane >> 5;
    float l = lsum + shx(lsum, 32, lane);
    const float inv = A8S / l;
#pragma unroll
    for (int d0 = 0; d0 < 2; ++d0) {
        unsigned pc[4];
#pragma unroll
        for (int g = 0; g < 4; ++g) pc[g] = pack4_fp8(o[d0][4 * g] * inv, o[d0][4 * g + 1] * inv, o[d0][4 * g + 2] * inv, o[d0][4 * g + 3] * inv);
        const auto s0 = __builtin_amdgcn_permlane32_swap(pc[0], pc[2], false, false), s1 = __builtin_amdgcn_permlane32_swap(pc[1], pc[3], false, false);
        u32x4 w; w.x = s0[0]; w.y = s0[1]; w.z = s1[0]; w.w = s1[1];
        *(u32x4*)(dst + 32 * d0 + 16 * hi) = w;
    }
}
}

struct Args { const float* in[18]; float* out; unsigned char* ws; int ph_lo, ph_hi; };
constexpr int PH_PRO = 0, PH_L0 = 1, PH_PER_LAYER = 9, PH_FINAL = PH_L0 + 2 * PH_PER_LAYER, NPH = PH_FINAL + 1;
enum { P_NORM1 = 0, P_INPROJ, P_ATTN, P_PAB, P_OUT, P_NORM2, P_PLACE, P_GU, P_DOWN };

__device__ __forceinline__ int tile256_srccol(int P) { const int p = P & 255; return (P & ~255) + 64 * ((p >> 5) & 3) + 16 * ((p >> 3) & 3) + 8 * (p >> 7) + (p & 7); }
template <int MAP, bool W8 = false>
__device__ __forceinline__ void transpose_item(const float* W, int N, int col0, bf16_t* dst, int dst_row0, int K, int k0, LAS float* scr, int lane, int dk0 = 0  ) {
    const int sc = (MAP == 1) ? inproj_srccol(col0 + lane) : (MAP == 2) ? tile256_srccol(col0 + lane) : col0 + lane;
    const float* src = W + (size_t)k0 * N + sc;
#pragma unroll 16
    for (int i = 0; i < 64; ++i) scr[i * 65 + lane] = src[(size_t)i * N];
    asm volatile("s_waitcnt lgkmcnt(0)" ::: "memory");
    const int c = lane & 7, nn = lane >> 3;
#pragma unroll
    for (int j = 0; j < 8; ++j) { const int n = nn + 8 * j; const LAS float* s = scr + (8 * c) * 65 + n;
        if (W8) { u32x2 w; w.x = pack4_fp8(s[0] * W8S, s[65] * W8S, s[2 * 65] * W8S, s[3 * 65] * W8S); w.y = pack4_fp8(s[4 * 65] * W8S, s[5 * 65] * W8S, s[6 * 65] * W8S, s[7 * 65] * W8S);
            *(u32x2*)((unsigned char*)dst + (size_t)(dst_row0 + n) * K + dk0 + k0 + 8 * c) = w; continue; }
        u32x4 w; w.x = cvt_pk_bf16(s[0], s[65]); w.y = cvt_pk_bf16(s[2 * 65], s[3 * 65]); w.z = cvt_pk_bf16(s[4 * 65], s[5 * 65]); w.w = cvt_pk_bf16(s[6 * 65], s[7 * 65]);
        *(u32x4*)(dst + (size_t)(dst_row0 + n) * K + dk0 + k0 + 8 * c) = w; }
    asm volatile("s_waitcnt lgkmcnt(0)" ::: "memory");
}


template <bool XF32, bool COMBINE, bool NORM, bool ROUTER, bool OUTF32, int H8 = 0  >
__device__ __forceinline__ void row_phase(LAS unsigned char* lds, int tid, int lane, int wave, int G, int bx, const float* xf, bf16_t* xb, float* outf, const float* gv,
                                          const float* modl, int sh_off, int sc_off, const float* modprev, bf16_t* Hh, const unsigned char* Ym, const int* Pos, float* Tw,
                                          const bf16_t* Wr, int* Te, int* Trk, int* Cnt, unsigned char* H8p = nullptr) {
    constexpr int RB = COMBINE ? 2 : ROWB;
    LAS float* lgs = (LAS float*)lds;
    LAS int* lcnt = (LAS int*)(lds + 40960);
    asm volatile("" : "+v"(tid), "+v"(lane));
    for (int chunk = bx; chunk < 256; chunk += G) {
        const int b = chunk >> 3;
        if (ROUTER) { if (tid < 32) lcnt[tid] = 0; }
        f32x4 pre[4], shv[4], g2[4];
#pragma unroll
        for (int j = 0; j < 4; ++j) { const int col = 512 * (j >> 1) + 8 * lane + 4 * (j & 1);
            if (NORM) { const f32x4 gg = *(const f32x4*)(gv + col), sc = *(const f32x4*)(modl + (size_t)b * MODW + sc_off + col);
                pre[j] = gg * (1.0f + sc); shv[j] = *(const f32x4*)(modl + (size_t)b * MODW + sh_off + col); }
            if (COMBINE) g2[j] = *(const f32x4*)(modprev + (size_t)b * MODW + 5 * DM + col); }
        f32x4 rawf[XF32 ? RB : 1][4]; u32x4 rawb[XF32 ? 1 : RB][2]; int pp[COMBINE ? RB : 1][2]; float pw[COMBINE ? RB : 1][2];
#define ROW_LOAD(rb_) do { _Pragma("unroll") for (int i = 0; i < RB; ++i) { const size_t ro = (size_t)((rb_) + i) * DM; \
            if (XF32) { _Pragma("unroll") for (int j = 0; j < 4; ++j) rawf[XF32 ? i : 0][j] = *(const f32x4*)(xf + ro + 512 * (j >> 1) + 8 * lane + 4 * (j & 1)); } \
            else { _Pragma("unroll") for (int h = 0; h < 2; ++h) rawb[XF32 ? 0 : i][h] = *(const u32x4*)(xb + ro + 512 * h + 8 * lane); } \
            if (COMBINE) { pp[COMBINE ? i : 0][0] = Pos[2 * ((rb_) + i)]; pp[COMBINE ? i : 0][1] = Pos[2 * ((rb_) + i) + 1]; pw[COMBINE ? i : 0][0] = Tw[2 * ((rb_) + i)]; pw[COMBINE ? i : 0][1] = Tw[2 * ((rb_) + i) + 1]; } } } while (0)
        ROW_LOAD(chunk * 256 + wave * 32);
#pragma unroll 1
        for (int r0 = 0; r0 < 32; r0 += RB) {
            const int rowb = chunk * 256 + wave * 32 + r0;
            f32x4 v[RB][4]; int cp[COMBINE ? RB : 1][2]; float cw[COMBINE ? RB : 1][2];
#pragma unroll
            for (int i = 0; i < RB; ++i) {
                if (XF32) {
#pragma unroll
                    for (int j = 0; j < 4; ++j) v[i][j] = rawf[XF32 ? i : 0][j];
                } else {
#pragma unroll
                    for (int h = 0; h < 2; ++h) { const u32x4 w = rawb[XF32 ? 0 : i][h];
                        v[i][2 * h] = (f32x4){bf_lo(w.x), bf_hi(w.x), bf_lo(w.y), bf_hi(w.y)}; v[i][2 * h + 1] = (f32x4){bf_lo(w.z), bf_hi(w.z), bf_lo(w.w), bf_hi(w.w)}; }
                }
                if (COMBINE) { cp[i][0] = pp[i][0]; cp[i][1] = pp[i][1]; cw[i][0] = pw[i][0]; cw[i][1] = pw[i][1]; }
            }
            u32x2 ya[COMBINE ? RB : 1][2], yc[COMBINE ? RB : 1][2];
            if (COMBINE) {
#pragma unroll
                for (int i = 0; i < RB; ++i)
#pragma unroll
                    for (int h = 0; h < 2; ++h) { ya[i][h] = *(const u32x2*)(Ym + (size_t)cp[i][0] * DM + 512 * h + 8 * lane); yc[i][h] = *(const u32x2*)(Ym + (size_t)cp[i][1] * DM + 512 * h + 8 * lane); }
            }
            if (r0 + RB < 32) ROW_LOAD(rowb + RB);
            if (COMBINE) {
#pragma unroll
                for (int i = 0; i < RB; ++i) {
                    const int row = rowb + i; const float w0 = cw[i][0], w1 = cw[i][1];
#pragma unroll
                    for (int h = 0; h < 2; ++h) { float fa[8], fc[8]; unpack8_fp8(ya[i][h], fa); unpack8_fp8(yc[i][h], fc);
                        const f32x4 m0 = {w0 * fa[0] + w1 * fc[0], w0 * fa[1] + w1 * fc[1], w0 * fa[2] + w1 * fc[2], w0 * fa[3] + w1 * fc[3]};
                        const f32x4 m1 = {w0 * fa[4] + w1 * fc[4], w0 * fa[5] + w1 * fc[5], w0 * fa[6] + w1 * fc[6], w0 * fa[7] + w1 * fc[7]};
                        v[i][2 * h] = v[i][2 * h] + g2[2 * h] * m0; v[i][2 * h + 1] = v[i][2 * h + 1] + g2[2 * h + 1] * m1;
                        if (OUTF32) { *(f32x4*)(outf + (size_t)row * DM + 512 * h + 8 * lane) = v[i][2 * h]; *(f32x4*)(outf + (size_t)row * DM + 512 * h + 8 * lane + 4) = v[i][2 * h + 1]; }
                        else *(u32x4*)(xb + (size_t)row * DM + 512 * h + 8 * lane) = pg8::pack8(v[i][2 * h], v[i][2 * h + 1]); }
                }
            }
            if (NORM) {
                float ss[RB];
#pragma unroll
                for (int i = 0; i < RB; ++i) { ss[i] = 0.f;
#pragma unroll
                    for (int j = 0; j < 4; ++j) { const f32x4 q = v[i][j] * v[i][j]; ss[i] += (q[0] + q[1]) + (q[2] + q[3]); } }
#pragma unroll
                for (int o = 1; o < 64; o <<= 1)
#pragma unroll
                    for (int i = 0; i < RB; ++i) ss[i] += shx(ss[i], o, lane);
#pragma unroll
                for (int i = 0; i < RB; ++i) { const float rstd = __builtin_amdgcn_rsqf(ss[i] * (1.0f / DM) + 1e-6f);
#pragma unroll
                    for (int h = 0; h < 2; ++h) { const f32x4 h0 = v[i][2 * h] * rstd * pre[2 * h] + shv[2 * h], h1 = v[i][2 * h + 1] * rstd * pre[2 * h + 1] + shv[2 * h + 1];
                        if (H8 != 0) *(u32x2*)((H8 == 2 ? H8p : (unsigned char*)Hh) + (size_t)(rowb + i) * DM + 512 * h + 8 * lane) = (u32x2){pack4_fp8(h0[0], h0[1], h0[2], h0[3]), pack4_fp8(h1[0], h1[1], h1[2], h1[3])};
                        if (H8 != 1) *(u32x4*)(Hh + (size_t)(rowb + i) * DM + 512 * h + 8 * lane) = pg8::pack8(h0, h1); } }
            }
        }
#undef ROW_LOAD
        if (ROUTER) {
            __syncthreads();
            const int row0 = chunk * 256 + wave * 32;
            f32x4 ra[2][2];
#pragma unroll
            for (int mt = 0; mt < 2; ++mt)
#pragma unroll
                for (int et = 0; et < 2; ++et) ra[mt][et] = (f32x4){0.f, 0.f, 0.f, 0.f};
#pragma unroll 4
            for (int kk = 0; kk < 32; ++kk) {
                bf16x8 a[2], bb[2];
#pragma unroll
                for (int mt = 0; mt < 2; ++mt) a[mt] = *(const bf16x8*)(Hh + (size_t)(row0 + 16 * mt + (lane & 15)) * DM + 32 * kk + 8 * (lane >> 4));
#pragma unroll
                for (int et = 0; et < 2; ++et) bb[et] = *(const bf16x8*)(Wr + (size_t)(16 * et + (lane & 15)) * DM + 32 * kk + 8 * (lane >> 4));
#pragma unroll
                for (int mt = 0; mt < 2; ++mt)
#pragma unroll
                    for (int et = 0; et < 2; ++et) ra[mt][et] = __builtin_amdgcn_mfma_f32_16x16x32_bf16(a[mt], bb[et], ra[mt][et], 0, 0, 0);
            }
#pragma unroll
            for (int mt = 0; mt < 2; ++mt)
#pragma unroll
                for (int et = 0; et < 2; ++et)
#pragma unroll
                    for (int r = 0; r < 4; ++r) lgs[(wave * 32 + 16 * mt + 4 * (lane >> 4) + r) * 33 + 16 * et + (lane & 15)] = ra[mt][et][r];
            asm volatile("s_waitcnt lgkmcnt(0)" ::: "memory");
            if (lane < 32) {
                const int tl = wave * 32 + lane, tok = chunk * 256 + tl;
                float lg[32]; float M = -3.0e38f;
#pragma unroll
                for (int e = 0; e < 32; ++e) { lg[e] = lgs[tl * 33 + e]; M = fmaxf(M, lg[e]); }
                float bm1 = 0.f, bm2 = 0.f, bsc = -1.f; int bi1 = 0, bi2 = 0, bg = 0;
#pragma unroll
                for (int g = 0; g < 4; ++g) {
                    float m1 = -3.0e38f, m2 = -3.0e38f; int i1 = 0, i2 = 0;
#pragma unroll
                    for (int j = 0; j < 8; ++j) { const float vv = lg[8 * g + j];
                        if (vv > m1) { m2 = m1; i2 = i1; m1 = vv; i1 = j; } else if (vv > m2) { m2 = vv; i2 = j; } }
                    const float sc = expf(m1 - M) + expf(m2 - M);
                    if (sc > bsc) { bsc = sc; bg = g; bm1 = m1; bm2 = m2; bi1 = i1; bi2 = i2; }
                }
                const int e0 = 8 * bg + bi1, e1 = 8 * bg + bi2;
                const float w0 = 1.0f / (1.0f + expf(bm2 - bm1)), w1 = 1.0f - w0;
                const int r0 = __hip_atomic_fetch_add(&lcnt[e0], 1, __ATOMIC_RELAXED, __HIP_MEMORY_SCOPE_WORKGROUP);
                const int r1 = __hip_atomic_fetch_add(&lcnt[e1], 1, __ATOMIC_RELAXED, __HIP_MEMORY_SCOPE_WORKGROUP);
                Te[2 * tok] = e0; Te[2 * tok + 1] = e1; Trk[2 * tok] = r0; Trk[2 * tok + 1] = r1; Tw[2 * tok] = w0; Tw[2 * tok + 1] = w1;
            }
            __syncthreads();
            if (tid < 32) Cnt[chunk * 32 + tid] = lcnt[tid];
            __syncthreads();
        }
    }
}

#define x_in ((const float*)(const GAS float*)args.in[0])
#define c_in ((const float*)(const GAS float*)args.in[1])
#define w_ada ((const float*)(const GAS float*)args.in[2])
#define b_ada ((const float*)(const GAS float*)args.in[3])
#define g_mix ((const float*)(const GAS float*)args.in[4])
#define w_in ((const float*)(const GAS float*)args.in[5])
#define qn_a ((const float*)(const GAS float*)args.in[6])
#define kn_a ((const float*)(const GAS float*)args.in[7])
#define qn_b ((const float*)(const GAS float*)args.in[8])
#define kn_b ((const float*)(const GAS float*)args.in[9])
#define w_pa ((const float*)(const GAS float*)args.in[10])
#define w_pb ((const float*)(const GAS float*)args.in[11])
#define w_out ((const float*)(const GAS float*)args.in[12])
#define g_ffn ((const float*)(const GAS float*)args.in[13])
#define w_router ((const float*)(const GAS float*)args.in[14])
#define w_gate ((const float*)(const GAS float*)args.in[15])
#define w_up ((const float*)(const GAS float*)args.in[16])
#define w_down ((const float*)(const GAS float*)args.in[17])
#define MOD ((float*)(GAS float*)(ws + WS_MOD))
#define XB ((bf16_t*)(GAS bf16_t*)(ws + WS_XB))
#define TE ((int*)(GAS int*)(ws + WS_TE))
#define TRK ((int*)(GAS int*)(ws + WS_TRK))
#define TW ((float*)(GAS float*)(ws + WS_TW))
#define POS ((int*)(GAS int*)(ws + WS_POS))
#define CNT ((int*)(GAS int*)(ws + WS_CNT))
#define BLKE ((int*)(GAS int*)(ws + WS_BLKE))
#define BTOK ((int*)(GAS int*)(ws + WS_BTOK))
#define WR ((bf16_t*)(bf16_t*)(GAS bf16_t*)(ws + WS_WR))
#define H ((bf16_t*)(bf16_t*)(GAS bf16_t*)(ws + WS_H))
#define YAB ((bf16_t*)(GAS bf16_t*)(ws + WS_H))
#define YA ((bf16_t*)(bf16_t*)(GAS bf16_t*)(ws + WS_H))
#define YB ((bf16_t*)(bf16_t*)(GAS bf16_t*)(ws + WS_H + 64 * MiB))
#define QA ((bf16_t*)(bf16_t*)(GAS bf16_t*)(ws + WS_QKV))
#define KA ((bf16_t*)(bf16_t*)(GAS bf16_t*)(ws + WS_QKV + 64 * MiB))
#define VA ((bf16_t*)(bf16_t*)(GAS bf16_t*)(ws + WS_QKV + 128 * MiB))
#define QB ((bf16_t*)(bf16_t*)(GAS bf16_t*)(ws + WS_QKV + 192 * MiB))
#define KB ((bf16_t*)(bf16_t*)(GAS bf16_t*)(ws + WS_QKV + 256 * MiB))
#define VB ((bf16_t*)(bf16_t*)(GAS bf16_t*)(ws + WS_QKV + 272 * MiB))
#define MERGED ((bf16_t*)(bf16_t*)(GAS bf16_t*)(ws + WS_QKV))
#define YM ((unsigned char*)(GAS unsigned char*)(ws + WS_QKV))
#define H2F8 ((unsigned char*)(GAS unsigned char*)(ws + WS_QKV + 160 * MiB))
#define SA ((bf16_t*)(bf16_t*)(GAS bf16_t*)(ws + WS_GATE))
#define SB ((bf16_t*)(bf16_t*)(GAS bf16_t*)(ws + WS_GATE + 128 * MiB))
#define ACT ((bf16_t*)(bf16_t*)(GAS bf16_t*)(ws + WS_GATE))
#define PHASE_ENTER() int lane; asm volatile("v_mbcnt_lo_u32_b32 %0, -1, 0\n\tv_mbcnt_hi_u32_b32 %0, -1, %0" : "=v"(lane)); const int tid = wave * 64 + lane; GAS unsigned char* ws = ws0; int bx = bx0, vcu = vcu0; asm volatile("" : "+s"(ws), "+s"(bx), "+s"(vcu))

__device__ __forceinline__ bool in_phase(int lo, int hi, int k) { asm volatile("" : "+s"(lo), "+s"(hi)); return lo <= k && k < hi; }
#define PGATE_A SA
#define PGATE_B SB
__global__ void __launch_bounds__(512, 2) fwd_kernel(Args args) {
    extern __shared__ __attribute__((aligned(16))) unsigned char lds_raw[];
    LAS unsigned char* lds = (LAS unsigned char*)lds_raw;
    volatile LAS unsigned* MISC = (volatile LAS unsigned*)(lds + MISC_OFF);
    const int tid0 = threadIdx.x, lane0 = tid0 & 63, wave = __builtin_amdgcn_readfirstlane(tid0 >> 6);
    const int G = gridDim.x, bx0 = blockIdx.x;
    const int vcu0 = (G % 8 == 0) ? (bx0 % 8) * (G / 8) + bx0 / 8 : bx0;
    GAS unsigned char* ws0 = (GAS unsigned char*)args.ws;
    float* out = (float*)(GAS float*)args.out;
    for (int u = tid0; u < 256; u += 512) ((LAS unsigned*)(lds + MISC_OFF))[u] = 0u;
    __syncthreads();
#if MK_ONE_LAUNCH
    XcdBarrier bar = xcd_barrier_post((unsigned*)((GAS unsigned*)(ws0 + WS_CTL) + CW_BAR), MISC + 8);
#define GRID_BAR() do { int l_; asm volatile("v_mbcnt_lo_u32_b32 %0, -1, 0\n\tv_mbcnt_hi_u32_b32 %0, -1, %0" : "=v"(l_)); xcd_barrier(bar, (wave == 0) && (l_ == 0)); } while (0)
#else
#define GRID_BAR() do {} while (0)
#endif
#ifndef PHMASK
#define PHMASK 0xFFFFFFFFu
#endif
#if MK_ONE_LAUNCH
#define IN(k) true
#else
#define IN(k) in_phase(args.ph_lo, args.ph_hi, (k))
#endif
#define EN(bit) ((PHMASK >> (bit)) & 1u)
#define SEAM(k) do { if (IN(k) && IN((k) + 1)) GRID_BAR(); } while (0)

    if (EN(0) && IN(PH_PRO)) {
        PHASE_ENTER();
#pragma unroll 1
        for (int rep = 0; rep < REP_PRO; ++rep) {
        LAS float* scr = (LAS float*)(lds + wave * 16640);
        const int gw = vcu * 8 + wave, NGW = G * 8;
        constexpr int I_IN = 68 * 16, I_PA = 16 * 8, I_OUT = 16 * 16, I_GU = 32 * 2 * 8 * 16, I_DN = 32 * 16 * 8;
        constexpr int I_LAYER = I_IN + 2 * I_PA + I_OUT + I_GU + I_DN;
        for (int it = gw; it < 2 * I_LAYER; it += NGW) {
            const int l = it / I_LAYER; int r = it % I_LAYER;
            if (r < I_IN) { const int nb = r / 16, kb = r % 16;
                transpose_item<1, true>(w_in + (size_t)l * DM * NC, NC, 64 * nb, (bf16_t*)(GAS bf16_t*)(ws + WS_WIN + l * WIN_BYTES), 64 * nb, DM, 64 * kb, scr, lane); continue; } r -= I_IN;
            if (r < I_PA) { const int nb = r / 8, kb = r % 8;
                transpose_item<2, true>(w_pa + (size_t)l * 512 * DM, DM, 64 * nb, (bf16_t*)(GAS bf16_t*)(ws + WS_WPA + l * 2 * MiB), 64 * nb, DM, 64 * kb, scr, lane, 0); continue; } r -= I_PA;
            if (r < I_PA) { const int nb = r / 8, kb = r % 8;
                transpose_item<2, true>(w_pb + (size_t)l * 512 * DM, DM, 64 * nb, (bf16_t*)(GAS bf16_t*)(ws + WS_WPA + l * 2 * MiB), 64 * nb, DM, 64 * kb, scr, lane, 512); continue; } r -= I_PA;
            if (r < I_OUT) { const int nb = r / 16, kb = r % 16;
                transpose_item<2, true>(w_out + (size_t)l * DM * DM, DM, 64 * nb, (bf16_t*)(GAS bf16_t*)(ws + WS_WOUT + l * 2 * MiB), 64 * nb, DM, 64 * kb, scr, lane); continue; } r -= I_OUT;
            if (r < I_GU) { const int e = r / 256, q = r % 256, up = q / 128, nb = (q % 128) / 16, kb = q % 16;
                const float* src = (up ? w_up : w_gate) + ((size_t)l * NEXP + e) * DM * DFF;
                const int c0 = 64 * nb, drow = 256 * (c0 >> 7) + 128 * up + (c0 & 127);
                transpose_item<0, GU_F8 != 0>(src, DFF, c0, (bf16_t*)(GAS bf16_t*)(ws + WS_WGU + ((size_t)l * NEXP + e) * (GU_F8 ? MiB : 2 * MiB)), drow, DM, 64 * kb, scr, lane); continue; } r -= I_GU;
            { const int e = r / 128, q = r % 128, nb = q / 8, kb = q % 8;
                transpose_item<2, DN_F8 != 0>(w_down + ((size_t)l * NEXP + e) * DFF * DM, DM, 64 * nb, (bf16_t*)(GAS bf16_t*)(ws + WS_WDN + ((size_t)l * NEXP + e) * (DN_F8 ? MiB / 2 : MiB)), 64 * nb, DFF, 64 * kb, scr, lane); }
        }
        for (int i = (vcu * 512 + tid); i < 32 * DM; i += G * 512) { const int e = i >> 10, k = i & 1023; WR[i] = (bf16_t)(cvt_pk_bf16(w_router[(size_t)k * NEXP + e], 0.f) & 0xffffu); }
        __syncthreads();
        if (vcu * 8 < 384) {
            LAS float* cond = (LAS float*)lds;
            for (int i = tid; i < NB * DM; i += 512) { const int b = i >> 10, k = i & 1023; const float cv = c_in[i]; cond[k * 32 + b] = cv / (1.0f + expf(-cv)); }
            __syncthreads();
            for (int it = gw; it < 384; it += NGW) {
                const int l = it / 192, n0 = (it % 192) * 32;
                const float* wp = w_ada + (size_t)l * DM * MODW + n0 + (lane & 31) + (size_t)(lane >> 5) * MODW;
                const LAS float* cp = cond + (lane >> 5) * 32 + (lane & 31);
                f32x16 acc;
#pragma unroll
                for (int r = 0; r < 16; ++r) acc[r] = 0.f;
#pragma unroll 16
                for (int k0 = 0; k0 < DM; k0 += 2) acc = __builtin_amdgcn_mfma_f32_32x32x2f32(cp[k0 * 32], wp[(size_t)k0 * MODW], acc, 0, 0, 0);
                const float bias = b_ada[l * MODW + n0 + (lane & 31)];
#pragma unroll
                for (int r = 0; r < 16; ++r) { const int b = (r & 3) + 8 * (r >> 2) + 4 * (lane >> 5); MOD[((size_t)l * NB + b) * MODW + n0 + (lane & 31)] = acc[r] + bias; }
            }
        }
        __syncthreads();
        }
    }
    SEAM(PH_PRO);

    for (int l = 0; l < 2; ++l) {
        const int pb = PH_L0 + l * PH_PER_LAYER;
        if (EN(1) && IN(pb + P_NORM1)) { PHASE_ENTER(); const float* modl = MOD + (size_t)l * NB * MODW;
            if (l == 0) {
#pragma unroll 1
                for (int rep = 0; rep < REP_NORM1; ++rep)
                    row_phase<true, false, true, false, false, 1>(lds, tid, lane, wave, G, bx, x_in, XB, out, g_mix, modl, 0, DM, MOD, H, YM, POS, TW, WR, TE, TRK, CNT);
            } else row_phase<false, true, true, false, false, 1>(lds, tid, lane, wave, G, bx, x_in, XB, out, g_mix + DM, modl, 0, DM, MOD, H, YM, POS, TW, WR, TE, TRK, CNT); }
            {
                SEAM(pb + P_NORM1);
                if (EN(2) && IN(pb + P_INPROJ)) {
                    PHASE_ENTER();
                    pg8::Gemm g{H, (const bf16_t*)(const GAS bf16_t*)(ws + WS_WIN + l * WIN_BYTES), DM / 2}; pg8::StaticOrder S; S.init(TT, NC, G, bx); S.wgm = INPROJ_WGM;
                    LAS float* normw = (LAS float*)(lds + MISC_OFF + 1024);
                    if (tid < 256) { const int sel = tid >> 6, d = tid & 63; const float* srcw = (sel == 0) ? qn_a : (sel == 1) ? kn_a : (sel == 2) ? qn_b : kn_b; normw[tid] = srcw[l * 64 + d]; }
                    __syncthreads();
                    pg8::EpiInProj E{QA, KA, VA, QB, KB, VB, SA, SB, normw};
#pragma unroll 1
                    for (int rep = 0; rep < REP_INPROJ; ++rep)
                    pg8::gemm_phase<pg8::EpiInProj, pg8::StaticOrder, true>(lds, g, S, E, wave);
                }
                SEAM(pb + P_INPROJ);
                if (EN(3) && IN(pb + P_ATTN)) {
                    PHASE_ENTER(); (void)lane;
                    LAS char* ring = (LAS char*)lds;
#pragma unroll 1
                    for (int rep = 0; rep < REP_ATTB; ++rep)
                    for (int L = vcu; L < NB * 32; L += G) {
                        int lane; asm volatile("v_mbcnt_lo_u32_b32 %0, -1, 0\n\tv_mbcnt_hi_u32_b32 %0, -1, %0" : "=v"(lane)); const int hi = lane >> 5;
                        const int b = L >> 5, kvh = (L >> 4) & 1, qh = 4 * kvh + ((L >> 2) & 3), qb2 = L & 3;
                        const int tq0 = 512 * qb2 + 64 * wave + (lane & 31);
                        u32x4 qr[2][2];
#pragma unroll
                        for (int g = 0; g < 2; ++g)
#pragma unroll
                            for (int e = 0; e < 2; ++e) qr[g][e] = *(const u32x4*)((const unsigned char*)QB + ((size_t)b * SEQ + tq0 + 32 * g) * 512 + qh * 64 + 32 * hi + 16 * e);
                        f32x16 o[2][2]; float lsum[2] = {0.f, 0.f};
#pragma unroll
                        for (int r = 0; r < 16; ++r) { o[0][0][r] = 0.f; o[0][1][r] = 0.f; o[1][0][r] = 0.f; o[1][1][r] = 0.f; }
                        __syncthreads();
                        att::dense64_lag_loop(ring, (const unsigned char*)KB + (size_t)b * SEQ * 128 + kvh * 64, VB + (size_t)b * SEQ * 128 + kvh * 64, 128, 32, qr, o, lsum, lane, wave, wave >= 4);
                        { int l2; asm volatile("v_mbcnt_lo_u32_b32 %0, -1, 0\n\tv_mbcnt_hi_u32_b32 %0, -1, %0" : "=v"(l2)); const int tqs = 512 * qb2 + 64 * wave + (l2 & 31);
#pragma unroll
                          for (int g = 0; g < 2; ++g) att::store_out(o[g], lsum[g], (unsigned char*)YAB + ((size_t)b * SEQ + tqs + 32 * g) * DM + 512 + qh * 64, l2); }
                    }
#pragma unroll 1
                    for (int rep = 0; rep < REP_ATTA; ++rep)
                    for (int L = vcu; L < NB * 32; L += G) {
                        int lane; asm volatile("v_mbcnt_lo_u32_b32 %0, -1, 0\n\tv_mbcnt_hi_u32_b32 %0, -1, %0" : "=v"(lane)); const int hi = lane >> 5;
                        const int b = L >> 5, h = (L >> 2) & 7, tb2 = L & 3, base = 512 * tb2;
                        const int tq0 = base + 16 * (lane & 31) + wave, tq1 = tq0 + 8;
                        const unsigned char* Kg = (const unsigned char*)KA + (size_t)b * SEQ * 512 + h * 64; const bf16_t* Vg = VA + (size_t)b * SEQ * 512 + h * 64;
                        u32x4 qr[2][2];
#pragma unroll
                        for (int g = 0; g < 2; ++g)
#pragma unroll
                            for (int e = 0; e < 2; ++e) qr[g][e] = *(const u32x4*)((const unsigned char*)QA + ((size_t)b * SEQ + tq0 + 8 * g) * 512 + h * 64 + 32 * hi + 16 * e);
                        f32x16 o[2][2]; float lsum[2] = {0.f, 0.f};
#pragma unroll
                        for (int r = 0; r < 16; ++r) { o[0][0][r] = 0.f; o[0][1][r] = 0.f; o[1][0][r] = 0.f; o[1][1][r] = 0.f; }
                        __syncthreads();
                        att::dense64_loop<true>(ring, Kg, Vg, 512, base - 64, 10, qr, o, lsum, tq0, tq1, lane, wave);
                        __syncthreads();
                        {
                            LAS char* vpriv = ring + att::PRIV_OFF + wave * att::VTILE;
#define A_TK0(j) ((j) < 4 ? base + wave - 256 + 256 * (j) : wave + 8 * (((j) - 4) >> 1) + 1024 * (((j) - 4) & 1))
#define A_DK(j) ((j) < 4 ? 4 : 16)
                            u32x4 kf[2][2];
                            att::priv_kload(kf, Kg, 512, A_TK0(0), 4, lane);
#pragma unroll 1
                            for (int j = 0; j < 8; ++j) {
                                const bool p2 = j < 4; const int g = (j - 4) >> 1;
                                att::priv2_step(kf, vpriv, Kg, Vg, 512, A_TK0(j), A_DK(j), p2 || g == 0, p2 || g == 1, j + 1 < 8, A_TK0(j + 1), A_DK(j + 1), qr, o, lsum, tq0, tq1, lane);
                            }
#undef A_TK0
#undef A_DK
                        }
                        { int l2; asm volatile("v_mbcnt_lo_u32_b32 %0, -1, 0\n\tv_mbcnt_hi_u32_b32 %0, -1, %0" : "=v"(l2)); const int tqs = base + 16 * (l2 & 31) + wave;
#pragma unroll
                          for (int g = 0; g < 2; ++g) att::store_out(o[g], lsum[g], (unsigned char*)YAB + ((size_t)b * SEQ + tqs + 8 * g) * DM + h * 64, l2); }
                    }
                    __syncthreads();
                }
                SEAM(pb + P_ATTN);
                if (EN(4) && IN(pb + P_PAB)) {
                    PHASE_ENTER();
                    pg8::StaticOrder S; S.init(TT, DM, G, bx); S.wgm = N1K_WGM;
                    pg8::Gemm g{YAB, (const bf16_t*)(const GAS bf16_t*)(ws + WS_WPA + l * 2 * MiB), DM / 2}; pg8::EpiMergeFused E{MERGED, (const unsigned char*)PGATE_A, (const unsigned char*)PGATE_B};
#pragma unroll 1
                    for (int rep = 0; rep < REP_PAB; ++rep)
                    pg8::gemm_phase<pg8::EpiMergeFused, pg8::StaticOrder, true>(lds, g, S, E, wave);
                }
                SEAM(pb + P_PAB);
                if (EN(5) && IN(pb + P_OUT)) {
                    PHASE_ENTER(); const float* modl = MOD + (size_t)l * NB * MODW;
                    pg8::Gemm g{MERGED, (const bf16_t*)(const GAS bf16_t*)(ws + WS_WOUT + l * 2 * MiB), DM / 2}; pg8::StaticOrder S; S.init(TT, DM, G, bx); S.rowmajor = OUT_ROWMAJOR; S.wgm = N1K_WGM;
                    pg8::EpiResidB E{(l == 0) ? x_in : (const float*)nullptr, XB, XB, modl + 2 * DM};
#pragma unroll 1
                    for (int rep = 0; rep < ((l == 0) ? REP_OUT : 1); ++rep)
                    pg8::gemm_phase<pg8::EpiResidB, pg8::StaticOrder, true>(lds, g, S, E, wave);
                }
                SEAM(pb + P_OUT);
            }
        if (EN(6) && IN(pb + P_NORM2)) { PHASE_ENTER(); const float* modl = MOD + (size_t)l * NB * MODW;
#pragma unroll 1
            for (int rep = 0; rep < REP_NORM2; ++rep)
            row_phase<false, false, true, true, false, GU_F8 ? 2 : 0>(lds, tid, lane, wave, G, bx, x_in, XB, out, g_ffn + l * DM, modl, 3 * DM, 4 * DM, MOD, H, YM, POS, TW, WR, TE, TRK, CNT, H2F8); }
        SEAM(pb + P_NORM2);
        if (EN(7) && IN(pb + P_PLACE)) {
            PHASE_ENTER();
            LAS int* part_tot = (LAS int*)lds;
            LAS int* part_pre = part_tot + 512;
            LAS int* basee = part_pre + 512;
            LAS int* pstart = basee + 32;
            LAS int* pend = pstart + 32;
            LAS int* tote = pend + 32;
            for (int chunk = bx; chunk < 256; chunk += G) {
                { const int e = tid & 31, part = tid >> 5; int st = 0, sp = 0;
                    for (int q = 0; q < 16; ++q) { const int ch = part * 16 + q; const int v = CNT[ch * 32 + e]; st += v; sp += (ch < chunk) ? v : 0; }
                    part_tot[part * 32 + e] = st; part_pre[part * 32 + e] = sp; }
                __syncthreads();
                if (tid < 32) { int st = 0, sp = 0; for (int q = 0; q < 16; ++q) { st += part_tot[q * 32 + tid]; sp += part_pre[q * 32 + tid]; } tote[tid] = st; basee[tid] = sp; }
                __syncthreads();
                if (tid == 0) { int run = 0; for (int e = 0; e < 32; ++e) { const int padded = (tote[e] + 255) & ~255; pstart[e] = run; basee[e] += run; run += padded; pend[e] = run; } }
                __syncthreads();
                { const int tok = chunk * 256 + (tid >> 1), slot = tid & 1; const int e = TE[2 * tok + slot], rk = TRK[2 * tok + slot]; const int dest = basee[e] + rk;
                    BTOK[dest] = tok; POS[2 * tok + slot] = dest; }
                if (chunk < 32) { const int e = chunk; const int from = pstart[e] + tote[e], n = pend[e] - from; if (tid < n) BTOK[from + tid] = 0; }
                if (chunk == 0) {
                    for (int blk = tid; blk < NBLK; blk += 512) { int e = 0; for (int q = 0; q < 32; ++q) e += (pend[q] <= blk * 256) ? 1 : 0; BLKE[blk] = e > 31 ? 31 : e; }
                    if (tid == 0) BLKE[1000] = pend[31] >> 8;
                }
                __syncthreads();
            }
        }
        SEAM(pb + P_PLACE);
        if (EN(8) && IN(pb + P_GU)) {
            PHASE_ENTER();
            const int nused = BLKE[1000];
            pg8::Gemm g{GU_F8 ? (const bf16_t*)H2F8 : H, (const bf16_t*)(const GAS bf16_t*)(ws + WS_WGU + (size_t)l * NEXP * (GU_F8 ? MiB : 2 * MiB)), GU_F8 ? DM / 2 : DM};
            pg8::MoeOrder<true> S{BLKE, BTOK, 4 * nused, G, vcu};
            pg8::EpiSwiGLU E{ACT, GU_F8 ? W8I : 1.0f};
#pragma unroll 1
            for (int rep = 0; rep < REP_GU; ++rep)
            pg8::gemm_phase<pg8::EpiSwiGLU, pg8::MoeOrder<true>, GU_F8 != 0>(lds, g, S, E, wave);
        }
        SEAM(pb + P_GU);
        if (EN(9) && IN(pb + P_DOWN)) {
            PHASE_ENTER();
            const int nused = BLKE[1000];
            pg8::Gemm g{ACT, (const bf16_t*)(const GAS bf16_t*)(ws + WS_WDN + (size_t)l * NEXP * (DN_F8 ? MiB / 2 : MiB)), DN_F8 ? DFF / 2 : DFF};
            pg8::MoeOrder<false> S{BLKE, nullptr, 4 * nused, G, vcu};
            pg8::EpiY E{YM};
#pragma unroll 1
            for (int rep = 0; rep < REP_DOWN; ++rep)
            pg8::gemm_phase<pg8::EpiY, pg8::MoeOrder<false>, DN_F8 != 0>(lds, g, S, E, wave);
        }
        SEAM(pb + P_DOWN);
    }
    if (EN(10) && IN(PH_FINAL)) {
        PHASE_ENTER();
        row_phase<false, true, false, false, true>(lds, tid, lane, wave, G, bx, x_in, XB, out, g_ffn, MOD, 0, 0, MOD + (size_t)NB * MODW, H, YM, POS, TW, WR, TE, TRK, CNT);
    }
#undef IN
#undef SEAM
#undef GRID_BAR
}

extern "C" void kernel_launch(void* const* d_in, const int* in_sizes, int n_in, void* d_out, int out_size, void* d_ws, size_t ws_size, hipStream_t stream) {
    static int grid = 0;
    if (grid == 0) {
        if (n_in != 18 || in_sizes[0] != TT * DM || out_size != TT * DM || ws_size < WS_END) { fprintf(stderr, "kernel_launch: unexpected shapes / workspace (n_in %d, ws %zu); nothing launched\n", n_in, ws_size); grid = -1; return; }
        int dev = 0, cus = 0, per_cu = 0;
        if (hipGetDevice(&dev) != hipSuccess || hipDeviceGetAttribute(&cus, hipDeviceAttributeMultiprocessorCount, dev) != hipSuccess) { grid = -1; return; }
        if (hipFuncSetAttribute((const void*)fwd_kernel, hipFuncAttributeMaxDynamicSharedMemorySize, LDS_BYTES) != hipSuccess) { fprintf(stderr, "kernel_launch: hipFuncSetAttribute failed\n"); grid = -1; return; }
        if (hipOccupancyMaxActiveBlocksPerMultiprocessor(&per_cu, (const void*)fwd_kernel, 512, LDS_BYTES) != hipSuccess || per_cu < 1) { fprintf(stderr, "kernel_launch: occupancy query says %d\n", per_cu); per_cu = 1; }
        (void)hipGetLastError();
        grid = cus;
    }
    if (grid < 0) return;
    (void)hipMemsetAsync((char*)d_ws + WS_CTL, 0, CTL_ZERO_BYTES, stream);
    Args a{};
    for (int i = 0; i < 18; ++i) a.in[i] = (const float*)d_in[i];
    a.out = (float*)d_out; a.ws = (unsigned char*)d_ws;
#if MK_ONE_LAUNCH
    a.ph_lo = 0; a.ph_hi = NPH;
    hipLaunchKernelGGL(fwd_kernel, dim3(grid), dim3(512), LDS_BYTES, stream, a);
#else
    for (int p = 0; p < NPH; ++p) { a.ph_lo = p; a.ph_hi = p + 1; hipLaunchKernelGGL(fwd_kernel, dim3(grid), dim3(512), LDS_BYTES, stream, a); }
#endif
}
```

```cpp
#include <hip/hip_runtime.h>
#include <cstdio>
#include <cstdint>

#ifndef INPROJ_WGM
#define INPROJ_WGM 4
#endif
#ifndef GEMM_ALIGN
#define GEMM_ALIGN 1
#endif
#ifndef ROWB
#define ROWB 4
#endif
#ifndef N1K_WGM
#define N1K_WGM 8
#endif
#ifndef OUT_ROWMAJOR
#define OUT_ROWMAJOR 0
#endif
#ifndef REP_PRO
#define REP_PRO 1
#endif
#ifndef REP_ATTB
#define REP_ATTB 1
#endif
#ifndef REP_ATTA
#define REP_ATTA 1
#endif
#ifndef REP_INPROJ
#define REP_INPROJ 1
#endif
#ifndef REP_NORM1
#define REP_NORM1 1
#endif
#ifndef REP_GU
#define REP_GU 1
#endif
#ifndef REP_PAB
#define REP_PAB 1
#endif
#ifndef REP_OUT
#define REP_OUT 1
#endif
#ifndef REP_DOWN
#define REP_DOWN 1
#endif
#ifndef REP_NORM2
#define REP_NORM2 1
#endif
#ifndef GU_F8
#define GU_F8 1
#endif
#ifndef DN_F8
#define DN_F8 1
#endif
#ifndef MK_ONE_LAUNCH
#define MK_ONE_LAUNCH 1
#endif

#define LAS __attribute__((address_space(3)))
#define GAS __attribute__((address_space(1)))
typedef unsigned short bf16_t;
typedef short bf16x8 __attribute__((ext_vector_type(8)));
typedef short s16x4 __attribute__((ext_vector_type(4)));
typedef float f32x4 __attribute__((ext_vector_type(4)));
typedef float f32x16 __attribute__((ext_vector_type(16)));
typedef unsigned u32x4 __attribute__((ext_vector_type(4)));
typedef unsigned u32x2 __attribute__((ext_vector_type(2)));

constexpr int NB = 32, SEQ = 2048, DM = 1024, TT = NB * SEQ;
constexpr int NC = 4352;
constexpr int NEXP = 32, DFF = 512, NPAD = 139264, NBLK = 544;
constexpr int MODW = 6 * DM;
constexpr float QSCALE = 0.125f * 1.4426950408889634f;

constexpr size_t MiB = 1u << 20;
constexpr size_t WS_CTL = 0, CTL_ZERO_BYTES = 64 * 1024;
constexpr size_t WS_MOD = 1 * MiB;
constexpr size_t WS_TE = 2 * MiB + 512 * 1024, WS_TRK = 3 * MiB, WS_TW = 3 * MiB + 512 * 1024, WS_POS = 4 * MiB;
constexpr size_t WS_CNT = 4 * MiB + 512 * 1024;
constexpr size_t WS_BLKE = WS_CNT + 64 * 1024;
constexpr size_t WS_BTOK = WS_CNT + 128 * 1024;
constexpr size_t WS_WR = 5 * MiB + 256 * 1024;
constexpr size_t WS_WIN = 6 * MiB;
constexpr size_t WIN_BYTES = (size_t)NC * DM * 2;
constexpr size_t WS_WPA = 23 * MiB, WS_WPB = 25 * MiB, WS_WOUT = 27 * MiB;
constexpr size_t WS_WGU = 31 * MiB;
constexpr size_t WS_WDN = 159 * MiB;
constexpr size_t WS_H = 223 * MiB;
constexpr size_t WS_QKV = 351 * MiB;
constexpr size_t WS_GATE = 639 * MiB;
constexpr size_t WS_XB = 896 * MiB;
constexpr size_t WS_END = 1024 * MiB;
constexpr int CW_BAR = 4096;

constexpr int RING_BYTES = 133120;
constexpr int MISC_OFF = RING_BYTES;
constexpr int LDS_BYTES = 147456;

#define RLX_AGENT __ATOMIC_RELAXED, __HIP_MEMORY_SCOPE_AGENT
typedef float f32x2_t __attribute__((ext_vector_type(2))); typedef __bf16 bf16x2_t __attribute__((ext_vector_type(2)));
__device__ __forceinline__ unsigned cvt_pk_bf16(float lo, float hi) { const f32x2_t v = {lo, hi}; const bf16x2_t b = __builtin_convertvector(v, bf16x2_t); return __builtin_bit_cast(unsigned, b); }
typedef float f32x2v __attribute__((ext_vector_type(2)));
__device__ __forceinline__ unsigned pack4_fp8(float a, float b, float c, float d) { unsigned w = 0; w = __builtin_amdgcn_cvt_pk_fp8_f32(a, b, w, false); w = __builtin_amdgcn_cvt_pk_fp8_f32(c, d, w, true); return w; }
__device__ __forceinline__ void unpack8_fp8(u32x2 w, float (&o)[8]) { const f32x2v a = __builtin_amdgcn_cvt_pk_f32_fp8(w.x, false), b = __builtin_amdgcn_cvt_pk_f32_fp8(w.x, true), c = __builtin_amdgcn_cvt_pk_f32_fp8(w.y, false), d = __builtin_amdgcn_cvt_pk_f32_fp8(w.y, true);
    o[0] = a.x; o[1] = a.y; o[2] = b.x; o[3] = b.y; o[4] = c.x; o[5] = c.y; o[6] = d.x; o[7] = d.y; }
constexpr float A8S = 4.f, A8I = 0.25f;
constexpr float W8S = 64.f, W8I = 1.f / 64.f;
__device__ __forceinline__ float bf_lo(unsigned w) { return __uint_as_float(w << 16); }
__device__ __forceinline__ float bf_hi(unsigned w) { return __uint_as_float(w & 0xffff0000u); }
__device__ __forceinline__ float shx(float v, int mask, int lane) { return __int_as_float(__builtin_amdgcn_ds_bpermute((lane ^ mask) << 2, __float_as_int(v))); }
__device__ __forceinline__ float wave_sum(float v, int lane) {
#pragma unroll
    for (int o = 1; o < 64; o <<= 1) v += shx(v, o, lane);
    return v;
}
__device__ __forceinline__ float wave_max(float v, int lane) {
#pragma unroll
    for (int o = 1; o < 64; o <<= 1) v = fmaxf(v, shx(v, o, lane));
    return v;
}
__device__ __forceinline__ float sigmoid_f(float x) { return __builtin_amdgcn_rcpf(1.0f + __builtin_amdgcn_exp2f(-1.4426950408889634f * x)); }

#define XB_TMO      128
#define XB_XCNT(j)  (256  + 64 * (j))
#define XB_XSUB(j)  (1280 + 64 * (j))
#define XB_XGEN(j)  (2304 + 64 * (j))
#define XB_TOP      3328
#define XB_TOPGEN   3392
#define XCD_BAR_WORDS 3456
#define XB_SPIN_CAP (1u << 18)

__device__ __forceinline__ unsigned xb_ld(unsigned* p)              { return __hip_atomic_load(p, __ATOMIC_RELAXED, __HIP_MEMORY_SCOPE_AGENT); }
__device__ __forceinline__ unsigned xb_add(unsigned* p, unsigned v) { return __hip_atomic_fetch_add(p, v, __ATOMIC_RELAXED, __HIP_MEMORY_SCOPE_AGENT); }
__device__ __forceinline__ unsigned xb_xcc_id() { return (unsigned)__builtin_amdgcn_s_getreg((3 << 11) | 20) & 0xFu; }
#define XB_SPIN(cond, bar) do { unsigned _sp = 0; while (cond) { __builtin_amdgcn_s_sleep(1); \
    if ((++_sp & 255u) == 0u) { if (xb_ld(&(bar)[XB_TMO])) break; if (_sp > XB_SPIN_CAP) { atomicAdd(&(bar)[XB_TMO], 1u); break; } } } } while (0)

struct XcdBarrier { unsigned* bar; unsigned x; volatile LAS unsigned* st; };

__device__ __forceinline__ XcdBarrier xcd_barrier_post(unsigned* bar, volatile LAS unsigned* st) {
    XcdBarrier b; b.bar = bar; b.x = xb_xcc_id(); b.st = st;
    if (threadIdx.x == 0) (void)xb_add(&bar[XB_XCNT(b.x)], 1u);
    return b;
}
__device__ __forceinline__ void xcd_barrier_complete(unsigned* bar, unsigned x, unsigned& nloc, unsigned& nx) {
    const unsigned G = gridDim.x * gridDim.y * gridDim.z;
    unsigned sum, cnt, mine, sp = 0u;
    for (;;) {
        sum = 0u; cnt = 0u; mine = 0u;
#pragma unroll
        for (unsigned j = 0; j < 16; ++j) { const unsigned c = xb_ld(&bar[XB_XCNT(j)]); sum += c; cnt += (c > 0u) ? 1u : 0u; mine = (j == x) ? c : mine; }
        if (sum == G) break;
        __builtin_amdgcn_s_sleep(1);
        if ((++sp & 255u) == 0u) { if (xb_ld(&bar[XB_TMO])) break; if (sp > XB_SPIN_CAP) { atomicAdd(&bar[XB_TMO], 1u); break; } }
    }
    nloc = mine > 0u ? mine : 1u; nx = cnt > 0u ? cnt : 1u;
}
__device__ __forceinline__ void xcd_barrier(const XcdBarrier& b, const bool is_t0  ) {
    asm volatile("s_waitcnt vmcnt(0)" ::: "memory");
    __syncthreads();
    if (is_t0) {
        unsigned* bar = b.bar; unsigned bx_ = b.x;
        asm volatile("" : "+s"(bar), "+s"(bx_));
        __builtin_amdgcn_s_waitcnt(0);
        unsigned nloc = b.st[0], nx = b.st[1];
        if (nloc == 0u) { xcd_barrier_complete(bar, bx_, nloc, nx); b.st[0] = nloc; b.st[1] = nx; }
        const unsigned old = xb_add(&bar[XB_XSUB(bx_)], 1u);
        const unsigned gen = old / nloc;
        if (old + 1u == (gen + 1u) * nloc) {
            __builtin_amdgcn_fence(__ATOMIC_RELEASE, "agent");
            asm volatile("s_waitcnt vmcnt(0)" ::: "memory");
            const unsigned og = xb_add(&bar[XB_TOP], 1u);
            const unsigned tg = og / nx;
            if (og + 1u == (tg + 1u) * nx) xb_add(&bar[XB_TOPGEN], 1u);
            else XB_SPIN(xb_ld(&bar[XB_TOPGEN]) == tg, bar);
            __builtin_amdgcn_fence(__ATOMIC_ACQUIRE, "agent");
            xb_add(&bar[XB_XGEN(bx_)], 1u);
            asm volatile("s_waitcnt vmcnt(0)" ::: "memory");
        } else {
            XB_SPIN(xb_ld(&bar[XB_XGEN(bx_)]) == gen, bar);
            __builtin_amdgcn_fence(__ATOMIC_ACQUIRE, "agent");
            asm volatile("s_waitcnt vmcnt(0)" ::: "memory");
        }
    }
    __syncthreads();
}

namespace pg8 {
constexpr int BM = 256, BK = 64, HALF = 128, HTB = HALF * BK * 2, STAGE_BYTES = 8 * HTB, NXCD = 8, WGM = 8;
__host__ __device__ __forceinline__ int lds_byte(int r, int c) { const int st = (r >> 4) * 2 + (c >> 5), rr = r & 15, cc = c & 31, ob = rr * 64 + cc * 2; return st * 1024 + (ob ^ (((ob >> 9) & 1) << 5)); }
__host__ __device__ __forceinline__ void stage_rc(int b, int& R, int& C) { const int st = b / 1024, sb = b % 1024, swz = sb ^ (((sb >> 9) & 1) << 5); R = (st >> 1) * 16 + swz / 64; C = (st & 1) * 32 + (swz % 64) / 2; }
__host__ __device__ __forceinline__ int perm32(int rho) { const int n = rho >> 4, i = rho & 15; return 8 * (i >> 2) + 4 * n + (i & 3); }

struct Unit { int pm, pn; };
struct Gemm { const bf16_t* A; const bf16_t* Bt; int K; };

struct StaticOrder {
    static constexpr bool GATHER = false;
    int nM, nN, nwg, G, c, wgm = WGM;
    __device__ void init(int M, int N, int G_, int c_) { asm volatile("" : "+s"(c_));     nM = M / BM; nN = N / BM; nwg = nM * nN; G = G_; c = c_; }
    int rowmajor = 0;
    __device__ __forceinline__ bool next(int i, Unit& u) const {
        if (rowmajor) { const int upw = (nwg + G - 1) / G, k = c * upw + i; if (i >= upw || k >= nwg) return false; u.pm = k / nN; u.pn = k % nN; return true; }
        const long L = (long)i * G + c; if (L >= nwg) return false;
        int wgid = (int)L; { const int q = nwg / NXCD, r = nwg % NXCD, xcd = wgid % NXCD, off = wgid / NXCD; wgid = (xcd < r ? xcd * (q + 1) : r * (q + 1) + (xcd - r) * q) + off; }
        const int nig = wgm * nN, gid = wgid / nig, fm = gid * wgm, gsz = (nM - fm) < wgm ? (nM - fm) : wgm;
        u.pm = fm + ((wgid % nig) % gsz); u.pn = (wgid % nig) / gsz; return true;
    }
    __device__ __forceinline__ void aoff(const Unit&, int, int, unsigned (&)[2][2]) const {}
};
template <bool GATH>
struct MoeOrder {
    static constexpr bool GATHER = GATH;
    const int* blk_e; const int* rowidx; int nunits, G, c;
    __device__ __forceinline__ bool next(int i, Unit& u) const {
        const int L = i * G + c; if (L >= nunits) return false;
        const int blk = L >> 2; const int e = blk_e[blk]; u.pm = blk; u.pn = 4 * e + (L & 3); return true;
    }
    __device__ __forceinline__ void aoff(const Unit& u, int tid_, int K, unsigned (&o)[2][2]) const {
        int tid = tid_; asm volatile("" : "+v"(tid));
#pragma unroll
        for (int i = 0; i < 2; ++i) { int R, C; stage_rc(tid * 16 + i * 8192, R, C);
#pragma unroll
            for (int h = 0; h < 2; ++h) { const int r = u.pm * BM + h * HALF + R; const int src = rowidx ? rowidx[r] : r; o[h][i] = (unsigned)src * (unsigned)(K * 2) + (unsigned)C * 2u; } }
    }
};

typedef int i32x8 __attribute__((ext_vector_type(8))); typedef int i32x4 __attribute__((ext_vector_type(4)));
__device__ __forceinline__ i32x8 cat8(const bf16x8& a, const bf16x8& b) { return __builtin_shufflevector(__builtin_bit_cast(i32x4, a), __builtin_bit_cast(i32x4, b), 0, 1, 2, 3, 4, 5, 6, 7); }
template <class Epi, class Sched, bool F8 = false>
__device__ __forceinline__ void gemm_phase(LAS unsigned char* lds, const Gemm g, const Sched& S, const Epi& E, const int wid) {
    int lane_; asm volatile("v_mbcnt_lo_u32_b32 %0, -1, 0\n\tv_mbcnt_hi_u32_b32 %0, -1, %0" : "=v"(lane_));
    const int lane = lane_, tid = wid * 64 + lane, wr = wid >> 2, wc = wid & 3, fr = lane & 15, fq = lane >> 4;
    const int K = g.K, nt = K / BK;
    unsigned voffA[2], voffB[2];
#pragma unroll
    for (int i = 0; i < 2; ++i) { int R, C; stage_rc(tid * 16 + i * 8192, R, C); const int Rb = Epi::PERM ? ((R & ~31) + perm32(R & 31)) : R;
        voffA[i] = (unsigned)(R * K + C) * 2u; voffB[i] = (unsigned)(Rb * K + C) * 2u; }
    const size_t kstep = (size_t)(BK * 2);
    const size_t hstep = (size_t)HALF * K * 2;
    const size_t tstep = 2 * hstep;
    const unsigned ldsw = (unsigned)wid * 1024u;
    const int aoff = lds_byte(wr * 64 + fr, fq * 8), boff = lds_byte(wc * 32 + fr, fq * 8);
    const char* Ab = (const char*)g.A;
#define PG8_SA(b, h) (((b) * 2 + (h)) * HTB)
#define PG8_SB(b, h) ((4 + (b) * 2 + (h)) * HTB)
#define PG8_UNI(p) asm volatile("" : "+s"(p))
#define PG8_LOFF(v) asm volatile("" : "+v"(v))
#define PG8_STAGEB(bufoff, gbase, voff) do { const char* _g = (const char*)(gbase); PG8_UNI(_g); _Pragma("unroll") for (int _i = 0; _i < 2; ++_i) { unsigned _v = (voff)[_i]; PG8_LOFF(_v); \
        __builtin_amdgcn_global_load_lds((const unsigned*)(_g + _v), (LAS unsigned*)(lds + (bufoff) + ldsw + _i * 8192), 16, 0, 0); } } while (0)
#define PG8_STAGEA(bufoff, H_, kb, NEXT) do { if constexpr (Sched::GATHER) { const char* _g = Ab + (size_t)(kb); PG8_UNI(_g); _Pragma("unroll") for (int _i = 0; _i < 2; ++_i) { unsigned _o = (NEXT) ? na[H_][_i] : ca[H_][_i]; PG8_LOFF(_o); \
            __builtin_amdgcn_global_load_lds((const unsigned*)(_g + _o), (LAS unsigned*)(lds + (bufoff) + ldsw + _i * 8192), 16, 0, 0); } } \
        else { const char* _b = Ab + ((NEXT) ? nU : cU) + (size_t)(H_) * hstep + (size_t)(kb); PG8_UNI(_b); _Pragma("unroll") for (int _i = 0; _i < 2; ++_i) { unsigned _v = voffA[_i]; PG8_LOFF(_v); \
            __builtin_amdgcn_global_load_lds((const unsigned*)(_b + _v), (LAS unsigned*)(lds + (bufoff) + ldsw + _i * 8192), 16, 0, 0); } } } while (0)
#define PG8_LDA(dst, b, h) do { _Pragma("unroll") for (int m = 0; m < 4; ++m) _Pragma("unroll") for (int k = 0; k < 2; ++k) dst[m][k] = *(const LAS bf16x8*)(lds + PG8_SA(b, h) + aoff + m * 2048 + k * 1024); } while (0)
#define PG8_LDB(dst, b, h) do { _Pragma("unroll") for (int n = 0; n < 2; ++n) _Pragma("unroll") for (int k = 0; k < 2; ++k) dst[n][k] = *(const LAS bf16x8*)(lds + PG8_SB(b, h) + boff + n * 2048 + k * 1024); } while (0)
#define PG8_MMA(ai, bj, At, Bt) do { __builtin_amdgcn_s_setprio(1); _Pragma("unroll") for (int m = 0; m < 4; ++m) _Pragma("unroll") for (int n = 0; n < 2; ++n) { \
        if constexpr (F8) { const i32x8 b_ = cat8(Bt[n][0], Bt[n][1]), a_ = cat8(At[m][0], At[m][1]); \
            asm volatile("v_mfma_f32_16x16x128_f8f6f4 %0, %1, %2, %0" : "+v"(acc[ai][bj][m][n]) : "v"(b_), "v"(a_)); } \
        else { _Pragma("unroll") for (int k = 0; k < 2; ++k) acc[ai][bj][m][n] = __builtin_amdgcn_mfma_f32_16x16x32_bf16(Bt[n][k], At[m][k], acc[ai][bj][m][n], 0, 0, 0); } } \
        __builtin_amdgcn_s_setprio(0); } while (0)
#define PG8_MFMA_DRAIN asm volatile("s_nop 7\n\ts_nop 7\n\ts_nop 3" ::: "memory")
#define PG8_WAIT_V(n) asm volatile("s_waitcnt vmcnt(" #n ")" ::: "memory")
#define PG8_WAIT_L(n) asm volatile("s_waitcnt lgkmcnt(" #n ")" ::: "memory")
#define PG8_BAR __builtin_amdgcn_s_barrier()
#define PG8_SCHED __builtin_amdgcn_sched_barrier(0)
    Unit cur, nxt; int ui = 0;
    if (!S.next(0, cur)) return;
    f32x4 acc[2][2][4][2];
#pragma unroll
    for (int a = 0; a < 2; ++a)
#pragma unroll
        for (int b = 0; b < 2; ++b)
#pragma unroll
            for (int m = 0; m < 4; ++m)
#pragma unroll
                for (int n = 0; n < 2; ++n) acc[a][b][m][n] = (f32x4){0.f, 0.f, 0.f, 0.f};
    bf16x8 At[4][2], B0[2][2], B1[2][2];
    unsigned ca[2][2], na[2][2];
    size_t cU = 0, nU = 0;
    if constexpr (Sched::GATHER) S.aoff(cur, tid, K, ca); else cU = (size_t)cur.pm * tstep;
    const char* cB = (const char*)g.Bt + (size_t)cur.pn * tstep;
    PG8_STAGEB(PG8_SB(0, 0), cB, voffB); PG8_STAGEB(PG8_SB(0, 1), cB + hstep, voffB); PG8_STAGEA(PG8_SA(0, 0), 0, 0, false); PG8_STAGEA(PG8_SA(0, 1), 1, 0, false);
    if (wr == 1) PG8_BAR;
    PG8_WAIT_V(2); PG8_BAR;
    PG8_STAGEB(PG8_SB(1, 0), cB + kstep, voffB); PG8_STAGEA(PG8_SA(1, 0), 0, kstep, false); PG8_STAGEB(PG8_SB(1, 1), cB + hstep + kstep, voffB);
    PG8_WAIT_V(6); PG8_BAR;
    for (;;) {
        const bool has_next = S.next(ui + 1, nxt);
        if constexpr (Sched::GATHER) {
            if (has_next) S.aoff(nxt, tid, K, na);
            else {
#pragma unroll
                for (int h = 0; h < 2; ++h)
#pragma unroll
                    for (int i = 0; i < 2; ++i) na[h][i] = ca[h][i];
            }
        } else nU = has_next ? (size_t)nxt.pm * tstep : cU;
        const char* nB = has_next ? (const char*)g.Bt + (size_t)nxt.pn * tstep : cB;
#pragma unroll 1
        for (int t = 0; t < nt; t += 2) {
            const bool last = (t == nt - 2);
            const size_t kb1 = (size_t)(t + 1) * kstep;
            const size_t kb2 = last ? 0 : (size_t)(t + 2) * kstep, kb3 = kb2 + kstep;
            const char* b2 = last ? nB : cB + (size_t)(t + 2) * kstep; const char* b3 = b2 + kstep;
            PG8_LDB(B0, 0, 0); PG8_LDB(B1, 0, 1); PG8_SCHED; PG8_LDA(At, 0, 0); PG8_STAGEA(PG8_SA(1, 1), 1, kb1, false);
            PG8_WAIT_V(8); PG8_WAIT_L(0); PG8_BAR; PG8_MMA(0, 0, At, B0); PG8_MMA(0, 1, At, B1); PG8_BAR; PG8_SCHED;
            PG8_LDA(At, 0, 1); PG8_STAGEB(PG8_SB(0, 0), b2, voffB); PG8_STAGEB(PG8_SB(0, 1), b2 + hstep, voffB); PG8_STAGEA(PG8_SA(0, 0), 0, kb2, last);
            PG8_WAIT_V(8); PG8_WAIT_L(0); PG8_BAR; PG8_MMA(1, 0, At, B0); PG8_MMA(1, 1, At, B1); PG8_BAR; PG8_SCHED;
            PG8_LDB(B0, 1, 0); PG8_LDB(B1, 1, 1); PG8_SCHED; PG8_LDA(At, 1, 0); PG8_STAGEA(PG8_SA(0, 1), 1, kb2, last);
            PG8_WAIT_V(8); PG8_WAIT_L(0); PG8_BAR; PG8_MMA(0, 0, At, B0); PG8_MMA(0, 1, At, B1); PG8_BAR; PG8_SCHED;
            PG8_LDA(At, 1, 1); PG8_STAGEB(PG8_SB(1, 0), b3, voffB); PG8_STAGEB(PG8_SB(1, 1), b3 + hstep, voffB); PG8_STAGEA(PG8_SA(1, 0), 0, kb3, last);
            PG8_WAIT_V(8); PG8_WAIT_L(0); PG8_BAR; PG8_MMA(1, 0, At, B0); PG8_MMA(1, 1, At, B1); PG8_BAR; PG8_SCHED;
            if constexpr (Epi::MIDK) { if (t + 2 == nt / 2) { if constexpr (F8) PG8_MFMA_DRAIN; E.mid(acc, cur, wr, wc, fr, fq); if constexpr (F8) asm volatile("s_nop 3" ::: "memory"); } }
        }
#if GEMM_ALIGN
        if (wr == 0) PG8_BAR;
#endif
        if constexpr (F8) PG8_MFMA_DRAIN;
        E(acc, cur, wr, wc, fr, fq);
        if (!has_next) break;
#pragma unroll
        for (int a = 0; a < 2; ++a)
#pragma unroll
            for (int b = 0; b < 2; ++b)
#pragma unroll
                for (int m = 0; m < 4; ++m)
#pragma unroll
                    for (int n = 0; n < 2; ++n) acc[a][b][m][n] = (f32x4){0.f, 0.f, 0.f, 0.f};
        cur = nxt; cB = nB; cU = nU; ++ui;
        if constexpr (Sched::GATHER) {
#pragma unroll
            for (int h = 0; h < 2; ++h)
#pragma unroll
                for (int i = 0; i < 2; ++i) ca[h][i] = na[h][i];
        }
#if GEMM_ALIGN
        if (wr == 1) PG8_BAR;
#endif
    }
    PG8_WAIT_V(0);
#if !GEMM_ALIGN
    if (wr == 0) PG8_BAR;
#endif
    PG8_BAR;
#undef PG8_SA
#undef PG8_SB
#undef PG8_STAGEA
#undef PG8_STAGEB
#undef PG8_UNI
#undef PG8_LOFF
#undef PG8_LDA
#undef PG8_LDB
#undef PG8_MMA
#undef PG8_WAIT_V
#undef PG8_MFMA_DRAIN
#undef PG8_WAIT_L
#undef PG8_BAR
#undef PG8_SCHED
}

typedef const f32x4 (&AccRef)[2][2][4][2];

__device__ __forceinline__ u32x4 pack8(const f32x4& a, const f32x4& b) { u32x4 w; w.x = cvt_pk_bf16(a[0], a[1]); w.y = cvt_pk_bf16(a[2], a[3]); w.z = cvt_pk_bf16(b[0], b[1]); w.w = cvt_pk_bf16(b[2], b[3]); return w; }

struct EpiInProj {
    static constexpr bool PERM = true, MIDK = false;
    bf16_t *QA, *KA, *VA, *QB, *KB, *VB, *SA, *SB;
    const LAS float* normw;
    template <int ROPE>
    __device__ __forceinline__ void head_tile(AccRef acc, bf16_t* dst_, int ld, int hcol, int gsel, float scale, int row0, int fr, int fq) const {
        unsigned char* dst = (unsigned char*)dst_;
        int d0[2];
#pragma unroll
        for (int bj = 0; bj < 2; ++bj) d0[bj] = (ROPE == 1) ? (fq == 0 ? 8 * bj : 8 + 8 * fq + 24 * bj) : (fq < 2 ? 8 * fq + 16 * bj : 16 + 8 * fq + 16 * bj);
        f32x4 g[2][2];
#pragma unroll
        for (int bj = 0; bj < 2; ++bj)
#pragma unroll
            for (int n = 0; n < 2; ++n) g[bj][n] = *(const LAS f32x4*)(normw + gsel * 64 + d0[bj] + 4 * n);
        constexpr float FA[8] = {1.591549431e-01f, 3.086376340e-02f, 5.985185713e-03f, 1.160663641e-03f, 2.250790790e-04f, 4.364795279e-05f, 8.464330808e-06f, 1.641426263e-06f};
        constexpr float FB[16] = {1.591549431e-01f, 8.949940161e-02f, 5.032921210e-02f, 2.830219583e-02f, 1.591549431e-02f, 8.949940161e-03f, 5.032921210e-03f, 2.830219583e-03f,
                                  1.591549431e-03f, 8.949940161e-04f, 5.032921210e-04f, 2.830219583e-04f, 1.591549431e-04f, 8.949940161e-05f, 5.032921210e-05f, 2.830219583e-05f};
        float fq8[8];
#pragma unroll
        for (int k = 0; k < 8; ++k) fq8[k] = (ROPE == 1) ? FA[k] : ((fq & 1) ? FB[8 + k] : FB[k]);
        const bool rot = (ROPE == 2) || (fq == 0);
#pragma unroll
        for (int ai = 0; ai < 2; ++ai)
#pragma unroll
            for (int m = 0; m < 4; ++m) {
                const int row = row0 + ai * HALF + m * 16; const int s = row & (SEQ - 1);
                f32x4 y[2][2]; float ss = 0.f;
#pragma unroll
                for (int bj = 0; bj < 2; ++bj)
#pragma unroll
                    for (int n = 0; n < 2; ++n) { y[bj][n] = acc[ai][bj][m][n]; const f32x4 q = y[bj][n] * y[bj][n]; ss += (q[0] + q[1]) + (q[2] + q[3]); }
                ss += shx(ss, 16, fr + 16 * fq); ss += shx(ss, 32, fr + 16 * fq);
                const float rinv = __builtin_amdgcn_rsqf(ss * (W8I * W8I / 64.0f) + 1e-6f) * W8I;
#pragma unroll
                for (int bj = 0; bj < 2; ++bj)
#pragma unroll
                    for (int n = 0; n < 2; ++n) y[bj][n] = y[bj][n] * rinv * g[bj][n];
                if (ROPE != 0) {
                    const float pos = (float)((ROPE == 1) ? s : (fq < 2 ? (s >> 6) : (s & 63)));
#pragma unroll
                    for (int n = 0; n < 2; ++n)
#pragma unroll
                        for (int j = 0; j < 4; ++j) {
                            const float xr = __builtin_amdgcn_fractf(pos * fq8[4 * n + j]);
                            const float c = rot ? __builtin_amdgcn_cosf(xr) : 1.0f, s_ = rot ? __builtin_amdgcn_sinf(xr) : 0.0f;
                            const float x1 = y[0][n][j], x2 = y[1][n][j];
                            y[0][n][j] = x1 * c - x2 * s_; y[1][n][j] = x2 * c + x1 * s_;
                        }
                }
                u32x4 w;
#pragma unroll
                for (int bj = 0; bj < 2; ++bj) { const f32x4 a = y[bj][0] * scale, c = y[bj][1] * scale;
                    const unsigned lo = pack4_fp8(a[0], a[1], a[2], a[3]), hi = pack4_fp8(c[0], c[1], c[2], c[3]);
                    if (bj == 0) { w.x = lo; w.y = hi; } else { w.z = lo; w.w = hi; } }
                *(u32x4*)(dst + (size_t)row * ld + hcol + 16 * fq) = w;
            }
    }
    __device__ __forceinline__ void operator()(AccRef acc, const Unit& u, int wr, int wc, int fr_, int fq_) const {
        int fr = fr_, fq = fq_; asm volatile("" : "+v"(fr), "+v"(fq));
        const int pn = u.pn; const int row0 = u.pm * BM + wr * 64 + fr;
        if (pn >= 9) {
            unsigned char* base = (unsigned char*)((pn < 13) ? SA : SB); const int colt = ((pn - 9) & 3) * 256 + wc * 64 + 16 * fq;
#pragma unroll
            for (int ai = 0; ai < 2; ++ai)
#pragma unroll
                for (int m = 0; m < 4; ++m) { u32x4 w;
#pragma unroll
                    for (int bj = 0; bj < 2; ++bj) { f32x4 v0 = acc[ai][bj][m][0], v1 = acc[ai][bj][m][1];
#pragma unroll
                        for (int j = 0; j < 4; ++j) { v0[j] = sigmoid_f(v0[j] * W8I); v1[j] = sigmoid_f(v1[j] * W8I); }
                        const unsigned lo = pack4_fp8(v0[0], v0[1], v0[2], v0[3]), hi = pack4_fp8(v1[0], v1[1], v1[2], v1[3]);
                        if (bj == 0) { w.x = lo; w.y = hi; } else { w.z = lo; w.w = hi; } }
                    *(u32x4*)(base + (size_t)(row0 + ai * HALF + m * 16) * DM + colt) = w; }
        } else if (pn == 4 || pn == 5) {
            const int colt = (pn - 4) * 256 + wc * 64 + 16 * fq;
#pragma unroll
            for (int ai = 0; ai < 2; ++ai)
#pragma unroll
                for (int m = 0; m < 4; ++m) { bf16_t* rowp = VA + (size_t)(row0 + ai * HALF + m * 16) * 512 + colt;
#pragma unroll
                    for (int bj = 0; bj < 2; ++bj) *(u32x4*)(rowp + 8 * bj) = pack8(acc[ai][bj][m][0] * W8I, acc[ai][bj][m][1] * W8I); }
        } else if (pn < 2)  head_tile<1>(acc, QA, 512, 64 * (4 * pn + wc), 0, QSCALE, row0, fr, fq);
        else if (pn < 4)    head_tile<1>(acc, KA, 512, 64 * (4 * (pn - 2) + wc), 1, 1.0f, row0, fr, fq);
        else if (pn < 8)    head_tile<2>(acc, QB, 512, 64 * (4 * (pn - 6) + wc), 2, QSCALE, row0, fr, fq);
        else if (wc < 2)    head_tile<2>(acc, KB, 128, 64 * wc, 3, 1.0f, row0, fr, fq);
        else {
#pragma unroll
            for (int ai = 0; ai < 2; ++ai)
#pragma unroll
                for (int m = 0; m < 4; ++m) { bf16_t* rowp = VB + (size_t)(row0 + ai * HALF + m * 16) * 128 + 64 * (wc - 2) + 8 * fq;
#pragma unroll
                    for (int bj = 0; bj < 2; ++bj) *(u32x4*)(rowp + 32 * bj) = pack8(acc[ai][bj][m][0] * W8I, acc[ai][bj][m][1] * W8I); }
        }
    }
};

struct EpiMergeFused {
    static constexpr bool PERM = true, MIDK = true;
    bf16_t* MG; const unsigned char* GA; const unsigned char* GB;
    __device__ __forceinline__ void mid(f32x4 (&acc)[2][2][4][2], const Unit& u, int wr, int wc, int fr_, int fq_) const {
        int fr = fr_, fq = fq_; asm volatile("" : "+v"(fr), "+v"(fq));
        const int row0 = u.pm * BM + wr * 64 + fr, col0 = u.pn * BM + wc * 64 + 16 * fq;
#pragma unroll
        for (int ai = 0; ai < 2; ++ai)
#pragma unroll
            for (int m = 0; m < 4; ++m) { const size_t ro = (size_t)(row0 + ai * HALF + m * 16) * DM + col0;
                const u32x4 a = *(const u32x4*)(GA + ro), b = *(const u32x4*)(GB + ro);
#pragma unroll
                for (int bj = 0; bj < 2; ++bj) {
                    float sa[8], sb[8]; unpack8_fp8(bj ? (u32x2){a.z, a.w} : (u32x2){a.x, a.y}, sa); unpack8_fp8(bj ? (u32x2){b.z, b.w} : (u32x2){b.x, b.y}, sb);
#pragma unroll
                    for (int n = 0; n < 2; ++n)
#pragma unroll
                        for (int j = 0; j < 4; ++j) acc[ai][bj][m][n][j] *= sa[4 * n + j] * __builtin_amdgcn_rcpf(fmaxf(sb[4 * n + j], 1e-12f));
                } }
    }
    __device__ __forceinline__ void operator()(AccRef acc, const Unit& u, int wr, int wc, int fr_, int fq_) const {
        int fr = fr_, fq = fq_; asm volatile("" : "+v"(fr), "+v"(fq));
        const int row0 = u.pm * BM + wr * 64 + fr, col0 = u.pn * BM + wc * 64 + 16 * fq;
#pragma unroll
        for (int ai = 0; ai < 2; ++ai)
#pragma unroll
            for (int m = 0; m < 4; ++m) { const size_t ro = (size_t)(row0 + ai * HALF + m * 16) * DM + col0;
                const u32x4 b = *(const u32x4*)(GB + ro); u32x4 w;
#pragma unroll
                for (int bj = 0; bj < 2; ++bj) {
                    float sb[8]; unpack8_fp8(bj ? (u32x2){b.z, b.w} : (u32x2){b.x, b.y}, sb);
                    f32x4 v0 = acc[ai][bj][m][0], v1 = acc[ai][bj][m][1];
                    constexpr float CS = A8I * W8I * A8S;
#pragma unroll
                    for (int j = 0; j < 4; ++j) { v0[j] *= fmaxf(sb[j], 1e-12f) * CS; v1[j] *= fmaxf(sb[4 + j], 1e-12f) * CS; }
                    const unsigned lo = pack4_fp8(v0[0], v0[1], v0[2], v0[3]), hi = pack4_fp8(v1[0], v1[1], v1[2], v1[3]);
                    if (bj == 0) { w.x = lo; w.y = hi; } else { w.z = lo; w.w = hi; } }
                *(u32x4*)((unsigned char*)MG + ro) = w; }
    }
};

struct EpiResidB {
    static constexpr bool PERM = true, MIDK = false;
    const float* Xf; const bf16_t* Xb; bf16_t* O; const float* gate;
    __device__ __forceinline__ void operator()(AccRef acc, const Unit& u, int wr, int wc, int fr_, int fq_) const {
        int fr = fr_, fq = fq_; asm volatile("" : "+v"(fr), "+v"(fq));
        const int row0 = u.pm * BM + wr * 64 + fr, col0 = u.pn * BM + wc * 64 + 16 * fq; const int b = (u.pm * BM) >> 11;
        f32x4 gt[2][2];
#pragma unroll
        for (int bj = 0; bj < 2; ++bj)
#pragma unroll
            for (int n = 0; n < 2; ++n) gt[bj][n] = *(const f32x4*)(gate + (size_t)b * MODW + col0 + 8 * bj + 4 * n) * (A8I * W8I);
#pragma unroll
        for (int ai = 0; ai < 2; ++ai)
#pragma unroll
            for (int m = 0; m < 4; ++m) { const size_t ro = (size_t)(row0 + ai * HALF + m * 16) * DM + col0;
#pragma unroll
                for (int bj = 0; bj < 2; ++bj) {
                    f32x4 x0, x1;
                    if (Xf) { x0 = *(const f32x4*)(Xf + ro + 8 * bj); x1 = *(const f32x4*)(Xf + ro + 8 * bj + 4); }
                    else { const u32x4 w = *(const u32x4*)(Xb + ro + 8 * bj); x0 = (f32x4){bf_lo(w.x), bf_hi(w.x), bf_lo(w.y), bf_hi(w.y)}; x1 = (f32x4){bf_lo(w.z), bf_hi(w.z), bf_lo(w.w), bf_hi(w.w)}; }
                    *(u32x4*)(O + ro + 8 * bj) = pack8(x0 + gt[bj][0] * acc[ai][bj][m][0], x1 + gt[bj][1] * acc[ai][bj][m][1]); } }
    }
};

struct EpiSwiGLU {
    static constexpr bool PERM = true, MIDK = false;
    bf16_t* ACT;
    float cs;
    __device__ __forceinline__ void operator()(AccRef acc, const Unit& u, int wr, int wc, int fr_, int fq_) const {
        int fr = fr_, fq = fq_; asm volatile("" : "+v"(fr), "+v"(fq));
        const int row0 = u.pm * BM + wr * 64 + fr, col0 = (u.pn & 3) * HALF + wc * 32 + 8 * fq;
#pragma unroll
        for (int ai = 0; ai < 2; ++ai)
#pragma unroll
            for (int m = 0; m < 4; ++m) { f32x4 r[2];
#pragma unroll
                for (int n = 0; n < 2; ++n)
#pragma unroll
                    for (int j = 0; j < 4; ++j) { const float gg = acc[ai][0][m][n][j] * cs, uu = acc[ai][1][m][n][j] * (DN_F8 ? cs * A8S : cs); r[n][j] = gg * sigmoid_f(gg) * uu; }
                if (DN_F8) *(u32x2*)((unsigned char*)ACT + (size_t)(row0 + ai * HALF + m * 16) * DFF + col0) = (u32x2){pack4_fp8(r[0][0], r[0][1], r[0][2], r[0][3]), pack4_fp8(r[1][0], r[1][1], r[1][2], r[1][3])};
                else *(u32x4*)(ACT + (size_t)(row0 + ai * HALF + m * 16) * DFF + col0) = pack8(r[0], r[1]); }
    }
};

struct EpiY {
    static constexpr bool PERM = true, MIDK = false;
    unsigned char* Y;
    __device__ __forceinline__ void operator()(AccRef acc, const Unit& u, int wr, int wc, int fr_, int fq_) const {
        int fr = fr_, fq = fq_; asm volatile("" : "+v"(fr), "+v"(fq));
        const int row0 = u.pm * BM + wr * 64 + fr, col0 = (u.pn & 3) * BM + wc * 64 + 16 * fq;
#pragma unroll
        for (int ai = 0; ai < 2; ++ai)
#pragma unroll
            for (int m = 0; m < 4; ++m) { u32x4 w;
                constexpr float CS = DN_F8 ? A8I * W8I : 1.0f;
                { const f32x4 a = acc[ai][0][m][0] * CS, b = acc[ai][0][m][1] * CS; w.x = pack4_fp8(a[0], a[1], a[2], a[3]); w.y = pack4_fp8(b[0], b[1], b[2], b[3]); }
                { const f32x4 a = acc[ai][1][m][0] * CS, b = acc[ai][1][m][1] * CS; w.z = pack4_fp8(a[0], a[1], a[2], a[3]); w.w = pack4_fp8(b[0], b[1], b[2], b[3]); }
                *(u32x4*)(Y + (size_t)(row0 + ai * HALF + m * 16) * DM + col0) = w; }
    }
};
}

__device__ __forceinline__ int dimA(int bj, int r) { return r < 8 ? r + 8 * bj : 16 + (r - 8) + 24 * bj; }
__device__ __forceinline__ int dimB(int bj, int r) { return r < 16 ? r + 16 * bj : 32 + (r - 16) + 16 * bj; }
__device__ __forceinline__ int inproj_srccol(int P) {
    const int pn = P >> 8, p = P & 255, bj = p >> 7, wc = (p >> 5) & 3, r = p & 31;
    if (pn < 2) return 64 * (4 * pn + wc) + dimA(bj, r);
    if (pn < 4) return 512 + 64 * (4 * (pn - 2) + wc) + dimA(bj, r);
    if (pn < 6) return 1024 + 256 * (pn - 4) + 64 * wc + 16 * ((p >> 3) & 3) + 8 * bj + (p & 7);
    if (pn < 8) return 1536 + 64 * (4 * (pn - 6) + wc) + dimB(bj, r);
    if (pn == 8) return wc < 2 ? 2048 + 64 * wc + dimB(bj, r) : 2176 + 64 * (wc - 2) + 32 * bj + r;
    { const int fq = (p >> 3) & 3, r8 = p & 7; return 2304 + 256 * (pn - 9) + 64 * wc + 16 * fq + 8 * bj + r8; }
}

namespace att {
constexpr int KSTR = 80, VSTR = 192;
constexpr int KTILE = 64 * KSTR, VTILE = 64 * VSTR;
constexpr int K_OFF = 0, V_OFF = 2 * KTILE;
constexpr int PRIV_OFF = 0;
__device__ __forceinline__ s16x4 vtr(LAS const char* p) { typedef short v4i16_t __attribute__((ext_vector_type(4)));
    return __builtin_bit_cast(s16x4, __builtin_amdgcn_ds_read_tr16_b64_v4i16((LAS v4i16_t*)p)); }
__device__ __forceinline__ int clamp_tok(int t) { return t < 0 ? 0 : (t > SEQ - 1 ? SEQ - 1 : t); }

__device__ __forceinline__ long mk64(unsigned lo, unsigned hi) { return (long)(((unsigned long long)hi << 32) | lo); }
__device__ __forceinline__ void qk_tile(f32x16& p0, f32x16& p1, const u32x4 (&kf)[2][2], const u32x4 (&qr)[2]) {
    const f32x16 z = {0.f, 0.f, 0.f, 0.f, 0.f, 0.f, 0.f, 0.f, 0.f, 0.f, 0.f, 0.f, 0.f, 0.f, 0.f, 0.f};
    p0 = __builtin_amdgcn_mfma_f32_32x32x16_fp8_fp8(mk64(kf[0][0].x, kf[0][0].y), mk64(qr[0].x, qr[0].y), z, 0, 0, 0);
    p1 = __builtin_amdgcn_mfma_f32_32x32x16_fp8_fp8(mk64(kf[1][0].x, kf[1][0].y), mk64(qr[0].x, qr[0].y), z, 0, 0, 0);
    p0 = __builtin_amdgcn_mfma_f32_32x32x16_fp8_fp8(mk64(kf[0][0].z, kf[0][0].w), mk64(qr[0].z, qr[0].w), p0, 0, 0, 0);
    p1 = __builtin_amdgcn_mfma_f32_32x32x16_fp8_fp8(mk64(kf[1][0].z, kf[1][0].w), mk64(qr[0].z, qr[0].w), p1, 0, 0, 0);
    p0 = __builtin_amdgcn_mfma_f32_32x32x16_fp8_fp8(mk64(kf[0][1].x, kf[0][1].y), mk64(qr[1].x, qr[1].y), p0, 0, 0, 0);
    p1 = __builtin_amdgcn_mfma_f32_32x32x16_fp8_fp8(mk64(kf[1][1].x, kf[1][1].y), mk64(qr[1].x, qr[1].y), p1, 0, 0, 0);
    p0 = __builtin_amdgcn_mfma_f32_32x32x16_fp8_fp8(mk64(kf[0][1].z, kf[0][1].w), mk64(qr[1].z, qr[1].w), p0, 0, 0, 0);
    p1 = __builtin_amdgcn_mfma_f32_32x32x16_fp8_fp8(mk64(kf[1][1].z, kf[1][1].w), mk64(qr[1].z, qr[1].w), p1, 0, 0, 0);
}
template <bool MASK>
__device__ __forceinline__ void exp_tile(const f32x16& p0, const f32x16& p1, float& lsum, bf16x8 (&pf)[2][2], int mbase, int mR, int dk) {
    float e0[16], e1[16]; float ls = 0.f;
#pragma unroll
    for (int r = 0; r < 16; ++r) {
        e0[r] = __builtin_amdgcn_exp2f(p0[r]); e1[r] = __builtin_amdgcn_exp2f(p1[r]);
        if (MASK) {
            const int c0 = (r & 3) + 8 * (r >> 2);
            e0[r] = ((unsigned)(mbase + dk * c0) <= (unsigned)mR) ? e0[r] : 0.f;
            e1[r] = ((unsigned)(mbase + dk * (c0 + 32)) <= (unsigned)mR) ? e1[r] : 0.f;
        }
        ls += e0[r] + e1[r];
    }
    lsum += ls;
#pragma unroll
    for (int s = 0; s < 2; ++s) {
        u32x4 w0, w1;
        w0.x = cvt_pk_bf16(e0[8 * s + 0], e0[8 * s + 1]); w0.y = cvt_pk_bf16(e0[8 * s + 2], e0[8 * s + 3]); w0.z = cvt_pk_bf16(e0[8 * s + 4], e0[8 * s + 5]); w0.w = cvt_pk_bf16(e0[8 * s + 6], e0[8 * s + 7]);
        w1.x = cvt_pk_bf16(e1[8 * s + 0], e1[8 * s + 1]); w1.y = cvt_pk_bf16(e1[8 * s + 2], e1[8 * s + 3]); w1.z = cvt_pk_bf16(e1[8 * s + 4], e1[8 * s + 5]); w1.w = cvt_pk_bf16(e1[8 * s + 6], e1[8 * s + 7]);
        pf[0][s] = __builtin_bit_cast(bf16x8, w0); pf[1][s] = __builtin_bit_cast(bf16x8, w1);
    }
}
__device__ __forceinline__ void vread(bf16x8 (&vf)[4], LAS const char* vb, int d0) {
#pragma unroll
    for (int blk = 0; blk < 2; ++blk)
#pragma unroll
        for (int s = 0; s < 2; ++s) {
            const s16x4 lo = vtr(vb + (32 * blk + 16 * s) * VSTR + 64 * d0), hi = vtr(vb + (32 * blk + 16 * s + 8) * VSTR + 64 * d0);
            vf[2 * blk + s] = (bf16x8){lo[0], lo[1], lo[2], lo[3], hi[0], hi[1], hi[2], hi[3]};
        }
}
__device__ __forceinline__ void pv_half(f32x16& od, const bf16x8 (&vf)[4], const bf16x8 (&pf)[2][2]) {
#pragma unroll
    for (int blk = 0; blk < 2; ++blk)
#pragma unroll
        for (int s = 0; s < 2; ++s) od = __builtin_amdgcn_mfma_f32_32x32x16_bf16(vf[2 * blk + s], pf[blk][s], od, 0, 0, 0);
}
__device__ __forceinline__ void mask_params(int dk, int tk0, int tq, int hi, int& mbase, int& mR) {
    const int dlo = (-64 * dk > -tq) ? -64 * dk : -tq, dhi = (64 * dk < SEQ - 1 - tq) ? 64 * dk : SEQ - 1 - tq;
    const int dA = tk0 + 4 * dk * hi - tq;
    mR = dhi - dlo; mbase = ((dA & (dk - 1)) == 0) ? dA - dlo : 0x7fffffff;
}

template <bool MASKED>
__device__ __forceinline__ void dense64_loop(LAS char* lds, const unsigned char* Kg, const bf16_t* Vg, int ld  , int tok0, int ntiles,
                                             const u32x4 (&qr)[2][2], f32x16 (&o)[2][2], float (&lsum)[2], int tq0, int tq1, int lane_, int wave) {
    constexpr int V2_OFF = 2 * KTILE;
    u32x2 kreg; u32x4 vreg;
#define D64_LANE() int ln_ = lane_; asm volatile("" : "+v"(ln_)); const int tid_ = wave * 64 + ln_, srow = tid_ >> 3, sch = tid_ & 7
#define D64_LD(t) do { D64_LANE(); int tk_ = tok0 + 64 * (t) + srow; if (MASKED) tk_ = clamp_tok(tk_); kreg = *(const u32x2*)(Kg + (size_t)tk_ * ld + sch * 8); vreg = *(const u32x4*)(Vg + (size_t)tk_ * ld + sch * 8); } while (0)
#define D64_ST(t) do { D64_LANE(); *(LAS u32x2*)(lds + ((t) & 1) * KTILE + srow * KSTR + sch * 8) = kreg; *(LAS u32x4*)(lds + V2_OFF + ((t) & 1) * VTILE + srow * VSTR + sch * 16) = vreg; } while (0)
    D64_LD(0); D64_ST(0); D64_LD(1);
    for (int t = 0; t < ntiles; ++t) {
        __syncthreads();
        if (t + 1 < ntiles) D64_ST(t + 1);
        if (t + 2 < ntiles) D64_LD(t + 2);
        int lane = lane_; asm volatile("" : "+v"(lane));
        const int hi = lane >> 5;
        const int vlane = (4 * hi + ((lane & 15) >> 2)) * VSTR + (16 * ((lane >> 4) & 1) + 4 * (lane & 3)) * 2;
        const int klane = (lane & 31) * KSTR + 32 * hi;
        u32x4 kf[2][2];
        { LAS const char* kb_ = lds + (t & 1) * KTILE + klane;
#pragma unroll
          for (int blk = 0; blk < 2; ++blk)
#pragma unroll
              for (int e = 0; e < 2; ++e) kf[blk][e] = *(const LAS u32x4*)(kb_ + 32 * blk * KSTR + 16 * e); }
        f32x16 p[2][2];
        bf16x8 vfa[4], vfb[4];
        LAS const char* vb_ = lds + V2_OFF + (t & 1) * VTILE + vlane;
        vread(vfa, vb_, 0); vread(vfb, vb_, 1);
        __builtin_amdgcn_sched_barrier(0);
        qk_tile(p[0][0], p[0][1], kf, qr[0]);
        qk_tile(p[1][0], p[1][1], kf, qr[1]);
#pragma unroll
        for (int g = 0; g < 2; ++g) {
            bf16x8 pf[2][2]; int mb = 0, mr = 0;
            if (MASKED) mask_params(1, tok0 + 64 * t, g ? tq1 : tq0, hi, mb, mr);
            exp_tile<MASKED>(p[g][0], p[g][1], lsum[g], pf, mb, mr, 1);
            pv_half(o[g][0], vfa, pf); pv_half(o[g][1], vfb, pf);
        }
    }
#undef D64_LANE
#undef D64_LD
#undef D64_ST
}
__device__ __forceinline__ void dense64_lag_loop(LAS char* lds, const unsigned char* Kg, const bf16_t* Vg, int ld  , int ntiles,
                                                 const u32x4 (&qr)[2][2], f32x16 (&o)[2][2], float (&lsum)[2], int lane_, int wave, const bool lag) {
    constexpr int V2_OFF = 2 * KTILE;
    u32x2 kreg; u32x4 vreg;
#define D64_LANE() int ln_ = lane_; asm volatile("" : "+v"(ln_)); const int tid_ = wave * 64 + ln_, srow = tid_ >> 3, sch = tid_ & 7
#define D64_LD(t) do { D64_LANE(); const int tk_ = 64 * (t) + srow; kreg = *(const u32x2*)(Kg + (size_t)tk_ * ld + sch * 8); vreg = *(const u32x4*)(Vg + (size_t)tk_ * ld + sch * 8); } while (0)
#define D64_ST(t) do { D64_LANE(); *(LAS u32x2*)(lds + ((t) & 1) * KTILE + srow * KSTR + sch * 8) = kreg; *(LAS u32x4*)(lds + V2_OFF + ((t) % 3) * VTILE + srow * VSTR + sch * 16) = vreg; } while (0)
#define D64_QK(t) do { int lane = lane_; asm volatile("" : "+v"(lane)); const int klane = (lane & 31) * KSTR + 32 * (lane >> 5); u32x4 kf[2][2]; LAS const char* kb_ = lds + ((t) & 1) * KTILE + klane; \
        _Pragma("unroll") for (int blk = 0; blk < 2; ++blk) _Pragma("unroll") for (int e = 0; e < 2; ++e) kf[blk][e] = *(const LAS u32x4*)(kb_ + 32 * blk * KSTR + 16 * e); \
        qk_tile(p[0][0], p[0][1], kf, qr[0]); qk_tile(p[1][0], p[1][1], kf, qr[1]); } while (0)
#define D64_PV(t) do { int lane = lane_; asm volatile("" : "+v"(lane)); const int hi = lane >> 5; const int vlane = (4 * hi + ((lane & 15) >> 2)) * VSTR + (16 * ((lane >> 4) & 1) + 4 * (lane & 3)) * 2; \
        bf16x8 vfa[4], vfb[4]; LAS const char* vb_ = lds + V2_OFF + ((t) % 3) * VTILE + vlane; vread(vfa, vb_, 0); vread(vfb, vb_, 1); \
        _Pragma("unroll") for (int g = 0; g < 2; ++g) { bf16x8 pf[2][2]; exp_tile<false>(p[g][0], p[g][1], lsum[g], pf, 0, 0, 0); pv_half(o[g][0], vfa, pf); pv_half(o[g][1], vfb, pf); } } while (0)
    f32x16 p[2][2];
    D64_LD(0); D64_ST(0);
    if (!lag) {
        D64_LD(1);
        for (int t = 0; t < ntiles; ++t) {
            __syncthreads();
            if (t + 1 < ntiles) D64_ST(t + 1);
            if (t + 2 < ntiles) D64_LD(t + 2);
            D64_QK(t);
            D64_PV(t);
        }
        __syncthreads();
    } else {
        D64_LD(1);
        __syncthreads();
        D64_ST(1); D64_LD(2);
        D64_QK(0);
        for (int t = 1; t < ntiles; ++t) {
            __syncthreads();
            if (t + 1 < ntiles) D64_ST(t + 1);
            if (t + 2 < ntiles) D64_LD(t + 2);
            D64_PV(t - 1);
            __builtin_amdgcn_sched_barrier(0);
            D64_QK(t);
        }
        __syncthreads();
        D64_PV(ntiles - 1);
    }
#undef D64_LANE
#undef D64_LD
#undef D64_ST
#undef D64_QK
#undef D64_PV
}
__device__ __forceinline__ void priv_kload(u32x4 (&kf)[2][2], const unsigned char* Kg, int ld, int tk0, int dk, int lane_) {
    int lane = lane_; asm volatile("" : "+v"(lane));
    const int hi = lane >> 5;
#pragma unroll
    for (int blk = 0; blk < 2; ++blk) { const int tk = clamp_tok(tk0 + dk * (32 * blk + (lane & 31)));
#pragma unroll
        for (int e = 0; e < 2; ++e) kf[blk][e] = *(const u32x4*)(Kg + (size_t)tk * ld + 32 * hi + 16 * e); }
}
__device__ __forceinline__ void priv2_step(u32x4 (&kf)[2][2], LAS char* vpriv, const unsigned char* Kg, const bf16_t* Vg, int ld, int tk0, int dk, bool g0, bool g1,
                                           bool has_next, int tk0n, int dkn, const u32x4 (&qr)[2][2], f32x16 (&o)[2][2], float (&lsum)[2], int tq0, int tq1, int lane_) {
    int lane = lane_; asm volatile("" : "+v"(lane));
    const int hi = lane >> 5;
    const int vlane = (4 * hi + ((lane & 15) >> 2)) * VSTR + (16 * ((lane >> 4) & 1) + 4 * (lane & 3)) * 2;
    u32x4 vr[8];
#pragma unroll
    for (int i = 0; i < 8; ++i) { const int idx = i * 64 + lane, row = idx >> 3, ch = idx & 7; const int tk = clamp_tok(tk0 + dk * row); vr[i] = *(const u32x4*)(Vg + (size_t)tk * ld + ch * 8); }
    const int gfirst = g0 ? 0 : 1, glast = g1 ? 1 : 0;
    f32x16 p0, p1; bf16x8 pf[2][2]; int mb, mr;
    if (gfirst == 0) qk_tile(p0, p1, kf, qr[0]); else qk_tile(p0, p1, kf, qr[1]);
    __builtin_amdgcn_sched_barrier(0);
#pragma unroll
    for (int i = 0; i < 8; ++i) { const int idx = i * 64 + lane; *(LAS u32x4*)(vpriv + (idx >> 3) * VSTR + (idx & 7) * 16) = vr[i]; }
    if (glast == gfirst) { __builtin_amdgcn_sched_barrier(0); if (has_next) priv_kload(kf, Kg, ld, tk0n, dkn, lane); __builtin_amdgcn_sched_barrier(0); }
    mask_params(dk, tk0, gfirst ? tq1 : tq0, hi, mb, mr);
    if (gfirst == 0) exp_tile<true>(p0, p1, lsum[0], pf, mb, mr, dk); else exp_tile<true>(p0, p1, lsum[1], pf, mb, mr, dk);
    { bf16x8 vfa[4], vfb[4]; vread(vfa, vpriv + vlane, 0); vread(vfb, vpriv + vlane, 1);
      if (gfirst == 0) { pv_half(o[0][0], vfa, pf); pv_half(o[0][1], vfb, pf); } else { pv_half(o[1][0], vfa, pf); pv_half(o[1][1], vfb, pf); } }
    if (glast != gfirst) {
        qk_tile(p0, p1, kf, qr[1]);
        __builtin_amdgcn_sched_barrier(0);
        if (has_next) priv_kload(kf, Kg, ld, tk0n, dkn, lane);
        __builtin_amdgcn_sched_barrier(0);
        mask_params(dk, tk0, tq1, hi, mb, mr);
        exp_tile<true>(p0, p1, lsum[1], pf, mb, mr, dk);
        bf16x8 vfa[4], vfb[4]; vread(vfa, vpriv + vlane, 0); vread(vfb, vpriv + vlane, 1);
        pv_half(o[1][0], vfa, pf); pv_half(o[1][1], vfb, pf);
    }
}
__device__ __forceinline__ void store_out(const f32x16 (&o)[2], float lsum, unsigned char* dst  , int lane_) {
    int lane = lane_; asm volatile("" : "+v"(lane));
    const int hi = lane >> 5;
    float l = lsum + shx(lsum, 32, lane);
    const float inv = A8S / l;
#pragma unroll
    for (int d0 = 0; d0 < 2; ++d0) {
        unsigned pc[4];
#pragma unroll
        for (int g = 0; g < 4; ++g) pc[g] = pack4_fp8(o[d0][4 * g] * inv, o[d0][4 * g + 1] * inv, o[d0][4 * g + 2] * inv, o[d0][4 * g + 3] * inv);
        const auto s0 = __builtin_amdgcn_permlane32_swap(pc[0], pc[2], false, false), s1 = __builtin_amdgcn_permlane32_swap(pc[1], pc[3], false, false);
        u32x4 w; w.x = s0[0]; w.y = s0[1]; w.z = s1[0]; w.w = s1[1];
        *(u32x4*)(dst + 32 * d0 + 16 * hi) = w;
    }
}
}

struct Args { const float* in[18]; float* out; unsigned char* ws; int ph_lo, ph_hi; };
constexpr int PH_PRO = 0, PH_L0 = 1, PH_PER_LAYER = 9, PH_FINAL = PH_L0 + 2 * PH_PER_LAYER, NPH = PH_FINAL + 1;
enum { P_NORM1 = 0, P_INPROJ, P_ATTN, P_PAB, P_OUT, P_NORM2, P_PLACE, P_GU, P_DOWN };

__device__ __forceinline__ int tile256_srccol(int P) { const int p = P & 255; return (P & ~255) + 64 * ((p >> 5) & 3) + 16 * ((p >> 3) & 3) + 8 * (p >> 7) + (p & 7); }
template <int MAP, bool W8 = false>
__device__ __forceinline__ void transpose_item(const float* W, int N, int col0, bf16_t* dst, int dst_row0, int K, int k0, LAS float* scr, int lane, int dk0 = 0  ) {
    const int sc = (MAP == 1) ? inproj_srccol(col0 + lane) : (MAP == 2) ? tile256_srccol(col0 + lane) : col0 + lane;
    const float* src = W + (size_t)k0 * N + sc;
#pragma unroll 16
    for (int i = 0; i < 64; ++i) scr[i * 65 + lane] = src[(size_t)i * N];
    asm volatile("s_waitcnt lgkmcnt(0)" ::: "memory");
    const int c = lane & 7, nn = lane >> 3;
#pragma unroll
    for (int j = 0; j < 8; ++j) { const int n = nn + 8 * j; const LAS float* s = scr + (8 * c) * 65 + n;
        if (W8) { u32x2 w; w.x = pack4_fp8(s[0] * W8S, s[65] * W8S, s[2 * 65] * W8S, s[3 * 65] * W8S); w.y = pack4_fp8(s[4 * 65] * W8S, s[5 * 65] * W8S, s[6 * 65] * W8S, s[7 * 65] * W8S);
            *(u32x2*)((unsigned char*)dst + (size_t)(dst_row0 + n) * K + dk0 + k0 + 8 * c) = w; continue; }
        u32x4 w; w.x = cvt_pk_bf16(s[0], s[65]); w.y = cvt_pk_bf16(s[2 * 65], s[3 * 65]); w.z = cvt_pk_bf16(s[4 * 65], s[5 * 65]); w.w = cvt_pk_bf16(s[6 * 65], s[7 * 65]);
        *(u32x4*)(dst + (size_t)(dst_row0 + n) * K + dk0 + k0 + 8 * c) = w; }
    asm volatile("s_waitcnt lgkmcnt(0)" ::: "memory");
}


template <bool XF32, bool COMBINE, bool NORM, bool ROUTER, bool OUTF32, int H8 = 0  >
__device__ __forceinline__ void row_phase(LAS unsigned char* lds, int tid, int lane, int wave, int G, int bx, const float* xf, bf16_t* xb, float* outf, const float* gv,
                                          const float* modl, int sh_off, int sc_off, const float* modprev, bf16_t* Hh, const unsigned char* Ym, const int* Pos, float* Tw,
                                          const bf16_t* Wr, int* Te, int* Trk, int* Cnt, unsigned char* H8p = nullptr) {
    constexpr int RB = COMBINE ? 2 : ROWB;
    LAS float* lgs = (LAS float*)lds;
    LAS int* lcnt = (LAS int*)(lds + 40960);
    asm volatile("" : "+v"(tid), "+v"(lane));
    for (int chunk = bx; chunk < 256; chunk += G) {
        const int b = chunk >> 3;
        if (ROUTER) { if (tid < 32) lcnt[tid] = 0; }
        f32x4 pre[4], shv[4], g2[4];
#pragma unroll
        for (int j = 0; j < 4; ++j) { const int col = 512 * (j >> 1) + 8 * lane + 4 * (j & 1);
            if (NORM) { const f32x4 gg = *(const f32x4*)(gv + col), sc = *(const f32x4*)(modl + (size_t)b * MODW + sc_off + col);
                pre[j] = gg * (1.0f + sc); shv[j] = *(const f32x4*)(modl + (size_t)b * MODW + sh_off + col); }
            if (COMBINE) g2[j] = *(const f32x4*)(modprev + (size_t)b * MODW + 5 * DM + col); }
        f32x4 rawf[XF32 ? RB : 1][4]; u32x4 rawb[XF32 ? 1 : RB][2]; int pp[COMBINE ? RB : 1][2]; float pw[COMBINE ? RB : 1][2];
#define ROW_LOAD(rb_) do { _Pragma("unroll") for (int i = 0; i < RB; ++i) { const size_t ro = (size_t)((rb_) + i) * DM; \
            if (XF32) { _Pragma("unroll") for (int j = 0; j < 4; ++j) rawf[XF32 ? i : 0][j] = *(const f32x4*)(xf + ro + 512 * (j >> 1) + 8 * lane + 4 * (j & 1)); } \
            else { _Pragma("unroll") for (int h = 0; h < 2; ++h) rawb[XF32 ? 0 : i][h] = *(const u32x4*)(xb + ro + 512 * h + 8 * lane); } \
            if (COMBINE) { pp[COMBINE ? i : 0][0] = Pos[2 * ((rb_) + i)]; pp[COMBINE ? i : 0][1] = Pos[2 * ((rb_) + i) + 1]; pw[COMBINE ? i : 0][0] = Tw[2 * ((rb_) + i)]; pw[COMBINE ? i : 0][1] = Tw[2 * ((rb_) + i) + 1]; } } } while (0)
        ROW_LOAD(chunk * 256 + wave * 32);
#pragma unroll 1
        for (int r0 = 0; r0 < 32; r0 += RB) {
            const int rowb = chunk * 256 + wave * 32 + r0;
            f32x4 v[RB][4]; int cp[COMBINE ? RB : 1][2]; float cw[COMBINE ? RB : 1][2];
#pragma unroll
            for (int i = 0; i < RB; ++i) {
                if (XF32) {
#pragma unroll
                    for (int j = 0; j < 4; ++j) v[i][j] = rawf[XF32 ? i : 0][j];
                } else {
#pragma unroll
                    for (int h = 0; h < 2; ++h) { const u32x4 w = rawb[XF32 ? 0 : i][h];
                        v[i][2 * h] = (f32x4){bf_lo(w.x), bf_hi(w.x), bf_lo(w.y), bf_hi(w.y)}; v[i][2 * h + 1] = (f32x4){bf_lo(w.z), bf_hi(w.z), bf_lo(w.w), bf_hi(w.w)}; }
                }
                if (COMBINE) { cp[i][0] = pp[i][0]; cp[i][1] = pp[i][1]; cw[i][0] = pw[i][0]; cw[i][1] = pw[i][1]; }
            }
            u32x2 ya[COMBINE ? RB : 1][2], yc[COMBINE ? RB : 1][2];
            if (COMBINE) {
#pragma unroll
                for (int i = 0; i < RB; ++i)
#pragma unroll
                    for (int h = 0; h < 2; ++h) { ya[i][h] = *(const u32x2*)(Ym + (size_t)cp[i][0] * DM + 512 * h + 8 * lane); yc[i][h] = *(const u32x2*)(Ym + (size_t)cp[i][1] * DM + 512 * h + 8 * lane); }
            }
            if (r0 + RB < 32) ROW_LOAD(rowb + RB);
            if (COMBINE) {
#pragma unroll
                for (int i = 0; i < RB; ++i) {
                    const int row = rowb + i; const float w0 = cw[i][0], w1 = cw[i][1];
#pragma unroll
                    for (int h = 0; h < 2; ++h) { float fa[8], fc[8]; unpack8_fp8(ya[i][h], fa); unpack8_fp8(yc[i][h], fc);
                        const f32x4 m0 = {w0 * fa[0] + w1 * fc[0], w0 * fa[1] + w1 * fc[1], w0 * fa[2] + w1 * fc[2], w0 * fa[3] + w1 * fc[3]};
                        const f32x4 m1 = {w0 * fa[4] + w1 * fc[4], w0 * fa[5] + w1 * fc[5], w0 * fa[6] + w1 * fc[6], w0 * fa[7] + w1 * fc[7]};
                        v[i][2 * h] = v[i][2 * h] + g2[2 * h] * m0; v[i][2 * h + 1] = v[i][2 * h + 1] + g2[2 * h + 1] * m1;
                        if (OUTF32) { *(f32x4*)(outf + (size_t)row * DM + 512 * h + 8 * lane) = v[i][2 * h]; *(f32x4*)(outf + (size_t)row * DM + 512 * h + 8 * lane + 4) = v[i][2 * h + 1]; }
                        else *(u32x4*)(xb + (size_t)row * DM + 512 * h + 8 * lane) = pg8::pack8(v[i][2 * h], v[i][2 * h + 1]); }
                }
            }
            if (NORM) {
                float ss[RB];
#pragma unroll
                for (int i = 0; i < RB; ++i) { ss[i] = 0.f;
#pragma unroll
                    for (int j = 0; j < 4; ++j) { const f32x4 q = v[i][j] * v[i][j]; ss[i] += (q[0] + q[1]) + (q[2] + q[3]); } }
#pragma unroll
                for (int o = 1; o < 64; o <<= 1)
#pragma unroll
                    for (int i = 0; i < RB; ++i) ss[i] += shx(ss[i], o, lane);
#pragma unroll
                for (int i = 0; i < RB; ++i) { const float rstd = __builtin_amdgcn_rsqf(ss[i] * (1.0f / DM) + 1e-6f);
#pragma unroll
                    for (int h = 0; h < 2; ++h) { const f32x4 h0 = v[i][2 * h] * rstd * pre[2 * h] + shv[2 * h], h1 = v[i][2 * h + 1] * rstd * pre[2 * h + 1] + shv[2 * h + 1];
                        if (H8 != 0) *(u32x2*)((H8 == 2 ? H8p : (unsigned char*)Hh) + (size_t)(rowb + i) * DM + 512 * h + 8 * lane) = (u32x2){pack4_fp8(h0[0], h0[1], h0[2], h0[3]), pack4_fp8(h1[0], h1[1], h1[2], h1[3])};
                        if (H8 != 1) *(u32x4*)(Hh + (size_t)(rowb + i) * DM + 512 * h + 8 * lane) = pg8::pack8(h0, h1); } }
            }
        }
#undef ROW_LOAD
        if (ROUTER) {
            __syncthreads();
            const int row0 = chunk * 256 + wave * 32;
            f32x4 ra[2][2];
#pragma unroll
            for (int mt = 0; mt < 2; ++mt)
#pragma unroll
                for (int et = 0; et < 2; ++et) ra[mt][et] = (f32x4){0.f, 0.f, 0.f, 0.f};
#pragma unroll 4
            for (int kk = 0; kk < 32; ++kk) {
                bf16x8 a[2], bb[2];
#pragma unroll
                for (int mt = 0; mt < 2; ++mt) a[mt] = *(const bf16x8*)(Hh + (size_t)(row0 + 16 * mt + (lane & 15)) * DM + 32 * kk + 8 * (lane >> 4));
#pragma unroll
                for (int et = 0; et < 2; ++et) bb[et] = *(const bf16x8*)(Wr + (size_t)(16 * et + (lane & 15)) * DM + 32 * kk + 8 * (lane >> 4));
#pragma unroll
                for (int mt = 0; mt < 2; ++mt)
#pragma unroll
                    for (int et = 0; et < 2; ++et) ra[mt][et] = __builtin_amdgcn_mfma_f32_16x16x32_bf16(a[mt], bb[et], ra[mt][et], 0, 0, 0);
            }
#pragma unroll
            for (int mt = 0; mt < 2; ++mt)
#pragma unroll
                for (int et = 0; et < 2; ++et)
#pragma unroll
                    for (int r = 0; r < 4; ++r) lgs[(wave * 32 + 16 * mt + 4 * (lane >> 4) + r) * 33 + 16 * et + (lane & 15)] = ra[mt][et][r];
            asm volatile("s_waitcnt lgkmcnt(0)" ::: "memory");
            if (lane < 32) {
                const int tl = wave * 32 + lane, tok = chunk * 256 + tl;
                float lg[32]; float M = -3.0e38f;
#pragma unroll
                for (int e = 0; e < 32; ++e) { lg[e] = lgs[tl * 33 + e]; M = fmaxf(M, lg[e]); }
                float bm1 = 0.f, bm2 = 0.f, bsc = -1.f; int bi1 = 0, bi2 = 0, bg = 0;
#pragma unroll
                for (int g = 0; g < 4; ++g) {
                    float m1 = -3.0e38f, m2 = -3.0e38f; int i1 = 0, i2 = 0;
#pragma unroll
                    for (int j = 0; j < 8; ++j) { const float vv = lg[8 * g + j];
                        if (vv > m1) { m2 = m1; i2 = i1; m1 = vv; i1 = j; } else if (vv > m2) { m2 = vv; i2 = j; } }
                    const float sc = expf(m1 - M) + expf(m2 - M);
                    if (sc > bsc) { bsc = sc; bg = g; bm1 = m1; bm2 = m2; bi1 = i1; bi2 = i2; }
                }
                const int e0 = 8 * bg + bi1, e1 = 8 * bg + bi2;
                const float w0 = 1.0f / (1.0f + expf(bm2 - bm1)), w1 = 1.0f - w0;
                const int r0 = __hip_atomic_fetch_add(&lcnt[e0], 1, __ATOMIC_RELAXED, __HIP_MEMORY_SCOPE_WORKGROUP);
                const int r1 = __hip_atomic_fetch_add(&lcnt[e1], 1, __ATOMIC_RELAXED, __HIP_MEMORY_SCOPE_WORKGROUP);
                Te[2 * tok] = e0; Te[2 * tok + 1] = e1; Trk[2 * tok] = r0; Trk[2 * tok + 1] = r1; Tw[2 * tok] = w0; Tw[2 * tok + 1] = w1;
            }
            __syncthreads();
            if (tid < 32) Cnt[chunk * 32 + tid] = lcnt[tid];
            __syncthreads();
        }
    }
}

#define x_in ((const float*)(const GAS float*)args.in[0])
#define c_in ((const float*)(const GAS float*)args.in[1])
#define w_ada ((const float*)(const GAS float*)args.in[2])
#define b_ada ((const float*)(const GAS float*)args.in[3])
#define g_mix ((const float*)(const GAS float*)args.in[4])
#define w_in ((const float*)(const GAS float*)args.in[5])
#define qn_a ((const float*)(const GAS float*)args.in[6])
#define kn_a ((const float*)(const GAS float*)args.in[7])
#define qn_b ((const float*)(const GAS float*)args.in[8])
#define kn_b ((const float*)(const GAS float*)args.in[9])
#define w_pa ((const float*)(const GAS float*)args.in[10])
#define w_pb ((const float*)(const GAS float*)args.in[11])
#define w_out ((const float*)(const GAS float*)args.in[12])
#define g_ffn ((const float*)(const GAS float*)args.in[13])
#define w_router ((const float*)(const GAS float*)args.in[14])
#define w_gate ((const float*)(const GAS float*)args.in[15])
#define w_up ((const float*)(const GAS float*)args.in[16])
#define w_down ((const float*)(const GAS float*)args.in[17])
#define MOD ((float*)(GAS float*)(ws + WS_MOD))
#define XB ((bf16_t*)(GAS bf16_t*)(ws + WS_XB))
#define TE ((int*)(GAS int*)(ws + WS_TE))
#define TRK ((int*)(GAS int*)(ws + WS_TRK))
#define TW ((float*)(GAS float*)(ws + WS_TW))
#define POS ((int*)(GAS int*)(ws + WS_POS))
#define CNT ((int*)(GAS int*)(ws + WS_CNT))
#define BLKE ((int*)(GAS int*)(ws + WS_BLKE))
#define BTOK ((int*)(GAS int*)(ws + WS_BTOK))
#define WR ((bf16_t*)(bf16_t*)(GAS bf16_t*)(ws + WS_WR))
#define H ((bf16_t*)(bf16_t*)(GAS bf16_t*)(ws + WS_H))
#define YAB ((bf16_t*)(GAS bf16_t*)(ws + WS_H))
#define YA ((bf16_t*)(bf16_t*)(GAS bf16_t*)(ws + WS_H))
#define YB ((bf16_t*)(bf16_t*)(GAS bf16_t*)(ws + WS_H + 64 * MiB))
#define QA ((bf16_t*)(bf16_t*)(GAS bf16_t*)(ws + WS_QKV))
#define KA ((bf16_t*)(bf16_t*)(GAS bf16_t*)(ws + WS_QKV + 64 * MiB))
#define VA ((bf16_t*)(bf16_t*)(GAS bf16_t*)(ws + WS_QKV + 128 * MiB))
#define QB ((bf16_t*)(bf16_t*)(GAS bf16_t*)(ws + WS_QKV + 192 * MiB))
#define KB ((bf16_t*)(bf16_t*)(GAS bf16_t*)(ws + WS_QKV + 256 * MiB))
#define VB ((bf16_t*)(bf16_t*)(GAS bf16_t*)(ws + WS_QKV + 272 * MiB))
#define MERGED ((bf16_t*)(bf16_t*)(GAS bf16_t*)(ws + WS_QKV))
#define YM ((unsigned char*)(GAS unsigned char*)(ws + WS_QKV))
#define H2F8 ((unsigned char*)(GAS unsigned char*)(ws + WS_QKV + 160 * MiB))
#define SA ((bf16_t*)(bf16_t*)(GAS bf16_t*)(ws + WS_GATE))
#define SB ((bf16_t*)(bf16_t*)(GAS bf16_t*)(ws + WS_GATE + 128 * MiB))
#define ACT ((bf16_t*)(bf16_t*)(GAS bf16_t*)(ws + WS_GATE))
#define PHASE_ENTER() int lane; asm volatile("v_mbcnt_lo_u32_b32 %0, -1, 0\n\tv_mbcnt_hi_u32_b32 %0, -1, %0" : "=v"(lane)); const int tid = wave * 64 + lane; GAS unsigned char* ws = ws0; int bx = bx0, vcu = vcu0; asm volatile("" : "+s"(ws), "+s"(bx), "+s"(vcu))

__device__ __forceinline__ bool in_phase(int lo, int hi, int k) { asm volatile("" : "+s"(lo), "+s"(hi)); return lo <= k && k < hi; }
#define PGATE_A SA
#define PGATE_B SB
__global__ void __launch_bounds__(512, 2) fwd_kernel(Args args) {
    extern __shared__ __attribute__((aligned(16))) unsigned char lds_raw[];
    LAS unsigned char* lds = (LAS unsigned char*)lds_raw;
    volatile LAS unsigned* MISC = (volatile LAS unsigned*)(lds + MISC_OFF);
    const int tid0 = threadIdx.x, lane0 = tid0 & 63, wave = __builtin_amdgcn_readfirstlane(tid0 >> 6);
    const int G = gridDim.x, bx0 = blockIdx.x;
    const int vcu0 = (G % 8 == 0) ? (bx0 % 8) * (G / 8) + bx0 / 8 : bx0;
    GAS unsigned char* ws0 = (GAS unsigned char*)args.ws;
    float* out = (float*)(GAS float*)args.out;
    for (int u = tid0; u < 256; u += 512) ((LAS unsigned*)(lds + MISC_OFF))[u] = 0u;
    __syncthreads();
#if MK_ONE_LAUNCH
    XcdBarrier bar = xcd_barrier_post((unsigned*)((GAS unsigned*)(ws0 + WS_CTL) + CW_BAR), MISC + 8);
#define GRID_BAR() do { int l_; asm volatile("v_mbcnt_lo_u32_b32 %0, -1, 0\n\tv_mbcnt_hi_u32_b32 %0, -1, %0" : "=v"(l_)); xcd_barrier(bar, (wave == 0) && (l_ == 0)); } while (0)
#else
#define GRID_BAR() do {} while (0)
#endif
#ifndef PHMASK
#define PHMASK 0xFFFFFFFFu
#endif
#if MK_ONE_LAUNCH
#define IN(k) true
#else
#define IN(k) in_phase(args.ph_lo, args.ph_hi, (k))
#endif
#define EN(bit) ((PHMASK >> (bit)) & 1u)
#define SEAM(k) do { if (IN(k) && IN((k) + 1)) GRID_BAR(); } while (0)

    if (EN(0) && IN(PH_PRO)) {
        PHASE_ENTER();
#pragma unroll 1
        for (int rep = 0; rep < REP_PRO; ++rep) {
        LAS float* scr = (LAS float*)(lds + wave * 16640);
        const int gw = vcu * 8 + wave, NGW = G * 8;
        constexpr int I_IN = 68 * 8, I_PA = 16 * 4, I_OUT = 16 * 8, I_GU = 32 * 2 * 8 * 8, I_DN = 32 * 16 * 4;
        constexpr int I_LAYER = I_IN + 2 * I_PA + I_OUT + I_GU + I_DN;
        auto decode = [&](int it, const float*& src, int& N, unsigned char*& dst, int& K) {
            const int l = it / I_LAYER; int r = it % I_LAYER;
            if (r < I_IN) { const int nb = r / 8, kb = r % 8; N = NC; K = DM;
                src = w_in + (size_t)l * DM * NC + (size_t)(128 * kb) * NC + inproj_srccol(64 * nb + lane);
                dst = (unsigned char*)(GAS unsigned char*)(ws + WS_WIN + l * WIN_BYTES) + (size_t)(64 * nb) * DM + 128 * kb; return; } r -= I_IN;
            if (r < 2 * I_PA) { const int pb_ = r / I_PA, q = r % I_PA, nb = q / 4, kb = q % 4; N = DM; K = DM;
                src = (pb_ ? w_pb : w_pa) + (size_t)l * 512 * DM + (size_t)(128 * kb) * DM + tile256_srccol(64 * nb + lane);
                dst = (unsigned char*)(GAS unsigned char*)(ws + WS_WPA + l * 2 * MiB) + (size_t)(64 * nb) * DM + 512 * pb_ + 128 * kb; return; } r -= 2 * I_PA;
            if (r < I_OUT) { const int nb = r / 8, kb = r % 8; N = DM; K = DM;
                src = w_out + (size_t)l * DM * DM + (size_t)(128 * kb) * DM + tile256_srccol(64 * nb + lane);
                dst = (unsigned char*)(GAS unsigned char*)(ws + WS_WOUT + l * 2 * MiB) + (size_t)(64 * nb) * DM + 128 * kb; return; } r -= I_OUT;
            if (r < I_GU) { const int e = r / 128, q = r % 128, up = q / 64, nb = (q % 64) / 8, kb = q % 8; N = DFF; K = DM;
                const int c0 = 64 * nb, drow = 256 * (c0 >> 7) + 128 * up + (c0 & 127);
                src = (up ? w_up : w_gate) + ((size_t)l * NEXP + e) * DM * DFF + (size_t)(128 * kb) * DFF + c0 + lane;
                dst = (unsigned char*)(GAS unsigned char*)(ws + WS_WGU + ((size_t)l * NEXP + e) * MiB) + (size_t)drow * DM + 128 * kb; return; } r -= I_GU;
            { const int e = r / 64, q = r % 64, nb = q / 4, kb = q % 4; N = DM; K = DFF;
                src = w_down + ((size_t)l * NEXP + e) * DFF * DM + (size_t)(128 * kb) * DM + tile256_srccol(64 * nb + lane);
                dst = (unsigned char*)(GAS unsigned char*)(ws + WS_WDN + ((size_t)l * NEXP + e) * (MiB / 2)) + (size_t)(64 * nb) * DFF + 128 * kb; }
        };
        {
            LAS unsigned char* scr8 = (LAS unsigned char*)scr;
#pragma unroll 1
            for (int it = gw; it < 2 * I_LAYER; it += NGW) {
                const float* src; int N, K; unsigned char* dst;
                decode(it, src, N, dst, K);
                float v[128];
#pragma unroll
                for (int i = 0; i < 128; ++i) v[i] = src[(size_t)i * N];
#pragma unroll
                for (int q = 0; q < 8; ++q) { u32x4 w;
                    w.x = pack4_fp8(v[16 * q + 0] * W8S, v[16 * q + 1] * W8S, v[16 * q + 2] * W8S, v[16 * q + 3] * W8S); w.y = pack4_fp8(v[16 * q + 4] * W8S, v[16 * q + 5] * W8S, v[16 * q + 6] * W8S, v[16 * q + 7] * W8S);
                    w.z = pack4_fp8(v[16 * q + 8] * W8S, v[16 * q + 9] * W8S, v[16 * q + 10] * W8S, v[16 * q + 11] * W8S); w.w = pack4_fp8(v[16 * q + 12] * W8S, v[16 * q + 13] * W8S, v[16 * q + 14] * W8S, v[16 * q + 15] * W8S);
                    *(LAS u32x4*)(scr8 + lane * 144 + 16 * q) = w; }
                asm volatile("s_waitcnt lgkmcnt(0)" ::: "memory");
#pragma unroll
                for (int j = 0; j < 8; ++j) { const int r_ = 8 * j + (lane >> 3), c = lane & 7;
                    const u32x4 w = *(const LAS u32x4*)(scr8 + r_ * 144 + 16 * c);
                    *(u32x4*)(dst + (size_t)r_ * K + 16 * c) = w; }
                asm volatile("s_waitcnt lgkmcnt(0)" ::: "memory");
            }
        }
        for (int i = (vcu * 512 + tid); i < 32 * DM; i += G * 512) { const int e = i >> 10, k = i & 1023; WR[i] = (bf16_t)(cvt_pk_bf16(w_router[(size_t)k * NEXP + e], 0.f) & 0xffffu); }
        __syncthreads();
        if (vcu < 192) {
            LAS float* cond = (LAS float*)lds;
            for (int i = tid; i < NB * DM; i += 512) { const int b = i >> 10, k = i & 1023; const float cv = c_in[i]; cond[k * 32 + b] = cv / (1.0f + expf(-cv)); }
            __syncthreads();
            const int T = 2 * vcu + (wave >> 2), kq = wave & 3;
            const int l = T / 192, n0 = (T % 192) * 32;
            const float* wp = w_ada + (size_t)l * DM * MODW + n0 + (lane & 31) + (size_t)(256 * kq + (lane >> 5)) * MODW;
            const LAS float* cp = cond + (256 * kq + (lane >> 5)) * 32 + (lane & 31);
            f32x16 acc;
#pragma unroll
            for (int r = 0; r < 16; ++r) acc[r] = 0.f;
#pragma unroll 16
            for (int k0 = 0; k0 < 256; k0 += 2) acc = __builtin_amdgcn_mfma_f32_32x32x2f32(cp[k0 * 32], wp[(size_t)k0 * MODW], acc, 0, 0, 0);
            __syncthreads();
            LAS float* part = (LAS float*)lds + wave * 1024;
#pragma unroll
            for (int r = 0; r < 16; ++r) part[r * 64 + lane] = acc[r];
            __syncthreads();
            if (kq == 0) {
                const float bias = b_ada[l * MODW + n0 + (lane & 31)];
#pragma unroll
                for (int r = 0; r < 16; ++r) { const int b = (r & 3) + 8 * (r >> 2) + 4 * (lane >> 5);
                    MOD[((size_t)l * NB + b) * MODW + n0 + (lane & 31)] = ((part[r * 64 + lane] + part[1024 + r * 64 + lane]) + (part[2048 + r * 64 + lane] + part[3072 + r * 64 + lane])) + bias; }
            }
        }
        __syncthreads();
        }
    }
    SEAM(PH_PRO);

    for (int l = 0; l < 2; ++l) {
        const int pb = PH_L0 + l * PH_PER_LAYER;
        if (EN(1) && IN(pb + P_NORM1)) { PHASE_ENTER(); const float* modl = MOD + (size_t)l * NB * MODW;
            if (l == 0) {
#pragma unroll 1
                for (int rep = 0; rep < REP_NORM1; ++rep)
                    row_phase<true, false, true, false, false, 1>(lds, tid, lane, wave, G, bx, x_in, XB, out, g_mix, modl, 0, DM, MOD, H, YM, POS, TW, WR, TE, TRK, CNT);
            } else row_phase<false, true, true, false, false, 1>(lds, tid, lane, wave, G, bx, x_in, XB, out, g_mix + DM, modl, 0, DM, MOD, H, YM, POS, TW, WR, TE, TRK, CNT); }
            {
                SEAM(pb + P_NORM1);
                if (EN(2) && IN(pb + P_INPROJ)) {
                    PHASE_ENTER();
                    pg8::Gemm g{H, (const bf16_t*)(const GAS bf16_t*)(ws + WS_WIN + l * WIN_BYTES), DM / 2}; pg8::StaticOrder S; S.init(TT, NC, G, bx); S.wgm = INPROJ_WGM;
                    LAS float* normw = (LAS float*)(lds + MISC_OFF + 1024);
                    if (tid < 256) { const int sel = tid >> 6, d = tid & 63; const float* srcw = (sel == 0) ? qn_a : (sel == 1) ? kn_a : (sel == 2) ? qn_b : kn_b; normw[tid] = srcw[l * 64 + d]; }
                    __syncthreads();
                    pg8::EpiInProj E{QA, KA, VA, QB, KB, VB, SA, SB, normw};
#pragma unroll 1
                    for (int rep = 0; rep < REP_INPROJ; ++rep)
                    pg8::gemm_phase<pg8::EpiInProj, pg8::StaticOrder, true>(lds, g, S, E, wave);
                }
                SEAM(pb + P_INPROJ);
                if (EN(3) && IN(pb + P_ATTN)) {
                    PHASE_ENTER(); (void)lane;
                    LAS char* ring = (LAS char*)lds;
#pragma unroll 1
                    for (int rep = 0; rep < REP_ATTB; ++rep)
                    for (int L = vcu; L < NB * 32; L += G) {
                        int lane; asm volatile("v_mbcnt_lo_u32_b32 %0, -1, 0\n\tv_mbcnt_hi_u32_b32 %0, -1, %0" : "=v"(lane)); const int hi = lane >> 5;
                        const int b = L >> 5, kvh = (L >> 4) & 1, qh = 4 * kvh + ((L >> 2) & 3), qb2 = L & 3;
                        const int tq0 = 512 * qb2 + 64 * wave + (lane & 31);
                        u32x4 qr[2][2];
#pragma unroll
                        for (int g = 0; g < 2; ++g)
#pragma unroll
                            for (int e = 0; e < 2; ++e) qr[g][e] = *(const u32x4*)((const unsigned char*)QB + ((size_t)b * SEQ + tq0 + 32 * g) * 512 + qh * 64 + 32 * hi + 16 * e);
                        f32x16 o[2][2]; float lsum[2] = {0.f, 0.f};
#pragma unroll
                        for (int r = 0; r < 16; ++r) { o[0][0][r] = 0.f; o[0][1][r] = 0.f; o[1][0][r] = 0.f; o[1][1][r] = 0.f; }
                        __syncthreads();
                        att::dense64_lag_loop(ring, (const unsigned char*)KB + (size_t)b * SEQ * 128 + kvh * 64, VB + (size_t)b * SEQ * 128 + kvh * 64, 128, 32, qr, o, lsum, lane, wave, wave >= 4);
                        { int l2; asm volatile("v_mbcnt_lo_u32_b32 %0, -1, 0\n\tv_mbcnt_hi_u32_b32 %0, -1, %0" : "=v"(l2)); const int tqs = 512 * qb2 + 64 * wave + (l2 & 31);
#pragma unroll
                          for (int g = 0; g < 2; ++g) att::store_out(o[g], lsum[g], (unsigned char*)YAB + ((size_t)b * SEQ + tqs + 32 * g) * DM + 512 + qh * 64, l2); }
                    }
#pragma unroll 1
                    for (int rep = 0; rep < REP_ATTA; ++rep)
                    for (int L = vcu; L < NB * 32; L += G) {
                        int lane; asm volatile("v_mbcnt_lo_u32_b32 %0, -1, 0\n\tv_mbcnt_hi_u32_b32 %0, -1, %0" : "=v"(lane)); const int hi = lane >> 5;
                        const int b = L >> 5, h = (L >> 2) & 7, tb2 = L & 3, base = 512 * tb2;
                        const int tq0 = base + 16 * (lane & 31) + wave, tq1 = tq0 + 8;
                        const unsigned char* Kg = (const unsigned char*)KA + (size_t)b * SEQ * 512 + h * 64; const bf16_t* Vg = VA + (size_t)b * SEQ * 512 + h * 64;
                        u32x4 qr[2][2];
#pragma unroll
                        for (int g = 0; g < 2; ++g)
#pragma unroll
                            for (int e = 0; e < 2; ++e) qr[g][e] = *(const u32x4*)((const unsigned char*)QA + ((size_t)b * SEQ + tq0 + 8 * g) * 512 + h * 64 + 32 * hi + 16 * e);
                        f32x16 o[2][2]; float lsum[2] = {0.f, 0.f};
#pragma unroll
                        for (int r = 0; r < 16; ++r) { o[0][0][r] = 0.f; o[0][1][r] = 0.f; o[1][0][r] = 0.f; o[1][1][r] = 0.f; }
                        __syncthreads();
                        att::dense64_loop<true>(ring, Kg, Vg, 512, base - 64, 10, qr, o, lsum, tq0, tq1, lane, wave);
                        __syncthreads();
                        {
                            LAS char* vpriv = ring + att::PRIV_OFF + wave * att::VTILE;
#define A_TK0(j) ((j) < 4 ? base + wave - 256 + 256 * (j) : wave + 8 * (((j) - 4) >> 1) + 1024 * (((j) - 4) & 1))
#define A_DK(j) ((j) < 4 ? 4 : 16)
                            u32x4 kf[2][2];
                            att::priv_kload(kf, Kg, 512, A_TK0(0), 4, lane);
#pragma unroll 1
                            for (int j = 0; j < 8; ++j) {
                                const bool p2 = j < 4; const int g = (j - 4) >> 1;
                                att::priv2_step(kf, vpriv, Kg, Vg, 512, A_TK0(j), A_DK(j), p2 || g == 0, p2 || g == 1, j + 1 < 8, A_TK0(j + 1), A_DK(j + 1), qr, o, lsum, tq0, tq1, lane);
                            }
#undef A_TK0
#undef A_DK
                        }
                        { int l2; asm volatile("v_mbcnt_lo_u32_b32 %0, -1, 0\n\tv_mbcnt_hi_u32_b32 %0, -1, %0" : "=v"(l2)); const int tqs = base + 16 * (l2 & 31) + wave;
#pragma unroll
                          for (int g = 0; g < 2; ++g) att::store_out(o[g], lsum[g], (unsigned char*)YAB + ((size_t)b * SEQ + tqs + 8 * g) * DM + h * 64, l2); }
                    }
                    __syncthreads();
                }
                SEAM(pb + P_ATTN);
                if (EN(4) && IN(pb + P_PAB)) {
                    PHASE_ENTER();
                    pg8::StaticOrder S; S.init(TT, DM, G, bx); S.wgm = N1K_WGM;
                    pg8::Gemm g{YAB, (const bf16_t*)(const GAS bf16_t*)(ws + WS_WPA + l * 2 * MiB), DM / 2}; pg8::EpiMergeFused E{MERGED, (const unsigned char*)PGATE_A, (const unsigned char*)PGATE_B};
#pragma unroll 1
                    for (int rep = 0; rep < REP_PAB; ++rep)
                    pg8::gemm_phase<pg8::EpiMergeFused, pg8::StaticOrder, true>(lds, g, S, E, wave);
                }
                SEAM(pb + P_PAB);
                if (EN(5) && IN(pb + P_OUT)) {
                    PHASE_ENTER(); const float* modl = MOD + (size_t)l * NB * MODW;
                    pg8::Gemm g{MERGED, (const bf16_t*)(const GAS bf16_t*)(ws + WS_WOUT + l * 2 * MiB), DM / 2}; pg8::StaticOrder S; S.init(TT, DM, G, bx); S.rowmajor = OUT_ROWMAJOR; S.wgm = N1K_WGM;
                    pg8::EpiResidB E{(l == 0) ? x_in : (const float*)nullptr, XB, XB, modl + 2 * DM};
#pragma unroll 1
                    for (int rep = 0; rep < ((l == 0) ? REP_OUT : 1); ++rep)
                    pg8::gemm_phase<pg8::EpiResidB, pg8::StaticOrder, true>(lds, g, S, E, wave);
                }
                SEAM(pb + P_OUT);
            }
        if (EN(6) && IN(pb + P_NORM2)) { PHASE_ENTER(); const float* modl = MOD + (size_t)l * NB * MODW;
#pragma unroll 1
            for (int rep = 0; rep < REP_NORM2; ++rep)
            row_phase<false, false, true, true, false, GU_F8 ? 2 : 0>(lds, tid, lane, wave, G, bx, x_in, XB, out, g_ffn + l * DM, modl, 3 * DM, 4 * DM, MOD, H, YM, POS, TW, WR, TE, TRK, CNT, H2F8); }
        SEAM(pb + P_NORM2);
        if (EN(7) && IN(pb + P_PLACE)) {
            PHASE_ENTER();
            LAS int* part_tot = (LAS int*)lds;
            LAS int* part_pre = part_tot + 512;
            LAS int* basee = part_pre + 512;
            LAS int* pstart = basee + 32;
            LAS int* pend = pstart + 32;
            LAS int* tote = pend + 32;
            for (int chunk = bx; chunk < 256; chunk += G) {
                { const int e = tid & 31, part = tid >> 5; int st = 0, sp = 0;
                    for (int q = 0; q < 16; ++q) { const int ch = part * 16 + q; const int v = CNT[ch * 32 + e]; st += v; sp += (ch < chunk) ? v : 0; }
                    part_tot[part * 32 + e] = st; part_pre[part * 32 + e] = sp; }
                __syncthreads();
                if (tid < 32) { int st = 0, sp = 0; for (int q = 0; q < 16; ++q) { st += part_tot[q * 32 + tid]; sp += part_pre[q * 32 + tid]; } tote[tid] = st; basee[tid] = sp; }
                __syncthreads();
                if (tid == 0) { int run = 0; for (int e = 0; e < 32; ++e) { const int padded = (tote[e] + 255) & ~255; pstart[e] = run; basee[e] += run; run += padded; pend[e] = run; } }
                __syncthreads();
                { const int tok = chunk * 256 + (tid >> 1), slot = tid & 1; const int e = TE[2 * tok + slot], rk = TRK[2 * tok + slot]; const int dest = basee[e] + rk;
                    BTOK[dest] = tok; POS[2 * tok + slot] = dest; }
                if (chunk < 32) { const int e = chunk; const int from = pstart[e] + tote[e], n = pend[e] - from; if (tid < n) BTOK[from + tid] = 0; }
                if (chunk == 0) {
                    for (int blk = tid; blk < NBLK; blk += 512) { int e = 0; for (int q = 0; q < 32; ++q) e += (pend[q] <= blk * 256) ? 1 : 0; BLKE[blk] = e > 31 ? 31 : e; }
                    if (tid == 0) BLKE[1000] = pend[31] >> 8;
                }
                __syncthreads();
            }
        }
        SEAM(pb + P_PLACE);
        if (EN(8) && IN(pb + P_GU)) {
            PHASE_ENTER();
            const int nused = BLKE[1000];
            pg8::Gemm g{GU_F8 ? (const bf16_t*)H2F8 : H, (const bf16_t*)(const GAS bf16_t*)(ws + WS_WGU + (size_t)l * NEXP * (GU_F8 ? MiB : 2 * MiB)), GU_F8 ? DM / 2 : DM};
            pg8::MoeOrder<true> S{BLKE, BTOK, 4 * nused, G, vcu};
            pg8::EpiSwiGLU E{ACT, GU_F8 ? W8I : 1.0f};
#pragma unroll 1
            for (int rep = 0; rep < REP_GU; ++rep)
            pg8::gemm_phase<pg8::EpiSwiGLU, pg8::MoeOrder<true>, GU_F8 != 0>(lds, g, S, E, wave);
        }
        SEAM(pb + P_GU);
        if (EN(9) && IN(pb + P_DOWN)) {
            PHASE_ENTER();
            const int nused = BLKE[1000];
            pg8::Gemm g{ACT, (const bf16_t*)(const GAS bf16_t*)(ws + WS_WDN + (size_t)l * NEXP * (DN_F8 ? MiB / 2 : MiB)), DN_F8 ? DFF / 2 : DFF};
            pg8::MoeOrder<false> S{BLKE, nullptr, 4 * nused, G, vcu};
            pg8::EpiY E{YM};
#pragma unroll 1
            for (int rep = 0; rep < REP_DOWN; ++rep)
            pg8::gemm_phase<pg8::EpiY, pg8::MoeOrder<false>, DN_F8 != 0>(lds, g, S, E, wave);
        }
        SEAM(pb + P_DOWN);
    }
    if (EN(10) && IN(PH_FINAL)) {
        PHASE_ENTER();
        row_phase<false, true, false, false, true>(lds, tid, lane, wave, G, bx, x_in, XB, out, g_ffn, MOD, 0, 0, MOD + (size_t)NB * MODW, H, YM, POS, TW, WR, TE, TRK, CNT);
    }
#undef IN
#undef SEAM
#undef GRID_BAR
}

extern "C" void kernel_launch(void* const* d_in, const int* in_sizes, int n_in, void* d_out, int out_size, void* d_ws, size_t ws_size, hipStream_t stream) {
    static int grid = 0;
    if (grid == 0) {
        if (n_in != 18 || in_sizes[0] != TT * DM || out_size != TT * DM || ws_size < WS_END) { fprintf(stderr, "kernel_launch: unexpected shapes / workspace (n_in %d, ws %zu); nothing launched\n", n_in, ws_size); grid = -1; return; }
        int dev = 0, cus = 0, per_cu = 0;
        if (hipGetDevice(&dev) != hipSuccess || hipDeviceGetAttribute(&cus, hipDeviceAttributeMultiprocessorCount, dev) != hipSuccess) { grid = -1; return; }
        if (hipFuncSetAttribute((const void*)fwd_kernel, hipFuncAttributeMaxDynamicSharedMemorySize, LDS_BYTES) != hipSuccess) { fprintf(stderr, "kernel_launch: hipFuncSetAttribute failed\n"); grid = -1; return; }
        if (hipOccupancyMaxActiveBlocksPerMultiprocessor(&per_cu, (const void*)fwd_kernel, 512, LDS_BYTES) != hipSuccess || per_cu < 1) { fprintf(stderr, "kernel_launch: occupancy query says %d\n", per_cu); per_cu = 1; }
        (void)hipGetLastError();
        grid = cus;
    }
    if (grid < 0) return;
    (void)hipMemsetAsync((char*)d_ws + WS_CTL, 0, CTL_ZERO_BYTES, stream);
    Args a{};
    for (int i = 0; i < 18; ++i) a.in[i] = (const float*)d_in[i];
    a.out = (float*)d_out; a.ws = (unsigned char*)d_ws;
#if MK_ONE_LAUNCH
    a.ph_lo = 0; a.ph_hi = NPH;
    hipLaunchKernelGGL(fwd_kernel, dim3(grid), dim3(512), LDS_BYTES, stream, a);
#else
    for (int p = 0; p < NPH; ++p) { a.ph_lo = p; a.ph_hi = p + 1; hipLaunchKernelGGL(fwd_kernel, dim3(grid), dim3(512), LDS_BYTES, stream, a); }
#endif
}
```

```cpp
#include <hip/hip_runtime.h>
#include <cstdio>
#include <cstdint>

#ifndef INPROJ_WGM
#define INPROJ_WGM 4
#endif
#ifndef GEMM_ALIGN
#define GEMM_ALIGN 1
#endif
#ifndef ROWB
#define ROWB 4
#endif
#ifndef N1K_WGM
#define N1K_WGM 8
#endif
#ifndef OUT_ROWMAJOR
#define OUT_ROWMAJOR 0
#endif
#ifndef REP_PRO
#define REP_PRO 1
#endif
#ifndef REP_ATTB
#define REP_ATTB 1
#endif
#ifndef REP_ATTA
#define REP_ATTA 1
#endif
#ifndef REP_INPROJ
#define REP_INPROJ 1
#endif
#ifndef REP_NORM1
#define REP_NORM1 1
#endif
#ifndef REP_GU
#define REP_GU 1
#endif
#ifndef REP_PAB
#define REP_PAB 1
#endif
#ifndef REP_OUT
#define REP_OUT 1
#endif
#ifndef REP_DOWN
#define REP_DOWN 1
#endif
#ifndef REP_NORM2
#define REP_NORM2 1
#endif
#ifndef GU_F8
#define GU_F8 1
#endif
#ifndef DN_F8
#define DN_F8 1
#endif
#ifndef MK_ONE_LAUNCH
#define MK_ONE_LAUNCH 1
#endif

#define LAS __attribute__((address_space(3)))
#define GAS __attribute__((address_space(1)))
typedef unsigned short bf16_t;
typedef short bf16x8 __attribute__((ext_vector_type(8)));
typedef short s16x4 __attribute__((ext_vector_type(4)));
typedef float f32x4 __attribute__((ext_vector_type(4)));
typedef float f32x16 __attribute__((ext_vector_type(16)));
typedef unsigned u32x4 __attribute__((ext_vector_type(4)));
typedef unsigned u32x2 __attribute__((ext_vector_type(2)));

constexpr int NB = 32, SEQ = 2048, DM = 1024, TT = NB * SEQ;
constexpr int NC = 4352;
constexpr int NEXP = 32, DFF = 512, NPAD = 139264, NBLK = 544;
constexpr int MODW = 6 * DM;
constexpr float QSCALE = 0.125f * 1.4426950408889634f;

constexpr size_t MiB = 1u << 20;
constexpr size_t WS_CTL = 0, CTL_ZERO_BYTES = 64 * 1024;
constexpr size_t WS_MOD = 1 * MiB;
constexpr size_t WS_TE = 2 * MiB + 512 * 1024, WS_TRK = 3 * MiB, WS_TW = 3 * MiB + 512 * 1024, WS_POS = 4 * MiB;
constexpr size_t WS_CNT = 4 * MiB + 512 * 1024;
constexpr size_t WS_BLKE = WS_CNT + 64 * 1024;
constexpr size_t WS_BTOK = WS_CNT + 128 * 1024;
constexpr size_t WS_WR = 5 * MiB + 256 * 1024;
constexpr size_t WS_WIN = 6 * MiB;
constexpr size_t WIN_BYTES = (size_t)NC * DM * 2;
constexpr size_t WS_WPA = 23 * MiB, WS_WPB = 25 * MiB, WS_WOUT = 27 * MiB;
constexpr size_t WS_WGU = 31 * MiB;
constexpr size_t WS_WDN = 159 * MiB;
constexpr size_t WS_H = 223 * MiB;
constexpr size_t WS_QKV = 351 * MiB;
constexpr size_t WS_GATE = 639 * MiB;
constexpr size_t WS_XB = 896 * MiB;
constexpr size_t WS_END = 1024 * MiB;
constexpr int CW_BAR = 4096;

constexpr int RING_BYTES = 133120;
constexpr int MISC_OFF = RING_BYTES;
constexpr int LDS_BYTES = 147456;

#define RLX_AGENT __ATOMIC_RELAXED, __HIP_MEMORY_SCOPE_AGENT
typedef float f32x2_t __attribute__((ext_vector_type(2))); typedef __bf16 bf16x2_t __attribute__((ext_vector_type(2)));
__device__ __forceinline__ unsigned cvt_pk_bf16(float lo, float hi) { const f32x2_t v = {lo, hi}; const bf16x2_t b = __builtin_convertvector(v, bf16x2_t); return __builtin_bit_cast(unsigned, b); }
typedef float f32x2v __attribute__((ext_vector_type(2)));
__device__ __forceinline__ unsigned pack4_fp8(float a, float b, float c, float d) { unsigned w = 0; w = __builtin_amdgcn_cvt_pk_fp8_f32(a, b, w, false); w = __builtin_amdgcn_cvt_pk_fp8_f32(c, d, w, true); return w; }
__device__ __forceinline__ void unpack8_fp8(u32x2 w, float (&o)[8]) { const f32x2v a = __builtin_amdgcn_cvt_pk_f32_fp8(w.x, false), b = __builtin_amdgcn_cvt_pk_f32_fp8(w.x, true), c = __builtin_amdgcn_cvt_pk_f32_fp8(w.y, false), d = __builtin_amdgcn_cvt_pk_f32_fp8(w.y, true);
    o[0] = a.x; o[1] = a.y; o[2] = b.x; o[3] = b.y; o[4] = c.x; o[5] = c.y; o[6] = d.x; o[7] = d.y; }
constexpr float A8S = 4.f, A8I = 0.25f;
constexpr float W8S = 64.f, W8I = 1.f / 64.f;
__device__ __forceinline__ float bf_lo(unsigned w) { return __uint_as_float(w << 16); }
__device__ __forceinline__ float bf_hi(unsigned w) { return __uint_as_float(w & 0xffff0000u); }
__device__ __forceinline__ float shx(float v, int mask, int lane) { return __int_as_float(__builtin_amdgcn_ds_bpermute((lane ^ mask) << 2, __float_as_int(v))); }
__device__ __forceinline__ float wave_sum(float v, int lane) {
#pragma unroll
    for (int o = 1; o < 64; o <<= 1) v += shx(v, o, lane);
    return v;
}
__device__ __forceinline__ float wave_max(float v, int lane) {
#pragma unroll
    for (int o = 1; o < 64; o <<= 1) v = fmaxf(v, shx(v, o, lane));
    return v;
}
__device__ __forceinline__ float sigmoid_f(float x) { return __builtin_amdgcn_rcpf(1.0f + __builtin_amdgcn_exp2f(-1.4426950408889634f * x)); }

#define XB_TMO      128
#define XB_XCNT(j)  (256  + 64 * (j))
#define XB_XSUB(j)  (1280 + 64 * (j))
#define XB_XGEN(j)  (2304 + 64 * (j))
#define XB_TOP      3328
#define XB_TOPGEN   3392
#define XCD_BAR_WORDS 3456
#define XB_SPIN_CAP (1u << 18)

__device__ __forceinline__ unsigned xb_ld(unsigned* p)              { return __hip_atomic_load(p, __ATOMIC_RELAXED, __HIP_MEMORY_SCOPE_AGENT); }
__device__ __forceinline__ unsigned xb_add(unsigned* p, unsigned v) { return __hip_atomic_fetch_add(p, v, __ATOMIC_RELAXED, __HIP_MEMORY_SCOPE_AGENT); }
__device__ __forceinline__ unsigned xb_xcc_id() { return (unsigned)__builtin_amdgcn_s_getreg((3 << 11) | 20) & 0xFu; }
#define XB_SPIN(cond, bar) do { unsigned _sp = 0; while (cond) { __builtin_amdgcn_s_sleep(1); \
    if ((++_sp & 255u) == 0u) { if (xb_ld(&(bar)[XB_TMO])) break; if (_sp > XB_SPIN_CAP) { atomicAdd(&(bar)[XB_TMO], 1u); break; } } } } while (0)

struct XcdBarrier { unsigned* bar; unsigned x; volatile LAS unsigned* st; };

__device__ __forceinline__ XcdBarrier xcd_barrier_post(unsigned* bar, volatile LAS unsigned* st) {
    XcdBarrier b; b.bar = bar; b.x = xb_xcc_id(); b.st = st;
    if (threadIdx.x == 0) (void)xb_add(&bar[XB_XCNT(b.x)], 1u);
    return b;
}
__device__ __forceinline__ void xcd_barrier_complete(unsigned* bar, unsigned x, unsigned& nloc, unsigned& nx) {
    const unsigned G = gridDim.x * gridDim.y * gridDim.z;
    unsigned sum, cnt, mine, sp = 0u;
    for (;;) {
        sum = 0u; cnt = 0u; mine = 0u;
#pragma unroll
        for (unsigned j = 0; j < 16; ++j) { const unsigned c = xb_ld(&bar[XB_XCNT(j)]); sum += c; cnt += (c > 0u) ? 1u : 0u; mine = (j == x) ? c : mine; }
        if (sum == G) break;
        __builtin_amdgcn_s_sleep(1);
        if ((++sp & 255u) == 0u) { if (xb_ld(&bar[XB_TMO])) break; if (sp > XB_SPIN_CAP) { atomicAdd(&bar[XB_TMO], 1u); break; } }
    }
    nloc = mine > 0u ? mine : 1u; nx = cnt > 0u ? cnt : 1u;
}
__device__ __forceinline__ void xcd_barrier(const XcdBarrier& b, const bool is_t0  ) {
    asm volatile("s_waitcnt vmcnt(0)" ::: "memory");
    __syncthreads();
    if (is_t0) {
        unsigned* bar = b.bar; unsigned bx_ = b.x;
        asm volatile("" : "+s"(bar), "+s"(bx_));
        __builtin_amdgcn_s_waitcnt(0);
        unsigned nloc = b.st[0], nx = b.st[1];
        if (nloc == 0u) { xcd_barrier_complete(bar, bx_, nloc, nx); b.st[0] = nloc; b.st[1] = nx; }
        const unsigned old = xb_add(&bar[XB_XSUB(bx_)], 1u);
        const unsigned gen = old / nloc;
        if (old + 1u == (gen + 1u) * nloc) {
            __builtin_amdgcn_fence(__ATOMIC_RELEASE, "agent");
            asm volatile("s_waitcnt vmcnt(0)" ::: "memory");
            const unsigned og = xb_add(&bar[XB_TOP], 1u);
            const unsigned tg = og / nx;
            if (og + 1u == (tg + 1u) * nx) xb_add(&bar[XB_TOPGEN], 1u);
            else XB_SPIN(xb_ld(&bar[XB_TOPGEN]) == tg, bar);
            __builtin_amdgcn_fence(__ATOMIC_ACQUIRE, "agent");
            xb_add(&bar[XB_XGEN(bx_)], 1u);
            asm volatile("s_waitcnt vmcnt(0)" ::: "memory");
        } else {
            XB_SPIN(xb_ld(&bar[XB_XGEN(bx_)]) == gen, bar);
            __builtin_amdgcn_fence(__ATOMIC_ACQUIRE, "agent");
            asm volatile("s_waitcnt vmcnt(0)" ::: "memory");
        }
    }
    __syncthreads();
}

namespace pg8 {
constexpr int BM = 256, BK = 64, HALF = 128, HTB = HALF * BK * 2, STAGE_BYTES = 8 * HTB, NXCD = 8, WGM = 8;
__host__ __device__ __forceinline__ int lds_byte(int r, int c) { const int st = (r >> 4) * 2 + (c >> 5), rr = r & 15, cc = c & 31, ob = rr * 64 + cc * 2; return st * 1024 + (ob ^ (((ob >> 9) & 1) << 5)); }
__host__ __device__ __forceinline__ void stage_rc(int b, int& R, int& C) { const int st = b / 1024, sb = b % 1024, swz = sb ^ (((sb >> 9) & 1) << 5); R = (st >> 1) * 16 + swz / 64; C = (st & 1) * 32 + (swz % 64) / 2; }
__host__ __device__ __forceinline__ int perm32(int rho) { const int n = rho >> 4, i = rho & 15; return 8 * (i >> 2) + 4 * n + (i & 3); }

struct Unit { int pm, pn; };
struct Gemm { const bf16_t* A; const bf16_t* Bt; int K; };

struct StaticOrder {
    static constexpr bool GATHER = false;
    int nM, nN, nwg, G, c, wgm = WGM;
    __device__ void init(int M, int N, int G_, int c_) { asm volatile("" : "+s"(c_));     nM = M / BM; nN = N / BM; nwg = nM * nN; G = G_; c = c_; }
    int rowmajor = 0;
    __device__ __forceinline__ bool next(int i, Unit& u) const {
        if (rowmajor) { const int upw = (nwg + G - 1) / G, k = c * upw + i; if (i >= upw || k >= nwg) return false; u.pm = k / nN; u.pn = k % nN; return true; }
        const long L = (long)i * G + c; if (L >= nwg) return false;
        int wgid = (int)L; { const int q = nwg / NXCD, r = nwg % NXCD, xcd = wgid % NXCD, off = wgid / NXCD; wgid = (xcd < r ? xcd * (q + 1) : r * (q + 1) + (xcd - r) * q) + off; }
        const int nig = wgm * nN, gid = wgid / nig, fm = gid * wgm, gsz = (nM - fm) < wgm ? (nM - fm) : wgm;
        u.pm = fm + ((wgid % nig) % gsz); u.pn = (wgid % nig) / gsz; return true;
    }
    __device__ __forceinline__ void aoff(const Unit&, int, int, unsigned (&)[2][2]) const {}
};
template <bool GATH>
struct MoeOrder {
    static constexpr bool GATHER = GATH;
    const int* blk_e; const int* rowidx; int nunits, G, c;
    __device__ __forceinline__ bool next(int i, Unit& u) const {
        const int L = i * G + c; if (L >= nunits) return false;
        const int blk = L >> 2; const int e = blk_e[blk]; u.pm = blk; u.pn = 4 * e + (L & 3); return true;
    }
    __device__ __forceinline__ void aoff(const Unit& u, int tid_, int K, unsigned (&o)[2][2]) const {
        int tid = tid_; asm volatile("" : "+v"(tid));
#pragma unroll
        for (int i = 0; i < 2; ++i) { int R, C; stage_rc(tid * 16 + i * 8192, R, C);
#pragma unroll
            for (int h = 0; h < 2; ++h) { const int r = u.pm * BM + h * HALF + R; const int src = rowidx ? rowidx[r] : r; o[h][i] = (unsigned)src * (unsigned)(K * 2) + (unsigned)C * 2u; } }
    }
};

typedef int i32x8 __attribute__((ext_vector_type(8))); typedef int i32x4 __attribute__((ext_vector_type(4)));
__device__ __forceinline__ i32x8 cat8(const bf16x8& a, const bf16x8& b) { return __builtin_shufflevector(__builtin_bit_cast(i32x4, a), __builtin_bit_cast(i32x4, b), 0, 1, 2, 3, 4, 5, 6, 7); }
template <class Epi, class Sched, bool F8 = false>
__device__ __forceinline__ void gemm_phase(LAS unsigned char* lds, const Gemm g, const Sched& S, const Epi& E, const int wid) {
    int lane_; asm volatile("v_mbcnt_lo_u32_b32 %0, -1, 0\n\tv_mbcnt_hi_u32_b32 %0, -1, %0" : "=v"(lane_));
    const int lane = lane_, tid = wid * 64 + lane, wr = wid >> 2, wc = wid & 3, fr = lane & 15, fq = lane >> 4;
    const int K = g.K, nt = K / BK;
    unsigned voffA[2], voffB[2];
#pragma unroll
    for (int i = 0; i < 2; ++i) { int R, C; stage_rc(tid * 16 + i * 8192, R, C); const int Rb = Epi::PERM ? ((R & ~31) + perm32(R & 31)) : R;
        voffA[i] = (unsigned)(R * K + C) * 2u; voffB[i] = (unsigned)(Rb * K + C) * 2u; }
    const size_t kstep = (size_t)(BK * 2);
    const size_t hstep = (size_t)HALF * K * 2;
    const size_t tstep = 2 * hstep;
    const unsigned ldsw = (unsigned)wid * 1024u;
    const int aoff = lds_byte(wr * 64 + fr, fq * 8), boff = lds_byte(wc * 32 + fr, fq * 8);
    const char* Ab = (const char*)g.A;
#define PG8_SA(b, h) (((b) * 2 + (h)) * HTB)
#define PG8_SB(b, h) ((4 + (b) * 2 + (h)) * HTB)
#define PG8_UNI(p) asm volatile("" : "+s"(p))
#define PG8_LOFF(v) asm volatile("" : "+v"(v))
#define PG8_STAGEB(bufoff, gbase, voff) do { const char* _g = (const char*)(gbase); PG8_UNI(_g); _Pragma("unroll") for (int _i = 0; _i < 2; ++_i) { unsigned _v = (voff)[_i]; PG8_LOFF(_v); \
        __builtin_amdgcn_global_load_lds((const unsigned*)(_g + _v), (LAS unsigned*)(lds + (bufoff) + ldsw + _i * 8192), 16, 0, 0); } } while (0)
#define PG8_STAGEA(bufoff, H_, kb, NEXT) do { if constexpr (Sched::GATHER) { const char* _g = Ab + (size_t)(kb); PG8_UNI(_g); _Pragma("unroll") for (int _i = 0; _i < 2; ++_i) { unsigned _o = (NEXT) ? na[H_][_i] : ca[H_][_i]; PG8_LOFF(_o); \
            __builtin_amdgcn_global_load_lds((const unsigned*)(_g + _o), (LAS unsigned*)(lds + (bufoff) + ldsw + _i * 8192), 16, 0, 0); } } \
        else { const char* _b = Ab + ((NEXT) ? nU : cU) + (size_t)(H_) * hstep + (size_t)(kb); PG8_UNI(_b); _Pragma("unroll") for (int _i = 0; _i < 2; ++_i) { unsigned _v = voffA[_i]; PG8_LOFF(_v); \
            __builtin_amdgcn_global_load_lds((const unsigned*)(_b + _v), (LAS unsigned*)(lds + (bufoff) + ldsw + _i * 8192), 16, 0, 0); } } } while (0)
#define PG8_LDA(dst, b, h) do { _Pragma("unroll") for (int m = 0; m < 4; ++m) _Pragma("unroll") for (int k = 0; k < 2; ++k) dst[m][k] = *(const LAS bf16x8*)(lds + PG8_SA(b, h) + aoff + m * 2048 + k * 1024); } while (0)
#define PG8_LDB(dst, b, h) do { _Pragma("unroll") for (int n = 0; n < 2; ++n) _Pragma("unroll") for (int k = 0; k < 2; ++k) dst[n][k] = *(const LAS bf16x8*)(lds + PG8_SB(b, h) + boff + n * 2048 + k * 1024); } while (0)
#define PG8_MMA(ai, bj, At, Bt) do { __builtin_amdgcn_s_setprio(1); _Pragma("unroll") for (int m = 0; m < 4; ++m) _Pragma("unroll") for (int n = 0; n < 2; ++n) { \
        if constexpr (F8) { const i32x8 b_ = cat8(Bt[n][0], Bt[n][1]), a_ = cat8(At[m][0], At[m][1]); \
            asm volatile("v_mfma_f32_16x16x128_f8f6f4 %0, %1, %2, %0" : "+v"(acc[ai][bj][m][n]) : "v"(b_), "v"(a_)); } \
        else { _Pragma("unroll") for (int k = 0; k < 2; ++k) acc[ai][bj][m][n] = __builtin_amdgcn_mfma_f32_16x16x32_bf16(Bt[n][k], At[m][k], acc[ai][bj][m][n], 0, 0, 0); } } \
        __builtin_amdgcn_s_setprio(0); } while (0)
#define PG8_MFMA_DRAIN asm volatile("s_nop 7\n\ts_nop 7\n\ts_nop 3" ::: "memory")
#define PG8_WAIT_V(n) asm volatile("s_waitcnt vmcnt(" #n ")" ::: "memory")
#define PG8_WAIT_L(n) asm volatile("s_waitcnt lgkmcnt(" #n ")" ::: "memory")
#define PG8_BAR __builtin_amdgcn_s_barrier()
#define PG8_SCHED __builtin_amdgcn_sched_barrier(0)
    Unit cur, nxt; int ui = 0;
    if (!S.next(0, cur)) return;
    f32x4 acc[2][2][4][2];
#pragma unroll
    for (int a = 0; a < 2; ++a)
#pragma unroll
        for (int b = 0; b < 2; ++b)
#pragma unroll
            for (int m = 0; m < 4; ++m)
#pragma unroll
                for (int n = 0; n < 2; ++n) acc[a][b][m][n] = (f32x4){0.f, 0.f, 0.f, 0.f};
    bf16x8 At[4][2], B0[2][2], B1[2][2];
    unsigned ca[2][2], na[2][2];
    size_t cU = 0, nU = 0;
    if constexpr (Sched::GATHER) S.aoff(cur, tid, K, ca); else cU = (size_t)cur.pm * tstep;
    const char* cB = (const char*)g.Bt + (size_t)cur.pn * tstep;
    PG8_STAGEB(PG8_SB(0, 0), cB, voffB); PG8_STAGEB(PG8_SB(0, 1), cB + hstep, voffB); PG8_STAGEA(PG8_SA(0, 0), 0, 0, false); PG8_STAGEA(PG8_SA(0, 1), 1, 0, false);
    if (wr == 1) PG8_BAR;
    PG8_WAIT_V(2); PG8_BAR;
    PG8_STAGEB(PG8_SB(1, 0), cB + kstep, voffB); PG8_STAGEA(PG8_SA(1, 0), 0, kstep, false); PG8_STAGEB(PG8_SB(1, 1), cB + hstep + kstep, voffB);
    PG8_WAIT_V(6); PG8_BAR;
    for (;;) {
        const bool has_next = S.next(ui + 1, nxt);
        if constexpr (Sched::GATHER) {
            if (has_next) S.aoff(nxt, tid, K, na);
            else {
#pragma unroll
                for (int h = 0; h < 2; ++h)
#pragma unroll
                    for (int i = 0; i < 2; ++i) na[h][i] = ca[h][i];
            }
        } else nU = has_next ? (size_t)nxt.pm * tstep : cU;
        const char* nB = has_next ? (const char*)g.Bt + (size_t)nxt.pn * tstep : cB;
#pragma unroll 1
        for (int t = 0; t < nt; t += 2) {
            const bool last = (t == nt - 2);
            const size_t kb1 = (size_t)(t + 1) * kstep;
            const size_t kb2 = last ? 0 : (size_t)(t + 2) * kstep, kb3 = kb2 + kstep;
            const char* b2 = last ? nB : cB + (size_t)(t + 2) * kstep; const char* b3 = b2 + kstep;
            PG8_LDB(B0, 0, 0); PG8_LDB(B1, 0, 1); PG8_SCHED; PG8_LDA(At, 0, 0); PG8_STAGEA(PG8_SA(1, 1), 1, kb1, false);
            PG8_WAIT_V(8); PG8_WAIT_L(0); PG8_BAR; PG8_MMA(0, 0, At, B0); PG8_MMA(0, 1, At, B1); PG8_BAR; PG8_SCHED;
            PG8_LDA(At, 0, 1); PG8_STAGEB(PG8_SB(0, 0), b2, voffB); PG8_STAGEB(PG8_SB(0, 1), b2 + hstep, voffB); PG8_STAGEA(PG8_SA(0, 0), 0, kb2, last);
            PG8_WAIT_V(8); PG8_WAIT_L(0); PG8_BAR; PG8_MMA(1, 0, At, B0); PG8_MMA(1, 1, At, B1); PG8_BAR; PG8_SCHED;
            PG8_LDB(B0, 1, 0); PG8_LDB(B1, 1, 1); PG8_SCHED; PG8_LDA(At, 1, 0); PG8_STAGEA(PG8_SA(0, 1), 1, kb2, last);
            PG8_WAIT_V(8); PG8_WAIT_L(0); PG8_BAR; PG8_MMA(0, 0, At, B0); PG8_MMA(0, 1, At, B1); PG8_BAR; PG8_SCHED;
            PG8_LDA(At, 1, 1); PG8_STAGEB(PG8_SB(1, 0), b3, voffB); PG8_STAGEB(PG8_SB(1, 1), b3 + hstep, voffB); PG8_STAGEA(PG8_SA(1, 0), 0, kb3, last);
            PG8_WAIT_V(8); PG8_WAIT_L(0); PG8_BAR; PG8_MMA(1, 0, At, B0); PG8_MMA(1, 1, At, B1); PG8_BAR; PG8_SCHED;
            if constexpr (Epi::MIDK) { if (t + 2 == nt / 2) { if constexpr (F8) PG8_MFMA_DRAIN; E.mid(acc, cur, wr, wc, fr, fq); if constexpr (F8) asm volatile("s_nop 3" ::: "memory"); } }
        }
#if GEMM_ALIGN
        if (wr == 0) PG8_BAR;
#endif
        if constexpr (F8) PG8_MFMA_DRAIN;
        E(acc, cur, wr, wc, fr, fq);
        if (!has_next) break;
#pragma unroll
        for (int a = 0; a < 2; ++a)
#pragma unroll
            for (int b = 0; b < 2; ++b)
#pragma unroll
                for (int m = 0; m < 4; ++m)
#pragma unroll
                    for (int n = 0; n < 2; ++n) acc[a][b][m][n] = (f32x4){0.f, 0.f, 0.f, 0.f};
        cur = nxt; cB = nB; cU = nU; ++ui;
        if constexpr (Sched::GATHER) {
#pragma unroll
            for (int h = 0; h < 2; ++h)
#pragma unroll
                for (int i = 0; i < 2; ++i) ca[h][i] = na[h][i];
        }
#if GEMM_ALIGN
        if (wr == 1) PG8_BAR;
#endif
    }
    PG8_WAIT_V(0);
#if !GEMM_ALIGN
    if (wr == 0) PG8_BAR;
#endif
    PG8_BAR;
#undef PG8_SA
#undef PG8_SB
#undef PG8_STAGEA
#undef PG8_STAGEB
#undef PG8_UNI
#undef PG8_LOFF
#undef PG8_LDA
#undef PG8_LDB
#undef PG8_MMA
#undef PG8_WAIT_V
#undef PG8_MFMA_DRAIN
#undef PG8_WAIT_L
#undef PG8_BAR
#undef PG8_SCHED
}

typedef const f32x4 (&AccRef)[2][2][4][2];

__device__ __forceinline__ u32x4 pack8(const f32x4& a, const f32x4& b) { u32x4 w; w.x = cvt_pk_bf16(a[0], a[1]); w.y = cvt_pk_bf16(a[2], a[3]); w.z = cvt_pk_bf16(b[0], b[1]); w.w = cvt_pk_bf16(b[2], b[3]); return w; }

struct EpiInProj {
    static constexpr bool PERM = true, MIDK = false;
    bf16_t *QA, *KA, *VA, *QB, *KB, *VB, *SA, *SB;
    const LAS float* normw;
    template <int ROPE>
    __device__ __forceinline__ void head_tile(AccRef acc, bf16_t* dst_, int ld, int hcol, int gsel, float scale, int row0, int fr, int fq) const {
        unsigned char* dst = (unsigned char*)dst_;
        int d0[2];
#pragma unroll
        for (int bj = 0; bj < 2; ++bj) d0[bj] = (ROPE == 1) ? (fq == 0 ? 8 * bj : 8 + 8 * fq + 24 * bj) : (fq < 2 ? 8 * fq + 16 * bj : 16 + 8 * fq + 16 * bj);
        f32x4 g[2][2];
#pragma unroll
        for (int bj = 0; bj < 2; ++bj)
#pragma unroll
            for (int n = 0; n < 2; ++n) g[bj][n] = *(const LAS f32x4*)(normw + gsel * 64 + d0[bj] + 4 * n);
        constexpr float FA[8] = {1.591549431e-01f, 3.086376340e-02f, 5.985185713e-03f, 1.160663641e-03f, 2.250790790e-04f, 4.364795279e-05f, 8.464330808e-06f, 1.641426263e-06f};
        constexpr float FB[16] = {1.591549431e-01f, 8.949940161e-02f, 5.032921210e-02f, 2.830219583e-02f, 1.591549431e-02f, 8.949940161e-03f, 5.032921210e-03f, 2.830219583e-03f,
                                  1.591549431e-03f, 8.949940161e-04f, 5.032921210e-04f, 2.830219583e-04f, 1.591549431e-04f, 8.949940161e-05f, 5.032921210e-05f, 2.830219583e-05f};
        float fq8[8];
#pragma unroll
        for (int k = 0; k < 8; ++k) fq8[k] = (ROPE == 1) ? FA[k] : ((fq & 1) ? FB[8 + k] : FB[k]);
        const bool rot = (ROPE == 2) || (fq == 0);
#pragma unroll
        for (int ai = 0; ai < 2; ++ai)
#pragma unroll
            for (int m = 0; m < 4; ++m) {
                const int row = row0 + ai * HALF + m * 16; const int s = row & (SEQ - 1);
                f32x4 y[2][2]; float ss = 0.f;
#pragma unroll
                for (int bj = 0; bj < 2; ++bj)
#pragma unroll
                    for (int n = 0; n < 2; ++n) { y[bj][n] = acc[ai][bj][m][n]; const f32x4 q = y[bj][n] * y[bj][n]; ss += (q[0] + q[1]) + (q[2] + q[3]); }
                ss += shx(ss, 16, fr + 16 * fq); ss += shx(ss, 32, fr + 16 * fq);
                const float rinv = __builtin_amdgcn_rsqf(ss * (W8I * W8I / 64.0f) + 1e-6f) * W8I;
#pragma unroll
                for (int bj = 0; bj < 2; ++bj)
#pragma unroll
                    for (int n = 0; n < 2; ++n) y[bj][n] = y[bj][n] * rinv * g[bj][n];
                if (ROPE != 0) {
                    const float pos = (float)((ROPE == 1) ? s : (fq < 2 ? (s >> 6) : (s & 63)));
#pragma unroll
                    for (int n = 0; n < 2; ++n)
#pragma unroll
                        for (int j = 0; j < 4; ++j) {
                            const float xr = __builtin_amdgcn_fractf(pos * fq8[4 * n + j]);
                            const float c = rot ? __builtin_amdgcn_cosf(xr) : 1.0f, s_ = rot ? __builtin_amdgcn_sinf(xr) : 0.0f;
                            const float x1 = y[0][n][j], x2 = y[1][n][j];
                            y[0][n][j] = x1 * c - x2 * s_; y[1][n][j] = x2 * c + x1 * s_;
                        }
                }
                u32x4 w;
#pragma unroll
                for (int bj = 0; bj < 2; ++bj) { const f32x4 a = y[bj][0] * scale, c = y[bj][1] * scale;
                    const unsigned lo = pack4_fp8(a[0], a[1], a[2], a[3]), hi = pack4_fp8(c[0], c[1], c[2], c[3]);
                    if (bj == 0) { w.x = lo; w.y = hi; } else { w.z = lo; w.w = hi; } }
                *(u32x4*)(dst + (size_t)row * ld + hcol + 16 * fq) = w;
            }
    }
    __device__ __forceinline__ void operator()(AccRef acc, const Unit& u, int wr, int wc, int fr_, int fq_) const {
        int fr = fr_, fq = fq_; asm volatile("" : "+v"(fr), "+v"(fq));
        const int pn = u.pn; const int row0 = u.pm * BM + wr * 64 + fr;
        if (pn >= 9) {
            unsigned char* base = (unsigned char*)((pn < 13) ? SA : SB); const int colt = ((pn - 9) & 3) * 256 + wc * 64 + 16 * fq;
#pragma unroll
            for (int ai = 0; ai < 2; ++ai)
#pragma unroll
                for (int m = 0; m < 4; ++m) { u32x4 w;
#pragma unroll
                    for (int bj = 0; bj < 2; ++bj) { f32x4 v0 = acc[ai][bj][m][0], v1 = acc[ai][bj][m][1];
#pragma unroll
                        for (int j = 0; j < 4; ++j) { v0[j] = sigmoid_f(v0[j] * W8I); v1[j] = sigmoid_f(v1[j] * W8I); }
                        const unsigned lo = pack4_fp8(v0[0], v0[1], v0[2], v0[3]), hi = pack4_fp8(v1[0], v1[1], v1[2], v1[3]);
                        if (bj == 0) { w.x = lo; w.y = hi; } else { w.z = lo; w.w = hi; } }
                    *(u32x4*)(base + (size_t)(row0 + ai * HALF + m * 16) * DM + colt) = w; }
        } else if (pn == 4 || pn == 5) {
            const int colt = (pn - 4) * 256 + wc * 64 + 16 * fq;
#pragma unroll
            for (int ai = 0; ai < 2; ++ai)
#pragma unroll
                for (int m = 0; m < 4; ++m) { u32x4 w;
                    { const f32x4 a = acc[ai][0][m][0] * W8I, c = acc[ai][0][m][1] * W8I; w.x = pack4_fp8(a[0], a[1], a[2], a[3]); w.y = pack4_fp8(c[0], c[1], c[2], c[3]); }
                    { const f32x4 a = acc[ai][1][m][0] * W8I, c = acc[ai][1][m][1] * W8I; w.z = pack4_fp8(a[0], a[1], a[2], a[3]); w.w = pack4_fp8(c[0], c[1], c[2], c[3]); }
                    *(u32x4*)((unsigned char*)VA + (size_t)(row0 + ai * HALF + m * 16) * 512 + colt) = w; }
        } else if (pn < 2)  head_tile<1>(acc, QA, 512, 64 * (4 * pn + wc), 0, QSCALE, row0, fr, fq);
        else if (pn < 4)    head_tile<1>(acc, KA, 512, 64 * (4 * (pn - 2) + wc), 1, 1.0f, row0, fr, fq);
        else if (pn < 8)    head_tile<2>(acc, QB, 512, 64 * (4 * (pn - 6) + wc), 2, QSCALE, row0, fr, fq);
        else if (wc < 2)    head_tile<2>(acc, KB, 128, 64 * wc, 3, 1.0f, row0, fr, fq);
        else {
#pragma unroll
            for (int ai = 0; ai < 2; ++ai)
#pragma unroll
                for (int m = 0; m < 4; ++m) { u32x4 w;
                    { const f32x4 a = acc[ai][0][m][0] * W8I, c = acc[ai][0][m][1] * W8I; w.x = pack4_fp8(a[0], a[1], a[2], a[3]); w.y = pack4_fp8(c[0], c[1], c[2], c[3]); }
                    { const f32x4 a = acc[ai][1][m][0] * W8I, c = acc[ai][1][m][1] * W8I; w.z = pack4_fp8(a[0], a[1], a[2], a[3]); w.w = pack4_fp8(c[0], c[1], c[2], c[3]); }
                    *(u32x4*)((unsigned char*)VB + (size_t)(row0 + ai * HALF + m * 16) * 128 + 64 * (wc - 2) + 16 * fq) = w; }
        }
    }
};

struct EpiMergeFused {
    static constexpr bool PERM = true, MIDK = true;
    bf16_t* MG; const unsigned char* GA; const unsigned char* GB;
    __device__ __forceinline__ void mid(f32x4 (&acc)[2][2][4][2], const Unit& u, int wr, int wc, int fr_, int fq_) const {
        int fr = fr_, fq = fq_; asm volatile("" : "+v"(fr), "+v"(fq));
        const int row0 = u.pm * BM + wr * 64 + fr, col0 = u.pn * BM + wc * 64 + 16 * fq;
#pragma unroll
        for (int ai = 0; ai < 2; ++ai)
#pragma unroll
            for (int m = 0; m < 4; ++m) { const size_t ro = (size_t)(row0 + ai * HALF + m * 16) * DM + col0;
                const u32x4 a = *(const u32x4*)(GA + ro), b = *(const u32x4*)(GB + ro);
#pragma unroll
                for (int bj = 0; bj < 2; ++bj) {
                    float sa[8], sb[8]; unpack8_fp8(bj ? (u32x2){a.z, a.w} : (u32x2){a.x, a.y}, sa); unpack8_fp8(bj ? (u32x2){b.z, b.w} : (u32x2){b.x, b.y}, sb);
#pragma unroll
                    for (int n = 0; n < 2; ++n)
#pragma unroll
                        for (int j = 0; j < 4; ++j) acc[ai][bj][m][n][j] *= sa[4 * n + j] * __builtin_amdgcn_rcpf(fmaxf(sb[4 * n + j], 1e-12f));
                } }
    }
    __device__ __forceinline__ void operator()(AccRef acc, const Unit& u, int wr, int wc, int fr_, int fq_) const {
        int fr = fr_, fq = fq_; asm volatile("" : "+v"(fr), "+v"(fq));
        const int row0 = u.pm * BM + wr * 64 + fr, col0 = u.pn * BM + wc * 64 + 16 * fq;
#pragma unroll
        for (int ai = 0; ai < 2; ++ai)
#pragma unroll
            for (int m = 0; m < 4; ++m) { const size_t ro = (size_t)(row0 + ai * HALF + m * 16) * DM + col0;
                const u32x4 b = *(const u32x4*)(GB + ro); u32x4 w;
#pragma unroll
                for (int bj = 0; bj < 2; ++bj) {
                    float sb[8]; unpack8_fp8(bj ? (u32x2){b.z, b.w} : (u32x2){b.x, b.y}, sb);
                    f32x4 v0 = acc[ai][bj][m][0], v1 = acc[ai][bj][m][1];
                    constexpr float CS = A8I * W8I * A8S;
#pragma unroll
                    for (int j = 0; j < 4; ++j) { v0[j] *= fmaxf(sb[j], 1e-12f) * CS; v1[j] *= fmaxf(sb[4 + j], 1e-12f) * CS; }
                    const unsigned lo = pack4_fp8(v0[0], v0[1], v0[2], v0[3]), hi = pack4_fp8(v1[0], v1[1], v1[2], v1[3]);
                    if (bj == 0) { w.x = lo; w.y = hi; } else { w.z = lo; w.w = hi; } }
                *(u32x4*)((unsigned char*)MG + ro) = w; }
    }
};

struct EpiResidB {
    static constexpr bool PERM = true, MIDK = false;
    const float* Xf; const bf16_t* Xb; bf16_t* O; const float* gate;
    __device__ __forceinline__ void operator()(AccRef acc, const Unit& u, int wr, int wc, int fr_, int fq_) const {
        int fr = fr_, fq = fq_; asm volatile("" : "+v"(fr), "+v"(fq));
        const int row0 = u.pm * BM + wr * 64 + fr, col0 = u.pn * BM + wc * 64 + 16 * fq; const int b = (u.pm * BM) >> 11;
        f32x4 gt[2][2];
#pragma unroll
        for (int bj = 0; bj < 2; ++bj)
#pragma unroll
            for (int n = 0; n < 2; ++n) gt[bj][n] = *(const f32x4*)(gate + (size_t)b * MODW + col0 + 8 * bj + 4 * n) * (A8I * W8I);
#pragma unroll
        for (int ai = 0; ai < 2; ++ai)
#pragma unroll
            for (int m = 0; m < 4; ++m) { const size_t ro = (size_t)(row0 + ai * HALF + m * 16) * DM + col0;
#pragma unroll
                for (int bj = 0; bj < 2; ++bj) {
                    f32x4 x0, x1;
                    if (Xf) { x0 = *(const f32x4*)(Xf + ro + 8 * bj); x1 = *(const f32x4*)(Xf + ro + 8 * bj + 4); }
                    else { const u32x4 w = *(const u32x4*)(Xb + ro + 8 * bj); x0 = (f32x4){bf_lo(w.x), bf_hi(w.x), bf_lo(w.y), bf_hi(w.y)}; x1 = (f32x4){bf_lo(w.z), bf_hi(w.z), bf_lo(w.w), bf_hi(w.w)}; }
                    *(u32x4*)(O + ro + 8 * bj) = pack8(x0 + gt[bj][0] * acc[ai][bj][m][0], x1 + gt[bj][1] * acc[ai][bj][m][1]); } }
    }
};

struct EpiSwiGLU {
    static constexpr bool PERM = true, MIDK = false;
    bf16_t* ACT;
    float cs;
    __device__ __forceinline__ void operator()(AccRef acc, const Unit& u, int wr, int wc, int fr_, int fq_) const {
        int fr = fr_, fq = fq_; asm volatile("" : "+v"(fr), "+v"(fq));
        const int row0 = u.pm * BM + wr * 64 + fr, col0 = (u.pn & 3) * HALF + wc * 32 + 8 * fq;
#pragma unroll
        for (int ai = 0; ai < 2; ++ai)
#pragma unroll
            for (int m = 0; m < 4; ++m) { f32x4 r[2];
#pragma unroll
                for (int n = 0; n < 2; ++n)
#pragma unroll
                    for (int j = 0; j < 4; ++j) { const float gg = acc[ai][0][m][n][j] * cs, uu = acc[ai][1][m][n][j] * (DN_F8 ? cs * A8S : cs); r[n][j] = gg * sigmoid_f(gg) * uu; }
                if (DN_F8) *(u32x2*)((unsigned char*)ACT + (size_t)(row0 + ai * HALF + m * 16) * DFF + col0) = (u32x2){pack4_fp8(r[0][0], r[0][1], r[0][2], r[0][3]), pack4_fp8(r[1][0], r[1][1], r[1][2], r[1][3])};
                else *(u32x4*)(ACT + (size_t)(row0 + ai * HALF + m * 16) * DFF + col0) = pack8(r[0], r[1]); }
    }
};

struct EpiY {
    static constexpr bool PERM = true, MIDK = false;
    unsigned char* Y;
    __device__ __forceinline__ void operator()(AccRef acc, const Unit& u, int wr, int wc, int fr_, int fq_) const {
        int fr = fr_, fq = fq_; asm volatile("" : "+v"(fr), "+v"(fq));
        const int row0 = u.pm * BM + wr * 64 + fr, col0 = (u.pn & 3) * BM + wc * 64 + 16 * fq;
#pragma unroll
        for (int ai = 0; ai < 2; ++ai)
#pragma unroll
            for (int m = 0; m < 4; ++m) { u32x4 w;
                constexpr float CS = DN_F8 ? A8I * W8I : 1.0f;
                { const f32x4 a = acc[ai][0][m][0] * CS, b = acc[ai][0][m][1] * CS; w.x = pack4_fp8(a[0], a[1], a[2], a[3]); w.y = pack4_fp8(b[0], b[1], b[2], b[3]); }
                { const f32x4 a = acc[ai][1][m][0] * CS, b = acc[ai][1][m][1] * CS; w.z = pack4_fp8(a[0], a[1], a[2], a[3]); w.w = pack4_fp8(b[0], b[1], b[2], b[3]); }
                *(u32x4*)(Y + (size_t)(row0 + ai * HALF + m * 16) * DM + col0) = w; }
    }
};
}

__device__ __forceinline__ int dimA(int bj, int r) { return r < 8 ? r + 8 * bj : 16 + (r - 8) + 24 * bj; }
__device__ __forceinline__ int dimB(int bj, int r) { return r < 16 ? r + 16 * bj : 32 + (r - 16) + 16 * bj; }
__device__ __forceinline__ int inproj_srccol(int P) {
    const int pn = P >> 8, p = P & 255, bj = p >> 7, wc = (p >> 5) & 3, r = p & 31;
    if (pn < 2) return 64 * (4 * pn + wc) + dimA(bj, r);
    if (pn < 4) return 512 + 64 * (4 * (pn - 2) + wc) + dimA(bj, r);
    if (pn < 6) return 1024 + 256 * (pn - 4) + 64 * wc + 16 * ((p >> 3) & 3) + 8 * bj + (p & 7);
    if (pn < 8) return 1536 + 64 * (4 * (pn - 6) + wc) + dimB(bj, r);
    if (pn == 8) return wc < 2 ? 2048 + 64 * wc + dimB(bj, r) : 2176 + 64 * (wc - 2) + 16 * ((p >> 3) & 3) + 8 * bj + (p & 7);
    { const int fq = (p >> 3) & 3, r8 = p & 7; return 2304 + 256 * (pn - 9) + 64 * wc + 16 * fq + 8 * bj + r8; }
}

namespace att {
constexpr int KSTR = 80, VSTR = 192;
constexpr int KTILE = 64 * KSTR, VTILE = 64 * VSTR;
constexpr int K_OFF = 0, V_OFF = 2 * KTILE;
constexpr int PRIV_OFF = 0;
__device__ __forceinline__ s16x4 vtr(LAS const char* p) { typedef short v4i16_t __attribute__((ext_vector_type(4)));
    return __builtin_bit_cast(s16x4, __builtin_amdgcn_ds_read_tr16_b64_v4i16((LAS v4i16_t*)p)); }
__device__ __forceinline__ u32x4 fp8x8_to_bf16(u32x2 w) { float f[8]; unpack8_fp8(w, f); u32x4 o; o.x = cvt_pk_bf16(f[0], f[1]); o.y = cvt_pk_bf16(f[2], f[3]); o.z = cvt_pk_bf16(f[4], f[5]); o.w = cvt_pk_bf16(f[6], f[7]); return o; }
__device__ __forceinline__ int clamp_tok(int t) { return t < 0 ? 0 : (t > SEQ - 1 ? SEQ - 1 : t); }

__device__ __forceinline__ long mk64(unsigned lo, unsigned hi) { return (long)(((unsigned long long)hi << 32) | lo); }
__device__ __forceinline__ void qk_tile(f32x16& p0, f32x16& p1, const u32x4 (&kf)[2][2], const u32x4 (&qr)[2]) {
    const f32x16 z = {0.f, 0.f, 0.f, 0.f, 0.f, 0.f, 0.f, 0.f, 0.f, 0.f, 0.f, 0.f, 0.f, 0.f, 0.f, 0.f};
    p0 = __builtin_amdgcn_mfma_f32_32x32x16_fp8_fp8(mk64(kf[0][0].x, kf[0][0].y), mk64(qr[0].x, qr[0].y), z, 0, 0, 0);
    p1 = __builtin_amdgcn_mfma_f32_32x32x16_fp8_fp8(mk64(kf[1][0].x, kf[1][0].y), mk64(qr[0].x, qr[0].y), z, 0, 0, 0);
    p0 = __builtin_amdgcn_mfma_f32_32x32x16_fp8_fp8(mk64(kf[0][0].z, kf[0][0].w), mk64(qr[0].z, qr[0].w), p0, 0, 0, 0);
    p1 = __builtin_amdgcn_mfma_f32_32x32x16_fp8_fp8(mk64(kf[1][0].z, kf[1][0].w), mk64(qr[0].z, qr[0].w), p1, 0, 0, 0);
    p0 = __builtin_amdgcn_mfma_f32_32x32x16_fp8_fp8(mk64(kf[0][1].x, kf[0][1].y), mk64(qr[1].x, qr[1].y), p0, 0, 0, 0);
    p1 = __builtin_amdgcn_mfma_f32_32x32x16_fp8_fp8(mk64(kf[1][1].x, kf[1][1].y), mk64(qr[1].x, qr[1].y), p1, 0, 0, 0);
    p0 = __builtin_amdgcn_mfma_f32_32x32x16_fp8_fp8(mk64(kf[0][1].z, kf[0][1].w), mk64(qr[1].z, qr[1].w), p0, 0, 0, 0);
    p1 = __builtin_amdgcn_mfma_f32_32x32x16_fp8_fp8(mk64(kf[1][1].z, kf[1][1].w), mk64(qr[1].z, qr[1].w), p1, 0, 0, 0);
}
template <bool MASK>
__device__ __forceinline__ void exp_tile(const f32x16& p0, const f32x16& p1, float& lsum, bf16x8 (&pf)[2][2], int mbase, int mR, int dk) {
    float e0[16], e1[16]; float ls = 0.f;
#pragma unroll
    for (int r = 0; r < 16; ++r) {
        e0[r] = __builtin_amdgcn_exp2f(p0[r]); e1[r] = __builtin_amdgcn_exp2f(p1[r]);
        if (MASK) {
            const int c0 = (r & 3) + 8 * (r >> 2);
            e0[r] = ((unsigned)(mbase + dk * c0) <= (unsigned)mR) ? e0[r] : 0.f;
            e1[r] = ((unsigned)(mbase + dk * (c0 + 32)) <= (unsigned)mR) ? e1[r] : 0.f;
        }
        ls += e0[r] + e1[r];
    }
    lsum += ls;
#pragma unroll
    for (int s = 0; s < 2; ++s) {
        u32x4 w0, w1;
        w0.x = cvt_pk_bf16(e0[8 * s + 0], e0[8 * s + 1]); w0.y = cvt_pk_bf16(e0[8 * s + 2], e0[8 * s + 3]); w0.z = cvt_pk_bf16(e0[8 * s + 4], e0[8 * s + 5]); w0.w = cvt_pk_bf16(e0[8 * s + 6], e0[8 * s + 7]);
        w1.x = cvt_pk_bf16(e1[8 * s + 0], e1[8 * s + 1]); w1.y = cvt_pk_bf16(e1[8 * s + 2], e1[8 * s + 3]); w1.z = cvt_pk_bf16(e1[8 * s + 4], e1[8 * s + 5]); w1.w = cvt_pk_bf16(e1[8 * s + 6], e1[8 * s + 7]);
        pf[0][s] = __builtin_bit_cast(bf16x8, w0); pf[1][s] = __builtin_bit_cast(bf16x8, w1);
    }
}
__device__ __forceinline__ void vread(bf16x8 (&vf)[4], LAS const char* vb, int d0) {
#pragma unroll
    for (int blk = 0; blk < 2; ++blk)
#pragma unroll
        for (int s = 0; s < 2; ++s) {
            const s16x4 lo = vtr(vb + (32 * blk + 16 * s) * VSTR + 64 * d0), hi = vtr(vb + (32 * blk + 16 * s + 8) * VSTR + 64 * d0);
            vf[2 * blk + s] = (bf16x8){lo[0], lo[1], lo[2], lo[3], hi[0], hi[1], hi[2], hi[3]};
        }
}
__device__ __forceinline__ void pv_half(f32x16& od, const bf16x8 (&vf)[4], const bf16x8 (&pf)[2][2]) {
#pragma unroll
    for (int blk = 0; blk < 2; ++blk)
#pragma unroll
        for (int s = 0; s < 2; ++s) od = __builtin_amdgcn_mfma_f32_32x32x16_bf16(vf[2 * blk + s], pf[blk][s], od, 0, 0, 0);
}
__device__ __forceinline__ void mask_params(int dk, int tk0, int tq, int hi, int& mbase, int& mR) {
    const int dlo = (-64 * dk > -tq) ? -64 * dk : -tq, dhi = (64 * dk < SEQ - 1 - tq) ? 64 * dk : SEQ - 1 - tq;
    const int dA = tk0 + 4 * dk * hi - tq;
    mR = dhi - dlo; mbase = ((dA & (dk - 1)) == 0) ? dA - dlo : 0x7fffffff;
}

template <bool MASKED>
__device__ __forceinline__ void dense64_loop(LAS char* lds, const unsigned char* Kg, const unsigned char* Vg, int ld  , int tok0, int ntiles,
                                             const u32x4 (&qr)[2][2], f32x16 (&o)[2][2], float (&lsum)[2], int tq0, int tq1, int lane_, int wave) {
    constexpr int V2_OFF = 2 * KTILE;
    u32x2 kreg, vreg;
#define D64_LANE() int ln_ = lane_; asm volatile("" : "+v"(ln_)); const int tid_ = wave * 64 + ln_, srow = tid_ >> 3, sch = tid_ & 7
#define D64_LD(t) do { D64_LANE(); int tk_ = tok0 + 64 * (t) + srow; if (MASKED) tk_ = clamp_tok(tk_); kreg = *(const u32x2*)(Kg + (size_t)tk_ * ld + sch * 8); vreg = *(const u32x2*)(Vg + (size_t)tk_ * ld + sch * 8); } while (0)
#define D64_ST(t) do { D64_LANE(); *(LAS u32x2*)(lds + ((t) & 1) * KTILE + srow * KSTR + sch * 8) = kreg; *(LAS u32x4*)(lds + V2_OFF + ((t) & 1) * VTILE + srow * VSTR + sch * 16) = fp8x8_to_bf16(vreg); } while (0)
    D64_LD(0); D64_ST(0); D64_LD(1);
    for (int t = 0; t < ntiles; ++t) {
        __syncthreads();
        if (t + 1 < ntiles) D64_ST(t + 1);
        if (t + 2 < ntiles) D64_LD(t + 2);
        int lane = lane_; asm volatile("" : "+v"(lane));
        const int hi = lane >> 5;
        const int vlane = (4 * hi + ((lane & 15) >> 2)) * VSTR + (16 * ((lane >> 4) & 1) + 4 * (lane & 3)) * 2;
        const int klane = (lane & 31) * KSTR + 32 * hi;
        u32x4 kf[2][2];
        { LAS const char* kb_ = lds + (t & 1) * KTILE + klane;
#pragma unroll
          for (int blk = 0; blk < 2; ++blk)
#pragma unroll
              for (int e = 0; e < 2; ++e) kf[blk][e] = *(const LAS u32x4*)(kb_ + 32 * blk * KSTR + 16 * e); }
        f32x16 p[2][2];
        bf16x8 vfa[4], vfb[4];
        LAS const char* vb_ = lds + V2_OFF + (t & 1) * VTILE + vlane;
        vread(vfa, vb_, 0); vread(vfb, vb_, 1);
        __builtin_amdgcn_sched_barrier(0);
        qk_tile(p[0][0], p[0][1], kf, qr[0]);
        qk_tile(p[1][0], p[1][1], kf, qr[1]);
#pragma unroll
        for (int g = 0; g < 2; ++g) {
            bf16x8 pf[2][2]; int mb = 0, mr = 0;
            if (MASKED) mask_params(1, tok0 + 64 * t, g ? tq1 : tq0, hi, mb, mr);
            exp_tile<MASKED>(p[g][0], p[g][1], lsum[g], pf, mb, mr, 1);
            pv_half(o[g][0], vfa, pf); pv_half(o[g][1], vfb, pf);
        }
    }
#undef D64_LANE
#undef D64_LD
#undef D64_ST
}
__device__ __forceinline__ void dense64_lag_loop(LAS char* lds, const unsigned char* Kg, const unsigned char* Vg, int ld  , int ntiles,
                                                 const u32x4 (&qr)[2][2], f32x16 (&o)[2][2], float (&lsum)[2], int lane_, int wave, const bool lag) {
    constexpr int V2_OFF = 2 * KTILE;
    u32x2 kreg, vreg;
#define D64_LANE() int ln_ = lane_; asm volatile("" : "+v"(ln_)); const int tid_ = wave * 64 + ln_, srow = tid_ >> 3, sch = tid_ & 7
#define D64_LD(t) do { D64_LANE(); const int tk_ = 64 * (t) + srow; kreg = *(const u32x2*)(Kg + (size_t)tk_ * ld + sch * 8); vreg = *(const u32x2*)(Vg + (size_t)tk_ * ld + sch * 8); } while (0)
#define D64_ST(t) do { D64_LANE(); *(LAS u32x2*)(lds + ((t) & 1) * KTILE + srow * KSTR + sch * 8) = kreg; *(LAS u32x4*)(lds + V2_OFF + ((t) % 3) * VTILE + srow * VSTR + sch * 16) = fp8x8_to_bf16(vreg); } while (0)
#define D64_QK(t) do { int lane = lane_; asm volatile("" : "+v"(lane)); const int klane = (lane & 31) * KSTR + 32 * (lane >> 5); u32x4 kf[2][2]; LAS const char* kb_ = lds + ((t) & 1) * KTILE + klane; \
        _Pragma("unroll") for (int blk = 0; blk < 2; ++blk) _Pragma("unroll") for (int e = 0; e < 2; ++e) kf[blk][e] = *(const LAS u32x4*)(kb_ + 32 * blk * KSTR + 16 * e); \
        qk_tile(p[0][0], p[0][1], kf, qr[0]); qk_tile(p[1][0], p[1][1], kf, qr[1]); } while (0)
#define D64_PV(t) do { int lane = lane_; asm volatile("" : "+v"(lane)); const int hi = lane >> 5; const int vlane = (4 * hi + ((lane & 15) >> 2)) * VSTR + (16 * ((lane >> 4) & 1) + 4 * (lane & 3)) * 2; \
        bf16x8 vfa[4], vfb[4]; LAS const char* vb_ = lds + V2_OFF + ((t) % 3) * VTILE + vlane; vread(vfa, vb_, 0); vread(vfb, vb_, 1); \
        _Pragma("unroll") for (int g = 0; g < 2; ++g) { bf16x8 pf[2][2]; exp_tile<false>(p[g][0], p[g][1], lsum[g], pf, 0, 0, 0); pv_half(o[g][0], vfa, pf); pv_half(o[g][1], vfb, pf); } } while (0)
    f32x16 p[2][2];
    D64_LD(0); D64_ST(0);
    if (!lag) {
        D64_LD(1);
        for (int t = 0; t < ntiles; ++t) {
            __syncthreads();
            if (t + 1 < ntiles) D64_ST(t + 1);
            if (t + 2 < ntiles) D64_LD(t + 2);
            D64_QK(t);
            D64_PV(t);
        }
        __syncthreads();
    } else {
        D64_LD(1);
        __syncthreads();
        D64_ST(1); D64_LD(2);
        D64_QK(0);
        for (int t = 1; t < ntiles; ++t) {
            __syncthreads();
            if (t + 1 < ntiles) D64_ST(t + 1);
            if (t + 2 < ntiles) D64_LD(t + 2);
            D64_PV(t - 1);
            __builtin_amdgcn_sched_barrier(0);
            D64_QK(t);
        }
        __syncthreads();
        D64_PV(ntiles - 1);
    }
#undef D64_LANE
#undef D64_LD
#undef D64_ST
#undef D64_QK
#undef D64_PV
}
__device__ __forceinline__ void priv_kload(u32x4 (&kf)[2][2], const unsigned char* Kg, int ld, int tk0, int dk, int lane_) {
    int lane = lane_; asm volatile("" : "+v"(lane));
    const int hi = lane >> 5;
#pragma unroll
    for (int blk = 0; blk < 2; ++blk) { const int tk = clamp_tok(tk0 + dk * (32 * blk + (lane & 31)));
#pragma unroll
        for (int e = 0; e < 2; ++e) kf[blk][e] = *(const u32x4*)(Kg + (size_t)tk * ld + 32 * hi + 16 * e); }
}
__device__ __forceinline__ void priv2_step(u32x4 (&kf)[2][2], LAS char* vpriv, const unsigned char* Kg, const unsigned char* Vg, int ld, int tk0, int dk, bool g0, bool g1,
                                           bool has_next, int tk0n, int dkn, const u32x4 (&qr)[2][2], f32x16 (&o)[2][2], float (&lsum)[2], int tq0, int tq1, int lane_) {
    int lane = lane_; asm volatile("" : "+v"(lane));
    const int hi = lane >> 5;
    const int vlane = (4 * hi + ((lane & 15) >> 2)) * VSTR + (16 * ((lane >> 4) & 1) + 4 * (lane & 3)) * 2;
    u32x2 vr[8];
#pragma unroll
    for (int i = 0; i < 8; ++i) { const int idx = i * 64 + lane, row = idx >> 3, ch = idx & 7; const int tk = clamp_tok(tk0 + dk * row); vr[i] = *(const u32x2*)(Vg + (size_t)tk * ld + ch * 8); }
    const int gfirst = g0 ? 0 : 1, glast = g1 ? 1 : 0;
    f32x16 p0, p1; bf16x8 pf[2][2]; int mb, mr;
    if (gfirst == 0) qk_tile(p0, p1, kf, qr[0]); else qk_tile(p0, p1, kf, qr[1]);
    __builtin_amdgcn_sched_barrier(0);
#pragma unroll
    for (int i = 0; i < 8; ++i) { const int idx = i * 64 + lane; *(LAS u32x4*)(vpriv + (idx >> 3) * VSTR + (idx & 7) * 16) = fp8x8_to_bf16(vr[i]); }
    if (glast == gfirst) { __builtin_amdgcn_sched_barrier(0); if (has_next) priv_kload(kf, Kg, ld, tk0n, dkn, lane); __builtin_amdgcn_sched_barrier(0); }
    mask_params(dk, tk0, gfirst ? tq1 : tq0, hi, mb, mr);
    if (gfirst == 0) exp_tile<true>(p0, p1, lsum[0], pf, mb, mr, dk); else exp_tile<true>(p0, p1, lsum[1], pf, mb, mr, dk);
    { bf16x8 vfa[4], vfb[4]; vread(vfa, vpriv + vlane, 0); vread(vfb, vpriv + vlane, 1);
      if (gfirst == 0) { pv_half(o[0][0], vfa, pf); pv_half(o[0][1], vfb, pf); } else { pv_half(o[1][0], vfa, pf); pv_half(o[1][1], vfb, pf); } }
    if (glast != gfirst) {
        qk_tile(p0, p1, kf, qr[1]);
        __builtin_amdgcn_sched_barrier(0);
        if (has_next) priv_kload(kf, Kg, ld, tk0n, dkn, lane);
        __builtin_amdgcn_sched_barrier(0);
        mask_params(dk, tk0, tq1, hi, mb, mr);
        exp_tile<true>(p0, p1, lsum[1], pf, mb, mr, dk);
        bf16x8 vfa[4], vfb[4]; vread(vfa, vpriv + vlane, 0); vread(vfb, vpriv + vlane, 1);
        pv_half(o[1][0], vfa, pf); pv_half(o[1][1], vfb, pf);
    }
}
__device__ __forceinline__ void store_out(const f32x16 (&o)[2], float lsum, unsigned char* dst  , int lane_) {
    int lane = lane_; asm volatile("" : "+v"(lane));
    const int hi = lane >> 5;
    float l = lsum + shx(lsum, 32, lane);
    const float inv = A8S / l;
#pragma unroll
    for (int d0 = 0; d0 < 2; ++d0) {
        unsigned pc[4];
#pragma unroll
        for (int g = 0; g < 4; ++g) pc[g] = pack4_fp8(o[d0][4 * g] * inv, o[d0][4 * g + 1] * inv, o[d0][4 * g + 2] * inv, o[d0][4 * g + 3] * inv);
        const auto s0 = __builtin_amdgcn_permlane32_swap(pc[0], pc[2], false, false), s1 = __builtin_amdgcn_permlane32_swap(pc[1], pc[3], false, false);
        u32x4 w; w.x = s0[0]; w.y = s0[1]; w.z = s1[0]; w.w = s1[1];
        *(u32x4*)(dst + 32 * d0 + 16 * hi) = w;
    }
}
}

struct Args { const float* in[18]; float* out; unsigned char* ws; int ph_lo, ph_hi; };
constexpr int PH_PRO = 0, PH_L0 = 1, PH_PER_LAYER = 9, PH_FINAL = PH_L0 + 2 * PH_PER_LAYER, NPH = PH_FINAL + 1;
enum { P_NORM1 = 0, P_INPROJ, P_ATTN, P_PAB, P_OUT, P_NORM2, P_PLACE, P_GU, P_DOWN };

__device__ __forceinline__ int tile256_srccol(int P) { const int p = P & 255; return (P & ~255) + 64 * ((p >> 5) & 3) + 16 * ((p >> 3) & 3) + 8 * (p >> 7) + (p & 7); }
template <int MAP, bool W8 = false>
__device__ __forceinline__ void transpose_item(const float* W, int N, int col0, bf16_t* dst, int dst_row0, int K, int k0, LAS float* scr, int lane, int dk0 = 0  ) {
    const int sc = (MAP == 1) ? inproj_srccol(col0 + lane) : (MAP == 2) ? tile256_srccol(col0 + lane) : col0 + lane;
    const float* src = W + (size_t)k0 * N + sc;
#pragma unroll 16
    for (int i = 0; i < 64; ++i) scr[i * 65 + lane] = src[(size_t)i * N];
    asm volatile("s_waitcnt lgkmcnt(0)" ::: "memory");
    const int c = lane & 7, nn = lane >> 3;
#pragma unroll
    for (int j = 0; j < 8; ++j) { const int n = nn + 8 * j; const LAS float* s = scr + (8 * c) * 65 + n;
        if (W8) { u32x2 w; w.x = pack4_fp8(s[0] * W8S, s[65] * W8S, s[2 * 65] * W8S, s[3 * 65] * W8S); w.y = pack4_fp8(s[4 * 65] * W8S, s[5 * 65] * W8S, s[6 * 65] * W8S, s[7 * 65] * W8S);
            *(u32x2*)((unsigned char*)dst + (size_t)(dst_row0 + n) * K + dk0 + k0 + 8 * c) = w; continue; }
        u32x4 w; w.x = cvt_pk_bf16(s[0], s[65]); w.y = cvt_pk_bf16(s[2 * 65], s[3 * 65]); w.z = cvt_pk_bf16(s[4 * 65], s[5 * 65]); w.w = cvt_pk_bf16(s[6 * 65], s[7 * 65]);
        *(u32x4*)(dst + (size_t)(dst_row0 + n) * K + dk0 + k0 + 8 * c) = w; }
    asm volatile("s_waitcnt lgkmcnt(0)" ::: "memory");
}


template <bool XF32, bool COMBINE, bool NORM, bool ROUTER, bool OUTF32, int H8 = 0  >
__device__ __forceinline__ void row_phase(LAS unsigned char* lds, int tid, int lane, int wave, int G, int bx, const float* xf, bf16_t* xb, float* outf, const float* gv,
                                          const float* modl, int sh_off, int sc_off, const float* modprev, bf16_t* Hh, const unsigned char* Ym, const int* Pos, float* Tw,
                                          const bf16_t* Wr, int* Te, int* Trk, int* Cnt, unsigned char* H8p = nullptr) {
    constexpr int RB = COMBINE ? 2 : ROWB;
    LAS float* lgs = (LAS float*)lds;
    LAS int* lcnt = (LAS int*)(lds + 40960);
    asm volatile("" : "+v"(tid), "+v"(lane));
    for (int chunk = bx; chunk < 256; chunk += G) {
        const int b = chunk >> 3;
        if (ROUTER) { if (tid < 32) lcnt[tid] = 0; }
        f32x4 pre[4], shv[4], g2[4];
#pragma unroll
        for (int j = 0; j < 4; ++j) { const int col = 512 * (j >> 1) + 8 * lane + 4 * (j & 1);
            if (NORM) { const f32x4 gg = *(const f32x4*)(gv + col), sc = *(const f32x4*)(modl + (size_t)b * MODW + sc_off + col);
                pre[j] = gg * (1.0f + sc); shv[j] = *(const f32x4*)(modl + (size_t)b * MODW + sh_off + col); }
            if (COMBINE) g2[j] = *(const f32x4*)(modprev + (size_t)b * MODW + 5 * DM + col); }
        f32x4 rawf[XF32 ? RB : 1][4]; u32x4 rawb[XF32 ? 1 : RB][2]; int pp[COMBINE ? RB : 1][2]; float pw[COMBINE ? RB : 1][2];
#define ROW_LOAD(rb_) do { _Pragma("unroll") for (int i = 0; i < RB; ++i) { const size_t ro = (size_t)((rb_) + i) * DM; \
            if (XF32) { _Pragma("unroll") for (int j = 0; j < 4; ++j) rawf[XF32 ? i : 0][j] = *(const f32x4*)(xf + ro + 512 * (j >> 1) + 8 * lane + 4 * (j & 1)); } \
            else { _Pragma("unroll") for (int h = 0; h < 2; ++h) rawb[XF32 ? 0 : i][h] = *(const u32x4*)(xb + ro + 512 * h + 8 * lane); } \
            if (COMBINE) { pp[COMBINE ? i : 0][0] = Pos[2 * ((rb_) + i)]; pp[COMBINE ? i : 0][1] = Pos[2 * ((rb_) + i) + 1]; pw[COMBINE ? i : 0][0] = Tw[2 * ((rb_) + i)]; pw[COMBINE ? i : 0][1] = Tw[2 * ((rb_) + i) + 1]; } } } while (0)
        ROW_LOAD(chunk * 256 + wave * 32);
#pragma unroll 1
        for (int r0 = 0; r0 < 32; r0 += RB) {
            const int rowb = chunk * 256 + wave * 32 + r0;
            f32x4 v[RB][4]; int cp[COMBINE ? RB : 1][2]; float cw[COMBINE ? RB : 1][2];
#pragma unroll
            for (int i = 0; i < RB; ++i) {
                if (XF32) {
#pragma unroll
                    for (int j = 0; j < 4; ++j) v[i][j] = rawf[XF32 ? i : 0][j];
                } else {
#pragma unroll
                    for (int h = 0; h < 2; ++h) { const u32x4 w = rawb[XF32 ? 0 : i][h];
                        v[i][2 * h] = (f32x4){bf_lo(w.x), bf_hi(w.x), bf_lo(w.y), bf_hi(w.y)}; v[i][2 * h + 1] = (f32x4){bf_lo(w.z), bf_hi(w.z), bf_lo(w.w), bf_hi(w.w)}; }
                }
                if (COMBINE) { cp[i][0] = pp[i][0]; cp[i][1] = pp[i][1]; cw[i][0] = pw[i][0]; cw[i][1] = pw[i][1]; }
            }
            u32x2 ya[COMBINE ? RB : 1][2], yc[COMBINE ? RB : 1][2];
            if (COMBINE) {
#pragma unroll
                for (int i = 0; i < RB; ++i)
#pragma unroll
                    for (int h = 0; h < 2; ++h) { ya[i][h] = *(const u32x2*)(Ym + (size_t)cp[i][0] * DM + 512 * h + 8 * lane); yc[i][h] = *(const u32x2*)(Ym + (size_t)cp[i][1] * DM + 512 * h + 8 * lane); }
            }
            if (r0 + RB < 32) ROW_LOAD(rowb + RB);
            if (COMBINE) {
#pragma unroll
                for (int i = 0; i < RB; ++i) {
                    const int row = rowb + i; const float w0 = cw[i][0], w1 = cw[i][1];
#pragma unroll
                    for (int h = 0; h < 2; ++h) { float fa[8], fc[8]; unpack8_fp8(ya[i][h], fa); unpack8_fp8(yc[i][h], fc);
                        const f32x4 m0 = {w0 * fa[0] + w1 * fc[0], w0 * fa[1] + w1 * fc[1], w0 * fa[2] + w1 * fc[2], w0 * fa[3] + w1 * fc[3]};
                        const f32x4 m1 = {w0 * fa[4] + w1 * fc[4], w0 * fa[5] + w1 * fc[5], w0 * fa[6] + w1 * fc[6], w0 * fa[7] + w1 * fc[7]};
                        v[i][2 * h] = v[i][2 * h] + g2[2 * h] * m0; v[i][2 * h + 1] = v[i][2 * h + 1] + g2[2 * h + 1] * m1;
                        if (OUTF32) { *(f32x4*)(outf + (size_t)row * DM + 512 * h + 8 * lane) = v[i][2 * h]; *(f32x4*)(outf + (size_t)row * DM + 512 * h + 8 * lane + 4) = v[i][2 * h + 1]; }
                        else *(u32x4*)(xb + (size_t)row * DM + 512 * h + 8 * lane) = pg8::pack8(v[i][2 * h], v[i][2 * h + 1]); }
                }
            }
            if (NORM) {
                float ss[RB];
#pragma unroll
                for (int i = 0; i < RB; ++i) { ss[i] = 0.f;
#pragma unroll
                    for (int j = 0; j < 4; ++j) { const f32x4 q = v[i][j] * v[i][j]; ss[i] += (q[0] + q[1]) + (q[2] + q[3]); } }
#pragma unroll
                for (int o = 1; o < 64; o <<= 1)
#pragma unroll
                    for (int i = 0; i < RB; ++i) ss[i] += shx(ss[i], o, lane);
#pragma unroll
                for (int i = 0; i < RB; ++i) { const float rstd = __builtin_amdgcn_rsqf(ss[i] * (1.0f / DM) + 1e-6f);
#pragma unroll
                    for (int h = 0; h < 2; ++h) { const f32x4 h0 = v[i][2 * h] * rstd * pre[2 * h] + shv[2 * h], h1 = v[i][2 * h + 1] * rstd * pre[2 * h + 1] + shv[2 * h + 1];
                        if (H8 != 0) *(u32x2*)((H8 == 2 ? H8p : (unsigned char*)Hh) + (size_t)(rowb + i) * DM + 512 * h + 8 * lane) = (u32x2){pack4_fp8(h0[0], h0[1], h0[2], h0[3]), pack4_fp8(h1[0], h1[1], h1[2], h1[3])};
                        if (H8 != 1) *(u32x4*)(Hh + (size_t)(rowb + i) * DM + 512 * h + 8 * lane) = pg8::pack8(h0, h1); } }
            }
        }
#undef ROW_LOAD
        if (ROUTER) {
            __syncthreads();
            const int row0 = chunk * 256 + wave * 32;
            f32x4 ra[2][2];
#pragma unroll
            for (int mt = 0; mt < 2; ++mt)
#pragma unroll
                for (int et = 0; et < 2; ++et) ra[mt][et] = (f32x4){0.f, 0.f, 0.f, 0.f};
#pragma unroll 4
            for (int kk = 0; kk < 32; ++kk) {
                bf16x8 a[2], bb[2];
#pragma unroll
                for (int mt = 0; mt < 2; ++mt) a[mt] = *(const bf16x8*)(Hh + (size_t)(row0 + 16 * mt + (lane & 15)) * DM + 32 * kk + 8 * (lane >> 4));
#pragma unroll
                for (int et = 0; et < 2; ++et) bb[et] = *(const bf16x8*)(Wr + (size_t)(16 * et + (lane & 15)) * DM + 32 * kk + 8 * (lane >> 4));
#pragma unroll
                for (int mt = 0; mt < 2; ++mt)
#pragma unroll
                    for (int et = 0; et < 2; ++et) ra[mt][et] = __builtin_amdgcn_mfma_f32_16x16x32_bf16(a[mt], bb[et], ra[mt][et], 0, 0, 0);
            }
#pragma unroll
            for (int mt = 0; mt < 2; ++mt)
#pragma unroll
                for (int et = 0; et < 2; ++et)
#pragma unroll
                    for (int r = 0; r < 4; ++r) lgs[(wave * 32 + 16 * mt + 4 * (lane >> 4) + r) * 33 + 16 * et + (lane & 15)] = ra[mt][et][r];
            asm volatile("s_waitcnt lgkmcnt(0)" ::: "memory");
            if (lane < 32) {
                const int tl = wave * 32 + lane, tok = chunk * 256 + tl;
                float lg[32]; float M = -3.0e38f;
#pragma unroll
                for (int e = 0; e < 32; ++e) { lg[e] = lgs[tl * 33 + e]; M = fmaxf(M, lg[e]); }
                float bm1 = 0.f, bm2 = 0.f, bsc = -1.f; int bi1 = 0, bi2 = 0, bg = 0;
#pragma unroll
                for (int g = 0; g < 4; ++g) {
                    float m1 = -3.0e38f, m2 = -3.0e38f; int i1 = 0, i2 = 0;
#pragma unroll
                    for (int j = 0; j < 8; ++j) { const float vv = lg[8 * g + j];
                        if (vv > m1) { m2 = m1; i2 = i1; m1 = vv; i1 = j; } else if (vv > m2) { m2 = vv; i2 = j; } }
                    const float sc = expf(m1 - M) + expf(m2 - M);
                    if (sc > bsc) { bsc = sc; bg = g; bm1 = m1; bm2 = m2; bi1 = i1; bi2 = i2; }
                }
                const int e0 = 8 * bg + bi1, e1 = 8 * bg + bi2;
                const float w0 = 1.0f / (1.0f + expf(bm2 - bm1)), w1 = 1.0f - w0;
                const int r0 = __hip_atomic_fetch_add(&lcnt[e0], 1, __ATOMIC_RELAXED, __HIP_MEMORY_SCOPE_WORKGROUP);
                const int r1 = __hip_atomic_fetch_add(&lcnt[e1], 1, __ATOMIC_RELAXED, __HIP_MEMORY_SCOPE_WORKGROUP);
                Te[2 * tok] = e0; Te[2 * tok + 1] = e1; Trk[2 * tok] = r0; Trk[2 * tok + 1] = r1; Tw[2 * tok] = w0; Tw[2 * tok + 1] = w1;
            }
            __syncthreads();
            if (tid < 32) Cnt[chunk * 32 + tid] = lcnt[tid];
            __syncthreads();
        }
    }
}

#define x_in ((const float*)(const GAS float*)args.in[0])
#define c_in ((const float*)(const GAS float*)args.in[1])
#define w_ada ((const float*)(const GAS float*)args.in[2])
#define b_ada ((const float*)(const GAS float*)args.in[3])
#define g_mix ((const float*)(const GAS float*)args.in[4])
#define w_in ((const float*)(const GAS float*)args.in[5])
#define qn_a ((const float*)(const GAS float*)args.in[6])
#define kn_a ((const float*)(const GAS float*)args.in[7])
#define qn_b ((const float*)(const GAS float*)args.in[8])
#define kn_b ((const float*)(const GAS float*)args.in[9])
#define w_pa ((const float*)(const GAS float*)args.in[10])
#define w_pb ((const float*)(const GAS float*)args.in[11])
#define w_out ((const float*)(const GAS float*)args.in[12])
#define g_ffn ((const float*)(const GAS float*)args.in[13])
#define w_router ((const float*)(const GAS float*)args.in[14])
#define w_gate ((const float*)(const GAS float*)args.in[15])
#define w_up ((const float*)(const GAS float*)args.in[16])
#define w_down ((const float*)(const GAS float*)args.in[17])
#define MOD ((float*)(GAS float*)(ws + WS_MOD))
#define XB ((bf16_t*)(GAS bf16_t*)(ws + WS_XB))
#define TE ((int*)(GAS int*)(ws + WS_TE))
#define TRK ((int*)(GAS int*)(ws + WS_TRK))
#define TW ((float*)(GAS float*)(ws + WS_TW))
#define POS ((int*)(GAS int*)(ws + WS_POS))
#define CNT ((int*)(GAS int*)(ws + WS_CNT))
#define BLKE ((int*)(GAS int*)(ws + WS_BLKE))
#define BTOK ((int*)(GAS int*)(ws + WS_BTOK))
#define WR ((bf16_t*)(bf16_t*)(GAS bf16_t*)(ws + WS_WR))
#define H ((bf16_t*)(bf16_t*)(GAS bf16_t*)(ws + WS_H))
#define YAB ((bf16_t*)(GAS bf16_t*)(ws + WS_H))
#define YA ((bf16_t*)(bf16_t*)(GAS bf16_t*)(ws + WS_H))
#define YB ((bf16_t*)(bf16_t*)(GAS bf16_t*)(ws + WS_H + 64 * MiB))
#define QA ((bf16_t*)(bf16_t*)(GAS bf16_t*)(ws + WS_QKV))
#define KA ((bf16_t*)(bf16_t*)(GAS bf16_t*)(ws + WS_QKV + 64 * MiB))
#define VA ((bf16_t*)(bf16_t*)(GAS bf16_t*)(ws + WS_QKV + 128 * MiB))
#define QB ((bf16_t*)(bf16_t*)(GAS bf16_t*)(ws + WS_QKV + 192 * MiB))
#define KB ((bf16_t*)(bf16_t*)(GAS bf16_t*)(ws + WS_QKV + 256 * MiB))
#define VB ((bf16_t*)(bf16_t*)(GAS bf16_t*)(ws + WS_QKV + 272 * MiB))
#define MERGED ((bf16_t*)(bf16_t*)(GAS bf16_t*)(ws + WS_QKV))
#define YM ((unsigned char*)(GAS unsigned char*)(ws + WS_QKV))
#define H2F8 ((unsigned char*)(GAS unsigned char*)(ws + WS_QKV + 160 * MiB))
#define SA ((bf16_t*)(bf16_t*)(GAS bf16_t*)(ws + WS_GATE))
#define SB ((bf16_t*)(bf16_t*)(GAS bf16_t*)(ws + WS_GATE + 128 * MiB))
#define ACT ((bf16_t*)(bf16_t*)(GAS bf16_t*)(ws + WS_GATE))
#define PHASE_ENTER() int lane; asm volatile("v_mbcnt_lo_u32_b32 %0, -1, 0\n\tv_mbcnt_hi_u32_b32 %0, -1, %0" : "=v"(lane)); const int tid = wave * 64 + lane; GAS unsigned char* ws = ws0; int bx = bx0, vcu = vcu0; asm volatile("" : "+s"(ws), "+s"(bx), "+s"(vcu))

__device__ __forceinline__ bool in_phase(int lo, int hi, int k) { asm volatile("" : "+s"(lo), "+s"(hi)); return lo <= k && k < hi; }
#define PGATE_A SA
#define PGATE_B SB
__global__ void __launch_bounds__(512, 2) fwd_kernel(Args args) {
    extern __shared__ __attribute__((aligned(16))) unsigned char lds_raw[];
    LAS unsigned char* lds = (LAS unsigned char*)lds_raw;
    volatile LAS unsigned* MISC = (volatile LAS unsigned*)(lds + MISC_OFF);
    const int tid0 = threadIdx.x, lane0 = tid0 & 63, wave = __builtin_amdgcn_readfirstlane(tid0 >> 6);
    const int G = gridDim.x, bx0 = blockIdx.x;
    const int vcu0 = (G % 8 == 0) ? (bx0 % 8) * (G / 8) + bx0 / 8 : bx0;
    GAS unsigned char* ws0 = (GAS unsigned char*)args.ws;
    float* out = (float*)(GAS float*)args.out;
    for (int u = tid0; u < 256; u += 512) ((LAS unsigned*)(lds + MISC_OFF))[u] = 0u;
    __syncthreads();
#if MK_ONE_LAUNCH
    XcdBarrier bar = xcd_barrier_post((unsigned*)((GAS unsigned*)(ws0 + WS_CTL) + CW_BAR), MISC + 8);
#define GRID_BAR() do { int l_; asm volatile("v_mbcnt_lo_u32_b32 %0, -1, 0\n\tv_mbcnt_hi_u32_b32 %0, -1, %0" : "=v"(l_)); xcd_barrier(bar, (wave == 0) && (l_ == 0)); } while (0)
#else
#define GRID_BAR() do {} while (0)
#endif
#ifndef PHMASK
#define PHMASK 0xFFFFFFFFu
#endif
#if MK_ONE_LAUNCH
#define IN(k) true
#else
#define IN(k) in_phase(args.ph_lo, args.ph_hi, (k))
#endif
#define EN(bit) ((PHMASK >> (bit)) & 1u)
#define SEAM(k) do { if (IN(k) && IN((k) + 1)) GRID_BAR(); } while (0)

    if (EN(0) && IN(PH_PRO)) {
        PHASE_ENTER();
#pragma unroll 1
        for (int rep = 0; rep < REP_PRO; ++rep) {
        LAS float* scr = (LAS float*)(lds + wave * 16640);
        const int gw = vcu * 8 + wave, NGW = G * 8;
        constexpr int I_IN = 68 * 8, I_PA = 16 * 4, I_OUT = 16 * 8, I_GU = 32 * 2 * 8 * 8, I_DN = 32 * 16 * 4;
        constexpr int I_LAYER = I_IN + 2 * I_PA + I_OUT + I_GU + I_DN;
        auto decode = [&](int it, const float*& src, int& N, unsigned char*& dst, int& K, int& t256  ) {
            t256 = -1;
            const int l = it / I_LAYER; int r = it % I_LAYER;
            if (r < I_IN) { const int nb = r / 8, kb = r % 8; N = NC; K = DM;
                src = w_in + (size_t)l * DM * NC + (size_t)(128 * kb) * NC + inproj_srccol(64 * nb + lane);
                dst = (unsigned char*)(GAS unsigned char*)(ws + WS_WIN + l * WIN_BYTES) + (size_t)(64 * nb) * DM + 128 * kb; return; } r -= I_IN;
            if (r < 2 * I_PA) { const int pb_ = r / I_PA, q = r % I_PA, nb = q / 4, kb = q % 4; N = DM; K = DM;
                src = (pb_ ? w_pb : w_pa) + (size_t)l * 512 * DM + (size_t)(128 * kb) * DM + 64 * nb + lane; t256 = nb;
                dst = (unsigned char*)(GAS unsigned char*)(ws + WS_WPA + l * 2 * MiB) + 512 * pb_ + 128 * kb; return; } r -= 2 * I_PA;
            if (r < I_OUT) { const int nb = r / 8, kb = r % 8; N = DM; K = DM;
                src = w_out + (size_t)l * DM * DM + (size_t)(128 * kb) * DM + 64 * nb + lane; t256 = nb;
                dst = (unsigned char*)(GAS unsigned char*)(ws + WS_WOUT + l * 2 * MiB) + 128 * kb; return; } r -= I_OUT;
            if (r < I_GU) { const int e = r / 128, q = r % 128, up = q / 64, nb = (q % 64) / 8, kb = q % 8; N = DFF; K = DM;
                const int c0 = 64 * nb, drow = 256 * (c0 >> 7) + 128 * up + (c0 & 127);
                src = (up ? w_up : w_gate) + ((size_t)l * NEXP + e) * DM * DFF + (size_t)(128 * kb) * DFF + c0 + lane;
                dst = (unsigned char*)(GAS unsigned char*)(ws + WS_WGU + ((size_t)l * NEXP + e) * MiB) + (size_t)drow * DM + 128 * kb; return; } r -= I_GU;
            { const int e = r / 64, q = r % 64, nb = q / 4, kb = q % 4; N = DM; K = DFF;
                src = w_down + ((size_t)l * NEXP + e) * DFF * DM + (size_t)(128 * kb) * DM + 64 * nb + lane; t256 = nb;
                dst = (unsigned char*)(GAS unsigned char*)(ws + WS_WDN + ((size_t)l * NEXP + e) * (MiB / 2)) + 128 * kb; }
        };
        {
            LAS unsigned char* scr8 = (LAS unsigned char*)scr;
#pragma unroll 1
            for (int it = gw; it < 2 * I_LAYER; it += NGW) {
                const float* src; int N, K, t256; unsigned char* dst;
                decode(it, src, N, dst, K, t256);
                float v[128];
#pragma unroll
                for (int i = 0; i < 128; ++i) v[i] = src[(size_t)i * N];
#pragma unroll
                for (int q = 0; q < 8; ++q) { u32x4 w;
                    w.x = pack4_fp8(v[16 * q + 0] * W8S, v[16 * q + 1] * W8S, v[16 * q + 2] * W8S, v[16 * q + 3] * W8S); w.y = pack4_fp8(v[16 * q + 4] * W8S, v[16 * q + 5] * W8S, v[16 * q + 6] * W8S, v[16 * q + 7] * W8S);
                    w.z = pack4_fp8(v[16 * q + 8] * W8S, v[16 * q + 9] * W8S, v[16 * q + 10] * W8S, v[16 * q + 11] * W8S); w.w = pack4_fp8(v[16 * q + 12] * W8S, v[16 * q + 13] * W8S, v[16 * q + 14] * W8S, v[16 * q + 15] * W8S);
                    *(LAS u32x4*)(scr8 + lane * 144 + 16 * q) = w; }
                asm volatile("s_waitcnt lgkmcnt(0)" ::: "memory");
#pragma unroll
                for (int j = 0; j < 8; ++j) { const int r_ = 8 * j + (lane >> 3), c = lane & 7;
                    const u32x4 w = *(const LAS u32x4*)(scr8 + r_ * 144 + 16 * c);
                    const int drow = (t256 < 0) ? r_ : 256 * (t256 >> 2) + 128 * (j & 1) + 32 * (t256 & 3) + 8 * (j >> 1) + (lane >> 3);
                    *(u32x4*)(dst + (size_t)drow * K + 16 * c) = w; }
                asm volatile("s_waitcnt lgkmcnt(0)" ::: "memory");
            }
        }
        for (int i = (vcu * 512 + tid); i < 32 * DM; i += G * 512) { const int e = i >> 10, k = i & 1023; WR[i] = (bf16_t)(cvt_pk_bf16(w_router[(size_t)k * NEXP + e], 0.f) & 0xffffu); }
        __syncthreads();
        if (vcu < 192) {
            LAS float* cond = (LAS float*)lds;
            for (int i = tid; i < NB * DM; i += 512) { const int b = i >> 10, k = i & 1023; const float cv = c_in[i]; cond[k * 32 + b] = cv / (1.0f + expf(-cv)); }
            __syncthreads();
            const int T = 2 * vcu + (wave >> 2), kq = wave & 3;
            const int l = T / 192, n0 = (T % 192) * 32;
            const float* wp = w_ada + (size_t)l * DM * MODW + n0 + (lane & 31) + (size_t)(256 * kq + (lane >> 5)) * MODW;
            const LAS float* cp = cond + (256 * kq + (lane >> 5)) * 32 + (lane & 31);
            f32x16 acc;
#pragma unroll
            for (int r = 0; r < 16; ++r) acc[r] = 0.f;
#pragma unroll 16
            for (int k0 = 0; k0 < 256; k0 += 2) acc = __builtin_amdgcn_mfma_f32_32x32x2f32(cp[k0 * 32], wp[(size_t)k0 * MODW], acc, 0, 0, 0);
            __syncthreads();
            LAS float* part = (LAS float*)lds + wave * 1024;
#pragma unroll
            for (int r = 0; r < 16; ++r) part[r * 64 + lane] = acc[r];
            __syncthreads();
            if (kq == 0) {
                const float bias = b_ada[l * MODW + n0 + (lane & 31)];
#pragma unroll
                for (int r = 0; r < 16; ++r) { const int b = (r & 3) + 8 * (r >> 2) + 4 * (lane >> 5);
                    MOD[((size_t)l * NB + b) * MODW + n0 + (lane & 31)] = ((part[r * 64 + lane] + part[1024 + r * 64 + lane]) + (part[2048 + r * 64 + lane] + part[3072 + r * 64 + lane])) + bias; }
            }
        }
        __syncthreads();
        }
    }
    SEAM(PH_PRO);

    for (int l = 0; l < 2; ++l) {
        const int pb = PH_L0 + l * PH_PER_LAYER;
        if (EN(1) && IN(pb + P_NORM1)) { PHASE_ENTER(); const float* modl = MOD + (size_t)l * NB * MODW;
            if (l == 0) {
#pragma unroll 1
                for (int rep = 0; rep < REP_NORM1; ++rep)
                    row_phase<true, false, true, false, false, 1>(lds, tid, lane, wave, G, bx, x_in, XB, out, g_mix, modl, 0, DM, MOD, H, YM, POS, TW, WR, TE, TRK, CNT);
            } else row_phase<false, true, true, false, false, 1>(lds, tid, lane, wave, G, bx, x_in, XB, out, g_mix + DM, modl, 0, DM, MOD, H, YM, POS, TW, WR, TE, TRK, CNT); }
            {
                SEAM(pb + P_NORM1);
                if (EN(2) && IN(pb + P_INPROJ)) {
                    PHASE_ENTER();
                    pg8::Gemm g{H, (const bf16_t*)(const GAS bf16_t*)(ws + WS_WIN + l * WIN_BYTES), DM / 2}; pg8::StaticOrder S; S.init(TT, NC, G, bx); S.wgm = INPROJ_WGM;
                    LAS float* normw = (LAS float*)(lds + MISC_OFF + 1024);
                    if (tid < 256) { const int sel = tid >> 6, d = tid & 63; const float* srcw = (sel == 0) ? qn_a : (sel == 1) ? kn_a : (sel == 2) ? qn_b : kn_b; normw[tid] = srcw[l * 64 + d]; }
                    __syncthreads();
                    pg8::EpiInProj E{QA, KA, VA, QB, KB, VB, SA, SB, normw};
#pragma unroll 1
                    for (int rep = 0; rep < REP_INPROJ; ++rep)
                    pg8::gemm_phase<pg8::EpiInProj, pg8::StaticOrder, true>(lds, g, S, E, wave);
                }
                SEAM(pb + P_INPROJ);
                if (EN(3) && IN(pb + P_ATTN)) {
                    PHASE_ENTER(); (void)lane;
                    LAS char* ring = (LAS char*)lds;
#pragma unroll 1
                    for (int rep = 0; rep < REP_ATTB; ++rep)
                    for (int L = vcu; L < NB * 32; L += G) {
                        int lane; asm volatile("v_mbcnt_lo_u32_b32 %0, -1, 0\n\tv_mbcnt_hi_u32_b32 %0, -1, %0" : "=v"(lane)); const int hi = lane >> 5;
                        const int b = L >> 5, kvh = (L >> 4) & 1, qh = 4 * kvh + ((L >> 2) & 3), qb2 = L & 3;
                        const int tq0 = 512 * qb2 + 64 * wave + (lane & 31);
                        u32x4 qr[2][2];
#pragma unroll
                        for (int g = 0; g < 2; ++g)
#pragma unroll
                            for (int e = 0; e < 2; ++e) qr[g][e] = *(const u32x4*)((const unsigned char*)QB + ((size_t)b * SEQ + tq0 + 32 * g) * 512 + qh * 64 + 32 * hi + 16 * e);
                        f32x16 o[2][2]; float lsum[2] = {0.f, 0.f};
#pragma unroll
                        for (int r = 0; r < 16; ++r) { o[0][0][r] = 0.f; o[0][1][r] = 0.f; o[1][0][r] = 0.f; o[1][1][r] = 0.f; }
                        __syncthreads();
                        att::dense64_lag_loop(ring, (const unsigned char*)KB + (size_t)b * SEQ * 128 + kvh * 64, (const unsigned char*)VB + (size_t)b * SEQ * 128 + kvh * 64, 128, 32, qr, o, lsum, lane, wave, wave >= 4);
                        { int l2; asm volatile("v_mbcnt_lo_u32_b32 %0, -1, 0\n\tv_mbcnt_hi_u32_b32 %0, -1, %0" : "=v"(l2)); const int tqs = 512 * qb2 + 64 * wave + (l2 & 31);
#pragma unroll
                          for (int g = 0; g < 2; ++g) att::store_out(o[g], lsum[g], (unsigned char*)YAB + ((size_t)b * SEQ + tqs + 32 * g) * DM + 512 + qh * 64, l2); }
                    }
#pragma unroll 1
                    for (int rep = 0; rep < REP_ATTA; ++rep)
                    for (int L = vcu; L < NB * 32; L += G) {
                        int lane; asm volatile("v_mbcnt_lo_u32_b32 %0, -1, 0\n\tv_mbcnt_hi_u32_b32 %0, -1, %0" : "=v"(lane)); const int hi = lane >> 5;
                        const int b = L >> 5, h = (L >> 2) & 7, tb2 = L & 3, base = 512 * tb2;
                        const int tq0 = base + 16 * (lane & 31) + wave, tq1 = tq0 + 8;
                        const unsigned char* Kg = (const unsigned char*)KA + (size_t)b * SEQ * 512 + h * 64; const unsigned char* Vg = (const unsigned char*)VA + (size_t)b * SEQ * 512 + h * 64;
                        u32x4 qr[2][2];
#pragma unroll
                        for (int g = 0; g < 2; ++g)
#pragma unroll
                            for (int e = 0; e < 2; ++e) qr[g][e] = *(const u32x4*)((const unsigned char*)QA + ((size_t)b * SEQ + tq0 + 8 * g) * 512 + h * 64 + 32 * hi + 16 * e);
                        f32x16 o[2][2]; float lsum[2] = {0.f, 0.f};
#pragma unroll
                        for (int r = 0; r < 16; ++r) { o[0][0][r] = 0.f; o[0][1][r] = 0.f; o[1][0][r] = 0.f; o[1][1][r] = 0.f; }
                        __syncthreads();
                        att::dense64_loop<true>(ring, Kg, Vg, 512, base - 64, 10, qr, o, lsum, tq0, tq1, lane, wave);
                        __syncthreads();
                        {
                            LAS char* vpriv = ring + att::PRIV_OFF + wave * att::VTILE;
#define A_TK0(j) ((j) < 4 ? base + wave - 256 + 256 * (j) : wave + 8 * (((j) - 4) >> 1) + 1024 * (((j) - 4) & 1))
#define A_DK(j) ((j) < 4 ? 4 : 16)
                            u32x4 kf[2][2];
                            att::priv_kload(kf, Kg, 512, A_TK0(0), 4, lane);
#pragma unroll 1
                            for (int j = 0; j < 8; ++j) {
                                const bool p2 = j < 4; const int g = (j - 4) >> 1;
                                att::priv2_step(kf, vpriv, Kg, Vg, 512, A_TK0(j), A_DK(j), p2 || g == 0, p2 || g == 1, j + 1 < 8, A_TK0(j + 1), A_DK(j + 1), qr, o, lsum, tq0, tq1, lane);
                            }
#undef A_TK0
#undef A_DK
                        }
                        { int l2; asm volatile("v_mbcnt_lo_u32_b32 %0, -1, 0\n\tv_mbcnt_hi_u32_b32 %0, -1, %0" : "=v"(l2)); const int tqs = base + 16 * (l2 & 31) + wave;
#pragma unroll
                          for (int g = 0; g < 2; ++g) att::store_out(o[g], lsum[g], (unsigned char*)YAB + ((size_t)b * SEQ + tqs + 8 * g) * DM + h * 64, l2); }
                    }
                    __syncthreads();
                }
                SEAM(pb + P_ATTN);
                if (EN(4) && IN(pb + P_PAB)) {
                    PHASE_ENTER();
                    pg8::StaticOrder S; S.init(TT, DM, G, bx); S.wgm = N1K_WGM;
                    pg8::Gemm g{YAB, (const bf16_t*)(const GAS bf16_t*)(ws + WS_WPA + l * 2 * MiB), DM / 2}; pg8::EpiMergeFused E{MERGED, (const unsigned char*)PGATE_A, (const unsigned char*)PGATE_B};
#pragma unroll 1
                    for (int rep = 0; rep < REP_PAB; ++rep)
                    pg8::gemm_phase<pg8::EpiMergeFused, pg8::StaticOrder, true>(lds, g, S, E, wave);
                }
                SEAM(pb + P_PAB);
                if (EN(5) && IN(pb + P_OUT)) {
                    PHASE_ENTER(); const float* modl = MOD + (size_t)l * NB * MODW;
                    pg8::Gemm g{MERGED, (const bf16_t*)(const GAS bf16_t*)(ws + WS_WOUT + l * 2 * MiB), DM / 2}; pg8::StaticOrder S; S.init(TT, DM, G, bx); S.rowmajor = OUT_ROWMAJOR; S.wgm = N1K_WGM;
                    pg8::EpiResidB E{(l == 0) ? x_in : (const float*)nullptr, XB, XB, modl + 2 * DM};
#pragma unroll 1
                    for (int rep = 0; rep < ((l == 0) ? REP_OUT : 1); ++rep)
                    pg8::gemm_phase<pg8::EpiResidB, pg8::StaticOrder, true>(lds, g, S, E, wave);
                }
                SEAM(pb + P_OUT);
            }
        if (EN(6) && IN(pb + P_NORM2)) { PHASE_ENTER(); const float* modl = MOD + (size_t)l * NB * MODW;
#pragma unroll 1
            for (int rep = 0; rep < REP_NORM2; ++rep)
            row_phase<false, false, true, true, false, GU_F8 ? 2 : 0>(lds, tid, lane, wave, G, bx, x_in, XB, out, g_ffn + l * DM, modl, 3 * DM, 4 * DM, MOD, H, YM, POS, TW, WR, TE, TRK, CNT, H2F8); }
        SEAM(pb + P_NORM2);
        if (EN(7) && IN(pb + P_PLACE)) {
            PHASE_ENTER();
            LAS int* part_tot = (LAS int*)lds;
            LAS int* part_pre = part_tot + 512;
            LAS int* basee = part_pre + 512;
            LAS int* pstart = basee + 32;
            LAS int* pend = pstart + 32;
            LAS int* tote = pend + 32;
            for (int chunk = bx; chunk < 256; chunk += G) {
                { const int e = tid & 31, part = tid >> 5; int st = 0, sp = 0;
                    for (int q = 0; q < 16; ++q) { const int ch = part * 16 + q; const int v = CNT[ch * 32 + e]; st += v; sp += (ch < chunk) ? v : 0; }
                    part_tot[part * 32 + e] = st; part_pre[part * 32 + e] = sp; }
                __syncthreads();
                if (tid < 32) { int st = 0, sp = 0; for (int q = 0; q < 16; ++q) { st += part_tot[q * 32 + tid]; sp += part_pre[q * 32 + tid]; } tote[tid] = st; basee[tid] = sp; }
                __syncthreads();
                if (tid == 0) { int run = 0; for (int e = 0; e < 32; ++e) { const int padded = (tote[e] + 255) & ~255; pstart[e] = run; basee[e] += run; run += padded; pend[e] = run; } }
                __syncthreads();
                { const int tok = chunk * 256 + (tid >> 1), slot = tid & 1; const int e = TE[2 * tok + slot], rk = TRK[2 * tok + slot]; const int dest = basee[e] + rk;
                    BTOK[dest] = tok; POS[2 * tok + slot] = dest; }
                if (chunk < 32) { const int e = chunk; const int from = pstart[e] + tote[e], n = pend[e] - from; if (tid < n) BTOK[from + tid] = 0; }
                if (chunk == 0) {
                    for (int blk = tid; blk < NBLK; blk += 512) { int e = 0; for (int q = 0; q < 32; ++q) e += (pend[q] <= blk * 256) ? 1 : 0; BLKE[blk] = e > 31 ? 31 : e; }
                    if (tid == 0) BLKE[1000] = pend[31] >> 8;
                }
                __syncthreads();
            }
        }
        SEAM(pb + P_PLACE);
        if (EN(8) && IN(pb + P_GU)) {
            PHASE_ENTER();
            const int nused = BLKE[1000];
            pg8::Gemm g{GU_F8 ? (const bf16_t*)H2F8 : H, (const bf16_t*)(const GAS bf16_t*)(ws + WS_WGU + (size_t)l * NEXP * (GU_F8 ? MiB : 2 * MiB)), GU_F8 ? DM / 2 : DM};
            pg8::MoeOrder<true> S{BLKE, BTOK, 4 * nused, G, vcu};
            pg8::EpiSwiGLU E{ACT, GU_F8 ? W8I : 1.0f};
#pragma unroll 1
            for (int rep = 0; rep < REP_GU; ++rep)
            pg8::gemm_phase<pg8::EpiSwiGLU, pg8::MoeOrder<true>, GU_F8 != 0>(lds, g, S, E, wave);
        }
        SEAM(pb + P_GU);
        if (EN(9) && IN(pb + P_DOWN)) {
            PHASE_ENTER();
            const int nused = BLKE[1000];
            pg8::Gemm g{ACT, (const bf16_t*)(const GAS bf16_t*)(ws + WS_WDN + (size_t)l * NEXP * (DN_F8 ? MiB / 2 : MiB)), DN_F8 ? DFF / 2 : DFF};
            pg8::MoeOrder<false> S{BLKE, nullptr, 4 * nused, G, vcu};
            pg8::EpiY E{YM};
#pragma unroll 1
            for (int rep = 0; rep < REP_DOWN; ++rep)
            pg8::gemm_phase<pg8::EpiY, pg8::MoeOrder<false>, DN_F8 != 0>(lds, g, S, E, wave);
        }
        SEAM(pb + P_DOWN);
    }
    if (EN(10) && IN(PH_FINAL)) {
        PHASE_ENTER();
        row_phase<false, true, false, false, true>(lds, tid, lane, wave, G, bx, x_in, XB, out, g_ffn, MOD, 0, 0, MOD + (size_t)NB * MODW, H, YM, POS, TW, WR, TE, TRK, CNT);
    }
#undef IN
#undef SEAM
#undef GRID_BAR
}

extern "C" void kernel_launch(void* const* d_in, const int* in_sizes, int n_in, void* d_out, int out_size, void* d_ws, size_t ws_size, hipStream_t stream) {
    static int grid = 0;
    if (grid == 0) {
        if (n_in != 18 || in_sizes[0] != TT * DM || out_size != TT * DM || ws_size < WS_END) { fprintf(stderr, "kernel_launch: unexpected shapes / workspace (n_in %d, ws %zu); nothing launched\n", n_in, ws_size); grid = -1; return; }
        int dev = 0, cus = 0, per_cu = 0;
        if (hipGetDevice(&dev) != hipSuccess || hipDeviceGetAttribute(&cus, hipDeviceAttributeMultiprocessorCount, dev) != hipSuccess) { grid = -1; return; }
        if (hipFuncSetAttribute((const void*)fwd_kernel, hipFuncAttributeMaxDynamicSharedMemorySize, LDS_BYTES) != hipSuccess) { fprintf(stderr, "kernel_launch: hipFuncSetAttribute failed\n"); grid = -1; return; }
        if (hipOccupancyMaxActiveBlocksPerMultiprocessor(&per_cu, (const void*)fwd_kernel, 512, LDS_BYTES) != hipSuccess || per_cu < 1) { fprintf(stderr, "kernel_launch: occupancy query says %d\n", per_cu); per_cu = 1; }
        (void)hipGetLastError();
        grid = cus;
    }
    if (grid < 0) return;
    (void)hipMemsetAsync((char*)d_ws + WS_CTL, 0, CTL_ZERO_BYTES, stream);
    Args a{};
    for (int i = 0; i < 18; ++i) a.in[i] = (const float*)d_in[i];
    a.out = (float*)d_out; a.ws = (unsigned char*)d_ws;
#if MK_ONE_LAUNCH
    a.ph_lo = 0; a.ph_hi = NPH;
    hipLaunchKernelGGL(fwd_kernel, dim3(grid), dim3(512), LDS_BYTES, stream, a);
#else
    for (int p = 0; p < NPH; ++p) { a.ph_lo = p; a.ph_hi = p + 1; hipLaunchKernelGGL(fwd_kernel, dim3(grid), dim3(512), LDS_BYTES, stream, a); }
#endif
}
```

```cpp
#include <hip/hip_runtime.h>
#include <cstdio>
#include <cstdint>

#ifndef INPROJ_WGM
#define INPROJ_WGM 4
#endif
#ifndef GEMM_ALIGN
#define GEMM_ALIGN 1
#endif
#ifndef ROWB
#define ROWB 4
#endif
#ifndef N1K_WGM
#define N1K_WGM 8
#endif
#ifndef OUT_ROWMAJOR
#define OUT_ROWMAJOR 0
#endif
#ifndef REP_PRO
#define REP_PRO 1
#endif
#ifndef REP_ATTB
#define REP_ATTB 1
#endif
#ifndef REP_ATTA
#define REP_ATTA 1
#endif
#ifndef REP_INPROJ
#define REP_INPROJ 1
#endif
#ifndef REP_NORM1
#define REP_NORM1 1
#endif
#ifndef REP_GU
#define REP_GU 1
#endif
#ifndef REP_PAB
#define REP_PAB 1
#endif
#ifndef REP_OUT
#define REP_OUT 1
#endif
#ifndef REP_DOWN
#define REP_DOWN 1
#endif
#ifndef REP_NORM2
#define REP_NORM2 1
#endif
#ifndef GU_F8
#define GU_F8 1
#endif
#ifndef DN_F8
#define DN_F8 1
#endif
#ifndef MK_ONE_LAUNCH
#define MK_ONE_LAUNCH 1
#endif

#define LAS __attribute__((address_space(3)))
#define GAS __attribute__((address_space(1)))
typedef unsigned short bf16_t;
typedef short bf16x8 __attribute__((ext_vector_type(8)));
typedef short s16x4 __attribute__((ext_vector_type(4)));
typedef float f32x4 __attribute__((ext_vector_type(4)));
typedef float f32x16 __attribute__((ext_vector_type(16)));
typedef unsigned u32x4 __attribute__((ext_vector_type(4)));
typedef unsigned u32x2 __attribute__((ext_vector_type(2)));

constexpr int NB = 32, SEQ = 2048, DM = 1024, TT = NB * SEQ;
constexpr int NC = 4352;
constexpr int NEXP = 32, DFF = 512, NPAD = 139264, NBLK = 544;
constexpr int MODW = 6 * DM;
constexpr float QSCALE = 0.125f * 1.4426950408889634f;

constexpr size_t MiB = 1u << 20;
constexpr size_t WS_CTL = 0, CTL_ZERO_BYTES = 64 * 1024;
constexpr size_t WS_MOD = 1 * MiB;
constexpr size_t WS_TE = 2 * MiB + 512 * 1024, WS_TRK = 3 * MiB, WS_TW = 3 * MiB + 512 * 1024, WS_POS = 4 * MiB;
constexpr size_t WS_CNT = 4 * MiB + 512 * 1024;
constexpr size_t WS_BLKE = WS_CNT + 64 * 1024;
constexpr size_t WS_BTOK = WS_CNT + 128 * 1024;
constexpr size_t WS_WR = 5 * MiB + 256 * 1024;
constexpr size_t WS_WIN = 6 * MiB;
constexpr size_t WIN_BYTES = (size_t)NC * DM * 2;
constexpr size_t WS_WPA = 23 * MiB, WS_WPB = 25 * MiB, WS_WOUT = 27 * MiB;
constexpr size_t WS_WGU = 31 * MiB;
constexpr size_t WS_WDN = 159 * MiB;
constexpr size_t WS_H = 223 * MiB;
constexpr size_t WS_QKV = 351 * MiB;
constexpr size_t WS_GATE = 639 * MiB;
constexpr size_t WS_XB = 896 * MiB;
constexpr size_t WS_END = 1024 * MiB;
constexpr int CW_BAR = 4096;

constexpr int RING_BYTES = 133120;
constexpr int MISC_OFF = RING_BYTES;
constexpr int LDS_BYTES = 147456;

#define RLX_AGENT __ATOMIC_RELAXED, __HIP_MEMORY_SCOPE_AGENT
typedef float f32x2_t __attribute__((ext_vector_type(2))); typedef __bf16 bf16x2_t __attribute__((ext_vector_type(2)));
__device__ __forceinline__ unsigned cvt_pk_bf16(float lo, float hi) { const f32x2_t v = {lo, hi}; const bf16x2_t b = __builtin_convertvector(v, bf16x2_t); return __builtin_bit_cast(unsigned, b); }
typedef float f32x2v __attribute__((ext_vector_type(2)));
__device__ __forceinline__ unsigned pack4_fp8(float a, float b, float c, float d) { unsigned w = 0; w = __builtin_amdgcn_cvt_pk_fp8_f32(a, b, w, false); w = __builtin_amdgcn_cvt_pk_fp8_f32(c, d, w, true); return w; }
__device__ __forceinline__ void unpack8_fp8(u32x2 w, float (&o)[8]) { const f32x2v a = __builtin_amdgcn_cvt_pk_f32_fp8(w.x, false), b = __builtin_amdgcn_cvt_pk_f32_fp8(w.x, true), c = __builtin_amdgcn_cvt_pk_f32_fp8(w.y, false), d = __builtin_amdgcn_cvt_pk_f32_fp8(w.y, true);
    o[0] = a.x; o[1] = a.y; o[2] = b.x; o[3] = b.y; o[4] = c.x; o[5] = c.y; o[6] = d.x; o[7] = d.y; }
constexpr float A8S = 4.f, A8I = 0.25f;
constexpr float W8S = 64.f, W8I = 1.f / 64.f;
__device__ __forceinline__ float bf_lo(unsigned w) { return __uint_as_float(w << 16); }
__device__ __forceinline__ float bf_hi(unsigned w) { return __uint_as_float(w & 0xffff0000u); }
__device__ __forceinline__ float shx(float v, int mask, int lane) { return __int_as_float(__builtin_amdgcn_ds_bpermute((lane ^ mask) << 2, __float_as_int(v))); }
__device__ __forceinline__ float wave_sum(float v, int lane) {
#pragma unroll
    for (int o = 1; o < 64; o <<= 1) v += shx(v, o, lane);
    return v;
}
__device__ __forceinline__ float wave_max(float v, int lane) {
#pragma unroll
    for (int o = 1; o < 64; o <<= 1) v = fmaxf(v, shx(v, o, lane));
    return v;
}
__device__ __forceinline__ float sigmoid_f(float x) { return __builtin_amdgcn_rcpf(1.0f + __builtin_amdgcn_exp2f(-1.4426950408889634f * x)); }

#define XB_TMO      128
#define XB_XCNT(j)  (256  + 64 * (j))
#define XB_XSUB(j)  (1280 + 64 * (j))
#define XB_XGEN(j)  (2304 + 64 * (j))
#define XB_TOP      3328
#define XB_TOPGEN   3392
#define XCD_BAR_WORDS 3456
#define XB_SPIN_CAP (1u << 18)

__device__ __forceinline__ unsigned xb_ld(unsigned* p)              { return __hip_atomic_load(p, __ATOMIC_RELAXED, __HIP_MEMORY_SCOPE_AGENT); }
__device__ __forceinline__ unsigned xb_add(unsigned* p, unsigned v) { return __hip_atomic_fetch_add(p, v, __ATOMIC_RELAXED, __HIP_MEMORY_SCOPE_AGENT); }
__device__ __forceinline__ unsigned xb_xcc_id() { return (unsigned)__builtin_amdgcn_s_getreg((3 << 11) | 20) & 0xFu; }
#define XB_SPIN(cond, bar) do { unsigned _sp = 0; while (cond) { __builtin_amdgcn_s_sleep(1); \
    if ((++_sp & 255u) == 0u) { if (xb_ld(&(bar)[XB_TMO])) break; if (_sp > XB_SPIN_CAP) { atomicAdd(&(bar)[XB_TMO], 1u); break; } } } } while (0)

struct XcdBarrier { unsigned* bar; unsigned x; volatile LAS unsigned* st; };

__device__ __forceinline__ XcdBarrier xcd_barrier_post(unsigned* bar, volatile LAS unsigned* st) {
    XcdBarrier b; b.bar = bar; b.x = xb_xcc_id(); b.st = st;
    if (threadIdx.x == 0) (void)xb_add(&bar[XB_XCNT(b.x)], 1u);
    return b;
}
__device__ __forceinline__ void xcd_barrier_complete(unsigned* bar, unsigned x, unsigned& nloc, unsigned& nx) {
    const unsigned G = gridDim.x * gridDim.y * gridDim.z;
    unsigned sum, cnt, mine, sp = 0u;
    for (;;) {
        sum = 0u; cnt = 0u; mine = 0u;
#pragma unroll
        for (unsigned j = 0; j < 16; ++j) { const unsigned c = xb_ld(&bar[XB_XCNT(j)]); sum += c; cnt += (c > 0u) ? 1u : 0u; mine = (j == x) ? c : mine; }
        if (sum == G) break;
        __builtin_amdgcn_s_sleep(1);
        if ((++sp & 255u) == 0u) { if (xb_ld(&bar[XB_TMO])) break; if (sp > XB_SPIN_CAP) { atomicAdd(&bar[XB_TMO], 1u); break; } }
    }
    nloc = mine > 0u ? mine : 1u; nx = cnt > 0u ? cnt : 1u;
}
__device__ __forceinline__ void xcd_barrier(const XcdBarrier& b, const bool is_t0  ) {
    asm volatile("s_waitcnt vmcnt(0)" ::: "memory");
    __syncthreads();
    if (is_t0) {
        unsigned* bar = b.bar; unsigned bx_ = b.x;
        asm volatile("" : "+s"(bar), "+s"(bx_));
        __builtin_amdgcn_s_waitcnt(0);
        unsigned nloc = b.st[0], nx = b.st[1];
        if (nloc == 0u) { xcd_barrier_complete(bar, bx_, nloc, nx); b.st[0] = nloc; b.st[1] = nx; }
        const unsigned old = xb_add(&bar[XB_XSUB(bx_)], 1u);
        const unsigned gen = old / nloc;
        if (old + 1u == (gen + 1u) * nloc) {
            __builtin_amdgcn_fence(__ATOMIC_RELEASE, "agent");
            asm volatile("s_waitcnt vmcnt(0)" ::: "memory");
            const unsigned og = xb_add(&bar[XB_TOP], 1u);
            const unsigned tg = og / nx;
            if (og + 1u == (tg + 1u) * nx) xb_add(&bar[XB_TOPGEN], 1u);
            else XB_SPIN(xb_ld(&bar[XB_TOPGEN]) == tg, bar);
            __builtin_amdgcn_fence(__ATOMIC_ACQUIRE, "agent");
            xb_add(&bar[XB_XGEN(bx_)], 1u);
            asm volatile("s_waitcnt vmcnt(0)" ::: "memory");
        } else {
            XB_SPIN(xb_ld(&bar[XB_XGEN(bx_)]) == gen, bar);
            __builtin_amdgcn_fence(__ATOMIC_ACQUIRE, "agent");
            asm volatile("s_waitcnt vmcnt(0)" ::: "memory");
        }
    }
    __syncthreads();
}

namespace pg8 {
constexpr int BM = 256, BK = 64, HALF = 128, HTB = HALF * BK * 2, STAGE_BYTES = 8 * HTB, NXCD = 8, WGM = 8;
__host__ __device__ __forceinline__ int lds_byte(int r, int c) { const int st = (r >> 4) * 2 + (c >> 5), rr = r & 15, cc = c & 31, ob = rr * 64 + cc * 2; return st * 1024 + (ob ^ (((ob >> 9) & 1) << 5)); }
__host__ __device__ __forceinline__ void stage_rc(int b, int& R, int& C) { const int st = b / 1024, sb = b % 1024, swz = sb ^ (((sb >> 9) & 1) << 5); R = (st >> 1) * 16 + swz / 64; C = (st & 1) * 32 + (swz % 64) / 2; }
__host__ __device__ __forceinline__ int perm32(int rho) { const int n = rho >> 4, i = rho & 15; return 8 * (i >> 2) + 4 * n + (i & 3); }

struct Unit { int pm, pn; };
struct Gemm { const bf16_t* A; const bf16_t* Bt; int K; };

struct StaticOrder {
    static constexpr bool GATHER = false;
    int nM, nN, nwg, G, c, wgm = WGM;
    __device__ void init(int M, int N, int G_, int c_) { asm volatile("" : "+s"(c_));     nM = M / BM; nN = N / BM; nwg = nM * nN; G = G_; c = c_; }
    int rowmajor = 0;
    __device__ __forceinline__ bool next(int i, Unit& u) const {
        if (rowmajor) { const int upw = (nwg + G - 1) / G, k = c * upw + i; if (i >= upw || k >= nwg) return false; u.pm = k / nN; u.pn = k % nN; return true; }
        const long L = (long)i * G + c; if (L >= nwg) return false;
        int wgid = (int)L; { const int q = nwg / NXCD, r = nwg % NXCD, xcd = wgid % NXCD, off = wgid / NXCD; wgid = (xcd < r ? xcd * (q + 1) : r * (q + 1) + (xcd - r) * q) + off; }
        const int nig = wgm * nN, gid = wgid / nig, fm = gid * wgm, gsz = (nM - fm) < wgm ? (nM - fm) : wgm;
        u.pm = fm + ((wgid % nig) % gsz); u.pn = (wgid % nig) / gsz; return true;
    }
    __device__ __forceinline__ void aoff(const Unit&, int, int, unsigned (&)[2][2]) const {}
};
template <bool GATH>
struct MoeOrder {
    static constexpr bool GATHER = GATH;
    const int* blk_e; const int* rowidx; int nunits, G, c;
    __device__ __forceinline__ bool next(int i, Unit& u) const {
        const int L = i * G + c; if (L >= nunits) return false;
        const int blk = L >> 2; const int e = blk_e[blk]; u.pm = blk; u.pn = 4 * e + (L & 3); return true;
    }
    __device__ __forceinline__ void aoff(const Unit& u, int tid_, int K, unsigned (&o)[2][2]) const {
        int tid = tid_; asm volatile("" : "+v"(tid));
#pragma unroll
        for (int i = 0; i < 2; ++i) { int R, C; stage_rc(tid * 16 + i * 8192, R, C);
#pragma unroll
            for (int h = 0; h < 2; ++h) { const int r = u.pm * BM + h * HALF + R; const int src = rowidx ? rowidx[r] : r; o[h][i] = (unsigned)src * (unsigned)(K * 2) + (unsigned)C * 2u; } }
    }
};

typedef int i32x8 __attribute__((ext_vector_type(8))); typedef int i32x4 __attribute__((ext_vector_type(4)));
__device__ __forceinline__ i32x8 cat8(const bf16x8& a, const bf16x8& b) { return __builtin_shufflevector(__builtin_bit_cast(i32x4, a), __builtin_bit_cast(i32x4, b), 0, 1, 2, 3, 4, 5, 6, 7); }
template <class Epi, class Sched, bool F8 = false>
__device__ __forceinline__ void gemm_phase(LAS unsigned char* lds, const Gemm g, const Sched& S, const Epi& E, const int wid) {
    int lane_; asm volatile("v_mbcnt_lo_u32_b32 %0, -1, 0\n\tv_mbcnt_hi_u32_b32 %0, -1, %0" : "=v"(lane_));
    const int lane = lane_, tid = wid * 64 + lane, wr = wid >> 2, wc = wid & 3, fr = lane & 15, fq = lane >> 4;
    const int K = g.K, nt = K / BK;
    unsigned voffA[2], voffB[2];
#pragma unroll
    for (int i = 0; i < 2; ++i) { int R, C; stage_rc(tid * 16 + i * 8192, R, C); const int Rb = Epi::PERM ? ((R & ~31) + perm32(R & 31)) : R;
        voffA[i] = (unsigned)(R * K + C) * 2u; voffB[i] = (unsigned)(Rb * K + C) * 2u; }
    const size_t kstep = (size_t)(BK * 2);
    const size_t hstep = (size_t)HALF * K * 2;
    const size_t tstep = 2 * hstep;
    const unsigned ldsw = (unsigned)wid * 1024u;
    const int aoff = lds_byte(wr * 64 + fr, fq * 8), boff = lds_byte(wc * 32 + fr, fq * 8);
    const char* Ab = (const char*)g.A;
#define PG8_SA(b, h) (((b) * 2 + (h)) * HTB)
#define PG8_SB(b, h) ((4 + (b) * 2 + (h)) * HTB)
#define PG8_UNI(p) asm volatile("" : "+s"(p))
#define PG8_LOFF(v) asm volatile("" : "+v"(v))
#define PG8_STAGEB(bufoff, gbase, voff) do { const char* _g = (const char*)(gbase); PG8_UNI(_g); _Pragma("unroll") for (int _i = 0; _i < 2; ++_i) { unsigned _v = (voff)[_i]; PG8_LOFF(_v); \
        __builtin_amdgcn_global_load_lds((const unsigned*)(_g + _v), (LAS unsigned*)(lds + (bufoff) + ldsw + _i * 8192), 16, 0, 0); } } while (0)
#define PG8_STAGEA(bufoff, H_, kb, NEXT) do { if constexpr (Sched::GATHER) { const char* _g = Ab + (size_t)(kb); PG8_UNI(_g); _Pragma("unroll") for (int _i = 0; _i < 2; ++_i) { unsigned _o = (NEXT) ? na[H_][_i] : ca[H_][_i]; PG8_LOFF(_o); \
            __builtin_amdgcn_global_load_lds((const unsigned*)(_g + _o), (LAS unsigned*)(lds + (bufoff) + ldsw + _i * 8192), 16, 0, 0); } } \
        else { const char* _b = Ab + ((NEXT) ? nU : cU) + (size_t)(H_) * hstep + (size_t)(kb); PG8_UNI(_b); _Pragma("unroll") for (int _i = 0; _i < 2; ++_i) { unsigned _v = voffA[_i]; PG8_LOFF(_v); \
            __builtin_amdgcn_global_load_lds((const unsigned*)(_b + _v), (LAS unsigned*)(lds + (bufoff) + ldsw + _i * 8192), 16, 0, 0); } } } while (0)
#define PG8_LDA(dst, b, h) do { _Pragma("unroll") for (int m = 0; m < 4; ++m) _Pragma("unroll") for (int k = 0; k < 2; ++k) dst[m][k] = *(const LAS bf16x8*)(lds + PG8_SA(b, h) + aoff + m * 2048 + k * 1024); } while (0)
#define PG8_LDB(dst, b, h) do { _Pragma("unroll") for (int n = 0; n < 2; ++n) _Pragma("unroll") for (int k = 0; k < 2; ++k) dst[n][k] = *(const LAS bf16x8*)(lds + PG8_SB(b, h) + boff + n * 2048 + k * 1024); } while (0)
#define PG8_MMA(ai, bj, At, Bt) do { __builtin_amdgcn_s_setprio(1); _Pragma("unroll") for (int m = 0; m < 4; ++m) _Pragma("unroll") for (int n = 0; n < 2; ++n) { \
        if constexpr (F8) { const i32x8 b_ = cat8(Bt[n][0], Bt[n][1]), a_ = cat8(At[m][0], At[m][1]); \
            asm volatile("v_mfma_f32_16x16x128_f8f6f4 %0, %1, %2, %0" : "+v"(acc[ai][bj][m][n]) : "v"(b_), "v"(a_)); } \
        else { _Pragma("unroll") for (int k = 0; k < 2; ++k) acc[ai][bj][m][n] = __builtin_amdgcn_mfma_f32_16x16x32_bf16(Bt[n][k], At[m][k], acc[ai][bj][m][n], 0, 0, 0); } } \
        __builtin_amdgcn_s_setprio(0); } while (0)
#define PG8_MFMA_DRAIN asm volatile("s_nop 7\n\ts_nop 7\n\ts_nop 3" ::: "memory")
#define PG8_WAIT_V(n) asm volatile("s_waitcnt vmcnt(" #n ")" ::: "memory")
#define PG8_WAIT_L(n) asm volatile("s_waitcnt lgkmcnt(" #n ")" ::: "memory")
#define PG8_BAR __builtin_amdgcn_s_barrier()
#define PG8_SCHED __builtin_amdgcn_sched_barrier(0)
    Unit cur, nxt; int ui = 0;
    if (!S.next(0, cur)) return;
    f32x4 acc[2][2][4][2];
#pragma unroll
    for (int a = 0; a < 2; ++a)
#pragma unroll
        for (int b = 0; b < 2; ++b)
#pragma unroll
            for (int m = 0; m < 4; ++m)
#pragma unroll
                for (int n = 0; n < 2; ++n) acc[a][b][m][n] = (f32x4){0.f, 0.f, 0.f, 0.f};
    bf16x8 At[4][2], B0[2][2], B1[2][2];
    unsigned ca[2][2], na[2][2];
    size_t cU = 0, nU = 0;
    if constexpr (Sched::GATHER) S.aoff(cur, tid, K, ca); else cU = (size_t)cur.pm * tstep;
    const char* cB = (const char*)g.Bt + (size_t)cur.pn * tstep;
    PG8_STAGEB(PG8_SB(0, 0), cB, voffB); PG8_STAGEB(PG8_SB(0, 1), cB + hstep, voffB); PG8_STAGEA(PG8_SA(0, 0), 0, 0, false); PG8_STAGEA(PG8_SA(0, 1), 1, 0, false);
    if (wr == 1) PG8_BAR;
    PG8_WAIT_V(2); PG8_BAR;
    PG8_STAGEB(PG8_SB(1, 0), cB + kstep, voffB); PG8_STAGEA(PG8_SA(1, 0), 0, kstep, false); PG8_STAGEB(PG8_SB(1, 1), cB + hstep + kstep, voffB);
    PG8_WAIT_V(6); PG8_BAR;
    for (;;) {
        const bool has_next = S.next(ui + 1, nxt);
        if constexpr (Sched::GATHER) {
            if (has_next) S.aoff(nxt, tid, K, na);
            else {
#pragma unroll
                for (int h = 0; h < 2; ++h)
#pragma unroll
                    for (int i = 0; i < 2; ++i) na[h][i] = ca[h][i];
            }
        } else nU = has_next ? (size_t)nxt.pm * tstep : cU;
        const char* nB = has_next ? (const char*)g.Bt + (size_t)nxt.pn * tstep : cB;
#pragma unroll 1
        for (int t = 0; t < nt; t += 2) {
            const bool last = (t == nt - 2);
            const size_t kb1 = (size_t)(t + 1) * kstep;
            const size_t kb2 = last ? 0 : (size_t)(t + 2) * kstep, kb3 = kb2 + kstep;
            const char* b2 = last ? nB : cB + (size_t)(t + 2) * kstep; const char* b3 = b2 + kstep;
            PG8_LDB(B0, 0, 0); PG8_LDB(B1, 0, 1); PG8_SCHED; PG8_LDA(At, 0, 0); PG8_STAGEA(PG8_SA(1, 1), 1, kb1, false);
            PG8_WAIT_V(8); PG8_WAIT_L(0); PG8_BAR; PG8_MMA(0, 0, At, B0); PG8_MMA(0, 1, At, B1); PG8_BAR; PG8_SCHED;
            PG8_LDA(At, 0, 1); PG8_STAGEB(PG8_SB(0, 0), b2, voffB); PG8_STAGEB(PG8_SB(0, 1), b2 + hstep, voffB); PG8_STAGEA(PG8_SA(0, 0), 0, kb2, last);
            PG8_WAIT_V(8); PG8_WAIT_L(0); PG8_BAR; PG8_MMA(1, 0, At, B0); PG8_MMA(1, 1, At, B1); PG8_BAR; PG8_SCHED;
            PG8_LDB(B0, 1, 0); PG8_LDB(B1, 1, 1); PG8_SCHED; PG8_LDA(At, 1, 0); PG8_STAGEA(PG8_SA(0, 1), 1, kb2, last);
            PG8_WAIT_V(8); PG8_WAIT_L(0); PG8_BAR; PG8_MMA(0, 0, At, B0); PG8_MMA(0, 1, At, B1); PG8_BAR; PG8_SCHED;
            PG8_LDA(At, 1, 1); PG8_STAGEB(PG8_SB(1, 0), b3, voffB); PG8_STAGEB(PG8_SB(1, 1), b3 + hstep, voffB); PG8_STAGEA(PG8_SA(1, 0), 0, kb3, last);
            PG8_WAIT_V(8); PG8_WAIT_L(0); PG8_BAR; PG8_MMA(1, 0, At, B0); PG8_MMA(1, 1, At, B1); PG8_BAR; PG8_SCHED;
            if constexpr (Epi::MIDK) { if (t + 2 == nt / 2) { if constexpr (F8) PG8_MFMA_DRAIN; E.mid(acc, cur, wr, wc, fr, fq); if constexpr (F8) asm volatile("s_nop 3" ::: "memory"); } }
        }
#if GEMM_ALIGN
        if (wr == 0) PG8_BAR;
#endif
        if constexpr (F8) PG8_MFMA_DRAIN;
        E(acc, cur, wr, wc, fr, fq);
        if (!has_next) break;
#pragma unroll
        for (int a = 0; a < 2; ++a)
#pragma unroll
            for (int b = 0; b < 2; ++b)
#pragma unroll
                for (int m = 0; m < 4; ++m)
#pragma unroll
                    for (int n = 0; n < 2; ++n) acc[a][b][m][n] = (f32x4){0.f, 0.f, 0.f, 0.f};
        cur = nxt; cB = nB; cU = nU; ++ui;
        if constexpr (Sched::GATHER) {
#pragma unroll
            for (int h = 0; h < 2; ++h)
#pragma unroll
                for (int i = 0; i < 2; ++i) ca[h][i] = na[h][i];
        }
#if GEMM_ALIGN
        if (wr == 1) PG8_BAR;
#endif
    }
    PG8_WAIT_V(0);
#if !GEMM_ALIGN
    if (wr == 0) PG8_BAR;
#endif
    PG8_BAR;
#undef PG8_SA
#undef PG8_SB
#undef PG8_STAGEA
#undef PG8_STAGEB
#undef PG8_UNI
#undef PG8_LOFF
#undef PG8_LDA
#undef PG8_LDB
#undef PG8_MMA
#undef PG8_WAIT_V
#undef PG8_MFMA_DRAIN
#undef PG8_WAIT_L
#undef PG8_BAR
#undef PG8_SCHED
}

typedef const f32x4 (&AccRef)[2][2][4][2];

__device__ __forceinline__ u32x4 pack8(const f32x4& a, const f32x4& b) { u32x4 w; w.x = cvt_pk_bf16(a[0], a[1]); w.y = cvt_pk_bf16(a[2], a[3]); w.z = cvt_pk_bf16(b[0], b[1]); w.w = cvt_pk_bf16(b[2], b[3]); return w; }

struct EpiInProj {
    static constexpr bool PERM = true, MIDK = false;
    bf16_t *QA, *KA, *VA, *QB, *KB, *VB, *SA, *SB;
    const LAS float* normw;
    template <int ROPE>
    __device__ __forceinline__ void head_tile(AccRef acc, bf16_t* dst_, int ld, int hcol, int gsel, float scale, int row0, int fr, int fq) const {
        unsigned char* dst = (unsigned char*)dst_;
        int d0[2];
#pragma unroll
        for (int bj = 0; bj < 2; ++bj) d0[bj] = (ROPE == 1) ? (fq == 0 ? 8 * bj : 8 + 8 * fq + 24 * bj) : (fq < 2 ? 8 * fq + 16 * bj : 16 + 8 * fq + 16 * bj);
        f32x4 g[2][2];
#pragma unroll
        for (int bj = 0; bj < 2; ++bj)
#pragma unroll
            for (int n = 0; n < 2; ++n) g[bj][n] = *(const LAS f32x4*)(normw + gsel * 64 + d0[bj] + 4 * n);
        constexpr float FA[8] = {1.591549431e-01f, 3.086376340e-02f, 5.985185713e-03f, 1.160663641e-03f, 2.250790790e-04f, 4.364795279e-05f, 8.464330808e-06f, 1.641426263e-06f};
        constexpr float FB[16] = {1.591549431e-01f, 8.949940161e-02f, 5.032921210e-02f, 2.830219583e-02f, 1.591549431e-02f, 8.949940161e-03f, 5.032921210e-03f, 2.830219583e-03f,
                                  1.591549431e-03f, 8.949940161e-04f, 5.032921210e-04f, 2.830219583e-04f, 1.591549431e-04f, 8.949940161e-05f, 5.032921210e-05f, 2.830219583e-05f};
        float fq8[8];
#pragma unroll
        for (int k = 0; k < 8; ++k) fq8[k] = (ROPE == 1) ? FA[k] : ((fq & 1) ? FB[8 + k] : FB[k]);
        const bool rot = (ROPE == 2) || (fq == 0);
#pragma unroll
        for (int ai = 0; ai < 2; ++ai)
#pragma unroll
            for (int m = 0; m < 4; ++m) {
                const int row = row0 + ai * HALF + m * 16; const int s = row & (SEQ - 1);
                f32x4 y[2][2]; float ss = 0.f;
#pragma unroll
                for (int bj = 0; bj < 2; ++bj)
#pragma unroll
                    for (int n = 0; n < 2; ++n) { y[bj][n] = acc[ai][bj][m][n]; const f32x4 q = y[bj][n] * y[bj][n]; ss += (q[0] + q[1]) + (q[2] + q[3]); }
                ss += shx(ss, 16, fr + 16 * fq); ss += shx(ss, 32, fr + 16 * fq);
                const float rinv = __builtin_amdgcn_rsqf(ss * (W8I * W8I / 64.0f) + 1e-6f) * W8I;
#pragma unroll
                for (int bj = 0; bj < 2; ++bj)
#pragma unroll
                    for (int n = 0; n < 2; ++n) y[bj][n] = y[bj][n] * rinv * g[bj][n];
                if (ROPE != 0) {
                    const float pos = (float)((ROPE == 1) ? s : (fq < 2 ? (s >> 6) : (s & 63)));
#pragma unroll
                    for (int n = 0; n < 2; ++n)
#pragma unroll
                        for (int j = 0; j < 4; ++j) {
                            const float xr = __builtin_amdgcn_fractf(pos * fq8[4 * n + j]);
                            const float c = rot ? __builtin_amdgcn_cosf(xr) : 1.0f, s_ = rot ? __builtin_amdgcn_sinf(xr) : 0.0f;
                            const float x1 = y[0][n][j], x2 = y[1][n][j];
                            y[0][n][j] = x1 * c - x2 * s_; y[1][n][j] = x2 * c + x1 * s_;
                        }
                }
                u32x4 w;
#pragma unroll
                for (int bj = 0; bj < 2; ++bj) { const f32x4 a = y[bj][0] * scale, c = y[bj][1] * scale;
                    const unsigned lo = pack4_fp8(a[0], a[1], a[2], a[3]), hi = pack4_fp8(c[0], c[1], c[2], c[3]);
                    if (bj == 0) { w.x = lo; w.y = hi; } else { w.z = lo; w.w = hi; } }
                *(u32x4*)(dst + (size_t)row * ld + hcol + 16 * fq) = w;
            }
    }
    __device__ __forceinline__ void operator()(AccRef acc, const Unit& u, int wr, int wc, int fr_, int fq_) const {
        int fr = fr_, fq = fq_; asm volatile("" : "+v"(fr), "+v"(fq));
        const int pn = u.pn; const int row0 = u.pm * BM + wr * 64 + fr;
        if (pn >= 9) {
            unsigned char* base = (unsigned char*)((pn < 13) ? SA : SB); const int colt = ((pn - 9) & 3) * 256 + wc * 64 + 16 * fq;
#pragma unroll
            for (int ai = 0; ai < 2; ++ai)
#pragma unroll
                for (int m = 0; m < 4; ++m) { u32x4 w;
#pragma unroll
                    for (int bj = 0; bj < 2; ++bj) { f32x4 v0 = acc[ai][bj][m][0], v1 = acc[ai][bj][m][1];
#pragma unroll
                        for (int j = 0; j < 4; ++j) { v0[j] = sigmoid_f(v0[j] * W8I); v1[j] = sigmoid_f(v1[j] * W8I); }
                        const unsigned lo = pack4_fp8(v0[0], v0[1], v0[2], v0[3]), hi = pack4_fp8(v1[0], v1[1], v1[2], v1[3]);
                        if (bj == 0) { w.x = lo; w.y = hi; } else { w.z = lo; w.w = hi; } }
                    *(u32x4*)(base + (size_t)(row0 + ai * HALF + m * 16) * DM + colt) = w; }
        } else if (pn == 4 || pn == 5) {
            const int colt = (pn - 4) * 256 + wc * 64 + 16 * fq;
#pragma unroll
            for (int ai = 0; ai < 2; ++ai)
#pragma unroll
                for (int m = 0; m < 4; ++m) { u32x4 w;
                    { const f32x4 a = acc[ai][0][m][0] * W8I, c = acc[ai][0][m][1] * W8I; w.x = pack4_fp8(a[0], a[1], a[2], a[3]); w.y = pack4_fp8(c[0], c[1], c[2], c[3]); }
                    { const f32x4 a = acc[ai][1][m][0] * W8I, c = acc[ai][1][m][1] * W8I; w.z = pack4_fp8(a[0], a[1], a[2], a[3]); w.w = pack4_fp8(c[0], c[1], c[2], c[3]); }
                    *(u32x4*)((unsigned char*)VA + (size_t)(row0 + ai * HALF + m * 16) * 512 + colt) = w; }
        } else if (pn < 2)  head_tile<1>(acc, QA, 512, 64 * (4 * pn + wc), 0, QSCALE, row0, fr, fq);
        else if (pn < 4)    head_tile<1>(acc, KA, 512, 64 * (4 * (pn - 2) + wc), 1, 1.0f, row0, fr, fq);
        else if (pn < 8)    head_tile<2>(acc, QB, 512, 64 * (4 * (pn - 6) + wc), 2, QSCALE, row0, fr, fq);
        else if (wc < 2)    head_tile<2>(acc, KB, 128, 64 * wc, 3, 1.0f, row0, fr, fq);
        else {
#pragma unroll
            for (int ai = 0; ai < 2; ++ai)
#pragma unroll
                for (int m = 0; m < 4; ++m) { u32x4 w;
                    { const f32x4 a = acc[ai][0][m][0] * W8I, c = acc[ai][0][m][1] * W8I; w.x = pack4_fp8(a[0], a[1], a[2], a[3]); w.y = pack4_fp8(c[0], c[1], c[2], c[3]); }
                    { const f32x4 a = acc[ai][1][m][0] * W8I, c = acc[ai][1][m][1] * W8I; w.z = pack4_fp8(a[0], a[1], a[2], a[3]); w.w = pack4_fp8(c[0], c[1], c[2], c[3]); }
                    *(u32x4*)((unsigned char*)VB + (size_t)(row0 + ai * HALF + m * 16) * 128 + 64 * (wc - 2) + 16 * fq) = w; }
        }
    }
};

struct EpiMergeFused {
    static constexpr bool PERM = true, MIDK = true;
    bf16_t* MG; const unsigned char* GA; const unsigned char* GB;
    __device__ __forceinline__ void mid(f32x4 (&acc)[2][2][4][2], const Unit& u, int wr, int wc, int fr_, int fq_) const {
        int fr = fr_, fq = fq_; asm volatile("" : "+v"(fr), "+v"(fq));
        const int row0 = u.pm * BM + wr * 64 + fr, col0 = u.pn * BM + wc * 64 + 16 * fq;
#pragma unroll
        for (int ai = 0; ai < 2; ++ai)
#pragma unroll
            for (int m = 0; m < 4; ++m) { const size_t ro = (size_t)(row0 + ai * HALF + m * 16) * DM + col0;
                const u32x4 a = *(const u32x4*)(GA + ro), b = *(const u32x4*)(GB + ro);
#pragma unroll
                for (int bj = 0; bj < 2; ++bj) {
                    float sa[8], sb[8]; unpack8_fp8(bj ? (u32x2){a.z, a.w} : (u32x2){a.x, a.y}, sa); unpack8_fp8(bj ? (u32x2){b.z, b.w} : (u32x2){b.x, b.y}, sb);
#pragma unroll
                    for (int n = 0; n < 2; ++n)
#pragma unroll
                        for (int j = 0; j < 4; ++j) acc[ai][bj][m][n][j] *= sa[4 * n + j] * __builtin_amdgcn_rcpf(fmaxf(sb[4 * n + j], 1e-12f));
                } }
    }
    __device__ __forceinline__ void operator()(AccRef acc, const Unit& u, int wr, int wc, int fr_, int fq_) const {
        int fr = fr_, fq = fq_; asm volatile("" : "+v"(fr), "+v"(fq));
        const int row0 = u.pm * BM + wr * 64 + fr, col0 = u.pn * BM + wc * 64 + 16 * fq;
#pragma unroll
        for (int ai = 0; ai < 2; ++ai)
#pragma unroll
            for (int m = 0; m < 4; ++m) { const size_t ro = (size_t)(row0 + ai * HALF + m * 16) * DM + col0;
                const u32x4 b = *(const u32x4*)(GB + ro); u32x4 w;
#pragma unroll
                for (int bj = 0; bj < 2; ++bj) {
                    float sb[8]; unpack8_fp8(bj ? (u32x2){b.z, b.w} : (u32x2){b.x, b.y}, sb);
                    f32x4 v0 = acc[ai][bj][m][0], v1 = acc[ai][bj][m][1];
                    constexpr float CS = A8I * W8I * A8S;
#pragma unroll
                    for (int j = 0; j < 4; ++j) { v0[j] *= fmaxf(sb[j], 1e-12f) * CS; v1[j] *= fmaxf(sb[4 + j], 1e-12f) * CS; }
                    const unsigned lo = pack4_fp8(v0[0], v0[1], v0[2], v0[3]), hi = pack4_fp8(v1[0], v1[1], v1[2], v1[3]);
                    if (bj == 0) { w.x = lo; w.y = hi; } else { w.z = lo; w.w = hi; } }
                *(u32x4*)((unsigned char*)MG + ro) = w; }
    }
};

struct EpiResidB {
    static constexpr bool PERM = true, MIDK = false;
    const float* Xf; const bf16_t* Xb; bf16_t* O; const float* gate;
    __device__ __forceinline__ void operator()(AccRef acc, const Unit& u, int wr, int wc, int fr_, int fq_) const {
        int fr = fr_, fq = fq_; asm volatile("" : "+v"(fr), "+v"(fq));
        const int row0 = u.pm * BM + wr * 64 + fr, col0 = u.pn * BM + wc * 64 + 16 * fq; const int b = (u.pm * BM) >> 11;
        f32x4 gt[2][2];
#pragma unroll
        for (int bj = 0; bj < 2; ++bj)
#pragma unroll
            for (int n = 0; n < 2; ++n) gt[bj][n] = *(const f32x4*)(gate + (size_t)b * MODW + col0 + 8 * bj + 4 * n) * (A8I * W8I);
#pragma unroll
        for (int ai = 0; ai < 2; ++ai)
#pragma unroll
            for (int m = 0; m < 4; ++m) { const size_t ro = (size_t)(row0 + ai * HALF + m * 16) * DM + col0;
#pragma unroll
                for (int bj = 0; bj < 2; ++bj) {
                    f32x4 x0, x1;
                    if (Xf) { x0 = *(const f32x4*)(Xf + ro + 8 * bj); x1 = *(const f32x4*)(Xf + ro + 8 * bj + 4); }
                    else { const u32x4 w = *(const u32x4*)(Xb + ro + 8 * bj); x0 = (f32x4){bf_lo(w.x), bf_hi(w.x), bf_lo(w.y), bf_hi(w.y)}; x1 = (f32x4){bf_lo(w.z), bf_hi(w.z), bf_lo(w.w), bf_hi(w.w)}; }
                    *(u32x4*)(O + ro + 8 * bj) = pack8(x0 + gt[bj][0] * acc[ai][bj][m][0], x1 + gt[bj][1] * acc[ai][bj][m][1]); } }
    }
};

struct EpiSwiGLU {
    static constexpr bool PERM = true, MIDK = false;
    bf16_t* ACT;
    float cs;
    __device__ __forceinline__ void operator()(AccRef acc, const Unit& u, int wr, int wc, int fr_, int fq_) const {
        int fr = fr_, fq = fq_; asm volatile("" : "+v"(fr), "+v"(fq));
        const int row0 = u.pm * BM + wr * 64 + fr, col0 = (u.pn & 3) * HALF + wc * 32 + 8 * fq;
#pragma unroll
        for (int ai = 0; ai < 2; ++ai)
#pragma unroll
            for (int m = 0; m < 4; ++m) { f32x4 r[2];
#pragma unroll
                for (int n = 0; n < 2; ++n)
#pragma unroll
                    for (int j = 0; j < 4; ++j) { const float gg = acc[ai][0][m][n][j] * cs, uu = acc[ai][1][m][n][j] * (DN_F8 ? cs * A8S : cs); r[n][j] = gg * sigmoid_f(gg) * uu; }
                if (DN_F8) *(u32x2*)((unsigned char*)ACT + (size_t)(row0 + ai * HALF + m * 16) * DFF + col0) = (u32x2){pack4_fp8(r[0][0], r[0][1], r[0][2], r[0][3]), pack4_fp8(r[1][0], r[1][1], r[1][2], r[1][3])};
                else *(u32x4*)(ACT + (size_t)(row0 + ai * HALF + m * 16) * DFF + col0) = pack8(r[0], r[1]); }
    }
};

struct EpiY {
    static constexpr bool PERM = true, MIDK = false;
    unsigned char* Y;
    __device__ __forceinline__ void operator()(AccRef acc, const Unit& u, int wr, int wc, int fr_, int fq_) const {
        int fr = fr_, fq = fq_; asm volatile("" : "+v"(fr), "+v"(fq));
        const int row0 = u.pm * BM + wr * 64 + fr, col0 = (u.pn & 3) * BM + wc * 64 + 16 * fq;
#pragma unroll
        for (int ai = 0; ai < 2; ++ai)
#pragma unroll
            for (int m = 0; m < 4; ++m) { u32x4 w;
                constexpr float CS = DN_F8 ? A8I * W8I : 1.0f;
                { const f32x4 a = acc[ai][0][m][0] * CS, b = acc[ai][0][m][1] * CS; w.x = pack4_fp8(a[0], a[1], a[2], a[3]); w.y = pack4_fp8(b[0], b[1], b[2], b[3]); }
                { const f32x4 a = acc[ai][1][m][0] * CS, b = acc[ai][1][m][1] * CS; w.z = pack4_fp8(a[0], a[1], a[2], a[3]); w.w = pack4_fp8(b[0], b[1], b[2], b[3]); }
                *(u32x4*)(Y + (size_t)(row0 + ai * HALF + m * 16) * DM + col0) = w; }
    }
};
}

__device__ __forceinline__ int dimA(int bj, int r) { return r < 8 ? r + 8 * bj : 16 + (r - 8) + 24 * bj; }
__device__ __forceinline__ int dimB(int bj, int r) { return r < 16 ? r + 16 * bj : 32 + (r - 16) + 16 * bj; }
__device__ __forceinline__ int inproj_srccol(int P) {
    const int pn = P >> 8, p = P & 255, bj = p >> 7, wc = (p >> 5) & 3, r = p & 31;
    if (pn < 2) return 64 * (4 * pn + wc) + dimA(bj, r);
    if (pn < 4) return 512 + 64 * (4 * (pn - 2) + wc) + dimA(bj, r);
    if (pn < 6) return 1024 + 256 * (pn - 4) + 64 * wc + 16 * ((p >> 3) & 3) + 8 * bj + (p & 7);
    if (pn < 8) return 1536 + 64 * (4 * (pn - 6) + wc) + dimB(bj, r);
    if (pn == 8) return wc < 2 ? 2048 + 64 * wc + dimB(bj, r) : 2176 + 64 * (wc - 2) + 16 * ((p >> 3) & 3) + 8 * bj + (p & 7);
    { const int fq = (p >> 3) & 3, r8 = p & 7; return 2304 + 256 * (pn - 9) + 64 * wc + 16 * fq + 8 * bj + r8; }
}

namespace att {
constexpr int KSTR = 80, VSTR = 192;
constexpr int KTILE = 64 * KSTR, VTILE = 64 * VSTR;
constexpr int K_OFF = 0, V_OFF = 2 * KTILE;
constexpr int PRIV_OFF = 0;
__device__ __forceinline__ s16x4 vtr(LAS const char* p) { typedef short v4i16_t __attribute__((ext_vector_type(4)));
    return __builtin_bit_cast(s16x4, __builtin_amdgcn_ds_read_tr16_b64_v4i16((LAS v4i16_t*)p)); }
__device__ __forceinline__ u32x4 fp8x8_to_bf16(u32x2 w) { float f[8]; unpack8_fp8(w, f); u32x4 o; o.x = cvt_pk_bf16(f[0], f[1]); o.y = cvt_pk_bf16(f[2], f[3]); o.z = cvt_pk_bf16(f[4], f[5]); o.w = cvt_pk_bf16(f[6], f[7]); return o; }
__device__ __forceinline__ int clamp_tok(int t) { return t < 0 ? 0 : (t > SEQ - 1 ? SEQ - 1 : t); }

__device__ __forceinline__ long mk64(unsigned lo, unsigned hi) { return (long)(((unsigned long long)hi << 32) | lo); }
__device__ __forceinline__ void qk_tile(f32x16& p0, f32x16& p1, const u32x4 (&kf)[2][2], const u32x4 (&qr)[2]) {
    const f32x16 z = {0.f, 0.f, 0.f, 0.f, 0.f, 0.f, 0.f, 0.f, 0.f, 0.f, 0.f, 0.f, 0.f, 0.f, 0.f, 0.f};
    p0 = __builtin_amdgcn_mfma_f32_32x32x16_fp8_fp8(mk64(kf[0][0].x, kf[0][0].y), mk64(qr[0].x, qr[0].y), z, 0, 0, 0);
    p1 = __builtin_amdgcn_mfma_f32_32x32x16_fp8_fp8(mk64(kf[1][0].x, kf[1][0].y), mk64(qr[0].x, qr[0].y), z, 0, 0, 0);
    p0 = __builtin_amdgcn_mfma_f32_32x32x16_fp8_fp8(mk64(kf[0][0].z, kf[0][0].w), mk64(qr[0].z, qr[0].w), p0, 0, 0, 0);
    p1 = __builtin_amdgcn_mfma_f32_32x32x16_fp8_fp8(mk64(kf[1][0].z, kf[1][0].w), mk64(qr[0].z, qr[0].w), p1, 0, 0, 0);
    p0 = __builtin_amdgcn_mfma_f32_32x32x16_fp8_fp8(mk64(kf[0][1].x, kf[0][1].y), mk64(qr[1].x, qr[1].y), p0, 0, 0, 0);
    p1 = __builtin_amdgcn_mfma_f32_32x32x16_fp8_fp8(mk64(kf[1][1].x, kf[1][1].y), mk64(qr[1].x, qr[1].y), p1, 0, 0, 0);
    p0 = __builtin_amdgcn_mfma_f32_32x32x16_fp8_fp8(mk64(kf[0][1].z, kf[0][1].w), mk64(qr[1].z, qr[1].w), p0, 0, 0, 0);
    p1 = __builtin_amdgcn_mfma_f32_32x32x16_fp8_fp8(mk64(kf[1][1].z, kf[1][1].w), mk64(qr[1].z, qr[1].w), p1, 0, 0, 0);
}
template <bool MASK>
__device__ __forceinline__ void exp_tile(const f32x16& p0, const f32x16& p1, float& lsum, bf16x8 (&pf)[2][2], int mbase, int mR, int dk) {
    float e0[16], e1[16]; float ls = 0.f;
#pragma unroll
    for (int r = 0; r < 16; ++r) {
        e0[r] = __builtin_amdgcn_exp2f(p0[r]); e1[r] = __builtin_amdgcn_exp2f(p1[r]);
        if (MASK) {
            const int c0 = (r & 3) + 8 * (r >> 2);
            e0[r] = ((unsigned)(mbase + dk * c0) <= (unsigned)mR) ? e0[r] : 0.f;
            e1[r] = ((unsigned)(mbase + dk * (c0 + 32)) <= (unsigned)mR) ? e1[r] : 0.f;
        }
        ls += e0[r] + e1[r];
    }
    lsum += ls;
#pragma unroll
    for (int s = 0; s < 2; ++s) {
        u32x4 w0, w1;
        w0.x = cvt_pk_bf16(e0[8 * s + 0], e0[8 * s + 1]); w0.y = cvt_pk_bf16(e0[8 * s + 2], e0[8 * s + 3]); w0.z = cvt_pk_bf16(e0[8 * s + 4], e0[8 * s + 5]); w0.w = cvt_pk_bf16(e0[8 * s + 6], e0[8 * s + 7]);
        w1.x = cvt_pk_bf16(e1[8 * s + 0], e1[8 * s + 1]); w1.y = cvt_pk_bf16(e1[8 * s + 2], e1[8 * s + 3]); w1.z = cvt_pk_bf16(e1[8 * s + 4], e1[8 * s + 5]); w1.w = cvt_pk_bf16(e1[8 * s + 6], e1[8 * s + 7]);
        pf[0][s] = __builtin_bit_cast(bf16x8, w0); pf[1][s] = __builtin_bit_cast(bf16x8, w1);
    }
}
__device__ __forceinline__ void vread(bf16x8 (&vf)[4], LAS const char* vb, int d0) {
#pragma unroll
    for (int blk = 0; blk < 2; ++blk)
#pragma unroll
        for (int s = 0; s < 2; ++s) {
            const s16x4 lo = vtr(vb + (32 * blk + 16 * s) * VSTR + 64 * d0), hi = vtr(vb + (32 * blk + 16 * s + 8) * VSTR + 64 * d0);
            vf[2 * blk + s] = (bf16x8){lo[0], lo[1], lo[2], lo[3], hi[0], hi[1], hi[2], hi[3]};
        }
}
__device__ __forceinline__ void pv_half(f32x16& od, const bf16x8 (&vf)[4], const bf16x8 (&pf)[2][2]) {
#pragma unroll
    for (int blk = 0; blk < 2; ++blk)
#pragma unroll
        for (int s = 0; s < 2; ++s) od = __builtin_amdgcn_mfma_f32_32x32x16_bf16(vf[2 * blk + s], pf[blk][s], od, 0, 0, 0);
}
__device__ __forceinline__ void mask_params(int dk, int tk0, int tq, int hi, int& mbase, int& mR) {
    const int dlo = (-64 * dk > -tq) ? -64 * dk : -tq, dhi = (64 * dk < SEQ - 1 - tq) ? 64 * dk : SEQ - 1 - tq;
    const int dA = tk0 + 4 * dk * hi - tq;
    mR = dhi - dlo; mbase = ((dA & (dk - 1)) == 0) ? dA - dlo : 0x7fffffff;
}

template <bool MASKED>
__device__ __forceinline__ void dense64_loop(LAS char* lds, const unsigned char* Kg, const unsigned char* Vg, int ld  , int tok0, int ntiles,
                                             const u32x4 (&qr)[2][2], f32x16 (&o)[2][2], float (&lsum)[2], int tq0, int tq1, int lane_, int wave) {
    constexpr int V2_OFF = 2 * KTILE;
    u32x2 kreg, vreg;
#define D64_LANE() int ln_ = lane_; asm volatile("" : "+v"(ln_)); const int tid_ = wave * 64 + ln_, srow = tid_ >> 3, sch = tid_ & 7
#define D64_LD(t) do { D64_LANE(); int tk_ = tok0 + 64 * (t) + srow; if (MASKED) tk_ = clamp_tok(tk_); kreg = *(const u32x2*)(Kg + (size_t)tk_ * ld + sch * 8); vreg = *(const u32x2*)(Vg + (size_t)tk_ * ld + sch * 8); } while (0)
#define D64_ST(t) do { D64_LANE(); *(LAS u32x2*)(lds + ((t) & 1) * KTILE + srow * KSTR + sch * 8) = kreg; *(LAS u32x4*)(lds + V2_OFF + ((t) & 1) * VTILE + srow * VSTR + sch * 16) = fp8x8_to_bf16(vreg); } while (0)
    D64_LD(0); D64_ST(0); D64_LD(1);
    for (int t = 0; t < ntiles; ++t) {
        __syncthreads();
        if (t + 1 < ntiles) D64_ST(t + 1);
        if (t + 2 < ntiles) D64_LD(t + 2);
        int lane = lane_; asm volatile("" : "+v"(lane));
        const int hi = lane >> 5;
        const int vlane = (4 * hi + ((lane & 15) >> 2)) * VSTR + (16 * ((lane >> 4) & 1) + 4 * (lane & 3)) * 2;
        const int klane = (lane & 31) * KSTR + 32 * hi;
        u32x4 kf[2][2];
        { LAS const char* kb_ = lds + (t & 1) * KTILE + klane;
#pragma unroll
          for (int blk = 0; blk < 2; ++blk)
#pragma unroll
              for (int e = 0; e < 2; ++e) kf[blk][e] = *(const LAS u32x4*)(kb_ + 32 * blk * KSTR + 16 * e); }
        f32x16 p[2][2];
        bf16x8 vfa[4], vfb[4];
        LAS const char* vb_ = lds + V2_OFF + (t & 1) * VTILE + vlane;
        vread(vfa, vb_, 0); vread(vfb, vb_, 1);
        __builtin_amdgcn_sched_barrier(0);
        qk_tile(p[0][0], p[0][1], kf, qr[0]);
        qk_tile(p[1][0], p[1][1], kf, qr[1]);
#pragma unroll
        for (int g = 0; g < 2; ++g) {
            bf16x8 pf[2][2]; int mb = 0, mr = 0;
            if (MASKED) mask_params(1, tok0 + 64 * t, g ? tq1 : tq0, hi, mb, mr);
            exp_tile<MASKED>(p[g][0], p[g][1], lsum[g], pf, mb, mr, 1);
            pv_half(o[g][0], vfa, pf); pv_half(o[g][1], vfb, pf);
        }
    }
#undef D64_LANE
#undef D64_LD
#undef D64_ST
}
__device__ __forceinline__ void dense64_lag_loop(LAS char* lds, const unsigned char* Kg, const unsigned char* Vg, int ld  , int ntiles,
                                                 const u32x4 (&qr)[2][2], f32x16 (&o)[2][2], float (&lsum)[2], int lane_, int wave, const bool lag) {
    constexpr int V2_OFF = 2 * KTILE;
    u32x2 kreg, vreg;
#define D64_LANE() int ln_ = lane_; asm volatile("" : "+v"(ln_)); const int tid_ = wave * 64 + ln_, srow = tid_ >> 3, sch = tid_ & 7
#define D64_LD(t) do { D64_LANE(); const int tk_ = 64 * (t) + srow; kreg = *(const u32x2*)(Kg + (size_t)tk_ * ld + sch * 8); vreg = *(const u32x2*)(Vg + (size_t)tk_ * ld + sch * 8); } while (0)
#define D64_ST(t) do { D64_LANE(); *(LAS u32x2*)(lds + ((t) & 1) * KTILE + srow * KSTR + sch * 8) = kreg; *(LAS u32x4*)(lds + V2_OFF + ((t) % 3) * VTILE + srow * VSTR + sch * 16) = fp8x8_to_bf16(vreg); } while (0)
#define D64_QK(t) do { int lane = lane_; asm volatile("" : "+v"(lane)); const int klane = (lane & 31) * KSTR + 32 * (lane >> 5); u32x4 kf[2][2]; LAS const char* kb_ = lds + ((t) & 1) * KTILE + klane; \
        _Pragma("unroll") for (int blk = 0; blk < 2; ++blk) _Pragma("unroll") for (int e = 0; e < 2; ++e) kf[blk][e] = *(const LAS u32x4*)(kb_ + 32 * blk * KSTR + 16 * e); \
        qk_tile(p[0][0], p[0][1], kf, qr[0]); qk_tile(p[1][0], p[1][1], kf, qr[1]); } while (0)
#define D64_PV(t) do { int lane = lane_; asm volatile("" : "+v"(lane)); const int hi = lane >> 5; const int vlane = (4 * hi + ((lane & 15) >> 2)) * VSTR + (16 * ((lane >> 4) & 1) + 4 * (lane & 3)) * 2; \
        bf16x8 vfa[4], vfb[4]; LAS const char* vb_ = lds + V2_OFF + ((t) % 3) * VTILE + vlane; vread(vfa, vb_, 0); vread(vfb, vb_, 1); \
        _Pragma("unroll") for (int g = 0; g < 2; ++g) { bf16x8 pf[2][2]; exp_tile<false>(p[g][0], p[g][1], lsum[g], pf, 0, 0, 0); pv_half(o[g][0], vfa, pf); pv_half(o[g][1], vfb, pf); } } while (0)
    f32x16 p[2][2];
    D64_LD(0); D64_ST(0);
    if (!lag) {
        D64_LD(1);
        for (int t = 0; t < ntiles; ++t) {
            __syncthreads();
            if (t + 1 < ntiles) D64_ST(t + 1);
            if (t + 2 < ntiles) D64_LD(t + 2);
            D64_QK(t);
            D64_PV(t);
        }
        __syncthreads();
    } else {
        D64_LD(1);
        __syncthreads();
        D64_ST(1); D64_LD(2);
        D64_QK(0);
        for (int t = 1; t < ntiles; ++t) {
            __syncthreads();
            if (t + 1 < ntiles) D64_ST(t + 1);
            if (t + 2 < ntiles) D64_LD(t + 2);
            D64_PV(t - 1);
            __builtin_amdgcn_sched_barrier(0);
            D64_QK(t);
        }
        __syncthreads();
        D64_PV(ntiles - 1);
    }
#undef D64_LANE
#undef D64_LD
#undef D64_ST
#undef D64_QK
#undef D64_PV
}
__device__ __forceinline__ void priv_kload(u32x4 (&kf)[2][2], const unsigned char* Kg, int ld, int tk0, int dk, int lane_) {
    int lane = lane_; asm volatile("" : "+v"(lane));
    const int hi = lane >> 5;
#pragma unroll
    for (int blk = 0; blk < 2; ++blk) { const int tk = clamp_tok(tk0 + dk * (32 * blk + (lane & 31)));
#pragma unroll
        for (int e = 0; e < 2; ++e) kf[blk][e] = *(const u32x4*)(Kg + (size_t)tk * ld + 32 * hi + 16 * e); }
}
__device__ __forceinline__ void priv2_step(u32x4 (&kf)[2][2], LAS char* vpriv, const unsigned char* Kg, const unsigned char* Vg, int ld, int tk0, int dk, bool g0, bool g1,
                                           bool has_next, int tk0n, int dkn, const u32x4 (&qr)[2][2], f32x16 (&o)[2][2], float (&lsum)[2], int tq0, int tq1, int lane_) {
    int lane = lane_; asm volatile("" : "+v"(lane));
    const int hi = lane >> 5;
    const int vlane = (4 * hi + ((lane & 15) >> 2)) * VSTR + (16 * ((lane >> 4) & 1) + 4 * (lane & 3)) * 2;
    u32x2 vr[8];
#pragma unroll
    for (int i = 0; i < 8; ++i) { const int idx = i * 64 + lane, row = idx >> 3, ch = idx & 7; const int tk = clamp_tok(tk0 + dk * row); vr[i] = *(const u32x2*)(Vg + (size_t)tk * ld + ch * 8); }
    const int gfirst = g0 ? 0 : 1, glast = g1 ? 1 : 0;
    f32x16 p0, p1; bf16x8 pf[2][2]; int mb, mr;
    if (gfirst == 0) qk_tile(p0, p1, kf, qr[0]); else qk_tile(p0, p1, kf, qr[1]);
    __builtin_amdgcn_sched_barrier(0);
#pragma unroll
    for (int i = 0; i < 8; ++i) { const int idx = i * 64 + lane; *(LAS u32x4*)(vpriv + (idx >> 3) * VSTR + (idx & 7) * 16) = fp8x8_to_bf16(vr[i]); }
    if (glast == gfirst) { __builtin_amdgcn_sched_barrier(0); if (has_next) priv_kload(kf, Kg, ld, tk0n, dkn, lane); __builtin_amdgcn_sched_barrier(0); }
    mask_params(dk, tk0, gfirst ? tq1 : tq0, hi, mb, mr);
    if (gfirst == 0) exp_tile<true>(p0, p1, lsum[0], pf, mb, mr, dk); else exp_tile<true>(p0, p1, lsum[1], pf, mb, mr, dk);
    { bf16x8 vfa[4], vfb[4]; vread(vfa, vpriv + vlane, 0); vread(vfb, vpriv + vlane, 1);
      if (gfirst == 0) { pv_half(o[0][0], vfa, pf); pv_half(o[0][1], vfb, pf); } else { pv_half(o[1][0], vfa, pf); pv_half(o[1][1], vfb, pf); } }
    if (glast != gfirst) {
        qk_tile(p0, p1, kf, qr[1]);
        __builtin_amdgcn_sched_barrier(0);
        if (has_next) priv_kload(kf, Kg, ld, tk0n, dkn, lane);
        __builtin_amdgcn_sched_barrier(0);
        mask_params(dk, tk0, tq1, hi, mb, mr);
        exp_tile<true>(p0, p1, lsum[1], pf, mb, mr, dk);
        bf16x8 vfa[4], vfb[4]; vread(vfa, vpriv + vlane, 0); vread(vfb, vpriv + vlane, 1);
        pv_half(o[1][0], vfa, pf); pv_half(o[1][1], vfb, pf);
    }
}
__device__ __forceinline__ void store_out(const f32x16 (&o)[2], float lsum, unsigned char* dst  , int lane_) {
    int lane = lane_; asm volatile("" : "+v"(lane));
    const int hi = lane >> 5;
    float l = lsum + shx(lsum, 32, lane);
    const float inv = A8S / l;
#pragma unroll
    for (int d0 = 0; d0 < 2; ++d0) {
        unsigned pc[4];
#pragma unroll
        for (int g = 0; g < 4; ++g) pc[g] = pack4_fp8(o[d0][4 * g] * inv, o[d0][4 * g + 1] * inv, o[d0][4 * g + 2] * inv, o[d0][4 * g + 3] * inv);
        const auto s0 = __builtin_amdgcn_permlane32_swap(pc[0], pc[2], false, false), s1 = __builtin_amdgcn_permlane32_swap(pc[1], pc[3], false, false);
        u32x4 w; w.x = s0[0]; w.y = s0[1]; w.z = s1[0]; w.w = s1[1];
        *(u32x4*)(dst + 32 * d0 + 16 * hi) = w;
    }
}
}

struct Args { const float* in[18]; float* out; unsigned char* ws; int ph_lo, ph_hi; };
constexpr int PH_PRO = 0, PH_L0 = 1, PH_PER_LAYER = 9, PH_FINAL = PH_L0 + 2 * PH_PER_LAYER, NPH = PH_FINAL + 1;
enum { P_NORM1 = 0, P_INPROJ, P_ATTN, P_PAB, P_OUT, P_NORM2, P_PLACE, P_GU, P_DOWN };

__device__ __forceinline__ int tile256_srccol(int P) { const int p = P & 255; return (P & ~255) + 64 * ((p >> 5) & 3) + 16 * ((p >> 3) & 3) + 8 * (p >> 7) + (p & 7); }
template <int MAP, bool W8 = false>
__device__ __forceinline__ void transpose_item(const float* W, int N, int col0, bf16_t* dst, int dst_row0, int K, int k0, LAS float* scr, int lane, int dk0 = 0  ) {
    const int sc = (MAP == 1) ? inproj_srccol(col0 + lane) : (MAP == 2) ? tile256_srccol(col0 + lane) : col0 + lane;
    const float* src = W + (size_t)k0 * N + sc;
#pragma unroll 16
    for (int i = 0; i < 64; ++i) scr[i * 65 + lane] = src[(size_t)i * N];
    asm volatile("s_waitcnt lgkmcnt(0)" ::: "memory");
    const int c = lane & 7, nn = lane >> 3;
#pragma unroll
    for (int j = 0; j < 8; ++j) { const int n = nn + 8 * j; const LAS float* s = scr + (8 * c) * 65 + n;
        if (W8) { u32x2 w; w.x = pack4_fp8(s[0] * W8S, s[65] * W8S, s[2 * 65] * W8S, s[3 * 65] * W8S); w.y = pack4_fp8(s[4 * 65] * W8S, s[5 * 65] * W8S, s[6 * 65] * W8S, s[7 * 65] * W8S);
            *(u32x2*)((unsigned char*)dst + (size_t)(dst_row0 + n) * K + dk0 + k0 + 8 * c) = w; continue; }
        u32x4 w; w.x = cvt_pk_bf16(s[0], s[65]); w.y = cvt_pk_bf16(s[2 * 65], s[3 * 65]); w.z = cvt_pk_bf16(s[4 * 65], s[5 * 65]); w.w = cvt_pk_bf16(s[6 * 65], s[7 * 65]);
        *(u32x4*)(dst + (size_t)(dst_row0 + n) * K + dk0 + k0 + 8 * c) = w; }
    asm volatile("s_waitcnt lgkmcnt(0)" ::: "memory");
}


template <bool XF32, bool COMBINE, bool NORM, bool ROUTER, bool OUTF32, int H8 = 0  >
__device__ __forceinline__ void row_phase(LAS unsigned char* lds, int tid, int lane, int wave, int G, int bx, const float* xf, bf16_t* xb, float* outf, const float* gv,
                                          const float* modl, int sh_off, int sc_off, const float* modprev, bf16_t* Hh, const unsigned char* Ym, const int* Pos, float* Tw,
                                          const bf16_t* Wr, int* Te, int* Trk, int* Cnt, unsigned char* H8p = nullptr) {
    constexpr int RB = COMBINE ? 2 : ROWB;
    constexpr int RSTR = 2080;
    LAS unsigned char* wrl = lds;
    LAS unsigned char* atile = lds + 32 * RSTR + wave * (4 * RSTR);
    LAS float* lgw = (LAS float*)(lds + MISC_OFF + 2048) + wave * 132;
    LAS int* lcnt = (LAS int*)(lds + MISC_OFF + 1024);
    asm volatile("" : "+v"(tid), "+v"(lane));
    if (ROUTER) {
#pragma unroll
        for (int p = 0; p < 8; ++p) { const int idx = p * 512 + tid, row = idx >> 7, c16 = idx & 127; *(LAS u32x4*)(wrl + row * RSTR + c16 * 16) = *(const u32x4*)(Wr + (size_t)row * DM + c16 * 8); }
    }
    for (int chunk = bx; chunk < 256; chunk += G) {
        const int b = chunk >> 3;
        if (ROUTER) { if (tid < 32) lcnt[tid] = 0; __syncthreads(); }
        f32x4 pre[4], shv[4], g2[4];
#pragma unroll
        for (int j = 0; j < 4; ++j) { const int col = 512 * (j >> 1) + 8 * lane + 4 * (j & 1);
            if (NORM) { const f32x4 gg = *(const f32x4*)(gv + col), sc = *(const f32x4*)(modl + (size_t)b * MODW + sc_off + col);
                pre[j] = gg * (1.0f + sc); shv[j] = *(const f32x4*)(modl + (size_t)b * MODW + sh_off + col); }
            if (COMBINE) g2[j] = *(const f32x4*)(modprev + (size_t)b * MODW + 5 * DM + col); }
        f32x4 rawf[XF32 ? RB : 1][4]; u32x4 rawb[XF32 ? 1 : RB][2]; int pp[COMBINE ? RB : 1][2]; float pw[COMBINE ? RB : 1][2];
#define ROW_LOAD(rb_) do { _Pragma("unroll") for (int i = 0; i < RB; ++i) { const size_t ro = (size_t)((rb_) + i) * DM; \
            if (XF32) { _Pragma("unroll") for (int j = 0; j < 4; ++j) rawf[XF32 ? i : 0][j] = *(const f32x4*)(xf + ro + 512 * (j >> 1) + 8 * lane + 4 * (j & 1)); } \
            else { _Pragma("unroll") for (int h = 0; h < 2; ++h) rawb[XF32 ? 0 : i][h] = *(const u32x4*)(xb + ro + 512 * h + 8 * lane); } \
            if (COMBINE) { pp[COMBINE ? i : 0][0] = Pos[2 * ((rb_) + i)]; pp[COMBINE ? i : 0][1] = Pos[2 * ((rb_) + i) + 1]; pw[COMBINE ? i : 0][0] = Tw[2 * ((rb_) + i)]; pw[COMBINE ? i : 0][1] = Tw[2 * ((rb_) + i) + 1]; } } } while (0)
        ROW_LOAD(chunk * 256 + wave * 32);
#pragma unroll 1
        for (int r0 = 0; r0 < 32; r0 += RB) {
            const int rowb = chunk * 256 + wave * 32 + r0;
            f32x4 v[RB][4]; int cp[COMBINE ? RB : 1][2]; float cw[COMBINE ? RB : 1][2];
#pragma unroll
            for (int i = 0; i < RB; ++i) {
                if (XF32) {
#pragma unroll
                    for (int j = 0; j < 4; ++j) v[i][j] = rawf[XF32 ? i : 0][j];
                } else {
#pragma unroll
                    for (int h = 0; h < 2; ++h) { const u32x4 w = rawb[XF32 ? 0 : i][h];
                        v[i][2 * h] = (f32x4){bf_lo(w.x), bf_hi(w.x), bf_lo(w.y), bf_hi(w.y)}; v[i][2 * h + 1] = (f32x4){bf_lo(w.z), bf_hi(w.z), bf_lo(w.w), bf_hi(w.w)}; }
                }
                if (COMBINE) { cp[i][0] = pp[i][0]; cp[i][1] = pp[i][1]; cw[i][0] = pw[i][0]; cw[i][1] = pw[i][1]; }
            }
            u32x2 ya[COMBINE ? RB : 1][2], yc[COMBINE ? RB : 1][2];
            if (COMBINE) {
#pragma unroll
                for (int i = 0; i < RB; ++i)
#pragma unroll
                    for (int h = 0; h < 2; ++h) { ya[i][h] = *(const u32x2*)(Ym + (size_t)cp[i][0] * DM + 512 * h + 8 * lane); yc[i][h] = *(const u32x2*)(Ym + (size_t)cp[i][1] * DM + 512 * h + 8 * lane); }
            }
            if (r0 + RB < 32) ROW_LOAD(rowb + RB);
            if (COMBINE) {
#pragma unroll
                for (int i = 0; i < RB; ++i) {
                    const int row = rowb + i; const float w0 = cw[i][0], w1 = cw[i][1];
#pragma unroll
                    for (int h = 0; h < 2; ++h) { float fa[8], fc[8]; unpack8_fp8(ya[i][h], fa); unpack8_fp8(yc[i][h], fc);
                        const f32x4 m0 = {w0 * fa[0] + w1 * fc[0], w0 * fa[1] + w1 * fc[1], w0 * fa[2] + w1 * fc[2], w0 * fa[3] + w1 * fc[3]};
                        const f32x4 m1 = {w0 * fa[4] + w1 * fc[4], w0 * fa[5] + w1 * fc[5], w0 * fa[6] + w1 * fc[6], w0 * fa[7] + w1 * fc[7]};
                        v[i][2 * h] = v[i][2 * h] + g2[2 * h] * m0; v[i][2 * h + 1] = v[i][2 * h + 1] + g2[2 * h + 1] * m1;
                        if (OUTF32) { *(f32x4*)(outf + (size_t)row * DM + 512 * h + 8 * lane) = v[i][2 * h]; *(f32x4*)(outf + (size_t)row * DM + 512 * h + 8 * lane + 4) = v[i][2 * h + 1]; }
                        else *(u32x4*)(xb + (size_t)row * DM + 512 * h + 8 * lane) = pg8::pack8(v[i][2 * h], v[i][2 * h + 1]); }
                }
            }
            if (NORM) {
                float ss[RB];
#pragma unroll
                for (int i = 0; i < RB; ++i) { ss[i] = 0.f;
#pragma unroll
                    for (int j = 0; j < 4; ++j) { const f32x4 q = v[i][j] * v[i][j]; ss[i] += (q[0] + q[1]) + (q[2] + q[3]); } }
#pragma unroll
                for (int o = 1; o < 64; o <<= 1)
#pragma unroll
                    for (int i = 0; i < RB; ++i) ss[i] += shx(ss[i], o, lane);
#pragma unroll
                for (int i = 0; i < RB; ++i) { const float rstd = __builtin_amdgcn_rsqf(ss[i] * (1.0f / DM) + 1e-6f);
#pragma unroll
                    for (int h = 0; h < 2; ++h) { const f32x4 h0 = v[i][2 * h] * rstd * pre[2 * h] + shv[2 * h], h1 = v[i][2 * h + 1] * rstd * pre[2 * h + 1] + shv[2 * h + 1];
                        if (H8 != 0) *(u32x2*)((H8 == 2 ? H8p : (unsigned char*)Hh) + (size_t)(rowb + i) * DM + 512 * h + 8 * lane) = (u32x2){pack4_fp8(h0[0], h0[1], h0[2], h0[3]), pack4_fp8(h1[0], h1[1], h1[2], h1[3])};
                        if (ROUTER) *(LAS u32x4*)(atile + i * RSTR + (512 * h + 8 * lane) * 2) = pg8::pack8(h0, h1);
                        else if (H8 != 1) *(u32x4*)(Hh + (size_t)(rowb + i) * DM + 512 * h + 8 * lane) = pg8::pack8(h0, h1); } }
                if (ROUTER) {
                    static_assert(!ROUTER || RB == 4, "the router batch is 4 rows");
                    asm volatile("s_waitcnt lgkmcnt(0)" ::: "memory");
                    f32x4 ra0 = {0.f, 0.f, 0.f, 0.f}, ra1 = {0.f, 0.f, 0.f, 0.f};
                    { int ln = lane; asm volatile("" : "+v"(ln));
                      LAS const unsigned char* ab = atile + (ln & 3) * RSTR + (ln >> 4) * 16;
                      LAS const unsigned char* bb = wrl + (ln & 15) * RSTR + (ln >> 4) * 16;
#pragma unroll 8
                      for (int kk = 0; kk < 32; ++kk) {
                          const bf16x8 a = *(const LAS bf16x8*)(ab + 64 * kk), b0 = *(const LAS bf16x8*)(bb + 64 * kk), b1 = *(const LAS bf16x8*)(bb + 16 * RSTR + 64 * kk);
                          ra0 = __builtin_amdgcn_mfma_f32_16x16x32_bf16(a, b0, ra0, 0, 0, 0); ra1 = __builtin_amdgcn_mfma_f32_16x16x32_bf16(a, b1, ra1, 0, 0, 0);
                      }
                      if (ln < 16) {
#pragma unroll
                          for (int r = 0; r < 4; ++r) { lgw[r * 33 + ln] = ra0[r]; lgw[r * 33 + 16 + ln] = ra1[r]; } }
                    }
                    asm volatile("s_waitcnt lgkmcnt(0)" ::: "memory");
                    { int ln = lane; asm volatile("" : "+v"(ln));
                      const int tk = (ln >> 2) & 3, g = ln & 3;
                      float m1 = -3.0e38f, m2 = -3.0e38f; int i1 = 0, i2 = 0;
#pragma unroll
                      for (int j = 0; j < 8; ++j) { const float vv = lgw[tk * 33 + 8 * g + j];
                          if (vv > m1) { m2 = m1; i2 = i1; m1 = vv; i1 = j; } else if (vv > m2) { m2 = vv; i2 = j; } }
                      float M = fmaxf(m1, shx(m1, 1, ln)); M = fmaxf(M, shx(M, 2, ln));
                      const float sc = expf(m1 - M) + expf(m2 - M);
                      const int base = ln & ~3;
                      const float s0 = __int_as_float(__builtin_amdgcn_ds_bpermute(base << 2, __float_as_int(sc))), s1 = __int_as_float(__builtin_amdgcn_ds_bpermute((base + 1) << 2, __float_as_int(sc))),
                                  s2 = __int_as_float(__builtin_amdgcn_ds_bpermute((base + 2) << 2, __float_as_int(sc))), s3 = __int_as_float(__builtin_amdgcn_ds_bpermute((base + 3) << 2, __float_as_int(sc)));
                      int bg = 0; float bs = s0; if (s1 > bs) { bs = s1; bg = 1; } if (s2 > bs) { bs = s2; bg = 2; } if (s3 > bs) { bs = s3; bg = 3; }
                      if (ln < 16 && g == bg) {
                          const int tok = rowb + tk, e0 = 8 * g + i1, e1 = 8 * g + i2;
                          const float w0 = 1.0f / (1.0f + expf(m2 - m1)), w1 = 1.0f - w0;
                          const int r0_ = __hip_atomic_fetch_add(&lcnt[e0], 1, __ATOMIC_RELAXED, __HIP_MEMORY_SCOPE_WORKGROUP);
                          const int r1_ = __hip_atomic_fetch_add(&lcnt[e1], 1, __ATOMIC_RELAXED, __HIP_MEMORY_SCOPE_WORKGROUP);
                          Te[2 * tok] = e0; Te[2 * tok + 1] = e1; Trk[2 * tok] = r0_; Trk[2 * tok + 1] = r1_; Tw[2 * tok] = w0; Tw[2 * tok + 1] = w1;
                      }
                    }
                }
            }
        }
#undef ROW_LOAD
        if (ROUTER) {
            __syncthreads();
            if (tid < 32) Cnt[chunk * 32 + tid] = lcnt[tid];
            __syncthreads();
        }
    }
}

#define x_in ((const float*)(const GAS float*)args.in[0])
#define c_in ((const float*)(const GAS float*)args.in[1])
#define w_ada ((const float*)(const GAS float*)args.in[2])
#define b_ada ((const float*)(const GAS float*)args.in[3])
#define g_mix ((const float*)(const GAS float*)args.in[4])
#define w_in ((const float*)(const GAS float*)args.in[5])
#define qn_a ((const float*)(const GAS float*)args.in[6])
#define kn_a ((const float*)(const GAS float*)args.in[7])
#define qn_b ((const float*)(const GAS float*)args.in[8])
#define kn_b ((const float*)(const GAS float*)args.in[9])
#define w_pa ((const float*)(const GAS float*)args.in[10])
#define w_pb ((const float*)(const GAS float*)args.in[11])
#define w_out ((const float*)(const GAS float*)args.in[12])
#define g_ffn ((const float*)(const GAS float*)args.in[13])
#define w_router ((const float*)(const GAS float*)args.in[14])
#define w_gate ((const float*)(const GAS float*)args.in[15])
#define w_up ((const float*)(const GAS float*)args.in[16])
#define w_down ((const float*)(const GAS float*)args.in[17])
#define MOD ((float*)(GAS float*)(ws + WS_MOD))
#define XB ((bf16_t*)(GAS bf16_t*)(ws + WS_XB))
#define TE ((int*)(GAS int*)(ws + WS_TE))
#define TRK ((int*)(GAS int*)(ws + WS_TRK))
#define TW ((float*)(GAS float*)(ws + WS_TW))
#define POS ((int*)(GAS int*)(ws + WS_POS))
#define CNT ((int*)(GAS int*)(ws + WS_CNT))
#define BLKE ((int*)(GAS int*)(ws + WS_BLKE))
#define BTOK ((int*)(GAS int*)(ws + WS_BTOK))
#define WR ((bf16_t*)(bf16_t*)(GAS bf16_t*)(ws + WS_WR))
#define H ((bf16_t*)(bf16_t*)(GAS bf16_t*)(ws + WS_H))
#define YAB ((bf16_t*)(GAS bf16_t*)(ws + WS_H))
#define YA ((bf16_t*)(bf16_t*)(GAS bf16_t*)(ws + WS_H))
#define YB ((bf16_t*)(bf16_t*)(GAS bf16_t*)(ws + WS_H + 64 * MiB))
#define QA ((bf16_t*)(bf16_t*)(GAS bf16_t*)(ws + WS_QKV))
#define KA ((bf16_t*)(bf16_t*)(GAS bf16_t*)(ws + WS_QKV + 64 * MiB))
#define VA ((bf16_t*)(bf16_t*)(GAS bf16_t*)(ws + WS_QKV + 128 * MiB))
#define QB ((bf16_t*)(bf16_t*)(GAS bf16_t*)(ws + WS_QKV + 192 * MiB))
#define KB ((bf16_t*)(bf16_t*)(GAS bf16_t*)(ws + WS_QKV + 256 * MiB))
#define VB ((bf16_t*)(bf16_t*)(GAS bf16_t*)(ws + WS_QKV + 272 * MiB))
#define MERGED ((bf16_t*)(bf16_t*)(GAS bf16_t*)(ws + WS_QKV))
#define YM ((unsigned char*)(GAS unsigned char*)(ws + WS_QKV))
#define H2F8 ((unsigned char*)(GAS unsigned char*)(ws + WS_QKV + 160 * MiB))
#define SA ((bf16_t*)(bf16_t*)(GAS bf16_t*)(ws + WS_GATE))
#define SB ((bf16_t*)(bf16_t*)(GAS bf16_t*)(ws + WS_GATE + 128 * MiB))
#define ACT ((bf16_t*)(bf16_t*)(GAS bf16_t*)(ws + WS_GATE))
#define PHASE_ENTER() int lane; asm volatile("v_mbcnt_lo_u32_b32 %0, -1, 0\n\tv_mbcnt_hi_u32_b32 %0, -1, %0" : "=v"(lane)); const int tid = wave * 64 + lane; GAS unsigned char* ws = ws0; int bx = bx0, vcu = vcu0; asm volatile("" : "+s"(ws), "+s"(bx), "+s"(vcu))

__device__ __forceinline__ bool in_phase(int lo, int hi, int k) { asm volatile("" : "+s"(lo), "+s"(hi)); return lo <= k && k < hi; }
#define PGATE_A SA
#define PGATE_B SB
__global__ void __launch_bounds__(512, 2) fwd_kernel(Args args) {
    extern __shared__ __attribute__((aligned(16))) unsigned char lds_raw[];
    LAS unsigned char* lds = (LAS unsigned char*)lds_raw;
    volatile LAS unsigned* MISC = (volatile LAS unsigned*)(lds + MISC_OFF);
    const int tid0 = threadIdx.x, lane0 = tid0 & 63, wave = __builtin_amdgcn_readfirstlane(tid0 >> 6);
    const int G = gridDim.x, bx0 = blockIdx.x;
    const int vcu0 = (G % 8 == 0) ? (bx0 % 8) * (G / 8) + bx0 / 8 : bx0;
    GAS unsigned char* ws0 = (GAS unsigned char*)args.ws;
    float* out = (float*)(GAS float*)args.out;
    for (int u = tid0; u < 256; u += 512) ((LAS unsigned*)(lds + MISC_OFF))[u] = 0u;
    __syncthreads();
#if MK_ONE_LAUNCH
    XcdBarrier bar = xcd_barrier_post((unsigned*)((GAS unsigned*)(ws0 + WS_CTL) + CW_BAR), MISC + 8);
#define GRID_BAR() do { int l_; asm volatile("v_mbcnt_lo_u32_b32 %0, -1, 0\n\tv_mbcnt_hi_u32_b32 %0, -1, %0" : "=v"(l_)); xcd_barrier(bar, (wave == 0) && (l_ == 0)); } while (0)
#else
#define GRID_BAR() do {} while (0)
#endif
#ifndef PHMASK
#define PHMASK 0xFFFFFFFFu
#endif
#if MK_ONE_LAUNCH
#define IN(k) true
#else
#define IN(k) in_phase(args.ph_lo, args.ph_hi, (k))
#endif
#define EN(bit) ((PHMASK >> (bit)) & 1u)
#define SEAM(k) do { if (IN(k) && IN((k) + 1)) GRID_BAR(); } while (0)

    if (EN(0) && IN(PH_PRO)) {
        PHASE_ENTER();
#pragma unroll 1
        for (int rep = 0; rep < REP_PRO; ++rep) {
        LAS float* scr = (LAS float*)(lds + wave * 16640);
        const int gw = vcu * 8 + wave, NGW = G * 8;
        constexpr int I_IN = 68 * 8, I_PA = 16 * 4, I_OUT = 16 * 8, I_GU = 32 * 2 * 8 * 8, I_DN = 32 * 16 * 4;
        constexpr int I_LAYER = I_IN + 2 * I_PA + I_OUT + I_GU + I_DN;
        auto decode = [&](int it, const float*& src, int& N, unsigned char*& dst, int& K, int& t256  ) {
            t256 = -1;
            const int l = it / I_LAYER; int r = it % I_LAYER;
            if (r < I_IN) { const int nb = r / 8, kb = r % 8; N = NC; K = DM;
                src = w_in + (size_t)l * DM * NC + (size_t)(128 * kb) * NC + inproj_srccol(64 * nb + lane);
                dst = (unsigned char*)(GAS unsigned char*)(ws + WS_WIN + l * WIN_BYTES) + (size_t)(64 * nb) * DM + 128 * kb; return; } r -= I_IN;
            if (r < 2 * I_PA) { const int pb_ = r / I_PA, q = r % I_PA, nb = q / 4, kb = q % 4; N = DM; K = DM;
                src = (pb_ ? w_pb : w_pa) + (size_t)l * 512 * DM + (size_t)(128 * kb) * DM + 64 * nb + lane; t256 = nb;
                dst = (unsigned char*)(GAS unsigned char*)(ws + WS_WPA + l * 2 * MiB) + 512 * pb_ + 128 * kb; return; } r -= 2 * I_PA;
            if (r < I_OUT) { const int nb = r / 8, kb = r % 8; N = DM; K = DM;
                src = w_out + (size_t)l * DM * DM + (size_t)(128 * kb) * DM + 64 * nb + lane; t256 = nb;
                dst = (unsigned char*)(GAS unsigned char*)(ws + WS_WOUT + l * 2 * MiB) + 128 * kb; return; } r -= I_OUT;
            if (r < I_GU) { const int e = r / 128, q = r % 128, up = q / 64, nb = (q % 64) / 8, kb = q % 8; N = DFF; K = DM;
                const int c0 = 64 * nb, drow = 256 * (c0 >> 7) + 128 * up + (c0 & 127);
                src = (up ? w_up : w_gate) + ((size_t)l * NEXP + e) * DM * DFF + (size_t)(128 * kb) * DFF + c0 + lane;
                dst = (unsigned char*)(GAS unsigned char*)(ws + WS_WGU + ((size_t)l * NEXP + e) * MiB) + (size_t)drow * DM + 128 * kb; return; } r -= I_GU;
            { const int e = r / 64, q = r % 64, nb = q / 4, kb = q % 4; N = DM; K = DFF;
                src = w_down + ((size_t)l * NEXP + e) * DFF * DM + (size_t)(128 * kb) * DM + 64 * nb + lane; t256 = nb;
                dst = (unsigned char*)(GAS unsigned char*)(ws + WS_WDN + ((size_t)l * NEXP + e) * (MiB / 2)) + 128 * kb; }
        };
        {
            LAS unsigned char* scr8 = (LAS unsigned char*)scr;
#pragma unroll 1
            for (int it = gw; it < 2 * I_LAYER; it += NGW) {
                const float* src; int N, K, t256; unsigned char* dst;
                decode(it, src, N, dst, K, t256);
                float v[128];
#pragma unroll
                for (int i = 0; i < 128; ++i) v[i] = src[(size_t)i * N];
#pragma unroll
                for (int q = 0; q < 8; ++q) { u32x4 w;
                    w.x = pack4_fp8(v[16 * q + 0] * W8S, v[16 * q + 1] * W8S, v[16 * q + 2] * W8S, v[16 * q + 3] * W8S); w.y = pack4_fp8(v[16 * q + 4] * W8S, v[16 * q + 5] * W8S, v[16 * q + 6] * W8S, v[16 * q + 7] * W8S);
                    w.z = pack4_fp8(v[16 * q + 8] * W8S, v[16 * q + 9] * W8S, v[16 * q + 10] * W8S, v[16 * q + 11] * W8S); w.w = pack4_fp8(v[16 * q + 12] * W8S, v[16 * q + 13] * W8S, v[16 * q + 14] * W8S, v[16 * q + 15] * W8S);
                    *(LAS u32x4*)(scr8 + lane * 144 + 16 * q) = w; }
                asm volatile("s_waitcnt lgkmcnt(0)" ::: "memory");
#pragma unroll
                for (int j = 0; j < 8; ++j) { const int r_ = 8 * j + (lane >> 3), c = lane & 7;
                    const u32x4 w = *(const LAS u32x4*)(scr8 + r_ * 144 + 16 * c);
                    const int drow = (t256 < 0) ? r_ : 256 * (t256 >> 2) + 128 * (j & 1) + 32 * (t256 & 3) + 8 * (j >> 1) + (lane >> 3);
                    *(u32x4*)(dst + (size_t)drow * K + 16 * c) = w; }
                asm volatile("s_waitcnt lgkmcnt(0)" ::: "memory");
            }
        }
        for (int i = (vcu * 512 + tid); i < 32 * DM; i += G * 512) { const int e = i >> 10, k = i & 1023; WR[i] = (bf16_t)(cvt_pk_bf16(w_router[(size_t)k * NEXP + e], 0.f) & 0xffffu); }
        __syncthreads();
        if (vcu < 192) {
            LAS float* cond = (LAS float*)lds;
            for (int i = tid; i < NB * DM; i += 512) { const int b = i >> 10, k = i & 1023; const float cv = c_in[i]; cond[k * 32 + b] = cv / (1.0f + expf(-cv)); }
            __syncthreads();
            const int T = 2 * vcu + (wave >> 2), kq = wave & 3;
            const int l = T / 192, n0 = (T % 192) * 32;
            const float* wp = w_ada + (size_t)l * DM * MODW + n0 + (lane & 31) + (size_t)(256 * kq + (lane >> 5)) * MODW;
            const LAS float* cp = cond + (256 * kq + (lane >> 5)) * 32 + (lane & 31);
            f32x16 acc;
#pragma unroll
            for (int r = 0; r < 16; ++r) acc[r] = 0.f;
#pragma unroll 16
            for (int k0 = 0; k0 < 256; k0 += 2) acc = __builtin_amdgcn_mfma_f32_32x32x2f32(cp[k0 * 32], wp[(size_t)k0 * MODW], acc, 0, 0, 0);
            __syncthreads();
            LAS float* part = (LAS float*)lds + wave * 1024;
#pragma unroll
            for (int r = 0; r < 16; ++r) part[r * 64 + lane] = acc[r];
            __syncthreads();
            if (kq == 0) {
                const float bias = b_ada[l * MODW + n0 + (lane & 31)];
#pragma unroll
                for (int r = 0; r < 16; ++r) { const int b = (r & 3) + 8 * (r >> 2) + 4 * (lane >> 5);
                    MOD[((size_t)l * NB + b) * MODW + n0 + (lane & 31)] = ((part[r * 64 + lane] + part[1024 + r * 64 + lane]) + (part[2048 + r * 64 + lane] + part[3072 + r * 64 + lane])) + bias; }
            }
        }
        __syncthreads();
        }
    }
    SEAM(PH_PRO);

    for (int l = 0; l < 2; ++l) {
        const int pb = PH_L0 + l * PH_PER_LAYER;
        if (EN(1) && IN(pb + P_NORM1)) { PHASE_ENTER(); const float* modl = MOD + (size_t)l * NB * MODW;
            if (l == 0) {
#pragma unroll 1
                for (int rep = 0; rep < REP_NORM1; ++rep)
                    row_phase<true, false, true, false, false, 1>(lds, tid, lane, wave, G, bx, x_in, XB, out, g_mix, modl, 0, DM, MOD, H, YM, POS, TW, WR, TE, TRK, CNT);
            } else row_phase<false, true, true, false, false, 1>(lds, tid, lane, wave, G, bx, x_in, XB, out, g_mix + DM, modl, 0, DM, MOD, H, YM, POS, TW, WR, TE, TRK, CNT); }
            {
                SEAM(pb + P_NORM1);
                if (EN(2) && IN(pb + P_INPROJ)) {
                    PHASE_ENTER();
                    pg8::Gemm g{H, (const bf16_t*)(const GAS bf16_t*)(ws + WS_WIN + l * WIN_BYTES), DM / 2}; pg8::StaticOrder S; S.init(TT, NC, G, bx); S.wgm = INPROJ_WGM;
                    LAS float* normw = (LAS float*)(lds + MISC_OFF + 1024);
                    if (tid < 256) { const int sel = tid >> 6, d = tid & 63; const float* srcw = (sel == 0) ? qn_a : (sel == 1) ? kn_a : (sel == 2) ? qn_b : kn_b; normw[tid] = srcw[l * 64 + d]; }
                    __syncthreads();
                    pg8::EpiInProj E{QA, KA, VA, QB, KB, VB, SA, SB, normw};
#pragma unroll 1
                    for (int rep = 0; rep < REP_INPROJ; ++rep)
                    pg8::gemm_phase<pg8::EpiInProj, pg8::StaticOrder, true>(lds, g, S, E, wave);
                }
                SEAM(pb + P_INPROJ);
                if (EN(3) && IN(pb + P_ATTN)) {
                    PHASE_ENTER(); (void)lane;
                    LAS char* ring = (LAS char*)lds;
#pragma unroll 1
                    for (int rep = 0; rep < REP_ATTB; ++rep)
                    for (int L = vcu; L < NB * 32; L += G) {
                        int lane; asm volatile("v_mbcnt_lo_u32_b32 %0, -1, 0\n\tv_mbcnt_hi_u32_b32 %0, -1, %0" : "=v"(lane)); const int hi = lane >> 5;
                        const int b = L >> 5, kvh = (L >> 4) & 1, qh = 4 * kvh + ((L >> 2) & 3), qb2 = L & 3;
                        const int tq0 = 512 * qb2 + 64 * wave + (lane & 31);
                        u32x4 qr[2][2];
#pragma unroll
                        for (int g = 0; g < 2; ++g)
#pragma unroll
                            for (int e = 0; e < 2; ++e) qr[g][e] = *(const u32x4*)((const unsigned char*)QB + ((size_t)b * SEQ + tq0 + 32 * g) * 512 + qh * 64 + 32 * hi + 16 * e);
                        f32x16 o[2][2]; float lsum[2] = {0.f, 0.f};
#pragma unroll
                        for (int r = 0; r < 16; ++r) { o[0][0][r] = 0.f; o[0][1][r] = 0.f; o[1][0][r] = 0.f; o[1][1][r] = 0.f; }
                        __syncthreads();
                        att::dense64_lag_loop(ring, (const unsigned char*)KB + (size_t)b * SEQ * 128 + kvh * 64, (const unsigned char*)VB + (size_t)b * SEQ * 128 + kvh * 64, 128, 32, qr, o, lsum, lane, wave, wave >= 4);
                        { int l2; asm volatile("v_mbcnt_lo_u32_b32 %0, -1, 0\n\tv_mbcnt_hi_u32_b32 %0, -1, %0" : "=v"(l2)); const int tqs = 512 * qb2 + 64 * wave + (l2 & 31);
#pragma unroll
                          for (int g = 0; g < 2; ++g) att::store_out(o[g], lsum[g], (unsigned char*)YAB + ((size_t)b * SEQ + tqs + 32 * g) * DM + 512 + qh * 64, l2); }
                    }
#pragma unroll 1
                    for (int rep = 0; rep < REP_ATTA; ++rep)
                    for (int L = vcu; L < NB * 32; L += G) {
                        int lane; asm volatile("v_mbcnt_lo_u32_b32 %0, -1, 0\n\tv_mbcnt_hi_u32_b32 %0, -1, %0" : "=v"(lane)); const int hi = lane >> 5;
                        const int b = L >> 5, h = (L >> 2) & 7, tb2 = L & 3, base = 512 * tb2;
                        const int tq0 = base + 16 * (lane & 31) + wave, tq1 = tq0 + 8;
                        const unsigned char* Kg = (const unsigned char*)KA + (size_t)b * SEQ * 512 + h * 64; const unsigned char* Vg = (const unsigned char*)VA + (size_t)b * SEQ * 512 + h * 64;
                        u32x4 qr[2][2];
#pragma unroll
                        for (int g = 0; g < 2; ++g)
#pragma unroll
                            for (int e = 0; e < 2; ++e) qr[g][e] = *(const u32x4*)((const unsigned char*)QA + ((size_t)b * SEQ + tq0 + 8 * g) * 512 + h * 64 + 32 * hi + 16 * e);
                        f32x16 o[2][2]; float lsum[2] = {0.f, 0.f};
#pragma unroll
                        for (int r = 0; r < 16; ++r) { o[0][0][r] = 0.f; o[0][1][r] = 0.f; o[1][0][r] = 0.f; o[1][1][r] = 0.f; }
                        __syncthreads();
                        att::dense64_loop<true>(ring, Kg, Vg, 512, base - 64, 10, qr, o, lsum, tq0, tq1, lane, wave);
                        __syncthreads();
                        {
                            LAS char* vpriv = ring + att::PRIV_OFF + wave * att::VTILE;
#define A_TK0(j) ((j) < 4 ? base + wave - 256 + 256 * (j) : wave + 8 * (((j) - 4) >> 1) + 1024 * (((j) - 4) & 1))
#define A_DK(j) ((j) < 4 ? 4 : 16)
                            u32x4 kf[2][2];
                            att::priv_kload(kf, Kg, 512, A_TK0(0), 4, lane);
#pragma unroll 1
                            for (int j = 0; j < 8; ++j) {
                                const bool p2 = j < 4; const int g = (j - 4) >> 1;
                                att::priv2_step(kf, vpriv, Kg, Vg, 512, A_TK0(j), A_DK(j), p2 || g == 0, p2 || g == 1, j + 1 < 8, A_TK0(j + 1), A_DK(j + 1), qr, o, lsum, tq0, tq1, lane);
                            }
#undef A_TK0
#undef A_DK
                        }
                        { int l2; asm volatile("v_mbcnt_lo_u32_b32 %0, -1, 0\n\tv_mbcnt_hi_u32_b32 %0, -1, %0" : "=v"(l2)); const int tqs = base + 16 * (l2 & 31) + wave;
#pragma unroll
                          for (int g = 0; g < 2; ++g) att::store_out(o[g], lsum[g], (unsigned char*)YAB + ((size_t)b * SEQ + tqs + 8 * g) * DM + h * 64, l2); }
                    }
                    __syncthreads();
                }
                SEAM(pb + P_ATTN);
                if (EN(4) && IN(pb + P_PAB)) {
                    PHASE_ENTER();
                    pg8::StaticOrder S; S.init(TT, DM, G, bx); S.wgm = N1K_WGM;
                    pg8::Gemm g{YAB, (const bf16_t*)(const GAS bf16_t*)(ws + WS_WPA + l * 2 * MiB), DM / 2}; pg8::EpiMergeFused E{MERGED, (const unsigned char*)PGATE_A, (const unsigned char*)PGATE_B};
#pragma unroll 1
                    for (int rep = 0; rep < REP_PAB; ++rep)
                    pg8::gemm_phase<pg8::EpiMergeFused, pg8::StaticOrder, true>(lds, g, S, E, wave);
                }
                SEAM(pb + P_PAB);
                if (EN(5) && IN(pb + P_OUT)) {
                    PHASE_ENTER(); const float* modl = MOD + (size_t)l * NB * MODW;
                    pg8::Gemm g{MERGED, (const bf16_t*)(const GAS bf16_t*)(ws + WS_WOUT + l * 2 * MiB), DM / 2}; pg8::StaticOrder S; S.init(TT, DM, G, bx); S.rowmajor = OUT_ROWMAJOR; S.wgm = N1K_WGM;
                    pg8::EpiResidB E{(l == 0) ? x_in : (const float*)nullptr, XB, XB, modl + 2 * DM};
#pragma unroll 1
                    for (int rep = 0; rep < ((l == 0) ? REP_OUT : 1); ++rep)
                    pg8::gemm_phase<pg8::EpiResidB, pg8::StaticOrder, true>(lds, g, S, E, wave);
                }
                SEAM(pb + P_OUT);
            }
        if (EN(6) && IN(pb + P_NORM2)) { PHASE_ENTER(); const float* modl = MOD + (size_t)l * NB * MODW;
#pragma unroll 1
            for (int rep = 0; rep < REP_NORM2; ++rep)
            row_phase<false, false, true, true, false, GU_F8 ? 2 : 0>(lds, tid, lane, wave, G, bx, x_in, XB, out, g_ffn + l * DM, modl, 3 * DM, 4 * DM, MOD, H, YM, POS, TW, WR, TE, TRK, CNT, H2F8); }
        SEAM(pb + P_NORM2);
        if (EN(7) && IN(pb + P_PLACE)) {
            PHASE_ENTER();
            LAS int* part_tot = (LAS int*)lds;
            LAS int* part_pre = part_tot + 512;
            LAS int* basee = part_pre + 512;
            LAS int* pstart = basee + 32;
            LAS int* pend = pstart + 32;
            LAS int* tote = pend + 32;
            for (int chunk = bx; chunk < 256; chunk += G) {
                { const int e = tid & 31, part = tid >> 5; int st = 0, sp = 0;
                    for (int q = 0; q < 16; ++q) { const int ch = part * 16 + q; const int v = CNT[ch * 32 + e]; st += v; sp += (ch < chunk) ? v : 0; }
                    part_tot[part * 32 + e] = st; part_pre[part * 32 + e] = sp; }
                __syncthreads();
                if (tid < 32) { int st = 0, sp = 0; for (int q = 0; q < 16; ++q) { st += part_tot[q * 32 + tid]; sp += part_pre[q * 32 + tid]; } tote[tid] = st; basee[tid] = sp; }
                __syncthreads();
                if (tid == 0) { int run = 0; for (int e = 0; e < 32; ++e) { const int padded = (tote[e] + 255) & ~255; pstart[e] = run; basee[e] += run; run += padded; pend[e] = run; } }
                __syncthreads();
                { const int tok = chunk * 256 + (tid >> 1), slot = tid & 1; const int e = TE[2 * tok + slot], rk = TRK[2 * tok + slot]; const int dest = basee[e] + rk;
                    BTOK[dest] = tok; POS[2 * tok + slot] = dest; }
                if (chunk < 32) { const int e = chunk; const int from = pstart[e] + tote[e], n = pend[e] - from; if (tid < n) BTOK[from + tid] = 0; }
                if (chunk == 0) {
                    for (int blk = tid; blk < NBLK; blk += 512) { int e = 0; for (int q = 0; q < 32; ++q) e += (pend[q] <= blk * 256) ? 1 : 0; BLKE[blk] = e > 31 ? 31 : e; }
                    if (tid == 0) BLKE[1000] = pend[31] >> 8;
                }
                __syncthreads();
            }
        }
        SEAM(pb + P_PLACE);
        if (EN(8) && IN(pb + P_GU)) {
            PHASE_ENTER();
            const int nused = BLKE[1000];
            pg8::Gemm g{GU_F8 ? (const bf16_t*)H2F8 : H, (const bf16_t*)(const GAS bf16_t*)(ws + WS_WGU + (size_t)l * NEXP * (GU_F8 ? MiB : 2 * MiB)), GU_F8 ? DM / 2 : DM};
            pg8::MoeOrder<true> S{BLKE, BTOK, 4 * nused, G, vcu};
            pg8::EpiSwiGLU E{ACT, GU_F8 ? W8I : 1.0f};
#pragma unroll 1
            for (int rep = 0; rep < REP_GU; ++rep)
            pg8::gemm_phase<pg8::EpiSwiGLU, pg8::MoeOrder<true>, GU_F8 != 0>(lds, g, S, E, wave);
        }
        SEAM(pb + P_GU);
        if (EN(9) && IN(pb + P_DOWN)) {
            PHASE_ENTER();
            const int nused = BLKE[1000];
            pg8::Gemm g{ACT, (const bf16_t*)(const GAS bf16_t*)(ws + WS_WDN + (size_t)l * NEXP * (DN_F8 ? MiB / 2 : MiB)), DN_F8 ? DFF / 2 : DFF};
            pg8::MoeOrder<false> S{BLKE, nullptr, 4 * nused, G, vcu};
            pg8::EpiY E{YM};
#pragma unroll 1
            for (int rep = 0; rep < REP_DOWN; ++rep)
            pg8::gemm_phase<pg8::EpiY, pg8::MoeOrder<false>, DN_F8 != 0>(lds, g, S, E, wave);
        }
        SEAM(pb + P_DOWN);
    }
    if (EN(10) && IN(PH_FINAL)) {
        PHASE_ENTER();
        row_phase<false, true, false, false, true>(lds, tid, lane, wave, G, bx, x_in, XB, out, g_ffn, MOD, 0, 0, MOD + (size_t)NB * MODW, H, YM, POS, TW, WR, TE, TRK, CNT);
    }
#undef IN
#undef SEAM
#undef GRID_BAR
}

extern "C" void kernel_launch(void* const* d_in, const int* in_sizes, int n_in, void* d_out, int out_size, void* d_ws, size_t ws_size, hipStream_t stream) {
    static int grid = 0;
    if (grid == 0) {
        if (n_in != 18 || in_sizes[0] != TT * DM || out_size != TT * DM || ws_size < WS_END) { fprintf(stderr, "kernel_launch: unexpected shapes / workspace (n_in %d, ws %zu); nothing launched\n", n_in, ws_size); grid = -1; return; }
        int dev = 0, cus = 0, per_cu = 0;
        if (hipGetDevice(&dev) != hipSuccess || hipDeviceGetAttribute(&cus, hipDeviceAttributeMultiprocessorCount, dev) != hipSuccess) { grid = -1; return; }
        if (hipFuncSetAttribute((const void*)fwd_kernel, hipFuncAttributeMaxDynamicSharedMemorySize, LDS_BYTES) != hipSuccess) { fprintf(stderr, "kernel_launch: hipFuncSetAttribute failed\n"); grid = -1; return; }
        if (hipOccupancyMaxActiveBlocksPerMultiprocessor(&per_cu, (const void*)fwd_kernel, 512, LDS_BYTES) != hipSuccess || per_cu < 1) { fprintf(stderr, "kernel_launch: occupancy query says %d\n", per_cu); per_cu = 1; }
        (void)hipGetLastError();
        grid = cus;
    }
    if (grid < 0) return;
    (void)hipMemsetAsync((char*)d_ws + WS_CTL, 0, CTL_ZERO_BYTES, stream);
    Args a{};
    for (int i = 0; i < 18; ++i) a.in[i] = (const float*)d_in[i];
    a.out = (float*)d_out; a.ws = (unsigned char*)d_ws;
#if MK_ONE_LAUNCH
    a.ph_lo = 0; a.ph_hi = NPH;
    hipLaunchKernelGGL(fwd_kernel, dim3(grid), dim3(512), LDS_BYTES, stream, a);
#else
    for (int p = 0; p < NPH; ++p) { a.ph_lo = p; a.ph_hi = p + 1; hipLaunchKernelGGL(fwd_kernel, dim3(grid), dim3(512), LDS_BYTES, stream, a); }
#endif
}
```

```cpp
#include <hip/hip_runtime.h>
#include <cstdio>
#include <cstdint>

#ifndef INPROJ_WGM
#define INPROJ_WGM 4
#endif
#ifndef GEMM_ALIGN
#define GEMM_ALIGN 1
#endif
#ifndef ROWB
#define ROWB 4
#endif
#ifndef N1K_WGM
#define N1K_WGM 8
#endif
#ifndef OUT_ROWMAJOR
#define OUT_ROWMAJOR 0
#endif
#ifndef REP_PRO
#define REP_PRO 1
#endif
#ifndef REP_ATTB
#define REP_ATTB 1
#endif
#ifndef REP_ATTA
#define REP_ATTA 1
#endif
#ifndef REP_INPROJ
#define REP_INPROJ 1
#endif
#ifndef REP_NORM1
#define REP_NORM1 1
#endif
#ifndef REP_GU
#define REP_GU 1
#endif
#ifndef REP_PAB
#define REP_PAB 1
#endif
#ifndef REP_OUT
#define REP_OUT 1
#endif
#ifndef REP_DOWN
#define REP_DOWN 1
#endif
#ifndef REP_NORM2
#define REP_NORM2 1
#endif
#ifndef GU_F8
#define GU_F8 1
#endif
#ifndef DN_F8
#define DN_F8 1
#endif
#ifndef MK_ONE_LAUNCH
#define MK_ONE_LAUNCH 1
#endif

#define LAS __attribute__((address_space(3)))
#define GAS __attribute__((address_space(1)))
typedef unsigned short bf16_t;
typedef short bf16x8 __attribute__((ext_vector_type(8)));
typedef short s16x4 __attribute__((ext_vector_type(4)));
typedef float f32x4 __attribute__((ext_vector_type(4)));
typedef float f32x16 __attribute__((ext_vector_type(16)));
typedef unsigned u32x4 __attribute__((ext_vector_type(4)));
typedef unsigned u32x2 __attribute__((ext_vector_type(2)));

constexpr int NB = 32, SEQ = 2048, DM = 1024, TT = NB * SEQ;
constexpr int NC = 4352;
constexpr int NEXP = 32, DFF = 512, NPAD = 139264, NBLK = 544;
constexpr int MODW = 6 * DM;
constexpr float QSCALE = 0.125f * 1.4426950408889634f;

constexpr size_t MiB = 1u << 20;
constexpr size_t WS_CTL = 0, CTL_ZERO_BYTES = 64 * 1024;
constexpr size_t WS_MOD = 1 * MiB;
constexpr size_t WS_TE = 2 * MiB + 512 * 1024, WS_TRK = 3 * MiB, WS_TW = 3 * MiB + 512 * 1024, WS_POS = 4 * MiB;
constexpr size_t WS_CNT = 4 * MiB + 512 * 1024;
constexpr size_t WS_BLKE = WS_CNT + 64 * 1024;
constexpr size_t WS_BTOK = WS_CNT + 128 * 1024;
constexpr size_t WS_WR = 5 * MiB + 256 * 1024;
constexpr size_t WS_WIN = 6 * MiB;
constexpr size_t WIN_BYTES = (size_t)NC * DM * 2;
constexpr size_t WS_WPA = 23 * MiB, WS_WPB = 25 * MiB, WS_WOUT = 27 * MiB;
constexpr size_t WS_WGU = 31 * MiB;
constexpr size_t WS_WDN = 159 * MiB;
constexpr size_t WS_H = 223 * MiB;
constexpr size_t WS_QKV = 351 * MiB;
constexpr size_t WS_GATE = 639 * MiB;
constexpr size_t WS_XB = 896 * MiB;
constexpr size_t WS_END = 1024 * MiB;
constexpr int CW_BAR = 4096;

constexpr int RING_BYTES = 133120;
constexpr int MISC_OFF = RING_BYTES;
constexpr int LDS_BYTES = 147456;

#define RLX_AGENT __ATOMIC_RELAXED, __HIP_MEMORY_SCOPE_AGENT
typedef float f32x2_t __attribute__((ext_vector_type(2))); typedef __bf16 bf16x2_t __attribute__((ext_vector_type(2)));
__device__ __forceinline__ unsigned cvt_pk_bf16(float lo, float hi) { const f32x2_t v = {lo, hi}; const bf16x2_t b = __builtin_convertvector(v, bf16x2_t); return __builtin_bit_cast(unsigned, b); }
typedef float f32x2v __attribute__((ext_vector_type(2)));
__device__ __forceinline__ unsigned pack4_fp8(float a, float b, float c, float d) { unsigned w = 0; w = __builtin_amdgcn_cvt_pk_fp8_f32(a, b, w, false); w = __builtin_amdgcn_cvt_pk_fp8_f32(c, d, w, true); return w; }
__device__ __forceinline__ void unpack8_fp8(u32x2 w, float (&o)[8]) { const f32x2v a = __builtin_amdgcn_cvt_pk_f32_fp8(w.x, false), b = __builtin_amdgcn_cvt_pk_f32_fp8(w.x, true), c = __builtin_amdgcn_cvt_pk_f32_fp8(w.y, false), d = __builtin_amdgcn_cvt_pk_f32_fp8(w.y, true);
    o[0] = a.x; o[1] = a.y; o[2] = b.x; o[3] = b.y; o[4] = c.x; o[5] = c.y; o[6] = d.x; o[7] = d.y; }
constexpr float A8S = 4.f, A8I = 0.25f;
constexpr float W8S = 64.f, W8I = 1.f / 64.f;
__device__ __forceinline__ float bf_lo(unsigned w) { return __uint_as_float(w << 16); }
__device__ __forceinline__ float bf_hi(unsigned w) { return __uint_as_float(w & 0xffff0000u); }
__device__ __forceinline__ float shx(float v, int mask, int lane) { return __int_as_float(__builtin_amdgcn_ds_bpermute((lane ^ mask) << 2, __float_as_int(v))); }
__device__ __forceinline__ float wave_sum(float v, int lane) {
#pragma unroll
    for (int o = 1; o < 64; o <<= 1) v += shx(v, o, lane);
    return v;
}
__device__ __forceinline__ float wave_max(float v, int lane) {
#pragma unroll
    for (int o = 1; o < 64; o <<= 1) v = fmaxf(v, shx(v, o, lane));
    return v;
}
__device__ __forceinline__ float sigmoid_f(float x) { return __builtin_amdgcn_rcpf(1.0f + __builtin_amdgcn_exp2f(-1.4426950408889634f * x)); }

#define XB_TMO      128
#define XB_XCNT(j)  (256  + 64 * (j))
#define XB_XSUB(j)  (1280 + 64 * (j))
#define XB_XGEN(j)  (2304 + 64 * (j))
#define XB_TOP      3328
#define XB_TOPGEN   3392
#define XCD_BAR_WORDS 3456
#define XB_SPIN_CAP (1u << 18)

__device__ __forceinline__ unsigned xb_ld(unsigned* p)              { return __hip_atomic_load(p, __ATOMIC_RELAXED, __HIP_MEMORY_SCOPE_AGENT); }
__device__ __forceinline__ unsigned xb_add(unsigned* p, unsigned v) { return __hip_atomic_fetch_add(p, v, __ATOMIC_RELAXED, __HIP_MEMORY_SCOPE_AGENT); }
__device__ __forceinline__ unsigned xb_xcc_id() { return (unsigned)__builtin_amdgcn_s_getreg((3 << 11) | 20) & 0xFu; }
#define XB_SPIN(cond, bar) do { unsigned _sp = 0; while (cond) { __builtin_amdgcn_s_sleep(1); \
    if ((++_sp & 255u) == 0u) { if (xb_ld(&(bar)[XB_TMO])) break; if (_sp > XB_SPIN_CAP) { atomicAdd(&(bar)[XB_TMO], 1u); break; } } } } while (0)

struct XcdBarrier { unsigned* bar; unsigned x; volatile LAS unsigned* st; };

__device__ __forceinline__ XcdBarrier xcd_barrier_post(unsigned* bar, volatile LAS unsigned* st) {
    XcdBarrier b; b.bar = bar; b.x = xb_xcc_id(); b.st = st;
    if (threadIdx.x == 0) (void)xb_add(&bar[XB_XCNT(b.x)], 1u);
    return b;
}
__device__ __forceinline__ void xcd_barrier_complete(unsigned* bar, unsigned x, unsigned& nloc, unsigned& nx) {
    const unsigned G = gridDim.x * gridDim.y * gridDim.z;
    unsigned sum, cnt, mine, sp = 0u;
    for (;;) {
        sum = 0u; cnt = 0u; mine = 0u;
#pragma unroll
        for (unsigned j = 0; j < 16; ++j) { const unsigned c = xb_ld(&bar[XB_XCNT(j)]); sum += c; cnt += (c > 0u) ? 1u : 0u; mine = (j == x) ? c : mine; }
        if (sum == G) break;
        __builtin_amdgcn_s_sleep(1);
        if ((++sp & 255u) == 0u) { if (xb_ld(&bar[XB_TMO])) break; if (sp > XB_SPIN_CAP) { atomicAdd(&bar[XB_TMO], 1u); break; } }
    }
    nloc = mine > 0u ? mine : 1u; nx = cnt > 0u ? cnt : 1u;
}
__device__ __forceinline__ void xcd_barrier(const XcdBarrier& b, const bool is_t0  ) {
    asm volatile("s_waitcnt vmcnt(0)" ::: "memory");
    __syncthreads();
    if (is_t0) {
        unsigned* bar = b.bar; unsigned bx_ = b.x;
        asm volatile("" : "+s"(bar), "+s"(bx_));
        __builtin_amdgcn_s_waitcnt(0);
        unsigned nloc = b.st[0], nx = b.st[1];
        if (nloc == 0u) { xcd_barrier_complete(bar, bx_, nloc, nx); b.st[0] = nloc; b.st[1] = nx; }
        const unsigned old = xb_add(&bar[XB_XSUB(bx_)], 1u);
        const unsigned gen = old / nloc;
        if (old + 1u == (gen + 1u) * nloc) {
            __builtin_amdgcn_fence(__ATOMIC_RELEASE, "agent");
            asm volatile("s_waitcnt vmcnt(0)" ::: "memory");
            const unsigned og = xb_add(&bar[XB_TOP], 1u);
            const unsigned tg = og / nx;
            if (og + 1u == (tg + 1u) * nx) xb_add(&bar[XB_TOPGEN], 1u);
            else XB_SPIN(xb_ld(&bar[XB_TOPGEN]) == tg, bar);
            __builtin_amdgcn_fence(__ATOMIC_ACQUIRE, "agent");
            xb_add(&bar[XB_XGEN(bx_)], 1u);
            asm volatile("s_waitcnt vmcnt(0)" ::: "memory");
        } else {
            XB_SPIN(xb_ld(&bar[XB_XGEN(bx_)]) == gen, bar);
            __builtin_amdgcn_fence(__ATOMIC_ACQUIRE, "agent");
            asm volatile("s_waitcnt vmcnt(0)" ::: "memory");
        }
    }
    __syncthreads();
}

namespace pg8 {
constexpr int BM = 256, BK = 64, HALF = 128, HTB = HALF * BK * 2, STAGE_BYTES = 8 * HTB, NXCD = 8, WGM = 8;
__host__ __device__ __forceinline__ int lds_byte(int r, int c) { const int st = (r >> 4) * 2 + (c >> 5), rr = r & 15, cc = c & 31, ob = rr * 64 + cc * 2; return st * 1024 + (ob ^ (((ob >> 9) & 1) << 5)); }
__host__ __device__ __forceinline__ void stage_rc(int b, int& R, int& C) { const int st = b / 1024, sb = b % 1024, swz = sb ^ (((sb >> 9) & 1) << 5); R = (st >> 1) * 16 + swz / 64; C = (st & 1) * 32 + (swz % 64) / 2; }
__host__ __device__ __forceinline__ int perm32(int rho) { const int n = rho >> 4, i = rho & 15; return 8 * (i >> 2) + 4 * n + (i & 3); }

struct Unit { int pm, pn; };
struct Gemm { const bf16_t* A; const bf16_t* Bt; int K; };

struct StaticOrder {
    static constexpr bool GATHER = false;
    int nM, nN, nwg, G, c, wgm = WGM;
    __device__ void init(int M, int N, int G_, int c_) { asm volatile("" : "+s"(c_));     nM = M / BM; nN = N / BM; nwg = nM * nN; G = G_; c = c_; }
    int rowmajor = 0;
    __device__ __forceinline__ bool next(int i, Unit& u) const {
        if (rowmajor) { const int upw = (nwg + G - 1) / G, k = c * upw + i; if (i >= upw || k >= nwg) return false; u.pm = k / nN; u.pn = k % nN; return true; }
        const long L = (long)i * G + c; if (L >= nwg) return false;
        int wgid = (int)L; { const int q = nwg / NXCD, r = nwg % NXCD, xcd = wgid % NXCD, off = wgid / NXCD; wgid = (xcd < r ? xcd * (q + 1) : r * (q + 1) + (xcd - r) * q) + off; }
        const int nig = wgm * nN, gid = wgid / nig, fm = gid * wgm, gsz = (nM - fm) < wgm ? (nM - fm) : wgm;
        u.pm = fm + ((wgid % nig) % gsz); u.pn = (wgid % nig) / gsz; return true;
    }
    __device__ __forceinline__ void aoff(const Unit&, int, int, unsigned (&)[2][2]) const {}
};
template <bool GATH>
struct MoeOrder {
    static constexpr bool GATHER = GATH;
    const int* blk_e; const int* rowidx; int nunits, G, c;
    __device__ __forceinline__ bool next(int i, Unit& u) const {
        const int L = i * G + c; if (L >= nunits) return false;
        const int blk = L >> 2; const int e = blk_e[blk]; u.pm = blk; u.pn = 4 * e + (L & 3); return true;
    }
    __device__ __forceinline__ void aoff(const Unit& u, int tid_, int K, unsigned (&o)[2][2]) const {
        int tid = tid_; asm volatile("" : "+v"(tid));
#pragma unroll
        for (int i = 0; i < 2; ++i) { int R, C; stage_rc(tid * 16 + i * 8192, R, C);
#pragma unroll
            for (int h = 0; h < 2; ++h) { const int r = u.pm * BM + h * HALF + R; const int src = rowidx ? rowidx[r] : r; o[h][i] = (unsigned)src * (unsigned)(K * 2) + (unsigned)C * 2u; } }
    }
};

typedef int i32x8 __attribute__((ext_vector_type(8))); typedef int i32x4 __attribute__((ext_vector_type(4)));
__device__ __forceinline__ i32x8 cat8(const bf16x8& a, const bf16x8& b) { return __builtin_shufflevector(__builtin_bit_cast(i32x4, a), __builtin_bit_cast(i32x4, b), 0, 1, 2, 3, 4, 5, 6, 7); }
template <class Epi, class Sched, bool F8 = false>
__device__ __forceinline__ void gemm_phase(LAS unsigned char* lds, const Gemm g, const Sched& S, const Epi& E, const int wid) {
    int lane_; asm volatile("v_mbcnt_lo_u32_b32 %0, -1, 0\n\tv_mbcnt_hi_u32_b32 %0, -1, %0" : "=v"(lane_));
    const int lane = lane_, tid = wid * 64 + lane, wr = wid >> 2, wc = wid & 3, fr = lane & 15, fq = lane >> 4;
    const int K = g.K, nt = K / BK;
    unsigned voffA[2], voffB[2];
#pragma unroll
    for (int i = 0; i < 2; ++i) { int R, C; stage_rc(tid * 16 + i * 8192, R, C); const int Rb = Epi::PERM ? ((R & ~31) + perm32(R & 31)) : R;
        voffA[i] = (unsigned)(R * K + C) * 2u; voffB[i] = (unsigned)(Rb * K + C) * 2u; }
    const size_t kstep = (size_t)(BK * 2);
    const size_t hstep = (size_t)HALF * K * 2;
    const size_t tstep = 2 * hstep;
    const unsigned ldsw = (unsigned)wid * 1024u;
    const int aoff = lds_byte(wr * 64 + fr, fq * 8), boff = lds_byte(wc * 32 + fr, fq * 8);
    const char* Ab = (const char*)g.A;
#define PG8_SA(b, h) (((b) * 2 + (h)) * HTB)
#define PG8_SB(b, h) ((4 + (b) * 2 + (h)) * HTB)
#define PG8_UNI(p) asm volatile("" : "+s"(p))
#define PG8_LOFF(v) asm volatile("" : "+v"(v))
#define PG8_STAGEB(bufoff, gbase, voff) do { const char* _g = (const char*)(gbase); PG8_UNI(_g); _Pragma("unroll") for (int _i = 0; _i < 2; ++_i) { unsigned _v = (voff)[_i]; PG8_LOFF(_v); \
        __builtin_amdgcn_global_load_lds((const unsigned*)(_g + _v), (LAS unsigned*)(lds + (bufoff) + ldsw + _i * 8192), 16, 0, 0); } } while (0)
#define PG8_STAGEA(bufoff, H_, kb, NEXT) do { if constexpr (Sched::GATHER) { const char* _g = Ab + (size_t)(kb); PG8_UNI(_g); _Pragma("unroll") for (int _i = 0; _i < 2; ++_i) { unsigned _o = (NEXT) ? na[H_][_i] : ca[H_][_i]; PG8_LOFF(_o); \
            __builtin_amdgcn_global_load_lds((const unsigned*)(_g + _o), (LAS unsigned*)(lds + (bufoff) + ldsw + _i * 8192), 16, 0, 0); } } \
        else { const char* _b = Ab + ((NEXT) ? nU : cU) + (size_t)(H_) * hstep + (size_t)(kb); PG8_UNI(_b); _Pragma("unroll") for (int _i = 0; _i < 2; ++_i) { unsigned _v = voffA[_i]; PG8_LOFF(_v); \
            __builtin_amdgcn_global_load_lds((const unsigned*)(_b + _v), (LAS unsigned*)(lds + (bufoff) + ldsw + _i * 8192), 16, 0, 0); } } } while (0)
#define PG8_LDA(dst, b, h) do { _Pragma("unroll") for (int m = 0; m < 4; ++m) _Pragma("unroll") for (int k = 0; k < 2; ++k) dst[m][k] = *(const LAS bf16x8*)(lds + PG8_SA(b, h) + aoff + m * 2048 + k * 1024); } while (0)
#define PG8_LDB(dst, b, h) do { _Pragma("unroll") for (int n = 0; n < 2; ++n) _Pragma("unroll") for (int k = 0; k < 2; ++k) dst[n][k] = *(const LAS bf16x8*)(lds + PG8_SB(b, h) + boff + n * 2048 + k * 1024); } while (0)
#define PG8_MMA(ai, bj, At, Bt) do { __builtin_amdgcn_s_setprio(1); _Pragma("unroll") for (int m = 0; m < 4; ++m) _Pragma("unroll") for (int n = 0; n < 2; ++n) { \
        if constexpr (F8) { const i32x8 b_ = cat8(Bt[n][0], Bt[n][1]), a_ = cat8(At[m][0], At[m][1]); \
            asm volatile("v_mfma_f32_16x16x128_f8f6f4 %0, %1, %2, %0" : "+v"(acc[ai][bj][m][n]) : "v"(b_), "v"(a_)); } \
        else { _Pragma("unroll") for (int k = 0; k < 2; ++k) acc[ai][bj][m][n] = __builtin_amdgcn_mfma_f32_16x16x32_bf16(Bt[n][k], At[m][k], acc[ai][bj][m][n], 0, 0, 0); } } \
        __builtin_amdgcn_s_setprio(0); } while (0)
#define PG8_MFMA_DRAIN asm volatile("s_nop 7\n\ts_nop 7\n\ts_nop 3" ::: "memory")
#define PG8_WAIT_V(n) asm volatile("s_waitcnt vmcnt(" #n ")" ::: "memory")
#define PG8_WAIT_L(n) asm volatile("s_waitcnt lgkmcnt(" #n ")" ::: "memory")
#define PG8_BAR __builtin_amdgcn_s_barrier()
#define PG8_SCHED __builtin_amdgcn_sched_barrier(0)
    Unit cur, nxt; int ui = 0;
    if (!S.next(0, cur)) return;
    f32x4 acc[2][2][4][2];
#pragma unroll
    for (int a = 0; a < 2; ++a)
#pragma unroll
        for (int b = 0; b < 2; ++b)
#pragma unroll
            for (int m = 0; m < 4; ++m)
#pragma unroll
                for (int n = 0; n < 2; ++n) acc[a][b][m][n] = (f32x4){0.f, 0.f, 0.f, 0.f};
    bf16x8 At[4][2], B0[2][2], B1[2][2];
    unsigned ca[2][2], na[2][2];
    size_t cU = 0, nU = 0;
    if constexpr (Sched::GATHER) S.aoff(cur, tid, K, ca); else cU = (size_t)cur.pm * tstep;
    const char* cB = (const char*)g.Bt + (size_t)cur.pn * tstep;
    PG8_STAGEB(PG8_SB(0, 0), cB, voffB); PG8_STAGEB(PG8_SB(0, 1), cB + hstep, voffB); PG8_STAGEA(PG8_SA(0, 0), 0, 0, false); PG8_STAGEA(PG8_SA(0, 1), 1, 0, false);
    if (wr == 1) PG8_BAR;
    PG8_WAIT_V(2); PG8_BAR;
    PG8_STAGEB(PG8_SB(1, 0), cB + kstep, voffB); PG8_STAGEA(PG8_SA(1, 0), 0, kstep, false); PG8_STAGEB(PG8_SB(1, 1), cB + hstep + kstep, voffB);
    PG8_WAIT_V(6); PG8_BAR;
    for (;;) {
        const bool has_next = S.next(ui + 1, nxt);
        if constexpr (Sched::GATHER) {
            if (has_next) S.aoff(nxt, tid, K, na);
            else {
#pragma unroll
                for (int h = 0; h < 2; ++h)
#pragma unroll
                    for (int i = 0; i < 2; ++i) na[h][i] = ca[h][i];
            }
        } else nU = has_next ? (size_t)nxt.pm * tstep : cU;
        const char* nB = has_next ? (const char*)g.Bt + (size_t)nxt.pn * tstep : cB;
#pragma unroll 1
        for (int t = 0; t < nt; t += 2) {
            const bool last = (t == nt - 2);
            const size_t kb1 = (size_t)(t + 1) * kstep;
            const size_t kb2 = last ? 0 : (size_t)(t + 2) * kstep, kb3 = kb2 + kstep;
            const char* b2 = last ? nB : cB + (size_t)(t + 2) * kstep; const char* b3 = b2 + kstep;
            PG8_LDB(B0, 0, 0); PG8_LDB(B1, 0, 1); PG8_SCHED; PG8_LDA(At, 0, 0); PG8_STAGEA(PG8_SA(1, 1), 1, kb1, false);
            PG8_WAIT_V(8); PG8_WAIT_L(0); PG8_BAR; PG8_MMA(0, 0, At, B0); PG8_MMA(0, 1, At, B1); PG8_BAR; PG8_SCHED;
            PG8_LDA(At, 0, 1); PG8_STAGEB(PG8_SB(0, 0), b2, voffB); PG8_STAGEB(PG8_SB(0, 1), b2 + hstep, voffB); PG8_STAGEA(PG8_SA(0, 0), 0, kb2, last);
            PG8_WAIT_V(8); PG8_WAIT_L(0); PG8_BAR; PG8_MMA(1, 0, At, B0); PG8_MMA(1, 1, At, B1); PG8_BAR; PG8_SCHED;
            PG8_LDB(B0, 1, 0); PG8_LDB(B1, 1, 1); PG8_SCHED; PG8_LDA(At, 1, 0); PG8_STAGEA(PG8_SA(0, 1), 1, kb2, last);
            PG8_WAIT_V(8); PG8_WAIT_L(0); PG8_BAR; PG8_MMA(0, 0, At, B0); PG8_MMA(0, 1, At, B1); PG8_BAR; PG8_SCHED;
            PG8_LDA(At, 1, 1); PG8_STAGEB(PG8_SB(1, 0), b3, voffB); PG8_STAGEB(PG8_SB(1, 1), b3 + hstep, voffB); PG8_STAGEA(PG8_SA(1, 0), 0, kb3, last);
            PG8_WAIT_V(8); PG8_WAIT_L(0); PG8_BAR; PG8_MMA(1, 0, At, B0); PG8_MMA(1, 1, At, B1); PG8_BAR; PG8_SCHED;
            if constexpr (Epi::MIDK) { if (t + 2 == nt / 2) { if constexpr (F8) PG8_MFMA_DRAIN; E.mid(acc, cur, wr, wc, fr, fq); if constexpr (F8) asm volatile("s_nop 3" ::: "memory"); } }
        }
#if GEMM_ALIGN
        if (wr == 0) PG8_BAR;
#endif
        if constexpr (F8) PG8_MFMA_DRAIN;
        E(acc, cur, wr, wc, fr, fq);
        if (!has_next) break;
#pragma unroll
        for (int a = 0; a < 2; ++a)
#pragma unroll
            for (int b = 0; b < 2; ++b)
#pragma unroll
                for (int m = 0; m < 4; ++m)
#pragma unroll
                    for (int n = 0; n < 2; ++n) acc[a][b][m][n] = (f32x4){0.f, 0.f, 0.f, 0.f};
        cur = nxt; cB = nB; cU = nU; ++ui;
        if constexpr (Sched::GATHER) {
#pragma unroll
            for (int h = 0; h < 2; ++h)
#pragma unroll
                for (int i = 0; i < 2; ++i) ca[h][i] = na[h][i];
        }
#if GEMM_ALIGN
        if (wr == 1) PG8_BAR;
#endif
    }
    PG8_WAIT_V(0);
#if !GEMM_ALIGN
    if (wr == 0) PG8_BAR;
#endif
    PG8_BAR;
#undef PG8_SA
#undef PG8_SB
#undef PG8_STAGEA
#undef PG8_STAGEB
#undef PG8_UNI
#undef PG8_LOFF
#undef PG8_LDA
#undef PG8_LDB
#undef PG8_MMA
#undef PG8_WAIT_V
#undef PG8_MFMA_DRAIN
#undef PG8_WAIT_L
#undef PG8_BAR
#undef PG8_SCHED
}

typedef const f32x4 (&AccRef)[2][2][4][2];

__device__ __forceinline__ u32x4 pack8(const f32x4& a, const f32x4& b) { u32x4 w; w.x = cvt_pk_bf16(a[0], a[1]); w.y = cvt_pk_bf16(a[2], a[3]); w.z = cvt_pk_bf16(b[0], b[1]); w.w = cvt_pk_bf16(b[2], b[3]); return w; }

struct EpiInProj {
    static constexpr bool PERM = true, MIDK = false;
    bf16_t *QA, *KA, *VA, *QB, *KB, *VB, *SA, *SB;
    const LAS float* normw;
    template <int ROPE>
    __device__ __forceinline__ void head_tile(AccRef acc, bf16_t* dst_, int ld, int hcol, int gsel, float scale, int row0, int fr, int fq) const {
        unsigned char* dst = (unsigned char*)dst_;
        int d0[2];
#pragma unroll
        for (int bj = 0; bj < 2; ++bj) d0[bj] = (ROPE == 1) ? (fq == 0 ? 8 * bj : 8 + 8 * fq + 24 * bj) : (fq < 2 ? 8 * fq + 16 * bj : 16 + 8 * fq + 16 * bj);
        f32x4 g[2][2];
#pragma unroll
        for (int bj = 0; bj < 2; ++bj)
#pragma unroll
            for (int n = 0; n < 2; ++n) g[bj][n] = *(const LAS f32x4*)(normw + gsel * 64 + d0[bj] + 4 * n);
        constexpr float FA[8] = {1.591549431e-01f, 3.086376340e-02f, 5.985185713e-03f, 1.160663641e-03f, 2.250790790e-04f, 4.364795279e-05f, 8.464330808e-06f, 1.641426263e-06f};
        constexpr float FB[16] = {1.591549431e-01f, 8.949940161e-02f, 5.032921210e-02f, 2.830219583e-02f, 1.591549431e-02f, 8.949940161e-03f, 5.032921210e-03f, 2.830219583e-03f,
                                  1.591549431e-03f, 8.949940161e-04f, 5.032921210e-04f, 2.830219583e-04f, 1.591549431e-04f, 8.949940161e-05f, 5.032921210e-05f, 2.830219583e-05f};
        float fq8[8];
#pragma unroll
        for (int k = 0; k < 8; ++k) fq8[k] = (ROPE == 1) ? FA[k] : ((fq & 1) ? FB[8 + k] : FB[k]);
        const bool rot = (ROPE == 2) || (fq == 0);
#pragma unroll
        for (int ai = 0; ai < 2; ++ai)
#pragma unroll
            for (int m = 0; m < 4; ++m) {
                const int row = row0 + ai * HALF + m * 16; const int s = row & (SEQ - 1);
                f32x4 y[2][2]; float ss = 0.f;
#pragma unroll
                for (int bj = 0; bj < 2; ++bj)
#pragma unroll
                    for (int n = 0; n < 2; ++n) { y[bj][n] = acc[ai][bj][m][n]; const f32x4 q = y[bj][n] * y[bj][n]; ss += (q[0] + q[1]) + (q[2] + q[3]); }
                ss += shx(ss, 16, fr + 16 * fq); ss += shx(ss, 32, fr + 16 * fq);
                const float rinv = __builtin_amdgcn_rsqf(ss * (W8I * W8I / 64.0f) + 1e-6f) * W8I;
#pragma unroll
                for (int bj = 0; bj < 2; ++bj)
#pragma unroll
                    for (int n = 0; n < 2; ++n) y[bj][n] = y[bj][n] * rinv * g[bj][n];
                if (ROPE != 0) {
                    const float pos = (float)((ROPE == 1) ? s : (fq < 2 ? (s >> 6) : (s & 63)));
#pragma unroll
                    for (int n = 0; n < 2; ++n)
#pragma unroll
                        for (int j = 0; j < 4; ++j) {
                            const float xr = __builtin_amdgcn_fractf(pos * fq8[4 * n + j]);
                            const float c = rot ? __builtin_amdgcn_cosf(xr) : 1.0f, s_ = rot ? __builtin_amdgcn_sinf(xr) : 0.0f;
                            const float x1 = y[0][n][j], x2 = y[1][n][j];
                            y[0][n][j] = x1 * c - x2 * s_; y[1][n][j] = x2 * c + x1 * s_;
                        }
                }
                u32x4 w;
#pragma unroll
                for (int bj = 0; bj < 2; ++bj) { const f32x4 a = y[bj][0] * scale, c = y[bj][1] * scale;
                    const unsigned lo = pack4_fp8(a[0], a[1], a[2], a[3]), hi = pack4_fp8(c[0], c[1], c[2], c[3]);
                    if (bj == 0) { w.x = lo; w.y = hi; } else { w.z = lo; w.w = hi; } }
                *(u32x4*)(dst + (size_t)row * ld + hcol + 16 * fq) = w;
            }
    }
    __device__ __forceinline__ void operator()(AccRef acc, const Unit& u, int wr, int wc, int fr_, int fq_) const {
        int fr = fr_, fq = fq_; asm volatile("" : "+v"(fr), "+v"(fq));
        const int pn = u.pn; const int row0 = u.pm * BM + wr * 64 + fr;
        if (pn >= 9) {
            unsigned char* base = (unsigned char*)((pn < 13) ? SA : SB); const int colt = ((pn - 9) & 3) * 256 + wc * 64 + 16 * fq;
#pragma unroll
            for (int ai = 0; ai < 2; ++ai)
#pragma unroll
                for (int m = 0; m < 4; ++m) { u32x4 w;
#pragma unroll
                    for (int bj = 0; bj < 2; ++bj) { f32x4 v0 = acc[ai][bj][m][0], v1 = acc[ai][bj][m][1];
#pragma unroll
                        for (int j = 0; j < 4; ++j) { v0[j] = sigmoid_f(v0[j] * W8I); v1[j] = sigmoid_f(v1[j] * W8I); }
                        const unsigned lo = pack4_fp8(v0[0], v0[1], v0[2], v0[3]), hi = pack4_fp8(v1[0], v1[1], v1[2], v1[3]);
                        if (bj == 0) { w.x = lo; w.y = hi; } else { w.z = lo; w.w = hi; } }
                    *(u32x4*)(base + (size_t)(row0 + ai * HALF + m * 16) * DM + colt) = w; }
        } else if (pn == 4 || pn == 5) {
            const int colt = (pn - 4) * 256 + wc * 64 + 16 * fq;
#pragma unroll
            for (int ai = 0; ai < 2; ++ai)
#pragma unroll
                for (int m = 0; m < 4; ++m) { u32x4 w;
                    { const f32x4 a = acc[ai][0][m][0] * W8I, c = acc[ai][0][m][1] * W8I; w.x = pack4_fp8(a[0], a[1], a[2], a[3]); w.y = pack4_fp8(c[0], c[1], c[2], c[3]); }
                    { const f32x4 a = acc[ai][1][m][0] * W8I, c = acc[ai][1][m][1] * W8I; w.z = pack4_fp8(a[0], a[1], a[2], a[3]); w.w = pack4_fp8(c[0], c[1], c[2], c[3]); }
                    *(u32x4*)((unsigned char*)VA + (size_t)(row0 + ai * HALF + m * 16) * 512 + colt) = w; }
        } else if (pn < 2)  head_tile<1>(acc, QA, 512, 64 * (4 * pn + wc), 0, QSCALE, row0, fr, fq);
        else if (pn < 4)    head_tile<1>(acc, KA, 512, 64 * (4 * (pn - 2) + wc), 1, 1.0f, row0, fr, fq);
        else if (pn < 8)    head_tile<2>(acc, QB, 512, 64 * (4 * (pn - 6) + wc), 2, QSCALE, row0, fr, fq);
        else if (wc < 2)    head_tile<2>(acc, KB, 128, 64 * wc, 3, 1.0f, row0, fr, fq);
        else {
#pragma unroll
            for (int ai = 0; ai < 2; ++ai)
#pragma unroll
                for (int m = 0; m < 4; ++m) { u32x4 w;
                    { const f32x4 a = acc[ai][0][m][0] * W8I, c = acc[ai][0][m][1] * W8I; w.x = pack4_fp8(a[0], a[1], a[2], a[3]); w.y = pack4_fp8(c[0], c[1], c[2], c[3]); }
                    { const f32x4 a = acc[ai][1][m][0] * W8I, c = acc[ai][1][m][1] * W8I; w.z = pack4_fp8(a[0], a[1], a[2], a[3]); w.w = pack4_fp8(c[0], c[1], c[2], c[3]); }
                    *(u32x4*)((unsigned char*)VB + (size_t)(row0 + ai * HALF + m * 16) * 128 + 64 * (wc - 2) + 16 * fq) = w; }
        }
    }
};

struct EpiMergeFused {
    static constexpr bool PERM = true, MIDK = true;
    bf16_t* MG; const unsigned char* GA; const unsigned char* GB;
    __device__ __forceinline__ void mid(f32x4 (&acc)[2][2][4][2], const Unit& u, int wr, int wc, int fr_, int fq_) const {
        int fr = fr_, fq = fq_; asm volatile("" : "+v"(fr), "+v"(fq));
        const int row0 = u.pm * BM + wr * 64 + fr, col0 = u.pn * BM + wc * 64 + 16 * fq;
#pragma unroll
        for (int ai = 0; ai < 2; ++ai)
#pragma unroll
            for (int m = 0; m < 4; ++m) { const size_t ro = (size_t)(row0 + ai * HALF + m * 16) * DM + col0;
                const u32x4 a = *(const u32x4*)(GA + ro), b = *(const u32x4*)(GB + ro);
#pragma unroll
                for (int bj = 0; bj < 2; ++bj) {
                    float sa[8], sb[8]; unpack8_fp8(bj ? (u32x2){a.z, a.w} : (u32x2){a.x, a.y}, sa); unpack8_fp8(bj ? (u32x2){b.z, b.w} : (u32x2){b.x, b.y}, sb);
#pragma unroll
                    for (int n = 0; n < 2; ++n)
#pragma unroll
                        for (int j = 0; j < 4; ++j) acc[ai][bj][m][n][j] *= sa[4 * n + j] * __builtin_amdgcn_rcpf(fmaxf(sb[4 * n + j], 1e-12f));
                } }
    }
    __device__ __forceinline__ void operator()(AccRef acc, const Unit& u, int wr, int wc, int fr_, int fq_) const {
        int fr = fr_, fq = fq_; asm volatile("" : "+v"(fr), "+v"(fq));
        const int row0 = u.pm * BM + wr * 64 + fr, col0 = u.pn * BM + wc * 64 + 16 * fq;
#pragma unroll
        for (int ai = 0; ai < 2; ++ai)
#pragma unroll
            for (int m = 0; m < 4; ++m) { const size_t ro = (size_t)(row0 + ai * HALF + m * 16) * DM + col0;
                const u32x4 b = *(const u32x4*)(GB + ro); u32x4 w;
#pragma unroll
                for (int bj = 0; bj < 2; ++bj) {
                    float sb[8]; unpack8_fp8(bj ? (u32x2){b.z, b.w} : (u32x2){b.x, b.y}, sb);
                    f32x4 v0 = acc[ai][bj][m][0], v1 = acc[ai][bj][m][1];
                    constexpr float CS = A8I * W8I * A8S;
#pragma unroll
                    for (int j = 0; j < 4; ++j) { v0[j] *= fmaxf(sb[j], 1e-12f) * CS; v1[j] *= fmaxf(sb[4 + j], 1e-12f) * CS; }
                    const unsigned lo = pack4_fp8(v0[0], v0[1], v0[2], v0[3]), hi = pack4_fp8(v1[0], v1[1], v1[2], v1[3]);
                    if (bj == 0) { w.x = lo; w.y = hi; } else { w.z = lo; w.w = hi; } }
                *(u32x4*)((unsigned char*)MG + ro) = w; }
    }
};

struct EpiResidB {
    static constexpr bool PERM = true, MIDK = false;
    const float* Xf; const bf16_t* Xb; bf16_t* O; const float* gate;
    __device__ __forceinline__ void operator()(AccRef acc, const Unit& u, int wr, int wc, int fr_, int fq_) const {
        int fr = fr_, fq = fq_; asm volatile("" : "+v"(fr), "+v"(fq));
        const int row0 = u.pm * BM + wr * 64 + fr, col0 = u.pn * BM + wc * 64 + 16 * fq; const int b = (u.pm * BM) >> 11;
        f32x4 gt[2][2];
#pragma unroll
        for (int bj = 0; bj < 2; ++bj)
#pragma unroll
            for (int n = 0; n < 2; ++n) gt[bj][n] = *(const f32x4*)(gate + (size_t)b * MODW + col0 + 8 * bj + 4 * n) * (A8I * W8I);
#pragma unroll
        for (int ai = 0; ai < 2; ++ai)
#pragma unroll
            for (int m = 0; m < 4; ++m) { const size_t ro = (size_t)(row0 + ai * HALF + m * 16) * DM + col0;
#pragma unroll
                for (int bj = 0; bj < 2; ++bj) {
                    f32x4 x0, x1;
                    if (Xf) { x0 = *(const f32x4*)(Xf + ro + 8 * bj); x1 = *(const f32x4*)(Xf + ro + 8 * bj + 4); }
                    else { const u32x4 w = *(const u32x4*)(Xb + ro + 8 * bj); x0 = (f32x4){bf_lo(w.x), bf_hi(w.x), bf_lo(w.y), bf_hi(w.y)}; x1 = (f32x4){bf_lo(w.z), bf_hi(w.z), bf_lo(w.w), bf_hi(w.w)}; }
                    *(u32x4*)(O + ro + 8 * bj) = pack8(x0 + gt[bj][0] * acc[ai][bj][m][0], x1 + gt[bj][1] * acc[ai][bj][m][1]); } }
    }
};

struct EpiSwiGLU {
    static constexpr bool PERM = true, MIDK = false;
    bf16_t* ACT;
    float cs;
    __device__ __forceinline__ void operator()(AccRef acc, const Unit& u, int wr, int wc, int fr_, int fq_) const {
        int fr = fr_, fq = fq_; asm volatile("" : "+v"(fr), "+v"(fq));
        const int row0 = u.pm * BM + wr * 64 + fr, col0 = (u.pn & 3) * HALF + wc * 32 + 8 * fq;
#pragma unroll
        for (int ai = 0; ai < 2; ++ai)
#pragma unroll
            for (int m = 0; m < 4; ++m) { f32x4 r[2];
#pragma unroll
                for (int n = 0; n < 2; ++n)
#pragma unroll
                    for (int j = 0; j < 4; ++j) { const float gg = acc[ai][0][m][n][j] * cs, uu = acc[ai][1][m][n][j] * (DN_F8 ? cs * A8S : cs); r[n][j] = gg * sigmoid_f(gg) * uu; }
                if (DN_F8) *(u32x2*)((unsigned char*)ACT + (size_t)(row0 + ai * HALF + m * 16) * DFF + col0) = (u32x2){pack4_fp8(r[0][0], r[0][1], r[0][2], r[0][3]), pack4_fp8(r[1][0], r[1][1], r[1][2], r[1][3])};
                else *(u32x4*)(ACT + (size_t)(row0 + ai * HALF + m * 16) * DFF + col0) = pack8(r[0], r[1]); }
    }
};

struct EpiY {
    static constexpr bool PERM = true, MIDK = false;
    unsigned char* Y;
    __device__ __forceinline__ void operator()(AccRef acc, const Unit& u, int wr, int wc, int fr_, int fq_) const {
        int fr = fr_, fq = fq_; asm volatile("" : "+v"(fr), "+v"(fq));
        const int row0 = u.pm * BM + wr * 64 + fr, col0 = (u.pn & 3) * BM + wc * 64 + 16 * fq;
#pragma unroll
        for (int ai = 0; ai < 2; ++ai)
#pragma unroll
            for (int m = 0; m < 4; ++m) { u32x4 w;
                constexpr float CS = DN_F8 ? A8I * W8I : 1.0f;
                { const f32x4 a = acc[ai][0][m][0] * CS, b = acc[ai][0][m][1] * CS; w.x = pack4_fp8(a[0], a[1], a[2], a[3]); w.y = pack4_fp8(b[0], b[1], b[2], b[3]); }
                { const f32x4 a = acc[ai][1][m][0] * CS, b = acc[ai][1][m][1] * CS; w.z = pack4_fp8(a[0], a[1], a[2], a[3]); w.w = pack4_fp8(b[0], b[1], b[2], b[3]); }
                *(u32x4*)(Y + (size_t)(row0 + ai * HALF + m * 16) * DM + col0) = w; }
    }
};
}

__device__ __forceinline__ int dimA(int bj, int r) { return r < 8 ? r + 8 * bj : 16 + (r - 8) + 24 * bj; }
__device__ __forceinline__ int dimB(int bj, int r) { return r < 16 ? r + 16 * bj : 32 + (r - 16) + 16 * bj; }
__device__ __forceinline__ int inproj_srccol(int P) {
    const int pn = P >> 8, p = P & 255, bj = p >> 7, wc = (p >> 5) & 3, r = p & 31;
    if (pn < 2) return 64 * (4 * pn + wc) + dimA(bj, r);
    if (pn < 4) return 512 + 64 * (4 * (pn - 2) + wc) + dimA(bj, r);
    if (pn < 6) return 1024 + 256 * (pn - 4) + 64 * wc + 16 * ((p >> 3) & 3) + 8 * bj + (p & 7);
    if (pn < 8) return 1536 + 64 * (4 * (pn - 6) + wc) + dimB(bj, r);
    if (pn == 8) return wc < 2 ? 2048 + 64 * wc + dimB(bj, r) : 2176 + 64 * (wc - 2) + 16 * ((p >> 3) & 3) + 8 * bj + (p & 7);
    { const int fq = (p >> 3) & 3, r8 = p & 7; return 2304 + 256 * (pn - 9) + 64 * wc + 16 * fq + 8 * bj + r8; }
}

namespace att {
constexpr int KSTR = 80, VSTR = 192;
constexpr int KTILE = 64 * KSTR, VTILE = 64 * VSTR;
constexpr int K_OFF = 0, V_OFF = 2 * KTILE;
constexpr int PRIV_OFF = 0;
__device__ __forceinline__ s16x4 vtr(LAS const char* p) { typedef short v4i16_t __attribute__((ext_vector_type(4)));
    return __builtin_bit_cast(s16x4, __builtin_amdgcn_ds_read_tr16_b64_v4i16((LAS v4i16_t*)p)); }
__device__ __forceinline__ u32x4 fp8x8_to_bf16(u32x2 w) { float f[8]; unpack8_fp8(w, f); u32x4 o; o.x = cvt_pk_bf16(f[0], f[1]); o.y = cvt_pk_bf16(f[2], f[3]); o.z = cvt_pk_bf16(f[4], f[5]); o.w = cvt_pk_bf16(f[6], f[7]); return o; }
__device__ __forceinline__ int clamp_tok(int t) { return t < 0 ? 0 : (t > SEQ - 1 ? SEQ - 1 : t); }

typedef int i32x8a __attribute__((ext_vector_type(8))); typedef int i32x4a __attribute__((ext_vector_type(4)));
__device__ __forceinline__ i32x8a cat32(const u32x4& a, const u32x4& b) { return __builtin_shufflevector(__builtin_bit_cast(i32x4a, a), __builtin_bit_cast(i32x4a, b), 0, 1, 2, 3, 4, 5, 6, 7); }
__device__ __forceinline__ void qk_tile(f32x16& p0, f32x16& p1, const u32x4 (&kf)[2][2], const u32x4 (&qr)[2]) {
    const f32x16 z = {0.f, 0.f, 0.f, 0.f, 0.f, 0.f, 0.f, 0.f, 0.f, 0.f, 0.f, 0.f, 0.f, 0.f, 0.f, 0.f};
    const i32x8a q8 = cat32(qr[0], qr[1]);
    p0 = __builtin_amdgcn_mfma_scale_f32_32x32x64_f8f6f4(cat32(kf[0][0], kf[0][1]), q8, z, 0, 0, 0, 0, 0, 0);
    p1 = __builtin_amdgcn_mfma_scale_f32_32x32x64_f8f6f4(cat32(kf[1][0], kf[1][1]), q8, z, 0, 0, 0, 0, 0, 0);
}
template <bool MASK>
__device__ __forceinline__ void exp_tile(const f32x16& p0, const f32x16& p1, float& lsum, bf16x8 (&pf)[2][2], int mbase, int mR, int dk) {
    float e0[16], e1[16]; float ls = 0.f;
#pragma unroll
    for (int r = 0; r < 16; ++r) {
        e0[r] = __builtin_amdgcn_exp2f(p0[r]); e1[r] = __builtin_amdgcn_exp2f(p1[r]);
        if (MASK) {
            const int c0 = (r & 3) + 8 * (r >> 2);
            e0[r] = ((unsigned)(mbase + dk * c0) <= (unsigned)mR) ? e0[r] : 0.f;
            e1[r] = ((unsigned)(mbase + dk * (c0 + 32)) <= (unsigned)mR) ? e1[r] : 0.f;
        }
        ls += e0[r] + e1[r];
    }
    lsum += ls;
#pragma unroll
    for (int s = 0; s < 2; ++s) {
        u32x4 w0, w1;
        w0.x = cvt_pk_bf16(e0[8 * s + 0], e0[8 * s + 1]); w0.y = cvt_pk_bf16(e0[8 * s + 2], e0[8 * s + 3]); w0.z = cvt_pk_bf16(e0[8 * s + 4], e0[8 * s + 5]); w0.w = cvt_pk_bf16(e0[8 * s + 6], e0[8 * s + 7]);
        w1.x = cvt_pk_bf16(e1[8 * s + 0], e1[8 * s + 1]); w1.y = cvt_pk_bf16(e1[8 * s + 2], e1[8 * s + 3]); w1.z = cvt_pk_bf16(e1[8 * s + 4], e1[8 * s + 5]); w1.w = cvt_pk_bf16(e1[8 * s + 6], e1[8 * s + 7]);
        pf[0][s] = __builtin_bit_cast(bf16x8, w0); pf[1][s] = __builtin_bit_cast(bf16x8, w1);
    }
}
__device__ __forceinline__ void vread(bf16x8 (&vf)[4], LAS const char* vb, int d0) {
#pragma unroll
    for (int blk = 0; blk < 2; ++blk)
#pragma unroll
        for (int s = 0; s < 2; ++s) {
            const s16x4 lo = vtr(vb + (32 * blk + 16 * s) * VSTR + 64 * d0), hi = vtr(vb + (32 * blk + 16 * s + 8) * VSTR + 64 * d0);
            vf[2 * blk + s] = (bf16x8){lo[0], lo[1], lo[2], lo[3], hi[0], hi[1], hi[2], hi[3]};
        }
}
__device__ __forceinline__ void pv_half(f32x16& od, const bf16x8 (&vf)[4], const bf16x8 (&pf)[2][2]) {
#pragma unroll
    for (int blk = 0; blk < 2; ++blk)
#pragma unroll
        for (int s = 0; s < 2; ++s) od = __builtin_amdgcn_mfma_f32_32x32x16_bf16(vf[2 * blk + s], pf[blk][s], od, 0, 0, 0);
}
__device__ __forceinline__ void mask_params(int dk, int tk0, int tq, int hi, int& mbase, int& mR) {
    const int dlo = (-64 * dk > -tq) ? -64 * dk : -tq, dhi = (64 * dk < SEQ - 1 - tq) ? 64 * dk : SEQ - 1 - tq;
    const int dA = tk0 + 4 * dk * hi - tq;
    mR = dhi - dlo; mbase = ((dA & (dk - 1)) == 0) ? dA - dlo : 0x7fffffff;
}

template <bool MASKED>
__device__ __forceinline__ void dense64_loop(LAS char* lds, const unsigned char* Kg, const unsigned char* Vg, int ld  , int tok0, int ntiles,
                                             const u32x4 (&qr)[2][2], f32x16 (&o)[2][2], float (&lsum)[2], int tq0, int tq1, int lane_, int wave) {
    constexpr int V2_OFF = 2 * KTILE;
    u32x2 kreg, vreg;
#define D64_LANE() int ln_ = lane_; asm volatile("" : "+v"(ln_)); const int tid_ = wave * 64 + ln_, srow = tid_ >> 3, sch = tid_ & 7
#define D64_LD(t) do { D64_LANE(); int tk_ = tok0 + 64 * (t) + srow; if (MASKED) tk_ = clamp_tok(tk_); kreg = *(const u32x2*)(Kg + (size_t)tk_ * ld + sch * 8); vreg = *(const u32x2*)(Vg + (size_t)tk_ * ld + sch * 8); } while (0)
#define D64_ST(t) do { D64_LANE(); *(LAS u32x2*)(lds + ((t) & 1) * KTILE + srow * KSTR + sch * 8) = kreg; *(LAS u32x4*)(lds + V2_OFF + ((t) & 1) * VTILE + srow * VSTR + sch * 16) = fp8x8_to_bf16(vreg); } while (0)
    D64_LD(0); D64_ST(0); D64_LD(1);
    for (int t = 0; t < ntiles; ++t) {
        __syncthreads();
        if (t + 1 < ntiles) D64_ST(t + 1);
        if (t + 2 < ntiles) D64_LD(t + 2);
        int lane = lane_; asm volatile("" : "+v"(lane));
        const int hi = lane >> 5;
        const int vlane = (4 * hi + ((lane & 15) >> 2)) * VSTR + (16 * ((lane >> 4) & 1) + 4 * (lane & 3)) * 2;
        const int klane = (lane & 31) * KSTR + 32 * hi;
        u32x4 kf[2][2];
        { LAS const char* kb_ = lds + (t & 1) * KTILE + klane;
#pragma unroll
          for (int blk = 0; blk < 2; ++blk)
#pragma unroll
              for (int e = 0; e < 2; ++e) kf[blk][e] = *(const LAS u32x4*)(kb_ + 32 * blk * KSTR + 16 * e); }
        f32x16 p[2][2];
        bf16x8 vfa[4], vfb[4];
        LAS const char* vb_ = lds + V2_OFF + (t & 1) * VTILE + vlane;
        vread(vfa, vb_, 0); vread(vfb, vb_, 1);
        __builtin_amdgcn_sched_barrier(0);
        qk_tile(p[0][0], p[0][1], kf, qr[0]);
        qk_tile(p[1][0], p[1][1], kf, qr[1]);
#pragma unroll
        for (int g = 0; g < 2; ++g) {
            bf16x8 pf[2][2]; int mb = 0, mr = 0;
            if (MASKED) mask_params(1, tok0 + 64 * t, g ? tq1 : tq0, hi, mb, mr);
            exp_tile<MASKED>(p[g][0], p[g][1], lsum[g], pf, mb, mr, 1);
            pv_half(o[g][0], vfa, pf); pv_half(o[g][1], vfb, pf);
        }
    }
#undef D64_LANE
#undef D64_LD
#undef D64_ST
}
__device__ __forceinline__ void dense64_lag_loop(LAS char* lds, const unsigned char* Kg, const unsigned char* Vg, int ld  , int ntiles,
                                                 const u32x4 (&qr)[2][2], f32x16 (&o)[2][2], float (&lsum)[2], int lane_, int wave, const bool lag) {
    constexpr int V2_OFF = 2 * KTILE;
    u32x2 kreg, vreg;
#define D64_LANE() int ln_ = lane_; asm volatile("" : "+v"(ln_)); const int tid_ = wave * 64 + ln_, srow = tid_ >> 3, sch = tid_ & 7
#define D64_LD(t) do { D64_LANE(); const int tk_ = 64 * (t) + srow; kreg = *(const u32x2*)(Kg + (size_t)tk_ * ld + sch * 8); vreg = *(const u32x2*)(Vg + (size_t)tk_ * ld + sch * 8); } while (0)
#define D64_ST(t) do { D64_LANE(); *(LAS u32x2*)(lds + ((t) & 1) * KTILE + srow * KSTR + sch * 8) = kreg; *(LAS u32x4*)(lds + V2_OFF + ((t) % 3) * VTILE + srow * VSTR + sch * 16) = fp8x8_to_bf16(vreg); } while (0)
#define D64_QK(t) do { int lane = lane_; asm volatile("" : "+v"(lane)); const int klane = (lane & 31) * KSTR + 32 * (lane >> 5); u32x4 kf[2][2]; LAS const char* kb_ = lds + ((t) & 1) * KTILE + klane; \
        _Pragma("unroll") for (int blk = 0; blk < 2; ++blk) _Pragma("unroll") for (int e = 0; e < 2; ++e) kf[blk][e] = *(const LAS u32x4*)(kb_ + 32 * blk * KSTR + 16 * e); \
        qk_tile(p[0][0], p[0][1], kf, qr[0]); qk_tile(p[1][0], p[1][1], kf, qr[1]); } while (0)
#define D64_PV(t) do { int lane = lane_; asm volatile("" : "+v"(lane)); const int hi = lane >> 5; const int vlane = (4 * hi + ((lane & 15) >> 2)) * VSTR + (16 * ((lane >> 4) & 1) + 4 * (lane & 3)) * 2; \
        bf16x8 vfa[4], vfb[4]; LAS const char* vb_ = lds + V2_OFF + ((t) % 3) * VTILE + vlane; vread(vfa, vb_, 0); vread(vfb, vb_, 1); \
        _Pragma("unroll") for (int g = 0; g < 2; ++g) { bf16x8 pf[2][2]; exp_tile<false>(p[g][0], p[g][1], lsum[g], pf, 0, 0, 0); pv_half(o[g][0], vfa, pf); pv_half(o[g][1], vfb, pf); } } while (0)
    f32x16 p[2][2];
    D64_LD(0); D64_ST(0);
    if (!lag) {
        D64_LD(1);
        for (int t = 0; t < ntiles; ++t) {
            __syncthreads();
            if (t + 1 < ntiles) D64_ST(t + 1);
            if (t + 2 < ntiles) D64_LD(t + 2);
            D64_QK(t);
            D64_PV(t);
        }
        __syncthreads();
    } else {
        D64_LD(1);
        __syncthreads();
        D64_ST(1); D64_LD(2);
        D64_QK(0);
        for (int t = 1; t < ntiles; ++t) {
            __syncthreads();
            if (t + 1 < ntiles) D64_ST(t + 1);
            if (t + 2 < ntiles) D64_LD(t + 2);
            D64_PV(t - 1);
            __builtin_amdgcn_sched_barrier(0);
            D64_QK(t);
        }
        __syncthreads();
        D64_PV(ntiles - 1);
    }
#undef D64_LANE
#undef D64_LD
#undef D64_ST
#undef D64_QK
#undef D64_PV
}
__device__ __forceinline__ void priv_kload(u32x4 (&kf)[2][2], const unsigned char* Kg, int ld, int tk0, int dk, int lane_) {
    int lane = lane_; asm volatile("" : "+v"(lane));
    const int hi = lane >> 5;
#pragma unroll
    for (int blk = 0; blk < 2; ++blk) { const int tk = clamp_tok(tk0 + dk * (32 * blk + (lane & 31)));
#pragma unroll
        for (int e = 0; e < 2; ++e) kf[blk][e] = *(const u32x4*)(Kg + (size_t)tk * ld + 32 * hi + 16 * e); }
}
__device__ __forceinline__ void priv2_step(u32x4 (&kf)[2][2], LAS char* vpriv, const unsigned char* Kg, const unsigned char* Vg, int ld, int tk0, int dk, bool g0, bool g1,
                                           bool has_next, int tk0n, int dkn, const u32x4 (&qr)[2][2], f32x16 (&o)[2][2], float (&lsum)[2], int tq0, int tq1, int lane_) {
    int lane = lane_; asm volatile("" : "+v"(lane));
    const int hi = lane >> 5;
    const int vlane = (4 * hi + ((lane & 15) >> 2)) * VSTR + (16 * ((lane >> 4) & 1) + 4 * (lane & 3)) * 2;
    u32x2 vr[8];
#pragma unroll
    for (int i = 0; i < 8; ++i) { const int idx = i * 64 + lane, row = idx >> 3, ch = idx & 7; const int tk = clamp_tok(tk0 + dk * row); vr[i] = *(const u32x2*)(Vg + (size_t)tk * ld + ch * 8); }
    const int gfirst = g0 ? 0 : 1, glast = g1 ? 1 : 0;
    f32x16 p0, p1; bf16x8 pf[2][2]; int mb, mr;
    if (gfirst == 0) qk_tile(p0, p1, kf, qr[0]); else qk_tile(p0, p1, kf, qr[1]);
    __builtin_amdgcn_sched_barrier(0);
#pragma unroll
    for (int i = 0; i < 8; ++i) { const int idx = i * 64 + lane; *(LAS u32x4*)(vpriv + (idx >> 3) * VSTR + (idx & 7) * 16) = fp8x8_to_bf16(vr[i]); }
    if (glast == gfirst) { __builtin_amdgcn_sched_barrier(0); if (has_next) priv_kload(kf, Kg, ld, tk0n, dkn, lane); __builtin_amdgcn_sched_barrier(0); }
    mask_params(dk, tk0, gfirst ? tq1 : tq0, hi, mb, mr);
    if (gfirst == 0) exp_tile<true>(p0, p1, lsum[0], pf, mb, mr, dk); else exp_tile<true>(p0, p1, lsum[1], pf, mb, mr, dk);
    { bf16x8 vfa[4], vfb[4]; vread(vfa, vpriv + vlane, 0); vread(vfb, vpriv + vlane, 1);
      if (gfirst == 0) { pv_half(o[0][0], vfa, pf); pv_half(o[0][1], vfb, pf); } else { pv_half(o[1][0], vfa, pf); pv_half(o[1][1], vfb, pf); } }
    if (glast != gfirst) {
        qk_tile(p0, p1, kf, qr[1]);
        __builtin_amdgcn_sched_barrier(0);
        if (has_next) priv_kload(kf, Kg, ld, tk0n, dkn, lane);
        __builtin_amdgcn_sched_barrier(0);
        mask_params(dk, tk0, tq1, hi, mb, mr);
        exp_tile<true>(p0, p1, lsum[1], pf, mb, mr, dk);
        bf16x8 vfa[4], vfb[4]; vread(vfa, vpriv + vlane, 0); vread(vfb, vpriv + vlane, 1);
        pv_half(o[1][0], vfa, pf); pv_half(o[1][1], vfb, pf);
    }
}
__device__ __forceinline__ void store_out(const f32x16 (&o)[2], float lsum, unsigned char* dst  , int lane_) {
    int lane = lane_; asm volatile("" : "+v"(lane));
    const int hi = lane >> 5;
    float l = lsum + shx(lsum, 32, lane);
    const float inv = A8S / l;
#pragma unroll
    for (int d0 = 0; d0 < 2; ++d0) {
        unsigned pc[4];
#pragma unroll
        for (int g = 0; g < 4; ++g) pc[g] = pack4_fp8(o[d0][4 * g] * inv, o[d0][4 * g + 1] * inv, o[d0][4 * g + 2] * inv, o[d0][4 * g + 3] * inv);
        const auto s0 = __builtin_amdgcn_permlane32_swap(pc[0], pc[2], false, false), s1 = __builtin_amdgcn_permlane32_swap(pc[1], pc[3], false, false);
        u32x4 w; w.x = s0[0]; w.y = s0[1]; w.z = s1[0]; w.w = s1[1];
        *(u32x4*)(dst + 32 * d0 + 16 * hi) = w;
    }
}
}

struct Args { const float* in[18]; float* out; unsigned char* ws; int ph_lo, ph_hi; };
constexpr int PH_PRO = 0, PH_L0 = 1, PH_PER_LAYER = 9, PH_FINAL = PH_L0 + 2 * PH_PER_LAYER, NPH = PH_FINAL + 1;
enum { P_NORM1 = 0, P_INPROJ, P_ATTN, P_PAB, P_OUT, P_NORM2, P_PLACE, P_GU, P_DOWN };

__device__ __forceinline__ int tile256_srccol(int P) { const int p = P & 255; return (P & ~255) + 64 * ((p >> 5) & 3) + 16 * ((p >> 3) & 3) + 8 * (p >> 7) + (p & 7); }
template <int MAP, bool W8 = false>
__device__ __forceinline__ void transpose_item(const float* W, int N, int col0, bf16_t* dst, int dst_row0, int K, int k0, LAS float* scr, int lane, int dk0 = 0  ) {
    const int sc = (MAP == 1) ? inproj_srccol(col0 + lane) : (MAP == 2) ? tile256_srccol(col0 + lane) : col0 + lane;
    const float* src = W + (size_t)k0 * N + sc;
#pragma unroll 16
    for (int i = 0; i < 64; ++i) scr[i * 65 + lane] = src[(size_t)i * N];
    asm volatile("s_waitcnt lgkmcnt(0)" ::: "memory");
    const int c = lane & 7, nn = lane >> 3;
#pragma unroll
    for (int j = 0; j < 8; ++j) { const int n = nn + 8 * j; const LAS float* s = scr + (8 * c) * 65 + n;
        if (W8) { u32x2 w; w.x = pack4_fp8(s[0] * W8S, s[65] * W8S, s[2 * 65] * W8S, s[3 * 65] * W8S); w.y = pack4_fp8(s[4 * 65] * W8S, s[5 * 65] * W8S, s[6 * 65] * W8S, s[7 * 65] * W8S);
            *(u32x2*)((unsigned char*)dst + (size_t)(dst_row0 + n) * K + dk0 + k0 + 8 * c) = w; continue; }
        u32x4 w; w.x = cvt_pk_bf16(s[0], s[65]); w.y = cvt_pk_bf16(s[2 * 65], s[3 * 65]); w.z = cvt_pk_bf16(s[4 * 65], s[5 * 65]); w.w = cvt_pk_bf16(s[6 * 65], s[7 * 65]);
        *(u32x4*)(dst + (size_t)(dst_row0 + n) * K + dk0 + k0 + 8 * c) = w; }
    asm volatile("s_waitcnt lgkmcnt(0)" ::: "memory");
}


template <bool XF32, bool COMBINE, bool NORM, bool ROUTER, bool OUTF32, int H8 = 0  >
__device__ __forceinline__ void row_phase(LAS unsigned char* lds, int tid, int lane, int wave, int G, int bx, const float* xf, bf16_t* xb, float* outf, const float* gv,
                                          const float* modl, int sh_off, int sc_off, const float* modprev, bf16_t* Hh, const unsigned char* Ym, const int* Pos, float* Tw,
                                          const bf16_t* Wr, int* Te, int* Trk, int* Cnt, unsigned char* H8p = nullptr) {
    constexpr int RB = COMBINE ? 2 : ROWB;
    constexpr int RSTR = 2080;
    LAS unsigned char* wrl = lds;
    LAS unsigned char* atile = lds + 32 * RSTR + wave * (4 * RSTR);
    LAS float* lgw = (LAS float*)(lds + MISC_OFF + 2048) + wave * 132;
    LAS int* lcnt = (LAS int*)(lds + MISC_OFF + 1024);
    asm volatile("" : "+v"(tid), "+v"(lane));
    if (ROUTER) {
#pragma unroll
        for (int p = 0; p < 8; ++p) { const int idx = p * 512 + tid, row = idx >> 7, c16 = idx & 127; *(LAS u32x4*)(wrl + row * RSTR + c16 * 16) = *(const u32x4*)(Wr + (size_t)row * DM + c16 * 8); }
    }
    for (int chunk = bx; chunk < 256; chunk += G) {
        const int b = chunk >> 3;
        if (ROUTER) { if (tid < 32) lcnt[tid] = 0; __syncthreads(); }
        f32x4 pre[4], shv[4], g2[4];
#pragma unroll
        for (int j = 0; j < 4; ++j) { const int col = 512 * (j >> 1) + 8 * lane + 4 * (j & 1);
            if (NORM) { const f32x4 gg = *(const f32x4*)(gv + col), sc = *(const f32x4*)(modl + (size_t)b * MODW + sc_off + col);
                pre[j] = gg * (1.0f + sc); shv[j] = *(const f32x4*)(modl + (size_t)b * MODW + sh_off + col); }
            if (COMBINE) g2[j] = *(const f32x4*)(modprev + (size_t)b * MODW + 5 * DM + col); }
        f32x4 rawf[XF32 ? RB : 1][4]; u32x4 rawb[XF32 ? 1 : RB][2]; int pp[COMBINE ? RB : 1][2]; float pw[COMBINE ? RB : 1][2];
#define ROW_LOAD(rb_) do { _Pragma("unroll") for (int i = 0; i < RB; ++i) { const size_t ro = (size_t)((rb_) + i) * DM; \
            if (XF32) { _Pragma("unroll") for (int j = 0; j < 4; ++j) rawf[XF32 ? i : 0][j] = *(const f32x4*)(xf + ro + 512 * (j >> 1) + 8 * lane + 4 * (j & 1)); } \
            else { _Pragma("unroll") for (int h = 0; h < 2; ++h) rawb[XF32 ? 0 : i][h] = *(const u32x4*)(xb + ro + 512 * h + 8 * lane); } \
            if (COMBINE) { pp[COMBINE ? i : 0][0] = Pos[2 * ((rb_) + i)]; pp[COMBINE ? i : 0][1] = Pos[2 * ((rb_) + i) + 1]; pw[COMBINE ? i : 0][0] = Tw[2 * ((rb_) + i)]; pw[COMBINE ? i : 0][1] = Tw[2 * ((rb_) + i) + 1]; } } } while (0)
        ROW_LOAD(chunk * 256 + wave * 32);
#pragma unroll 1
        for (int r0 = 0; r0 < 32; r0 += RB) {
            const int rowb = chunk * 256 + wave * 32 + r0;
            f32x4 v[RB][4]; int cp[COMBINE ? RB : 1][2]; float cw[COMBINE ? RB : 1][2];
#pragma unroll
            for (int i = 0; i < RB; ++i) {
                if (XF32) {
#pragma unroll
                    for (int j = 0; j < 4; ++j) v[i][j] = rawf[XF32 ? i : 0][j];
                } else {
#pragma unroll
                    for (int h = 0; h < 2; ++h) { const u32x4 w = rawb[XF32 ? 0 : i][h];
                        v[i][2 * h] = (f32x4){bf_lo(w.x), bf_hi(w.x), bf_lo(w.y), bf_hi(w.y)}; v[i][2 * h + 1] = (f32x4){bf_lo(w.z), bf_hi(w.z), bf_lo(w.w), bf_hi(w.w)}; }
                }
                if (COMBINE) { cp[i][0] = pp[i][0]; cp[i][1] = pp[i][1]; cw[i][0] = pw[i][0]; cw[i][1] = pw[i][1]; }
            }
            u32x2 ya[COMBINE ? RB : 1][2], yc[COMBINE ? RB : 1][2];
            if (COMBINE) {
#pragma unroll
                for (int i = 0; i < RB; ++i)
#pragma unroll
                    for (int h = 0; h < 2; ++h) { ya[i][h] = *(const u32x2*)(Ym + (size_t)cp[i][0] * DM + 512 * h + 8 * lane); yc[i][h] = *(const u32x2*)(Ym + (size_t)cp[i][1] * DM + 512 * h + 8 * lane); }
            }
            if (r0 + RB < 32) ROW_LOAD(rowb + RB);
            if (COMBINE) {
#pragma unroll
                for (int i = 0; i < RB; ++i) {
                    const int row = rowb + i; const float w0 = cw[i][0], w1 = cw[i][1];
#pragma unroll
                    for (int h = 0; h < 2; ++h) { float fa[8], fc[8]; unpack8_fp8(ya[i][h], fa); unpack8_fp8(yc[i][h], fc);
                        const f32x4 m0 = {w0 * fa[0] + w1 * fc[0], w0 * fa[1] + w1 * fc[1], w0 * fa[2] + w1 * fc[2], w0 * fa[3] + w1 * fc[3]};
                        const f32x4 m1 = {w0 * fa[4] + w1 * fc[4], w0 * fa[5] + w1 * fc[5], w0 * fa[6] + w1 * fc[6], w0 * fa[7] + w1 * fc[7]};
                        v[i][2 * h] = v[i][2 * h] + g2[2 * h] * m0; v[i][2 * h + 1] = v[i][2 * h + 1] + g2[2 * h + 1] * m1;
                        if (OUTF32) { *(f32x4*)(outf + (size_t)row * DM + 512 * h + 8 * lane) = v[i][2 * h]; *(f32x4*)(outf + (size_t)row * DM + 512 * h + 8 * lane + 4) = v[i][2 * h + 1]; }
                        else *(u32x4*)(xb + (size_t)row * DM + 512 * h + 8 * lane) = pg8::pack8(v[i][2 * h], v[i][2 * h + 1]); }
                }
            }
            if (NORM) {
                float ss[RB];
#pragma unroll
                for (int i = 0; i < RB; ++i) { ss[i] = 0.f;
#pragma unroll
                    for (int j = 0; j < 4; ++j) { const f32x4 q = v[i][j] * v[i][j]; ss[i] += (q[0] + q[1]) + (q[2] + q[3]); } }
#pragma unroll
                for (int o = 1; o < 64; o <<= 1)
#pragma unroll
                    for (int i = 0; i < RB; ++i) ss[i] += shx(ss[i], o, lane);
#pragma unroll
                for (int i = 0; i < RB; ++i) { const float rstd = __builtin_amdgcn_rsqf(ss[i] * (1.0f / DM) + 1e-6f);
#pragma unroll
                    for (int h = 0; h < 2; ++h) { const f32x4 h0 = v[i][2 * h] * rstd * pre[2 * h] + shv[2 * h], h1 = v[i][2 * h + 1] * rstd * pre[2 * h + 1] + shv[2 * h + 1];
                        if (H8 != 0) *(u32x2*)((H8 == 2 ? H8p : (unsigned char*)Hh) + (size_t)(rowb + i) * DM + 512 * h + 8 * lane) = (u32x2){pack4_fp8(h0[0], h0[1], h0[2], h0[3]), pack4_fp8(h1[0], h1[1], h1[2], h1[3])};
                        if (ROUTER) *(LAS u32x4*)(atile + i * RSTR + (512 * h + 8 * lane) * 2) = pg8::pack8(h0, h1);
                        else if (H8 != 1) *(u32x4*)(Hh + (size_t)(rowb + i) * DM + 512 * h + 8 * lane) = pg8::pack8(h0, h1); } }
                if (ROUTER) {
                    static_assert(!ROUTER || RB == 4, "the router batch is 4 rows");
                    asm volatile("s_waitcnt lgkmcnt(0)" ::: "memory");
                    f32x4 ra0 = {0.f, 0.f, 0.f, 0.f}, ra1 = {0.f, 0.f, 0.f, 0.f};
                    { int ln = lane; asm volatile("" : "+v"(ln));
                      LAS const unsigned char* ab = atile + (ln & 3) * RSTR + (ln >> 4) * 16;
                      LAS const unsigned char* bb = wrl + (ln & 15) * RSTR + (ln >> 4) * 16;
#pragma unroll 8
                      for (int kk = 0; kk < 32; ++kk) {
                          const bf16x8 a = *(const LAS bf16x8*)(ab + 64 * kk), b0 = *(const LAS bf16x8*)(bb + 64 * kk), b1 = *(const LAS bf16x8*)(bb + 16 * RSTR + 64 * kk);
                          ra0 = __builtin_amdgcn_mfma_f32_16x16x32_bf16(a, b0, ra0, 0, 0, 0); ra1 = __builtin_amdgcn_mfma_f32_16x16x32_bf16(a, b1, ra1, 0, 0, 0);
                      }
                      if (ln < 16) {
#pragma unroll
                          for (int r = 0; r < 4; ++r) { lgw[r * 33 + ln] = ra0[r]; lgw[r * 33 + 16 + ln] = ra1[r]; } }
                    }
                    asm volatile("s_waitcnt lgkmcnt(0)" ::: "memory");
                    { int ln = lane; asm volatile("" : "+v"(ln));
                      const int tk = (ln >> 2) & 3, g = ln & 3;
                      float m1 = -3.0e38f, m2 = -3.0e38f; int i1 = 0, i2 = 0;
#pragma unroll
                      for (int j = 0; j < 8; ++j) { const float vv = lgw[tk * 33 + 8 * g + j];
                          if (vv > m1) { m2 = m1; i2 = i1; m1 = vv; i1 = j; } else if (vv > m2) { m2 = vv; i2 = j; } }
                      float M = fmaxf(m1, shx(m1, 1, ln)); M = fmaxf(M, shx(M, 2, ln));
                      const float sc = expf(m1 - M) + expf(m2 - M);
                      const int base = ln & ~3;
                      const float s0 = __int_as_float(__builtin_amdgcn_ds_bpermute(base << 2, __float_as_int(sc))), s1 = __int_as_float(__builtin_amdgcn_ds_bpermute((base + 1) << 2, __float_as_int(sc))),
                                  s2 = __int_as_float(__builtin_amdgcn_ds_bpermute((base + 2) << 2, __float_as_int(sc))), s3 = __int_as_float(__builtin_amdgcn_ds_bpermute((base + 3) << 2, __float_as_int(sc)));
                      int bg = 0; float bs = s0; if (s1 > bs) { bs = s1; bg = 1; } if (s2 > bs) { bs = s2; bg = 2; } if (s3 > bs) { bs = s3; bg = 3; }
                      if (ln < 16 && g == bg) {
                          const int tok = rowb + tk, e0 = 8 * g + i1, e1 = 8 * g + i2;
                          const float w0 = 1.0f / (1.0f + expf(m2 - m1)), w1 = 1.0f - w0;
                          const int r0_ = __hip_atomic_fetch_add(&lcnt[e0], 1, __ATOMIC_RELAXED, __HIP_MEMORY_SCOPE_WORKGROUP);
                          const int r1_ = __hip_atomic_fetch_add(&lcnt[e1], 1, __ATOMIC_RELAXED, __HIP_MEMORY_SCOPE_WORKGROUP);
                          Te[2 * tok] = e0; Te[2 * tok + 1] = e1; Trk[2 * tok] = r0_; Trk[2 * tok + 1] = r1_; Tw[2 * tok] = w0; Tw[2 * tok + 1] = w1;
                      }
                    }
                }
            }
        }
#undef ROW_LOAD
        if (ROUTER) {
            __syncthreads();
            if (tid < 32) Cnt[chunk * 32 + tid] = lcnt[tid];
            __syncthreads();
        }
    }
}

#define x_in ((const float*)(const GAS float*)args.in[0])
#define c_in ((const float*)(const GAS float*)args.in[1])
#define w_ada ((const float*)(const GAS float*)args.in[2])
#define b_ada ((const float*)(const GAS float*)args.in[3])
#define g_mix ((const float*)(const GAS float*)args.in[4])
#define w_in ((const float*)(const GAS float*)args.in[5])
#define qn_a ((const float*)(const GAS float*)args.in[6])
#define kn_a ((const float*)(const GAS float*)args.in[7])
#define qn_b ((const float*)(const GAS float*)args.in[8])
#define kn_b ((const float*)(const GAS float*)args.in[9])
#define w_pa ((const float*)(const GAS float*)args.in[10])
#define w_pb ((const float*)(const GAS float*)args.in[11])
#define w_out ((const float*)(const GAS float*)args.in[12])
#define g_ffn ((const float*)(const GAS float*)args.in[13])
#define w_router ((const float*)(const GAS float*)args.in[14])
#define w_gate ((const float*)(const GAS float*)args.in[15])
#define w_up ((const float*)(const GAS float*)args.in[16])
#define w_down ((const float*)(const GAS float*)args.in[17])
#define MOD ((float*)(GAS float*)(ws + WS_MOD))
#define XB ((bf16_t*)(GAS bf16_t*)(ws + WS_XB))
#define TE ((int*)(GAS int*)(ws + WS_TE))
#define TRK ((int*)(GAS int*)(ws + WS_TRK))
#define TW ((float*)(GAS float*)(ws + WS_TW))
#define POS ((int*)(GAS int*)(ws + WS_POS))
#define CNT ((int*)(GAS int*)(ws + WS_CNT))
#define BLKE ((int*)(GAS int*)(ws + WS_BLKE))
#define BTOK ((int*)(GAS int*)(ws + WS_BTOK))
#define WR ((bf16_t*)(bf16_t*)(GAS bf16_t*)(ws + WS_WR))
#define H ((bf16_t*)(bf16_t*)(GAS bf16_t*)(ws + WS_H))
#define YAB ((bf16_t*)(GAS bf16_t*)(ws + WS_H))
#define YA ((bf16_t*)(bf16_t*)(GAS bf16_t*)(ws + WS_H))
#define YB ((bf16_t*)(bf16_t*)(GAS bf16_t*)(ws + WS_H + 64 * MiB))
#define QA ((bf16_t*)(bf16_t*)(GAS bf16_t*)(ws + WS_QKV))
#define KA ((bf16_t*)(bf16_t*)(GAS bf16_t*)(ws + WS_QKV + 64 * MiB))
#define VA ((bf16_t*)(bf16_t*)(GAS bf16_t*)(ws + WS_QKV + 128 * MiB))
#define QB ((bf16_t*)(bf16_t*)(GAS bf16_t*)(ws + WS_QKV + 192 * MiB))
#define KB ((bf16_t*)(bf16_t*)(GAS bf16_t*)(ws + WS_QKV + 256 * MiB))
#define VB ((bf16_t*)(bf16_t*)(GAS bf16_t*)(ws + WS_QKV + 272 * MiB))
#define MERGED ((bf16_t*)(bf16_t*)(GAS bf16_t*)(ws + WS_QKV))
#define YM ((unsigned char*)(GAS unsigned char*)(ws + WS_QKV))
#define H2F8 ((unsigned char*)(GAS unsigned char*)(ws + WS_QKV + 160 * MiB))
#define SA ((bf16_t*)(bf16_t*)(GAS bf16_t*)(ws + WS_GATE))
#define SB ((bf16_t*)(bf16_t*)(GAS bf16_t*)(ws + WS_GATE + 128 * MiB))
#define ACT ((bf16_t*)(bf16_t*)(GAS bf16_t*)(ws + WS_GATE))
#define PHASE_ENTER() int lane; asm volatile("v_mbcnt_lo_u32_b32 %0, -1, 0\n\tv_mbcnt_hi_u32_b32 %0, -1, %0" : "=v"(lane)); const int tid = wave * 64 + lane; GAS unsigned char* ws = ws0; int bx = bx0, vcu = vcu0; asm volatile("" : "+s"(ws), "+s"(bx), "+s"(vcu))

__device__ __forceinline__ bool in_phase(int lo, int hi, int k) { asm volatile("" : "+s"(lo), "+s"(hi)); return lo <= k && k < hi; }
#define PGATE_A SA
#define PGATE_B SB
__global__ void __launch_bounds__(512, 2) fwd_kernel(Args args) {
    extern __shared__ __attribute__((aligned(16))) unsigned char lds_raw[];
    LAS unsigned char* lds = (LAS unsigned char*)lds_raw;
    volatile LAS unsigned* MISC = (volatile LAS unsigned*)(lds + MISC_OFF);
    const int tid0 = threadIdx.x, lane0 = tid0 & 63, wave = __builtin_amdgcn_readfirstlane(tid0 >> 6);
    const int G = gridDim.x, bx0 = blockIdx.x;
    const int vcu0 = (G % 8 == 0) ? (bx0 % 8) * (G / 8) + bx0 / 8 : bx0;
    GAS unsigned char* ws0 = (GAS unsigned char*)args.ws;
    float* out = (float*)(GAS float*)args.out;
    for (int u = tid0; u < 256; u += 512) ((LAS unsigned*)(lds + MISC_OFF))[u] = 0u;
    __syncthreads();
#if MK_ONE_LAUNCH
    XcdBarrier bar = xcd_barrier_post((unsigned*)((GAS unsigned*)(ws0 + WS_CTL) + CW_BAR), MISC + 8);
#define GRID_BAR() do { int l_; asm volatile("v_mbcnt_lo_u32_b32 %0, -1, 0\n\tv_mbcnt_hi_u32_b32 %0, -1, %0" : "=v"(l_)); xcd_barrier(bar, (wave == 0) && (l_ == 0)); } while (0)
#else
#define GRID_BAR() do {} while (0)
#endif
#ifndef PHMASK
#define PHMASK 0xFFFFFFFFu
#endif
#if MK_ONE_LAUNCH
#define IN(k) true
#else
#define IN(k) in_phase(args.ph_lo, args.ph_hi, (k))
#endif
#define EN(bit) ((PHMASK >> (bit)) & 1u)
#define SEAM(k) do { if (IN(k) && IN((k) + 1)) GRID_BAR(); } while (0)

    if (EN(0) && IN(PH_PRO)) {
        PHASE_ENTER();
#pragma unroll 1
        for (int rep = 0; rep < REP_PRO; ++rep) {
        LAS float* scr = (LAS float*)(lds + wave * 16640);
        const int gw = vcu * 8 + wave, NGW = G * 8;
        constexpr int I_IN = 68 * 8, I_PA = 16 * 4, I_OUT = 16 * 8, I_GU = 32 * 2 * 8 * 8, I_DN = 32 * 16 * 4;
        constexpr int I_LAYER = I_IN + 2 * I_PA + I_OUT + I_GU + I_DN;
        auto decode = [&](int it, const float*& src, int& N, unsigned char*& dst, int& K, int& t256  ) {
            t256 = -1;
            const int l = it / I_LAYER; int r = it % I_LAYER;
            if (r < I_IN) { const int nb = r / 8, kb = r % 8; N = NC; K = DM;
                src = w_in + (size_t)l * DM * NC + (size_t)(128 * kb) * NC + inproj_srccol(64 * nb + lane);
                dst = (unsigned char*)(GAS unsigned char*)(ws + WS_WIN + l * WIN_BYTES) + (size_t)(64 * nb) * DM + 128 * kb; return; } r -= I_IN;
            if (r < 2 * I_PA) { const int pb_ = r / I_PA, q = r % I_PA, nb = q / 4, kb = q % 4; N = DM; K = DM;
                src = (pb_ ? w_pb : w_pa) + (size_t)l * 512 * DM + (size_t)(128 * kb) * DM + 64 * nb + lane; t256 = nb;
                dst = (unsigned char*)(GAS unsigned char*)(ws + WS_WPA + l * 2 * MiB) + 512 * pb_ + 128 * kb; return; } r -= 2 * I_PA;
            if (r < I_OUT) { const int nb = r / 8, kb = r % 8; N = DM; K = DM;
                src = w_out + (size_t)l * DM * DM + (size_t)(128 * kb) * DM + 64 * nb + lane; t256 = nb;
                dst = (unsigned char*)(GAS unsigned char*)(ws + WS_WOUT + l * 2 * MiB) + 128 * kb; return; } r -= I_OUT;
            if (r < I_GU) { const int e = r / 128, q = r % 128, up = q / 64, nb = (q % 64) / 8, kb = q % 8; N = DFF; K = DM;
                const int c0 = 64 * nb, drow = 256 * (c0 >> 7) + 128 * up + (c0 & 127);
                src = (up ? w_up : w_gate) + ((size_t)l * NEXP + e) * DM * DFF + (size_t)(128 * kb) * DFF + c0 + lane;
                dst = (unsigned char*)(GAS unsigned char*)(ws + WS_WGU + ((size_t)l * NEXP + e) * MiB) + (size_t)drow * DM + 128 * kb; return; } r -= I_GU;
            { const int e = r / 64, q = r % 64, nb = q / 4, kb = q % 4; N = DM; K = DFF;
                src = w_down + ((size_t)l * NEXP + e) * DFF * DM + (size_t)(128 * kb) * DM + 64 * nb + lane; t256 = nb;
                dst = (unsigned char*)(GAS unsigned char*)(ws + WS_WDN + ((size_t)l * NEXP + e) * (MiB / 2)) + 128 * kb; }
        };
        {
            LAS unsigned char* scr8 = (LAS unsigned char*)scr;
#pragma unroll 1
            for (int it = gw; it < 2 * I_LAYER; it += NGW) {
                const float* src; int N, K, t256; unsigned char* dst;
                decode(it, src, N, dst, K, t256);
                float v[128];
#pragma unroll
                for (int i = 0; i < 128; ++i) v[i] = src[(size_t)i * N];
#pragma unroll
                for (int q = 0; q < 8; ++q) { u32x4 w;
                    w.x = pack4_fp8(v[16 * q + 0] * W8S, v[16 * q + 1] * W8S, v[16 * q + 2] * W8S, v[16 * q + 3] * W8S); w.y = pack4_fp8(v[16 * q + 4] * W8S, v[16 * q + 5] * W8S, v[16 * q + 6] * W8S, v[16 * q + 7] * W8S);
                    w.z = pack4_fp8(v[16 * q + 8] * W8S, v[16 * q + 9] * W8S, v[16 * q + 10] * W8S, v[16 * q + 11] * W8S); w.w = pack4_fp8(v[16 * q + 12] * W8S, v[16 * q + 13] * W8S, v[16 * q + 14] * W8S, v[16 * q + 15] * W8S);
                    *(LAS u32x4*)(scr8 + lane * 144 + 16 * q) = w; }
                asm volatile("s_waitcnt lgkmcnt(0)" ::: "memory");
#pragma unroll
                for (int j = 0; j < 8; ++j) { const int r_ = 8 * j + (lane >> 3), c = lane & 7;
                    const u32x4 w = *(const LAS u32x4*)(scr8 + r_ * 144 + 16 * c);
                    const int drow = (t256 < 0) ? r_ : 256 * (t256 >> 2) + 128 * (j & 1) + 32 * (t256 & 3) + 8 * (j >> 1) + (lane >> 3);
                    *(u32x4*)(dst + (size_t)drow * K + 16 * c) = w; }
                asm volatile("s_waitcnt lgkmcnt(0)" ::: "memory");
            }
        }
        for (int i = (vcu * 512 + tid); i < 32 * DM; i += G * 512) { const int e = i >> 10, k = i & 1023; WR[i] = (bf16_t)(cvt_pk_bf16(w_router[(size_t)k * NEXP + e], 0.f) & 0xffffu); }
        __syncthreads();
        if (vcu < 192) {
            LAS float* cond = (LAS float*)lds;
            for (int i = tid; i < NB * DM; i += 512) { const int b = i >> 10, k = i & 1023; const float cv = c_in[i]; cond[k * 32 + b] = cv / (1.0f + expf(-cv)); }
            __syncthreads();
            const int T = 2 * vcu + (wave >> 2), kq = wave & 3;
            const int l = T / 192, n0 = (T % 192) * 32;
            const float* wp = w_ada + (size_t)l * DM * MODW + n0 + (lane & 31) + (size_t)(256 * kq + (lane >> 5)) * MODW;
            const LAS float* cp = cond + (256 * kq + (lane >> 5)) * 32 + (lane & 31);
            f32x16 acc;
#pragma unroll
            for (int r = 0; r < 16; ++r) acc[r] = 0.f;
#pragma unroll 16
            for (int k0 = 0; k0 < 256; k0 += 2) acc = __builtin_amdgcn_mfma_f32_32x32x2f32(cp[k0 * 32], wp[(size_t)k0 * MODW], acc, 0, 0, 0);
            __syncthreads();
            LAS float* part = (LAS float*)lds + wave * 1024;
#pragma unroll
            for (int r = 0; r < 16; ++r) part[r * 64 + lane] = acc[r];
            __syncthreads();
            if (kq == 0) {
                const float bias = b_ada[l * MODW + n0 + (lane & 31)];
#pragma unroll
                for (int r = 0; r < 16; ++r) { const int b = (r & 3) + 8 * (r >> 2) + 4 * (lane >> 5);
                    MOD[((size_t)l * NB + b) * MODW + n0 + (lane & 31)] = ((part[r * 64 + lane] + part[1024 + r * 64 + lane]) + (part[2048 + r * 64 + lane] + part[3072 + r * 64 + lane])) + bias; }
            }
        }
        __syncthreads();
        }
    }
    SEAM(PH_PRO);

    for (int l = 0; l < 2; ++l) {
        const int pb = PH_L0 + l * PH_PER_LAYER;
        if (EN(1) && IN(pb + P_NORM1)) { PHASE_ENTER(); const float* modl = MOD + (size_t)l * NB * MODW;
            if (l == 0) {
#pragma unroll 1
                for (int rep = 0; rep < REP_NORM1; ++rep)
                    row_phase<true, false, true, false, false, 1>(lds, tid, lane, wave, G, bx, x_in, XB, out, g_mix, modl, 0, DM, MOD, H, YM, POS, TW, WR, TE, TRK, CNT);
            } else row_phase<false, true, true, false, false, 1>(lds, tid, lane, wave, G, bx, x_in, XB, out, g_mix + DM, modl, 0, DM, MOD, H, YM, POS, TW, WR, TE, TRK, CNT); }
            {
                SEAM(pb + P_NORM1);
                if (EN(2) && IN(pb + P_INPROJ)) {
                    PHASE_ENTER();
                    pg8::Gemm g{H, (const bf16_t*)(const GAS bf16_t*)(ws + WS_WIN + l * WIN_BYTES), DM / 2}; pg8::StaticOrder S; S.init(TT, NC, G, bx); S.wgm = INPROJ_WGM;
                    LAS float* normw = (LAS float*)(lds + MISC_OFF + 1024);
                    if (tid < 256) { const int sel = tid >> 6, d = tid & 63; const float* srcw = (sel == 0) ? qn_a : (sel == 1) ? kn_a : (sel == 2) ? qn_b : kn_b; normw[tid] = srcw[l * 64 + d]; }
                    __syncthreads();
                    pg8::EpiInProj E{QA, KA, VA, QB, KB, VB, SA, SB, normw};
#pragma unroll 1
                    for (int rep = 0; rep < REP_INPROJ; ++rep)
                    pg8::gemm_phase<pg8::EpiInProj, pg8::StaticOrder, true>(lds, g, S, E, wave);
                }
                SEAM(pb + P_INPROJ);
                if (EN(3) && IN(pb + P_ATTN)) {
                    PHASE_ENTER(); (void)lane;
                    LAS char* ring = (LAS char*)lds;
#pragma unroll 1
                    for (int rep = 0; rep < REP_ATTB; ++rep)
                    for (int L = vcu; L < NB * 32; L += G) {
                        int lane; asm volatile("v_mbcnt_lo_u32_b32 %0, -1, 0\n\tv_mbcnt_hi_u32_b32 %0, -1, %0" : "=v"(lane)); const int hi = lane >> 5;
                        const int b = L >> 5, kvh = (L >> 4) & 1, qh = 4 * kvh + ((L >> 2) & 3), qb2 = L & 3;
                        const int tq0 = 512 * qb2 + 64 * wave + (lane & 31);
                        u32x4 qr[2][2];
#pragma unroll
                        for (int g = 0; g < 2; ++g)
#pragma unroll
                            for (int e = 0; e < 2; ++e) qr[g][e] = *(const u32x4*)((const unsigned char*)QB + ((size_t)b * SEQ + tq0 + 32 * g) * 512 + qh * 64 + 32 * hi + 16 * e);
                        f32x16 o[2][2]; float lsum[2] = {0.f, 0.f};
#pragma unroll
                        for (int r = 0; r < 16; ++r) { o[0][0][r] = 0.f; o[0][1][r] = 0.f; o[1][0][r] = 0.f; o[1][1][r] = 0.f; }
                        __syncthreads();
                        att::dense64_lag_loop(ring, (const unsigned char*)KB + (size_t)b * SEQ * 128 + kvh * 64, (const unsigned char*)VB + (size_t)b * SEQ * 128 + kvh * 64, 128, 32, qr, o, lsum, lane, wave, wave >= 4);
                        { int l2; asm volatile("v_mbcnt_lo_u32_b32 %0, -1, 0\n\tv_mbcnt_hi_u32_b32 %0, -1, %0" : "=v"(l2)); const int tqs = 512 * qb2 + 64 * wave + (l2 & 31);
#pragma unroll
                          for (int g = 0; g < 2; ++g) att::store_out(o[g], lsum[g], (unsigned char*)YAB + ((size_t)b * SEQ + tqs + 32 * g) * DM + 512 + qh * 64, l2); }
                    }
#pragma unroll 1
                    for (int rep = 0; rep < REP_ATTA; ++rep)
                    for (int L = vcu; L < NB * 32; L += G) {
                        int lane; asm volatile("v_mbcnt_lo_u32_b32 %0, -1, 0\n\tv_mbcnt_hi_u32_b32 %0, -1, %0" : "=v"(lane)); const int hi = lane >> 5;
                        const int b = L >> 5, h = (L >> 2) & 7, tb2 = L & 3, base = 512 * tb2;
                        const int tq0 = base + 16 * (lane & 31) + wave, tq1 = tq0 + 8;
                        const unsigned char* Kg = (const unsigned char*)KA + (size_t)b * SEQ * 512 + h * 64; const unsigned char* Vg = (const unsigned char*)VA + (size_t)b * SEQ * 512 + h * 64;
                        u32x4 qr[2][2];
#pragma unroll
                        for (int g = 0; g < 2; ++g)
#pragma unroll
                            for (int e = 0; e < 2; ++e) qr[g][e] = *(const u32x4*)((const unsigned char*)QA + ((size_t)b * SEQ + tq0 + 8 * g) * 512 + h * 64 + 32 * hi + 16 * e);
                        f32x16 o[2][2]; float lsum[2] = {0.f, 0.f};
#pragma unroll
                        for (int r = 0; r < 16; ++r) { o[0][0][r] = 0.f; o[0][1][r] = 0.f; o[1][0][r] = 0.f; o[1][1][r] = 0.f; }
                        __syncthreads();
                        att::dense64_loop<true>(ring, Kg, Vg, 512, base - 64, 10, qr, o, lsum, tq0, tq1, lane, wave);
                        __syncthreads();
                        {
                            LAS char* vpriv = ring + att::PRIV_OFF + wave * att::VTILE;
#define A_TK0(j) ((j) < 4 ? base + wave - 256 + 256 * (j) : wave + 8 * (((j) - 4) >> 1) + 1024 * (((j) - 4) & 1))
#define A_DK(j) ((j) < 4 ? 4 : 16)
                            u32x4 kf[2][2];
                            att::priv_kload(kf, Kg, 512, A_TK0(0), 4, lane);
#pragma unroll 1
                            for (int j = 0; j < 8; ++j) {
                                const bool p2 = j < 4; const int g = (j - 4) >> 1;
                                att::priv2_step(kf, vpriv, Kg, Vg, 512, A_TK0(j), A_DK(j), p2 || g == 0, p2 || g == 1, j + 1 < 8, A_TK0(j + 1), A_DK(j + 1), qr, o, lsum, tq0, tq1, lane);
                            }
#undef A_TK0
#undef A_DK
                        }
                        { int l2; asm volatile("v_mbcnt_lo_u32_b32 %0, -1, 0\n\tv_mbcnt_hi_u32_b32 %0, -1, %0" : "=v"(l2)); const int tqs = base + 16 * (l2 & 31) + wave;
#pragma unroll
                          for (int g = 0; g < 2; ++g) att::store_out(o[g], lsum[g], (unsigned char*)YAB + ((size_t)b * SEQ + tqs + 8 * g) * DM + h * 64, l2); }
                    }
                    __syncthreads();
                }
                SEAM(pb + P_ATTN);
                if (EN(4) && IN(pb + P_PAB)) {
                    PHASE_ENTER();
                    pg8::StaticOrder S; S.init(TT, DM, G, bx); S.wgm = N1K_WGM;
                    pg8::Gemm g{YAB, (const bf16_t*)(const GAS bf16_t*)(ws + WS_WPA + l * 2 * MiB), DM / 2}; pg8::EpiMergeFused E{MERGED, (const unsigned char*)PGATE_A, (const unsigned char*)PGATE_B};
#pragma unroll 1
                    for (int rep = 0; rep < REP_PAB; ++rep)
                    pg8::gemm_phase<pg8::EpiMergeFused, pg8::StaticOrder, true>(lds, g, S, E, wave);
                }
                SEAM(pb + P_PAB);
                if (EN(5) && IN(pb + P_OUT)) {
                    PHASE_ENTER(); const float* modl = MOD + (size_t)l * NB * MODW;
                    pg8::Gemm g{MERGED, (const bf16_t*)(const GAS bf16_t*)(ws + WS_WOUT + l * 2 * MiB), DM / 2}; pg8::StaticOrder S; S.init(TT, DM, G, bx); S.rowmajor = OUT_ROWMAJOR; S.wgm = N1K_WGM;
                    pg8::EpiResidB E{(l == 0) ? x_in : (const float*)nullptr, XB, XB, modl + 2 * DM};
#pragma unroll 1
                    for (int rep = 0; rep < ((l == 0) ? REP_OUT : 1); ++rep)
                    pg8::gemm_phase<pg8::EpiResidB, pg8::StaticOrder, true>(lds, g, S, E, wave);
                }
                SEAM(pb + P_OUT);
            }
        if (EN(6) && IN(pb + P_NORM2)) { PHASE_ENTER(); const float* modl = MOD + (size_t)l * NB * MODW;
#pragma unroll 1
            for (int rep = 0; rep < REP_NORM2; ++rep)
            row_phase<false, false, true, true, false, GU_F8 ? 2 : 0>(lds, tid, lane, wave, G, bx, x_in, XB, out, g_ffn + l * DM, modl, 3 * DM, 4 * DM, MOD, H, YM, POS, TW, WR, TE, TRK, CNT, H2F8); }
        SEAM(pb + P_NORM2);
        if (EN(7) && IN(pb + P_PLACE)) {
            PHASE_ENTER();
            LAS int* part_tot = (LAS int*)lds;
            LAS int* part_pre = part_tot + 512;
            LAS int* basee = part_pre + 512;
            LAS int* pstart = basee + 32;
            LAS int* pend = pstart + 32;
            LAS int* tote = pend + 32;
            for (int chunk = bx; chunk < 256; chunk += G) {
                { const int e = tid & 31, part = tid >> 5; int st = 0, sp = 0;
                    for (int q = 0; q < 16; ++q) { const int ch = part * 16 + q; const int v = CNT[ch * 32 + e]; st += v; sp += (ch < chunk) ? v : 0; }
                    part_tot[part * 32 + e] = st; part_pre[part * 32 + e] = sp; }
                __syncthreads();
                if (tid < 32) { int st = 0, sp = 0; for (int q = 0; q < 16; ++q) { st += part_tot[q * 32 + tid]; sp += part_pre[q * 32 + tid]; } tote[tid] = st; basee[tid] = sp; }
                __syncthreads();
                if (tid == 0) { int run = 0; for (int e = 0; e < 32; ++e) { const int padded = (tote[e] + 255) & ~255; pstart[e] = run; basee[e] += run; run += padded; pend[e] = run; } }
                __syncthreads();
                { const int tok = chunk * 256 + (tid >> 1), slot = tid & 1; const int e = TE[2 * tok + slot], rk = TRK[2 * tok + slot]; const int dest = basee[e] + rk;
                    BTOK[dest] = tok; POS[2 * tok + slot] = dest; }
                if (chunk < 32) { const int e = chunk; const int from = pstart[e] + tote[e], n = pend[e] - from; if (tid < n) BTOK[from + tid] = 0; }
                if (chunk == 0) {
                    for (int blk = tid; blk < NBLK; blk += 512) { int e = 0; for (int q = 0; q < 32; ++q) e += (pend[q] <= blk * 256) ? 1 : 0; BLKE[blk] = e > 31 ? 31 : e; }
                    if (tid == 0) BLKE[1000] = pend[31] >> 8;
                }
                __syncthreads();
            }
        }
        SEAM(pb + P_PLACE);
        if (EN(8) && IN(pb + P_GU)) {
            PHASE_ENTER();
            const int nused = BLKE[1000];
            pg8::Gemm g{GU_F8 ? (const bf16_t*)H2F8 : H, (const bf16_t*)(const GAS bf16_t*)(ws + WS_WGU + (size_t)l * NEXP * (GU_F8 ? MiB : 2 * MiB)), GU_F8 ? DM / 2 : DM};
            pg8::MoeOrder<true> S{BLKE, BTOK, 4 * nused, G, vcu};
            pg8::EpiSwiGLU E{ACT, GU_F8 ? W8I : 1.0f};
#pragma unroll 1
            for (int rep = 0; rep < REP_GU; ++rep)
            pg8::gemm_phase<pg8::EpiSwiGLU, pg8::MoeOrder<true>, GU_F8 != 0>(lds, g, S, E, wave);
        }
        SEAM(pb + P_GU);
        if (EN(9) && IN(pb + P_DOWN)) {
            PHASE_ENTER();
            const int nused = BLKE[1000];
            pg8::Gemm g{ACT, (const bf16_t*)(const GAS bf16_t*)(ws + WS_WDN + (size_t)l * NEXP * (DN_F8 ? MiB / 2 : MiB)), DN_F8 ? DFF / 2 : DFF};
            pg8::MoeOrder<false> S{BLKE, nullptr, 4 * nused, G, vcu};
            pg8::EpiY E{YM};
#pragma unroll 1
            for (int rep = 0; rep < REP_DOWN; ++rep)
            pg8::gemm_phase<pg8::EpiY, pg8::MoeOrder<false>, DN_F8 != 0>(lds, g, S, E, wave);
        }
        SEAM(pb + P_DOWN);
    }
    if (EN(10) && IN(PH_FINAL)) {
        PHASE_ENTER();
        row_phase<false, true, false, false, true>(lds, tid, lane, wave, G, bx, x_in, XB, out, g_ffn, MOD, 0, 0, MOD + (size_t)NB * MODW, H, YM, POS, TW, WR, TE, TRK, CNT);
    }
#undef IN
#undef SEAM
#undef GRID_BAR
}

extern "C" void kernel_launch(void* const* d_in, const int* in_sizes, int n_in, void* d_out, int out_size, void* d_ws, size_t ws_size, hipStream_t stream) {
    static int grid = 0;
    if (grid == 0) {
        if (n_in != 18 || in_sizes[0] != TT * DM || out_size != TT * DM || ws_size < WS_END) { fprintf(stderr, "kernel_launch: unexpected shapes / workspace (n_in %d, ws %zu); nothing launched\n", n_in, ws_size); grid = -1; return; }
        int dev = 0, cus = 0, per_cu = 0;
        if (hipGetDevice(&dev) != hipSuccess || hipDeviceGetAttribute(&cus, hipDeviceAttributeMultiprocessorCount, dev) != hipSuccess) { grid = -1; return; }
        if (hipFuncSetAttribute((const void*)fwd_kernel, hipFuncAttributeMaxDynamicSharedMemorySize, LDS_BYTES) != hipSuccess) { fprintf(stderr, "kernel_launch: hipFuncSetAttribute failed\n"); grid = -1; return; }
        if (hipOccupancyMaxActiveBlocksPerMultiprocessor(&per_cu, (const void*)fwd_kernel, 512, LDS_BYTES) != hipSuccess || per_cu < 1) { fprintf(stderr, "kernel_launch: occupancy query says %d\n", per_cu); per_cu = 1; }
        (void)hipGetLastError();
        grid = cus;
    }
    if (grid < 0) return;
    (void)hipMemsetAsync((char*)d_ws + WS_CTL, 0, CTL_ZERO_BYTES, stream);
    Args a{};
    for (int i = 0; i < 18; ++i) a.in[i] = (const float*)d_in[i];
    a.out = (float*)d_out; a.ws = (unsigned char*)d_ws;
#if MK_ONE_LAUNCH
    a.ph_lo = 0; a.ph_hi = NPH;
    hipLaunchKernelGGL(fwd_kernel, dim3(grid), dim3(512), LDS_BYTES, stream, a);
#else
    for (int p = 0; p < NPH; ++p) { a.ph_lo = p; a.ph_hi = p + 1; hipLaunchKernelGGL(fwd_kernel, dim3(grid), dim3(512), LDS_BYTES, stream, a); }
#endif
}
```

```cpp
#include <hip/hip_runtime.h>
#include <cstdio>
#include <cstdint>

#ifndef INPROJ_WGM
#define INPROJ_WGM 4
#endif
#ifndef GEMM_ALIGN
#define GEMM_ALIGN 1
#endif
#ifndef ROWB
#define ROWB 4
#endif
#ifndef N1K_WGM
#define N1K_WGM 8
#endif
#ifndef OUT_ROWMAJOR
#define OUT_ROWMAJOR 0
#endif
#ifndef REP_PRO
#define REP_PRO 1
#endif
#ifndef REP_ATTB
#define REP_ATTB 1
#endif
#ifndef REP_ATTA
#define REP_ATTA 1
#endif
#ifndef REP_INPROJ
#define REP_INPROJ 1
#endif
#ifndef REP_NORM1
#define REP_NORM1 1
#endif
#ifndef REP_GU
#define REP_GU 1
#endif
#ifndef REP_PAB
#define REP_PAB 1
#endif
#ifndef REP_OUT
#define REP_OUT 1
#endif
#ifndef REP_DOWN
#define REP_DOWN 1
#endif
#ifndef REP_NORM2
#define REP_NORM2 1
#endif
#ifndef GU_F8
#define GU_F8 1
#endif
#ifndef DN_F8
#define DN_F8 1
#endif
#ifndef MK_ONE_LAUNCH
#define MK_ONE_LAUNCH 1
#endif

#define LAS __attribute__((address_space(3)))
#define GAS __attribute__((address_space(1)))
typedef unsigned short bf16_t;
typedef short bf16x8 __attribute__((ext_vector_type(8)));
typedef short s16x4 __attribute__((ext_vector_type(4)));
typedef float f32x4 __attribute__((ext_vector_type(4)));
typedef float f32x16 __attribute__((ext_vector_type(16)));
typedef unsigned u32x4 __attribute__((ext_vector_type(4)));
typedef unsigned u32x2 __attribute__((ext_vector_type(2)));

constexpr int NB = 32, SEQ = 2048, DM = 1024, TT = NB * SEQ;
constexpr int NC = 4352;
constexpr int NEXP = 32, DFF = 512, NPAD = 139264, NBLK = 544;
constexpr int MODW = 6 * DM;
constexpr float QSCALE = 0.125f * 1.4426950408889634f;

constexpr size_t MiB = 1u << 20;
constexpr size_t WS_CTL = 0, CTL_ZERO_BYTES = 64 * 1024;
constexpr size_t WS_MOD = 1 * MiB;
constexpr size_t WS_TE = 2 * MiB + 512 * 1024, WS_TRK = 3 * MiB, WS_TW = 3 * MiB + 512 * 1024, WS_POS = 4 * MiB;
constexpr size_t WS_CNT = 4 * MiB + 512 * 1024;
constexpr size_t WS_BLKE = WS_CNT + 64 * 1024;
constexpr size_t WS_BTOK = WS_CNT + 128 * 1024;
constexpr size_t WS_WR = 5 * MiB + 256 * 1024;
constexpr size_t WS_WIN = 6 * MiB;
constexpr size_t WIN_BYTES = (size_t)NC * DM * 2;
constexpr size_t WS_WPA = 23 * MiB, WS_WPB = 25 * MiB, WS_WOUT = 27 * MiB;
constexpr size_t WS_WGU = 31 * MiB;
constexpr size_t WS_WDN = 159 * MiB;
constexpr size_t WS_H = 223 * MiB;
constexpr size_t WS_QKV = 351 * MiB;
constexpr size_t WS_GATE = 639 * MiB;
constexpr size_t WS_XB = 896 * MiB;
constexpr size_t WS_END = 1024 * MiB;
constexpr int CW_BAR = 4096;

constexpr int RING_BYTES = 133120;
constexpr int MISC_OFF = RING_BYTES;
constexpr int LDS_BYTES = 147456;

#define RLX_AGENT __ATOMIC_RELAXED, __HIP_MEMORY_SCOPE_AGENT
typedef float f32x2_t __attribute__((ext_vector_type(2))); typedef __bf16 bf16x2_t __attribute__((ext_vector_type(2)));
__device__ __forceinline__ unsigned cvt_pk_bf16(float lo, float hi) { const f32x2_t v = {lo, hi}; const bf16x2_t b = __builtin_convertvector(v, bf16x2_t); return __builtin_bit_cast(unsigned, b); }
typedef float f32x2v __attribute__((ext_vector_type(2)));
__device__ __forceinline__ unsigned pack4_fp8(float a, float b, float c, float d) { unsigned w = 0; w = __builtin_amdgcn_cvt_pk_fp8_f32(a, b, w, false); w = __builtin_amdgcn_cvt_pk_fp8_f32(c, d, w, true); return w; }
__device__ __forceinline__ void unpack8_fp8(u32x2 w, float (&o)[8]) { const f32x2v a = __builtin_amdgcn_cvt_pk_f32_fp8(w.x, false), b = __builtin_amdgcn_cvt_pk_f32_fp8(w.x, true), c = __builtin_amdgcn_cvt_pk_f32_fp8(w.y, false), d = __builtin_amdgcn_cvt_pk_f32_fp8(w.y, true);
    o[0] = a.x; o[1] = a.y; o[2] = b.x; o[3] = b.y; o[4] = c.x; o[5] = c.y; o[6] = d.x; o[7] = d.y; }
constexpr float A8S = 4.f, A8I = 0.25f;
constexpr float W8S = 64.f, W8I = 1.f / 64.f;
__device__ __forceinline__ float bf_lo(unsigned w) { return __uint_as_float(w << 16); }
__device__ __forceinline__ float bf_hi(unsigned w) { return __uint_as_float(w & 0xffff0000u); }
__device__ __forceinline__ float shx(float v, int mask, int lane) { return __int_as_float(__builtin_amdgcn_ds_bpermute((lane ^ mask) << 2, __float_as_int(v))); }
__device__ __forceinline__ float wave_sum(float v, int lane) {
#pragma unroll
    for (int o = 1; o < 64; o <<= 1) v += shx(v, o, lane);
    return v;
}
__device__ __forceinline__ float wave_max(float v, int lane) {
#pragma unroll
    for (int o = 1; o < 64; o <<= 1) v = fmaxf(v, shx(v, o, lane));
    return v;
}
__device__ __forceinline__ float sigmoid_f(float x) { return __builtin_amdgcn_rcpf(1.0f + __builtin_amdgcn_exp2f(-1.4426950408889634f * x)); }

#define XB_TMO      128
#define XB_XCNT(j)  (256  + 64 * (j))
#define XB_XSUB(j)  (1280 + 64 * (j))
#define XB_XGEN(j)  (2304 + 64 * (j))
#define XB_TOP      3328
#define XB_TOPGEN   3392
#define XCD_BAR_WORDS 3456
#define XB_SPIN_CAP (1u << 18)

__device__ __forceinline__ unsigned xb_ld(unsigned* p)              { return __hip_atomic_load(p, __ATOMIC_RELAXED, __HIP_MEMORY_SCOPE_AGENT); }
__device__ __forceinline__ unsigned xb_add(unsigned* p, unsigned v) { return __hip_atomic_fetch_add(p, v, __ATOMIC_RELAXED, __HIP_MEMORY_SCOPE_AGENT); }
__device__ __forceinline__ unsigned xb_xcc_id() { return (unsigned)__builtin_amdgcn_s_getreg((3 << 11) | 20) & 0xFu; }
#define XB_SPIN(cond, bar) do { unsigned _sp = 0; while (cond) { __builtin_amdgcn_s_sleep(1); \
    if ((++_sp & 255u) == 0u) { if (xb_ld(&(bar)[XB_TMO])) break; if (_sp > XB_SPIN_CAP) { atomicAdd(&(bar)[XB_TMO], 1u); break; } } } } while (0)

struct XcdBarrier { unsigned* bar; unsigned x; volatile LAS unsigned* st; };

__device__ __forceinline__ XcdBarrier xcd_barrier_post(unsigned* bar, volatile LAS unsigned* st) {
    XcdBarrier b; b.bar = bar; b.x = xb_xcc_id(); b.st = st;
    if (threadIdx.x == 0) (void)xb_add(&bar[XB_XCNT(b.x)], 1u);
    return b;
}
__device__ __forceinline__ void xcd_barrier_complete(unsigned* bar, unsigned x, unsigned& nloc, unsigned& nx) {
    const unsigned G = gridDim.x * gridDim.y * gridDim.z;
    unsigned sum, cnt, mine, sp = 0u;
    for (;;) {
        sum = 0u; cnt = 0u; mine = 0u;
#pragma unroll
        for (unsigned j = 0; j < 16; ++j) { const unsigned c = xb_ld(&bar[XB_XCNT(j)]); sum += c; cnt += (c > 0u) ? 1u : 0u; mine = (j == x) ? c : mine; }
        if (sum == G) break;
        __builtin_amdgcn_s_sleep(1);
        if ((++sp & 255u) == 0u) { if (xb_ld(&bar[XB_TMO])) break; if (sp > XB_SPIN_CAP) { atomicAdd(&bar[XB_TMO], 1u); break; } }
    }
    nloc = mine > 0u ? mine : 1u; nx = cnt > 0u ? cnt : 1u;
}
__device__ __forceinline__ void xcd_barrier(const XcdBarrier& b, const bool is_t0  ) {
    asm volatile("s_waitcnt vmcnt(0)" ::: "memory");
    __syncthreads();
    if (is_t0) {
        unsigned* bar = b.bar; unsigned bx_ = b.x;
        asm volatile("" : "+s"(bar), "+s"(bx_));
        __builtin_amdgcn_s_waitcnt(0);
        unsigned nloc = b.st[0], nx = b.st[1];
        if (nloc == 0u) { xcd_barrier_complete(bar, bx_, nloc, nx); b.st[0] = nloc; b.st[1] = nx; }
        const unsigned old = xb_add(&bar[XB_XSUB(bx_)], 1u);
        const unsigned gen = old / nloc;
        if (old + 1u == (gen + 1u) * nloc) {
            __builtin_amdgcn_fence(__ATOMIC_RELEASE, "agent");
            asm volatile("s_waitcnt vmcnt(0)" ::: "memory");
            const unsigned og = xb_add(&bar[XB_TOP], 1u);
            const unsigned tg = og / nx;
            if (og + 1u == (tg + 1u) * nx) xb_add(&bar[XB_TOPGEN], 1u);
            else XB_SPIN(xb_ld(&bar[XB_TOPGEN]) == tg, bar);
            __builtin_amdgcn_fence(__ATOMIC_ACQUIRE, "agent");
            xb_add(&bar[XB_XGEN(bx_)], 1u);
            asm volatile("s_waitcnt vmcnt(0)" ::: "memory");
        } else {
            XB_SPIN(xb_ld(&bar[XB_XGEN(bx_)]) == gen, bar);
            __builtin_amdgcn_fence(__ATOMIC_ACQUIRE, "agent");
            asm volatile("s_waitcnt vmcnt(0)" ::: "memory");
        }
    }
    __syncthreads();
}

namespace pg8 {
constexpr int BM = 256, BK = 64, HALF = 128, HTB = HALF * BK * 2, STAGE_BYTES = 8 * HTB, NXCD = 8, WGM = 8;
__host__ __device__ __forceinline__ int lds_byte(int r, int c) { const int st = (r >> 4) * 2 + (c >> 5), rr = r & 15, cc = c & 31, ob = rr * 64 + cc * 2; return st * 1024 + (ob ^ (((ob >> 9) & 1) << 5)); }
__host__ __device__ __forceinline__ void stage_rc(int b, int& R, int& C) { const int st = b / 1024, sb = b % 1024, swz = sb ^ (((sb >> 9) & 1) << 5); R = (st >> 1) * 16 + swz / 64; C = (st & 1) * 32 + (swz % 64) / 2; }
__host__ __device__ __forceinline__ int perm32(int rho) { const int n = rho >> 4, i = rho & 15; return 8 * (i >> 2) + 4 * n + (i & 3); }

struct Unit { int pm, pn; };
struct Gemm { const bf16_t* A; const bf16_t* Bt; int K; };

struct StaticOrder {
    static constexpr bool GATHER = false;
    int nM, nN, nwg, G, c, wgm = WGM;
    __device__ void init(int M, int N, int G_, int c_) { asm volatile("" : "+s"(c_));     nM = M / BM; nN = N / BM; nwg = nM * nN; G = G_; c = c_; }
    int rowmajor = 0;
    __device__ __forceinline__ bool next(int i, Unit& u) const {
        if (rowmajor) { const int upw = (nwg + G - 1) / G, k = c * upw + i; if (i >= upw || k >= nwg) return false; u.pm = k / nN; u.pn = k % nN; return true; }
        const long L = (long)i * G + c; if (L >= nwg) return false;
        int wgid = (int)L; { const int q = nwg / NXCD, r = nwg % NXCD, xcd = wgid % NXCD, off = wgid / NXCD; wgid = (xcd < r ? xcd * (q + 1) : r * (q + 1) + (xcd - r) * q) + off; }
        const int nig = wgm * nN, gid = wgid / nig, fm = gid * wgm, gsz = (nM - fm) < wgm ? (nM - fm) : wgm;
        u.pm = fm + ((wgid % nig) % gsz); u.pn = (wgid % nig) / gsz; return true;
    }
    __device__ __forceinline__ void aoff(const Unit&, int, int, unsigned (&)[2][2]) const {}
};
template <bool GATH>
struct MoeOrder {
    static constexpr bool GATHER = GATH;
    const int* blk_e; const int* rowidx; int nunits, G, c;
    __device__ __forceinline__ bool next(int i, Unit& u) const {
        const int L = i * G + c; if (L >= nunits) return false;
        const int blk = L >> 2; const int e = blk_e[blk]; u.pm = blk; u.pn = 4 * e + (L & 3); return true;
    }
    __device__ __forceinline__ void aoff(const Unit& u, int tid_, int K, unsigned (&o)[2][2]) const {
        int tid = tid_; asm volatile("" : "+v"(tid));
#pragma unroll
        for (int i = 0; i < 2; ++i) { int R, C; stage_rc(tid * 16 + i * 8192, R, C);
#pragma unroll
            for (int h = 0; h < 2; ++h) { const int r = u.pm * BM + h * HALF + R; const int src = rowidx ? rowidx[r] : r; o[h][i] = (unsigned)src * (unsigned)(K * 2) + (unsigned)C * 2u; } }
    }
};

typedef int i32x8 __attribute__((ext_vector_type(8))); typedef int i32x4 __attribute__((ext_vector_type(4)));
__device__ __forceinline__ i32x8 cat8(const bf16x8& a, const bf16x8& b) { return __builtin_shufflevector(__builtin_bit_cast(i32x4, a), __builtin_bit_cast(i32x4, b), 0, 1, 2, 3, 4, 5, 6, 7); }
template <class Epi, class Sched, bool F8 = false>
__device__ __forceinline__ void gemm_phase(LAS unsigned char* lds, const Gemm g, const Sched& S, const Epi& E, const int wid) {
    int lane_; asm volatile("v_mbcnt_lo_u32_b32 %0, -1, 0\n\tv_mbcnt_hi_u32_b32 %0, -1, %0" : "=v"(lane_));
    const int lane = lane_, tid = wid * 64 + lane, wr = wid >> 2, wc = wid & 3, fr = lane & 15, fq = lane >> 4;
    const int K = g.K, nt = K / BK;
    unsigned voffA[2], voffB[2];
#pragma unroll
    for (int i = 0; i < 2; ++i) { int R, C; stage_rc(tid * 16 + i * 8192, R, C); const int Rb = Epi::PERM ? ((R & ~31) + perm32(R & 31)) : R;
        voffA[i] = (unsigned)(R * K + C) * 2u; voffB[i] = (unsigned)(Rb * K + C) * 2u; }
    const size_t kstep = (size_t)(BK * 2);
    const size_t hstep = (size_t)HALF * K * 2;
    const size_t tstep = 2 * hstep;
    const unsigned ldsw = (unsigned)wid * 1024u;
    const int aoff = lds_byte(wr * 64 + fr, fq * 8), boff = lds_byte(wc * 32 + fr, fq * 8);
    const char* Ab = (const char*)g.A;
#define PG8_SA(b, h) (((b) * 2 + (h)) * HTB)
#define PG8_SB(b, h) ((4 + (b) * 2 + (h)) * HTB)
#define PG8_UNI(p) asm volatile("" : "+s"(p))
#define PG8_LOFF(v) asm volatile("" : "+v"(v))
#define PG8_STAGEB(bufoff, gbase, voff) do { const char* _g = (const char*)(gbase); PG8_UNI(_g); _Pragma("unroll") for (int _i = 0; _i < 2; ++_i) { unsigned _v = (voff)[_i]; PG8_LOFF(_v); \
        __builtin_amdgcn_global_load_lds((const unsigned*)(_g + _v), (LAS unsigned*)(lds + (bufoff) + ldsw + _i * 8192), 16, 0, 0); } } while (0)
#define PG8_STAGEA(bufoff, H_, kb, NEXT) do { if constexpr (Sched::GATHER) { const char* _g = Ab + (size_t)(kb); PG8_UNI(_g); _Pragma("unroll") for (int _i = 0; _i < 2; ++_i) { unsigned _o = (NEXT) ? na[H_][_i] : ca[H_][_i]; PG8_LOFF(_o); \
            __builtin_amdgcn_global_load_lds((const unsigned*)(_g + _o), (LAS unsigned*)(lds + (bufoff) + ldsw + _i * 8192), 16, 0, 0); } } \
        else { const char* _b = Ab + ((NEXT) ? nU : cU) + (size_t)(H_) * hstep + (size_t)(kb); PG8_UNI(_b); _Pragma("unroll") for (int _i = 0; _i < 2; ++_i) { unsigned _v = voffA[_i]; PG8_LOFF(_v); \
            __builtin_amdgcn_global_load_lds((const unsigned*)(_b + _v), (LAS unsigned*)(lds + (bufoff) + ldsw + _i * 8192), 16, 0, 0); } } } while (0)
#define PG8_LDA(dst, b, h) do { _Pragma("unroll") for (int m = 0; m < 4; ++m) _Pragma("unroll") for (int k = 0; k < 2; ++k) dst[m][k] = *(const LAS bf16x8*)(lds + PG8_SA(b, h) + aoff + m * 2048 + k * 1024); } while (0)
#define PG8_LDB(dst, b, h) do { _Pragma("unroll") for (int n = 0; n < 2; ++n) _Pragma("unroll") for (int k = 0; k < 2; ++k) dst[n][k] = *(const LAS bf16x8*)(lds + PG8_SB(b, h) + boff + n * 2048 + k * 1024); } while (0)
#define PG8_MMA(ai, bj, At, Bt) do { __builtin_amdgcn_s_setprio(1); _Pragma("unroll") for (int m = 0; m < 4; ++m) _Pragma("unroll") for (int n = 0; n < 2; ++n) { \
        if constexpr (F8) { const i32x8 b_ = cat8(Bt[n][0], Bt[n][1]), a_ = cat8(At[m][0], At[m][1]); \
            asm volatile("v_mfma_f32_16x16x128_f8f6f4 %0, %1, %2, %0" : "+v"(acc[ai][bj][m][n]) : "v"(b_), "v"(a_)); } \
        else { _Pragma("unroll") for (int k = 0; k < 2; ++k) acc[ai][bj][m][n] = __builtin_amdgcn_mfma_f32_16x16x32_bf16(Bt[n][k], At[m][k], acc[ai][bj][m][n], 0, 0, 0); } } \
        __builtin_amdgcn_s_setprio(0); } while (0)
#define PG8_MFMA_DRAIN asm volatile("s_nop 7\n\ts_nop 7\n\ts_nop 3" ::: "memory")
#define PG8_WAIT_V(n) asm volatile("s_waitcnt vmcnt(" #n ")" ::: "memory")
#define PG8_WAIT_L(n) asm volatile("s_waitcnt lgkmcnt(" #n ")" ::: "memory")
#define PG8_BAR __builtin_amdgcn_s_barrier()
#define PG8_SCHED __builtin_amdgcn_sched_barrier(0)
    Unit cur, nxt; int ui = 0;
    if (!S.next(0, cur)) return;
    f32x4 acc[2][2][4][2];
#pragma unroll
    for (int a = 0; a < 2; ++a)
#pragma unroll
        for (int b = 0; b < 2; ++b)
#pragma unroll
            for (int m = 0; m < 4; ++m)
#pragma unroll
                for (int n = 0; n < 2; ++n) acc[a][b][m][n] = (f32x4){0.f, 0.f, 0.f, 0.f};
    bf16x8 At[4][2], B0[2][2], B1[2][2];
    unsigned ca[2][2], na[2][2];
    size_t cU = 0, nU = 0;
    if constexpr (Sched::GATHER) S.aoff(cur, tid, K, ca); else cU = (size_t)cur.pm * tstep;
    const char* cB = (const char*)g.Bt + (size_t)cur.pn * tstep;
    PG8_STAGEB(PG8_SB(0, 0), cB, voffB); PG8_STAGEB(PG8_SB(0, 1), cB + hstep, voffB); PG8_STAGEA(PG8_SA(0, 0), 0, 0, false); PG8_STAGEA(PG8_SA(0, 1), 1, 0, false);
    if (wr == 1) PG8_BAR;
    PG8_WAIT_V(2); PG8_BAR;
    PG8_STAGEB(PG8_SB(1, 0), cB + kstep, voffB); PG8_STAGEA(PG8_SA(1, 0), 0, kstep, false); PG8_STAGEB(PG8_SB(1, 1), cB + hstep + kstep, voffB);
    PG8_WAIT_V(6); PG8_BAR;
    for (;;) {
        const bool has_next = S.next(ui + 1, nxt);
        if constexpr (Sched::GATHER) {
            if (has_next) S.aoff(nxt, tid, K, na);
            else {
#pragma unroll
                for (int h = 0; h < 2; ++h)
#pragma unroll
                    for (int i = 0; i < 2; ++i) na[h][i] = ca[h][i];
            }
        } else nU = has_next ? (size_t)nxt.pm * tstep : cU;
        const char* nB = has_next ? (const char*)g.Bt + (size_t)nxt.pn * tstep : cB;
#pragma unroll 1
        for (int t = 0; t < nt; t += 2) {
            const bool last = (t == nt - 2);
            const size_t kb1 = (size_t)(t + 1) * kstep;
            const size_t kb2 = last ? 0 : (size_t)(t + 2) * kstep, kb3 = kb2 + kstep;
            const char* b2 = last ? nB : cB + (size_t)(t + 2) * kstep; const char* b3 = b2 + kstep;
            PG8_LDB(B0, 0, 0); PG8_LDB(B1, 0, 1); PG8_SCHED; PG8_LDA(At, 0, 0); PG8_STAGEA(PG8_SA(1, 1), 1, kb1, false);
            PG8_WAIT_V(8); PG8_WAIT_L(0); PG8_BAR; PG8_MMA(0, 0, At, B0); PG8_MMA(0, 1, At, B1); PG8_BAR; PG8_SCHED;
            PG8_LDA(At, 0, 1); PG8_STAGEB(PG8_SB(0, 0), b2, voffB); PG8_STAGEB(PG8_SB(0, 1), b2 + hstep, voffB); PG8_STAGEA(PG8_SA(0, 0), 0, kb2, last);
            PG8_WAIT_V(8); PG8_WAIT_L(0); PG8_BAR; PG8_MMA(1, 0, At, B0); PG8_MMA(1, 1, At, B1); PG8_BAR; PG8_SCHED;
            PG8_LDB(B0, 1, 0); PG8_LDB(B1, 1, 1); PG8_SCHED; PG8_LDA(At, 1, 0); PG8_STAGEA(PG8_SA(0, 1), 1, kb2, last);
            PG8_WAIT_V(8); PG8_WAIT_L(0); PG8_BAR; PG8_MMA(0, 0, At, B0); PG8_MMA(0, 1, At, B1); PG8_BAR; PG8_SCHED;
            PG8_LDA(At, 1, 1); PG8_STAGEB(PG8_SB(1, 0), b3, voffB); PG8_STAGEB(PG8_SB(1, 1), b3 + hstep, voffB); PG8_STAGEA(PG8_SA(1, 0), 0, kb3, last);
            PG8_WAIT_V(8); PG8_WAIT_L(0); PG8_BAR; PG8_MMA(1, 0, At, B0); PG8_MMA(1, 1, At, B1); PG8_BAR; PG8_SCHED;
            if constexpr (Epi::MIDK) { if (t + 2 == nt / 2) { if constexpr (F8) PG8_MFMA_DRAIN; E.mid(acc, cur, wr, wc, fr, fq); if constexpr (F8) asm volatile("s_nop 3" ::: "memory"); } }
        }
#if GEMM_ALIGN
        if (wr == 0) PG8_BAR;
#endif
        if constexpr (F8) PG8_MFMA_DRAIN;
        E(acc, cur, wr, wc, fr, fq);
        if (!has_next) break;
#pragma unroll
        for (int a = 0; a < 2; ++a)
#pragma unroll
            for (int b = 0; b < 2; ++b)
#pragma unroll
                for (int m = 0; m < 4; ++m)
#pragma unroll
                    for (int n = 0; n < 2; ++n) acc[a][b][m][n] = (f32x4){0.f, 0.f, 0.f, 0.f};
        cur = nxt; cB = nB; cU = nU; ++ui;
        if constexpr (Sched::GATHER) {
#pragma unroll
            for (int h = 0; h < 2; ++h)
#pragma unroll
                for (int i = 0; i < 2; ++i) ca[h][i] = na[h][i];
        }
#if GEMM_ALIGN
        if (wr == 1) PG8_BAR;
#endif
    }
    PG8_WAIT_V(0);
#if !GEMM_ALIGN
    if (wr == 0) PG8_BAR;
#endif
    PG8_BAR;
#undef PG8_SA
#undef PG8_SB
#undef PG8_STAGEA
#undef PG8_STAGEB
#undef PG8_UNI
#undef PG8_LOFF
#undef PG8_LDA
#undef PG8_LDB
#undef PG8_MMA
#undef PG8_WAIT_V
#undef PG8_MFMA_DRAIN
#undef PG8_WAIT_L
#undef PG8_BAR
#undef PG8_SCHED
}

typedef const f32x4 (&AccRef)[2][2][4][2];

__device__ __forceinline__ u32x4 pack8(const f32x4& a, const f32x4& b) { u32x4 w; w.x = cvt_pk_bf16(a[0], a[1]); w.y = cvt_pk_bf16(a[2], a[3]); w.z = cvt_pk_bf16(b[0], b[1]); w.w = cvt_pk_bf16(b[2], b[3]); return w; }

struct EpiInProj {
    static constexpr bool PERM = true, MIDK = false;
    bf16_t *QA, *KA, *VA, *QB, *KB, *VB, *SA, *SB;
    const LAS float* normw;
    template <int ROPE>
    __device__ __forceinline__ void head_tile(AccRef acc, bf16_t* dst_, int ld, int hcol, int gsel, float scale, int row0, int fr, int fq) const {
        unsigned char* dst = (unsigned char*)dst_;
        int d0[2];
#pragma unroll
        for (int bj = 0; bj < 2; ++bj) d0[bj] = (ROPE == 1) ? (fq == 0 ? 8 * bj : 8 + 8 * fq + 24 * bj) : (fq < 2 ? 8 * fq + 16 * bj : 16 + 8 * fq + 16 * bj);
        f32x4 g[2][2];
#pragma unroll
        for (int bj = 0; bj < 2; ++bj)
#pragma unroll
            for (int n = 0; n < 2; ++n) g[bj][n] = *(const LAS f32x4*)(normw + gsel * 64 + d0[bj] + 4 * n);
        constexpr float FA[8] = {1.591549431e-01f, 3.086376340e-02f, 5.985185713e-03f, 1.160663641e-03f, 2.250790790e-04f, 4.364795279e-05f, 8.464330808e-06f, 1.641426263e-06f};
        constexpr float FB[16] = {1.591549431e-01f, 8.949940161e-02f, 5.032921210e-02f, 2.830219583e-02f, 1.591549431e-02f, 8.949940161e-03f, 5.032921210e-03f, 2.830219583e-03f,
                                  1.591549431e-03f, 8.949940161e-04f, 5.032921210e-04f, 2.830219583e-04f, 1.591549431e-04f, 8.949940161e-05f, 5.032921210e-05f, 2.830219583e-05f};
        float fq8[8];
#pragma unroll
        for (int k = 0; k < 8; ++k) fq8[k] = (ROPE == 1) ? FA[k] : ((fq & 1) ? FB[8 + k] : FB[k]);
        const bool rot = (ROPE == 2) || (fq == 0);
#pragma unroll
        for (int ai = 0; ai < 2; ++ai)
#pragma unroll
            for (int m = 0; m < 4; ++m) {
                const int row = row0 + ai * HALF + m * 16; const int s = row & (SEQ - 1);
                f32x4 y[2][2]; float ss = 0.f;
#pragma unroll
                for (int bj = 0; bj < 2; ++bj)
#pragma unroll
                    for (int n = 0; n < 2; ++n) { y[bj][n] = acc[ai][bj][m][n]; const f32x4 q = y[bj][n] * y[bj][n]; ss += (q[0] + q[1]) + (q[2] + q[3]); }
                ss += shx(ss, 16, fr + 16 * fq); ss += shx(ss, 32, fr + 16 * fq);
                const float rinv = __builtin_amdgcn_rsqf(ss * (W8I * W8I / 64.0f) + 1e-6f) * W8I;
#pragma unroll
                for (int bj = 0; bj < 2; ++bj)
#pragma unroll
                    for (int n = 0; n < 2; ++n) y[bj][n] = y[bj][n] * rinv * g[bj][n];
                if (ROPE != 0) {
                    const float pos = (float)((ROPE == 1) ? s : (fq < 2 ? (s >> 6) : (s & 63)));
#pragma unroll
                    for (int n = 0; n < 2; ++n)
#pragma unroll
                        for (int j = 0; j < 4; ++j) {
                            const float xr = __builtin_amdgcn_fractf(pos * fq8[4 * n + j]);
                            const float c = rot ? __builtin_amdgcn_cosf(xr) : 1.0f, s_ = rot ? __builtin_amdgcn_sinf(xr) : 0.0f;
                            const float x1 = y[0][n][j], x2 = y[1][n][j];
                            y[0][n][j] = x1 * c - x2 * s_; y[1][n][j] = x2 * c + x1 * s_;
                        }
                }
                u32x4 w;
#pragma unroll
                for (int bj = 0; bj < 2; ++bj) { const f32x4 a = y[bj][0] * scale, c = y[bj][1] * scale;
                    const unsigned lo = pack4_fp8(a[0], a[1], a[2], a[3]), hi = pack4_fp8(c[0], c[1], c[2], c[3]);
                    if (bj == 0) { w.x = lo; w.y = hi; } else { w.z = lo; w.w = hi; } }
                *(u32x4*)(dst + (size_t)row * ld + hcol + 16 * fq) = w;
            }
    }
    __device__ __forceinline__ void operator()(AccRef acc, const Unit& u, int wr, int wc, int fr_, int fq_) const {
        int fr = fr_, fq = fq_; asm volatile("" : "+v"(fr), "+v"(fq));
        const int pn = u.pn; const int row0 = u.pm * BM + wr * 64 + fr;
        if (pn >= 9) {
            unsigned char* base = (unsigned char*)((pn < 13) ? SA : SB); const int colt = ((pn - 9) & 3) * 256 + wc * 64 + 16 * fq;
#pragma unroll
            for (int ai = 0; ai < 2; ++ai)
#pragma unroll
                for (int m = 0; m < 4; ++m) { u32x4 w;
#pragma unroll
                    for (int bj = 0; bj < 2; ++bj) { f32x4 v0 = acc[ai][bj][m][0], v1 = acc[ai][bj][m][1];
#pragma unroll
                        for (int j = 0; j < 4; ++j) { v0[j] = sigmoid_f(v0[j] * W8I); v1[j] = sigmoid_f(v1[j] * W8I); }
                        const unsigned lo = pack4_fp8(v0[0], v0[1], v0[2], v0[3]), hi = pack4_fp8(v1[0], v1[1], v1[2], v1[3]);
                        if (bj == 0) { w.x = lo; w.y = hi; } else { w.z = lo; w.w = hi; } }
                    *(u32x4*)(base + (size_t)(row0 + ai * HALF + m * 16) * DM + colt) = w; }
        } else if (pn == 4 || pn == 5) {
            const int colt = (pn - 4) * 256 + wc * 64 + 16 * fq;
#pragma unroll
            for (int ai = 0; ai < 2; ++ai)
#pragma unroll
                for (int m = 0; m < 4; ++m) { u32x4 w;
                    { const f32x4 a = acc[ai][0][m][0] * W8I, c = acc[ai][0][m][1] * W8I; w.x = pack4_fp8(a[0], a[1], a[2], a[3]); w.y = pack4_fp8(c[0], c[1], c[2], c[3]); }
                    { const f32x4 a = acc[ai][1][m][0] * W8I, c = acc[ai][1][m][1] * W8I; w.z = pack4_fp8(a[0], a[1], a[2], a[3]); w.w = pack4_fp8(c[0], c[1], c[2], c[3]); }
                    *(u32x4*)((unsigned char*)VA + (size_t)(row0 + ai * HALF + m * 16) * 512 + colt) = w; }
        } else if (pn < 2)  head_tile<1>(acc, QA, 512, 64 * (4 * pn + wc), 0, QSCALE, row0, fr, fq);
        else if (pn < 4)    head_tile<1>(acc, KA, 512, 64 * (4 * (pn - 2) + wc), 1, 1.0f, row0, fr, fq);
        else if (pn < 8)    head_tile<2>(acc, QB, 512, 64 * (4 * (pn - 6) + wc), 2, QSCALE, row0, fr, fq);
        else if (wc < 2)    head_tile<2>(acc, KB, 128, 64 * wc, 3, 1.0f, row0, fr, fq);
        else {
#pragma unroll
            for (int ai = 0; ai < 2; ++ai)
#pragma unroll
                for (int m = 0; m < 4; ++m) { u32x4 w;
                    { const f32x4 a = acc[ai][0][m][0] * W8I, c = acc[ai][0][m][1] * W8I; w.x = pack4_fp8(a[0], a[1], a[2], a[3]); w.y = pack4_fp8(c[0], c[1], c[2], c[3]); }
                    { const f32x4 a = acc[ai][1][m][0] * W8I, c = acc[ai][1][m][1] * W8I; w.z = pack4_fp8(a[0], a[1], a[2], a[3]); w.w = pack4_fp8(c[0], c[1], c[2], c[3]); }
                    *(u32x4*)((unsigned char*)VB + (size_t)(row0 + ai * HALF + m * 16) * 128 + 64 * (wc - 2) + 16 * fq) = w; }
        }
    }
};

struct EpiMergeFused {
    static constexpr bool PERM = true, MIDK = true;
    bf16_t* MG; const unsigned char* GA; const unsigned char* GB;
    __device__ __forceinline__ void mid(f32x4 (&acc)[2][2][4][2], const Unit& u, int wr, int wc, int fr_, int fq_) const {
        int fr = fr_, fq = fq_; asm volatile("" : "+v"(fr), "+v"(fq));
        const int row0 = u.pm * BM + wr * 64 + fr, col0 = u.pn * BM + wc * 64 + 16 * fq;
#pragma unroll
        for (int ai = 0; ai < 2; ++ai)
#pragma unroll
            for (int m = 0; m < 4; ++m) { const size_t ro = (size_t)(row0 + ai * HALF + m * 16) * DM + col0;
                const u32x4 a = *(const u32x4*)(GA + ro), b = *(const u32x4*)(GB + ro);
#pragma unroll
                for (int bj = 0; bj < 2; ++bj) {
                    float sa[8], sb[8]; unpack8_fp8(bj ? (u32x2){a.z, a.w} : (u32x2){a.x, a.y}, sa); unpack8_fp8(bj ? (u32x2){b.z, b.w} : (u32x2){b.x, b.y}, sb);
#pragma unroll
                    for (int n = 0; n < 2; ++n)
#pragma unroll
                        for (int j = 0; j < 4; ++j) acc[ai][bj][m][n][j] *= sa[4 * n + j] * __builtin_amdgcn_rcpf(fmaxf(sb[4 * n + j], 1e-12f));
                } }
    }
    __device__ __forceinline__ void operator()(AccRef acc, const Unit& u, int wr, int wc, int fr_, int fq_) const {
        int fr = fr_, fq = fq_; asm volatile("" : "+v"(fr), "+v"(fq));
        const int row0 = u.pm * BM + wr * 64 + fr, col0 = u.pn * BM + wc * 64 + 16 * fq;
#pragma unroll
        for (int ai = 0; ai < 2; ++ai)
#pragma unroll
            for (int m = 0; m < 4; ++m) { const size_t ro = (size_t)(row0 + ai * HALF + m * 16) * DM + col0;
                const u32x4 b = *(const u32x4*)(GB + ro); u32x4 w;
#pragma unroll
                for (int bj = 0; bj < 2; ++bj) {
                    float sb[8]; unpack8_fp8(bj ? (u32x2){b.z, b.w} : (u32x2){b.x, b.y}, sb);
                    f32x4 v0 = acc[ai][bj][m][0], v1 = acc[ai][bj][m][1];
                    constexpr float CS = A8I * W8I * A8S;
#pragma unroll
                    for (int j = 0; j < 4; ++j) { v0[j] *= fmaxf(sb[j], 1e-12f) * CS; v1[j] *= fmaxf(sb[4 + j], 1e-12f) * CS; }
                    const unsigned lo = pack4_fp8(v0[0], v0[1], v0[2], v0[3]), hi = pack4_fp8(v1[0], v1[1], v1[2], v1[3]);
                    if (bj == 0) { w.x = lo; w.y = hi; } else { w.z = lo; w.w = hi; } }
                *(u32x4*)((unsigned char*)MG + ro) = w; }
    }
};

struct EpiResidB {
    static constexpr bool PERM = true, MIDK = false;
    const float* Xf; const bf16_t* Xb; bf16_t* O; const float* gate;
    __device__ __forceinline__ void operator()(AccRef acc, const Unit& u, int wr, int wc, int fr_, int fq_) const {
        int fr = fr_, fq = fq_; asm volatile("" : "+v"(fr), "+v"(fq));
        const int row0 = u.pm * BM + wr * 64 + fr, col0 = u.pn * BM + wc * 64 + 16 * fq; const int b = (u.pm * BM) >> 11;
        f32x4 gt[2][2];
#pragma unroll
        for (int bj = 0; bj < 2; ++bj)
#pragma unroll
            for (int n = 0; n < 2; ++n) gt[bj][n] = *(const f32x4*)(gate + (size_t)b * MODW + col0 + 8 * bj + 4 * n) * (A8I * W8I);
#pragma unroll
        for (int ai = 0; ai < 2; ++ai)
#pragma unroll
            for (int m = 0; m < 4; ++m) { const size_t ro = (size_t)(row0 + ai * HALF + m * 16) * DM + col0;
#pragma unroll
                for (int bj = 0; bj < 2; ++bj) {
                    f32x4 x0, x1;
                    if (Xf) { x0 = *(const f32x4*)(Xf + ro + 8 * bj); x1 = *(const f32x4*)(Xf + ro + 8 * bj + 4); }
                    else { const u32x4 w = *(const u32x4*)(Xb + ro + 8 * bj); x0 = (f32x4){bf_lo(w.x), bf_hi(w.x), bf_lo(w.y), bf_hi(w.y)}; x1 = (f32x4){bf_lo(w.z), bf_hi(w.z), bf_lo(w.w), bf_hi(w.w)}; }
                    *(u32x4*)(O + ro + 8 * bj) = pack8(x0 + gt[bj][0] * acc[ai][bj][m][0], x1 + gt[bj][1] * acc[ai][bj][m][1]); } }
    }
};

struct EpiSwiGLU {
    static constexpr bool PERM = true, MIDK = false;
    bf16_t* ACT;
    float cs;
    __device__ __forceinline__ void operator()(AccRef acc, const Unit& u, int wr, int wc, int fr_, int fq_) const {
        int fr = fr_, fq = fq_; asm volatile("" : "+v"(fr), "+v"(fq));
        const int row0 = u.pm * BM + wr * 64 + fr, col0 = (u.pn & 3) * HALF + wc * 32 + 8 * fq;
#pragma unroll
        for (int ai = 0; ai < 2; ++ai)
#pragma unroll
            for (int m = 0; m < 4; ++m) { f32x4 r[2];
#pragma unroll
                for (int n = 0; n < 2; ++n)
#pragma unroll
                    for (int j = 0; j < 4; ++j) { const float gg = acc[ai][0][m][n][j] * cs, uu = acc[ai][1][m][n][j] * (DN_F8 ? cs * A8S : cs); r[n][j] = gg * sigmoid_f(gg) * uu; }
                if (DN_F8) *(u32x2*)((unsigned char*)ACT + (size_t)(row0 + ai * HALF + m * 16) * DFF + col0) = (u32x2){pack4_fp8(r[0][0], r[0][1], r[0][2], r[0][3]), pack4_fp8(r[1][0], r[1][1], r[1][2], r[1][3])};
                else *(u32x4*)(ACT + (size_t)(row0 + ai * HALF + m * 16) * DFF + col0) = pack8(r[0], r[1]); }
    }
};

struct EpiY {
    static constexpr bool PERM = true, MIDK = false;
    unsigned char* Y;
    __device__ __forceinline__ void operator()(AccRef acc, const Unit& u, int wr, int wc, int fr_, int fq_) const {
        int fr = fr_, fq = fq_; asm volatile("" : "+v"(fr), "+v"(fq));
        const int row0 = u.pm * BM + wr * 64 + fr, col0 = (u.pn & 3) * BM + wc * 64 + 16 * fq;
#pragma unroll
        for (int ai = 0; ai < 2; ++ai)
#pragma unroll
            for (int m = 0; m < 4; ++m) { u32x4 w;
                constexpr float CS = DN_F8 ? A8I * W8I : 1.0f;
                { const f32x4 a = acc[ai][0][m][0] * CS, b = acc[ai][0][m][1] * CS; w.x = pack4_fp8(a[0], a[1], a[2], a[3]); w.y = pack4_fp8(b[0], b[1], b[2], b[3]); }
                { const f32x4 a = acc[ai][1][m][0] * CS, b = acc[ai][1][m][1] * CS; w.z = pack4_fp8(a[0], a[1], a[2], a[3]); w.w = pack4_fp8(b[0], b[1], b[2], b[3]); }
                *(u32x4*)(Y + (size_t)(row0 + ai * HALF + m * 16) * DM + col0) = w; }
    }
};
}

__device__ __forceinline__ int dimA(int bj, int r) { return r < 8 ? r + 8 * bj : 16 + (r - 8) + 24 * bj; }
__device__ __forceinline__ int dimB(int bj, int r) { return r < 16 ? r + 16 * bj : 32 + (r - 16) + 16 * bj; }
__device__ __forceinline__ int inproj_srccol(int P) {
    const int pn = P >> 8, p = P & 255, bj = p >> 7, wc = (p >> 5) & 3, r = p & 31;
    if (pn < 2) return 64 * (4 * pn + wc) + dimA(bj, r);
    if (pn < 4) return 512 + 64 * (4 * (pn - 2) + wc) + dimA(bj, r);
    if (pn < 6) return 1024 + 256 * (pn - 4) + 64 * wc + 16 * ((p >> 3) & 3) + 8 * bj + (p & 7);
    if (pn < 8) return 1536 + 64 * (4 * (pn - 6) + wc) + dimB(bj, r);
    if (pn == 8) return wc < 2 ? 2048 + 64 * wc + dimB(bj, r) : 2176 + 64 * (wc - 2) + 16 * ((p >> 3) & 3) + 8 * bj + (p & 7);
    { const int fq = (p >> 3) & 3, r8 = p & 7; return 2304 + 256 * (pn - 9) + 64 * wc + 16 * fq + 8 * bj + r8; }
}

namespace att {
constexpr int KSTR = 80, VSTR = 96;
constexpr int KTILE = 64 * KSTR, VTILE = 64 * VSTR;
constexpr float PSH = 6.0f;
__device__ __forceinline__ int vrow(int k) { return 32 * ((k >> 2) & 1) + 16 * (k >> 5) + 4 * ((k >> 3) & 3) + (k & 3); }
constexpr int K_OFF = 0, V_OFF = 2 * KTILE;
constexpr int PRIV_OFF = 0;
__device__ __forceinline__ s16x4 vtr(LAS const char* p) { typedef short v4i16_t __attribute__((ext_vector_type(4)));
    return __builtin_bit_cast(s16x4, __builtin_amdgcn_ds_read_tr16_b64_v4i16((LAS v4i16_t*)p)); }
__device__ __forceinline__ u32x4 fp8x8_to_bf16(u32x2 w) { float f[8]; unpack8_fp8(w, f); u32x4 o; o.x = cvt_pk_bf16(f[0], f[1]); o.y = cvt_pk_bf16(f[2], f[3]); o.z = cvt_pk_bf16(f[4], f[5]); o.w = cvt_pk_bf16(f[6], f[7]); return o; }
__device__ __forceinline__ int clamp_tok(int t) { return t < 0 ? 0 : (t > SEQ - 1 ? SEQ - 1 : t); }

typedef int i32x8a __attribute__((ext_vector_type(8))); typedef int i32x4a __attribute__((ext_vector_type(4)));
__device__ __forceinline__ i32x8a cat32(const u32x4& a, const u32x4& b) { return __builtin_shufflevector(__builtin_bit_cast(i32x4a, a), __builtin_bit_cast(i32x4a, b), 0, 1, 2, 3, 4, 5, 6, 7); }
__device__ __forceinline__ void qk_tile(f32x16& p0, f32x16& p1, const u32x4 (&kf)[2][2], const u32x4 (&qr)[2]) {
    const f32x16 z = {-PSH, -PSH, -PSH, -PSH, -PSH, -PSH, -PSH, -PSH, -PSH, -PSH, -PSH, -PSH, -PSH, -PSH, -PSH, -PSH};
    const i32x8a q8 = cat32(qr[0], qr[1]);
    p0 = __builtin_amdgcn_mfma_scale_f32_32x32x64_f8f6f4(cat32(kf[0][0], kf[0][1]), q8, z, 0, 0, 0, 0, 0, 0);
    p1 = __builtin_amdgcn_mfma_scale_f32_32x32x64_f8f6f4(cat32(kf[1][0], kf[1][1]), q8, z, 0, 0, 0, 0, 0, 0);
}
template <bool MASK>
__device__ __forceinline__ void exp_tile(const f32x16& p0, const f32x16& p1, float& lsum, i32x8a& pf, int mbase, int mR, int dk) {
    float e0[16], e1[16]; float ls = 0.f;
#pragma unroll
    for (int r = 0; r < 16; ++r) {
        e0[r] = __builtin_amdgcn_exp2f(p0[r]); e1[r] = __builtin_amdgcn_exp2f(p1[r]);
        if (MASK) {
            const int c0 = (r & 3) + 8 * (r >> 2);
            e0[r] = ((unsigned)(mbase + dk * c0) <= (unsigned)mR) ? e0[r] : 0.f;
            e1[r] = ((unsigned)(mbase + dk * (c0 + 32)) <= (unsigned)mR) ? e1[r] : 0.f;
        }
        ls += e0[r] + e1[r];
    }
    lsum += ls;
#pragma unroll
    for (int d = 0; d < 4; ++d) { pf[d] = (int)pack4_fp8(e0[4 * d], e0[4 * d + 1], e0[4 * d + 2], e0[4 * d + 3]); pf[4 + d] = (int)pack4_fp8(e1[4 * d], e1[4 * d + 1], e1[4 * d + 2], e1[4 * d + 3]); }
}
__device__ __forceinline__ u32x2 vtr8(LAS const char* p) { typedef int v2i_t __attribute__((ext_vector_type(2))); return __builtin_bit_cast(u32x2, __builtin_amdgcn_ds_read_tr8_b64_v2i32((LAS v2i_t*)p)); }
__device__ __forceinline__ int vlane_off(int lane) { return (32 * (lane >> 5) + ((lane & 15) >> 1)) * VSTR + 16 * ((lane >> 4) & 1) + 8 * (lane & 1); }
__device__ __forceinline__ void vread(i32x8a& vf, LAS const char* vb, int d0) {
#pragma unroll
    for (int t = 0; t < 4; ++t) { const u32x2 w = vtr8(vb + 8 * t * VSTR + 32 * d0); vf[2 * t] = (int)w.x; vf[2 * t + 1] = (int)w.y; }
}
__device__ __forceinline__ void pv_half(f32x16& od, const i32x8a& vf, const i32x8a& pf) { od = __builtin_amdgcn_mfma_scale_f32_32x32x64_f8f6f4(vf, pf, od, 0, 0, 0, 0, 0, 0); }
__device__ __forceinline__ void mask_params(int dk, int tk0, int tq, int hi, int& mbase, int& mR) {
    const int dlo = (-64 * dk > -tq) ? -64 * dk : -tq, dhi = (64 * dk < SEQ - 1 - tq) ? 64 * dk : SEQ - 1 - tq;
    const int dA = tk0 + 4 * dk * hi - tq;
    mR = dhi - dlo; mbase = ((dA & (dk - 1)) == 0) ? dA - dlo : 0x7fffffff;
}

template <bool MASKED>
__device__ __forceinline__ void dense64_loop(LAS char* lds, const unsigned char* Kg, const unsigned char* Vg, int ld  , int tok0, int ntiles,
                                             const u32x4 (&qr)[2][2], f32x16 (&o)[2][2], float (&lsum)[2], int tq0, int tq1, int lane_, int wave) {
    constexpr int V2_OFF = 2 * KTILE;
    u32x2 kreg, vreg;
#define D64_LANE() int ln_ = lane_; asm volatile("" : "+v"(ln_)); const int tid_ = wave * 64 + ln_, srow = tid_ >> 3, sch = tid_ & 7
#define D64_LD(t) do { D64_LANE(); int tk_ = tok0 + 64 * (t) + srow; if (MASKED) tk_ = clamp_tok(tk_); kreg = *(const u32x2*)(Kg + (size_t)tk_ * ld + sch * 8); vreg = *(const u32x2*)(Vg + (size_t)tk_ * ld + sch * 8); } while (0)
#define D64_ST(t) do { D64_LANE(); *(LAS u32x2*)(lds + ((t) & 1) * KTILE + srow * KSTR + sch * 8) = kreg; *(LAS u32x2*)(lds + V2_OFF + ((t) & 1) * VTILE + vrow(srow) * VSTR + sch * 8) = vreg; } while (0)
    D64_LD(0); D64_ST(0); D64_LD(1);
    for (int t = 0; t < ntiles; ++t) {
        __syncthreads();
        if (t + 1 < ntiles) D64_ST(t + 1);
        if (t + 2 < ntiles) D64_LD(t + 2);
        int lane = lane_; asm volatile("" : "+v"(lane));
        const int hi = lane >> 5;
        const int vlane = vlane_off(lane);
        const int klane = (lane & 31) * KSTR + 32 * hi;
        u32x4 kf[2][2];
        { LAS const char* kb_ = lds + (t & 1) * KTILE + klane;
#pragma unroll
          for (int blk = 0; blk < 2; ++blk)
#pragma unroll
              for (int e = 0; e < 2; ++e) kf[blk][e] = *(const LAS u32x4*)(kb_ + 32 * blk * KSTR + 16 * e); }
        f32x16 p[2][2];
        i32x8a vfa, vfb;
        LAS const char* vb_ = lds + V2_OFF + (t & 1) * VTILE + vlane;
        vread(vfa, vb_, 0); vread(vfb, vb_, 1);
        __builtin_amdgcn_sched_barrier(0);
        qk_tile(p[0][0], p[0][1], kf, qr[0]);
        qk_tile(p[1][0], p[1][1], kf, qr[1]);
#pragma unroll
        for (int g = 0; g < 2; ++g) {
            i32x8a pf; int mb = 0, mr = 0;
            if (MASKED) mask_params(1, tok0 + 64 * t, g ? tq1 : tq0, hi, mb, mr);
            exp_tile<MASKED>(p[g][0], p[g][1], lsum[g], pf, mb, mr, 1);
            pv_half(o[g][0], vfa, pf); pv_half(o[g][1], vfb, pf);
        }
    }
#undef D64_LANE
#undef D64_LD
#undef D64_ST
}
__device__ __forceinline__ void dense64_lag_loop(LAS char* lds, const unsigned char* Kg, const unsigned char* Vg, int ld  , int ntiles,
                                                 const u32x4 (&qr)[2][2], f32x16 (&o)[2][2], float (&lsum)[2], int lane_, int wave, const bool lag) {
    constexpr int V2_OFF = 2 * KTILE;
    u32x2 kreg, vreg;
#define D64_LANE() int ln_ = lane_; asm volatile("" : "+v"(ln_)); const int tid_ = wave * 64 + ln_, srow = tid_ >> 3, sch = tid_ & 7
#define D64_LD(t) do { D64_LANE(); const int tk_ = 64 * (t) + srow; kreg = *(const u32x2*)(Kg + (size_t)tk_ * ld + sch * 8); vreg = *(const u32x2*)(Vg + (size_t)tk_ * ld + sch * 8); } while (0)
#define D64_ST(t) do { D64_LANE(); *(LAS u32x2*)(lds + ((t) & 1) * KTILE + srow * KSTR + sch * 8) = kreg; *(LAS u32x2*)(lds + V2_OFF + ((t) % 3) * VTILE + vrow(srow) * VSTR + sch * 8) = vreg; } while (0)
#define D64_QK(t) do { int lane = lane_; asm volatile("" : "+v"(lane)); const int klane = (lane & 31) * KSTR + 32 * (lane >> 5); u32x4 kf[2][2]; LAS const char* kb_ = lds + ((t) & 1) * KTILE + klane; \
        _Pragma("unroll") for (int blk = 0; blk < 2; ++blk) _Pragma("unroll") for (int e = 0; e < 2; ++e) kf[blk][e] = *(const LAS u32x4*)(kb_ + 32 * blk * KSTR + 16 * e); \
        qk_tile(p[0][0], p[0][1], kf, qr[0]); qk_tile(p[1][0], p[1][1], kf, qr[1]); } while (0)
#define D64_PV(t) do { int lane = lane_; asm volatile("" : "+v"(lane)); const int vlane = vlane_off(lane); \
        i32x8a vfa, vfb; LAS const char* vb_ = lds + V2_OFF + ((t) % 3) * VTILE + vlane; vread(vfa, vb_, 0); vread(vfb, vb_, 1); \
        _Pragma("unroll") for (int g = 0; g < 2; ++g) { i32x8a pf; exp_tile<false>(p[g][0], p[g][1], lsum[g], pf, 0, 0, 0); pv_half(o[g][0], vfa, pf); pv_half(o[g][1], vfb, pf); } } while (0)
    f32x16 p[2][2];
    D64_LD(0); D64_ST(0);
    if (!lag) {
        D64_LD(1);
        for (int t = 0; t < ntiles; ++t) {
            __syncthreads();
            if (t + 1 < ntiles) D64_ST(t + 1);
            if (t + 2 < ntiles) D64_LD(t + 2);
            D64_QK(t);
            D64_PV(t);
        }
        __syncthreads();
    } else {
        D64_LD(1);
        __syncthreads();
        D64_ST(1); D64_LD(2);
        D64_QK(0);
        for (int t = 1; t < ntiles; ++t) {
            __syncthreads();
            if (t + 1 < ntiles) D64_ST(t + 1);
            if (t + 2 < ntiles) D64_LD(t + 2);
            D64_PV(t - 1);
            __builtin_amdgcn_sched_barrier(0);
            D64_QK(t);
        }
        __syncthreads();
        D64_PV(ntiles - 1);
    }
#undef D64_LANE
#undef D64_LD
#undef D64_ST
#undef D64_QK
#undef D64_PV
}
__device__ __forceinline__ void priv_kload(u32x4 (&kf)[2][2], const unsigned char* Kg, int ld, int tk0, int dk, int lane_) {
    int lane = lane_; asm volatile("" : "+v"(lane));
    const int hi = lane >> 5;
#pragma unroll
    for (int blk = 0; blk < 2; ++blk) { const int tk = clamp_tok(tk0 + dk * (32 * blk + (lane & 31)));
#pragma unroll
        for (int e = 0; e < 2; ++e) kf[blk][e] = *(const u32x4*)(Kg + (size_t)tk * ld + 32 * hi + 16 * e); }
}
__device__ __forceinline__ void priv2_step(u32x4 (&kf)[2][2], LAS char* vpriv, const unsigned char* Kg, const unsigned char* Vg, int ld, int tk0, int dk, bool g0, bool g1,
                                           bool has_next, int tk0n, int dkn, const u32x4 (&qr)[2][2], f32x16 (&o)[2][2], float (&lsum)[2], int tq0, int tq1, int lane_) {
    int lane = lane_; asm volatile("" : "+v"(lane));
    const int hi = lane >> 5;
    const int vlane = vlane_off(lane);
    u32x2 vr[8];
#pragma unroll
    for (int i = 0; i < 8; ++i) { const int idx = i * 64 + lane, row = idx >> 3, ch = idx & 7; const int tk = clamp_tok(tk0 + dk * row); vr[i] = *(const u32x2*)(Vg + (size_t)tk * ld + ch * 8); }
    const int gfirst = g0 ? 0 : 1, glast = g1 ? 1 : 0;
    f32x16 p0, p1; i32x8a pf; int mb, mr;
    if (gfirst == 0) qk_tile(p0, p1, kf, qr[0]); else qk_tile(p0, p1, kf, qr[1]);
    __builtin_amdgcn_sched_barrier(0);
#pragma unroll
    for (int i = 0; i < 8; ++i) { const int idx = i * 64 + lane; *(LAS u32x2*)(vpriv + vrow(idx >> 3) * VSTR + (idx & 7) * 8) = vr[i]; }
    if (glast == gfirst) { __builtin_amdgcn_sched_barrier(0); if (has_next) priv_kload(kf, Kg, ld, tk0n, dkn, lane); __builtin_amdgcn_sched_barrier(0); }
    mask_params(dk, tk0, gfirst ? tq1 : tq0, hi, mb, mr);
    if (gfirst == 0) exp_tile<true>(p0, p1, lsum[0], pf, mb, mr, dk); else exp_tile<true>(p0, p1, lsum[1], pf, mb, mr, dk);
    { i32x8a vfa, vfb; vread(vfa, vpriv + vlane, 0); vread(vfb, vpriv + vlane, 1);
      if (gfirst == 0) { pv_half(o[0][0], vfa, pf); pv_half(o[0][1], vfb, pf); } else { pv_half(o[1][0], vfa, pf); pv_half(o[1][1], vfb, pf); } }
    if (glast != gfirst) {
        qk_tile(p0, p1, kf, qr[1]);
        __builtin_amdgcn_sched_barrier(0);
        if (has_next) priv_kload(kf, Kg, ld, tk0n, dkn, lane);
        __builtin_amdgcn_sched_barrier(0);
        mask_params(dk, tk0, tq1, hi, mb, mr);
        exp_tile<true>(p0, p1, lsum[1], pf, mb, mr, dk);
        i32x8a vfa, vfb; vread(vfa, vpriv + vlane, 0); vread(vfb, vpriv + vlane, 1);
        pv_half(o[1][0], vfa, pf); pv_half(o[1][1], vfb, pf);
    }
}
__device__ __forceinline__ void store_out(const f32x16 (&o)[2], float lsum, unsigned char* dst  , int lane_) {
    int lane = lane_; asm volatile("" : "+v"(lane));
    const int hi = lane >> 5;
    float l = lsum + shx(lsum, 32, lane);
    const float inv = A8S / l;
#pragma unroll
    for (int d0 = 0; d0 < 2; ++d0) {
        unsigned pc[4];
#pragma unroll
        for (int g = 0; g < 4; ++g) pc[g] = pack4_fp8(o[d0][4 * g] * inv, o[d0][4 * g + 1] * inv, o[d0][4 * g + 2] * inv, o[d0][4 * g + 3] * inv);
        const auto s0 = __builtin_amdgcn_permlane32_swap(pc[0], pc[2], false, false), s1 = __builtin_amdgcn_permlane32_swap(pc[1], pc[3], false, false);
        u32x4 w; w.x = s0[0]; w.y = s0[1]; w.z = s1[0]; w.w = s1[1];
        *(u32x4*)(dst + 32 * d0 + 16 * hi) = w;
    }
}
}

struct Args { const float* in[18]; float* out; unsigned char* ws; int ph_lo, ph_hi; };
constexpr int PH_PRO = 0, PH_L0 = 1, PH_PER_LAYER = 9, PH_FINAL = PH_L0 + 2 * PH_PER_LAYER, NPH = PH_FINAL + 1;
enum { P_NORM1 = 0, P_INPROJ, P_ATTN, P_PAB, P_OUT, P_NORM2, P_PLACE, P_GU, P_DOWN };

__device__ __forceinline__ int tile256_srccol(int P) { const int p = P & 255; return (P & ~255) + 64 * ((p >> 5) & 3) + 16 * ((p >> 3) & 3) + 8 * (p >> 7) + (p & 7); }
template <int MAP, bool W8 = false>
__device__ __forceinline__ void transpose_item(const float* W, int N, int col0, bf16_t* dst, int dst_row0, int K, int k0, LAS float* scr, int lane, int dk0 = 0  ) {
    const int sc = (MAP == 1) ? inproj_srccol(col0 + lane) : (MAP == 2) ? tile256_srccol(col0 + lane) : col0 + lane;
    const float* src = W + (size_t)k0 * N + sc;
#pragma unroll 16
    for (int i = 0; i < 64; ++i) scr[i * 65 + lane] = src[(size_t)i * N];
    asm volatile("s_waitcnt lgkmcnt(0)" ::: "memory");
    const int c = lane & 7, nn = lane >> 3;
#pragma unroll
    for (int j = 0; j < 8; ++j) { const int n = nn + 8 * j; const LAS float* s = scr + (8 * c) * 65 + n;
        if (W8) { u32x2 w; w.x = pack4_fp8(s[0] * W8S, s[65] * W8S, s[2 * 65] * W8S, s[3 * 65] * W8S); w.y = pack4_fp8(s[4 * 65] * W8S, s[5 * 65] * W8S, s[6 * 65] * W8S, s[7 * 65] * W8S);
            *(u32x2*)((unsigned char*)dst + (size_t)(dst_row0 + n) * K + dk0 + k0 + 8 * c) = w; continue; }
        u32x4 w; w.x = cvt_pk_bf16(s[0], s[65]); w.y = cvt_pk_bf16(s[2 * 65], s[3 * 65]); w.z = cvt_pk_bf16(s[4 * 65], s[5 * 65]); w.w = cvt_pk_bf16(s[6 * 65], s[7 * 65]);
        *(u32x4*)(dst + (size_t)(dst_row0 + n) * K + dk0 + k0 + 8 * c) = w; }
    asm volatile("s_waitcnt lgkmcnt(0)" ::: "memory");
}


template <bool XF32, bool COMBINE, bool NORM, bool ROUTER, bool OUTF32, int H8 = 0  >
__device__ __forceinline__ void row_phase(LAS unsigned char* lds, int tid, int lane, int wave, int G, int bx, const float* xf, bf16_t* xb, float* outf, const float* gv,
                                          const float* modl, int sh_off, int sc_off, const float* modprev, bf16_t* Hh, const unsigned char* Ym, const int* Pos, float* Tw,
                                          const bf16_t* Wr, int* Te, int* Trk, int* Cnt, unsigned char* H8p = nullptr) {
    constexpr int RB = COMBINE ? 2 : ROWB;
    constexpr int RSTR = 2080;
    LAS unsigned char* wrl = lds;
    LAS unsigned char* atile = lds + 32 * RSTR + wave * (4 * RSTR);
    LAS float* lgw = (LAS float*)(lds + MISC_OFF + 2048) + wave * 132;
    LAS int* lcnt = (LAS int*)(lds + MISC_OFF + 1024);
    asm volatile("" : "+v"(tid), "+v"(lane));
    if (ROUTER) {
#pragma unroll
        for (int p = 0; p < 8; ++p) { const int idx = p * 512 + tid, row = idx >> 7, c16 = idx & 127; *(LAS u32x4*)(wrl + row * RSTR + c16 * 16) = *(const u32x4*)(Wr + (size_t)row * DM + c16 * 8); }
    }
    for (int chunk = bx; chunk < 256; chunk += G) {
        const int b = chunk >> 3;
        if (ROUTER) { if (tid < 32) lcnt[tid] = 0; __syncthreads(); }
        f32x4 pre[4], shv[4], g2[4];
#pragma unroll
        for (int j = 0; j < 4; ++j) { const int col = 512 * (j >> 1) + 8 * lane + 4 * (j & 1);
            if (NORM) { const f32x4 gg = *(const f32x4*)(gv + col), sc = *(const f32x4*)(modl + (size_t)b * MODW + sc_off + col);
                pre[j] = gg * (1.0f + sc); shv[j] = *(const f32x4*)(modl + (size_t)b * MODW + sh_off + col); }
            if (COMBINE) g2[j] = *(const f32x4*)(modprev + (size_t)b * MODW + 5 * DM + col); }
        f32x4 rawf[XF32 ? RB : 1][4]; u32x4 rawb[XF32 ? 1 : RB][2]; int pp[COMBINE ? RB : 1][2]; float pw[COMBINE ? RB : 1][2];
#define ROW_LOAD(rb_) do { _Pragma("unroll") for (int i = 0; i < RB; ++i) { const size_t ro = (size_t)((rb_) + i) * DM; \
            if (XF32) { _Pragma("unroll") for (int j = 0; j < 4; ++j) rawf[XF32 ? i : 0][j] = *(const f32x4*)(xf + ro + 512 * (j >> 1) + 8 * lane + 4 * (j & 1)); } \
            else { _Pragma("unroll") for (int h = 0; h < 2; ++h) rawb[XF32 ? 0 : i][h] = *(const u32x4*)(xb + ro + 512 * h + 8 * lane); } \
            if (COMBINE) { pp[COMBINE ? i : 0][0] = Pos[2 * ((rb_) + i)]; pp[COMBINE ? i : 0][1] = Pos[2 * ((rb_) + i) + 1]; pw[COMBINE ? i : 0][0] = Tw[2 * ((rb_) + i)]; pw[COMBINE ? i : 0][1] = Tw[2 * ((rb_) + i) + 1]; } } } while (0)
        ROW_LOAD(chunk * 256 + wave * 32);
#pragma unroll 1
        for (int r0 = 0; r0 < 32; r0 += RB) {
            const int rowb = chunk * 256 + wave * 32 + r0;
            f32x4 v[RB][4]; int cp[COMBINE ? RB : 1][2]; float cw[COMBINE ? RB : 1][2];
#pragma unroll
            for (int i = 0; i < RB; ++i) {
                if (XF32) {
#pragma unroll
                    for (int j = 0; j < 4; ++j) v[i][j] = rawf[XF32 ? i : 0][j];
                } else {
#pragma unroll
                    for (int h = 0; h < 2; ++h) { const u32x4 w = rawb[XF32 ? 0 : i][h];
                        v[i][2 * h] = (f32x4){bf_lo(w.x), bf_hi(w.x), bf_lo(w.y), bf_hi(w.y)}; v[i][2 * h + 1] = (f32x4){bf_lo(w.z), bf_hi(w.z), bf_lo(w.w), bf_hi(w.w)}; }
                }
                if (COMBINE) { cp[i][0] = pp[i][0]; cp[i][1] = pp[i][1]; cw[i][0] = pw[i][0]; cw[i][1] = pw[i][1]; }
            }
            u32x2 ya[COMBINE ? RB : 1][2], yc[COMBINE ? RB : 1][2];
            if (COMBINE) {
#pragma unroll
                for (int i = 0; i < RB; ++i)
#pragma unroll
                    for (int h = 0; h < 2; ++h) { ya[i][h] = *(const u32x2*)(Ym + (size_t)cp[i][0] * DM + 512 * h + 8 * lane); yc[i][h] = *(const u32x2*)(Ym + (size_t)cp[i][1] * DM + 512 * h + 8 * lane); }
            }
            if (r0 + RB < 32) ROW_LOAD(rowb + RB);
            if (COMBINE) {
#pragma unroll
                for (int i = 0; i < RB; ++i) {
                    const int row = rowb + i; const float w0 = cw[i][0], w1 = cw[i][1];
#pragma unroll
                    for (int h = 0; h < 2; ++h) { float fa[8], fc[8]; unpack8_fp8(ya[i][h], fa); unpack8_fp8(yc[i][h], fc);
                        const f32x4 m0 = {w0 * fa[0] + w1 * fc[0], w0 * fa[1] + w1 * fc[1], w0 * fa[2] + w1 * fc[2], w0 * fa[3] + w1 * fc[3]};
                        const f32x4 m1 = {w0 * fa[4] + w1 * fc[4], w0 * fa[5] + w1 * fc[5], w0 * fa[6] + w1 * fc[6], w0 * fa[7] + w1 * fc[7]};
                        v[i][2 * h] = v[i][2 * h] + g2[2 * h] * m0; v[i][2 * h + 1] = v[i][2 * h + 1] + g2[2 * h + 1] * m1;
                        if (OUTF32) { *(f32x4*)(outf + (size_t)row * DM + 512 * h + 8 * lane) = v[i][2 * h]; *(f32x4*)(outf + (size_t)row * DM + 512 * h + 8 * lane + 4) = v[i][2 * h + 1]; }
                        else *(u32x4*)(xb + (size_t)row * DM + 512 * h + 8 * lane) = pg8::pack8(v[i][2 * h], v[i][2 * h + 1]); }
                }
            }
            if (NORM) {
                float ss[RB];
#pragma unroll
                for (int i = 0; i < RB; ++i) { ss[i] = 0.f;
#pragma unroll
                    for (int j = 0; j < 4; ++j) { const f32x4 q = v[i][j] * v[i][j]; ss[i] += (q[0] + q[1]) + (q[2] + q[3]); } }
#pragma unroll
                for (int o = 1; o < 64; o <<= 1)
#pragma unroll
                    for (int i = 0; i < RB; ++i) ss[i] += shx(ss[i], o, lane);
#pragma unroll
                for (int i = 0; i < RB; ++i) { const float rstd = __builtin_amdgcn_rsqf(ss[i] * (1.0f / DM) + 1e-6f);
#pragma unroll
                    for (int h = 0; h < 2; ++h) { const f32x4 h0 = v[i][2 * h] * rstd * pre[2 * h] + shv[2 * h], h1 = v[i][2 * h + 1] * rstd * pre[2 * h + 1] + shv[2 * h + 1];
                        if (H8 != 0) *(u32x2*)((H8 == 2 ? H8p : (unsigned char*)Hh) + (size_t)(rowb + i) * DM + 512 * h + 8 * lane) = (u32x2){pack4_fp8(h0[0], h0[1], h0[2], h0[3]), pack4_fp8(h1[0], h1[1], h1[2], h1[3])};
                        if (ROUTER) *(LAS u32x4*)(atile + i * RSTR + (512 * h + 8 * lane) * 2) = pg8::pack8(h0, h1);
                        else if (H8 != 1) *(u32x4*)(Hh + (size_t)(rowb + i) * DM + 512 * h + 8 * lane) = pg8::pack8(h0, h1); } }
                if (ROUTER) {
                    static_assert(!ROUTER || RB == 4, "the router batch is 4 rows");
                    asm volatile("s_waitcnt lgkmcnt(0)" ::: "memory");
                    f32x4 ra0 = {0.f, 0.f, 0.f, 0.f}, ra1 = {0.f, 0.f, 0.f, 0.f};
                    { int ln = lane; asm volatile("" : "+v"(ln));
                      LAS const unsigned char* ab = atile + (ln & 3) * RSTR + (ln >> 4) * 16;
                      LAS const unsigned char* bb = wrl + (ln & 15) * RSTR + (ln >> 4) * 16;
#pragma unroll 8
                      for (int kk = 0; kk < 32; ++kk) {
                          const bf16x8 a = *(const LAS bf16x8*)(ab + 64 * kk), b0 = *(const LAS bf16x8*)(bb + 64 * kk), b1 = *(const LAS bf16x8*)(bb + 16 * RSTR + 64 * kk);
                          ra0 = __builtin_amdgcn_mfma_f32_16x16x32_bf16(a, b0, ra0, 0, 0, 0); ra1 = __builtin_amdgcn_mfma_f32_16x16x32_bf16(a, b1, ra1, 0, 0, 0);
                      }
                      if (ln < 16) {
#pragma unroll
                          for (int r = 0; r < 4; ++r) { lgw[r * 33 + ln] = ra0[r]; lgw[r * 33 + 16 + ln] = ra1[r]; } }
                    }
                    asm volatile("s_waitcnt lgkmcnt(0)" ::: "memory");
                    { int ln = lane; asm volatile("" : "+v"(ln));
                      const int tk = (ln >> 2) & 3, g = ln & 3;
                      float m1 = -3.0e38f, m2 = -3.0e38f; int i1 = 0, i2 = 0;
#pragma unroll
                      for (int j = 0; j < 8; ++j) { const float vv = lgw[tk * 33 + 8 * g + j];
                          if (vv > m1) { m2 = m1; i2 = i1; m1 = vv; i1 = j; } else if (vv > m2) { m2 = vv; i2 = j; } }
                      float M = fmaxf(m1, shx(m1, 1, ln)); M = fmaxf(M, shx(M, 2, ln));
                      const float sc = expf(m1 - M) + expf(m2 - M);
                      const int base = ln & ~3;
                      const float s0 = __int_as_float(__builtin_amdgcn_ds_bpermute(base << 2, __float_as_int(sc))), s1 = __int_as_float(__builtin_amdgcn_ds_bpermute((base + 1) << 2, __float_as_int(sc))),
                                  s2 = __int_as_float(__builtin_amdgcn_ds_bpermute((base + 2) << 2, __float_as_int(sc))), s3 = __int_as_float(__builtin_amdgcn_ds_bpermute((base + 3) << 2, __float_as_int(sc)));
                      int bg = 0; float bs = s0; if (s1 > bs) { bs = s1; bg = 1; } if (s2 > bs) { bs = s2; bg = 2; } if (s3 > bs) { bs = s3; bg = 3; }
                      if (ln < 16 && g == bg) {
                          const int tok = rowb + tk, e0 = 8 * g + i1, e1 = 8 * g + i2;
                          const float w0 = 1.0f / (1.0f + expf(m2 - m1)), w1 = 1.0f - w0;
                          const int r0_ = __hip_atomic_fetch_add(&lcnt[e0], 1, __ATOMIC_RELAXED, __HIP_MEMORY_SCOPE_WORKGROUP);
                          const int r1_ = __hip_atomic_fetch_add(&lcnt[e1], 1, __ATOMIC_RELAXED, __HIP_MEMORY_SCOPE_WORKGROUP);
                          Te[2 * tok] = e0; Te[2 * tok + 1] = e1; Trk[2 * tok] = r0_; Trk[2 * tok + 1] = r1_; Tw[2 * tok] = w0; Tw[2 * tok + 1] = w1;
                      }
                    }
                }
            }
        }
#undef ROW_LOAD
        if (ROUTER) {
            __syncthreads();
            if (tid < 32) Cnt[chunk * 32 + tid] = lcnt[tid];
            __syncthreads();
        }
    }
}

#define x_in ((const float*)(const GAS float*)args.in[0])
#define c_in ((const float*)(const GAS float*)args.in[1])
#define w_ada ((const float*)(const GAS float*)args.in[2])
#define b_ada ((const float*)(const GAS float*)args.in[3])
#define g_mix ((const float*)(const GAS float*)args.in[4])
#define w_in ((const float*)(const GAS float*)args.in[5])
#define qn_a ((const float*)(const GAS float*)args.in[6])
#define kn_a ((const float*)(const GAS float*)args.in[7])
#define qn_b ((const float*)(const GAS float*)args.in[8])
#define kn_b ((const float*)(const GAS float*)args.in[9])
#define w_pa ((const float*)(const GAS float*)args.in[10])
#define w_pb ((const float*)(const GAS float*)args.in[11])
#define w_out ((const float*)(const GAS float*)args.in[12])
#define g_ffn ((const float*)(const GAS float*)args.in[13])
#define w_router ((const float*)(const GAS float*)args.in[14])
#define w_gate ((const float*)(const GAS float*)args.in[15])
#define w_up ((const float*)(const GAS float*)args.in[16])
#define w_down ((const float*)(const GAS float*)args.in[17])
#define MOD ((float*)(GAS float*)(ws + WS_MOD))
#define XB ((bf16_t*)(GAS bf16_t*)(ws + WS_XB))
#define TE ((int*)(GAS int*)(ws + WS_TE))
#define TRK ((int*)(GAS int*)(ws + WS_TRK))
#define TW ((float*)(GAS float*)(ws + WS_TW))
#define POS ((int*)(GAS int*)(ws + WS_POS))
#define CNT ((int*)(GAS int*)(ws + WS_CNT))
#define BLKE ((int*)(GAS int*)(ws + WS_BLKE))
#define BTOK ((int*)(GAS int*)(ws + WS_BTOK))
#define WR ((bf16_t*)(bf16_t*)(GAS bf16_t*)(ws + WS_WR))
#define H ((bf16_t*)(bf16_t*)(GAS bf16_t*)(ws + WS_H))
#define YAB ((bf16_t*)(GAS bf16_t*)(ws + WS_H))
#define YA ((bf16_t*)(bf16_t*)(GAS bf16_t*)(ws + WS_H))
#define YB ((bf16_t*)(bf16_t*)(GAS bf16_t*)(ws + WS_H + 64 * MiB))
#define QA ((bf16_t*)(bf16_t*)(GAS bf16_t*)(ws + WS_QKV))
#define KA ((bf16_t*)(bf16_t*)(GAS bf16_t*)(ws + WS_QKV + 64 * MiB))
#define VA ((bf16_t*)(bf16_t*)(GAS bf16_t*)(ws + WS_QKV + 128 * MiB))
#define QB ((bf16_t*)(bf16_t*)(GAS bf16_t*)(ws + WS_QKV + 192 * MiB))
#define KB ((bf16_t*)(bf16_t*)(GAS bf16_t*)(ws + WS_QKV + 256 * MiB))
#define VB ((bf16_t*)(bf16_t*)(GAS bf16_t*)(ws + WS_QKV + 272 * MiB))
#define MERGED ((bf16_t*)(bf16_t*)(GAS bf16_t*)(ws + WS_QKV))
#define YM ((unsigned char*)(GAS unsigned char*)(ws + WS_QKV))
#define H2F8 ((unsigned char*)(GAS unsigned char*)(ws + WS_QKV + 160 * MiB))
#define SA ((bf16_t*)(bf16_t*)(GAS bf16_t*)(ws + WS_GATE))
#define SB ((bf16_t*)(bf16_t*)(GAS bf16_t*)(ws + WS_GATE + 128 * MiB))
#define ACT ((bf16_t*)(bf16_t*)(GAS bf16_t*)(ws + WS_GATE))
#define PHASE_ENTER() int lane; asm volatile("v_mbcnt_lo_u32_b32 %0, -1, 0\n\tv_mbcnt_hi_u32_b32 %0, -1, %0" : "=v"(lane)); const int tid = wave * 64 + lane; GAS unsigned char* ws = ws0; int bx = bx0, vcu = vcu0; asm volatile("" : "+s"(ws), "+s"(bx), "+s"(vcu))

__device__ __forceinline__ bool in_phase(int lo, int hi, int k) { asm volatile("" : "+s"(lo), "+s"(hi)); return lo <= k && k < hi; }
#define PGATE_A SA
#define PGATE_B SB
__global__ void __launch_bounds__(512, 2) fwd_kernel(Args args) {
    extern __shared__ __attribute__((aligned(16))) unsigned char lds_raw[];
    LAS unsigned char* lds = (LAS unsigned char*)lds_raw;
    volatile LAS unsigned* MISC = (volatile LAS unsigned*)(lds + MISC_OFF);
    const int tid0 = threadIdx.x, lane0 = tid0 & 63, wave = __builtin_amdgcn_readfirstlane(tid0 >> 6);
    const int G = gridDim.x, bx0 = blockIdx.x;
    const int vcu0 = (G % 8 == 0) ? (bx0 % 8) * (G / 8) + bx0 / 8 : bx0;
    GAS unsigned char* ws0 = (GAS unsigned char*)args.ws;
    float* out = (float*)(GAS float*)args.out;
    for (int u = tid0; u < 256; u += 512) ((LAS unsigned*)(lds + MISC_OFF))[u] = 0u;
    __syncthreads();
#if MK_ONE_LAUNCH
    XcdBarrier bar = xcd_barrier_post((unsigned*)((GAS unsigned*)(ws0 + WS_CTL) + CW_BAR), MISC + 8);
#define GRID_BAR() do { int l_; asm volatile("v_mbcnt_lo_u32_b32 %0, -1, 0\n\tv_mbcnt_hi_u32_b32 %0, -1, %0" : "=v"(l_)); xcd_barrier(bar, (wave == 0) && (l_ == 0)); } while (0)
#else
#define GRID_BAR() do {} while (0)
#endif
#ifndef PHMASK
#define PHMASK 0xFFFFFFFFu
#endif
#if MK_ONE_LAUNCH
#define IN(k) true
#else
#define IN(k) in_phase(args.ph_lo, args.ph_hi, (k))
#endif
#define EN(bit) ((PHMASK >> (bit)) & 1u)
#define SEAM(k) do { if (IN(k) && IN((k) + 1)) GRID_BAR(); } while (0)

    if (EN(0) && IN(PH_PRO)) {
        PHASE_ENTER();
#pragma unroll 1
        for (int rep = 0; rep < REP_PRO; ++rep) {
        LAS float* scr = (LAS float*)(lds + wave * 16640);
        const int gw = vcu * 8 + wave, NGW = G * 8;
        constexpr int I_IN = 68 * 8, I_PA = 16 * 4, I_OUT = 16 * 8, I_GU = 32 * 2 * 8 * 8, I_DN = 32 * 16 * 4;
        constexpr int I_LAYER = I_IN + 2 * I_PA + I_OUT + I_GU + I_DN;
        auto decode = [&](int it, const float*& src, int& N, unsigned char*& dst, int& K, int& t256  ) {
            t256 = -1;
            const int l = it / I_LAYER; int r = it % I_LAYER;
            if (r < I_IN) { const int nb = r / 8, kb = r % 8; N = NC; K = DM;
                src = w_in + (size_t)l * DM * NC + (size_t)(128 * kb) * NC + inproj_srccol(64 * nb + lane);
                dst = (unsigned char*)(GAS unsigned char*)(ws + WS_WIN + l * WIN_BYTES) + (size_t)(64 * nb) * DM + 128 * kb; return; } r -= I_IN;
            if (r < 2 * I_PA) { const int pb_ = r / I_PA, q = r % I_PA, nb = q / 4, kb = q % 4; N = DM; K = DM;
                src = (pb_ ? w_pb : w_pa) + (size_t)l * 512 * DM + (size_t)(128 * kb) * DM + 64 * nb + lane; t256 = nb;
                dst = (unsigned char*)(GAS unsigned char*)(ws + WS_WPA + l * 2 * MiB) + 512 * pb_ + 128 * kb; return; } r -= 2 * I_PA;
            if (r < I_OUT) { const int nb = r / 8, kb = r % 8; N = DM; K = DM;
                src = w_out + (size_t)l * DM * DM + (size_t)(128 * kb) * DM + 64 * nb + lane; t256 = nb;
                dst = (unsigned char*)(GAS unsigned char*)(ws + WS_WOUT + l * 2 * MiB) + 128 * kb; return; } r -= I_OUT;
            if (r < I_GU) { const int e = r / 128, q = r % 128, up = q / 64, nb = (q % 64) / 8, kb = q % 8; N = DFF; K = DM;
                const int c0 = 64 * nb, drow = 256 * (c0 >> 7) + 128 * up + (c0 & 127);
                src = (up ? w_up : w_gate) + ((size_t)l * NEXP + e) * DM * DFF + (size_t)(128 * kb) * DFF + c0 + lane;
                dst = (unsigned char*)(GAS unsigned char*)(ws + WS_WGU + ((size_t)l * NEXP + e) * MiB) + (size_t)drow * DM + 128 * kb; return; } r -= I_GU;
            { const int e = r / 64, q = r % 64, nb = q / 4, kb = q % 4; N = DM; K = DFF;
                src = w_down + ((size_t)l * NEXP + e) * DFF * DM + (size_t)(128 * kb) * DM + 64 * nb + lane; t256 = nb;
                dst = (unsigned char*)(GAS unsigned char*)(ws + WS_WDN + ((size_t)l * NEXP + e) * (MiB / 2)) + 128 * kb; }
        };
        {
            LAS unsigned char* scr8 = (LAS unsigned char*)scr;
#pragma unroll 1
            for (int it = gw; it < 2 * I_LAYER; it += NGW) {
                const float* src; int N, K, t256; unsigned char* dst;
                decode(it, src, N, dst, K, t256);
                float v[128];
#pragma unroll
                for (int i = 0; i < 128; ++i) v[i] = src[(size_t)i * N];
#pragma unroll
                for (int q = 0; q < 8; ++q) { u32x4 w;
                    w.x = pack4_fp8(v[16 * q + 0] * W8S, v[16 * q + 1] * W8S, v[16 * q + 2] * W8S, v[16 * q + 3] * W8S); w.y = pack4_fp8(v[16 * q + 4] * W8S, v[16 * q + 5] * W8S, v[16 * q + 6] * W8S, v[16 * q + 7] * W8S);
                    w.z = pack4_fp8(v[16 * q + 8] * W8S, v[16 * q + 9] * W8S, v[16 * q + 10] * W8S, v[16 * q + 11] * W8S); w.w = pack4_fp8(v[16 * q + 12] * W8S, v[16 * q + 13] * W8S, v[16 * q + 14] * W8S, v[16 * q + 15] * W8S);
                    *(LAS u32x4*)(scr8 + lane * 144 + 16 * q) = w; }
                asm volatile("s_waitcnt lgkmcnt(0)" ::: "memory");
#pragma unroll
                for (int j = 0; j < 8; ++j) { const int r_ = 8 * j + (lane >> 3), c = lane & 7;
                    const u32x4 w = *(const LAS u32x4*)(scr8 + r_ * 144 + 16 * c);
                    const int drow = (t256 < 0) ? r_ : 256 * (t256 >> 2) + 128 * (j & 1) + 32 * (t256 & 3) + 8 * (j >> 1) + (lane >> 3);
                    *(u32x4*)(dst + (size_t)drow * K + 16 * c) = w; }
                asm volatile("s_waitcnt lgkmcnt(0)" ::: "memory");
            }
        }
        for (int i = (vcu * 512 + tid); i < 32 * DM; i += G * 512) { const int e = i >> 10, k = i & 1023; WR[i] = (bf16_t)(cvt_pk_bf16(w_router[(size_t)k * NEXP + e], 0.f) & 0xffffu); }
        __syncthreads();
        if (vcu < 192) {
            LAS float* cond = (LAS float*)lds;
            for (int i = tid; i < NB * DM; i += 512) { const int b = i >> 10, k = i & 1023; const float cv = c_in[i]; cond[k * 32 + b] = cv / (1.0f + expf(-cv)); }
            __syncthreads();
            const int T = 2 * vcu + (wave >> 2), kq = wave & 3;
            const int l = T / 192, n0 = (T % 192) * 32;
            const float* wp = w_ada + (size_t)l * DM * MODW + n0 + (lane & 31) + (size_t)(256 * kq + (lane >> 5)) * MODW;
            const LAS float* cp = cond + (256 * kq + (lane >> 5)) * 32 + (lane & 31);
            f32x16 acc;
#pragma unroll
            for (int r = 0; r < 16; ++r) acc[r] = 0.f;
#pragma unroll 16
            for (int k0 = 0; k0 < 256; k0 += 2) acc = __builtin_amdgcn_mfma_f32_32x32x2f32(cp[k0 * 32], wp[(size_t)k0 * MODW], acc, 0, 0, 0);
            __syncthreads();
            LAS float* part = (LAS float*)lds + wave * 1024;
#pragma unroll
            for (int r = 0; r < 16; ++r) part[r * 64 + lane] = acc[r];
            __syncthreads();
            if (kq == 0) {
                const float bias = b_ada[l * MODW + n0 + (lane & 31)];
#pragma unroll
                for (int r = 0; r < 16; ++r) { const int b = (r & 3) + 8 * (r >> 2) + 4 * (lane >> 5);
                    MOD[((size_t)l * NB + b) * MODW + n0 + (lane & 31)] = ((part[r * 64 + lane] + part[1024 + r * 64 + lane]) + (part[2048 + r * 64 + lane] + part[3072 + r * 64 + lane])) + bias; }
            }
        }
        __syncthreads();
        }
    }
    SEAM(PH_PRO);

    for (int l = 0; l < 2; ++l) {
        const int pb = PH_L0 + l * PH_PER_LAYER;
        if (EN(1) && IN(pb + P_NORM1)) { PHASE_ENTER(); const float* modl = MOD + (size_t)l * NB * MODW;
            if (l == 0) {
#pragma unroll 1
                for (int rep = 0; rep < REP_NORM1; ++rep)
                    row_phase<true, false, true, false, false, 1>(lds, tid, lane, wave, G, bx, x_in, XB, out, g_mix, modl, 0, DM, MOD, H, YM, POS, TW, WR, TE, TRK, CNT);
            } else row_phase<false, true, true, false, false, 1>(lds, tid, lane, wave, G, bx, x_in, XB, out, g_mix + DM, modl, 0, DM, MOD, H, YM, POS, TW, WR, TE, TRK, CNT); }
            {
                SEAM(pb + P_NORM1);
                if (EN(2) && IN(pb + P_INPROJ)) {
                    PHASE_ENTER();
                    pg8::Gemm g{H, (const bf16_t*)(const GAS bf16_t*)(ws + WS_WIN + l * WIN_BYTES), DM / 2}; pg8::StaticOrder S; S.init(TT, NC, G, bx); S.wgm = INPROJ_WGM;
                    LAS float* normw = (LAS float*)(lds + MISC_OFF + 1024);
                    if (tid < 256) { const int sel = tid >> 6, d = tid & 63; const float* srcw = (sel == 0) ? qn_a : (sel == 1) ? kn_a : (sel == 2) ? qn_b : kn_b; normw[tid] = srcw[l * 64 + d]; }
                    __syncthreads();
                    pg8::EpiInProj E{QA, KA, VA, QB, KB, VB, SA, SB, normw};
#pragma unroll 1
                    for (int rep = 0; rep < REP_INPROJ; ++rep)
                    pg8::gemm_phase<pg8::EpiInProj, pg8::StaticOrder, true>(lds, g, S, E, wave);
                }
                SEAM(pb + P_INPROJ);
                if (EN(3) && IN(pb + P_ATTN)) {
                    PHASE_ENTER(); (void)lane;
                    LAS char* ring = (LAS char*)lds;
#pragma unroll 1
                    for (int rep = 0; rep < REP_ATTB; ++rep)
                    for (int L = vcu; L < NB * 32; L += G) {
                        int lane; asm volatile("v_mbcnt_lo_u32_b32 %0, -1, 0\n\tv_mbcnt_hi_u32_b32 %0, -1, %0" : "=v"(lane)); const int hi = lane >> 5;
                        const int b = L >> 5, kvh = (L >> 4) & 1, qh = 4 * kvh + ((L >> 2) & 3), qb2 = L & 3;
                        const int tq0 = 512 * qb2 + 64 * wave + (lane & 31);
                        u32x4 qr[2][2];
#pragma unroll
                        for (int g = 0; g < 2; ++g)
#pragma unroll
                            for (int e = 0; e < 2; ++e) qr[g][e] = *(const u32x4*)((const unsigned char*)QB + ((size_t)b * SEQ + tq0 + 32 * g) * 512 + qh * 64 + 32 * hi + 16 * e);
                        f32x16 o[2][2]; float lsum[2] = {0.f, 0.f};
#pragma unroll
                        for (int r = 0; r < 16; ++r) { o[0][0][r] = 0.f; o[0][1][r] = 0.f; o[1][0][r] = 0.f; o[1][1][r] = 0.f; }
                        __syncthreads();
                        att::dense64_lag_loop(ring, (const unsigned char*)KB + (size_t)b * SEQ * 128 + kvh * 64, (const unsigned char*)VB + (size_t)b * SEQ * 128 + kvh * 64, 128, 32, qr, o, lsum, lane, wave, wave >= 4);
                        { int l2; asm volatile("v_mbcnt_lo_u32_b32 %0, -1, 0\n\tv_mbcnt_hi_u32_b32 %0, -1, %0" : "=v"(l2)); const int tqs = 512 * qb2 + 64 * wave + (l2 & 31);
#pragma unroll
                          for (int g = 0; g < 2; ++g) att::store_out(o[g], lsum[g], (unsigned char*)YAB + ((size_t)b * SEQ + tqs + 32 * g) * DM + 512 + qh * 64, l2); }
                    }
#pragma unroll 1
                    for (int rep = 0; rep < REP_ATTA; ++rep)
                    for (int L = vcu; L < NB * 32; L += G) {
                        int lane; asm volatile("v_mbcnt_lo_u32_b32 %0, -1, 0\n\tv_mbcnt_hi_u32_b32 %0, -1, %0" : "=v"(lane)); const int hi = lane >> 5;
                        const int b = L >> 5, h = (L >> 2) & 7, tb2 = L & 3, base = 512 * tb2;
                        const int tq0 = base + 16 * (lane & 31) + wave, tq1 = tq0 + 8;
                        const unsigned char* Kg = (const unsigned char*)KA + (size_t)b * SEQ * 512 + h * 64; const unsigned char* Vg = (const unsigned char*)VA + (size_t)b * SEQ * 512 + h * 64;
                        u32x4 qr[2][2];
#pragma unroll
                        for (int g = 0; g < 2; ++g)
#pragma unroll
                            for (int e = 0; e < 2; ++e) qr[g][e] = *(const u32x4*)((const unsigned char*)QA + ((size_t)b * SEQ + tq0 + 8 * g) * 512 + h * 64 + 32 * hi + 16 * e);
                        f32x16 o[2][2]; float lsum[2] = {0.f, 0.f};
#pragma unroll
                        for (int r = 0; r < 16; ++r) { o[0][0][r] = 0.f; o[0][1][r] = 0.f; o[1][0][r] = 0.f; o[1][1][r] = 0.f; }
                        __syncthreads();
                        att::dense64_loop<true>(ring, Kg, Vg, 512, base - 64, 10, qr, o, lsum, tq0, tq1, lane, wave);
                        __syncthreads();
                        {
                            LAS char* vpriv = ring + att::PRIV_OFF + wave * att::VTILE;
#define A_TK0(j) ((j) < 4 ? base + wave - 256 + 256 * (j) : wave + 8 * (((j) - 4) >> 1) + 1024 * (((j) - 4) & 1))
#define A_DK(j) ((j) < 4 ? 4 : 16)
                            u32x4 kf[2][2];
                            att::priv_kload(kf, Kg, 512, A_TK0(0), 4, lane);
#pragma unroll 1
                            for (int j = 0; j < 8; ++j) {
                                const bool p2 = j < 4; const int g = (j - 4) >> 1;
                                att::priv2_step(kf, vpriv, Kg, Vg, 512, A_TK0(j), A_DK(j), p2 || g == 0, p2 || g == 1, j + 1 < 8, A_TK0(j + 1), A_DK(j + 1), qr, o, lsum, tq0, tq1, lane);
                            }
#undef A_TK0
#undef A_DK
                        }
                        { int l2; asm volatile("v_mbcnt_lo_u32_b32 %0, -1, 0\n\tv_mbcnt_hi_u32_b32 %0, -1, %0" : "=v"(l2)); const int tqs = base + 16 * (l2 & 31) + wave;
#pragma unroll
                          for (int g = 0; g < 2; ++g) att::store_out(o[g], lsum[g], (unsigned char*)YAB + ((size_t)b * SEQ + tqs + 8 * g) * DM + h * 64, l2); }
                    }
                    __syncthreads();
                }
                SEAM(pb + P_ATTN);
                if (EN(4) && IN(pb + P_PAB)) {
                    PHASE_ENTER();
                    pg8::StaticOrder S; S.init(TT, DM, G, bx); S.wgm = N1K_WGM;
                    pg8::Gemm g{YAB, (const bf16_t*)(const GAS bf16_t*)(ws + WS_WPA + l * 2 * MiB), DM / 2}; pg8::EpiMergeFused E{MERGED, (const unsigned char*)PGATE_A, (const unsigned char*)PGATE_B};
#pragma unroll 1
                    for (int rep = 0; rep < REP_PAB; ++rep)
                    pg8::gemm_phase<pg8::EpiMergeFused, pg8::StaticOrder, true>(lds, g, S, E, wave);
                }
                SEAM(pb + P_PAB);
                if (EN(5) && IN(pb + P_OUT)) {
                    PHASE_ENTER(); const float* modl = MOD + (size_t)l * NB * MODW;
                    pg8::Gemm g{MERGED, (const bf16_t*)(const GAS bf16_t*)(ws + WS_WOUT + l * 2 * MiB), DM / 2}; pg8::StaticOrder S; S.init(TT, DM, G, bx); S.rowmajor = OUT_ROWMAJOR; S.wgm = N1K_WGM;
                    pg8::EpiResidB E{(l == 0) ? x_in : (const float*)nullptr, XB, XB, modl + 2 * DM};
#pragma unroll 1
                    for (int rep = 0; rep < ((l == 0) ? REP_OUT : 1); ++rep)
                    pg8::gemm_phase<pg8::EpiResidB, pg8::StaticOrder, true>(lds, g, S, E, wave);
                }
                SEAM(pb + P_OUT);
            }
        if (EN(6) && IN(pb + P_NORM2)) { PHASE_ENTER(); const float* modl = MOD + (size_t)l * NB * MODW;
#pragma unroll 1
            for (int rep = 0; rep < REP_NORM2; ++rep)
            row_phase<false, false, true, true, false, GU_F8 ? 2 : 0>(lds, tid, lane, wave, G, bx, x_in, XB, out, g_ffn + l * DM, modl, 3 * DM, 4 * DM, MOD, H, YM, POS, TW, WR, TE, TRK, CNT, H2F8); }
        SEAM(pb + P_NORM2);
        if (EN(7) && IN(pb + P_PLACE)) {
            PHASE_ENTER();
            LAS int* part_tot = (LAS int*)lds;
            LAS int* part_pre = part_tot + 512;
            LAS int* basee = part_pre + 512;
            LAS int* pstart = basee + 32;
            LAS int* pend = pstart + 32;
            LAS int* tote = pend + 32;
            for (int chunk = bx; chunk < 256; chunk += G) {
                { const int e = tid & 31, part = tid >> 5; int st = 0, sp = 0;
                    for (int q = 0; q < 16; ++q) { const int ch = part * 16 + q; const int v = CNT[ch * 32 + e]; st += v; sp += (ch < chunk) ? v : 0; }
                    part_tot[part * 32 + e] = st; part_pre[part * 32 + e] = sp; }
                __syncthreads();
                if (tid < 32) { int st = 0, sp = 0; for (int q = 0; q < 16; ++q) { st += part_tot[q * 32 + tid]; sp += part_pre[q * 32 + tid]; } tote[tid] = st; basee[tid] = sp; }
                __syncthreads();
                if (tid == 0) { int run = 0; for (int e = 0; e < 32; ++e) { const int padded = (tote[e] + 255) & ~255; pstart[e] = run; basee[e] += run; run += padded; pend[e] = run; } }
                __syncthreads();
                { const int tok = chunk * 256 + (tid >> 1), slot = tid & 1; const int e = TE[2 * tok + slot], rk = TRK[2 * tok + slot]; const int dest = basee[e] + rk;
                    BTOK[dest] = tok; POS[2 * tok + slot] = dest; }
                if (chunk < 32) { const int e = chunk; const int from = pstart[e] + tote[e], n = pend[e] - from; if (tid < n) BTOK[from + tid] = 0; }
                if (chunk == 0) {
                    for (int blk = tid; blk < NBLK; blk += 512) { int e = 0; for (int q = 0; q < 32; ++q) e += (pend[q] <= blk * 256) ? 1 : 0; BLKE[blk] = e > 31 ? 31 : e; }
                    if (tid == 0) BLKE[1000] = pend[31] >> 8;
                }
                __syncthreads();
            }
        }
        SEAM(pb + P_PLACE);
        if (EN(8) && IN(pb + P_GU)) {
            PHASE_ENTER();
            const int nused = BLKE[1000];
            pg8::Gemm g{GU_F8 ? (const bf16_t*)H2F8 : H, (const bf16_t*)(const GAS bf16_t*)(ws + WS_WGU + (size_t)l * NEXP * (GU_F8 ? MiB : 2 * MiB)), GU_F8 ? DM / 2 : DM};
            pg8::MoeOrder<true> S{BLKE, BTOK, 4 * nused, G, vcu};
            pg8::EpiSwiGLU E{ACT, GU_F8 ? W8I : 1.0f};
#pragma unroll 1
            for (int rep = 0; rep < REP_GU; ++rep)
            pg8::gemm_phase<pg8::EpiSwiGLU, pg8::MoeOrder<true>, GU_F8 != 0>(lds, g, S, E, wave);
        }
        SEAM(pb + P_GU);
        if (EN(9) && IN(pb + P_DOWN)) {
            PHASE_ENTER();
            const int nused = BLKE[1000];
            pg8::Gemm g{ACT, (const bf16_t*)(const GAS bf16_t*)(ws + WS_WDN + (size_t)l * NEXP * (DN_F8 ? MiB / 2 : MiB)), DN_F8 ? DFF / 2 : DFF};
            pg8::MoeOrder<false> S{BLKE, nullptr, 4 * nused, G, vcu};
            pg8::EpiY E{YM};
#pragma unroll 1
            for (int rep = 0; rep < REP_DOWN; ++rep)
            pg8::gemm_phase<pg8::EpiY, pg8::MoeOrder<false>, DN_F8 != 0>(lds, g, S, E, wave);
        }
        SEAM(pb + P_DOWN);
    }
    if (EN(10) && IN(PH_FINAL)) {
        PHASE_ENTER();
        row_phase<false, true, false, false, true>(lds, tid, lane, wave, G, bx, x_in, XB, out, g_ffn, MOD, 0, 0, MOD + (size_t)NB * MODW, H, YM, POS, TW, WR, TE, TRK, CNT);
    }
#undef IN
#undef SEAM
#undef GRID_BAR
}

extern "C" void kernel_launch(void* const* d_in, const int* in_sizes, int n_in, void* d_out, int out_size, void* d_ws, size_t ws_size, hipStream_t stream) {
    static int grid = 0;
    if (grid == 0) {
        if (n_in != 18 || in_sizes[0] != TT * DM || out_size != TT * DM || ws_size < WS_END) { fprintf(stderr, "kernel_launch: unexpected shapes / workspace (n_in %d, ws %zu); nothing launched\n", n_in, ws_size); grid = -1; return; }
        int dev = 0, cus = 0, per_cu = 0;
        if (hipGetDevice(&dev) != hipSuccess || hipDeviceGetAttribute(&cus, hipDeviceAttributeMultiprocessorCount, dev) != hipSuccess) { grid = -1; return; }
        if (hipFuncSetAttribute((const void*)fwd_kernel, hipFuncAttributeMaxDynamicSharedMemorySize, LDS_BYTES) != hipSuccess) { fprintf(stderr, "kernel_launch: hipFuncSetAttribute failed\n"); grid = -1; return; }
        if (hipOccupancyMaxActiveBlocksPerMultiprocessor(&per_cu, (const void*)fwd_kernel, 512, LDS_BYTES) != hipSuccess || per_cu < 1) { fprintf(stderr, "kernel_launch: occupancy query says %d\n", per_cu); per_cu = 1; }
        (void)hipGetLastError();
        grid = cus;
    }
    if (grid < 0) return;
    (void)hipMemsetAsync((char*)d_ws + WS_CTL, 0, CTL_ZERO_BYTES, stream);
    Args a{};
    for (int i = 0; i < 18; ++i) a.in[i] = (const float*)d_in[i];
    a.out = (float*)d_out; a.ws = (unsigned char*)d_ws;
#if MK_ONE_LAUNCH
    a.ph_lo = 0; a.ph_hi = NPH;
    hipLaunchKernelGGL(fwd_kernel, dim3(grid), dim3(512), LDS_BYTES, stream, a);
#else
    for (int p = 0; p < NPH; ++p) { a.ph_lo = p; a.ph_hi = p + 1; hipLaunchKernelGGL(fwd_kernel, dim3(grid), dim3(512), LDS_BYTES, stream, a); }
#endif
}
```
